# Optimizing an MI355X kernel written in HIP

```python
import jax, jax.numpy as jnp
from jax import lax
import numpy as np

D_MODEL = 1024
BATCH = 8
SEQ = 4096
DEPTH = 1

N_HEADS_ATTN = 8
HEAD_DIM = 64
ATTN_WIDTH = N_HEADS_ATTN * HEAD_DIM
MOBA_BLOCK = 256
MOBA_TOPK = 3
Q_CHUNK = 32
ROPE_THETA = 500000.0
ROT_DIM = HEAD_DIM // 4
CONV_WIDTH = 512
CONV_K = 3
N_BRANCH = 2
IN_COLS = 3 * ATTN_WIDTH + 3 * CONV_WIDTH + N_BRANCH * D_MODEL
N_GROUPS = 4
EXPERTS_PER_GROUP = 8
N_EXPERTS = N_GROUPS * EXPERTS_PER_GROUP
TOPK_IN_GROUP = 2
D_EXPERT = 512
MOE_BLOCK = 128
N_MOD = 6
EPS = 1e-6

kernel_name = "hybrid_moba_shortconv_hmoe_block"


def rms_norm(x, g):
    xf = x.astype(jnp.float32)
    y = xf * lax.rsqrt(jnp.mean(xf * xf, axis=-1, keepdims=True) + EPS)
    return (y * g.astype(jnp.float32)).astype(x.dtype)


def modulate(h, shift, scale):
    return h * (1 + scale[:, None, :]) + shift[:, None, :]


def rope_tables(seq_len, dtype):
    pos = jnp.arange(seq_len, dtype=jnp.float32)
    inv_freq = ROPE_THETA ** (-jnp.arange(0, ROT_DIM, 2, dtype=jnp.float32) / ROT_DIM)
    ang = pos[:, None] * inv_freq[None, :]
    return jnp.cos(ang).astype(dtype), jnp.sin(ang).astype(dtype)


def partial_rope(x, cos, sin):
    half = ROT_DIM // 2
    x1, x2, xp = x[..., :half], x[..., half:ROT_DIM], x[..., ROT_DIM:]
    return jnp.concatenate([x1 * cos - x2 * sin, x2 * cos + x1 * sin, xp], axis=-1)


def moba_attention(q, k, v):
    B, H, S, dh = q.shape
    nb = -(-S // MOBA_BLOCK)
    pad = nb * MOBA_BLOCK - S
    kb = jnp.pad(k, ((0, 0), (0, 0), (0, pad), (0, 0))).reshape(B, H, nb, MOBA_BLOCK, dh)
    vb = jnp.pad(v, ((0, 0), (0, 0), (0, pad), (0, 0))).reshape(B, H, nb, MOBA_BLOCK, dh)
    kmean = jnp.mean(kb.astype(jnp.float32), axis=3)
    topk = min(MOBA_TOPK, nb)
    scale = HEAD_DIM ** -0.5
    b_ix = jnp.arange(B)[:, None, None, None]
    h_ix = jnp.arange(H)[None, :, None, None]
    blk_ids = jnp.arange(nb)
    t_in_blk = jnp.arange(MOBA_BLOCK)

    def chunk(ci):
        q0 = ci * Q_CHUNK
        qc = lax.dynamic_slice_in_dim(q, q0, Q_CHUNK, axis=2)
        qpos = q0 + jnp.arange(Q_CHUNK)
        cur = q0 // MOBA_BLOCK
        gate = jnp.einsum('bhqd,bhnd->bhqn', qc.astype(jnp.float32), kmean)
        gate = jnp.where(blk_ids < cur, gate, -jnp.inf)
        _, sel = lax.top_k(gate, topk)
        sel_valid = jnp.arange(topk) < cur
        k_sel = kb[b_ix, h_ix, sel]
        v_sel = vb[b_ix, h_ix, sel]
        s_sel = jnp.einsum('bhqd,bhqntd->bhqnt', qc, k_sel).astype(jnp.float32) * scale
        s_sel = jnp.where(sel_valid[:, None], s_sel, -jnp.inf)
        k_own = lax.dynamic_index_in_dim(kb, cur, axis=2, keepdims=False)
        v_own = lax.dynamic_index_in_dim(vb, cur, axis=2, keepdims=False)
        s_own = jnp.einsum('bhqd,bhtd->bhqt', qc, k_own).astype(jnp.float32) * scale
        kpos = cur * MOBA_BLOCK + t_in_blk
        s_own = jnp.where(kpos[None, :] <= qpos[:, None], s_own, -jnp.inf)
        logits = jnp.concatenate([s_sel.reshape(B, H, Q_CHUNK, topk * MOBA_BLOCK), s_own], axis=-1)
        p = jax.nn.softmax(logits, axis=-1).astype(v.dtype)
        p_sel = p[..., :topk * MOBA_BLOCK].reshape(B, H, Q_CHUNK, topk, MOBA_BLOCK)
        p_own = p[..., topk * MOBA_BLOCK:]
        return (jnp.einsum('bhqnt,bhqntd->bhqd', p_sel, v_sel)
                + jnp.einsum('bhqt,bhtd->bhqd', p_own, v_own))

    out = lax.map(chunk, jnp.arange(S // Q_CHUNK))
    return out.transpose(1, 2, 0, 3, 4).reshape(B, H, S, dh)


def short_gated_conv(xb, bg, cg, conv_w, conv_b):
    u = cg * xb
    y = lax.conv_general_dilated(u, conv_w[:, None, :], window_strides=(1,), padding=[(CONV_K - 1, 0)],
                                 dimension_numbers=('NWC', 'WIO', 'NWC'), feature_group_count=CONV_WIDTH)
    return bg * (y + conv_b)


def hierarchical_moe(h, w_rg, b_rg, w_re, b_re, w1, w3, w2):
    B, S, D = h.shape
    T = B * S
    xt = h.reshape(T, D)
    g_logits = (xt @ w_rg).astype(jnp.float32) + b_rg.astype(jnp.float32)
    g_prob = jax.nn.softmax(g_logits, axis=-1)
    g_idx = jnp.argmax(g_logits, axis=-1)
    g_w = jnp.take_along_axis(g_prob, g_idx[:, None], axis=-1)
    e_logits = ((xt @ w_re).astype(jnp.float32) + b_re.astype(jnp.float32)).reshape(T, N_GROUPS, EXPERTS_PER_GROUP)
    e_logits = jnp.take_along_axis(e_logits, g_idx[:, None, None], axis=1)[:, 0]
    e_val, e_loc = lax.top_k(e_logits, TOPK_IN_GROUP)
    e_w = jax.nn.softmax(e_val, axis=-1) * g_w
    e_id = g_idx[:, None].astype(jnp.int32) * EXPERTS_PER_GROUP + e_loc.astype(jnp.int32)

    n_assign = T * TOPK_IN_GROUP
    flat_e = e_id.reshape(-1)
    flat_w = e_w.reshape(-1)
    order = jnp.argsort(flat_e)
    sorted_e = flat_e[order]
    counts = jnp.bincount(flat_e, length=N_EXPERTS)
    padded = (counts + MOE_BLOCK - 1) // MOE_BLOCK * MOE_BLOCK
    start = jnp.cumsum(counts) - counts
    pad_end = jnp.cumsum(padded)
    pad_start = pad_end - padded
    dest = pad_start[sorted_e] + (jnp.arange(n_assign) - start[sorted_e])
    n_pad = (-(-n_assign // MOE_BLOCK) + N_EXPERTS) * MOE_BLOCK
    n_blocks = n_pad // MOE_BLOCK
    tok = jnp.full((n_pad,), T, jnp.int32).at[dest].set((order // TOPK_IN_GROUP).astype(jnp.int32))
    wpad = jnp.zeros((n_pad,), jnp.float32).at[dest].set(flat_w[order])
    blk_start = jnp.arange(n_blocks) * MOE_BLOCK
    blk_expert = jnp.minimum(jnp.sum(pad_end[None, :] <= blk_start[:, None], axis=-1), N_EXPERTS - 1)
    x_ext = jnp.concatenate([xt, jnp.zeros((1, D), xt.dtype)], axis=0)
    xs = x_ext[tok].reshape(n_blocks, MOE_BLOCK, D)

    def expert_block(args):
        xb, e = args
        hid = jax.nn.silu(xb @ w1[e]) * (xb @ w3[e])
        return hid @ w2[e]

    ys = lax.map(expert_block, (xs, blk_expert)).reshape(n_pad, D)
    ys = ys * wpad[:, None].astype(ys.dtype)
    out = jnp.zeros((T + 1, D), ys.dtype).at[tok].add(ys)[:T]
    return out.reshape(B, S, D)


def setup_inputs(seed: int = 0) -> dict:
    key = jax.random.key(seed)
    ks = jax.random.split(key, 24)
    L, D = DEPTH, D_MODEL
    f32 = jnp.float32
    nrm = lambda k, shape, s: jax.random.normal(k, shape, f32) * s
    return {
        "x": nrm(ks[0], (BATCH, SEQ, D), 1.0),
        "c": nrm(ks[1], (BATCH, D), 1.0),
        "w_ada": nrm(ks[2], (L, D, N_MOD * D), 0.5 * D ** -0.5),
        "b_ada": nrm(ks[3], (L, N_MOD * D), 0.02),
        "g_norm1": 1.0 + nrm(ks[4], (L, D), 0.02),
        "g_norm2": 1.0 + nrm(ks[5], (L, D), 0.02),
        "w_in": nrm(ks[6], (L, D, IN_COLS), D ** -0.5),
        "g_q": 1.0 + nrm(ks[7], (L, HEAD_DIM), 0.02),
        "g_k": 1.0 + nrm(ks[8], (L, HEAD_DIM), 0.02),
        "conv_w": nrm(ks[9], (L, CONV_K, CONV_WIDTH), CONV_K ** -0.5),
        "conv_b": nrm(ks[10], (L, CONV_WIDTH), 0.02),
        "w_pa": nrm(ks[11], (L, ATTN_WIDTH, D), ATTN_WIDTH ** -0.5),
        "w_pb": nrm(ks[12], (L, CONV_WIDTH, D), CONV_WIDTH ** -0.5),
        "w_o": nrm(ks[13], (L, D, D), D ** -0.5),
        "w_rg": nrm(ks[14], (L, D, N_GROUPS), D ** -0.5),
        "b_rg": nrm(ks[15], (L, N_GROUPS), 0.01),
        "w_re": nrm(ks[16], (L, D, N_EXPERTS), D ** -0.5),
        "b_re": nrm(ks[17], (L, N_EXPERTS), 0.01),
        "w1": nrm(ks[18], (L, N_EXPERTS, D, D_EXPERT), D ** -0.5),
        "w3": nrm(ks[19], (L, N_EXPERTS, D, D_EXPERT), D ** -0.5),
        "w2": nrm(ks[20], (L, N_EXPERTS, D_EXPERT, D), D_EXPERT ** -0.5),
    }


def reference(x, c, w_ada, b_ada, g_norm1, g_norm2, w_in, g_q, g_k, conv_w, conv_b,
              w_pa, w_pb, w_o, w_rg, b_rg, w_re, b_re, w1, w3, w2):
    B, S, D = x.shape
    cos, sin = rope_tables(S, x.dtype)
    splits = [ATTN_WIDTH, 2 * ATTN_WIDTH, 3 * ATTN_WIDTH,
              3 * ATTN_WIDTH + CONV_WIDTH, 3 * ATTN_WIDTH + 2 * CONV_WIDTH, 3 * ATTN_WIDTH + 3 * CONV_WIDTH]
    for l in range(DEPTH):
        mod = jax.nn.silu(c) @ w_ada[l] + b_ada[l]
        sh1, sc1, ga1, sh2, sc2, ga2 = jnp.split(mod, N_MOD, axis=-1)

        h = modulate(rms_norm(x, g_norm1[l]), sh1, sc1)
        z = h @ w_in[l]
        q, k, v, xb, bg, cg, gates = jnp.split(z, splits, axis=-1)
        to_heads = lambda t: t.reshape(B, S, N_HEADS_ATTN, HEAD_DIM).transpose(0, 2, 1, 3)
        q = partial_rope(rms_norm(to_heads(q), g_q[l]), cos, sin)
        k = partial_rope(rms_norm(to_heads(k), g_k[l]), cos, sin)
        v = to_heads(v)
        y_a = moba_attention(q, k, v).transpose(0, 2, 1, 3).reshape(B, S, ATTN_WIDTH)
        y_b = short_gated_conv(xb, bg, cg, conv_w[l], conv_b[l])
        gate_a, gate_b = jnp.split(jax.nn.sigmoid(gates), N_BRANCH, axis=-1)
        merged = gate_a * (y_a @ w_pa[l]) + gate_b * (y_b @ w_pb[l])
        x = x + ga1[:, None, :] * (merged @ w_o[l])

        h2 = modulate(rms_norm(x, g_norm2[l]), sh2, sc2)
        x = x + ga2[:, None, :] * hierarchical_moe(h2, w_rg[l], b_rg[l], w_re[l], b_re[l], w1[l], w3[l], w2[l])
    return x
```

```cpp
#include <hip/hip_runtime.h>
#include <hip/hip_bf16.h>
#include <cstdio>
#include <cstdint>

#define GAS __attribute__((address_space(1)))
#define LAS __attribute__((address_space(3)))
typedef unsigned short bf16_t;
typedef short bf16x8 __attribute__((ext_vector_type(8)));
typedef float f32x4 __attribute__((ext_vector_type(4)));
typedef unsigned u32x4 __attribute__((ext_vector_type(4)));
typedef unsigned u32x2 __attribute__((ext_vector_type(2)));

constexpr int T = 32768, D = 1024, NB = 8, S = 4096, NH = 8, DH = 64, NIN = 5120, NE = 32, DE = 512, NMOD = 6144;
constexpr int NTHREADS = 512, NWAVES = 8;
constexpr float EPS = 1e-6f;
constexpr float C2 = 0.125f * 1.4426950408889634f;
constexpr int MAX_MT = 288;
constexpr int NPAD = MAX_MT * 256;

constexpr size_t MiB = 1u << 20, KiB = 1024;
constexpr size_t WS_CTL = 0, CTL_ZERO_BYTES = 1 * MiB;
constexpr size_t WS_MOD = 1 * MiB;
constexpr size_t WS_ROPE = 1 * MiB + 256 * KiB;
constexpr size_t WS_KMEAN = 1 * MiB + 512 * KiB;
constexpr size_t WS_EID = 2 * MiB;
constexpr size_t WS_EW = 2 * MiB + 256 * KiB;
constexpr size_t WS_BCNT = 2 * MiB + 512 * KiB;
constexpr size_t WS_TILEE = 2 * MiB + 768 * KiB;
constexpr size_t WS_ATOK = 3 * MiB;
constexpr size_t WS_AINFO = 3 * MiB + 512 * KiB;
constexpr size_t WS_AW = 4 * MiB;
constexpr size_t WS_WIN_T = 8 * MiB;
constexpr size_t WS_WP_T = 18 * MiB;
constexpr size_t WS_WO_T = 20 * MiB;
constexpr size_t WS_W13_T = 24 * MiB;
constexpr size_t WS_W2_T = 88 * MiB;
constexpr size_t WS_H = 120 * MiB;
constexpr size_t WS_YAB = 184 * MiB;
constexpr size_t WS_K = 248 * MiB;
constexpr size_t WS_V = 280 * MiB;
constexpr size_t WS_U = 312 * MiB;
constexpr size_t WS_BG = 344 * MiB;
constexpr size_t WS_GATES = 376 * MiB;
constexpr size_t WS_H2 = 184 * MiB;
constexpr size_t WS_HID = 248 * MiB;
constexpr size_t WS_YSLOT = 320 * MiB;
constexpr size_t WS_END = 504 * MiB;
constexpr int CW_BAR = 4096;

constexpr int LDS_BYTES = 159744;
constexpr int MISC_OFF = 147456;

__device__ __forceinline__ unsigned f2bf(float f) { unsigned u = __builtin_bit_cast(unsigned, f); return (u + 0x7fffu + ((u >> 16) & 1u)) >> 16; }
__device__ __forceinline__ float bf2f(unsigned h) { return __builtin_bit_cast(float, h << 16); }
__device__ __forceinline__ unsigned pk2(float lo, float hi) { return f2bf(lo) | (f2bf(hi) << 16); }
__device__ __forceinline__ void unpack8(const u32x4 w, float (&v)[8]) {
    v[0] = bf2f(w.x & 0xffffu); v[1] = bf2f(w.x >> 16); v[2] = bf2f(w.y & 0xffffu); v[3] = bf2f(w.y >> 16);
    v[4] = bf2f(w.z & 0xffffu); v[5] = bf2f(w.z >> 16); v[6] = bf2f(w.w & 0xffffu); v[7] = bf2f(w.w >> 16);
}
__device__ __forceinline__ u32x4 pack8(const float (&v)[8]) { u32x4 w; w.x = pk2(v[0], v[1]); w.y = pk2(v[2], v[3]); w.z = pk2(v[4], v[5]); w.w = pk2(v[6], v[7]); return w; }
#define LDS_WAIT() asm volatile("s_waitcnt lgkmcnt(0)" ::: "memory")
__device__ __forceinline__ int lds_add(LAS int* p, int v) { return __hip_atomic_fetch_add(p, v, __ATOMIC_RELAXED, __HIP_MEMORY_SCOPE_WORKGROUP); }

#define XB_TMO      128
#define XB_XCNT(j)  (256  + 64 * (j))
#define XB_XSUB(j)  (1280 + 64 * (j))
#define XB_XGEN(j)  (2304 + 64 * (j))
#define XB_TOP      3328
#define XB_TOPGEN   3392
#define XCD_BAR_WORDS 3456
#define XB_SPIN_CAP (1u << 22)
__device__ __forceinline__ unsigned xb_ld(unsigned* p)              { return __hip_atomic_load(p, __ATOMIC_RELAXED, __HIP_MEMORY_SCOPE_AGENT); }
__device__ __forceinline__ unsigned xb_add(unsigned* p, unsigned v) { return __hip_atomic_fetch_add(p, v, __ATOMIC_RELAXED, __HIP_MEMORY_SCOPE_AGENT); }
__device__ __forceinline__ unsigned xb_xcc_id() { return (unsigned)__builtin_amdgcn_s_getreg((3 << 11) | 20) & 0xFu; }
#define XB_SPIN(cond, bar) do { unsigned _sp = 0; while (cond) { __builtin_amdgcn_s_sleep(1); \
    if ((++_sp & 255u) == 0u) { if (xb_ld(&(bar)[XB_TMO])) break; if (_sp > XB_SPIN_CAP) { atomicAdd(&(bar)[XB_TMO], 1u); break; } } } } while (0)
struct XcdBarrier { unsigned* bar; unsigned x; volatile LAS unsigned* st; };
__device__ __forceinline__ XcdBarrier xcd_barrier_post(unsigned* bar, volatile LAS unsigned* st) {
    XcdBarrier b; b.bar = bar; b.x = xb_xcc_id(); b.st = st;
    if (threadIdx.x == 0) (void)xb_add(&bar[XB_XCNT(b.x)], 1u);
    return b;
}
__device__ __forceinline__ void xcd_barrier_complete(unsigned* bar, unsigned x, unsigned& nloc, unsigned& nx) {
    const unsigned G = gridDim.x * gridDim.y * gridDim.z;
    unsigned sum, cnt, mine, sp = 0u;
    for (;;) {
        sum = 0u; cnt = 0u; mine = 0u;
#pragma unroll
        for (unsigned j = 0; j < 16; ++j) { const unsigned c = xb_ld(&bar[XB_XCNT(j)]); sum += c; cnt += (c > 0u) ? 1u : 0u; mine = (j == x) ? c : mine; }
        if (sum == G) break;
        __builtin_amdgcn_s_sleep(1);
        if ((++sp & 255u) == 0u) { if (xb_ld(&bar[XB_TMO])) break; if (sp > XB_SPIN_CAP) { atomicAdd(&bar[XB_TMO], 1u); break; } }
    }
    nloc = mine > 0u ? mine : 1u; nx = cnt > 0u ? cnt : 1u;
}
__device__ __forceinline__ void xcd_barrier(const XcdBarrier& b) {
    asm volatile("s_waitcnt vmcnt(0)" ::: "memory");
    __syncthreads();
    if (threadIdx.x == 0) {
        unsigned* bar = b.bar;
        __builtin_amdgcn_s_waitcnt(0);
        unsigned nloc = b.st[0], nx = b.st[1];
        if (nloc == 0u) { xcd_barrier_complete(bar, b.x, nloc, nx); b.st[0] = nloc; b.st[1] = nx; }
        const unsigned old = xb_add(&bar[XB_XSUB(b.x)], 1u);
        const unsigned gen = old / nloc;
        if (old + 1u == (gen + 1u) * nloc) {
            __builtin_amdgcn_fence(__ATOMIC_RELEASE, "agent");
            asm volatile("s_waitcnt vmcnt(0)" ::: "memory");
            const unsigned og = xb_add(&bar[XB_TOP], 1u);
            const unsigned tg = og / nx;
            if (og + 1u == (tg + 1u) * nx) xb_add(&bar[XB_TOPGEN], 1u);
            else XB_SPIN(xb_ld(&bar[XB_TOPGEN]) == tg, bar);
            __builtin_amdgcn_fence(__ATOMIC_ACQUIRE, "agent");
            xb_add(&bar[XB_XGEN(b.x)], 1u);
            asm volatile("s_waitcnt vmcnt(0)" ::: "memory");
        } else {
            XB_SPIN(xb_ld(&bar[XB_XGEN(b.x)]) == gen, bar);
            __builtin_amdgcn_fence(__ATOMIC_ACQUIRE, "agent");
            asm volatile("s_waitcnt vmcnt(0)" ::: "memory");
        }
    }
    __syncthreads();
}

struct Frame {
    LAS unsigned char* lds;
    int tid, lane, wave, G;
    const float *x, *c, *w_ada, *b_ada, *g1, *g2, *w_in, *g_q, *g_k, *conv_w, *conv_b, *w_pa, *w_pb, *w_o, *w_rg, *b_rg, *w_re, *b_re, *w1, *w3, *w2;
    float* out; unsigned char* ws;
};
#define WSP(type, off) ((type*)(F.ws + (off)))

__device__ __forceinline__ void transpose_item(const float* W, int N, int k0, int n0, bf16_t* dst  , int pitch, LAS float* scr, int lane) {
#pragma unroll 8
    for (int i = 0; i < 32; ++i) { const int kk = 2 * i + (lane >> 5); scr[kk * 33 + (lane & 31)] = W[(size_t)(k0 + kk) * N + n0 + (lane & 31)]; }
    LDS_WAIT(); asm volatile("" ::: "memory");
    const int c = lane & 7;
#pragma unroll
    for (int j = 0; j < 4; ++j) { const int n = (lane >> 3) + 8 * j; const LAS float* s = scr + (8 * c) * 33 + n;
        u32x4 o; o.x = pk2(s[0 * 33], s[1 * 33]); o.y = pk2(s[2 * 33], s[3 * 33]); o.z = pk2(s[4 * 33], s[5 * 33]); o.w = pk2(s[6 * 33], s[7 * 33]);
        *(u32x4*)(dst + (size_t)n * pitch + 8 * c) = o; }
    LDS_WAIT(); asm volatile("" ::: "memory");
}
__device__ __forceinline__ int win_dest_row(int sc) {
    if (sc < 32) { const int isk = sc >> 4, s2 = sc & 15, hh = s2 >> 1, bj = s2 & 1; return 512 * isk + 256 * (hh >> 2) + 128 * bj + 32 * (hh & 3); }
    if (sc < 48) return 32 * sc;
    if (sc < 64) { const int cx = 32 * (sc - 48); return 256 * (6 + (cx >> 7)) + (cx & 127); }
    if (sc < 80) return 2560 + 32 * (sc - 64);
    if (sc < 96) { const int cx = 32 * (sc - 80); return 256 * (6 + (cx >> 7)) + 128 + (cx & 127); }
    return 3072 + 32 * (sc - 96);
}
__device__ __forceinline__ void s0_prologue(Frame& F) {
    const int gt = blockIdx.x * NTHREADS + F.tid;
    if (gt < NB * NH * 16 * 64) WSP(float, WS_KMEAN)[gt] = 0.f;
    if (gt < S * 8) { const int pos = gt >> 3, i = gt & 7; const float inv = powf(500000.0f, -(float)(2 * i) / 16.0f); const float ang = (float)pos * inv;
        WSP(float2, WS_ROPE)[gt] = make_float2(cosf(ang), sinf(ang)); }
    if (blockIdx.x < 192) {
        LAS float* sc = (LAS float*)F.lds;
        for (int i = F.tid; i < NB * D; i += NTHREADS) { const float v = F.c[i]; sc[i] = v / (1.f + expf(-v)); }
        __syncthreads();
        const int j0 = blockIdx.x * 32, col = j0 + (F.lane & 31), kpar = F.lane >> 5;
        float acc[8];
#pragma unroll
        for (int b = 0; b < 8; ++b) acc[b] = 0.f;
        for (int i = 0; i < 64; ++i) { const int k = F.wave * 128 + 2 * i + kpar; const float w = F.w_ada[(size_t)k * NMOD + col];
#pragma unroll
            for (int b = 0; b < 8; ++b) acc[b] += sc[b * D + k] * w; }
#pragma unroll
        for (int b = 0; b < 8; ++b) acc[b] += __shfl_xor(acc[b], 32);
        LAS float* red = (LAS float*)(F.lds + 32768);
        if (F.lane < 32) {
#pragma unroll
            for (int b = 0; b < 8; ++b) red[(F.wave * 8 + b) * 32 + F.lane] = acc[b]; }
        __syncthreads();
        if (F.tid < 256) { const int b = F.tid >> 5, cc = F.tid & 31; float s = F.b_ada[j0 + cc];
#pragma unroll
            for (int w = 0; w < 8; ++w) s += red[(w * 8 + b) * 32 + cc];
            WSP(float, WS_MOD)[b * NMOD + j0 + cc] = s; }
        __syncthreads();
    }
    LAS float* scr = (LAS float*)(F.lds + F.wave * 16384);
    const int gw = blockIdx.x * NWAVES + F.wave, NGW = F.G * NWAVES;
    constexpr int I_IN = 16 * 160, I_PA = 8 * 32, I_O = 16 * 32, I_E1 = 16 * 16, I_E2 = 8 * 32;
    constexpr int NITEMS = I_IN + 2 * I_PA + I_O + NE * (2 * I_E1 + I_E2);
    for (int it = gw; it < NITEMS; it += NGW) {
        int r = it;
        if (r < I_IN) { const int kb = r / 160, sc = r % 160; transpose_item(F.w_in, NIN, 64 * kb, 32 * sc, WSP(bf16_t, WS_WIN_T) + (size_t)win_dest_row(sc) * 1024 + 64 * kb, 1024, scr, F.lane); continue; } r -= I_IN;
        if (r < I_PA) { const int kb = r / 32, sc = r % 32; transpose_item(F.w_pa, 1024, 64 * kb, 32 * sc, WSP(bf16_t, WS_WP_T) + (size_t)(32 * sc) * 1024 + 64 * kb, 1024, scr, F.lane); continue; } r -= I_PA;
        if (r < I_PA) { const int kb = r / 32, sc = r % 32; transpose_item(F.w_pb, 1024, 64 * kb, 32 * sc, WSP(bf16_t, WS_WP_T) + (size_t)(32 * sc) * 1024 + 512 + 64 * kb, 1024, scr, F.lane); continue; } r -= I_PA;
        if (r < I_O) { const int kb = r / 32, sc = r % 32; transpose_item(F.w_o, 1024, 64 * kb, 32 * sc, WSP(bf16_t, WS_WO_T) + (size_t)(32 * sc) * 1024 + 64 * kb, 1024, scr, F.lane); continue; } r -= I_O;
        const int e = r / (2 * I_E1 + I_E2); r -= e * (2 * I_E1 + I_E2);
        if (r < 2 * I_E1) { const int is3 = r >= I_E1; if (is3) r -= I_E1; const int kb = r / 16, sc = r % 16;
            transpose_item((is3 ? F.w3 : F.w1) + (size_t)e * D * DE, DE, 64 * kb, 32 * sc, WSP(bf16_t, WS_W13_T) + ((size_t)e * 1024 + 256 * (sc >> 2) + 128 * is3 + 32 * (sc & 3)) * 1024 + 64 * kb, 1024, scr, F.lane); continue; }
        r -= 2 * I_E1;
        { const int kb = r / 32, sc = r % 32;
            transpose_item(F.w2 + (size_t)e * DE * D, D, 64 * kb, 32 * sc, WSP(bf16_t, WS_W2_T) + ((size_t)e * 1024 + 32 * sc) * 512 + 64 * kb, 512, scr, F.lane); }
    }
}

__device__ __forceinline__ float wave_sum(float v) {
#pragma unroll
    for (int o = 1; o < 64; o <<= 1) v += __shfl_xor(v, o);
    return v;
}
__device__ __forceinline__ void s1_norm1(Frame& F) {
    const int gw = blockIdx.x * NWAVES + F.wave;
    const int row0 = gw * 16, b = row0 / S;
    if (row0 >= T) return;
    const float* mod = WSP(float, WS_MOD) + (size_t)b * NMOD;
    f32x4 gs[4], sh[4];
#pragma unroll
    for (int j = 0; j < 4; ++j) { const int col = 4 * F.lane + 256 * j; const f32x4 g = *(const f32x4*)(F.g1 + col), s = *(const f32x4*)(mod + 1024 + col); gs[j] = g * (s + 1.0f); sh[j] = *(const f32x4*)(mod + col); }
    for (int r = 0; r < 16; ++r) {
        const float* xr = F.x + (size_t)(row0 + r) * D;
        f32x4 v[4]; float ss = 0.f;
#pragma unroll
        for (int j = 0; j < 4; ++j) { v[j] = *(const f32x4*)(xr + 4 * F.lane + 256 * j); ss += (v[j].x * v[j].x + v[j].y * v[j].y) + (v[j].z * v[j].z + v[j].w * v[j].w); }
        const float rinv = rsqrtf(wave_sum(ss) * (1.f / D) + EPS);
        bf16_t* o = WSP(bf16_t, WS_H) + (size_t)(row0 + r) * D;
#pragma unroll
        for (int j = 0; j < 4; ++j) { const f32x4 h = v[j] * rinv * gs[j] + sh[j]; u32x2 w; w.x = pk2(h.x, h.y); w.y = pk2(h.z, h.w); *(u32x2*)(o + 4 * F.lane + 256 * j) = w; }
    }
}

struct RowsLinear { const bf16_t* base; size_t pitch; __device__ __forceinline__ const bf16_t* operator()(int r) const { return base + (size_t)r * pitch; } };
template <class AR, class BR>
__device__ __forceinline__ void sgemm_tile(LAS float* tile, int K, const AR& arow, const BR& brow, int wave, int lane) {
    const int fr = lane & 15, fq = lane >> 4, rb = 16 * (wave & 3), cb = 32 * (wave >> 2);
    const bf16_t* ap = arow(rb + fr) + 8 * fq;
    const bf16_t* bp0 = brow(cb + fr) + 8 * fq;
    const bf16_t* bp1 = brow(cb + 16 + fr) + 8 * fq;
    f32x4 acc0 = {0.f, 0.f, 0.f, 0.f}, acc1 = {0.f, 0.f, 0.f, 0.f};
#pragma unroll 4
    for (int k = 0; k < K; k += 32) {
        const bf16x8 a = *(const bf16x8*)(ap + k), b0 = *(const bf16x8*)(bp0 + k), b1 = *(const bf16x8*)(bp1 + k);
        acc0 = __builtin_amdgcn_mfma_f32_16x16x32_bf16(a, b0, acc0, 0, 0, 0);
        acc1 = __builtin_amdgcn_mfma_f32_16x16x32_bf16(a, b1, acc1, 0, 0, 0);
    }
#pragma unroll
    for (int j = 0; j < 4; ++j) { tile[(rb + fq * 4 + j) * 65 + cb + fr] = acc0[j]; tile[(rb + fq * 4 + j) * 65 + cb + 16 + fr] = acc1[j]; }
}

struct WinRowsHead { const bf16_t* base; int rb; __device__ __forceinline__ const bf16_t* operator()(int d) const { return base + (size_t)(rb + 128 * (d >> 5) + (d & 31)) * 1024; } };
__device__ __forceinline__ void s2_simple(Frame& F) {
    LAS float* tile = (LAS float*)F.lds; LAS float* tile2 = tile + 64 * 65;
    const bf16_t* H = WSP(bf16_t, WS_H); const bf16_t* WT = WSP(bf16_t, WS_WIN_T);
    const int row = F.tid >> 3, seg = F.tid & 7;
    for (int it = blockIdx.x; it < 512 * 72; it += F.G) {
        const int rt = it / 72, ct = it % 72, r0 = rt * 64, gr = r0 + row;
        const RowsLinear ar{H + (size_t)r0 * 1024, 1024};
        float v[8];
        if (ct < 16) {
            const int isk = ct >> 3, hh = ct & 7;
            const WinRowsHead br{WT, 512 * isk + 256 * (hh >> 2) + 32 * (hh & 3)};
            sgemm_tile(tile, 1024, ar, br, F.wave, F.lane); __syncthreads();
            float ss = 0.f;
#pragma unroll
            for (int e = 0; e < 8; ++e) { v[e] = tile[row * 65 + 8 * seg + e]; ss += v[e] * v[e]; }
            ss += __shfl_xor(ss, 1); ss += __shfl_xor(ss, 2); ss += __shfl_xor(ss, 4);
            const float rinv = rsqrtf(ss * (1.f / 64.f) + EPS);
            const float* g = isk ? F.g_k : F.g_q;
            const int pos = gr & (S - 1);
#pragma unroll
            for (int e = 0; e < 8; ++e) { v[e] = v[e] * rinv * g[8 * seg + e]; const float pv = __shfl_xor(v[e], 1);
                if (seg < 2) { const float2 cs = WSP(float2, WS_ROPE)[pos * 8 + e]; v[e] = (seg == 0) ? (v[e] * cs.x - pv * cs.y) : (v[e] * cs.x + pv * cs.y); } }
            if (!isk) {
#pragma unroll
                for (int e = 0; e < 8; ++e) v[e] *= C2;
                *(u32x4*)(WSP(bf16_t, WS_YAB) + (size_t)gr * 1024 + hh * 64 + 8 * seg) = pack8(v);
            } else {
                *(u32x4*)(WSP(bf16_t, WS_K) + (size_t)gr * 512 + hh * 64 + 8 * seg) = pack8(v);
#pragma unroll
                for (int e = 0; e < 8; ++e) tile[row * 65 + 8 * seg + e] = v[e];
                __syncthreads();
                if (F.tid < 64) { float s = 0.f; for (int r = 0; r < 64; ++r) s += tile[r * 65 + F.tid];
                    const int b = r0 / S, blk = (r0 & (S - 1)) >> 8;
                    atomicAdd(WSP(float, WS_KMEAN) + ((size_t)(b * NH + hh) * 16 + blk) * 64 + F.tid, s * (1.f / 256.f)); }
            }
        } else if (ct < 24) {
            const RowsLinear br{WT + (size_t)(1024 + 64 * (ct - 16)) * 1024, 1024};
            sgemm_tile(tile, 1024, ar, br, F.wave, F.lane); __syncthreads();
#pragma unroll
            for (int e = 0; e < 8; ++e) v[e] = tile[row * 65 + 8 * seg + e];
            *(u32x4*)(WSP(bf16_t, WS_V) + (size_t)gr * 512 + 64 * (ct - 16) + 8 * seg) = pack8(v);
        } else if (ct < 32) {
            const int cu = 64 * (ct - 24), rb = 256 * (6 + (cu >> 7)) + (cu & 127);
            const RowsLinear bx{WT + (size_t)rb * 1024, 1024}, bc{WT + (size_t)(rb + 128) * 1024, 1024};
            sgemm_tile(tile, 1024, ar, bx, F.wave, F.lane); sgemm_tile(tile2, 1024, ar, bc, F.wave, F.lane); __syncthreads();
#pragma unroll
            for (int e = 0; e < 8; ++e) v[e] = tile[row * 65 + 8 * seg + e] * tile2[row * 65 + 8 * seg + e];
            *(u32x4*)(WSP(bf16_t, WS_U) + (size_t)gr * 512 + cu + 8 * seg) = pack8(v);
        } else if (ct < 40) {
            const RowsLinear br{WT + (size_t)(2560 + 64 * (ct - 32)) * 1024, 1024};
            sgemm_tile(tile, 1024, ar, br, F.wave, F.lane); __syncthreads();
#pragma unroll
            for (int e = 0; e < 8; ++e) v[e] = tile[row * 65 + 8 * seg + e];
            *(u32x4*)(WSP(bf16_t, WS_BG) + (size_t)gr * 512 + 64 * (ct - 32) + 8 * seg) = pack8(v);
        } else {
            const RowsLinear br{WT + (size_t)(3072 + 64 * (ct - 40)) * 1024, 1024};
            sgemm_tile(tile, 1024, ar, br, F.wave, F.lane); __syncthreads();
#pragma unroll
            for (int e = 0; e < 8; ++e) v[e] = 1.f / (1.f + __expf(-tile[row * 65 + 8 * seg + e]));
            *(u32x4*)(WSP(bf16_t, WS_GATES) + (size_t)gr * 2048 + 64 * (ct - 40) + 8 * seg) = pack8(v);
        }
        __syncthreads();
    }
}

constexpr float NEG_BIG = -1e30f;
__device__ __forceinline__ void s3_simple(Frame& F) {
    LAS float* tS = (LAS float*)F.lds;
    LAS bf16_t* Pb = (LAS bf16_t*)(F.lds + 16896);
    LAS bf16_t* Vt = (LAS bf16_t*)(F.lds + 16896 + 9216);
    LAS float* mrow = (LAS float*)(F.lds + 16896 + 18432);
    LAS float* lrow = mrow + 64; LAS float* arow_ = mrow + 128; LAS int* sel = (LAS int*)(mrow + 192); LAS int* um = sel + 64;
    bf16_t* YAB = WSP(bf16_t, WS_YAB); const bf16_t* Kb = WSP(bf16_t, WS_K); const bf16_t* Vb = WSP(bf16_t, WS_V);
    const float* kmean = WSP(float, WS_KMEAN);
    const int row = F.tid >> 3, seg = F.tid & 7, fr = F.lane & 15, fq = F.lane >> 4, rb = 16 * (F.wave & 3), cb = 32 * (F.wave >> 2);
    for (int it = blockIdx.x; it < NB * NH * 64; it += F.G) {
        const int qc = it & 63, h = (it >> 6) & 7, b = it >> 9, cur = qc >> 2, t0 = 64 * qc;
        const size_t tb = (size_t)b * S;
        if (F.tid < 64) {
            float q[64];
            const bf16_t* qp = YAB + (tb + t0 + F.tid) * 1024 + h * 64;
#pragma unroll
            for (int i = 0; i < 8; ++i) { float t8[8]; unpack8(*(const u32x4*)(qp + 8 * i), t8);
#pragma unroll
                for (int e = 0; e < 8; ++e) q[8 * i + e] = t8[e]; }
            float b0 = -INFINITY, b1 = -INFINITY, b2 = -INFINITY; int i0 = -1, i1 = -1, i2 = -1;
            for (int j = 0; j < cur; ++j) { const float* km = kmean + ((size_t)(b * NH + h) * 16 + j) * 64; float s = 0.f;
#pragma unroll
                for (int d = 0; d < 64; ++d) s += q[d] * km[d];
                if (s > b0) { b2 = b1; i2 = i1; b1 = b0; i1 = i0; b0 = s; i0 = j; } else if (s > b1) { b2 = b1; i2 = i1; b1 = s; i1 = j; } else if (s > b2) { b2 = s; i2 = j; } }
            int m = 0; if (i0 >= 0) m |= 1 << i0; if (i1 >= 0) m |= 1 << i1; if (i2 >= 0) m |= 1 << i2;
            sel[F.tid] = m; mrow[F.tid] = NEG_BIG; lrow[F.tid] = 0.f;
            int u = m;
#pragma unroll
            for (int o = 1; o < 64; o <<= 1) u |= __shfl_xor(u, o);
            if (F.tid == 0) um[0] = u;
        }
        __syncthreads();
        const int umask = um[0];
        f32x4 o0 = {0.f, 0.f, 0.f, 0.f}, o1 = {0.f, 0.f, 0.f, 0.f};
        const RowsLinear aq{YAB + (tb + t0) * 1024 + h * 64, 1024};
        for (int j = 0; j <= cur; ++j) {
            if (j < cur && !((umask >> j) & 1)) continue;
            const int nkt = (j == cur) ? ((qc & 3) + 1) : 4;
            for (int kt = 0; kt < nkt; ++kt) {
                const int kbase = 256 * j + 64 * kt;
                const RowsLinear bk{Kb + (tb + kbase) * 512 + h * 64, 512};
                sgemm_tile(tS, 64, aq, bk, F.wave, F.lane);
                { float vv[8]; unpack8(*(const u32x4*)(Vb + (tb + kbase + row) * 512 + h * 64 + 8 * seg), vv);
#pragma unroll
                    for (int e = 0; e < 8; ++e) Vt[(8 * seg + e) * 72 + row] = (bf16_t)f2bf(vv[e]); }
                __syncthreads();
                {
                    float s[8]; float mx = NEG_BIG;
                    const bool rowsel = (j == cur) || ((sel[row] >> j) & 1);
#pragma unroll
                    for (int e = 0; e < 8; ++e) { const int c = 8 * seg + e; float x = tS[row * 65 + c];
                        if (!rowsel || (j == cur && kbase + c > t0 + row)) x = NEG_BIG; s[e] = x; mx = fmaxf(mx, x); }
                    mx = fmaxf(mx, __shfl_xor(mx, 1)); mx = fmaxf(mx, __shfl_xor(mx, 2)); mx = fmaxf(mx, __shfl_xor(mx, 4));
                    const float mold = mrow[row], mnew = fmaxf(mold, mx);
                    float alpha = 1.f, ps = 0.f; float p[8];
                    if (mnew <= NEG_BIG) {
#pragma unroll
                        for (int e = 0; e < 8; ++e) p[e] = 0.f;
                    } else { alpha = exp2f(mold - mnew);
#pragma unroll
                        for (int e = 0; e < 8; ++e) { p[e] = (s[e] <= NEG_BIG) ? 0.f : exp2f(s[e] - mnew); ps += p[e]; } }
                    ps += __shfl_xor(ps, 1); ps += __shfl_xor(ps, 2); ps += __shfl_xor(ps, 4);
                    const float lold = lrow[row];
                    *(LAS u32x4*)(Pb + row * 72 + 8 * seg) = pack8(p);
                    if (seg == 0) { mrow[row] = mnew; lrow[row] = lold * alpha + ps; arow_[row] = alpha; }
                }
                __syncthreads();
                {
#pragma unroll
                    for (int r = 0; r < 4; ++r) { const float a = arow_[rb + fq * 4 + r]; o0[r] *= a; o1[r] *= a; }
#pragma unroll
                    for (int ks = 0; ks < 2; ++ks) {
                        const bf16x8 a = *(const LAS bf16x8*)(Pb + (rb + fr) * 72 + 32 * ks + 8 * fq);
                        const bf16x8 v0 = *(const LAS bf16x8*)(Vt + (cb + fr) * 72 + 32 * ks + 8 * fq);
                        const bf16x8 v1 = *(const LAS bf16x8*)(Vt + (cb + 16 + fr) * 72 + 32 * ks + 8 * fq);
                        o0 = __builtin_amdgcn_mfma_f32_16x16x32_bf16(a, v0, o0, 0, 0, 0);
                        o1 = __builtin_amdgcn_mfma_f32_16x16x32_bf16(a, v1, o1, 0, 0, 0);
                    }
                }
                __syncthreads();
            }
        }
#pragma unroll
        for (int r = 0; r < 4; ++r) { const float li = 1.f / lrow[rb + fq * 4 + r]; tS[(rb + fq * 4 + r) * 65 + cb + fr] = o0[r] * li; tS[(rb + fq * 4 + r) * 65 + cb + 16 + fr] = o1[r] * li; }
        __syncthreads();
        { float v[8];
#pragma unroll
            for (int e = 0; e < 8; ++e) v[e] = tS[row * 65 + 8 * seg + e];
            *(u32x4*)(YAB + (tb + t0 + row) * 1024 + h * 64 + 8 * seg) = pack8(v); }
        __syncthreads();
    }
    const bf16_t* U = WSP(bf16_t, WS_U); const bf16_t* BG = WSP(bf16_t, WS_BG);
    for (int i = blockIdx.x * NTHREADS + F.tid; i < T * 64; i += F.G * NTHREADS) {
        const int t = i >> 6, c0 = (i & 63) * 8, pos = t & (S - 1);
        float u0[8], u1[8], u2[8], bg[8], y[8];
        unpack8(*(const u32x4*)(U + (size_t)t * 512 + c0), u2); unpack8(*(const u32x4*)(BG + (size_t)t * 512 + c0), bg);
        if (pos >= 1) unpack8(*(const u32x4*)(U + (size_t)(t - 1) * 512 + c0), u1); else {
#pragma unroll
            for (int e = 0; e < 8; ++e) u1[e] = 0.f; }
        if (pos >= 2) unpack8(*(const u32x4*)(U + (size_t)(t - 2) * 512 + c0), u0); else {
#pragma unroll
            for (int e = 0; e < 8; ++e) u0[e] = 0.f; }
#pragma unroll
        for (int e = 0; e < 8; ++e) y[e] = bg[e] * (F.conv_w[c0 + e] * u0[e] + F.conv_w[512 + c0 + e] * u1[e] + F.conv_w[1024 + c0 + e] * u2[e] + F.conv_b[c0 + e]);
        *(u32x4*)(YAB + (size_t)t * 1024 + 512 + c0) = pack8(y);
    }
}

__device__ __forceinline__ void s4_simple(Frame& F) {
    LAS float* tile = (LAS float*)F.lds; LAS float* tile2 = tile + 64 * 65;
    const bf16_t* YAB = WSP(bf16_t, WS_YAB); const bf16_t* WP = WSP(bf16_t, WS_WP_T); const bf16_t* GT = WSP(bf16_t, WS_GATES);
    const int row = F.tid >> 3, seg = F.tid & 7;
    for (int it = blockIdx.x; it < 512 * 16; it += F.G) {
        const int rt = it >> 4, ct = it & 15, r0 = rt * 64, gr = r0 + row;
        const RowsLinear aa{YAB + (size_t)r0 * 1024, 1024}, ab{YAB + (size_t)r0 * 1024 + 512, 1024};
        const RowsLinear ba{WP + (size_t)(64 * ct) * 1024, 1024}, bb{WP + (size_t)(64 * ct) * 1024 + 512, 1024};
        sgemm_tile(tile, 512, aa, ba, F.wave, F.lane); sgemm_tile(tile2, 512, ab, bb, F.wave, F.lane); __syncthreads();
        float ga[8], gb[8], v[8];
        unpack8(*(const u32x4*)(GT + (size_t)gr * 2048 + 64 * ct + 8 * seg), ga); unpack8(*(const u32x4*)(GT + (size_t)gr * 2048 + 1024 + 64 * ct + 8 * seg), gb);
#pragma unroll
        for (int e = 0; e < 8; ++e) v[e] = ga[e] * tile[row * 65 + 8 * seg + e] + gb[e] * tile2[row * 65 + 8 * seg + e];
        *(u32x4*)(WSP(bf16_t, WS_H) + (size_t)gr * 1024 + 64 * ct + 8 * seg) = pack8(v);
        __syncthreads();
    }
}
__device__ __forceinline__ void s5_simple(Frame& F) {
    LAS float* tile = (LAS float*)F.lds;
    const bf16_t* MG = WSP(bf16_t, WS_H); const bf16_t* WO = WSP(bf16_t, WS_WO_T);
    const int row = F.tid >> 3, seg = F.tid & 7;
    for (int it = blockIdx.x; it < 512 * 16; it += F.G) {
        const int rt = it >> 4, ct = it & 15, r0 = rt * 64, gr = r0 + row, b = r0 / S;
        const RowsLinear aa{MG + (size_t)r0 * 1024, 1024}, bb{WO + (size_t)(64 * ct) * 1024, 1024};
        sgemm_tile(tile, 1024, aa, bb, F.wave, F.lane); __syncthreads();
        const float* ga1 = WSP(float, WS_MOD) + (size_t)b * NMOD + 2048 + 64 * ct + 8 * seg;
        const float* xr = F.x + (size_t)gr * D + 64 * ct + 8 * seg; float* orow = F.out + (size_t)gr * D + 64 * ct + 8 * seg;
#pragma unroll
        for (int e4 = 0; e4 < 2; ++e4) { const f32x4 xv = *(const f32x4*)(xr + 4 * e4), gv = *(const f32x4*)(ga1 + 4 * e4); f32x4 o;
#pragma unroll
            for (int e = 0; e < 4; ++e) o[e] = xv[e] + gv[e] * tile[row * 65 + 8 * seg + 4 * e4 + e];
            *(f32x4*)(orow + 4 * e4) = o; }
        __syncthreads();
    }
}

__device__ __forceinline__ void s6_router(Frame& F) {
    LAS float* W = (LAS float*)F.lds;
    LAS int* cnt = (LAS int*)(F.lds + MISC_OFF + 256);
    for (int i = F.tid; i < 36 * 1024; i += NTHREADS) { const int jj = i >> 10, k = i & 1023; W[i] = (jj < 4) ? F.w_rg[k * 4 + jj] : F.w_re[k * 32 + (jj - 4)]; }
    if (F.tid < 32) cnt[F.tid] = 0;
    __syncthreads();
    const int gw = blockIdx.x * NWAVES + F.wave, row0 = gw * 16, b = row0 / S;
    const float* mod = WSP(float, WS_MOD) + (size_t)b * NMOD;
    f32x4 gs[4], sh[4];
#pragma unroll
    for (int j = 0; j < 4; ++j) { const int col = 4 * F.lane + 256 * j; const f32x4 g = *(const f32x4*)(F.g2 + col), s = *(const f32x4*)(mod + 4096 + col); gs[j] = g * (s + 1.0f); sh[j] = *(const f32x4*)(mod + 3072 + col); }
    for (int r = 0; r < 16; ++r) {
        const int t = row0 + r;
        const float* xr = F.out + (size_t)t * D;
        f32x4 v[4]; float ss = 0.f;
#pragma unroll
        for (int j = 0; j < 4; ++j) { v[j] = *(const f32x4*)(xr + 4 * F.lane + 256 * j); ss += (v[j].x * v[j].x + v[j].y * v[j].y) + (v[j].z * v[j].z + v[j].w * v[j].w); }
        const float rinv = rsqrtf(wave_sum(ss) * (1.f / D) + EPS);
        bf16_t* o = WSP(bf16_t, WS_H2) + (size_t)t * D;
#pragma unroll
        for (int j = 0; j < 4; ++j) { v[j] = v[j] * rinv * gs[j] + sh[j]; u32x2 w; w.x = pk2(v[j].x, v[j].y); w.y = pk2(v[j].z, v[j].w); *(u32x2*)(o + 4 * F.lane + 256 * j) = w; }
        float lg[36];
#pragma unroll
        for (int jj = 0; jj < 36; ++jj) { float a = 0.f;
#pragma unroll
            for (int j = 0; j < 4; ++j) { const f32x4 w = *(const LAS f32x4*)(W + jj * 1024 + 4 * F.lane + 256 * j); a += (v[j].x * w.x + v[j].y * w.y) + (v[j].z * w.z + v[j].w * w.w); }
            lg[jj] = wave_sum(a); }
        if (F.lane == 0) {
            float gl[4];
#pragma unroll
            for (int i = 0; i < 4; ++i) gl[i] = lg[i] + F.b_rg[i];
            int gi = 0; float gm = gl[0];
#pragma unroll
            for (int i = 1; i < 4; ++i) if (gl[i] > gm) { gm = gl[i]; gi = i; }
            float den = 0.f;
#pragma unroll
            for (int i = 0; i < 4; ++i) den += expf(gl[i] - gm);
            const float gw_ = 1.f / den;
            float v1 = -INFINITY, v2 = -INFINITY; int e1 = 0, e2 = 0;
#pragma unroll
            for (int g = 0; g < 4; ++g) if (g == gi) {
#pragma unroll
                for (int i = 0; i < 8; ++i) { const float el = lg[4 + g * 8 + i] + F.b_re[g * 8 + i];
                    if (el > v1) { v2 = v1; e2 = e1; v1 = el; e1 = i; } else if (el > v2) { v2 = el; e2 = i; } } }
            const float p1 = 1.f / (1.f + expf(v2 - v1)), p2 = 1.f - p1;
            const int id1 = gi * 8 + e1, id2 = gi * 8 + e2;
            WSP(int, WS_EID)[2 * t] = id1; WSP(int, WS_EID)[2 * t + 1] = id2;
            WSP(float, WS_EW)[2 * t] = p1 * gw_; WSP(float, WS_EW)[2 * t + 1] = p2 * gw_;
            lds_add(&cnt[id1], 1); lds_add(&cnt[id2], 1);
        }
    }
    __syncthreads();
    if (F.tid < 32) WSP(int, WS_BCNT)[blockIdx.x * 32 + F.tid] = cnt[F.tid];
}

__device__ __forceinline__ void s7_lists(Frame& F) {
    LAS int* sm = (LAS int*)F.lds;
    const int* bc = WSP(int, WS_BCNT);
    if (F.tid < 32) { int tot = 0, base = 0; for (int bb = 0; bb < 256; ++bb) { const int c = bc[bb * 32 + F.tid]; if (bb < (int)blockIdx.x) base += c; tot += c; }
        sm[F.tid] = tot; sm[32 + F.tid] = base; sm[96 + F.tid] = 0; }
    __syncthreads();
    if (F.tid == 0) { int ps = 0; for (int e = 0; e < 32; ++e) { sm[64 + e] = ps; ps += (sm[e] + 255) & ~255; }
        if (blockIdx.x == 0) { int* te = WSP(int, WS_TILEE); int pm = 0; for (int e = 0; e < 32; ++e) { const int n = (sm[e] + 255) >> 8; for (int i = 0; i < n; ++i) te[1 + pm++] = e; } te[0] = pm; } }
    __syncthreads();
    int* atok = WSP(int, WS_ATOK); int* ainfo = WSP(int, WS_AINFO); float* aw = WSP(float, WS_AW);
    if (F.tid < 256) { const int a = blockIdx.x * 256 + F.tid;
        const int e = WSP(int, WS_EID)[a]; const int rank = lds_add(&sm[96 + e], 1); const int pos = sm[64 + e] + sm[32 + e] + rank;
        atok[pos] = a >> 1; ainfo[pos] = a; aw[pos] = WSP(float, WS_EW)[a]; }
    if (blockIdx.x < 32) { const int e = blockIdx.x; const int lo = sm[64 + e] + sm[e], hi = sm[64 + e] + ((sm[e] + 255) & ~255);
        for (int p = lo + F.tid; p < hi; p += NTHREADS) { atok[p] = 0; ainfo[p] = -1; aw[p] = 0.f; } }
}

struct RowsGather { const bf16_t* base; const int* idx; __device__ __forceinline__ const bf16_t* operator()(int r) const { return base + (size_t)idx[r] * 1024; } };
__device__ __forceinline__ void s8_simple(Frame& F) {
    LAS float* tile = (LAS float*)F.lds; LAS float* tile2 = tile + 64 * 65;
    const int* te = WSP(int, WS_TILEE); const int nmt = te[0];
    const int row = F.tid >> 3, seg = F.tid & 7;
    for (int it = blockIdx.x; it < nmt * 4 * 8; it += F.G) {
        const int rt = it >> 3, ct = it & 7, e = te[1 + (rt >> 2)], pos0 = 64 * rt, hc = 64 * ct;
        const RowsGather ar{WSP(bf16_t, WS_H2), WSP(int, WS_ATOK) + pos0};
        const bf16_t* wb = WSP(bf16_t, WS_W13_T) + ((size_t)e * 1024 + 256 * (hc >> 7) + (hc & 127)) * 1024;
        const RowsLinear b1{wb, 1024}, b3{wb + (size_t)128 * 1024, 1024};
        sgemm_tile(tile, 1024, ar, b1, F.wave, F.lane); sgemm_tile(tile2, 1024, ar, b3, F.wave, F.lane); __syncthreads();
        const float wt = WSP(float, WS_AW)[pos0 + row]; float v[8];
#pragma unroll
        for (int e8 = 0; e8 < 8; ++e8) { const float a = tile[row * 65 + 8 * seg + e8], c = tile2[row * 65 + 8 * seg + e8]; v[e8] = (a / (1.f + __expf(-a))) * c * wt; }
        *(u32x4*)(WSP(bf16_t, WS_HID) + (size_t)(pos0 + row) * 512 + hc + 8 * seg) = pack8(v);
        __syncthreads();
    }
}
__device__ __forceinline__ void s9_simple(Frame& F) {
    LAS float* tile = (LAS float*)F.lds;
    const int* te = WSP(int, WS_TILEE); const int nmt = te[0];
    const int row = F.tid >> 3, seg = F.tid & 7;
    for (int it = blockIdx.x; it < nmt * 4 * 16; it += F.G) {
        const int rt = it >> 4, ct = it & 15, e = te[1 + (rt >> 2)], pos0 = 64 * rt;
        const RowsLinear ar{WSP(bf16_t, WS_HID) + (size_t)pos0 * 512, 512};
        const RowsLinear br{WSP(bf16_t, WS_W2_T) + ((size_t)e * 1024 + 64 * ct) * 512, 512};
        sgemm_tile(tile, 512, ar, br, F.wave, F.lane); __syncthreads();
        const int info = WSP(int, WS_AINFO)[pos0 + row];
        if (info >= 0) { float v[8];
#pragma unroll
            for (int e8 = 0; e8 < 8; ++e8) v[e8] = tile[row * 65 + 8 * seg + e8];
            *(u32x4*)(WSP(bf16_t, WS_YSLOT) + (size_t)info * 1024 + 64 * ct + 8 * seg) = pack8(v); }
        __syncthreads();
    }
}
__device__ __forceinline__ void s10_combine(Frame& F) {
    const bf16_t* Y = WSP(bf16_t, WS_YSLOT);
    for (int i = blockIdx.x * NTHREADS + F.tid; i < T * 128; i += F.G * NTHREADS) {
        const int t = i >> 7, c0 = (i & 127) * 8, b = t / S;
        float y0[8], y1[8]; unpack8(*(const u32x4*)(Y + (size_t)(2 * t) * 1024 + c0), y0); unpack8(*(const u32x4*)(Y + (size_t)(2 * t + 1) * 1024 + c0), y1);
        const float* ga2 = WSP(float, WS_MOD) + (size_t)b * NMOD + 5120 + c0; float* o = F.out + (size_t)t * D + c0;
#pragma unroll
        for (int e4 = 0; e4 < 2; ++e4) { f32x4 xv = *(const f32x4*)(o + 4 * e4); const f32x4 gv = *(const f32x4*)(ga2 + 4 * e4);
#pragma unroll
            for (int e = 0; e < 4; ++e) xv[e] += gv[e] * (y0[4 * e4 + e] + y1[4 * e4 + e]);
            *(f32x4*)(o + 4 * e4) = xv; }
    }
}

constexpr int N_PHASES = 11;
struct Args { const float* in[21]; float* out; unsigned char* ws; int ph_lo, ph_hi; };
__global__ void __launch_bounds__(NTHREADS, 2) mega_fwd(Args args) {
    extern __shared__ __attribute__((aligned(16))) unsigned char lds_raw[];
    Frame F;
    F.lds = (LAS unsigned char*)lds_raw;
    F.tid = threadIdx.x; F.lane = F.tid & 63; F.wave = __builtin_amdgcn_readfirstlane(F.tid >> 6); F.G = gridDim.x;
    F.x = args.in[0]; F.c = args.in[1]; F.w_ada = args.in[2]; F.b_ada = args.in[3]; F.g1 = args.in[4]; F.g2 = args.in[5]; F.w_in = args.in[6]; F.g_q = args.in[7]; F.g_k = args.in[8];
    F.conv_w = args.in[9]; F.conv_b = args.in[10]; F.w_pa = args.in[11]; F.w_pb = args.in[12]; F.w_o = args.in[13]; F.w_rg = args.in[14]; F.b_rg = args.in[15]; F.w_re = args.in[16]; F.b_re = args.in[17];
    F.w1 = args.in[18]; F.w3 = args.in[19]; F.w2 = args.in[20]; F.out = args.out; F.ws = args.ws;
    volatile LAS unsigned* MISC = (volatile LAS unsigned*)(F.lds + MISC_OFF);
    if (F.tid < 64) MISC[F.tid] = 0u;
    __syncthreads();
    XcdBarrier bar = xcd_barrier_post((unsigned*)(F.ws + WS_CTL) + CW_BAR, MISC + 8);
    const int lo = args.ph_lo, hi = args.ph_hi;
#define PHASE(k, body) if (lo <= (k) && (k) < hi) { body; if ((k) + 1 < hi) xcd_barrier(bar); }
    PHASE(0, s0_prologue(F))
    PHASE(1, s1_norm1(F))
    PHASE(2, s2_simple(F))
    PHASE(3, s3_simple(F))
    PHASE(4, s4_simple(F))
    PHASE(5, s5_simple(F))
    PHASE(6, s6_router(F))
    PHASE(7, s7_lists(F))
    PHASE(8, s8_simple(F))
    PHASE(9, s9_simple(F))
    PHASE(10, s10_combine(F))
#undef PHASE
}

extern "C" void kernel_launch(void* const* d_in, const int* in_sizes, int n_in, void* d_out, int out_size, void* d_ws, size_t ws_size, hipStream_t stream) {
    static int grid = 0;
    if (grid == 0) {
        if (n_in != 21 || in_sizes[0] != T * D || out_size != T * D || ws_size < WS_END) { fprintf(stderr, "kernel_launch: unexpected shapes (n_in %d, in0 %d, out %d, ws %zu); nothing launched\n", n_in, n_in > 0 ? in_sizes[0] : -1, out_size, ws_size); grid = -1; return; }
        int dev = 0, cus = 0, per_cu = 0;
        if (hipGetDevice(&dev) != hipSuccess || hipDeviceGetAttribute(&cus, hipDeviceAttributeMultiprocessorCount, dev) != hipSuccess) { grid = -1; return; }
        if (hipFuncSetAttribute((const void*)mega_fwd, hipFuncAttributeMaxDynamicSharedMemorySize, LDS_BYTES) != hipSuccess) { fprintf(stderr, "kernel_launch: hipFuncSetAttribute failed\n"); grid = -1; return; }
        if (hipOccupancyMaxActiveBlocksPerMultiprocessor(&per_cu, (const void*)mega_fwd, NTHREADS, LDS_BYTES) != hipSuccess || per_cu < 1) { fprintf(stderr, "kernel_launch: occupancy query says %d blocks per CU\n", per_cu); per_cu = 1; }
        (void)hipGetLastError();
        if (cus < 256) { fprintf(stderr, "kernel_launch: built for a 256-CU device, found %d CUs; nothing launched\n", cus); grid = -1; return; }
        grid = 256;
    }
    if (grid < 0) return;
    (void)hipMemsetAsync((char*)d_ws + WS_CTL, 0, CTL_ZERO_BYTES, stream);
    Args a{};
    for (int i = 0; i < 21; ++i) a.in[i] = (const float*)d_in[i];
    a.out = (float*)d_out; a.ws = (unsigned char*)d_ws; a.ph_lo = 0; a.ph_hi = N_PHASES;
    hipLaunchKernelGGL(mega_fwd, dim3(grid), dim3(NTHREADS), LDS_BYTES, stream, a);
}
```

```cpp
#include <hip/hip_runtime.h>
#include <hip/hip_bf16.h>
#include <cstdio>
#include <cstdint>

#define GAS __attribute__((address_space(1)))
#define LAS __attribute__((address_space(3)))
typedef unsigned short bf16_t;
typedef short bf16x8 __attribute__((ext_vector_type(8)));
typedef float f32x4 __attribute__((ext_vector_type(4)));
typedef unsigned u32x4 __attribute__((ext_vector_type(4)));
typedef unsigned u32x2 __attribute__((ext_vector_type(2)));

constexpr int T = 32768, D = 1024, NB = 8, S = 4096, NH = 8, DH = 64, NIN = 5120, NE = 32, DE = 512, NMOD = 6144;
constexpr int NTHREADS = 512, NWAVES = 8;
constexpr float EPS = 1e-6f;
constexpr float C2 = 0.125f * 1.4426950408889634f;
constexpr int MAX_MT = 288;
constexpr int NPAD = MAX_MT * 256;

constexpr size_t MiB = 1u << 20, KiB = 1024;
constexpr size_t WS_CTL = 0, CTL_ZERO_BYTES = 1 * MiB;
constexpr size_t WS_MOD = 1 * MiB;
constexpr size_t WS_ROPE = 1 * MiB + 256 * KiB;
constexpr size_t WS_KMEAN = 1 * MiB + 512 * KiB;
constexpr size_t WS_EID = 2 * MiB;
constexpr size_t WS_EW = 2 * MiB + 256 * KiB;
constexpr size_t WS_BCNT = 2 * MiB + 512 * KiB;
constexpr size_t WS_TILEE = 2 * MiB + 768 * KiB;
constexpr size_t WS_ATOK = 3 * MiB;
constexpr size_t WS_AINFO = 3 * MiB + 512 * KiB;
constexpr size_t WS_AW = 4 * MiB;
constexpr size_t WS_WIN_T = 8 * MiB;
constexpr size_t WS_WP_T = 18 * MiB;
constexpr size_t WS_WO_T = 20 * MiB;
constexpr size_t WS_W13_T = 24 * MiB;
constexpr size_t WS_W2_T = 88 * MiB;
constexpr size_t WS_H = 120 * MiB;
constexpr size_t WS_YAB = 184 * MiB;
constexpr size_t WS_K = 248 * MiB;
constexpr size_t WS_V = 280 * MiB;
constexpr size_t WS_U = 312 * MiB;
constexpr size_t WS_BG = 344 * MiB;
constexpr size_t WS_GATES = 376 * MiB;
constexpr size_t WS_H2 = 184 * MiB;
constexpr size_t WS_HID = 248 * MiB;
constexpr size_t WS_YSLOT = 320 * MiB;
constexpr size_t WS_END = 504 * MiB;
constexpr int CW_BAR = 4096;

constexpr int LDS_BYTES = 159744;
constexpr int MISC_OFF = 147456;

__device__ __forceinline__ unsigned f2bf(float f) { unsigned u = __builtin_bit_cast(unsigned, f); return (u + 0x7fffu + ((u >> 16) & 1u)) >> 16; }
__device__ __forceinline__ float bf2f(unsigned h) { return __builtin_bit_cast(float, h << 16); }
__device__ __forceinline__ unsigned pk2(float lo, float hi) { return f2bf(lo) | (f2bf(hi) << 16); }
__device__ __forceinline__ void unpack8(const u32x4 w, float (&v)[8]) {
    v[0] = bf2f(w.x & 0xffffu); v[1] = bf2f(w.x >> 16); v[2] = bf2f(w.y & 0xffffu); v[3] = bf2f(w.y >> 16);
    v[4] = bf2f(w.z & 0xffffu); v[5] = bf2f(w.z >> 16); v[6] = bf2f(w.w & 0xffffu); v[7] = bf2f(w.w >> 16);
}
__device__ __forceinline__ u32x4 pack8(const float (&v)[8]) { u32x4 w; w.x = pk2(v[0], v[1]); w.y = pk2(v[2], v[3]); w.z = pk2(v[4], v[5]); w.w = pk2(v[6], v[7]); return w; }
#define LDS_WAIT() asm volatile("s_waitcnt lgkmcnt(0)" ::: "memory")
__device__ __forceinline__ int lds_add(LAS int* p, int v) { return __hip_atomic_fetch_add(p, v, __ATOMIC_RELAXED, __HIP_MEMORY_SCOPE_WORKGROUP); }

#define XB_TMO      128
#define XB_XCNT(j)  (256  + 64 * (j))
#define XB_XSUB(j)  (1280 + 64 * (j))
#define XB_XGEN(j)  (2304 + 64 * (j))
#define XB_TOP      3328
#define XB_TOPGEN   3392
#define XCD_BAR_WORDS 3456
#define XB_SPIN_CAP (1u << 22)
__device__ __forceinline__ unsigned xb_ld(unsigned* p)              { return __hip_atomic_load(p, __ATOMIC_RELAXED, __HIP_MEMORY_SCOPE_AGENT); }
__device__ __forceinline__ unsigned xb_add(unsigned* p, unsigned v) { return __hip_atomic_fetch_add(p, v, __ATOMIC_RELAXED, __HIP_MEMORY_SCOPE_AGENT); }
__device__ __forceinline__ unsigned xb_xcc_id() { return (unsigned)__builtin_amdgcn_s_getreg((3 << 11) | 20) & 0xFu; }
#define XB_SPIN(cond, bar) do { unsigned _sp = 0; while (cond) { __builtin_amdgcn_s_sleep(1); \
    if ((++_sp & 255u) == 0u) { if (xb_ld(&(bar)[XB_TMO])) break; if (_sp > XB_SPIN_CAP) { atomicAdd(&(bar)[XB_TMO], 1u); break; } } } } while (0)
struct XcdBarrier { unsigned* bar; unsigned x; volatile LAS unsigned* st; };
__device__ __forceinline__ XcdBarrier xcd_barrier_post(unsigned* bar, volatile LAS unsigned* st) {
    XcdBarrier b; b.bar = bar; b.x = xb_xcc_id(); b.st = st;
    if (threadIdx.x == 0) (void)xb_add(&bar[XB_XCNT(b.x)], 1u);
    return b;
}
__device__ __forceinline__ void xcd_barrier_complete(unsigned* bar, unsigned x, unsigned& nloc, unsigned& nx) {
    const unsigned G = gridDim.x * gridDim.y * gridDim.z;
    unsigned sum, cnt, mine, sp = 0u;
    for (;;) {
        sum = 0u; cnt = 0u; mine = 0u;
#pragma unroll
        for (unsigned j = 0; j < 16; ++j) { const unsigned c = xb_ld(&bar[XB_XCNT(j)]); sum += c; cnt += (c > 0u) ? 1u : 0u; mine = (j == x) ? c : mine; }
        if (sum == G) break;
        __builtin_amdgcn_s_sleep(1);
        if ((++sp & 255u) == 0u) { if (xb_ld(&bar[XB_TMO])) break; if (sp > XB_SPIN_CAP) { atomicAdd(&bar[XB_TMO], 1u); break; } }
    }
    nloc = mine > 0u ? mine : 1u; nx = cnt > 0u ? cnt : 1u;
}
__device__ __forceinline__ void xcd_barrier(const XcdBarrier& b) {
    asm volatile("s_waitcnt vmcnt(0)" ::: "memory");
    __syncthreads();
    if (threadIdx.x == 0) {
        unsigned* bar = b.bar;
        __builtin_amdgcn_s_waitcnt(0);
        unsigned nloc = b.st[0], nx = b.st[1];
        if (nloc == 0u) { xcd_barrier_complete(bar, b.x, nloc, nx); b.st[0] = nloc; b.st[1] = nx; }
        const unsigned old = xb_add(&bar[XB_XSUB(b.x)], 1u);
        const unsigned gen = old / nloc;
        if (old + 1u == (gen + 1u) * nloc) {
            __builtin_amdgcn_fence(__ATOMIC_RELEASE, "agent");
            asm volatile("s_waitcnt vmcnt(0)" ::: "memory");
            const unsigned og = xb_add(&bar[XB_TOP], 1u);
            const unsigned tg = og / nx;
            if (og + 1u == (tg + 1u) * nx) xb_add(&bar[XB_TOPGEN], 1u);
            else XB_SPIN(xb_ld(&bar[XB_TOPGEN]) == tg, bar);
            __builtin_amdgcn_fence(__ATOMIC_ACQUIRE, "agent");
            xb_add(&bar[XB_XGEN(b.x)], 1u);
            asm volatile("s_waitcnt vmcnt(0)" ::: "memory");
        } else {
            XB_SPIN(xb_ld(&bar[XB_XGEN(b.x)]) == gen, bar);
            __builtin_amdgcn_fence(__ATOMIC_ACQUIRE, "agent");
            asm volatile("s_waitcnt vmcnt(0)" ::: "memory");
        }
    }
    __syncthreads();
}

struct Frame {
    LAS unsigned char* lds;
    int tid, lane, wave, G;
    const float *x, *c, *w_ada, *b_ada, *g1, *g2, *w_in, *g_q, *g_k, *conv_w, *conv_b, *w_pa, *w_pb, *w_o, *w_rg, *b_rg, *w_re, *b_re, *w1, *w3, *w2;
    float* out; unsigned char* ws;
};
#define WSP(type, off) ((type*)(F.ws + (off)))

__device__ __forceinline__ void transpose_item(const float* W, int N, int k0, int n0, bf16_t* dst  , int pitch, LAS float* scr, int lane) {
#pragma unroll 8
    for (int i = 0; i < 32; ++i) { const int kk = 2 * i + (lane >> 5); scr[kk * 33 + (lane & 31)] = W[(size_t)(k0 + kk) * N + n0 + (lane & 31)]; }
    LDS_WAIT(); asm volatile("" ::: "memory");
    const int c = lane & 7;
#pragma unroll
    for (int j = 0; j < 4; ++j) { const int n = (lane >> 3) + 8 * j; const LAS float* s = scr + (8 * c) * 33 + n;
        u32x4 o; o.x = pk2(s[0 * 33], s[1 * 33]); o.y = pk2(s[2 * 33], s[3 * 33]); o.z = pk2(s[4 * 33], s[5 * 33]); o.w = pk2(s[6 * 33], s[7 * 33]);
        *(u32x4*)(dst + (size_t)n * pitch + 8 * c) = o; }
    LDS_WAIT(); asm volatile("" ::: "memory");
}
__device__ __forceinline__ int win_dest_row(int sc) {
    if (sc < 32) { const int isk = sc >> 4, s2 = sc & 15, hh = s2 >> 1, bj = s2 & 1; return 512 * isk + 256 * (hh >> 2) + 128 * bj + 32 * (hh & 3); }
    if (sc < 48) return 32 * sc;
    if (sc < 64) { const int cx = 32 * (sc - 48); return 256 * (6 + (cx >> 7)) + (cx & 127); }
    if (sc < 80) return 2560 + 32 * (sc - 64);
    if (sc < 96) { const int cx = 32 * (sc - 80); return 256 * (6 + (cx >> 7)) + 128 + (cx & 127); }
    return 3072 + 32 * (sc - 96);
}
__device__ __forceinline__ void s0_prologue(Frame& F) {
    const int gt = blockIdx.x * NTHREADS + F.tid;
    if (gt < NB * NH * 16 * 64) WSP(float, WS_KMEAN)[gt] = 0.f;
    if (gt < S * 8) { const int pos = gt >> 3, i = gt & 7; const float inv = powf(500000.0f, -(float)(2 * i) / 16.0f); const float ang = (float)pos * inv;
        WSP(float2, WS_ROPE)[gt] = make_float2(cosf(ang), sinf(ang)); }
    if (blockIdx.x < 192) {
        LAS float* sc = (LAS float*)F.lds;
        for (int i = F.tid; i < NB * D; i += NTHREADS) { const float v = F.c[i]; sc[i] = v / (1.f + expf(-v)); }
        __syncthreads();
        const int j0 = blockIdx.x * 32, col = j0 + (F.lane & 31), kpar = F.lane >> 5;
        float acc[8];
#pragma unroll
        for (int b = 0; b < 8; ++b) acc[b] = 0.f;
        for (int i = 0; i < 64; ++i) { const int k = F.wave * 128 + 2 * i + kpar; const float w = F.w_ada[(size_t)k * NMOD + col];
#pragma unroll
            for (int b = 0; b < 8; ++b) acc[b] += sc[b * D + k] * w; }
#pragma unroll
        for (int b = 0; b < 8; ++b) acc[b] += __shfl_xor(acc[b], 32);
        LAS float* red = (LAS float*)(F.lds + 32768);
        if (F.lane < 32) {
#pragma unroll
            for (int b = 0; b < 8; ++b) red[(F.wave * 8 + b) * 32 + F.lane] = acc[b]; }
        __syncthreads();
        if (F.tid < 256) { const int b = F.tid >> 5, cc = F.tid & 31; float s = F.b_ada[j0 + cc];
#pragma unroll
            for (int w = 0; w < 8; ++w) s += red[(w * 8 + b) * 32 + cc];
            WSP(float, WS_MOD)[b * NMOD + j0 + cc] = s; }
        __syncthreads();
    }
    LAS float* scr = (LAS float*)(F.lds + F.wave * 16384);
    const int gw = blockIdx.x * NWAVES + F.wave, NGW = F.G * NWAVES;
    constexpr int I_IN = 16 * 160, I_PA = 8 * 32, I_O = 16 * 32, I_E1 = 16 * 16, I_E2 = 8 * 32;
    constexpr int NITEMS = I_IN + 2 * I_PA + I_O + NE * (2 * I_E1 + I_E2);
    for (int it = gw; it < NITEMS; it += NGW) {
        int r = it;
        if (r < I_IN) { const int kb = r / 160, sc = r % 160; transpose_item(F.w_in, NIN, 64 * kb, 32 * sc, WSP(bf16_t, WS_WIN_T) + (size_t)win_dest_row(sc) * 1024 + 64 * kb, 1024, scr, F.lane); continue; } r -= I_IN;
        if (r < I_PA) { const int kb = r / 32, sc = r % 32; transpose_item(F.w_pa, 1024, 64 * kb, 32 * sc, WSP(bf16_t, WS_WP_T) + (size_t)(32 * sc) * 1024 + 64 * kb, 1024, scr, F.lane); continue; } r -= I_PA;
        if (r < I_PA) { const int kb = r / 32, sc = r % 32; transpose_item(F.w_pb, 1024, 64 * kb, 32 * sc, WSP(bf16_t, WS_WP_T) + (size_t)(32 * sc) * 1024 + 512 + 64 * kb, 1024, scr, F.lane); continue; } r -= I_PA;
        if (r < I_O) { const int kb = r / 32, sc = r % 32; transpose_item(F.w_o, 1024, 64 * kb, 32 * sc, WSP(bf16_t, WS_WO_T) + (size_t)(32 * sc) * 1024 + 64 * kb, 1024, scr, F.lane); continue; } r -= I_O;
        const int e = r / (2 * I_E1 + I_E2); r -= e * (2 * I_E1 + I_E2);
        if (r < 2 * I_E1) { const int is3 = r >= I_E1; if (is3) r -= I_E1; const int kb = r / 16, sc = r % 16;
            transpose_item((is3 ? F.w3 : F.w1) + (size_t)e * D * DE, DE, 64 * kb, 32 * sc, WSP(bf16_t, WS_W13_T) + ((size_t)e * 1024 + 256 * (sc >> 2) + 128 * is3 + 32 * (sc & 3)) * 1024 + 64 * kb, 1024, scr, F.lane); continue; }
        r -= 2 * I_E1;
        { const int kb = r / 32, sc = r % 32;
            transpose_item(F.w2 + (size_t)e * DE * D, D, 64 * kb, 32 * sc, WSP(bf16_t, WS_W2_T) + ((size_t)e * 1024 + 32 * sc) * 512 + 64 * kb, 512, scr, F.lane); }
    }
}

__device__ __forceinline__ float wave_sum(float v) {
#pragma unroll
    for (int o = 1; o < 64; o <<= 1) v += __shfl_xor(v, o);
    return v;
}
__device__ __forceinline__ void s1_norm1(Frame& F) {
    const int gw = blockIdx.x * NWAVES + F.wave;
    const int row0 = gw * 16, b = row0 / S;
    if (row0 >= T) return;
    const float* mod = WSP(float, WS_MOD) + (size_t)b * NMOD;
    f32x4 gs[4], sh[4];
#pragma unroll
    for (int j = 0; j < 4; ++j) { const int col = 4 * F.lane + 256 * j; const f32x4 g = *(const f32x4*)(F.g1 + col), s = *(const f32x4*)(mod + 1024 + col); gs[j] = g * (s + 1.0f); sh[j] = *(const f32x4*)(mod + col); }
    for (int r = 0; r < 16; ++r) {
        const float* xr = F.x + (size_t)(row0 + r) * D;
        f32x4 v[4]; float ss = 0.f;
#pragma unroll
        for (int j = 0; j < 4; ++j) { v[j] = *(const f32x4*)(xr + 4 * F.lane + 256 * j); ss += (v[j].x * v[j].x + v[j].y * v[j].y) + (v[j].z * v[j].z + v[j].w * v[j].w); }
        const float rinv = rsqrtf(wave_sum(ss) * (1.f / D) + EPS);
        bf16_t* o = WSP(bf16_t, WS_H) + (size_t)(row0 + r) * D;
#pragma unroll
        for (int j = 0; j < 4; ++j) { const f32x4 h = v[j] * rinv * gs[j] + sh[j]; u32x2 w; w.x = pk2(h.x, h.y); w.y = pk2(h.z, h.w); *(u32x2*)(o + 4 * F.lane + 256 * j) = w; }
    }
}

struct RowsLinear { const bf16_t* base; size_t pitch; __device__ __forceinline__ const bf16_t* operator()(int r) const { return base + (size_t)r * pitch; } };
template <class AR, class BR>
__device__ __forceinline__ void sgemm_tile(LAS float* tile, int K, const AR& arow, const BR& brow, int wave, int lane) {
    const int fr = lane & 15, fq = lane >> 4, rb = 16 * (wave & 3), cb = 32 * (wave >> 2);
    const bf16_t* ap = arow(rb + fr) + 8 * fq;
    const bf16_t* bp0 = brow(cb + fr) + 8 * fq;
    const bf16_t* bp1 = brow(cb + 16 + fr) + 8 * fq;
    f32x4 acc0 = {0.f, 0.f, 0.f, 0.f}, acc1 = {0.f, 0.f, 0.f, 0.f};
#pragma unroll 4
    for (int k = 0; k < K; k += 32) {
        const bf16x8 a = *(const bf16x8*)(ap + k), b0 = *(const bf16x8*)(bp0 + k), b1 = *(const bf16x8*)(bp1 + k);
        acc0 = __builtin_amdgcn_mfma_f32_16x16x32_bf16(a, b0, acc0, 0, 0, 0);
        acc1 = __builtin_amdgcn_mfma_f32_16x16x32_bf16(a, b1, acc1, 0, 0, 0);
    }
#pragma unroll
    for (int j = 0; j < 4; ++j) { tile[(rb + fq * 4 + j) * 65 + cb + fr] = acc0[j]; tile[(rb + fq * 4 + j) * 65 + cb + 16 + fr] = acc1[j]; }
}

struct WinRowsHead { const bf16_t* base; int rb; __device__ __forceinline__ const bf16_t* operator()(int d) const { return base + (size_t)(rb + 128 * (d >> 5) + (d & 31)) * 1024; } };
__device__ __forceinline__ void s2_simple(Frame& F) {
    LAS float* tile = (LAS float*)F.lds; LAS float* tile2 = tile + 64 * 65;
    const bf16_t* H = WSP(bf16_t, WS_H); const bf16_t* WT = WSP(bf16_t, WS_WIN_T);
    const int row = F.tid >> 3, seg = F.tid & 7;
    for (int it = blockIdx.x; it < 512 * 72; it += F.G) {
        const int rt = it / 72, ct = it % 72, r0 = rt * 64, gr = r0 + row;
        const RowsLinear ar{H + (size_t)r0 * 1024, 1024};
        float v[8];
        if (ct < 16) {
            const int isk = ct >> 3, hh = ct & 7;
            const WinRowsHead br{WT, 512 * isk + 256 * (hh >> 2) + 32 * (hh & 3)};
            sgemm_tile(tile, 1024, ar, br, F.wave, F.lane); __syncthreads();
            float ss = 0.f;
#pragma unroll
            for (int e = 0; e < 8; ++e) { v[e] = tile[row * 65 + 8 * seg + e]; ss += v[e] * v[e]; }
            ss += __shfl_xor(ss, 1); ss += __shfl_xor(ss, 2); ss += __shfl_xor(ss, 4);
            const float rinv = rsqrtf(ss * (1.f / 64.f) + EPS);
            const float* g = isk ? F.g_k : F.g_q;
            const int pos = gr & (S - 1);
#pragma unroll
            for (int e = 0; e < 8; ++e) { v[e] = v[e] * rinv * g[8 * seg + e]; const float pv = __shfl_xor(v[e], 1);
                if (seg < 2) { const float2 cs = WSP(float2, WS_ROPE)[pos * 8 + e]; v[e] = (seg == 0) ? (v[e] * cs.x - pv * cs.y) : (v[e] * cs.x + pv * cs.y); } }
            if (!isk) {
#pragma unroll
                for (int e = 0; e < 8; ++e) v[e] *= C2;
                *(u32x4*)(WSP(bf16_t, WS_YAB) + (size_t)gr * 1024 + hh * 64 + 8 * seg) = pack8(v);
            } else {
                *(u32x4*)(WSP(bf16_t, WS_K) + (size_t)gr * 512 + hh * 64 + 8 * seg) = pack8(v);
#pragma unroll
                for (int e = 0; e < 8; ++e) tile[row * 65 + 8 * seg + e] = v[e];
                __syncthreads();
                if (F.tid < 64) { float s = 0.f; for (int r = 0; r < 64; ++r) s += tile[r * 65 + F.tid];
                    const int b = r0 / S, blk = (r0 & (S - 1)) >> 8;
                    atomicAdd(WSP(float, WS_KMEAN) + ((size_t)(b * NH + hh) * 16 + blk) * 64 + F.tid, s * (1.f / 256.f)); }
            }
        } else if (ct < 24) {
            const RowsLinear br{WT + (size_t)(1024 + 64 * (ct - 16)) * 1024, 1024};
            sgemm_tile(tile, 1024, ar, br, F.wave, F.lane); __syncthreads();
#pragma unroll
            for (int e = 0; e < 8; ++e) v[e] = tile[row * 65 + 8 * seg + e];
            *(u32x4*)(WSP(bf16_t, WS_V) + (size_t)gr * 512 + 64 * (ct - 16) + 8 * seg) = pack8(v);
        } else if (ct < 32) {
            const int cu = 64 * (ct - 24), rb = 256 * (6 + (cu >> 7)) + (cu & 127);
            const RowsLinear bx{WT + (size_t)rb * 1024, 1024}, bc{WT + (size_t)(rb + 128) * 1024, 1024};
            sgemm_tile(tile, 1024, ar, bx, F.wave, F.lane); sgemm_tile(tile2, 1024, ar, bc, F.wave, F.lane); __syncthreads();
#pragma unroll
            for (int e = 0; e < 8; ++e) v[e] = tile[row * 65 + 8 * seg + e] * tile2[row * 65 + 8 * seg + e];
            *(u32x4*)(WSP(bf16_t, WS_U) + (size_t)gr * 512 + cu + 8 * seg) = pack8(v);
        } else if (ct < 40) {
            const RowsLinear br{WT + (size_t)(2560 + 64 * (ct - 32)) * 1024, 1024};
            sgemm_tile(tile, 1024, ar, br, F.wave, F.lane); __syncthreads();
#pragma unroll
            for (int e = 0; e < 8; ++e) v[e] = tile[row * 65 + 8 * seg + e];
            *(u32x4*)(WSP(bf16_t, WS_BG) + (size_t)gr * 512 + 64 * (ct - 32) + 8 * seg) = pack8(v);
        } else {
            const RowsLinear br{WT + (size_t)(3072 + 64 * (ct - 40)) * 1024, 1024};
            sgemm_tile(tile, 1024, ar, br, F.wave, F.lane); __syncthreads();
#pragma unroll
            for (int e = 0; e < 8; ++e) v[e] = 1.f / (1.f + __expf(-tile[row * 65 + 8 * seg + e]));
            *(u32x4*)(WSP(bf16_t, WS_GATES) + (size_t)gr * 2048 + 64 * (ct - 40) + 8 * seg) = pack8(v);
        }
        __syncthreads();
    }
}

namespace pg8 {
constexpr int BM = 256, BK = 64, HALF = 128, HTB = HALF * BK * 2, STAGE_BYTES = 8 * HTB, NXCD = 8, WGM = 8;
__device__ __forceinline__ int lds_byte(int r, int c) { const int st = (r >> 4) * 2 + (c >> 5), rr = r & 15, cc = c & 31, ob = rr * 64 + cc * 2; return st * 1024 + (ob ^ (((ob >> 9) & 1) << 5)); }
__device__ __forceinline__ void stage_rc(int b, int& R, int& C) { const int st = b / 1024, sb = b % 1024, swz = sb ^ (((sb >> 9) & 1) << 5); R = (st >> 1) * 16 + swz / 64; C = (st & 1) * 32 + (swz % 64) / 2; }
__device__ __forceinline__ int perm32(int rho) { const int n = rho >> 4, i = rho & 15; return 8 * (i >> 2) + 4 * n + (i & 3); }
struct Unit { int pm, pn; const char* a; const char* b; };
__device__ __forceinline__ bool static_unit(int i, int G, int c, int nM, int nN, int& pm, int& pn) {
    const int nwg = nM * nN; const long L = (long)i * G + c; if (L >= nwg) return false;
    int wgid = (int)L; { const int q = nwg / NXCD, r = nwg % NXCD, xcd = wgid % NXCD, off = wgid / NXCD; wgid = (xcd < r ? xcd * (q + 1) : r * (q + 1) + (xcd - r) * q) + off; }
    const int nig = WGM * nN, gid = wgid / nig, fm = gid * WGM, gsz = (nM - fm) < WGM ? (nM - fm) : WGM;
    pm = fm + ((wgid % nig) % gsz); pn = (wgid % nig) / gsz; return true;
}
struct DenseSched {
    static constexpr bool GATHER = false;
    const char* A; const char* Bt; int nM, nN, K, G, c;
    __device__ __forceinline__ bool next(int i, Unit& u) const { if (!static_unit(i, G, c, nM, nN, u.pm, u.pn)) return false;
        u.a = A + (size_t)u.pm * BM * K * 2; u.b = Bt + (size_t)u.pn * BM * K * 2; return true; }
    __device__ __forceinline__ int row_index(const Unit&, int) const { return 0; }
};

template <class Epi, class Sched>
__device__ __forceinline__ void gemm_phase(LAS unsigned char* lds, const int K, const Sched& S, const Epi& E) {
    const int tid = threadIdx.x, wid = __builtin_amdgcn_readfirstlane(tid >> 6), lane = tid & 63, wr = wid >> 2, wc = wid & 3, fr = lane & 15, fq = lane >> 4;
    const int nt = K / BK;
    unsigned voffB[2], vA[2][2], vN[2][2]; int Rr[2], Cc[2];
#pragma unroll
    for (int i = 0; i < 2; ++i) { int R, C; stage_rc(tid * 16 + i * 8192, R, C); const int Rb = (R & ~31) + perm32(R & 31);
        Rr[i] = R; Cc[i] = C; voffB[i] = (unsigned)(Rb * K + C) * 2u;
        vA[0][i] = (unsigned)(R * K + C) * 2u; vA[1][i] = (unsigned)((HALF + R) * K + C) * 2u; vN[0][i] = vA[0][i]; vN[1][i] = vA[1][i]; }
    const size_t kstep = (size_t)(BK * 2);
    const size_t hstep = (size_t)HALF * K * 2;
    const unsigned ldsw = (unsigned)wid * 1024u;
    const int aoff = lds_byte(wr * 64 + fr, fq * 8), boff = lds_byte(wc * 32 + fr, fq * 8);
#define PG8_SA(b, h) (((b) * 2 + (h)) * HTB)
#define PG8_SB(b, h) ((4 + (b) * 2 + (h)) * HTB)
#define PG8_STAGE(bufoff, gbase, voff) do { _Pragma("unroll") for (int _i = 0; _i < 2; ++_i) \
        __builtin_amdgcn_global_load_lds((const unsigned*)((const char*)(gbase) + (voff)[_i]), (LAS unsigned*)(lds + (bufoff) + ldsw + _i * 8192), 16, 0, 0); } while (0)
#define PG8_LDA(dst, b, h) do { _Pragma("unroll") for (int m = 0; m < 4; ++m) _Pragma("unroll") for (int k = 0; k < 2; ++k) dst[m][k] = *(const LAS bf16x8*)(lds + PG8_SA(b, h) + aoff + m * 2048 + k * 1024); } while (0)
#define PG8_LDB(dst, b, h) do { _Pragma("unroll") for (int n = 0; n < 2; ++n) _Pragma("unroll") for (int k = 0; k < 2; ++k) dst[n][k] = *(const LAS bf16x8*)(lds + PG8_SB(b, h) + boff + n * 2048 + k * 1024); } while (0)
#define PG8_MMA(ai, bj, At, Bt) do { __builtin_amdgcn_s_setprio(1); _Pragma("unroll") for (int m = 0; m < 4; ++m) _Pragma("unroll") for (int n = 0; n < 2; ++n) _Pragma("unroll") for (int k = 0; k < 2; ++k) \
        acc[ai][bj][m][n] = __builtin_amdgcn_mfma_f32_16x16x32_bf16(Bt[n][k], At[m][k], acc[ai][bj][m][n], 0, 0, 0); __builtin_amdgcn_s_setprio(0); } while (0)
#define PG8_WAIT_V(n) asm volatile("s_waitcnt vmcnt(" #n ")" ::: "memory")
#define PG8_WAIT_L(n) asm volatile("s_waitcnt lgkmcnt(" #n ")" ::: "memory")
#define PG8_BAR __builtin_amdgcn_s_barrier()
#define PG8_SCHED __builtin_amdgcn_sched_barrier(0)
#define PG8_AOFF(dst, u) do { _Pragma("unroll") for (int _h = 0; _h < 2; ++_h) _Pragma("unroll") for (int _i = 0; _i < 2; ++_i) \
        dst[_h][_i] = (unsigned)(S.row_index(u, _h * HALF + Rr[_i]) * K + Cc[_i]) * 2u; } while (0)
    Unit cur, nxt; int ui = 0;
    if (!S.next(0, cur)) return;
    if constexpr (Sched::GATHER) PG8_AOFF(vA, cur);
    f32x4 acc[2][2][4][2];
#pragma unroll
    for (int a = 0; a < 2; ++a)
#pragma unroll
        for (int b = 0; b < 2; ++b)
#pragma unroll
            for (int m = 0; m < 4; ++m)
#pragma unroll
                for (int n = 0; n < 2; ++n) acc[a][b][m][n] = (f32x4){0.f, 0.f, 0.f, 0.f};
    bf16x8 At[4][2], B0[2][2], B1[2][2];
    const char* cA = cur.a; const char* cB = cur.b;
    PG8_STAGE(PG8_SB(0, 0), cB, voffB); PG8_STAGE(PG8_SB(0, 1), cB + hstep, voffB); PG8_STAGE(PG8_SA(0, 0), cA, vA[0]); PG8_STAGE(PG8_SA(0, 1), cA, vA[1]);
    if (wr == 1) PG8_BAR;
    PG8_WAIT_V(2); PG8_BAR;
    PG8_STAGE(PG8_SB(1, 0), cB + kstep, voffB); PG8_STAGE(PG8_SA(1, 0), cA + kstep, vA[0]); PG8_STAGE(PG8_SB(1, 1), cB + hstep + kstep, voffB);
    PG8_WAIT_V(6); PG8_BAR;
    for (;;) {
        const bool has_next = S.next(ui + 1, nxt);
        const char* nA = has_next ? nxt.a : cA; const char* nB = has_next ? nxt.b : cB;
        if constexpr (Sched::GATHER) { if (has_next) PG8_AOFF(vN, nxt); else {
#pragma unroll
            for (int h = 0; h < 2; ++h)
#pragma unroll
                for (int i = 0; i < 2; ++i) vN[h][i] = vA[h][i]; } }
        for (int hk = 0; hk < (Epi::HAS_MID ? 2 : 1); ++hk) {
        if constexpr (Epi::HAS_MID) { if (hk == 1) E.mid(acc, cur, wr, wc, fr, fq); }
        const int tb = (Epi::HAS_MID && hk == 1) ? nt / 2 : 0, te = (Epi::HAS_MID && hk == 0) ? nt / 2 : nt;
        for (int t = tb; t < te; t += 2) {
            const bool last = (t == nt - 2);
            const char* a1 = cA + (size_t)(t + 1) * kstep;
            const char* a2 = last ? nA : cA + (size_t)(t + 2) * kstep; const char* b2 = last ? nB : cB + (size_t)(t + 2) * kstep;
            const char* a3 = a2 + kstep; const char* b3 = b2 + kstep;
            unsigned w0[2], w1[2];
#pragma unroll
            for (int i = 0; i < 2; ++i) { w0[i] = (Sched::GATHER && last) ? vN[0][i] : vA[0][i]; w1[i] = (Sched::GATHER && last) ? vN[1][i] : vA[1][i]; }
            PG8_LDB(B0, 0, 0); PG8_LDB(B1, 0, 1); PG8_SCHED; PG8_LDA(At, 0, 0); PG8_STAGE(PG8_SA(1, 1), a1, vA[1]);
            PG8_WAIT_V(8); PG8_WAIT_L(0); PG8_BAR; PG8_MMA(0, 0, At, B0); PG8_MMA(0, 1, At, B1); PG8_BAR; PG8_SCHED;
            PG8_LDA(At, 0, 1); PG8_STAGE(PG8_SB(0, 0), b2, voffB); PG8_STAGE(PG8_SB(0, 1), b2 + hstep, voffB); PG8_STAGE(PG8_SA(0, 0), a2, w0);
            PG8_WAIT_V(8); PG8_WAIT_L(0); PG8_BAR; PG8_MMA(1, 0, At, B0); PG8_MMA(1, 1, At, B1); PG8_BAR; PG8_SCHED;
            PG8_LDB(B0, 1, 0); PG8_LDB(B1, 1, 1); PG8_SCHED; PG8_LDA(At, 1, 0); PG8_STAGE(PG8_SA(0, 1), a2, w1);
            PG8_WAIT_V(8); PG8_WAIT_L(0); PG8_BAR; PG8_MMA(0, 0, At, B0); PG8_MMA(0, 1, At, B1); PG8_BAR; PG8_SCHED;
            PG8_LDA(At, 1, 1); PG8_STAGE(PG8_SB(1, 0), b3, voffB); PG8_STAGE(PG8_SB(1, 1), b3 + hstep, voffB); PG8_STAGE(PG8_SA(1, 0), a3, w0);
            PG8_WAIT_V(8); PG8_WAIT_L(0); PG8_BAR; PG8_MMA(1, 0, At, B0); PG8_MMA(1, 1, At, B1); PG8_BAR; PG8_SCHED;
        }
        }
        if (wr == 0) PG8_BAR;
        E(acc, cur, wr, wc, fr, fq);
        if (!has_next) break;
#pragma unroll
        for (int a = 0; a < 2; ++a)
#pragma unroll
            for (int b = 0; b < 2; ++b)
#pragma unroll
                for (int m = 0; m < 4; ++m)
#pragma unroll
                    for (int n = 0; n < 2; ++n) acc[a][b][m][n] = (f32x4){0.f, 0.f, 0.f, 0.f};
        cur = nxt; cA = nA; cB = nB; ++ui;
        if constexpr (Sched::GATHER) {
#pragma unroll
            for (int h = 0; h < 2; ++h)
#pragma unroll
                for (int i = 0; i < 2; ++i) vA[h][i] = vN[h][i]; }
        if (wr == 1) PG8_BAR;
    }
    PG8_WAIT_V(0);
    PG8_BAR;
#undef PG8_SA
#undef PG8_SB
#undef PG8_STAGE
#undef PG8_LDA
#undef PG8_LDB
#undef PG8_MMA
#undef PG8_WAIT_V
#undef PG8_WAIT_L
#undef PG8_BAR
#undef PG8_SCHED
#undef PG8_AOFF
}
}

typedef f32x4 Acc[2][2][4][2];
struct EpiG1 {
    static constexpr bool HAS_MID = false;
    unsigned char* ws; const float* g_q; const float* g_k;
    __device__ __forceinline__ void mid(Acc&, const pg8::Unit&, int, int, int, int) const {}
    __device__ __forceinline__ void operator()(Acc& acc, const pg8::Unit& u, int wr, int wc, int fr, int fq) const {
        const int pn = u.pn, row0 = u.pm * 256 + wr * 64 + fr;
        if (pn < 4) {
            const int isk = pn >> 1, hh = 4 * (pn & 1) + wc;
            const float* g = isk ? g_k : g_q;
            f32x4 gv[2][2];
#pragma unroll
            for (int bj = 0; bj < 2; ++bj)
#pragma unroll
                for (int n = 0; n < 2; ++n) gv[bj][n] = *(const f32x4*)(g + 32 * bj + 8 * fq + 4 * n);
            f32x4 cs_[2][2];
#pragma unroll
            for (int bj = 0; bj < 2; ++bj)
#pragma unroll
                for (int n = 0; n < 2; ++n) cs_[bj][n] = (f32x4){0.f, 0.f, 0.f, 0.f};
            const float2* rope = (const float2*)(ws + WS_ROPE);
            bf16_t* dst = isk ? (bf16_t*)(ws + WS_K) : (bf16_t*)(ws + WS_YAB);
            const int pitch = isk ? 512 : 1024;
#pragma unroll
            for (int ai = 0; ai < 2; ++ai)
#pragma unroll
                for (int m = 0; m < 4; ++m) {
                    const int r = row0 + 128 * ai + 16 * m, pos = r & (S - 1);
                    f32x4 v[2][2]; float ss = 0.f;
#pragma unroll
                    for (int bj = 0; bj < 2; ++bj)
#pragma unroll
                        for (int n = 0; n < 2; ++n) { v[bj][n] = acc[ai][bj][m][n]; ss += (v[bj][n].x * v[bj][n].x + v[bj][n].y * v[bj][n].y) + (v[bj][n].z * v[bj][n].z + v[bj][n].w * v[bj][n].w); }
                    ss += __shfl_xor(ss, 16); ss += __shfl_xor(ss, 32);
                    const float rinv = rsqrtf(ss * (1.f / 64.f) + EPS);
#pragma unroll
                    for (int bj = 0; bj < 2; ++bj)
#pragma unroll
                        for (int n = 0; n < 2; ++n) v[bj][n] = v[bj][n] * rinv * gv[bj][n];
#pragma unroll
                    for (int n = 0; n < 2; ++n)
#pragma unroll
                        for (int e = 0; e < 4; ++e) { const float pv = __shfl_xor(v[0][n][e], 16);
                            if (fq < 2) { const float2 cs = rope[pos * 8 + 4 * n + e]; v[0][n][e] = (fq == 0) ? (v[0][n][e] * cs.x - pv * cs.y) : (v[0][n][e] * cs.x + pv * cs.y); } }
                    if (isk) {
#pragma unroll
                        for (int bj = 0; bj < 2; ++bj)
#pragma unroll
                            for (int n = 0; n < 2; ++n) cs_[bj][n] += v[bj][n];
                    }
                    const float sc = isk ? 1.f : C2;
#pragma unroll
                    for (int bj = 0; bj < 2; ++bj) { u32x4 w; const f32x4 a = v[bj][0] * sc, b = v[bj][1] * sc;
                        w.x = pk2(a.x, a.y); w.y = pk2(a.z, a.w); w.z = pk2(b.x, b.y); w.w = pk2(b.z, b.w);
                        *(u32x4*)(dst + (size_t)r * pitch + hh * 64 + 32 * bj + 8 * fq) = w; }
                }
            if (isk) {
                const int b = u.pm >> 4, blk = u.pm & 15;
                float* km = (float*)(ws + WS_KMEAN) + ((size_t)(b * NH + hh) * 16 + blk) * 64;
#pragma unroll
                for (int bj = 0; bj < 2; ++bj)
#pragma unroll
                    for (int n = 0; n < 2; ++n)
#pragma unroll
                        for (int e = 0; e < 4; ++e) { float s = cs_[bj][n][e]; s += __shfl_xor(s, 1); s += __shfl_xor(s, 2); s += __shfl_xor(s, 4); s += __shfl_xor(s, 8);
                            if (fr == 0) atomicAdd(km + 32 * bj + 8 * fq + 4 * n + e, s * (1.f / 256.f)); }
            }
        } else if (pn >= 6 && pn < 10) {
            bf16_t* dst = (bf16_t*)(ws + WS_U);
#pragma unroll
            for (int ai = 0; ai < 2; ++ai)
#pragma unroll
                for (int m = 0; m < 4; ++m) { const int r = row0 + 128 * ai + 16 * m;
                    const f32x4 a = acc[ai][0][m][0] * acc[ai][1][m][0], b = acc[ai][0][m][1] * acc[ai][1][m][1]; u32x4 w;
                    w.x = pk2(a.x, a.y); w.y = pk2(a.z, a.w); w.z = pk2(b.x, b.y); w.w = pk2(b.z, b.w);
                    *(u32x4*)(dst + (size_t)r * 512 + 128 * (pn - 6) + 32 * wc + 8 * fq) = w; }
        } else {
            bf16_t* dst; int pitch, c0; bool sig = false;
            if (pn < 6) { dst = (bf16_t*)(ws + WS_V); pitch = 512; c0 = 256 * (pn - 4); }
            else if (pn < 12) { dst = (bf16_t*)(ws + WS_BG); pitch = 512; c0 = 256 * (pn - 10); }
            else { dst = (bf16_t*)(ws + WS_GATES); pitch = 2048; c0 = 256 * (pn - 12); sig = true; }
#pragma unroll
            for (int ai = 0; ai < 2; ++ai)
#pragma unroll
                for (int m = 0; m < 4; ++m) { const int r = row0 + 128 * ai + 16 * m;
#pragma unroll
                    for (int bj = 0; bj < 2; ++bj) { f32x4 a = acc[ai][bj][m][0], b = acc[ai][bj][m][1];
                        if (sig) {
#pragma unroll
                            for (int e = 0; e < 4; ++e) { a[e] = __builtin_amdgcn_rcpf(1.f + __expf(-a[e])); b[e] = __builtin_amdgcn_rcpf(1.f + __expf(-b[e])); } }
                        u32x4 w; w.x = pk2(a.x, a.y); w.y = pk2(a.z, a.w); w.z = pk2(b.x, b.y); w.w = pk2(b.z, b.w);
                        *(u32x4*)(dst + (size_t)r * pitch + c0 + 128 * bj + 32 * wc + 8 * fq) = w; } }
        }
    }
};
__device__ __forceinline__ void s2_fast(Frame& F) {
    const pg8::DenseSched Sd{(const char*)(F.ws + WS_H), (const char*)(F.ws + WS_WIN_T), T / 256, NIN / 256, 1024, F.G, (int)blockIdx.x};
    const EpiG1 E{F.ws, F.g_q, F.g_k};
    pg8::gemm_phase<EpiG1, pg8::DenseSched>(F.lds, 1024, Sd, E);
}

constexpr float NEG_BIG = -1e30f;
__device__ __forceinline__ void s3_simple(Frame& F) {
    LAS float* tS = (LAS float*)F.lds;
    LAS bf16_t* Pb = (LAS bf16_t*)(F.lds + 16896);
    LAS bf16_t* Vt = (LAS bf16_t*)(F.lds + 16896 + 9216);
    LAS float* mrow = (LAS float*)(F.lds + 16896 + 18432);
    LAS float* lrow = mrow + 64; LAS float* arow_ = mrow + 128; LAS int* sel = (LAS int*)(mrow + 192); LAS int* um = sel + 64;
    bf16_t* YAB = WSP(bf16_t, WS_YAB); const bf16_t* Kb = WSP(bf16_t, WS_K); const bf16_t* Vb = WSP(bf16_t, WS_V);
    const float* kmean = WSP(float, WS_KMEAN);
    const int row = F.tid >> 3, seg = F.tid & 7, fr = F.lane & 15, fq = F.lane >> 4, rb = 16 * (F.wave & 3), cb = 32 * (F.wave >> 2);
    for (int it = blockIdx.x; it < NB * NH * 64; it += F.G) {
        const int qc = it & 63, h = (it >> 6) & 7, b = it >> 9, cur = qc >> 2, t0 = 64 * qc;
        const size_t tb = (size_t)b * S;
        if (F.tid < 64) {
            float q[64];
            const bf16_t* qp = YAB + (tb + t0 + F.tid) * 1024 + h * 64;
#pragma unroll
            for (int i = 0; i < 8; ++i) { float t8[8]; unpack8(*(const u32x4*)(qp + 8 * i), t8);
#pragma unroll
                for (int e = 0; e < 8; ++e) q[8 * i + e] = t8[e]; }
            float b0 = -INFINITY, b1 = -INFINITY, b2 = -INFINITY; int i0 = -1, i1 = -1, i2 = -1;
            for (int j = 0; j < cur; ++j) { const float* km = kmean + ((size_t)(b * NH + h) * 16 + j) * 64; float s = 0.f;
#pragma unroll
                for (int d = 0; d < 64; ++d) s += q[d] * km[d];
                if (s > b0) { b2 = b1; i2 = i1; b1 = b0; i1 = i0; b0 = s; i0 = j; } else if (s > b1) { b2 = b1; i2 = i1; b1 = s; i1 = j; } else if (s > b2) { b2 = s; i2 = j; } }
            int m = 0; if (i0 >= 0) m |= 1 << i0; if (i1 >= 0) m |= 1 << i1; if (i2 >= 0) m |= 1 << i2;
            sel[F.tid] = m; mrow[F.tid] = NEG_BIG; lrow[F.tid] = 0.f;
            int u = m;
#pragma unroll
            for (int o = 1; o < 64; o <<= 1) u |= __shfl_xor(u, o);
            if (F.tid == 0) um[0] = u;
        }
        __syncthreads();
        const int umask = um[0];
        f32x4 o0 = {0.f, 0.f, 0.f, 0.f}, o1 = {0.f, 0.f, 0.f, 0.f};
        const RowsLinear aq{YAB + (tb + t0) * 1024 + h * 64, 1024};
        for (int j = 0; j <= cur; ++j) {
            if (j < cur && !((umask >> j) & 1)) continue;
            const int nkt = (j == cur) ? ((qc & 3) + 1) : 4;
            for (int kt = 0; kt < nkt; ++kt) {
                const int kbase = 256 * j + 64 * kt;
                const RowsLinear bk{Kb + (tb + kbase) * 512 + h * 64, 512};
                sgemm_tile(tS, 64, aq, bk, F.wave, F.lane);
                { float vv[8]; unpack8(*(const u32x4*)(Vb + (tb + kbase + row) * 512 + h * 64 + 8 * seg), vv);
#pragma unroll
                    for (int e = 0; e < 8; ++e) Vt[(8 * seg + e) * 72 + row] = (bf16_t)f2bf(vv[e]); }
                __syncthreads();
                {
                    float s[8]; float mx = NEG_BIG;
                    const bool rowsel = (j == cur) || ((sel[row] >> j) & 1);
#pragma unroll
                    for (int e = 0; e < 8; ++e) { const int c = 8 * seg + e; float x = tS[row * 65 + c];
                        if (!rowsel || (j == cur && kbase + c > t0 + row)) x = NEG_BIG; s[e] = x; mx = fmaxf(mx, x); }
                    mx = fmaxf(mx, __shfl_xor(mx, 1)); mx = fmaxf(mx, __shfl_xor(mx, 2)); mx = fmaxf(mx, __shfl_xor(mx, 4));
                    const float mold = mrow[row], mnew = fmaxf(mold, mx);
                    float alpha = 1.f, ps = 0.f; float p[8];
                    if (mnew <= NEG_BIG) {
#pragma unroll
                        for (int e = 0; e < 8; ++e) p[e] = 0.f;
                    } else { alpha = exp2f(mold - mnew);
#pragma unroll
                        for (int e = 0; e < 8; ++e) { p[e] = (s[e] <= NEG_BIG) ? 0.f : exp2f(s[e] - mnew); ps += p[e]; } }
                    ps += __shfl_xor(ps, 1); ps += __shfl_xor(ps, 2); ps += __shfl_xor(ps, 4);
                    const float lold = lrow[row];
                    *(LAS u32x4*)(Pb + row * 72 + 8 * seg) = pack8(p);
                    if (seg == 0) { mrow[row] = mnew; lrow[row] = lold * alpha + ps; arow_[row] = alpha; }
                }
                __syncthreads();
                {
#pragma unroll
                    for (int r = 0; r < 4; ++r) { const float a = arow_[rb + fq * 4 + r]; o0[r] *= a; o1[r] *= a; }
#pragma unroll
                    for (int ks = 0; ks < 2; ++ks) {
                        const bf16x8 a = *(const LAS bf16x8*)(Pb + (rb + fr) * 72 + 32 * ks + 8 * fq);
                        const bf16x8 v0 = *(const LAS bf16x8*)(Vt + (cb + fr) * 72 + 32 * ks + 8 * fq);
                        const bf16x8 v1 = *(const LAS bf16x8*)(Vt + (cb + 16 + fr) * 72 + 32 * ks + 8 * fq);
                        o0 = __builtin_amdgcn_mfma_f32_16x16x32_bf16(a, v0, o0, 0, 0, 0);
                        o1 = __builtin_amdgcn_mfma_f32_16x16x32_bf16(a, v1, o1, 0, 0, 0);
                    }
                }
                __syncthreads();
            }
        }
#pragma unroll
        for (int r = 0; r < 4; ++r) { const float li = 1.f / lrow[rb + fq * 4 + r]; tS[(rb + fq * 4 + r) * 65 + cb + fr] = o0[r] * li; tS[(rb + fq * 4 + r) * 65 + cb + 16 + fr] = o1[r] * li; }
        __syncthreads();
        { float v[8];
#pragma unroll
            for (int e = 0; e < 8; ++e) v[e] = tS[row * 65 + 8 * seg + e];
            *(u32x4*)(YAB + (tb + t0 + row) * 1024 + h * 64 + 8 * seg) = pack8(v); }
        __syncthreads();
    }
    const bf16_t* U = WSP(bf16_t, WS_U); const bf16_t* BG = WSP(bf16_t, WS_BG);
    for (int i = blockIdx.x * NTHREADS + F.tid; i < T * 64; i += F.G * NTHREADS) {
        const int t = i >> 6, c0 = (i & 63) * 8, pos = t & (S - 1);
        float u0[8], u1[8], u2[8], bg[8], y[8];
        unpack8(*(const u32x4*)(U + (size_t)t * 512 + c0), u2); unpack8(*(const u32x4*)(BG + (size_t)t * 512 + c0), bg);
        if (pos >= 1) unpack8(*(const u32x4*)(U + (size_t)(t - 1) * 512 + c0), u1); else {
#pragma unroll
            for (int e = 0; e < 8; ++e) u1[e] = 0.f; }
        if (pos >= 2) unpack8(*(const u32x4*)(U + (size_t)(t - 2) * 512 + c0), u0); else {
#pragma unroll
            for (int e = 0; e < 8; ++e) u0[e] = 0.f; }
#pragma unroll
        for (int e = 0; e < 8; ++e) y[e] = bg[e] * (F.conv_w[c0 + e] * u0[e] + F.conv_w[512 + c0 + e] * u1[e] + F.conv_w[1024 + c0 + e] * u2[e] + F.conv_b[c0 + e]);
        *(u32x4*)(YAB + (size_t)t * 1024 + 512 + c0) = pack8(y);
    }
}

namespace attn_body {
using bf16x8 = __attribute__((ext_vector_type(8))) short;
using s16x4 = __attribute__((ext_vector_type(4))) short;
using f32x16 = __attribute__((ext_vector_type(16))) float;
using u32x4 = __attribute__((ext_vector_type(4))) unsigned;
constexpr int SEQ = 4096, D = 64, DMQ = 1024, DMK = 512;
constexpr int NW = 8, QBLK = 32, QB = QBLK * NW, KVBLK = 64;
constexpr float NEGB = -1e30f;
__device__ __forceinline__ int crow(int r, int hi) { return (r & 3) + 8 * (r >> 2) + 4 * hi; }
#define SBAR() __builtin_amdgcn_sched_barrier(0)
__device__ __forceinline__ void cmask(f32x16& p0, f32x16& p1, int jb, int qrel, int hi) {
  const float NEG = -INFINITY; int kb = 64 * jb + 4 * hi;
  #pragma unroll
  for (int r = 0; r < 16; ++r) { int kv = kb + (r & 3) + 8 * (r >> 2); if (kv > qrel) p0[r] = NEG; if (kv + 32 > qrel) p1[r] = NEG; }
}
constexpr int NSLOT = 3, SLOTB = 8192;
constexpr int LDS_K = 0, LDS_V = NSLOT * SLOTB, LDS_WS = 2 * NSLOT * SLOTB, LDS_OST = LDS_WS + NW * 128 * 4, LDS_BYTES_A = LDS_OST + NW * 4096;
__device__ __forceinline__ void glds16(const void* gsrc, unsigned lds_dst) { unsigned keep;
  asm volatile("s_mov_b32 %0, m0\n\ts_mov_b32 m0, %2\n\ts_nop 0\n\tglobal_load_lds_dwordx4 %1, off\n\ts_mov_b32 m0, %0" : "=&s"(keep) : "v"(gsrc), "s"(lds_dst) : "memory"); }
__device__ __forceinline__ float max3f(float a, float b, float c) { float r; asm("v_max3_f32 %0, %1, %2, %3" : "=v"(r) : "v"(a), "v"(b), "v"(c)); return r; }
__device__ __forceinline__ float max2f(float a, float b) { float r; asm("v_max_f32_e32 %0, %1, %2" : "=v"(r) : "v"(a), "v"(b)); return r; }
__device__ __forceinline__ float fadd_s(float a, float b) { float r; asm("v_add_f32_e32 %0, %1, %2" : "=v"(r) : "v"(a), "v"(b)); return r; }
__device__ __forceinline__ float fsub_s(float a, float b) { float r; asm("v_sub_f32_e32 %0, %1, %2" : "=v"(r) : "v"(a), "v"(b)); return r; }
typedef float f32x2_t __attribute__((ext_vector_type(2))); typedef __bf16 bf16x2_t __attribute__((ext_vector_type(2)));
__device__ __forceinline__ unsigned cvtpk_s(float lo, float hi) { f32x2_t v = {lo, hi}; bf16x2_t b = __builtin_convertvector(v, bf16x2_t); return __builtin_bit_cast(unsigned, b); }
#define WAIT_BAR(N) asm volatile("s_waitcnt vmcnt(" #N ") lgkmcnt(0)\n\ts_barrier" ::: "memory")
__device__ __forceinline__ void qkt(f32x16& p0, f32x16& p1, const char* Kslot, const bf16x8* qr, const f32x16& negm, int r32, int hi) {
  const char* kb = Kslot + hi * 1024 + r32 * 16;
  #pragma unroll
  for (int d0 = 0; d0 < 4; ++d0) {
    const bf16x8 b0 = *reinterpret_cast<const bf16x8*>(kb + d0 * 2048);
    const bf16x8 b1 = *reinterpret_cast<const bf16x8*>(kb + d0 * 2048 + 512);
    if (d0 == 0) { p0 = __builtin_amdgcn_mfma_f32_32x32x16_bf16(b0, qr[0], negm, 0, 0, 0); p1 = __builtin_amdgcn_mfma_f32_32x32x16_bf16(b1, qr[0], negm, 0, 0, 0); }
    else { p0 = __builtin_amdgcn_mfma_f32_32x32x16_bf16(b0, qr[d0], p0, 0, 0, 0); p1 = __builtin_amdgcn_mfma_f32_32x32x16_bf16(b1, qr[d0], p1, 0, 0, 0); } }
}
typedef __attribute__((address_space(3))) const char* lds_cptr;
typedef __attribute__((address_space(3))) char* lds_ptr;
typedef short v4i16_t __attribute__((ext_vector_type(4)));
__device__ __forceinline__ void kload8(bf16x8* kf, lds_cptr kp) {
  kf[0] = *(const __attribute__((address_space(3))) bf16x8*)(kp);        kf[1] = *(const __attribute__((address_space(3))) bf16x8*)(kp + 512);
  kf[2] = *(const __attribute__((address_space(3))) bf16x8*)(kp + 2048); kf[3] = *(const __attribute__((address_space(3))) bf16x8*)(kp + 2560);
  kf[4] = *(const __attribute__((address_space(3))) bf16x8*)(kp + 4096); kf[5] = *(const __attribute__((address_space(3))) bf16x8*)(kp + 4608);
  kf[6] = *(const __attribute__((address_space(3))) bf16x8*)(kp + 6144); kf[7] = *(const __attribute__((address_space(3))) bf16x8*)(kp + 6656);
}
__device__ __forceinline__ void kload2(bf16x8* kf, lds_cptr kp, int j) { kf[2 * j] = *(const __attribute__((address_space(3))) bf16x8*)(kp + j * 2048); kf[2 * j + 1] = *(const __attribute__((address_space(3))) bf16x8*)(kp + j * 2048 + 512); }
__device__ __forceinline__ s16x4 vtr(lds_cptr p) { return __builtin_bit_cast(s16x4, __builtin_amdgcn_ds_read_tr16_b64_v4i16((__attribute__((address_space(3))) v4i16_t*)p)); }
__device__ __forceinline__ float rowmax(const f32x16& p0, const f32x16& p1) {
  float a = max3f(p0[0], p0[1], p1[0]), b = max3f(p0[2], p0[3], p1[1]); a = max3f(a, p1[2], p1[3]);
  #pragma unroll
  for (int r = 4; r < 16; r += 4) { a = max3f(a, p0[r], p0[r + 1]); b = max3f(b, p0[r + 2], p0[r + 3]); a = max3f(a, p1[r], p1[r + 1]); b = max3f(b, p1[r + 2], p1[r + 3]); }
  const float m = max2f(a, b);
  auto rr = __builtin_amdgcn_permlane32_swap(__float_as_uint(m), __float_as_uint(m), false, false);
  return max2f(__uint_as_float(rr[0]), __uint_as_float(rr[1]));
}
__device__ __forceinline__ void pv(f32x16* o, int vb, bf16x8 pa0, bf16x8 pa1, bf16x8 pa2, bf16x8 pa3) {
  #pragma unroll
  for (int d0 = 0; d0 < 2; ++d0) { s16x4 lo[4], hi[4];
    #pragma unroll
    for (int ks = 0; ks < 4; ++ks) {
      asm volatile("ds_read_b64_tr_b16 %0,%1 offset:%c2" : "=&v"(lo[ks]) : "v"(vb), "i"(d0 * 4096 + ks * 1024) : "memory");
      asm volatile("ds_read_b64_tr_b16 %0,%1 offset:%c2" : "=&v"(hi[ks]) : "v"(vb), "i"(d0 * 4096 + ks * 1024 + 512) : "memory"); }
    asm volatile("s_waitcnt lgkmcnt(0)" ::: "memory"); SBAR();
    #define PK(k) (bf16x8){lo[k][0], lo[k][1], lo[k][2], lo[k][3], hi[k][0], hi[k][1], hi[k][2], hi[k][3]}
    o[d0] = __builtin_amdgcn_mfma_f32_32x32x16_bf16(pa0, PK(0), o[d0], 0, 0, 0);
    o[d0] = __builtin_amdgcn_mfma_f32_32x32x16_bf16(pa1, PK(1), o[d0], 0, 0, 0);
    o[d0] = __builtin_amdgcn_mfma_f32_32x32x16_bf16(pa2, PK(2), o[d0], 0, 0, 0);
    o[d0] = __builtin_amdgcn_mfma_f32_32x32x16_bf16(pa3, PK(3), o[d0], 0, 0, 0);
    #undef PK
  }
}
#define ATTN_STORE16(p, v) (*(u32x4*)(p) = (v))
template <int THRL> __device__ __forceinline__ void attn_unit(int b, int h, int qb, bf16_t* QO, const bf16_t* __restrict__ K, const bf16_t* __restrict__ V, const float* __restrict__ kmean, char* shm) {
  int tid_ = threadIdx.x; asm volatile("" : "+v"(tid_));
  const int tid = tid_, lane = tid & 63, r32 = lane & 31, hi = lane >> 5; const int wid = __builtin_amdgcn_readfirstlane(tid >> 6);
  const long rowbase = (long)b * SEQ; const int q0 = qb * QB;
  const bf16_t* Qw = QO + (rowbase + q0 + wid * QBLK) * DMQ + h * D;
  const bf16_t* Kh = K + rowbase * DMK + h * D, *Vh = V + rowbase * DMK + h * D;
  const unsigned lds0 = (unsigned)(uintptr_t)shm;
  float* wsf = (float*)(shm + LDS_WS) + wid * 128;
  bf16x8 qr[4];
  #pragma unroll
  for (int d0 = 0; d0 < 4; ++d0) qr[d0] = *reinterpret_cast<const bf16x8*>(&Qw[(long)r32 * DMQ + d0 * 16 + hi * 8]);
  unsigned selm = 0u;
  if (qb > 0) {
    float* kmL = (float*)(shm + LDS_OST);
    const float* kmg = kmean + ((size_t)(b * 8 + h) * 16) * 64;
    for (int i = tid; i < qb * 64; i += 512) kmL[i] = kmg[i];
    asm volatile("s_waitcnt vmcnt(0) lgkmcnt(0)\n\ts_barrier" ::: "memory");
    float qf[32];
    #pragma unroll
    for (int d0 = 0; d0 < 4; ++d0)
      #pragma unroll
      for (int e = 0; e < 8; ++e) qf[8 * d0 + e] = __uint_as_float(((unsigned)(unsigned short)qr[d0][e]) << 16);
    float b0 = -INFINITY, b1 = -INFINITY, b2 = -INFINITY; int i0 = -1, i1 = -1, i2 = -1;
    for (int j = 0; j < qb; ++j) {
      const float* km = kmL + j * 64 + 8 * hi; float sc = 0.f;
      #pragma unroll
      for (int d0 = 0; d0 < 4; ++d0)
        #pragma unroll
        for (int e = 0; e < 8; ++e) sc += qf[8 * d0 + e] * km[16 * d0 + e];
      sc += __shfl_xor(sc, 32);
      if (sc > b0) { b2 = b1; i2 = i1; b1 = b0; i1 = i0; b0 = sc; i0 = j; } else if (sc > b1) { b2 = b1; i2 = i1; b1 = sc; i1 = j; } else if (sc > b2) { b2 = sc; i2 = j; }
    }
    if (i0 >= 0) selm |= 1u << i0; if (i1 >= 0) selm |= 1u << i1; if (i2 >= 0) selm |= 1u << i2;
    asm volatile("s_waitcnt lgkmcnt(0)\n\ts_barrier" ::: "memory");
  }
  if (hi == 0) ((unsigned*)wsf)[64 + r32] = selm;
  { const lds_ptr qst = (lds_ptr)shm + LDS_OST + wid * 4096 + lane * 16;
    #pragma unroll
    for (int d0 = 0; d0 < 4; ++d0) *(__attribute__((address_space(3))) bf16x8*)(qst + d0 * 1024) = qr[d0]; }
  #define SELROW(j) (((j) >= qb) || ((((const unsigned*)wsf)[64 + r32] >> (j)) & 1u))
  #define NEGM_SET(blk) do { const float nv_ = SELROW(blk) ? -mhat : NEGB; _Pragma("unroll") for (int r = 0; r < 16; ++r) negm[r] = nv_; asm volatile("" : "+v"(negm)); } while (0)
  const bf16_t* ksrc = Kh + (long)lane * DMK + wid * 8;
  const bf16_t* vsrc = Vh + (long)(16 * (wid & 3) + (lane >> 2)) * DMK + (wid >> 2) * 32 + (lane & 3) * 8;
  const unsigned kdst = lds0 + LDS_K + wid * 1024, vdst = lds0 + LDS_V + wid * 1024;
  #define DMA_K(t, slot) glds16(ksrc + (long)(t) * KVBLK * DMK, (unsigned)__builtin_amdgcn_readfirstlane(kdst + (slot)))
  #define DMA_V(t, slot) glds16(vsrc + (long)(t) * KVBLK * DMK, (unsigned)__builtin_amdgcn_readfirstlane(vdst + (slot)))
  const int vb0 = (int)(lds0 + LDS_V) + ((lane >> 4) & 1) * 32 + (lane & 3) * 8 + (4 * hi + ((lane & 15) >> 2)) * 64;
  const char* Kbase = shm + LDS_K; bf16x8 kf[8];
  const lds_cptr qp0 = (lds_cptr)shm + LDS_OST + wid * 4096 + lane * 16;
  const lds_cptr shm3 = (lds_cptr)shm; const lds_cptr kp0 = shm3 + LDS_K + hi * 1024 + r32 * 16; const lds_cptr vp0 = shm3 + LDS_V + ((lane >> 4) & 1) * 32 + (lane & 3) * 8 + (4 * hi + ((lane & 15) >> 2)) * 64;
  const int NT = (q0 + QB) / KVBLK;
  DMA_K(0, 0); DMA_V(0, 0); DMA_K(1, SLOTB);
  float mhat = 0.f, l_reg = 0.f; f32x16 o[2]; o[0] = f32x16{}; o[1] = f32x16{}; f32x16 negm;
  NEGM_SET(0);
  const int qrel = wid * QBLK + r32;
  #define CMASK(P0, P1, t) do { int jb_ = (t) - (NT - 4); if (jb_ >= 0) cmask(P0, P1, jb_, qrel, hi); } while (0)
  bool resc = false;
  #define START(P0, P1) do { const float rm = rowmax(P0, P1); resc = false; \
    { const float dl = SELROW(0) ? rm : 0.f; mhat = fadd_s(mhat, dl); \
      _Pragma("unroll") for (int r = 0; r < 16; ++r) { P0[r] = fsub_s(P0[r], dl); P1[r] = fsub_s(P1[r], dl); } \
      NEGM_SET(0); } \
    _Pragma("unroll") for (int r = 0; r < 16; ++r) P0[r] = __builtin_amdgcn_exp2f(P0[r]); } while (0)
  #define RESC() do { if (resc) { asm volatile("s_waitcnt lgkmcnt(0)" ::: "memory"); \
      _Pragma("unroll") for (int d_ = 0; d_ < 2; ++d_) _Pragma("unroll") for (int r = 0; r < 16; ++r) o[d_][r] *= wsf[crow(r, hi)]; } } while (0)
  f32x16 pA0, pA1, pB0, pB1;
  int sl_prev = 0, sl_cur = 0, sl_next = SLOTB;
  #define ROT() do { sl_prev = sl_cur; sl_cur = sl_next; sl_next = (sl_next == (NSLOT - 1) * SLOTB) ? 0 : sl_next + SLOTB; } while (0)
  DMA_K(2, 2 * SLOTB);
  WAIT_BAR(3);
  qkt(pA0, pA1, Kbase, qr, negm, r32, hi); asm volatile("s_nop 15\n\ts_nop 7" : "+v"(pA0), "+v"(pA1)); CMASK(pA0, pA1, 0);
  START(pA0, pA1);
  _Pragma("unroll") for (int r = 0; r < 16; ++r) pA1[r] = __builtin_amdgcn_exp2f(pA1[r]);
  WAIT_BAR(0);
  DMA_K(3, 0); DMA_V(1, SLOTB);
  ROT();
  kload8(kf, kp0 + sl_cur);
  WAIT_BAR(2);
  s16x4 vlo[8], vhi[8]; u32x4 pw0, pw1, pw2, pw3; bf16x8 q0_, q1_, q2_, q3_;
  #define QRD(d) do { q##d##_ = *(const __attribute__((address_space(3))) bf16x8*)(qp0 + (d) * 1024); } while (0)
  QRD(0); QRD(1);
  #define PKW(P, B) cvtpk_s(P[B], P[B + 1])
  #define PAF(k) __builtin_bit_cast(bf16x8, pw##k)
  #define VFR(i) (bf16x8){vlo[i][0], vlo[i][1], vlo[i][2], vlo[i][3], vhi[i][0], vhi[i][1], vhi[i][2], vhi[i][3]}
  #define PIN(x) asm volatile("" : "+v"(x))
  #define MX3(a, b, c) __builtin_fmaxf(__builtin_fmaxf((a), (b)), (c))
  #define GAPA(MF, A0, A1, A2, A3, W0, W1, PW) do { MF; sacc += A0; sacc += A1; sacc += A2; sacc += A3; PIN(sacc); W0; W1; PIN(PW); SBAR(); } while (0)
  #define EX(v) __builtin_amdgcn_exp2f(v)
  #define GAPB(MF, X, B) do { MF; X[B] = EX(X[B]); X[B + 1] = EX(X[B + 1]); X[B + 2] = EX(X[B + 2]); X[B + 3] = EX(X[B + 3]); PIN(X); SBAR(); } while (0)
  #define VRD(i) do { vlo[i] = vtr(vp_ + (((i) >> 2) * 4096 + ((i) & 3) * 1024)); vhi[i] = vtr(vp_ + (((i) >> 2) * 4096 + ((i) & 3) * 1024 + 512)); } while (0)
  #define KRD(G, j) do { if (G) { kload2(kf, kp0 + sl_next, j); SBAR(); } } while (0)
  #define STEP(C0, C1, P0, P1, t, GK, GV, GL) do { SBAR(); \
    const lds_cptr vp_ = vp0 + sl_prev; \
    VRD(0); SBAR(); float sacc = (P0[0] + P0[1]); \
    GAPA(C0 = __builtin_amdgcn_mfma_f32_32x32x16_bf16(kf[0], q0_, negm, 0, 0, 0), P0[2], P0[3], P0[4], P0[5],     pw0[0] = PKW(P0, 0), pw0[1] = PKW(P0, 2), pw0); \
    VRD(4); SBAR(); GAPA(C1 = __builtin_amdgcn_mfma_f32_32x32x16_bf16(kf[1], q0_, negm, 0, 0, 0), P0[6], P0[7], P0[8], P0[9],     pw0[2] = PKW(P0, 4), pw0[3] = PKW(P0, 6), pw0); \
    QRD(2); SBAR(); \
    VRD(1); SBAR(); GAPA(C0 = __builtin_amdgcn_mfma_f32_32x32x16_bf16(kf[2], q1_, C0, 0, 0, 0),   P0[10], P0[11], P0[12], P0[13], pw1[0] = PKW(P0, 8), pw1[1] = PKW(P0, 10), pw1); \
    VRD(5); SBAR(); GAPA(C1 = __builtin_amdgcn_mfma_f32_32x32x16_bf16(kf[3], q1_, C1, 0, 0, 0),   P0[14], P0[15], P1[0], P1[1],   pw1[2] = PKW(P0, 12), pw1[3] = PKW(P0, 14), pw1); \
    QRD(3); SBAR(); \
    VRD(2); SBAR(); GAPA(C0 = __builtin_amdgcn_mfma_f32_32x32x16_bf16(kf[4], q2_, C0, 0, 0, 0),   P1[2], P1[3], P1[4], P1[5],     pw2[0] = PKW(P1, 0), pw2[1] = PKW(P1, 2), pw2); \
    VRD(6); SBAR(); GAPA(C1 = __builtin_amdgcn_mfma_f32_32x32x16_bf16(kf[5], q2_, C1, 0, 0, 0),   P1[6], P1[7], P1[8], P1[9],     pw2[2] = PKW(P1, 4), pw2[3] = PKW(P1, 6), pw2); \
    VRD(3); SBAR(); GAPA(C0 = __builtin_amdgcn_mfma_f32_32x32x16_bf16(kf[6], q3_, C0, 0, 0, 0),   P1[10], P1[11], P1[12], P1[13], pw3[0] = PKW(P1, 8), pw3[1] = PKW(P1, 10), pw3); \
    VRD(7); SBAR(); GAPA(C1 = __builtin_amdgcn_mfma_f32_32x32x16_bf16(kf[7], q3_, C1, 0, 0, 0),   P1[14], P1[15], 0.f, 0.f,       pw3[2] = PKW(P1, 12), pw3[3] = PKW(P1, 14), pw3); \
    l_reg += sacc; \
    if (GK) { DMA_K((t) + 3, sl_cur); } if (GV) { DMA_V((t) + 1, sl_next); } \
    CMASK(C0, C1, t); \
    { float a = MX3(C0[0], C0[1], C1[0]), b = MX3(C0[2], C0[3], C1[1]); a = MX3(a, C1[2], C1[3]); \
      _Pragma("unroll") for (int r = 4; r < 16; r += 4) { a = MX3(a, C0[r], C0[r + 1]); b = MX3(b, C0[r + 2], C0[r + 3]); a = MX3(a, C1[r], C1[r + 1]); b = MX3(b, C1[r + 2], C1[r + 3]); } \
      float rm = __builtin_fmaxf(a, b); { auto rr = __builtin_amdgcn_permlane32_swap(__float_as_uint(rm), __float_as_uint(rm), false, false); rm = __builtin_fmaxf(__uint_as_float(rr[0]), __uint_as_float(rr[1])); } \
      resc = false; \
      if (__builtin_expect(__any(rm > (float)THRL), 0)) { const float dl = __builtin_fmaxf(rm, 0.f); mhat += dl; \
        _Pragma("unroll") for (int r = 0; r < 16; ++r) { C0[r] -= dl; C1[r] -= dl; } \
        NEGM_SET(((t) + 1) >> 2); \
        const float f = __builtin_amdgcn_exp2f(-dl); l_reg *= f; if (hi == 0) wsf[r32] = f; resc = true; } \
      else if ((((t) + 1) & 3) == 0) { NEGM_SET(((t) + 1) >> 2); } } \
    SBAR(); \
    GAPB(o[0] = __builtin_amdgcn_mfma_f32_32x32x16_bf16(PAF(0), VFR(0), o[0], 0, 0, 0), C0, 0); \
    GAPB(o[1] = __builtin_amdgcn_mfma_f32_32x32x16_bf16(PAF(0), VFR(4), o[1], 0, 0, 0), C0, 4); \
    KRD(GL, 0); GAPB(o[0] = __builtin_amdgcn_mfma_f32_32x32x16_bf16(PAF(1), VFR(1), o[0], 0, 0, 0), C0, 8); \
    KRD(GL, 1); GAPB(o[1] = __builtin_amdgcn_mfma_f32_32x32x16_bf16(PAF(1), VFR(5), o[1], 0, 0, 0), C0, 12); \
    KRD(GL, 2); GAPB(o[0] = __builtin_amdgcn_mfma_f32_32x32x16_bf16(PAF(2), VFR(2), o[0], 0, 0, 0), C1, 0); \
    KRD(GL, 3); GAPB(o[1] = __builtin_amdgcn_mfma_f32_32x32x16_bf16(PAF(2), VFR(6), o[1], 0, 0, 0), C1, 4); \
    GAPB(o[0] = __builtin_amdgcn_mfma_f32_32x32x16_bf16(PAF(3), VFR(3), o[0], 0, 0, 0), C1, 8); \
    GAPB(o[1] = __builtin_amdgcn_mfma_f32_32x32x16_bf16(PAF(3), VFR(7), o[1], 0, 0, 0), C1, 12); \
    QRD(0); QRD(1); SBAR(); \
    } while (0)
  int t = 1;
  #undef CMASK
  #define CMASK(P0, P1, t) do {} while (0)
  for (; t + 5 < NT; t += 2) {
    STEP(pB0, pB1, pA0, pA1, t, true, true, true);     WAIT_BAR(2); RESC(); ROT();
    STEP(pA0, pA1, pB0, pB1, t + 1, true, true, true); WAIT_BAR(2); RESC(); ROT();
  }
  #undef CMASK
  #define CMASK(P0, P1, t) do { int jb_ = (t) - (NT - 4); if (jb_ >= 0) cmask(P0, P1, jb_, qrel, hi); } while (0)
  #define ENDW(tt) do { if ((tt) + 3 < NT) { WAIT_BAR(2); } else if ((tt) + 2 < NT) { WAIT_BAR(1); } else { WAIT_BAR(0); } } while (0)
  for (; t + 1 < NT; t += 2) {
    STEP(pB0, pB1, pA0, pA1, t, (t + 3 < NT), (t + 1 < NT), (t + 1 < NT));       ENDW(t);     RESC(); ROT();
    STEP(pA0, pA1, pB0, pB1, t + 1, (t + 4 < NT), (t + 2 < NT), (t + 2 < NT));   ENDW(t + 1); RESC(); ROT();
  }
  STEP(pB0, pB1, pA0, pA1, NT - 1, false, false, false); RESC();
  { float sacc = pB0[0] + pB0[1]; _Pragma("unroll") for (int r = 2; r < 16; ++r) sacc += pB0[r]; _Pragma("unroll") for (int r = 0; r < 16; ++r) sacc += pB1[r]; l_reg += sacc;
    pw0 = (u32x4){PKW(pB0, 0), PKW(pB0, 2), PKW(pB0, 4), PKW(pB0, 6)}; pw1 = (u32x4){PKW(pB0, 8), PKW(pB0, 10), PKW(pB0, 12), PKW(pB0, 14)}; pw2 = (u32x4){PKW(pB1, 0), PKW(pB1, 2), PKW(pB1, 4), PKW(pB1, 6)}; pw3 = (u32x4){PKW(pB1, 8), PKW(pB1, 10), PKW(pB1, 12), PKW(pB1, 14)};
    SBAR(); pv(o, vb0 + sl_cur, PAF(0), PAF(1), PAF(2), PAF(3)); }
  #undef PKW
  #undef PAF
  #undef VFR
  #undef PIN
  #undef MX3
  #undef GAPA
  #undef GAPB
  #undef EX
  #undef VRD
  #undef KRD
  #undef QRD
  #undef STEP
  #undef ENDW
  { auto rr = __builtin_amdgcn_permlane32_swap(__float_as_uint(l_reg), __float_as_uint(l_reg), false, false); l_reg = __uint_as_float(rr[0]) + __uint_as_float(rr[1]); }
  if (hi == 0) wsf[32 + r32] = l_reg; asm volatile("s_waitcnt lgkmcnt(0)" ::: "memory");
  float rli[16];
  #pragma unroll
  for (int r = 0; r < 16; ++r) rli[r] = __builtin_amdgcn_rcpf(wsf[32 + crow(r, hi)]);
  bf16_t* Ow = QO + (rowbase + q0 + wid * QBLK) * DMQ + h * D;
  { bf16_t* stg = (bf16_t*)(shm + LDS_OST) + wid * 2048;
    #pragma unroll
    for (int r = 0; r < 16; ++r) { const int orow = crow(r, hi);
      #pragma unroll
      for (int d0 = 0; d0 < 2; ++d0) stg[orow * 64 + d0 * 32 + r32] = (bf16_t)f2bf(o[d0][r] * rli[r]); }
    asm volatile("s_waitcnt lgkmcnt(0)" ::: "memory");
    #pragma unroll
    for (int i = 0; i < 4; ++i) { const int row = i * 8 + (lane >> 3), ch = lane & 7; const u32x4 v = *(const u32x4*)(stg + row * 64 + ch * 8); ATTN_STORE16(Ow + (long)row * DMQ + ch * 8, v); } }
  asm volatile("s_waitcnt lgkmcnt(0)\n\ts_barrier" ::: "memory");
  #undef DMA_K
  #undef DMA_V
  #undef CMASK
  #undef START
  #undef RESC
  #undef ROT
  #undef SELROW
  #undef NEGM_SET
}
#undef SBAR
#undef WAIT_BAR
}
__device__ __forceinline__ void conv_pass(Frame& F) {
    bf16_t* YAB = WSP(bf16_t, WS_YAB); const bf16_t* U = WSP(bf16_t, WS_U); const bf16_t* BG = WSP(bf16_t, WS_BG);
    for (int i = blockIdx.x * NTHREADS + F.tid; i < T * 64; i += F.G * NTHREADS) {
        const int t = i >> 6, c0 = (i & 63) * 8, pos = t & (S - 1);
        float u0[8], u1[8], u2[8], bg[8], y[8];
        unpack8(*(const u32x4*)(U + (size_t)t * 512 + c0), u2); unpack8(*(const u32x4*)(BG + (size_t)t * 512 + c0), bg);
        if (pos >= 1) unpack8(*(const u32x4*)(U + (size_t)(t - 1) * 512 + c0), u1); else {
#pragma unroll
            for (int e = 0; e < 8; ++e) u1[e] = 0.f; }
        if (pos >= 2) unpack8(*(const u32x4*)(U + (size_t)(t - 2) * 512 + c0), u0); else {
#pragma unroll
            for (int e = 0; e < 8; ++e) u0[e] = 0.f; }
#pragma unroll
        for (int e = 0; e < 8; ++e) y[e] = bg[e] * (F.conv_w[c0 + e] * u0[e] + F.conv_w[512 + c0 + e] * u1[e] + F.conv_w[1024 + c0 + e] * u2[e] + F.conv_b[c0 + e]);
        *(u32x4*)(YAB + (size_t)t * 1024 + 512 + c0) = pack8(y);
    }
}
__device__ __forceinline__ void s3_fast(Frame& F, char* lds_gen) {
    const int vcu = (blockIdx.x % 8) * (F.G / 8) + blockIdx.x / 8;
    const int s = vcu & 7, pr = vcu >> 3;
    for (int i = 0; i < 4; ++i) {
        const int bh = 2 * pr + (i >> 1), qb = (i & 1) ? 15 - s : s;
        attn_body::attn_unit<8>(bh >> 3, bh & 7, qb, WSP(bf16_t, WS_YAB), WSP(bf16_t, WS_K), WSP(bf16_t, WS_V), WSP(float, WS_KMEAN), lds_gen);
    }
    conv_pass(F);
}

__device__ __forceinline__ void s4_simple(Frame& F) {
    LAS float* tile = (LAS float*)F.lds; LAS float* tile2 = tile + 64 * 65;
    const bf16_t* YAB = WSP(bf16_t, WS_YAB); const bf16_t* WP = WSP(bf16_t, WS_WP_T); const bf16_t* GT = WSP(bf16_t, WS_GATES);
    const int row = F.tid >> 3, seg = F.tid & 7;
    for (int it = blockIdx.x; it < 512 * 16; it += F.G) {
        const int rt = it >> 4, ct = it & 15, r0 = rt * 64, gr = r0 + row;
        const RowsLinear aa{YAB + (size_t)r0 * 1024, 1024}, ab{YAB + (size_t)r0 * 1024 + 512, 1024};
        const RowsLinear ba{WP + (size_t)(64 * ct) * 1024, 1024}, bb{WP + (size_t)(64 * ct) * 1024 + 512, 1024};
        sgemm_tile(tile, 512, aa, ba, F.wave, F.lane); sgemm_tile(tile2, 512, ab, bb, F.wave, F.lane); __syncthreads();
        float ga[8], gb[8], v[8];
        unpack8(*(const u32x4*)(GT + (size_t)gr * 2048 + 64 * ct + 8 * seg), ga); unpack8(*(const u32x4*)(GT + (size_t)gr * 2048 + 1024 + 64 * ct + 8 * seg), gb);
#pragma unroll
        for (int e = 0; e < 8; ++e) v[e] = ga[e] * tile[row * 65 + 8 * seg + e] + gb[e] * tile2[row * 65 + 8 * seg + e];
        *(u32x4*)(WSP(bf16_t, WS_H) + (size_t)gr * 1024 + 64 * ct + 8 * seg) = pack8(v);
        __syncthreads();
    }
}
__device__ __forceinline__ void s5_simple(Frame& F) {
    LAS float* tile = (LAS float*)F.lds;
    const bf16_t* MG = WSP(bf16_t, WS_H); const bf16_t* WO = WSP(bf16_t, WS_WO_T);
    const int row = F.tid >> 3, seg = F.tid & 7;
    for (int it = blockIdx.x; it < 512 * 16; it += F.G) {
        const int rt = it >> 4, ct = it & 15, r0 = rt * 64, gr = r0 + row, b = r0 / S;
        const RowsLinear aa{MG + (size_t)r0 * 1024, 1024}, bb{WO + (size_t)(64 * ct) * 1024, 1024};
        sgemm_tile(tile, 1024, aa, bb, F.wave, F.lane); __syncthreads();
        const float* ga1 = WSP(float, WS_MOD) + (size_t)b * NMOD + 2048 + 64 * ct + 8 * seg;
        const float* xr = F.x + (size_t)gr * D + 64 * ct + 8 * seg; float* orow = F.out + (size_t)gr * D + 64 * ct + 8 * seg;
#pragma unroll
        for (int e4 = 0; e4 < 2; ++e4) { const f32x4 xv = *(const f32x4*)(xr + 4 * e4), gv = *(const f32x4*)(ga1 + 4 * e4); f32x4 o;
#pragma unroll
            for (int e = 0; e < 4; ++e) o[e] = xv[e] + gv[e] * tile[row * 65 + 8 * seg + 4 * e4 + e];
            *(f32x4*)(orow + 4 * e4) = o; }
        __syncthreads();
    }
}

__device__ __forceinline__ u32x4 pack8v(const f32x4 a, const f32x4 b) { u32x4 w; w.x = pk2(a.x, a.y); w.y = pk2(a.z, a.w); w.z = pk2(b.x, b.y); w.w = pk2(b.z, b.w); return w; }
__device__ __forceinline__ void unpack8v(const u32x4 w, f32x4& a, f32x4& b) {
    a.x = bf2f(w.x & 0xffffu); a.y = bf2f(w.x >> 16); a.z = bf2f(w.y & 0xffffu); a.w = bf2f(w.y >> 16);
    b.x = bf2f(w.z & 0xffffu); b.y = bf2f(w.z >> 16); b.z = bf2f(w.w & 0xffffu); b.w = bf2f(w.w >> 16); }
struct EpiG2 {
    static constexpr bool HAS_MID = true;
    const bf16_t* gates; bf16_t* merged;
    __device__ __forceinline__ void mid(Acc& acc, const pg8::Unit& u, int wr, int wc, int fr, int fq) const {
        int row0 = u.pm * 256 + wr * 64 + fr; const int c0 = u.pn * 256 + 32 * wc + 8 * fq; asm volatile("" : "+v"(row0));
#pragma unroll
        for (int ai = 0; ai < 2; ++ai)
#pragma unroll
            for (int m = 0; m < 4; ++m) { const bf16_t* gp = gates + (size_t)(row0 + 128 * ai + 16 * m) * 2048 + c0;
#pragma unroll
                for (int bj = 0; bj < 2; ++bj) { f32x4 a0, a1, b0, b1; unpack8v(*(const u32x4*)(gp + 128 * bj), a0, a1); unpack8v(*(const u32x4*)(gp + 1024 + 128 * bj), b0, b1);
#pragma unroll
                    for (int e = 0; e < 4; ++e) { acc[ai][bj][m][0][e] *= a0[e] * __builtin_amdgcn_rcpf(b0[e]); acc[ai][bj][m][1][e] *= a1[e] * __builtin_amdgcn_rcpf(b1[e]); }
 }
                asm volatile("" ::: "memory"); }
    }
    __device__ __forceinline__ void operator()(Acc& acc, const pg8::Unit& u, int wr, int wc, int fr, int fq) const {
        int row0 = u.pm * 256 + wr * 64 + fr; const int c0 = u.pn * 256 + 32 * wc + 8 * fq; asm volatile("" : "+v"(row0));
#pragma unroll
        for (int ai = 0; ai < 2; ++ai)
#pragma unroll
            for (int m = 0; m < 4; ++m) { const size_t r = (size_t)(row0 + 128 * ai + 16 * m);
#pragma unroll
                for (int bj = 0; bj < 2; ++bj) { f32x4 b0, b1; unpack8v(*(const u32x4*)(gates + r * 2048 + 1024 + c0 + 128 * bj), b0, b1);
                    *(u32x4*)(merged + r * 1024 + c0 + 128 * bj) = pack8v(acc[ai][bj][m][0] * b0, acc[ai][bj][m][1] * b1); }
                asm volatile("" ::: "memory"); }
    }
};
__device__ __forceinline__ void s4_fast(Frame& F) {
    const pg8::DenseSched Sd{(const char*)(F.ws + WS_YAB), (const char*)(F.ws + WS_WP_T), T / 256, 4, 1024, F.G, (int)blockIdx.x};
    const EpiG2 E{WSP(bf16_t, WS_GATES), WSP(bf16_t, WS_H)};
    pg8::gemm_phase<EpiG2, pg8::DenseSched>(F.lds, 1024, Sd, E);
}
struct EpiG3 {
    static constexpr bool HAS_MID = false;
    const float* x; float* out; const float* mod;
    __device__ __forceinline__ void mid(Acc&, const pg8::Unit&, int, int, int, int) const {}
    __device__ __forceinline__ void operator()(Acc& acc, const pg8::Unit& u, int wr, int wc, int fr, int fq) const {
        const int row0 = u.pm * 256 + wr * 64 + fr, c0 = u.pn * 256 + 32 * wc + 8 * fq, b = u.pm >> 4;
        f32x4 gv[2][2];
#pragma unroll
        for (int bj = 0; bj < 2; ++bj)
#pragma unroll
            for (int n = 0; n < 2; ++n) gv[bj][n] = *(const f32x4*)(mod + (size_t)b * NMOD + 2048 + c0 + 128 * bj + 4 * n);
#pragma unroll
        for (int ai = 0; ai < 2; ++ai)
#pragma unroll
            for (int m = 0; m < 4; ++m) { const size_t off = (size_t)(row0 + 128 * ai + 16 * m) * D + c0;
#pragma unroll
                for (int bj = 0; bj < 2; ++bj)
#pragma unroll
                    for (int n = 0; n < 2; ++n) { const f32x4 xv = *(const f32x4*)(x + off + 128 * bj + 4 * n); *(f32x4*)(out + off + 128 * bj + 4 * n) = xv + gv[bj][n] * acc[ai][bj][m][n]; }
                if (m & 1) asm volatile("" ::: "memory"); }
    }
};
__device__ __forceinline__ void s5_fast(Frame& F) {
    const pg8::DenseSched Sd{(const char*)(F.ws + WS_H), (const char*)(F.ws + WS_WO_T), T / 256, 4, 1024, F.G, (int)blockIdx.x};
    const EpiG3 E{F.x, F.out, WSP(float, WS_MOD)};
    pg8::gemm_phase<EpiG3, pg8::DenseSched>(F.lds, 1024, Sd, E);
}
struct MoeUpSched {
    static constexpr bool GATHER = true;
    const char* h2; const char* w13; const int* te; const int* atok; int nM, G, c;
    __device__ __forceinline__ bool next(int i, pg8::Unit& u) const { if (!pg8::static_unit(i, G, c, nM, 4, u.pm, u.pn)) return false;
        const int e = te[1 + u.pm]; u.a = h2; u.b = w13 + ((size_t)e * 1024 + 256 * u.pn) * 1024 * 2; return true; }
    __device__ __forceinline__ int row_index(const pg8::Unit& u, int r) const { return atok[256 * u.pm + r]; }
};
struct EpiUp {
    static constexpr bool HAS_MID = false;
    bf16_t* hid; const float* aw;
    __device__ __forceinline__ void mid(Acc&, const pg8::Unit&, int, int, int, int) const {}
    __device__ __forceinline__ void operator()(Acc& acc, const pg8::Unit& u, int wr, int wc, int fr, int fq) const {
        const int row0 = u.pm * 256 + wr * 64 + fr, c0 = u.pn * 128 + 32 * wc + 8 * fq;
#pragma unroll
        for (int ai = 0; ai < 2; ++ai)
#pragma unroll
            for (int m = 0; m < 4; ++m) { const int pos = row0 + 128 * ai + 16 * m; const float wt = aw[pos]; f32x4 o[2];
#pragma unroll
                for (int n = 0; n < 2; ++n)
#pragma unroll
                    for (int e = 0; e < 4; ++e) { const float a = acc[ai][0][m][n][e], c = acc[ai][1][m][n][e]; o[n][e] = a * __builtin_amdgcn_rcpf(1.f + __expf(-a)) * c * wt; }
                *(u32x4*)(hid + (size_t)pos * 512 + c0) = pack8v(o[0], o[1]); }
    }
};
__device__ __forceinline__ void s8_fast(Frame& F) {
    const int* te = WSP(int, WS_TILEE);
    const MoeUpSched Sd{(const char*)(F.ws + WS_H2), (const char*)(F.ws + WS_W13_T), te, WSP(int, WS_ATOK), te[0], F.G, (int)blockIdx.x};
    const EpiUp E{WSP(bf16_t, WS_HID), WSP(float, WS_AW)};
    pg8::gemm_phase<EpiUp, MoeUpSched>(F.lds, 1024, Sd, E);
}
struct MoeDownSched {
    static constexpr bool GATHER = false;
    const char* hid; const char* w2; const int* te; int nM, G, c;
    __device__ __forceinline__ bool next(int i, pg8::Unit& u) const { if (!pg8::static_unit(i, G, c, nM, 4, u.pm, u.pn)) return false;
        const int e = te[1 + u.pm]; u.a = hid + (size_t)u.pm * 256 * 512 * 2; u.b = w2 + ((size_t)e * 1024 + 256 * u.pn) * 512 * 2; return true; }
    __device__ __forceinline__ int row_index(const pg8::Unit&, int) const { return 0; }
};
struct EpiDown {
    static constexpr bool HAS_MID = false;
    bf16_t* yslot; const int* ainfo;
    __device__ __forceinline__ void mid(Acc&, const pg8::Unit&, int, int, int, int) const {}
    __device__ __forceinline__ void operator()(Acc& acc, const pg8::Unit& u, int wr, int wc, int fr, int fq) const {
        const int row0 = u.pm * 256 + wr * 64 + fr, c0 = u.pn * 256 + 32 * wc + 8 * fq;
#pragma unroll
        for (int ai = 0; ai < 2; ++ai)
#pragma unroll
            for (int m = 0; m < 4; ++m) { const int info = ainfo[row0 + 128 * ai + 16 * m];
                if (info >= 0) {
#pragma unroll
                    for (int bj = 0; bj < 2; ++bj) *(u32x4*)(yslot + (size_t)info * 1024 + c0 + 128 * bj) = pack8v(acc[ai][bj][m][0], acc[ai][bj][m][1]); } }
    }
};
__device__ __forceinline__ void s9_fast(Frame& F) {
    const int* te = WSP(int, WS_TILEE);
    const MoeDownSched Sd{(const char*)(F.ws + WS_HID), (const char*)(F.ws + WS_W2_T), te, te[0], F.G, (int)blockIdx.x};
    const EpiDown E{WSP(bf16_t, WS_YSLOT), WSP(int, WS_AINFO)};
    pg8::gemm_phase<EpiDown, MoeDownSched>(F.lds, 512, Sd, E);
}

__device__ __forceinline__ void s6_router(Frame& F) {
    LAS float* W = (LAS float*)F.lds;
    LAS int* cnt = (LAS int*)(F.lds + MISC_OFF + 256);
    for (int i = F.tid; i < 36 * 1024; i += NTHREADS) { const int jj = i >> 10, k = i & 1023; W[i] = (jj < 4) ? F.w_rg[k * 4 + jj] : F.w_re[k * 32 + (jj - 4)]; }
    if (F.tid < 32) cnt[F.tid] = 0;
    __syncthreads();
    const int gw = blockIdx.x * NWAVES + F.wave, row0 = gw * 16, b = row0 / S;
    const float* mod = WSP(float, WS_MOD) + (size_t)b * NMOD;
    f32x4 gs[4], sh[4];
#pragma unroll
    for (int j = 0; j < 4; ++j) { const int col = 4 * F.lane + 256 * j; const f32x4 g = *(const f32x4*)(F.g2 + col), s = *(const f32x4*)(mod + 4096 + col); gs[j] = g * (s + 1.0f); sh[j] = *(const f32x4*)(mod + 3072 + col); }
    for (int r = 0; r < 16; ++r) {
        const int t = row0 + r;
        const float* xr = F.out + (size_t)t * D;
        f32x4 v[4]; float ss = 0.f;
#pragma unroll
        for (int j = 0; j < 4; ++j) { v[j] = *(const f32x4*)(xr + 4 * F.lane + 256 * j); ss += (v[j].x * v[j].x + v[j].y * v[j].y) + (v[j].z * v[j].z + v[j].w * v[j].w); }
        const float rinv = rsqrtf(wave_sum(ss) * (1.f / D) + EPS);
        bf16_t* o = WSP(bf16_t, WS_H2) + (size_t)t * D;
#pragma unroll
        for (int j = 0; j < 4; ++j) { v[j] = v[j] * rinv * gs[j] + sh[j]; u32x2 w; w.x = pk2(v[j].x, v[j].y); w.y = pk2(v[j].z, v[j].w); *(u32x2*)(o + 4 * F.lane + 256 * j) = w; }
        float lg[36];
#pragma unroll
        for (int jj = 0; jj < 36; ++jj) { float a = 0.f;
#pragma unroll
            for (int j = 0; j < 4; ++j) { const f32x4 w = *(const LAS f32x4*)(W + jj * 1024 + 4 * F.lane + 256 * j); a += (v[j].x * w.x + v[j].y * w.y) + (v[j].z * w.z + v[j].w * w.w); }
            lg[jj] = wave_sum(a); }
        if (F.lane == 0) {
            float gl[4];
#pragma unroll
            for (int i = 0; i < 4; ++i) gl[i] = lg[i] + F.b_rg[i];
            int gi = 0; float gm = gl[0];
#pragma unroll
            for (int i = 1; i < 4; ++i) if (gl[i] > gm) { gm = gl[i]; gi = i; }
            float den = 0.f;
#pragma unroll
            for (int i = 0; i < 4; ++i) den += expf(gl[i] - gm);
            const float gw_ = 1.f / den;
            float v1 = -INFINITY, v2 = -INFINITY; int e1 = 0, e2 = 0;
#pragma unroll
            for (int g = 0; g < 4; ++g) if (g == gi) {
#pragma unroll
                for (int i = 0; i < 8; ++i) { const float el = lg[4 + g * 8 + i] + F.b_re[g * 8 + i];
                    if (el > v1) { v2 = v1; e2 = e1; v1 = el; e1 = i; } else if (el > v2) { v2 = el; e2 = i; } } }
            const float p1 = 1.f / (1.f + expf(v2 - v1)), p2 = 1.f - p1;
            const int id1 = gi * 8 + e1, id2 = gi * 8 + e2;
            WSP(int, WS_EID)[2 * t] = id1; WSP(int, WS_EID)[2 * t + 1] = id2;
            WSP(float, WS_EW)[2 * t] = p1 * gw_; WSP(float, WS_EW)[2 * t + 1] = p2 * gw_;
            lds_add(&cnt[id1], 1); lds_add(&cnt[id2], 1);
        }
    }
    __syncthreads();
    if (F.tid < 32) WSP(int, WS_BCNT)[blockIdx.x * 32 + F.tid] = cnt[F.tid];
}

__device__ __forceinline__ void s7_lists(Frame& F) {
    LAS int* sm = (LAS int*)F.lds;
    const int* bc = WSP(int, WS_BCNT);
    if (F.tid < 32) { int tot = 0, base = 0; for (int bb = 0; bb < 256; ++bb) { const int c = bc[bb * 32 + F.tid]; if (bb < (int)blockIdx.x) base += c; tot += c; }
        sm[F.tid] = tot; sm[32 + F.tid] = base; sm[96 + F.tid] = 0; }
    __syncthreads();
    if (F.tid == 0) { int ps = 0; for (int e = 0; e < 32; ++e) { sm[64 + e] = ps; ps += (sm[e] + 255) & ~255; }
        if (blockIdx.x == 0) { int* te = WSP(int, WS_TILEE); int pm = 0; for (int e = 0; e < 32; ++e) { const int n = (sm[e] + 255) >> 8; for (int i = 0; i < n; ++i) te[1 + pm++] = e; } te[0] = pm; } }
    __syncthreads();
    int* atok = WSP(int, WS_ATOK); int* ainfo = WSP(int, WS_AINFO); float* aw = WSP(float, WS_AW);
    if (F.tid < 256) { const int a = blockIdx.x * 256 + F.tid;
        const int e = WSP(int, WS_EID)[a]; const int rank = lds_add(&sm[96 + e], 1); const int pos = sm[64 + e] + sm[32 + e] + rank;
        atok[pos] = a >> 1; ainfo[pos] = a; aw[pos] = WSP(float, WS_EW)[a]; }
    if (blockIdx.x < 32) { const int e = blockIdx.x; const int lo = sm[64 + e] + sm[e], hi = sm[64 + e] + ((sm[e] + 255) & ~255);
        for (int p = lo + F.tid; p < hi; p += NTHREADS) { atok[p] = 0; ainfo[p] = -1; aw[p] = 0.f; } }
}

struct RowsGather { const bf16_t* base; const int* idx; __device__ __forceinline__ const bf16_t* operator()(int r) const { return base + (size_t)idx[r] * 1024; } };
__device__ __forceinline__ void s8_simple(Frame& F) {
    LAS float* tile = (LAS float*)F.lds; LAS float* tile2 = tile + 64 * 65;
    const int* te = WSP(int, WS_TILEE); const int nmt = te[0];
    const int row = F.tid >> 3, seg = F.tid & 7;
    for (int it = blockIdx.x; it < nmt * 4 * 8; it += F.G) {
        const int rt = it >> 3, ct = it & 7, e = te[1 + (rt >> 2)], pos0 = 64 * rt, hc = 64 * ct;
        const RowsGather ar{WSP(bf16_t, WS_H2), WSP(int, WS_ATOK) + pos0};
        const bf16_t* wb = WSP(bf16_t, WS_W13_T) + ((size_t)e * 1024 + 256 * (hc >> 7) + (hc & 127)) * 1024;
        const RowsLinear b1{wb, 1024}, b3{wb + (size_t)128 * 1024, 1024};
        sgemm_tile(tile, 1024, ar, b1, F.wave, F.lane); sgemm_tile(tile2, 1024, ar, b3, F.wave, F.lane); __syncthreads();
        const float wt = WSP(float, WS_AW)[pos0 + row]; float v[8];
#pragma unroll
        for (int e8 = 0; e8 < 8; ++e8) { const float a = tile[row * 65 + 8 * seg + e8], c = tile2[row * 65 + 8 * seg + e8]; v[e8] = (a / (1.f + __expf(-a))) * c * wt; }
        *(u32x4*)(WSP(bf16_t, WS_HID) + (size_t)(pos0 + row) * 512 + hc + 8 * seg) = pack8(v);
        __syncthreads();
    }
}
__device__ __forceinline__ void s9_simple(Frame& F) {
    LAS float* tile = (LAS float*)F.lds;
    const int* te = WSP(int, WS_TILEE); const int nmt = te[0];
    const int row = F.tid >> 3, seg = F.tid & 7;
    for (int it = blockIdx.x; it < nmt * 4 * 16; it += F.G) {
        const int rt = it >> 4, ct = it & 15, e = te[1 + (rt >> 2)], pos0 = 64 * rt;
        const RowsLinear ar{WSP(bf16_t, WS_HID) + (size_t)pos0 * 512, 512};
        const RowsLinear br{WSP(bf16_t, WS_W2_T) + ((size_t)e * 1024 + 64 * ct) * 512, 512};
        sgemm_tile(tile, 512, ar, br, F.wave, F.lane); __syncthreads();
        const int info = WSP(int, WS_AINFO)[pos0 + row];
        if (info >= 0) { float v[8];
#pragma unroll
            for (int e8 = 0; e8 < 8; ++e8) v[e8] = tile[row * 65 + 8 * seg + e8];
            *(u32x4*)(WSP(bf16_t, WS_YSLOT) + (size_t)info * 1024 + 64 * ct + 8 * seg) = pack8(v); }
        __syncthreads();
    }
}
__device__ __forceinline__ void s10_combine(Frame& F) {
    const bf16_t* Y = WSP(bf16_t, WS_YSLOT);
    for (int i = blockIdx.x * NTHREADS + F.tid; i < T * 128; i += F.G * NTHREADS) {
        const int t = i >> 7, c0 = (i & 127) * 8, b = t / S;
        float y0[8], y1[8]; unpack8(*(const u32x4*)(Y + (size_t)(2 * t) * 1024 + c0), y0); unpack8(*(const u32x4*)(Y + (size_t)(2 * t + 1) * 1024 + c0), y1);
        const float* ga2 = WSP(float, WS_MOD) + (size_t)b * NMOD + 5120 + c0; float* o = F.out + (size_t)t * D + c0;
#pragma unroll
        for (int e4 = 0; e4 < 2; ++e4) { f32x4 xv = *(const f32x4*)(o + 4 * e4); const f32x4 gv = *(const f32x4*)(ga2 + 4 * e4);
#pragma unroll
            for (int e = 0; e < 4; ++e) xv[e] += gv[e] * (y0[4 * e4 + e] + y1[4 * e4 + e]);
            *(f32x4*)(o + 4 * e4) = xv; }
    }
}

constexpr int N_PHASES = 11;
struct Args { const float* in[21]; float* out; unsigned char* ws; int ph_lo, ph_hi; };
__global__ void __launch_bounds__(NTHREADS, 2) mega_fwd(Args args) {
    extern __shared__ __attribute__((aligned(16))) unsigned char lds_raw[];
    Frame F;
    F.lds = (LAS unsigned char*)lds_raw;
    F.tid = threadIdx.x; F.lane = F.tid & 63; F.wave = __builtin_amdgcn_readfirstlane(F.tid >> 6); F.G = gridDim.x;
    F.x = args.in[0]; F.c = args.in[1]; F.w_ada = args.in[2]; F.b_ada = args.in[3]; F.g1 = args.in[4]; F.g2 = args.in[5]; F.w_in = args.in[6]; F.g_q = args.in[7]; F.g_k = args.in[8];
    F.conv_w = args.in[9]; F.conv_b = args.in[10]; F.w_pa = args.in[11]; F.w_pb = args.in[12]; F.w_o = args.in[13]; F.w_rg = args.in[14]; F.b_rg = args.in[15]; F.w_re = args.in[16]; F.b_re = args.in[17];
    F.w1 = args.in[18]; F.w3 = args.in[19]; F.w2 = args.in[20]; F.out = args.out; F.ws = args.ws;
    volatile LAS unsigned* MISC = (volatile LAS unsigned*)(F.lds + MISC_OFF);
    if (F.tid < 64) MISC[F.tid] = 0u;
    __syncthreads();
    XcdBarrier bar = xcd_barrier_post((unsigned*)(F.ws + WS_CTL) + CW_BAR, MISC + 8);
    const int lo = args.ph_lo, hi = args.ph_hi;
#define PHASE(k, body) if (lo <= (k) && (k) < hi) { { int t_ = threadIdx.x; asm volatile("" : "+v"(t_)); F.tid = t_; F.lane = t_ & 63; } body; if ((k) + 1 < hi) xcd_barrier(bar); }
    PHASE(0, s0_prologue(F))
    PHASE(1, s1_norm1(F))
    PHASE(2, s2_fast(F))
    PHASE(3, s3_fast(F, (char*)lds_raw))
    PHASE(4, s4_fast(F))
    PHASE(5, s5_fast(F))
    PHASE(6, s6_router(F))
    PHASE(7, s7_lists(F))
    PHASE(8, s8_fast(F))
    PHASE(9, s9_fast(F))
    PHASE(10, s10_combine(F))
#undef PHASE
}

extern "C" void kernel_launch(void* const* d_in, const int* in_sizes, int n_in, void* d_out, int out_size, void* d_ws, size_t ws_size, hipStream_t stream) {
    static int grid = 0;
    if (grid == 0) {
        if (n_in != 21 || in_sizes[0] != T * D || out_size != T * D || ws_size < WS_END) { fprintf(stderr, "kernel_launch: unexpected shapes (n_in %d, in0 %d, out %d, ws %zu); nothing launched\n", n_in, n_in > 0 ? in_sizes[0] : -1, out_size, ws_size); grid = -1; return; }
        int dev = 0, cus = 0, per_cu = 0;
        if (hipGetDevice(&dev) != hipSuccess || hipDeviceGetAttribute(&cus, hipDeviceAttributeMultiprocessorCount, dev) != hipSuccess) { grid = -1; return; }
        if (hipFuncSetAttribute((const void*)mega_fwd, hipFuncAttributeMaxDynamicSharedMemorySize, LDS_BYTES) != hipSuccess) { fprintf(stderr, "kernel_launch: hipFuncSetAttribute failed\n"); grid = -1; return; }
        if (hipOccupancyMaxActiveBlocksPerMultiprocessor(&per_cu, (const void*)mega_fwd, NTHREADS, LDS_BYTES) != hipSuccess || per_cu < 1) { fprintf(stderr, "kernel_launch: occupancy query says %d blocks per CU\n", per_cu); per_cu = 1; }
        (void)hipGetLastError();
        if (cus < 256) { fprintf(stderr, "kernel_launch: built for a 256-CU device, found %d CUs; nothing launched\n", cus); grid = -1; return; }
        grid = 256;
    }
    if (grid < 0) return;
    (void)hipMemsetAsync((char*)d_ws + WS_CTL, 0, CTL_ZERO_BYTES, stream);
    Args a{};
    for (int i = 0; i < 21; ++i) a.in[i] = (const float*)d_in[i];
    a.out = (float*)d_out; a.ws = (unsigned char*)d_ws; a.ph_lo = 0; a.ph_hi = N_PHASES;
    hipLaunchKernelGGL(mega_fwd, dim3(grid), dim3(NTHREADS), LDS_BYTES, stream, a);
}
```

```cpp
#include <hip/hip_runtime.h>
#include <hip/hip_bf16.h>
#include <cstdio>
#include <cstdint>

#define GAS __attribute__((address_space(1)))
#define LAS __attribute__((address_space(3)))
typedef unsigned short bf16_t;
typedef short bf16x8 __attribute__((ext_vector_type(8)));
typedef float f32x4 __attribute__((ext_vector_type(4)));
typedef unsigned u32x4 __attribute__((ext_vector_type(4)));
typedef unsigned u32x2 __attribute__((ext_vector_type(2)));

constexpr int T = 32768, D = 1024, NB = 8, S = 4096, NH = 8, DH = 64, NIN = 5120, NE = 32, DE = 512, NMOD = 6144;
constexpr int NTHREADS = 512, NWAVES = 8;
constexpr float EPS = 1e-6f;
constexpr float C2 = 0.125f * 1.4426950408889634f;
constexpr int MAX_MT = 288;
constexpr int NPAD = MAX_MT * 256;

constexpr size_t MiB = 1u << 20, KiB = 1024;
constexpr size_t WS_CTL = 0, CTL_ZERO_BYTES = 1 * MiB;
constexpr size_t WS_MOD = 1 * MiB;
constexpr size_t WS_ROPE = 1 * MiB + 256 * KiB;
constexpr size_t WS_KMEAN = 1 * MiB + 512 * KiB;
constexpr size_t WS_EID = 2 * MiB;
constexpr size_t WS_EW = 2 * MiB + 256 * KiB;
constexpr size_t WS_BCNT = 2 * MiB + 512 * KiB;
constexpr size_t WS_TILEE = 2 * MiB + 768 * KiB;
constexpr size_t WS_ATOK = 3 * MiB;
constexpr size_t WS_AINFO = 3 * MiB + 512 * KiB;
constexpr size_t WS_AW = 4 * MiB;
constexpr size_t WS_W36T = 5 * MiB;
constexpr size_t WS_WIN_T = 8 * MiB;
constexpr size_t WS_WP_T = 18 * MiB;
constexpr size_t WS_WO_T = 20 * MiB;
constexpr size_t WS_W13_T = 24 * MiB;
constexpr size_t WS_W2_T = 88 * MiB;
constexpr size_t WS_H = 120 * MiB;
constexpr size_t WS_YAB = 184 * MiB;
constexpr size_t WS_K = 248 * MiB;
constexpr size_t WS_V = 280 * MiB;
constexpr size_t WS_U = 312 * MiB;
constexpr size_t WS_BG = 344 * MiB;
constexpr size_t WS_GATES = 376 * MiB;
constexpr size_t WS_H2 = 184 * MiB;
constexpr size_t WS_HID = 248 * MiB;
constexpr size_t WS_YSLOT = 320 * MiB;
constexpr size_t WS_LINFO = 448 * MiB;
constexpr size_t WS_LW = 456 * MiB;
constexpr size_t WS_END = 504 * MiB;
constexpr int CW_BAR = 4096, CW_MODCNT = 8192, CW_GCNT = 12288;

constexpr int LDS_BYTES = 159744;
constexpr int MISC_OFF = 147456;

__device__ __forceinline__ unsigned f2bf(float f) { unsigned u = __builtin_bit_cast(unsigned, f); return (u + 0x7fffu + ((u >> 16) & 1u)) >> 16; }
__device__ __forceinline__ float bf2f(unsigned h) { return __builtin_bit_cast(float, h << 16); }
__device__ __forceinline__ unsigned pk2(float lo, float hi) { return f2bf(lo) | (f2bf(hi) << 16); }
__device__ __forceinline__ void unpack8(const u32x4 w, float (&v)[8]) {
    v[0] = bf2f(w.x & 0xffffu); v[1] = bf2f(w.x >> 16); v[2] = bf2f(w.y & 0xffffu); v[3] = bf2f(w.y >> 16);
    v[4] = bf2f(w.z & 0xffffu); v[5] = bf2f(w.z >> 16); v[6] = bf2f(w.w & 0xffffu); v[7] = bf2f(w.w >> 16);
}
__device__ __forceinline__ u32x4 pack8(const float (&v)[8]) { u32x4 w; w.x = pk2(v[0], v[1]); w.y = pk2(v[2], v[3]); w.z = pk2(v[4], v[5]); w.w = pk2(v[6], v[7]); return w; }
__device__ __forceinline__ u32x4 pack8v(const f32x4 a, const f32x4 b) { u32x4 w; w.x = pk2(a.x, a.y); w.y = pk2(a.z, a.w); w.z = pk2(b.x, b.y); w.w = pk2(b.z, b.w); return w; }
__device__ __forceinline__ void unpack8v(const u32x4 w, f32x4& a, f32x4& b) {
    a.x = bf2f(w.x & 0xffffu); a.y = bf2f(w.x >> 16); a.z = bf2f(w.y & 0xffffu); a.w = bf2f(w.y >> 16);
    b.x = bf2f(w.z & 0xffffu); b.y = bf2f(w.z >> 16); b.z = bf2f(w.w & 0xffffu); b.w = bf2f(w.w >> 16); }
#define LDS_WAIT() asm volatile("s_waitcnt lgkmcnt(0)" ::: "memory")
__device__ __forceinline__ int lds_add(LAS int* p, int v) { return __hip_atomic_fetch_add(p, v, __ATOMIC_RELAXED, __HIP_MEMORY_SCOPE_WORKGROUP); }

#define XB_TMO      128
#define XB_XCNT(j)  (256  + 64 * (j))
#define XB_XSUB(j)  (1280 + 64 * (j))
#define XB_XGEN(j)  (2304 + 64 * (j))
#define XB_TOP      3328
#define XB_TOPGEN   3392
#define XCD_BAR_WORDS 3456
#define XB_SPIN_CAP (1u << 22)
__device__ __forceinline__ unsigned xb_ld(unsigned* p)              { return __hip_atomic_load(p, __ATOMIC_RELAXED, __HIP_MEMORY_SCOPE_AGENT); }
__device__ __forceinline__ unsigned xb_add(unsigned* p, unsigned v) { return __hip_atomic_fetch_add(p, v, __ATOMIC_RELAXED, __HIP_MEMORY_SCOPE_AGENT); }
__device__ __forceinline__ unsigned xb_xcc_id() { return (unsigned)__builtin_amdgcn_s_getreg((3 << 11) | 20) & 0xFu; }
#define XB_SPIN(cond, bar) do { unsigned _sp = 0; while (cond) { __builtin_amdgcn_s_sleep(1); \
    if ((++_sp & 255u) == 0u) { if (xb_ld(&(bar)[XB_TMO])) break; if (_sp > XB_SPIN_CAP) { atomicAdd(&(bar)[XB_TMO], 1u); break; } } } } while (0)
struct XcdBarrier { unsigned* bar; unsigned x; volatile LAS unsigned* st; };
__device__ __forceinline__ XcdBarrier xcd_barrier_post(unsigned* bar, volatile LAS unsigned* st) {
    XcdBarrier b; b.bar = bar; b.x = xb_xcc_id(); b.st = st;
    if (threadIdx.x == 0) (void)xb_add(&bar[XB_XCNT(b.x)], 1u);
    return b;
}
__device__ __forceinline__ void xcd_barrier_complete(unsigned* bar, unsigned x, unsigned& nloc, unsigned& nx) {
    const unsigned G = gridDim.x * gridDim.y * gridDim.z;
    unsigned sum, cnt, mine, sp = 0u;
    for (;;) {
        sum = 0u; cnt = 0u; mine = 0u;
#pragma unroll
        for (unsigned j = 0; j < 16; ++j) { const unsigned c = xb_ld(&bar[XB_XCNT(j)]); sum += c; cnt += (c > 0u) ? 1u : 0u; mine = (j == x) ? c : mine; }
        if (sum == G) break;
        __builtin_amdgcn_s_sleep(1);
        if ((++sp & 255u) == 0u) { if (xb_ld(&bar[XB_TMO])) break; if (sp > XB_SPIN_CAP) { atomicAdd(&bar[XB_TMO], 1u); break; } }
    }
    nloc = mine > 0u ? mine : 1u; nx = cnt > 0u ? cnt : 1u;
}
__device__ __forceinline__ void xcd_barrier(const XcdBarrier& b) {
    asm volatile("s_waitcnt vmcnt(0)" ::: "memory");
    __syncthreads();
    if (threadIdx.x == 0) {
        unsigned* bar = b.bar;
        __builtin_amdgcn_s_waitcnt(0);
        unsigned nloc = b.st[0], nx = b.st[1];
        if (nloc == 0u) { xcd_barrier_complete(bar, b.x, nloc, nx); b.st[0] = nloc; b.st[1] = nx; }
        const unsigned old = xb_add(&bar[XB_XSUB(b.x)], 1u);
        const unsigned gen = old / nloc;
        if (old + 1u == (gen + 1u) * nloc) {
            __builtin_amdgcn_fence(__ATOMIC_RELEASE, "agent");
            asm volatile("s_waitcnt vmcnt(0)" ::: "memory");
            const unsigned og = xb_add(&bar[XB_TOP], 1u);
            const unsigned tg = og / nx;
            if (og + 1u == (tg + 1u) * nx) xb_add(&bar[XB_TOPGEN], 1u);
            else XB_SPIN(xb_ld(&bar[XB_TOPGEN]) == tg, bar);
            __builtin_amdgcn_fence(__ATOMIC_ACQUIRE, "agent");
            xb_add(&bar[XB_XGEN(b.x)], 1u);
            asm volatile("s_waitcnt vmcnt(0)" ::: "memory");
        } else {
            XB_SPIN(xb_ld(&bar[XB_XGEN(b.x)]) == gen, bar);
            __builtin_amdgcn_fence(__ATOMIC_ACQUIRE, "agent");
            asm volatile("s_waitcnt vmcnt(0)" ::: "memory");
        }
    }
    __syncthreads();
}

struct Frame {
    LAS unsigned char* lds;
    int tid, lane, wave, G;
    const float *x, *c, *w_ada, *b_ada, *g1, *g2, *w_in, *g_q, *g_k, *conv_w, *conv_b, *w_pa, *w_pb, *w_o, *w_rg, *b_rg, *w_re, *b_re, *w1, *w3, *w2;
    float* out; unsigned char* ws;
};
#define WSP(type, off) ((type*)(F.ws + (off)))

__device__ __forceinline__ void transpose_item(const float* W, int N, int k0, int n0, bf16_t* dst  , int pitch, LAS float* scr, int lane) {
#pragma unroll 8
    for (int i = 0; i < 32; ++i) { const int kk = 2 * i + (lane >> 5); scr[kk * 33 + (lane & 31)] = W[(size_t)(k0 + kk) * N + n0 + (lane & 31)]; }
    LDS_WAIT(); asm volatile("" ::: "memory");
    const int c = lane & 7;
#pragma unroll
    for (int j = 0; j < 4; ++j) { const int n = (lane >> 3) + 8 * j; const LAS float* s = scr + (8 * c) * 33 + n;
        u32x4 o; o.x = pk2(s[0 * 33], s[1 * 33]); o.y = pk2(s[2 * 33], s[3 * 33]); o.z = pk2(s[4 * 33], s[5 * 33]); o.w = pk2(s[6 * 33], s[7 * 33]);
        *(u32x4*)(dst + (size_t)n * pitch + 8 * c) = o; }
    LDS_WAIT(); asm volatile("" ::: "memory");
}
__device__ __forceinline__ int win_dest_row(int sc) {
    if (sc < 32) { const int isk = sc >> 4, s2 = sc & 15, hh = s2 >> 1, bj = s2 & 1; return 512 * isk + 256 * (hh >> 2) + 128 * bj + 32 * (hh & 3); }
    if (sc < 48) return 32 * sc;
    if (sc < 64) { const int cx = 32 * (sc - 48); return 256 * (6 + (cx >> 7)) + (cx & 127); }
    if (sc < 80) return 2560 + 32 * (sc - 64);
    if (sc < 96) { const int cx = 32 * (sc - 80); return 256 * (6 + (cx >> 7)) + 128 + (cx & 127); }
    return 3072 + 32 * (sc - 96);
}
__device__ __forceinline__ void s0_prologue(Frame& F) {
    const int gt = blockIdx.x * NTHREADS + F.tid;
    if (gt < NB * NH * 16 * 64) WSP(float, WS_KMEAN)[gt] = 0.f;
    if (gt < 36 * 1024) { const int jj = gt >> 10, k = gt & 1023; WSP(float, WS_W36T)[gt] = (jj < 4) ? F.w_rg[k * 4 + jj] : F.w_re[k * 32 + (jj - 4)]; }
    if (gt < S * 8) { const int pos = gt >> 3, i = gt & 7; const float inv = powf(500000.0f, -(float)(2 * i) / 16.0f); const float ang = (float)pos * inv;
        WSP(float2, WS_ROPE)[gt] = make_float2(cosf(ang), sinf(ang)); }
    if (blockIdx.x < 192) {
        LAS float* sc = (LAS float*)F.lds;
        for (int i = F.tid; i < NB * D; i += NTHREADS) { const float v = F.c[i]; sc[i] = v / (1.f + expf(-v)); }
        __syncthreads();
        const int j0 = blockIdx.x * 32, col = j0 + (F.lane & 31), kpar = F.lane >> 5;
        float acc[8];
#pragma unroll
        for (int b = 0; b < 8; ++b) acc[b] = 0.f;
        for (int i = 0; i < 64; ++i) { const int k = F.wave * 128 + 2 * i + kpar; const float w = F.w_ada[(size_t)k * NMOD + col];
#pragma unroll
            for (int b = 0; b < 8; ++b) acc[b] += sc[b * D + k] * w; }
#pragma unroll
        for (int b = 0; b < 8; ++b) acc[b] += __shfl_xor(acc[b], 32);
        LAS float* red = (LAS float*)(F.lds + 32768);
        if (F.lane < 32) {
#pragma unroll
            for (int b = 0; b < 8; ++b) red[(F.wave * 8 + b) * 32 + F.lane] = acc[b]; }
        __syncthreads();
        if (F.tid < 256) { const int b = F.tid >> 5, cc = F.tid & 31; float s = F.b_ada[j0 + cc];
#pragma unroll
            for (int w = 0; w < 8; ++w) s += red[(w * 8 + b) * 32 + cc];
            WSP(float, WS_MOD)[b * NMOD + j0 + cc] = s; }
        asm volatile("s_waitcnt vmcnt(0)" ::: "memory");
        __syncthreads();
        if (F.tid == 0) { __builtin_amdgcn_fence(__ATOMIC_RELEASE, "agent"); asm volatile("s_waitcnt vmcnt(0)" ::: "memory");
            __hip_atomic_fetch_add(WSP(unsigned, WS_CTL) + CW_MODCNT, 1u, __ATOMIC_RELAXED, __HIP_MEMORY_SCOPE_AGENT); }
    }
    LAS float* scr = (LAS float*)(F.lds + F.wave * 16384);
    const int gw = blockIdx.x * NWAVES + F.wave, NGW = F.G * NWAVES;
    constexpr int I_IN = 16 * 160, I_PA = 8 * 32, I_O = 16 * 32, I_E1 = 16 * 16, I_E2 = 8 * 32;
    constexpr int NITEMS = I_IN + 2 * I_PA + I_O + NE * (2 * I_E1 + I_E2);
    for (int it = gw; it < NITEMS; it += NGW) {
        int r = it;
        if (r < I_IN) { const int kb = r / 160, sc = r % 160; transpose_item(F.w_in, NIN, 64 * kb, 32 * sc, WSP(bf16_t, WS_WIN_T) + (size_t)win_dest_row(sc) * 1024 + 64 * kb, 1024, scr, F.lane); continue; } r -= I_IN;
        if (r < I_PA) { const int kb = r / 32, sc = r % 32; transpose_item(F.w_pa, 1024, 64 * kb, 32 * sc, WSP(bf16_t, WS_WP_T) + (size_t)(32 * sc) * 1024 + 64 * kb, 1024, scr, F.lane); continue; } r -= I_PA;
        if (r < I_PA) { const int kb = r / 32, sc = r % 32; transpose_item(F.w_pb, 1024, 64 * kb, 32 * sc, WSP(bf16_t, WS_WP_T) + (size_t)(32 * sc) * 1024 + 512 + 64 * kb, 1024, scr, F.lane); continue; } r -= I_PA;
        if (r < I_O) { const int kb = r / 32, sc = r % 32; transpose_item(F.w_o, 1024, 64 * kb, 32 * sc, WSP(bf16_t, WS_WO_T) + (size_t)(32 * sc) * 1024 + 64 * kb, 1024, scr, F.lane); continue; } r -= I_O;
        const int e = r / (2 * I_E1 + I_E2); r -= e * (2 * I_E1 + I_E2);
        if (r < 2 * I_E1) { const int is3 = r >= I_E1; if (is3) r -= I_E1; const int kb = r / 16, sc = r % 16;
            transpose_item((is3 ? F.w3 : F.w1) + (size_t)e * D * DE, DE, 64 * kb, 32 * sc, WSP(bf16_t, WS_W13_T) + ((size_t)e * 1024 + 256 * (sc >> 2) + 128 * is3 + 32 * (sc & 3)) * 1024 + 64 * kb, 1024, scr, F.lane); continue; }
        r -= 2 * I_E1;
        { const int kb = r / 32, sc = r % 32;
            transpose_item(F.w2 + (size_t)e * DE * D, D, 64 * kb, 32 * sc, WSP(bf16_t, WS_W2_T) + ((size_t)e * 1024 + 32 * sc) * 512 + 64 * kb, 512, scr, F.lane); }
    }
}

__device__ __forceinline__ void wait_mod(Frame& F) {
    if (F.tid == 0) { unsigned* c = WSP(unsigned, WS_CTL) + CW_MODCNT; unsigned sp = 0;
        while (__hip_atomic_load(c, __ATOMIC_RELAXED, __HIP_MEMORY_SCOPE_AGENT) < 192u) { __builtin_amdgcn_s_sleep(2); if (++sp > (1u << 24)) break; }
        __builtin_amdgcn_fence(__ATOMIC_ACQUIRE, "agent"); asm volatile("s_waitcnt vmcnt(0)" ::: "memory"); }
    __syncthreads();
}
template <int N> __device__ __forceinline__ float dpp_ror(float v) { return __builtin_bit_cast(float, __builtin_amdgcn_update_dpp(0, __builtin_bit_cast(int, v), 0x120 + N, 0xF, 0xF, false)); }
__device__ __forceinline__ float wave_sum(float v) {
#pragma unroll
    for (int o = 1; o < 64; o <<= 1) v += __shfl_xor(v, o);
    return v;
}
__device__ __forceinline__ void s1_norm1(Frame& F) {
    const int gw = blockIdx.x * NWAVES + F.wave;
    const int row0 = gw * 16, b = row0 / S;
    if (row0 >= T) return;
    const float* mod = WSP(float, WS_MOD) + (size_t)b * NMOD;
    f32x4 gs[4], sh[4];
#pragma unroll
    for (int j = 0; j < 4; ++j) { const int col = 4 * F.lane + 256 * j; const f32x4 g = *(const f32x4*)(F.g1 + col), s = *(const f32x4*)(mod + 1024 + col); gs[j] = g * (s + 1.0f); sh[j] = *(const f32x4*)(mod + col); }
    for (int r = 0; r < 16; ++r) {
        const float* xr = F.x + (size_t)(row0 + r) * D;
        f32x4 v[4]; float ss = 0.f;
#pragma unroll
        for (int j = 0; j < 4; ++j) { v[j] = *(const f32x4*)(xr + 4 * F.lane + 256 * j); ss += (v[j].x * v[j].x + v[j].y * v[j].y) + (v[j].z * v[j].z + v[j].w * v[j].w); }
        const float rinv = rsqrtf(wave_sum(ss) * (1.f / D) + EPS);
        bf16_t* o = WSP(bf16_t, WS_H) + (size_t)(row0 + r) * D;
#pragma unroll
        for (int j = 0; j < 4; ++j) { const f32x4 h = v[j] * rinv * gs[j] + sh[j]; u32x2 w; w.x = pk2(h.x, h.y); w.y = pk2(h.z, h.w); *(u32x2*)(o + 4 * F.lane + 256 * j) = w; }
    }
}

struct RowsLinear { const bf16_t* base; size_t pitch; __device__ __forceinline__ const bf16_t* operator()(int r) const { return base + (size_t)r * pitch; } };
template <class AR, class BR>
__device__ __forceinline__ void sgemm_tile(LAS float* tile, int K, const AR& arow, const BR& brow, int wave, int lane) {
    const int fr = lane & 15, fq = lane >> 4, rb = 16 * (wave & 3), cb = 32 * (wave >> 2);
    const bf16_t* ap = arow(rb + fr) + 8 * fq;
    const bf16_t* bp0 = brow(cb + fr) + 8 * fq;
    const bf16_t* bp1 = brow(cb + 16 + fr) + 8 * fq;
    f32x4 acc0 = {0.f, 0.f, 0.f, 0.f}, acc1 = {0.f, 0.f, 0.f, 0.f};
#pragma unroll 4
    for (int k = 0; k < K; k += 32) {
        const bf16x8 a = *(const bf16x8*)(ap + k), b0 = *(const bf16x8*)(bp0 + k), b1 = *(const bf16x8*)(bp1 + k);
        acc0 = __builtin_amdgcn_mfma_f32_16x16x32_bf16(a, b0, acc0, 0, 0, 0);
        acc1 = __builtin_amdgcn_mfma_f32_16x16x32_bf16(a, b1, acc1, 0, 0, 0);
    }
#pragma unroll
    for (int j = 0; j < 4; ++j) { tile[(rb + fq * 4 + j) * 65 + cb + fr] = acc0[j]; tile[(rb + fq * 4 + j) * 65 + cb + 16 + fr] = acc1[j]; }
}

struct WinRowsHead { const bf16_t* base; int rb; __device__ __forceinline__ const bf16_t* operator()(int d) const { return base + (size_t)(rb + 128 * (d >> 5) + (d & 31)) * 1024; } };
__device__ __forceinline__ void s2_simple(Frame& F) {
    LAS float* tile = (LAS float*)F.lds; LAS float* tile2 = tile + 64 * 65;
    const bf16_t* H = WSP(bf16_t, WS_H); const bf16_t* WT = WSP(bf16_t, WS_WIN_T);
    const int row = F.tid >> 3, seg = F.tid & 7;
    for (int it = blockIdx.x; it < 512 * 72; it += F.G) {
        const int rt = it / 72, ct = it % 72, r0 = rt * 64, gr = r0 + row;
        const RowsLinear ar{H + (size_t)r0 * 1024, 1024};
        float v[8];
        if (ct < 16) {
            const int isk = ct >> 3, hh = ct & 7;
            const WinRowsHead br{WT, 512 * isk + 256 * (hh >> 2) + 32 * (hh & 3)};
            sgemm_tile(tile, 1024, ar, br, F.wave, F.lane); __syncthreads();
            float ss = 0.f;
#pragma unroll
            for (int e = 0; e < 8; ++e) { v[e] = tile[row * 65 + 8 * seg + e]; ss += v[e] * v[e]; }
            ss += __shfl_xor(ss, 1); ss += __shfl_xor(ss, 2); ss += __shfl_xor(ss, 4);
            const float rinv = rsqrtf(ss * (1.f / 64.f) + EPS);
            const float* g = isk ? F.g_k : F.g_q;
            const int pos = gr & (S - 1);
#pragma unroll
            for (int e = 0; e < 8; ++e) { v[e] = v[e] * rinv * g[8 * seg + e]; const float pv = __shfl_xor(v[e], 1);
                if (seg < 2) { const float2 cs = WSP(float2, WS_ROPE)[pos * 8 + e]; v[e] = (seg == 0) ? (v[e] * cs.x - pv * cs.y) : (v[e] * cs.x + pv * cs.y); } }
            if (!isk) {
#pragma unroll
                for (int e = 0; e < 8; ++e) v[e] *= C2;
                *(u32x4*)(WSP(bf16_t, WS_YAB) + (size_t)gr * 1024 + hh * 64 + 8 * seg) = pack8(v);
            } else {
                *(u32x4*)(WSP(bf16_t, WS_K) + (size_t)gr * 512 + hh * 64 + 8 * seg) = pack8(v);
#pragma unroll
                for (int e = 0; e < 8; ++e) tile[row * 65 + 8 * seg + e] = v[e];
                __syncthreads();
                if (F.tid < 64) { float s = 0.f; for (int r = 0; r < 64; ++r) s += tile[r * 65 + F.tid];
                    const int b = r0 / S, blk = (r0 & (S - 1)) >> 8;
                    atomicAdd(WSP(float, WS_KMEAN) + ((size_t)(b * NH + hh) * 16 + blk) * 64 + F.tid, s * (1.f / 256.f)); }
            }
        } else if (ct < 24) {
            const RowsLinear br{WT + (size_t)(1024 + 64 * (ct - 16)) * 1024, 1024};
            sgemm_tile(tile, 1024, ar, br, F.wave, F.lane); __syncthreads();
#pragma unroll
            for (int e = 0; e < 8; ++e) v[e] = tile[row * 65 + 8 * seg + e];
            *(u32x4*)(WSP(bf16_t, WS_V) + (size_t)gr * 512 + 64 * (ct - 16) + 8 * seg) = pack8(v);
        } else if (ct < 32) {
            const int cu = 64 * (ct - 24), rb = 256 * (6 + (cu >> 7)) + (cu & 127);
            const RowsLinear bx{WT + (size_t)rb * 1024, 1024}, bc{WT + (size_t)(rb + 128) * 1024, 1024};
            sgemm_tile(tile, 1024, ar, bx, F.wave, F.lane); sgemm_tile(tile2, 1024, ar, bc, F.wave, F.lane); __syncthreads();
#pragma unroll
            for (int e = 0; e < 8; ++e) v[e] = tile[row * 65 + 8 * seg + e] * tile2[row * 65 + 8 * seg + e];
            *(u32x4*)(WSP(bf16_t, WS_U) + (size_t)gr * 512 + cu + 8 * seg) = pack8(v);
        } else if (ct < 40) {
            const RowsLinear br{WT + (size_t)(2560 + 64 * (ct - 32)) * 1024, 1024};
            sgemm_tile(tile, 1024, ar, br, F.wave, F.lane); __syncthreads();
#pragma unroll
            for (int e = 0; e < 8; ++e) v[e] = tile[row * 65 + 8 * seg + e];
            *(u32x4*)(WSP(bf16_t, WS_BG) + (size_t)gr * 512 + 64 * (ct - 32) + 8 * seg) = pack8(v);
        } else {
            const RowsLinear br{WT + (size_t)(3072 + 64 * (ct - 40)) * 1024, 1024};
            sgemm_tile(tile, 1024, ar, br, F.wave, F.lane); __syncthreads();
#pragma unroll
            for (int e = 0; e < 8; ++e) v[e] = 1.f / (1.f + __expf(-tile[row * 65 + 8 * seg + e]));
            *(u32x4*)(WSP(bf16_t, WS_GATES) + (size_t)gr * 2048 + 64 * (ct - 40) + 8 * seg) = pack8(v);
        }
        __syncthreads();
    }
}

namespace pg8 {
constexpr int BM = 256, BK = 64, HALF = 128, HTB = HALF * BK * 2, STAGE_BYTES = 8 * HTB, NXCD = 8, WGM = 8;
__device__ __forceinline__ int lds_byte(int r, int c) { const int st = (r >> 4) * 2 + (c >> 5), rr = r & 15, cc = c & 31, ob = rr * 64 + cc * 2; return st * 1024 + (ob ^ (((ob >> 9) & 1) << 5)); }
__device__ __forceinline__ void stage_rc(int b, int& R, int& C) { const int st = b / 1024, sb = b % 1024, swz = sb ^ (((sb >> 9) & 1) << 5); R = (st >> 1) * 16 + swz / 64; C = (st & 1) * 32 + (swz % 64) / 2; }
__device__ __forceinline__ int perm32(int rho) { const int n = rho >> 4, i = rho & 15; return 8 * (i >> 2) + 4 * n + (i & 3); }
struct Unit { int pm, pn; const char* a; const char* b; int e, rbase; };
__device__ __forceinline__ bool static_unit(int i, int G, int c, int nM, int nN, int& pm, int& pn) {
    const int nwg = nM * nN; const long L = (long)i * G + c; if (L >= nwg) return false;
    int wgid = (int)L; { const int q = nwg / NXCD, r = nwg % NXCD, xcd = wgid % NXCD, off = wgid / NXCD; wgid = (xcd < r ? xcd * (q + 1) : r * (q + 1) + (xcd - r) * q) + off; }
    const int nig = WGM * nN, gid = wgid / nig, fm = gid * WGM, gsz = (nM - fm) < WGM ? (nM - fm) : WGM;
    pm = fm + ((wgid % nig) % gsz); pn = (wgid % nig) / gsz; return true;
}
struct DenseSched {
    static constexpr bool GATHER = false;
    const char* A; const char* Bt; int nM, nN, K, G, c;
    __device__ __forceinline__ bool next(int i, Unit& u) const { if (!static_unit(i, G, c, nM, nN, u.pm, u.pn)) return false;
        u.a = A + (size_t)u.pm * BM * K * 2; u.b = Bt + (size_t)u.pn * BM * K * 2; u.e = 0; u.rbase = 0; return true; }
    __device__ __forceinline__ int row_index(const Unit&, int) const { return 0; }
};

template <class Epi, class Sched>
__device__ __forceinline__ void gemm_phase(LAS unsigned char* lds, const int K, const Sched& S, const Epi& E) {
    const int tid = threadIdx.x, wid = __builtin_amdgcn_readfirstlane(tid >> 6), lane = tid & 63, wr = wid >> 2, wc = wid & 3, fr = lane & 15, fq = lane >> 4;
    const int nt = K / BK;
    unsigned voffB[2], vA[2][2], vN[2][2]; int Rr[2], Cc[2];
#pragma unroll
    for (int i = 0; i < 2; ++i) { int R, C; stage_rc(tid * 16 + i * 8192, R, C); const int Rb = (R & ~31) + perm32(R & 31);
        Rr[i] = R; Cc[i] = C; voffB[i] = (unsigned)(Rb * K + C) * 2u;
        vA[0][i] = (unsigned)(R * K + C) * 2u; vA[1][i] = (unsigned)((HALF + R) * K + C) * 2u; vN[0][i] = vA[0][i]; vN[1][i] = vA[1][i]; }
    const size_t kstep = (size_t)(BK * 2);
    const size_t hstep = (size_t)HALF * K * 2;
    const unsigned ldsw = (unsigned)wid * 1024u;
    const int aoff = lds_byte(wr * 64 + fr, fq * 8), boff = lds_byte(wc * 32 + fr, fq * 8);
#define PG8_SA(b, h) (((b) * 2 + (h)) * HTB)
#define PG8_SB(b, h) ((4 + (b) * 2 + (h)) * HTB)
#define PG8_STAGE(bufoff, gbase, voff) do { _Pragma("unroll") for (int _i = 0; _i < 2; ++_i) \
        __builtin_amdgcn_global_load_lds((const unsigned*)((const char*)(gbase) + (voff)[_i]), (LAS unsigned*)(lds + (bufoff) + ldsw + _i * 8192), 16, 0, 0); } while (0)
#define PG8_LDA(dst, b, h) do { _Pragma("unroll") for (int m = 0; m < 4; ++m) _Pragma("unroll") for (int k = 0; k < 2; ++k) dst[m][k] = *(const LAS bf16x8*)(lds + PG8_SA(b, h) + aoff + m * 2048 + k * 1024); } while (0)
#define PG8_LDB(dst, b, h) do { _Pragma("unroll") for (int n = 0; n < 2; ++n) _Pragma("unroll") for (int k = 0; k < 2; ++k) dst[n][k] = *(const LAS bf16x8*)(lds + PG8_SB(b, h) + boff + n * 2048 + k * 1024); } while (0)
#define PG8_MMA(ai, bj, At, Bt) do { __builtin_amdgcn_s_setprio(1); _Pragma("unroll") for (int m = 0; m < 4; ++m) _Pragma("unroll") for (int n = 0; n < 2; ++n) _Pragma("unroll") for (int k = 0; k < 2; ++k) \
        acc[ai][bj][m][n] = __builtin_amdgcn_mfma_f32_16x16x32_bf16(Bt[n][k], At[m][k], acc[ai][bj][m][n], 0, 0, 0); __builtin_amdgcn_s_setprio(0); } while (0)
#define PG8_WAIT_V(n) asm volatile("s_waitcnt vmcnt(" #n ")" ::: "memory")
#define PG8_WAIT_L(n) asm volatile("s_waitcnt lgkmcnt(" #n ")" ::: "memory")
#define PG8_BAR __builtin_amdgcn_s_barrier()
#define PG8_SCHED __builtin_amdgcn_sched_barrier(0)
#define PG8_AOFF(dst, u) do { _Pragma("unroll") for (int _h = 0; _h < 2; ++_h) _Pragma("unroll") for (int _i = 0; _i < 2; ++_i) \
        dst[_h][_i] = (unsigned)(S.row_index(u, _h * HALF + Rr[_i]) * K + Cc[_i]) * 2u; } while (0)
    Unit cur, nxt; int ui = 0;
    if (!S.next(0, cur)) return;
    if constexpr (Sched::GATHER) PG8_AOFF(vA, cur);
    f32x4 acc[2][2][4][2];
#pragma unroll
    for (int a = 0; a < 2; ++a)
#pragma unroll
        for (int b = 0; b < 2; ++b)
#pragma unroll
            for (int m = 0; m < 4; ++m)
#pragma unroll
                for (int n = 0; n < 2; ++n) acc[a][b][m][n] = (f32x4){0.f, 0.f, 0.f, 0.f};
    bf16x8 At[4][2], B0[2][2], B1[2][2];
    const char* cA = cur.a; const char* cB = cur.b;
    PG8_STAGE(PG8_SB(0, 0), cB, voffB); PG8_STAGE(PG8_SB(0, 1), cB + hstep, voffB); PG8_STAGE(PG8_SA(0, 0), cA, vA[0]); PG8_STAGE(PG8_SA(0, 1), cA, vA[1]);
    if (wr == 1) PG8_BAR;
    PG8_WAIT_V(2); PG8_BAR;
    PG8_STAGE(PG8_SB(1, 0), cB + kstep, voffB); PG8_STAGE(PG8_SA(1, 0), cA + kstep, vA[0]); PG8_STAGE(PG8_SB(1, 1), cB + hstep + kstep, voffB);
    PG8_WAIT_V(6); PG8_BAR;
    for (;;) {
        const bool has_next = S.next(ui + 1, nxt);
        const char* nA = has_next ? nxt.a : cA; const char* nB = has_next ? nxt.b : cB;
        if constexpr (Sched::GATHER) { if (has_next) PG8_AOFF(vN, nxt); else {
#pragma unroll
            for (int h = 0; h < 2; ++h)
#pragma unroll
                for (int i = 0; i < 2; ++i) vN[h][i] = vA[h][i]; } }
        for (int hk = 0; hk < (Epi::HAS_MID ? 2 : 1); ++hk) {
        if constexpr (Epi::HAS_MID) { if (hk == 1) E.mid(acc, cur, wr, wc, fr, fq); }
        const int tb = (Epi::HAS_MID && hk == 1) ? nt / 2 : 0, te = (Epi::HAS_MID && hk == 0) ? nt / 2 : nt;
        for (int t = tb; t < te; t += 2) {
            const bool last = (t == nt - 2);
            const char* a1 = cA + (size_t)(t + 1) * kstep;
            const char* a2 = last ? nA : cA + (size_t)(t + 2) * kstep; const char* b2 = last ? nB : cB + (size_t)(t + 2) * kstep;
            const char* a3 = a2 + kstep; const char* b3 = b2 + kstep;
            unsigned w0[2], w1[2];
#pragma unroll
            for (int i = 0; i < 2; ++i) { w0[i] = (Sched::GATHER && last) ? vN[0][i] : vA[0][i]; w1[i] = (Sched::GATHER && last) ? vN[1][i] : vA[1][i]; }
            PG8_LDB(B0, 0, 0); PG8_LDB(B1, 0, 1); PG8_SCHED; PG8_LDA(At, 0, 0); PG8_STAGE(PG8_SA(1, 1), a1, vA[1]);
            PG8_WAIT_V(8); PG8_WAIT_L(0); PG8_BAR; PG8_MMA(0, 0, At, B0); PG8_MMA(0, 1, At, B1); PG8_BAR; PG8_SCHED;
            PG8_LDA(At, 0, 1); PG8_STAGE(PG8_SB(0, 0), b2, voffB); PG8_STAGE(PG8_SB(0, 1), b2 + hstep, voffB); PG8_STAGE(PG8_SA(0, 0), a2, w0);
            PG8_WAIT_V(8); PG8_WAIT_L(0); PG8_BAR; PG8_MMA(1, 0, At, B0); PG8_MMA(1, 1, At, B1); PG8_BAR; PG8_SCHED;
            PG8_LDB(B0, 1, 0); PG8_LDB(B1, 1, 1); PG8_SCHED; PG8_LDA(At, 1, 0); PG8_STAGE(PG8_SA(0, 1), a2, w1);
            PG8_WAIT_V(8); PG8_WAIT_L(0); PG8_BAR; PG8_MMA(0, 0, At, B0); PG8_MMA(0, 1, At, B1); PG8_BAR; PG8_SCHED;
            PG8_LDA(At, 1, 1); PG8_STAGE(PG8_SB(1, 0), b3, voffB); PG8_STAGE(PG8_SB(1, 1), b3 + hstep, voffB); PG8_STAGE(PG8_SA(1, 0), a3, w0);
            PG8_WAIT_V(8); PG8_WAIT_L(0); PG8_BAR; PG8_MMA(1, 0, At, B0); PG8_MMA(1, 1, At, B1); PG8_BAR; PG8_SCHED;
        }
        }
        if (wr == 0) PG8_BAR;
        E(acc, cur, wr, wc, fr, fq);
        if (!has_next) break;
#pragma unroll
        for (int a = 0; a < 2; ++a)
#pragma unroll
            for (int b = 0; b < 2; ++b)
#pragma unroll
                for (int m = 0; m < 4; ++m)
#pragma unroll
                    for (int n = 0; n < 2; ++n) acc[a][b][m][n] = (f32x4){0.f, 0.f, 0.f, 0.f};
        cur = nxt; cA = nA; cB = nB; ++ui;
        if constexpr (Sched::GATHER) {
#pragma unroll
            for (int h = 0; h < 2; ++h)
#pragma unroll
                for (int i = 0; i < 2; ++i) vA[h][i] = vN[h][i]; }
        if (wr == 1) PG8_BAR;
    }
    PG8_WAIT_V(0);
    PG8_BAR;
#undef PG8_SA
#undef PG8_SB
#undef PG8_STAGE
#undef PG8_LDA
#undef PG8_LDB
#undef PG8_MMA
#undef PG8_WAIT_V
#undef PG8_WAIT_L
#undef PG8_BAR
#undef PG8_SCHED
#undef PG8_AOFF
}
}

typedef f32x4 Acc[2][2][4][2];
struct EpiG1 {
    static constexpr bool HAS_MID = false;
    unsigned char* ws; const float* g_q; const float* g_k;
    __device__ __forceinline__ void mid(Acc&, const pg8::Unit&, int, int, int, int) const {}
    __device__ __forceinline__ void operator()(Acc& acc, const pg8::Unit& u, int wr, int wc, int fr, int fq) const {
        const int pn = u.pn, row0 = u.pm * 256 + wr * 64 + fr;
        if (pn < 4) {
            const int isk = pn >> 1, hh = 4 * (pn & 1) + wc;
            const float* g = isk ? g_k : g_q;
            f32x4 gv[2][2];
#pragma unroll
            for (int bj = 0; bj < 2; ++bj)
#pragma unroll
                for (int n = 0; n < 2; ++n) gv[bj][n] = *(const f32x4*)(g + 32 * bj + 8 * fq + 4 * n);
            f32x4 cs_[2][2];
#pragma unroll
            for (int bj = 0; bj < 2; ++bj)
#pragma unroll
                for (int n = 0; n < 2; ++n) cs_[bj][n] = (f32x4){0.f, 0.f, 0.f, 0.f};
            const float2* rope = (const float2*)(ws + WS_ROPE);
            bf16_t* dst = isk ? (bf16_t*)(ws + WS_K) : (bf16_t*)(ws + WS_YAB);
            const int pitch = isk ? 512 : 1024;
#pragma unroll
            for (int ai = 0; ai < 2; ++ai)
#pragma unroll
                for (int m = 0; m < 4; ++m) {
                    const int r = row0 + 128 * ai + 16 * m, pos = r & (S - 1);
                    f32x4 v[2][2]; float ss = 0.f;
#pragma unroll
                    for (int bj = 0; bj < 2; ++bj)
#pragma unroll
                        for (int n = 0; n < 2; ++n) { v[bj][n] = acc[ai][bj][m][n]; ss += (v[bj][n].x * v[bj][n].x + v[bj][n].y * v[bj][n].y) + (v[bj][n].z * v[bj][n].z + v[bj][n].w * v[bj][n].w); }
                    ss += __shfl_xor(ss, 16); ss += __shfl_xor(ss, 32);
                    const float rinv = rsqrtf(ss * (1.f / 64.f) + EPS);
#pragma unroll
                    for (int bj = 0; bj < 2; ++bj)
#pragma unroll
                        for (int n = 0; n < 2; ++n) v[bj][n] = v[bj][n] * rinv * gv[bj][n];
#pragma unroll
                    for (int n = 0; n < 2; ++n)
#pragma unroll
                        for (int e = 0; e < 4; ++e) { const float pv = __shfl_xor(v[0][n][e], 16);
                            if (fq < 2) { const float2 cs = rope[pos * 8 + 4 * n + e]; v[0][n][e] = (fq == 0) ? (v[0][n][e] * cs.x - pv * cs.y) : (v[0][n][e] * cs.x + pv * cs.y); } }
                    if (isk) {
#pragma unroll
                        for (int bj = 0; bj < 2; ++bj)
#pragma unroll
                            for (int n = 0; n < 2; ++n) cs_[bj][n] += v[bj][n];
                    }
                    const float sc = isk ? 1.f : C2;
#pragma unroll
                    for (int bj = 0; bj < 2; ++bj) { u32x4 w; const f32x4 a = v[bj][0] * sc, b = v[bj][1] * sc;
                        w.x = pk2(a.x, a.y); w.y = pk2(a.z, a.w); w.z = pk2(b.x, b.y); w.w = pk2(b.z, b.w);
                        *(u32x4*)(dst + (size_t)r * pitch + hh * 64 + 32 * bj + 8 * fq) = w; }
                }
            if (isk) {
                const int b = u.pm >> 4, blk = u.pm & 15;
                float* km = (float*)(ws + WS_KMEAN) + ((size_t)(b * NH + hh) * 16 + blk) * 64;
#pragma unroll
                for (int bj = 0; bj < 2; ++bj)
#pragma unroll
                    for (int n = 0; n < 2; ++n)
#pragma unroll
                        for (int e = 0; e < 4; ++e) { float s = cs_[bj][n][e]; s += __shfl_xor(s, 1); s += __shfl_xor(s, 2); s += __shfl_xor(s, 4); s += __shfl_xor(s, 8);
                            if (fr == 0) atomicAdd(km + 32 * bj + 8 * fq + 4 * n + e, s * (1.f / 256.f)); }
            }
        } else if (pn >= 6 && pn < 10) {
            bf16_t* dst = (bf16_t*)(ws + WS_U);
#pragma unroll
            for (int ai = 0; ai < 2; ++ai)
#pragma unroll
                for (int m = 0; m < 4; ++m) { const int r = row0 + 128 * ai + 16 * m;
                    const f32x4 a = acc[ai][0][m][0] * acc[ai][1][m][0], b = acc[ai][0][m][1] * acc[ai][1][m][1]; u32x4 w;
                    w.x = pk2(a.x, a.y); w.y = pk2(a.z, a.w); w.z = pk2(b.x, b.y); w.w = pk2(b.z, b.w);
                    *(u32x4*)(dst + (size_t)r * 512 + 128 * (pn - 6) + 32 * wc + 8 * fq) = w; }
        } else {
            bf16_t* dst; int pitch, c0; bool sig = false;
            if (pn < 6) { dst = (bf16_t*)(ws + WS_V); pitch = 512; c0 = 256 * (pn - 4); }
            else if (pn < 12) { dst = (bf16_t*)(ws + WS_BG); pitch = 512; c0 = 256 * (pn - 10); }
            else { dst = (bf16_t*)(ws + WS_GATES); pitch = 2048; c0 = 256 * (pn - 12); sig = true; }
#pragma unroll
            for (int ai = 0; ai < 2; ++ai)
#pragma unroll
                for (int m = 0; m < 4; ++m) { const int r = row0 + 128 * ai + 16 * m;
#pragma unroll
                    for (int bj = 0; bj < 2; ++bj) { f32x4 a = acc[ai][bj][m][0], b = acc[ai][bj][m][1];
                        if (sig) {
#pragma unroll
                            for (int e = 0; e < 4; ++e) { a[e] = __builtin_amdgcn_rcpf(1.f + __expf(-a[e])); b[e] = __builtin_amdgcn_rcpf(1.f + __expf(-b[e])); } }
                        u32x4 w; w.x = pk2(a.x, a.y); w.y = pk2(a.z, a.w); w.z = pk2(b.x, b.y); w.w = pk2(b.z, b.w);
                        *(u32x4*)(dst + (size_t)r * pitch + c0 + 128 * bj + 32 * wc + 8 * fq) = w; } }
        }
    }
};
__device__ __forceinline__ void s2_fast(Frame& F) {
    const pg8::DenseSched Sd{(const char*)(F.ws + WS_H), (const char*)(F.ws + WS_WIN_T), T / 256, NIN / 256, 1024, F.G, (int)blockIdx.x};
    const EpiG1 E{F.ws, F.g_q, F.g_k};
    pg8::gemm_phase<EpiG1, pg8::DenseSched>(F.lds, 1024, Sd, E);
}

constexpr float NEG_BIG = -1e30f;
__device__ __forceinline__ void s3_simple(Frame& F) {
    LAS float* tS = (LAS float*)F.lds;
    LAS bf16_t* Pb = (LAS bf16_t*)(F.lds + 16896);
    LAS bf16_t* Vt = (LAS bf16_t*)(F.lds + 16896 + 9216);
    LAS float* mrow = (LAS float*)(F.lds + 16896 + 18432);
    LAS float* lrow = mrow + 64; LAS float* arow_ = mrow + 128; LAS int* sel = (LAS int*)(mrow + 192); LAS int* um = sel + 64;
    bf16_t* YAB = WSP(bf16_t, WS_YAB); const bf16_t* Kb = WSP(bf16_t, WS_K); const bf16_t* Vb = WSP(bf16_t, WS_V);
    const float* kmean = WSP(float, WS_KMEAN);
    const int row = F.tid >> 3, seg = F.tid & 7, fr = F.lane & 15, fq = F.lane >> 4, rb = 16 * (F.wave & 3), cb = 32 * (F.wave >> 2);
    for (int it = blockIdx.x; it < NB * NH * 64; it += F.G) {
        const int qc = it & 63, h = (it >> 6) & 7, b = it >> 9, cur = qc >> 2, t0 = 64 * qc;
        const size_t tb = (size_t)b * S;
        if (F.tid < 64) {
            float q[64];
            const bf16_t* qp = YAB + (tb + t0 + F.tid) * 1024 + h * 64;
#pragma unroll
            for (int i = 0; i < 8; ++i) { float t8[8]; unpack8(*(const u32x4*)(qp + 8 * i), t8);
#pragma unroll
                for (int e = 0; e < 8; ++e) q[8 * i + e] = t8[e]; }
            float b0 = -INFINITY, b1 = -INFINITY, b2 = -INFINITY; int i0 = -1, i1 = -1, i2 = -1;
            for (int j = 0; j < cur; ++j) { const float* km = kmean + ((size_t)(b * NH + h) * 16 + j) * 64; float s = 0.f;
#pragma unroll
                for (int d = 0; d < 64; ++d) s += q[d] * km[d];
                if (s > b0) { b2 = b1; i2 = i1; b1 = b0; i1 = i0; b0 = s; i0 = j; } else if (s > b1) { b2 = b1; i2 = i1; b1 = s; i1 = j; } else if (s > b2) { b2 = s; i2 = j; } }
            int m = 0; if (i0 >= 0) m |= 1 << i0; if (i1 >= 0) m |= 1 << i1; if (i2 >= 0) m |= 1 << i2;
            sel[F.tid] = m; mrow[F.tid] = NEG_BIG; lrow[F.tid] = 0.f;
            int u = m;
#pragma unroll
            for (int o = 1; o < 64; o <<= 1) u |= __shfl_xor(u, o);
            if (F.tid == 0) um[0] = u;
        }
        __syncthreads();
        const int umask = um[0];
        f32x4 o0 = {0.f, 0.f, 0.f, 0.f}, o1 = {0.f, 0.f, 0.f, 0.f};
        const RowsLinear aq{YAB + (tb + t0) * 1024 + h * 64, 1024};
        for (int j = 0; j <= cur; ++j) {
            if (j < cur && !((umask >> j) & 1)) continue;
            const int nkt = (j == cur) ? ((qc & 3) + 1) : 4;
            for (int kt = 0; kt < nkt; ++kt) {
                const int kbase = 256 * j + 64 * kt;
                const RowsLinear bk{Kb + (tb + kbase) * 512 + h * 64, 512};
                sgemm_tile(tS, 64, aq, bk, F.wave, F.lane);
                { float vv[8]; unpack8(*(const u32x4*)(Vb + (tb + kbase + row) * 512 + h * 64 + 8 * seg), vv);
#pragma unroll
                    for (int e = 0; e < 8; ++e) Vt[(8 * seg + e) * 72 + row] = (bf16_t)f2bf(vv[e]); }
                __syncthreads();
                {
                    float s[8]; float mx = NEG_BIG;
                    const bool rowsel = (j == cur) || ((sel[row] >> j) & 1);
#pragma unroll
                    for (int e = 0; e < 8; ++e) { const int c = 8 * seg + e; float x = tS[row * 65 + c];
                        if (!rowsel || (j == cur && kbase + c > t0 + row)) x = NEG_BIG; s[e] = x; mx = fmaxf(mx, x); }
                    mx = fmaxf(mx, __shfl_xor(mx, 1)); mx = fmaxf(mx, __shfl_xor(mx, 2)); mx = fmaxf(mx, __shfl_xor(mx, 4));
                    const float mold = mrow[row], mnew = fmaxf(mold, mx);
                    float alpha = 1.f, ps = 0.f; float p[8];
                    if (mnew <= NEG_BIG) {
#pragma unroll
                        for (int e = 0; e < 8; ++e) p[e] = 0.f;
                    } else { alpha = exp2f(mold - mnew);
#pragma unroll
                        for (int e = 0; e < 8; ++e) { p[e] = (s[e] <= NEG_BIG) ? 0.f : exp2f(s[e] - mnew); ps += p[e]; } }
                    ps += __shfl_xor(ps, 1); ps += __shfl_xor(ps, 2); ps += __shfl_xor(ps, 4);
                    const float lold = lrow[row];
                    *(LAS u32x4*)(Pb + row * 72 + 8 * seg) = pack8(p);
                    if (seg == 0) { mrow[row] = mnew; lrow[row] = lold * alpha + ps; arow_[row] = alpha; }
                }
                __syncthreads();
                {
#pragma unroll
                    for (int r = 0; r < 4; ++r) { const float a = arow_[rb + fq * 4 + r]; o0[r] *= a; o1[r] *= a; }
#pragma unroll
                    for (int ks = 0; ks < 2; ++ks) {
                        const bf16x8 a = *(const LAS bf16x8*)(Pb + (rb + fr) * 72 + 32 * ks + 8 * fq);
                        const bf16x8 v0 = *(const LAS bf16x8*)(Vt + (cb + fr) * 72 + 32 * ks + 8 * fq);
                        const bf16x8 v1 = *(const LAS bf16x8*)(Vt + (cb + 16 + fr) * 72 + 32 * ks + 8 * fq);
                        o0 = __builtin_amdgcn_mfma_f32_16x16x32_bf16(a, v0, o0, 0, 0, 0);
                        o1 = __builtin_amdgcn_mfma_f32_16x16x32_bf16(a, v1, o1, 0, 0, 0);
                    }
                }
                __syncthreads();
            }
        }
#pragma unroll
        for (int r = 0; r < 4; ++r) { const float li = 1.f / lrow[rb + fq * 4 + r]; tS[(rb + fq * 4 + r) * 65 + cb + fr] = o0[r] * li; tS[(rb + fq * 4 + r) * 65 + cb + 16 + fr] = o1[r] * li; }
        __syncthreads();
        { float v[8];
#pragma unroll
            for (int e = 0; e < 8; ++e) v[e] = tS[row * 65 + 8 * seg + e];
            *(u32x4*)(YAB + (tb + t0 + row) * 1024 + h * 64 + 8 * seg) = pack8(v); }
        __syncthreads();
    }
    const bf16_t* U = WSP(bf16_t, WS_U); const bf16_t* BG = WSP(bf16_t, WS_BG);
    for (int i = blockIdx.x * NTHREADS + F.tid; i < T * 64; i += F.G * NTHREADS) {
        const int t = i >> 6, c0 = (i & 63) * 8, pos = t & (S - 1);
        float u0[8], u1[8], u2[8], bg[8], y[8];
        unpack8(*(const u32x4*)(U + (size_t)t * 512 + c0), u2); unpack8(*(const u32x4*)(BG + (size_t)t * 512 + c0), bg);
        if (pos >= 1) unpack8(*(const u32x4*)(U + (size_t)(t - 1) * 512 + c0), u1); else {
#pragma unroll
            for (int e = 0; e < 8; ++e) u1[e] = 0.f; }
        if (pos >= 2) unpack8(*(const u32x4*)(U + (size_t)(t - 2) * 512 + c0), u0); else {
#pragma unroll
            for (int e = 0; e < 8; ++e) u0[e] = 0.f; }
#pragma unroll
        for (int e = 0; e < 8; ++e) y[e] = bg[e] * (F.conv_w[c0 + e] * u0[e] + F.conv_w[512 + c0 + e] * u1[e] + F.conv_w[1024 + c0 + e] * u2[e] + F.conv_b[c0 + e]);
        *(u32x4*)(YAB + (size_t)t * 1024 + 512 + c0) = pack8(y);
    }
}

namespace attn_body {
using bf16x8 = __attribute__((ext_vector_type(8))) short;
using s16x4 = __attribute__((ext_vector_type(4))) short;
using f32x16 = __attribute__((ext_vector_type(16))) float;
using u32x4 = __attribute__((ext_vector_type(4))) unsigned;
constexpr int SEQ = 4096, D = 64, DMQ = 1024, DMK = 512;
constexpr int NW = 8, QBLK = 32, QB = QBLK * NW, KVBLK = 64;
constexpr float NEGB = -1e30f;
__device__ __forceinline__ int crow(int r, int hi) { return (r & 3) + 8 * (r >> 2) + 4 * hi; }
#define SBAR() __builtin_amdgcn_sched_barrier(0)
__device__ __forceinline__ void cmask(f32x16& p0, f32x16& p1, int jb, int qrel, int hi) {
  const float NEG = -INFINITY; int kb = 64 * jb + 4 * hi;
  #pragma unroll
  for (int r = 0; r < 16; ++r) { int kv = kb + (r & 3) + 8 * (r >> 2); if (kv > qrel) p0[r] = NEG; if (kv + 32 > qrel) p1[r] = NEG; }
}
constexpr int NSLOT = 3, SLOTB = 8192;
constexpr int LDS_K = 0, LDS_V = NSLOT * SLOTB, LDS_WS = 2 * NSLOT * SLOTB, LDS_OST = LDS_WS + NW * 128 * 4, LDS_BYTES_A = LDS_OST + NW * 4096;
__device__ __forceinline__ void glds16(const void* gsrc, unsigned lds_dst) { unsigned keep;
  asm volatile("s_mov_b32 %0, m0\n\ts_mov_b32 m0, %2\n\ts_nop 0\n\tglobal_load_lds_dwordx4 %1, off\n\ts_mov_b32 m0, %0" : "=&s"(keep) : "v"(gsrc), "s"(lds_dst) : "memory"); }
__device__ __forceinline__ float max3f(float a, float b, float c) { float r; asm("v_max3_f32 %0, %1, %2, %3" : "=v"(r) : "v"(a), "v"(b), "v"(c)); return r; }
__device__ __forceinline__ float max2f(float a, float b) { float r; asm("v_max_f32_e32 %0, %1, %2" : "=v"(r) : "v"(a), "v"(b)); return r; }
__device__ __forceinline__ float fadd_s(float a, float b) { float r; asm("v_add_f32_e32 %0, %1, %2" : "=v"(r) : "v"(a), "v"(b)); return r; }
__device__ __forceinline__ float fsub_s(float a, float b) { float r; asm("v_sub_f32_e32 %0, %1, %2" : "=v"(r) : "v"(a), "v"(b)); return r; }
typedef float f32x2_t __attribute__((ext_vector_type(2))); typedef __bf16 bf16x2_t __attribute__((ext_vector_type(2)));
__device__ __forceinline__ unsigned cvtpk_s(float lo, float hi) { f32x2_t v = {lo, hi}; bf16x2_t b = __builtin_convertvector(v, bf16x2_t); return __builtin_bit_cast(unsigned, b); }
#define WAIT_BAR(N) asm volatile("s_waitcnt vmcnt(" #N ") lgkmcnt(0)\n\ts_barrier" ::: "memory")
__device__ __forceinline__ void qkt(f32x16& p0, f32x16& p1, const char* Kslot, const bf16x8* qr, const f32x16& negm, int r32, int hi) {
  const char* kb = Kslot + hi * 1024 + r32 * 16;
  #pragma unroll
  for (int d0 = 0; d0 < 4; ++d0) {
    const bf16x8 b0 = *reinterpret_cast<const bf16x8*>(kb + d0 * 2048);
    const bf16x8 b1 = *reinterpret_cast<const bf16x8*>(kb + d0 * 2048 + 512);
    if (d0 == 0) { p0 = __builtin_amdgcn_mfma_f32_32x32x16_bf16(b0, qr[0], negm, 0, 0, 0); p1 = __builtin_amdgcn_mfma_f32_32x32x16_bf16(b1, qr[0], negm, 0, 0, 0); }
    else { p0 = __builtin_amdgcn_mfma_f32_32x32x16_bf16(b0, qr[d0], p0, 0, 0, 0); p1 = __builtin_amdgcn_mfma_f32_32x32x16_bf16(b1, qr[d0], p1, 0, 0, 0); } }
}
typedef __attribute__((address_space(3))) const char* lds_cptr;
typedef __attribute__((address_space(3))) char* lds_ptr;
typedef short v4i16_t __attribute__((ext_vector_type(4)));
__device__ __forceinline__ void kload8(bf16x8* kf, lds_cptr kp) {
  kf[0] = *(const __attribute__((address_space(3))) bf16x8*)(kp);        kf[1] = *(const __attribute__((address_space(3))) bf16x8*)(kp + 512);
  kf[2] = *(const __attribute__((address_space(3))) bf16x8*)(kp + 2048); kf[3] = *(const __attribute__((address_space(3))) bf16x8*)(kp + 2560);
  kf[4] = *(const __attribute__((address_space(3))) bf16x8*)(kp + 4096); kf[5] = *(const __attribute__((address_space(3))) bf16x8*)(kp + 4608);
  kf[6] = *(const __attribute__((address_space(3))) bf16x8*)(kp + 6144); kf[7] = *(const __attribute__((address_space(3))) bf16x8*)(kp + 6656);
}
__device__ __forceinline__ void kload2(bf16x8* kf, lds_cptr kp, int j) { kf[2 * j] = *(const __attribute__((address_space(3))) bf16x8*)(kp + j * 2048); kf[2 * j + 1] = *(const __attribute__((address_space(3))) bf16x8*)(kp + j * 2048 + 512); }
__device__ __forceinline__ s16x4 vtr(lds_cptr p) { return __builtin_bit_cast(s16x4, __builtin_amdgcn_ds_read_tr16_b64_v4i16((__attribute__((address_space(3))) v4i16_t*)p)); }
__device__ __forceinline__ float rowmax(const f32x16& p0, const f32x16& p1) {
  float a = max3f(p0[0], p0[1], p1[0]), b = max3f(p0[2], p0[3], p1[1]); a = max3f(a, p1[2], p1[3]);
  #pragma unroll
  for (int r = 4; r < 16; r += 4) { a = max3f(a, p0[r], p0[r + 1]); b = max3f(b, p0[r + 2], p0[r + 3]); a = max3f(a, p1[r], p1[r + 1]); b = max3f(b, p1[r + 2], p1[r + 3]); }
  const float m = max2f(a, b);
  auto rr = __builtin_amdgcn_permlane32_swap(__float_as_uint(m), __float_as_uint(m), false, false);
  return max2f(__uint_as_float(rr[0]), __uint_as_float(rr[1]));
}
__device__ __forceinline__ void pv(f32x16* o, int vb, bf16x8 pa0, bf16x8 pa1, bf16x8 pa2, bf16x8 pa3) {
  #pragma unroll
  for (int d0 = 0; d0 < 2; ++d0) { s16x4 lo[4], hi[4];
    #pragma unroll
    for (int ks = 0; ks < 4; ++ks) {
      asm volatile("ds_read_b64_tr_b16 %0,%1 offset:%c2" : "=&v"(lo[ks]) : "v"(vb), "i"(d0 * 4096 + ks * 1024) : "memory");
      asm volatile("ds_read_b64_tr_b16 %0,%1 offset:%c2" : "=&v"(hi[ks]) : "v"(vb), "i"(d0 * 4096 + ks * 1024 + 512) : "memory"); }
    asm volatile("s_waitcnt lgkmcnt(0)" ::: "memory"); SBAR();
    #define PK(k) (bf16x8){lo[k][0], lo[k][1], lo[k][2], lo[k][3], hi[k][0], hi[k][1], hi[k][2], hi[k][3]}
    o[d0] = __builtin_amdgcn_mfma_f32_32x32x16_bf16(pa0, PK(0), o[d0], 0, 0, 0);
    o[d0] = __builtin_amdgcn_mfma_f32_32x32x16_bf16(pa1, PK(1), o[d0], 0, 0, 0);
    o[d0] = __builtin_amdgcn_mfma_f32_32x32x16_bf16(pa2, PK(2), o[d0], 0, 0, 0);
    o[d0] = __builtin_amdgcn_mfma_f32_32x32x16_bf16(pa3, PK(3), o[d0], 0, 0, 0);
    #undef PK
  }
}
#define ATTN_STORE16(p, v) (*(u32x4*)(p) = (v))
template <int THRL> __device__ __forceinline__ void attn_unit(int b, int h, int qb, const bf16_t* QO, bf16_t* Ob, const bf16_t* __restrict__ K, const bf16_t* __restrict__ V, const float* __restrict__ kmean, char* shm) {
  int tid_ = threadIdx.x; asm volatile("" : "+v"(tid_));
  const int tid = tid_, lane = tid & 63, r32 = lane & 31, hi = lane >> 5; const int wid = __builtin_amdgcn_readfirstlane(tid >> 6);
  const long rowbase = (long)b * SEQ; const int q0 = qb * QB;
  const bf16_t* Qw = QO + (rowbase + q0 + wid * QBLK) * DMQ + h * D;
  const bf16_t* Kh = K + rowbase * DMK + h * D, *Vh = V + rowbase * DMK + h * D;
  const unsigned lds0 = (unsigned)(uintptr_t)shm;
  float* wsf = (float*)(shm + LDS_WS) + wid * 128;
  const bf16_t* ksrc = Kh + (long)lane * DMK + wid * 8;
  const bf16_t* vsrc = Vh + (long)(16 * (wid & 3) + (lane >> 2)) * DMK + (wid >> 2) * 32 + (lane & 3) * 8;
  const unsigned kdst = lds0 + LDS_K + wid * 1024, vdst = lds0 + LDS_V + wid * 1024;
  #define DMA_K(t, slot) glds16(ksrc + (long)(t) * KVBLK * DMK, (unsigned)__builtin_amdgcn_readfirstlane(kdst + (slot)))
  #define DMA_V(t, slot) glds16(vsrc + (long)(t) * KVBLK * DMK, (unsigned)__builtin_amdgcn_readfirstlane(vdst + (slot)))
  DMA_K(0, 0); DMA_V(0, 0); DMA_K(1, SLOTB);
  bf16x8 qr[4];
  #pragma unroll
  for (int d0 = 0; d0 < 4; ++d0) qr[d0] = *reinterpret_cast<const bf16x8*>(&Qw[(long)r32 * DMQ + d0 * 16 + hi * 8]);
  unsigned selm = 0u;
  if (qb > 0) {
    float* kmL = (float*)(shm + LDS_OST);
    const float* kmg = kmean + ((size_t)(b * 8 + h) * 16) * 64;
    for (int i = tid; i < qb * 64; i += 512) kmL[i] = kmg[i];
    asm volatile("s_waitcnt vmcnt(0) lgkmcnt(0)\n\ts_barrier" ::: "memory");
    float qf[32];
    #pragma unroll
    for (int d0 = 0; d0 < 4; ++d0)
      #pragma unroll
      for (int e = 0; e < 8; ++e) qf[8 * d0 + e] = __uint_as_float(((unsigned)(unsigned short)qr[d0][e]) << 16);
    float b0 = -INFINITY, b1 = -INFINITY, b2 = -INFINITY; int i0 = -1, i1 = -1, i2 = -1;
    for (int j = 0; j < qb; ++j) {
      const float* km = kmL + j * 64 + 8 * hi; float sc = 0.f;
      #pragma unroll
      for (int d0 = 0; d0 < 4; ++d0)
        #pragma unroll
        for (int e = 0; e < 8; ++e) sc += qf[8 * d0 + e] * km[16 * d0 + e];
      sc += __shfl_xor(sc, 32);
      if (sc > b0) { b2 = b1; i2 = i1; b1 = b0; i1 = i0; b0 = sc; i0 = j; } else if (sc > b1) { b2 = b1; i2 = i1; b1 = sc; i1 = j; } else if (sc > b2) { b2 = sc; i2 = j; }
    }
    if (i0 >= 0) selm |= 1u << i0; if (i1 >= 0) selm |= 1u << i1; if (i2 >= 0) selm |= 1u << i2;
    asm volatile("s_waitcnt lgkmcnt(0)\n\ts_barrier" ::: "memory");
  }
  if (hi == 0) ((unsigned*)wsf)[64 + r32] = selm;
  { const lds_ptr qst = (lds_ptr)shm + LDS_OST + wid * 4096 + lane * 16;
    #pragma unroll
    for (int d0 = 0; d0 < 4; ++d0) *(__attribute__((address_space(3))) bf16x8*)(qst + d0 * 1024) = qr[d0]; }
  #define SELROW(j) (((j) >= qb) || ((((const unsigned*)wsf)[64 + r32] >> (j)) & 1u))
  #define NEGM_SET(blk) do { const float nv_ = SELROW(blk) ? -mhat : NEGB; _Pragma("unroll") for (int r = 0; r < 16; ++r) negm[r] = nv_; asm volatile("" : "+v"(negm)); } while (0)
  const int vb0 = (int)(lds0 + LDS_V) + ((lane >> 4) & 1) * 32 + (lane & 3) * 8 + (4 * hi + ((lane & 15) >> 2)) * 64;
  const char* Kbase = shm + LDS_K; bf16x8 kf[8];
  const lds_cptr qp0 = (lds_cptr)shm + LDS_OST + wid * 4096 + lane * 16;
  const lds_cptr shm3 = (lds_cptr)shm; const lds_cptr kp0 = shm3 + LDS_K + hi * 1024 + r32 * 16; const lds_cptr vp0 = shm3 + LDS_V + ((lane >> 4) & 1) * 32 + (lane & 3) * 8 + (4 * hi + ((lane & 15) >> 2)) * 64;
  const int NT = (q0 + QB) / KVBLK;
  float mhat = 0.f, l_reg = 0.f; f32x16 o[2]; o[0] = f32x16{}; o[1] = f32x16{}; f32x16 negm;
  NEGM_SET(0);
  const int qrel = wid * QBLK + r32;
  #define CMASK(P0, P1, t) do { int jb_ = (t) - (NT - 4); if (jb_ >= 0) cmask(P0, P1, jb_, qrel, hi); } while (0)
  bool resc = false;
  #define START(P0, P1) do { const float rm = rowmax(P0, P1); resc = false; \
    { const float dl = SELROW(0) ? rm : 0.f; mhat = fadd_s(mhat, dl); \
      _Pragma("unroll") for (int r = 0; r < 16; ++r) { P0[r] = fsub_s(P0[r], dl); P1[r] = fsub_s(P1[r], dl); } \
      NEGM_SET(0); } \
    _Pragma("unroll") for (int r = 0; r < 16; ++r) P0[r] = __builtin_amdgcn_exp2f(P0[r]); } while (0)
  #define RESC() do { if (resc) { asm volatile("s_waitcnt lgkmcnt(0)" ::: "memory"); \
      _Pragma("unroll") for (int d_ = 0; d_ < 2; ++d_) _Pragma("unroll") for (int r = 0; r < 16; ++r) o[d_][r] *= wsf[crow(r, hi)]; } } while (0)
  f32x16 pA0, pA1, pB0, pB1;
  int sl_prev = 0, sl_cur = 0, sl_next = SLOTB;
  #define ROT() do { sl_prev = sl_cur; sl_cur = sl_next; sl_next = (sl_next == (NSLOT - 1) * SLOTB) ? 0 : sl_next + SLOTB; } while (0)
  DMA_K(2, 2 * SLOTB);
  WAIT_BAR(3);
  qkt(pA0, pA1, Kbase, qr, negm, r32, hi); asm volatile("s_nop 15\n\ts_nop 7" : "+v"(pA0), "+v"(pA1)); CMASK(pA0, pA1, 0);
  START(pA0, pA1);
  _Pragma("unroll") for (int r = 0; r < 16; ++r) pA1[r] = __builtin_amdgcn_exp2f(pA1[r]);
  WAIT_BAR(0);
  DMA_K(3, 0); DMA_V(1, SLOTB);
  ROT();
  kload8(kf, kp0 + sl_cur);
  WAIT_BAR(2);
  s16x4 vlo[8], vhi[8]; u32x4 pw0, pw1, pw2, pw3; bf16x8 q0_, q1_, q2_, q3_;
  #define QRD(d) do { q##d##_ = *(const __attribute__((address_space(3))) bf16x8*)(qp0 + (d) * 1024); } while (0)
  QRD(0); QRD(1);
  #define PKW(P, B) cvtpk_s(P[B], P[B + 1])
  #define PAF(k) __builtin_bit_cast(bf16x8, pw##k)
  #define VFR(i) (bf16x8){vlo[i][0], vlo[i][1], vlo[i][2], vlo[i][3], vhi[i][0], vhi[i][1], vhi[i][2], vhi[i][3]}
  #define PIN(x) asm volatile("" : "+v"(x))
  #define MX3(a, b, c) __builtin_fmaxf(__builtin_fmaxf((a), (b)), (c))
  #define GAPA(MF, A0, A1, A2, A3, W0, W1, PW) do { MF; sacc += A0; sacc += A1; sacc += A2; sacc += A3; PIN(sacc); W0; W1; PIN(PW); SBAR(); } while (0)
  #define EX(v) __builtin_amdgcn_exp2f(v)
  #define GAPB(MF, X, B) do { MF; X[B] = EX(X[B]); X[B + 1] = EX(X[B + 1]); X[B + 2] = EX(X[B + 2]); X[B + 3] = EX(X[B + 3]); PIN(X); SBAR(); } while (0)
  #define VRD(i) do { vlo[i] = vtr(vp_ + (((i) >> 2) * 4096 + ((i) & 3) * 1024)); vhi[i] = vtr(vp_ + (((i) >> 2) * 4096 + ((i) & 3) * 1024 + 512)); } while (0)
  #define KRD(G, j) do { if (G) { kload2(kf, kp0 + sl_next, j); SBAR(); } } while (0)
  #define STEP(C0, C1, P0, P1, t, GK, GV, GL) do { SBAR(); \
    const lds_cptr vp_ = vp0 + sl_prev; \
    VRD(0); SBAR(); float sacc = (P0[0] + P0[1]); \
    GAPA(C0 = __builtin_amdgcn_mfma_f32_32x32x16_bf16(kf[0], q0_, negm, 0, 0, 0), P0[2], P0[3], P0[4], P0[5],     pw0[0] = PKW(P0, 0), pw0[1] = PKW(P0, 2), pw0); \
    VRD(4); SBAR(); GAPA(C1 = __builtin_amdgcn_mfma_f32_32x32x16_bf16(kf[1], q0_, negm, 0, 0, 0), P0[6], P0[7], P0[8], P0[9],     pw0[2] = PKW(P0, 4), pw0[3] = PKW(P0, 6), pw0); \
    QRD(2); SBAR(); \
    VRD(1); SBAR(); GAPA(C0 = __builtin_amdgcn_mfma_f32_32x32x16_bf16(kf[2], q1_, C0, 0, 0, 0),   P0[10], P0[11], P0[12], P0[13], pw1[0] = PKW(P0, 8), pw1[1] = PKW(P0, 10), pw1); \
    VRD(5); SBAR(); GAPA(C1 = __builtin_amdgcn_mfma_f32_32x32x16_bf16(kf[3], q1_, C1, 0, 0, 0),   P0[14], P0[15], P1[0], P1[1],   pw1[2] = PKW(P0, 12), pw1[3] = PKW(P0, 14), pw1); \
    QRD(3); SBAR(); \
    VRD(2); SBAR(); GAPA(C0 = __builtin_amdgcn_mfma_f32_32x32x16_bf16(kf[4], q2_, C0, 0, 0, 0),   P1[2], P1[3], P1[4], P1[5],     pw2[0] = PKW(P1, 0), pw2[1] = PKW(P1, 2), pw2); \
    VRD(6); SBAR(); GAPA(C1 = __builtin_amdgcn_mfma_f32_32x32x16_bf16(kf[5], q2_, C1, 0, 0, 0),   P1[6], P1[7], P1[8], P1[9],     pw2[2] = PKW(P1, 4), pw2[3] = PKW(P1, 6), pw2); \
    VRD(3); SBAR(); GAPA(C0 = __builtin_amdgcn_mfma_f32_32x32x16_bf16(kf[6], q3_, C0, 0, 0, 0),   P1[10], P1[11], P1[12], P1[13], pw3[0] = PKW(P1, 8), pw3[1] = PKW(P1, 10), pw3); \
    VRD(7); SBAR(); GAPA(C1 = __builtin_amdgcn_mfma_f32_32x32x16_bf16(kf[7], q3_, C1, 0, 0, 0),   P1[14], P1[15], 0.f, 0.f,       pw3[2] = PKW(P1, 12), pw3[3] = PKW(P1, 14), pw3); \
    l_reg += sacc; \
    if (GK) { DMA_K((t) + 3, sl_cur); } if (GV) { DMA_V((t) + 1, sl_next); } \
    CMASK(C0, C1, t); \
    { float a = MX3(C0[0], C0[1], C1[0]), b = MX3(C0[2], C0[3], C1[1]); a = MX3(a, C1[2], C1[3]); \
      _Pragma("unroll") for (int r = 4; r < 16; r += 4) { a = MX3(a, C0[r], C0[r + 1]); b = MX3(b, C0[r + 2], C0[r + 3]); a = MX3(a, C1[r], C1[r + 1]); b = MX3(b, C1[r + 2], C1[r + 3]); } \
      float rm = __builtin_fmaxf(a, b); { auto rr = __builtin_amdgcn_permlane32_swap(__float_as_uint(rm), __float_as_uint(rm), false, false); rm = __builtin_fmaxf(__uint_as_float(rr[0]), __uint_as_float(rr[1])); } \
      resc = false; \
      if (__builtin_expect(__any(rm > (float)THRL), 0)) { const float dl = __builtin_fmaxf(rm, 0.f); mhat += dl; \
        _Pragma("unroll") for (int r = 0; r < 16; ++r) { C0[r] -= dl; C1[r] -= dl; } \
        NEGM_SET(((t) + 1) >> 2); \
        const float f = __builtin_amdgcn_exp2f(-dl); l_reg *= f; if (hi == 0) wsf[r32] = f; resc = true; } \
      else if ((((t) + 1) & 3) == 0) { NEGM_SET(((t) + 1) >> 2); } } \
    SBAR(); \
    GAPB(o[0] = __builtin_amdgcn_mfma_f32_32x32x16_bf16(PAF(0), VFR(0), o[0], 0, 0, 0), C0, 0); \
    GAPB(o[1] = __builtin_amdgcn_mfma_f32_32x32x16_bf16(PAF(0), VFR(4), o[1], 0, 0, 0), C0, 4); \
    KRD(GL, 0); GAPB(o[0] = __builtin_amdgcn_mfma_f32_32x32x16_bf16(PAF(1), VFR(1), o[0], 0, 0, 0), C0, 8); \
    KRD(GL, 1); GAPB(o[1] = __builtin_amdgcn_mfma_f32_32x32x16_bf16(PAF(1), VFR(5), o[1], 0, 0, 0), C0, 12); \
    KRD(GL, 2); GAPB(o[0] = __builtin_amdgcn_mfma_f32_32x32x16_bf16(PAF(2), VFR(2), o[0], 0, 0, 0), C1, 0); \
    KRD(GL, 3); GAPB(o[1] = __builtin_amdgcn_mfma_f32_32x32x16_bf16(PAF(2), VFR(6), o[1], 0, 0, 0), C1, 4); \
    GAPB(o[0] = __builtin_amdgcn_mfma_f32_32x32x16_bf16(PAF(3), VFR(3), o[0], 0, 0, 0), C1, 8); \
    GAPB(o[1] = __builtin_amdgcn_mfma_f32_32x32x16_bf16(PAF(3), VFR(7), o[1], 0, 0, 0), C1, 12); \
    QRD(0); QRD(1); SBAR(); \
    } while (0)
  int t = 1;
  #undef CMASK
  #define CMASK(P0, P1, t) do {} while (0)
  for (; t + 5 < NT; t += 2) {
    STEP(pB0, pB1, pA0, pA1, t, true, true, true);     WAIT_BAR(2); RESC(); ROT();
    STEP(pA0, pA1, pB0, pB1, t + 1, true, true, true); WAIT_BAR(2); RESC(); ROT();
  }
  #undef CMASK
  #define CMASK(P0, P1, t) do { int jb_ = (t) - (NT - 4); if (jb_ >= 0) cmask(P0, P1, jb_, qrel, hi); } while (0)
  #define ENDW(tt) do { if ((tt) + 3 < NT) { WAIT_BAR(2); } else if ((tt) + 2 < NT) { WAIT_BAR(1); } else { WAIT_BAR(0); } } while (0)
  for (; t + 1 < NT; t += 2) {
    STEP(pB0, pB1, pA0, pA1, t, (t + 3 < NT), (t + 1 < NT), (t + 1 < NT));       ENDW(t);     RESC(); ROT();
    STEP(pA0, pA1, pB0, pB1, t + 1, (t + 4 < NT), (t + 2 < NT), (t + 2 < NT));   ENDW(t + 1); RESC(); ROT();
  }
  STEP(pB0, pB1, pA0, pA1, NT - 1, false, false, false); RESC();
  { float sacc = pB0[0] + pB0[1]; _Pragma("unroll") for (int r = 2; r < 16; ++r) sacc += pB0[r]; _Pragma("unroll") for (int r = 0; r < 16; ++r) sacc += pB1[r]; l_reg += sacc;
    pw0 = (u32x4){PKW(pB0, 0), PKW(pB0, 2), PKW(pB0, 4), PKW(pB0, 6)}; pw1 = (u32x4){PKW(pB0, 8), PKW(pB0, 10), PKW(pB0, 12), PKW(pB0, 14)}; pw2 = (u32x4){PKW(pB1, 0), PKW(pB1, 2), PKW(pB1, 4), PKW(pB1, 6)}; pw3 = (u32x4){PKW(pB1, 8), PKW(pB1, 10), PKW(pB1, 12), PKW(pB1, 14)};
    SBAR(); pv(o, vb0 + sl_cur, PAF(0), PAF(1), PAF(2), PAF(3)); }
  #undef PKW
  #undef PAF
  #undef VFR
  #undef PIN
  #undef MX3
  #undef GAPA
  #undef GAPB
  #undef EX
  #undef VRD
  #undef KRD
  #undef QRD
  #undef STEP
  #undef ENDW
  { auto rr = __builtin_amdgcn_permlane32_swap(__float_as_uint(l_reg), __float_as_uint(l_reg), false, false); l_reg = __uint_as_float(rr[0]) + __uint_as_float(rr[1]); }
  if (hi == 0) wsf[32 + r32] = l_reg; asm volatile("s_waitcnt lgkmcnt(0)" ::: "memory");
  float rli[16];
  #pragma unroll
  for (int r = 0; r < 16; ++r) rli[r] = __builtin_amdgcn_rcpf(wsf[32 + crow(r, hi)]);
  bf16_t* Ow = Ob + (rowbase + q0 + wid * QBLK) * DMQ + h * D;
  { bf16_t* stg = (bf16_t*)(shm + LDS_OST) + wid * 2048;
    #pragma unroll
    for (int r = 0; r < 16; ++r) { const int orow = crow(r, hi);
      #pragma unroll
      for (int d0 = 0; d0 < 2; ++d0) stg[orow * 64 + d0 * 32 + r32] = (bf16_t)f2bf(o[d0][r] * rli[r]); }
    asm volatile("s_waitcnt lgkmcnt(0)" ::: "memory");
    #pragma unroll
    for (int i = 0; i < 4; ++i) { const int row = i * 8 + (lane >> 3), ch = lane & 7; const u32x4 v = *(const u32x4*)(stg + row * 64 + ch * 8); ATTN_STORE16(Ow + (long)row * DMQ + ch * 8, v); } }
  asm volatile("s_waitcnt lgkmcnt(0)\n\ts_barrier" ::: "memory");
  #undef DMA_K
  #undef DMA_V
  #undef CMASK
  #undef START
  #undef RESC
  #undef ROT
  #undef SELROW
  #undef NEGM_SET
}
#undef SBAR
#undef WAIT_BAR
}
__device__ __forceinline__ void conv_pass(Frame& F) {
    bf16_t* YAB = WSP(bf16_t, WS_YAB); const bf16_t* U = WSP(bf16_t, WS_U); const bf16_t* BG = WSP(bf16_t, WS_BG);
    for (int i = blockIdx.x * NTHREADS + F.tid; i < T * 64; i += F.G * NTHREADS) {
        const int t = i >> 6, c0 = (i & 63) * 8, pos = t & (S - 1);
        float u0[8], u1[8], u2[8], bg[8], y[8];
        unpack8(*(const u32x4*)(U + (size_t)t * 512 + c0), u2); unpack8(*(const u32x4*)(BG + (size_t)t * 512 + c0), bg);
        if (pos >= 1) unpack8(*(const u32x4*)(U + (size_t)(t - 1) * 512 + c0), u1); else {
#pragma unroll
            for (int e = 0; e < 8; ++e) u1[e] = 0.f; }
        if (pos >= 2) unpack8(*(const u32x4*)(U + (size_t)(t - 2) * 512 + c0), u0); else {
#pragma unroll
            for (int e = 0; e < 8; ++e) u0[e] = 0.f; }
#pragma unroll
        for (int e4 = 0; e4 < 2; ++e4) { const f32x4 w0 = *(const f32x4*)(F.conv_w + c0 + 4 * e4), w1 = *(const f32x4*)(F.conv_w + 512 + c0 + 4 * e4), w2 = *(const f32x4*)(F.conv_w + 1024 + c0 + 4 * e4), cb = *(const f32x4*)(F.conv_b + c0 + 4 * e4);
#pragma unroll
            for (int e = 0; e < 4; ++e) y[4 * e4 + e] = bg[4 * e4 + e] * (w0[e] * u0[4 * e4 + e] + w1[e] * u1[4 * e4 + e] + w2[e] * u2[4 * e4 + e] + cb[e]); }
        *(u32x4*)(YAB + (size_t)t * 1024 + 512 + c0) = pack8(y);
    }
}
__device__ __forceinline__ void s3_attn(Frame& F, char* lds_gen, bf16_t* obase) {
    const int vcu = (blockIdx.x % 8) * (F.G / 8) + blockIdx.x / 8;
    const int s = vcu & 7, pr = vcu >> 3;
    for (int i = 0; i < 4; ++i) {
        const int bh = 2 * pr + (i >> 1), qb = (i & 1) ? 15 - s : s;
        attn_body::attn_unit<8>(bh >> 3, bh & 7, qb, WSP(bf16_t, WS_YAB), obase, WSP(bf16_t, WS_K), WSP(bf16_t, WS_V), WSP(float, WS_KMEAN), lds_gen);
    }
}
__device__ __forceinline__ void s3_fast(Frame& F, char* lds_gen) { s3_attn(F, lds_gen, WSP(bf16_t, WS_YAB)); conv_pass(F); }

__device__ __forceinline__ void s4_simple(Frame& F) {
    LAS float* tile = (LAS float*)F.lds; LAS float* tile2 = tile + 64 * 65;
    const bf16_t* YAB = WSP(bf16_t, WS_YAB); const bf16_t* WP = WSP(bf16_t, WS_WP_T); const bf16_t* GT = WSP(bf16_t, WS_GATES);
    const int row = F.tid >> 3, seg = F.tid & 7;
    for (int it = blockIdx.x; it < 512 * 16; it += F.G) {
        const int rt = it >> 4, ct = it & 15, r0 = rt * 64, gr = r0 + row;
        const RowsLinear aa{YAB + (size_t)r0 * 1024, 1024}, ab{YAB + (size_t)r0 * 1024 + 512, 1024};
        const RowsLinear ba{WP + (size_t)(64 * ct) * 1024, 1024}, bb{WP + (size_t)(64 * ct) * 1024 + 512, 1024};
        sgemm_tile(tile, 512, aa, ba, F.wave, F.lane); sgemm_tile(tile2, 512, ab, bb, F.wave, F.lane); __syncthreads();
        float ga[8], gb[8], v[8];
        unpack8(*(const u32x4*)(GT + (size_t)gr * 2048 + 64 * ct + 8 * seg), ga); unpack8(*(const u32x4*)(GT + (size_t)gr * 2048 + 1024 + 64 * ct + 8 * seg), gb);
#pragma unroll
        for (int e = 0; e < 8; ++e) v[e] = ga[e] * tile[row * 65 + 8 * seg + e] + gb[e] * tile2[row * 65 + 8 * seg + e];
        *(u32x4*)(WSP(bf16_t, WS_H) + (size_t)gr * 1024 + 64 * ct + 8 * seg) = pack8(v);
        __syncthreads();
    }
}
__device__ __forceinline__ void s5_simple(Frame& F) {
    LAS float* tile = (LAS float*)F.lds;
    const bf16_t* MG = WSP(bf16_t, WS_H); const bf16_t* WO = WSP(bf16_t, WS_WO_T);
    const int row = F.tid >> 3, seg = F.tid & 7;
    for (int it = blockIdx.x; it < 512 * 16; it += F.G) {
        const int rt = it >> 4, ct = it & 15, r0 = rt * 64, gr = r0 + row, b = r0 / S;
        const RowsLinear aa{MG + (size_t)r0 * 1024, 1024}, bb{WO + (size_t)(64 * ct) * 1024, 1024};
        sgemm_tile(tile, 1024, aa, bb, F.wave, F.lane); __syncthreads();
        const float* ga1 = WSP(float, WS_MOD) + (size_t)b * NMOD + 2048 + 64 * ct + 8 * seg;
        const float* xr = F.x + (size_t)gr * D + 64 * ct + 8 * seg; float* orow = F.out + (size_t)gr * D + 64 * ct + 8 * seg;
#pragma unroll
        for (int e4 = 0; e4 < 2; ++e4) { const f32x4 xv = *(const f32x4*)(xr + 4 * e4), gv = *(const f32x4*)(ga1 + 4 * e4); f32x4 o;
#pragma unroll
            for (int e = 0; e < 4; ++e) o[e] = xv[e] + gv[e] * tile[row * 65 + 8 * seg + 4 * e4 + e];
            *(f32x4*)(orow + 4 * e4) = o; }
        __syncthreads();
    }
}

struct EpiG2 {
    static constexpr bool HAS_MID = true;
    const bf16_t* gates; bf16_t* merged;
    __device__ __forceinline__ void mid(Acc& acc, const pg8::Unit& u, int wr, int wc, int fr, int fq) const {
        int row0 = u.pm * 256 + wr * 64 + fr; const int c0 = u.pn * 256 + 32 * wc + 8 * fq; asm volatile("" : "+v"(row0));
#pragma unroll
        for (int ai = 0; ai < 2; ++ai)
#pragma unroll
            for (int m = 0; m < 4; ++m) { const bf16_t* gp = gates + (size_t)(row0 + 128 * ai + 16 * m) * 2048 + c0;
#pragma unroll
                for (int bj = 0; bj < 2; ++bj) { f32x4 a0, a1, b0, b1; unpack8v(*(const u32x4*)(gp + 128 * bj), a0, a1); unpack8v(*(const u32x4*)(gp + 1024 + 128 * bj), b0, b1);
#pragma unroll
                    for (int e = 0; e < 4; ++e) { acc[ai][bj][m][0][e] *= a0[e] * __builtin_amdgcn_rcpf(b0[e]); acc[ai][bj][m][1][e] *= a1[e] * __builtin_amdgcn_rcpf(b1[e]); }
 }
                asm volatile("" ::: "memory"); }
    }
    __device__ __forceinline__ void operator()(Acc& acc, const pg8::Unit& u, int wr, int wc, int fr, int fq) const {
        int row0 = u.pm * 256 + wr * 64 + fr; const int c0 = u.pn * 256 + 32 * wc + 8 * fq; asm volatile("" : "+v"(row0));
#pragma unroll
        for (int ai = 0; ai < 2; ++ai)
#pragma unroll
            for (int m = 0; m < 4; ++m) { const size_t r = (size_t)(row0 + 128 * ai + 16 * m);
#pragma unroll
                for (int bj = 0; bj < 2; ++bj) { f32x4 b0, b1; unpack8v(*(const u32x4*)(gates + r * 2048 + 1024 + c0 + 128 * bj), b0, b1);
                    *(u32x4*)(merged + r * 1024 + c0 + 128 * bj) = pack8v(acc[ai][bj][m][0] * b0, acc[ai][bj][m][1] * b1); }
                asm volatile("" ::: "memory"); }
    }
};
__device__ __forceinline__ void s4_fast(Frame& F) {
    const pg8::DenseSched Sd{(const char*)(F.ws + WS_YAB), (const char*)(F.ws + WS_WP_T), T / 256, 4, 1024, F.G, (int)blockIdx.x};
    const EpiG2 E{WSP(bf16_t, WS_GATES), WSP(bf16_t, WS_H)};
    pg8::gemm_phase<EpiG2, pg8::DenseSched>(F.lds, 1024, Sd, E);
}
struct EpiG3 {
    static constexpr bool HAS_MID = false;
    const float* x; float* out; const float* mod;
    __device__ __forceinline__ void mid(Acc&, const pg8::Unit&, int, int, int, int) const {}
    __device__ __forceinline__ void operator()(Acc& acc, const pg8::Unit& u, int wr, int wc, int fr, int fq) const {
        const int row0 = u.pm * 256 + wr * 64 + fr, c0 = u.pn * 256 + 32 * wc + 8 * fq, b = u.pm >> 4;
        f32x4 gv[2][2];
#pragma unroll
        for (int bj = 0; bj < 2; ++bj)
#pragma unroll
            for (int n = 0; n < 2; ++n) gv[bj][n] = *(const f32x4*)(mod + (size_t)b * NMOD + 2048 + c0 + 128 * bj + 4 * n);
#pragma unroll
        for (int ai = 0; ai < 2; ++ai)
#pragma unroll
            for (int m = 0; m < 4; ++m) { const size_t off = (size_t)(row0 + 128 * ai + 16 * m) * D + c0;
#pragma unroll
                for (int bj = 0; bj < 2; ++bj)
#pragma unroll
                    for (int n = 0; n < 2; ++n) { const f32x4 xv = *(const f32x4*)(x + off + 128 * bj + 4 * n); *(f32x4*)(out + off + 128 * bj + 4 * n) = xv + gv[bj][n] * acc[ai][bj][m][n]; }
                if (m & 1) asm volatile("" ::: "memory"); }
    }
};
__device__ __forceinline__ void s5_fast(Frame& F) {
    const pg8::DenseSched Sd{(const char*)(F.ws + WS_H), (const char*)(F.ws + WS_WO_T), T / 256, 4, 1024, F.G, (int)blockIdx.x};
    const EpiG3 E{F.x, F.out, WSP(float, WS_MOD)};
    pg8::gemm_phase<EpiG3, pg8::DenseSched>(F.lds, 1024, Sd, E);
}
struct MoeTab { const LAS int* cnt; const LAS int* tstart; const LAS int* tile_e; int nM; };
__device__ __forceinline__ MoeTab moe_table(Frame& F) {
    LAS int* cntL = (LAS int*)(F.lds + MISC_OFF + 1024); LAS int* ts = cntL + 32; LAS int* te = cntL + 96;
    if (F.tid < 32) cntL[F.tid] = (int)__hip_atomic_load(WSP(unsigned, WS_CTL) + CW_GCNT + 64 * F.tid, __ATOMIC_RELAXED, __HIP_MEMORY_SCOPE_AGENT);
    __syncthreads();
    if (F.tid == 0) { int pm = 0; for (int e = 0; e < 32; ++e) { ts[e] = pm; const int n = (cntL[e] + 255) >> 8; for (int i = 0; i < n; ++i) te[pm++] = e; } ts[32] = pm; }
    __syncthreads();
    return MoeTab{cntL, ts, te, ts[32]};
}
struct MoeUpSched {
    static constexpr bool GATHER = true;
    const char* h2; const char* w13; MoeTab tb; const int* linfo; int G, c;
    __device__ __forceinline__ bool next(int i, pg8::Unit& u) const { if (!pg8::static_unit(i, G, c, tb.nM, 4, u.pm, u.pn)) return false;
        u.e = tb.tile_e[u.pm]; u.rbase = (u.pm - tb.tstart[u.e]) * 256; u.a = h2; u.b = w13 + ((size_t)u.e * 1024 + 256 * u.pn) * 1024 * 2; return true; }
    __device__ __forceinline__ int row_index(const pg8::Unit& u, int r) const { const int rank = u.rbase + r; return rank < tb.cnt[u.e] ? (linfo[(size_t)u.e * 65536 + rank] >> 1) : 0; }
};
struct EpiUp {
    static constexpr bool HAS_MID = false;
    bf16_t* hid; const float* lw; const LAS int* cnt;
    __device__ __forceinline__ void mid(Acc&, const pg8::Unit&, int, int, int, int) const {}
    __device__ __forceinline__ void operator()(Acc& acc, const pg8::Unit& u, int wr, int wc, int fr, int fq) const {
        const int rl0 = wr * 64 + fr, c0 = u.pn * 128 + 32 * wc + 8 * fq, n_e = cnt[u.e];
#pragma unroll
        for (int ai = 0; ai < 2; ++ai)
#pragma unroll
            for (int m = 0; m < 4; ++m) { const int rl = rl0 + 128 * ai + 16 * m, rank = u.rbase + rl; const float wt = rank < n_e ? lw[(size_t)u.e * 65536 + rank] : 0.f; f32x4 o[2];
#pragma unroll
                for (int n = 0; n < 2; ++n)
#pragma unroll
                    for (int e = 0; e < 4; ++e) { const float a = acc[ai][0][m][n][e], c = acc[ai][1][m][n][e]; o[n][e] = a * __builtin_amdgcn_rcpf(1.f + __expf(-a)) * c * wt; }
                *(u32x4*)(hid + (size_t)(u.pm * 256 + rl) * 512 + c0) = pack8v(o[0], o[1]); }
    }
};
__device__ __forceinline__ void s8_fast(Frame& F) {
    const MoeTab tb = moe_table(F);
    const MoeUpSched Sd{(const char*)(F.ws + WS_H2), (const char*)(F.ws + WS_W13_T), tb, WSP(int, WS_LINFO), F.G, (int)blockIdx.x};
    const EpiUp E{WSP(bf16_t, WS_HID), WSP(float, WS_LW), tb.cnt};
    pg8::gemm_phase<EpiUp, MoeUpSched>(F.lds, 1024, Sd, E);
}
struct MoeDownSched {
    static constexpr bool GATHER = false;
    const char* hid; const char* w2; MoeTab tb; int G, c;
    __device__ __forceinline__ bool next(int i, pg8::Unit& u) const { if (!pg8::static_unit(i, G, c, tb.nM, 4, u.pm, u.pn)) return false;
        u.e = tb.tile_e[u.pm]; u.rbase = (u.pm - tb.tstart[u.e]) * 256; u.a = hid + (size_t)u.pm * 256 * 512 * 2; u.b = w2 + ((size_t)u.e * 1024 + 256 * u.pn) * 512 * 2; return true; }
    __device__ __forceinline__ int row_index(const pg8::Unit&, int) const { return 0; }
};
struct EpiDown {
    static constexpr bool HAS_MID = false;
    bf16_t* yslot; const int* linfo; const LAS int* cnt;
    __device__ __forceinline__ void mid(Acc&, const pg8::Unit&, int, int, int, int) const {}
    __device__ __forceinline__ void operator()(Acc& acc, const pg8::Unit& u, int wr, int wc, int fr, int fq) const {
        const int rl0 = wr * 64 + fr, c0 = u.pn * 256 + 32 * wc + 8 * fq, n_e = cnt[u.e];
#pragma unroll
        for (int ai = 0; ai < 2; ++ai)
#pragma unroll
            for (int m = 0; m < 4; ++m) { const int rank = u.rbase + rl0 + 128 * ai + 16 * m;
                if (rank < n_e) { const int info = linfo[(size_t)u.e * 65536 + rank];
#pragma unroll
                    for (int bj = 0; bj < 2; ++bj) *(u32x4*)(yslot + (size_t)info * 1024 + c0 + 128 * bj) = pack8v(acc[ai][bj][m][0], acc[ai][bj][m][1]); } }
    }
};
__device__ __forceinline__ void s9_fast(Frame& F) {
    const MoeTab tb = moe_table(F);
    const MoeDownSched Sd{(const char*)(F.ws + WS_HID), (const char*)(F.ws + WS_W2_T), tb, F.G, (int)blockIdx.x};
    const EpiDown E{WSP(bf16_t, WS_YSLOT), WSP(int, WS_LINFO), tb.cnt};
    pg8::gemm_phase<EpiDown, MoeDownSched>(F.lds, 512, Sd, E);
}

__device__ __forceinline__ void s6_router(Frame& F) {
    constexpr int WROW = 1032;
    LAS bf16_t* WT = (LAS bf16_t*)F.lds;
    LAS float* gsL = (LAS float*)(F.lds + 48 * WROW * 2);
    LAS float* shL = gsL + 1024;
    LAS float* biasL = shL + 1024;
    LAS float* lgt = biasL + 64;
    LAS int* cnt = (LAS int*)(F.lds + MISC_OFF + 256);
    LAS int* baseL = cnt + 32; LAS int* runL = cnt + 64; LAS int* eidL = cnt + 128; LAS float* ewL = (LAS float*)(cnt + 384);
    const int b = blockIdx.x >> 5;
    const float* mod = WSP(float, WS_MOD) + (size_t)b * NMOD;
    const float* W36 = WSP(float, WS_W36T);
    for (int i = F.tid; i < 36 * 256; i += NTHREADS) { const int jj = i >> 8, k4 = (i & 255) * 4; const f32x4 w = *(const f32x4*)(W36 + jj * 1024 + k4);
        u32x2 p; p.x = pk2(w.x, w.y); p.y = pk2(w.z, w.w); *(LAS u32x2*)(WT + jj * WROW + k4) = p; }
    for (int i = F.tid; i < 12 * 256; i += NTHREADS) { const int jj = 36 + (i >> 8), k4 = (i & 255) * 4; *(LAS u32x2*)(WT + jj * WROW + k4) = (u32x2){0u, 0u}; }
    if (F.tid < 256) { const int col = 4 * F.tid; const f32x4 g = *(const f32x4*)(F.g2 + col), s_ = *(const f32x4*)(mod + 4096 + col); *(LAS f32x4*)(gsL + col) = g * (s_ + 1.0f); *(LAS f32x4*)(shL + col) = *(const f32x4*)(mod + 3072 + col); }
    if (F.tid < 32) cnt[F.tid] = 0;
    __syncthreads();
    for (int jj = F.wave; jj < 36; jj += NWAVES) { float a = 0.f;
#pragma unroll
        for (int i = 0; i < 16; ++i) a += shL[F.lane + 64 * i] * W36[jj * 1024 + F.lane + 64 * i];
        a = wave_sum(a); if (F.lane == 0) biasL[jj] = a + ((jj < 4) ? F.b_rg[jj] : F.b_re[jj - 4]); }
    __syncthreads();
    const int fr = F.lane & 15, fq = F.lane >> 4, row0 = (blockIdx.x * NWAVES + F.wave) * 16, r = row0 + fr;
    const float* xr = F.out + (size_t)r * D + 8 * fq;
    f32x4 D0 = {0.f, 0.f, 0.f, 0.f}, D1 = D0, D2 = D0; float ss = 0.f;
    for (int kb = 0; kb < 4; ++kb) {
        f32x4 xa[8][2];
#pragma unroll
        for (int i = 0; i < 8; ++i) { xa[i][0] = *(const f32x4*)(xr + 32 * (8 * kb + i)); xa[i][1] = *(const f32x4*)(xr + 32 * (8 * kb + i) + 4); }
#pragma unroll
        for (int i = 0; i < 8; ++i) { const int k0 = 32 * (8 * kb + i) + 8 * fq;
            f32x4 a0 = xa[i][0], a1 = xa[i][1];
            ss += (a0.x * a0.x + a0.y * a0.y) + (a0.z * a0.z + a0.w * a0.w) + (a1.x * a1.x + a1.y * a1.y) + (a1.z * a1.z + a1.w * a1.w);
            a0 *= *(const LAS f32x4*)(gsL + k0); a1 *= *(const LAS f32x4*)(gsL + k0 + 4);
            const bf16x8 A = __builtin_bit_cast(bf16x8, pack8v(a0, a1));
            const bf16x8 B0 = *(const LAS bf16x8*)(WT + fr * WROW + k0), B1 = *(const LAS bf16x8*)(WT + (16 + fr) * WROW + k0), B2 = *(const LAS bf16x8*)(WT + (32 + fr) * WROW + k0);
            D0 = __builtin_amdgcn_mfma_f32_16x16x32_bf16(A, B0, D0, 0, 0, 0);
            D1 = __builtin_amdgcn_mfma_f32_16x16x32_bf16(A, B1, D1, 0, 0, 0);
            D2 = __builtin_amdgcn_mfma_f32_16x16x32_bf16(A, B2, D2, 0, 0, 0); }
    }
    ss += __shfl_xor(ss, 16); ss += __shfl_xor(ss, 32);
    const float rinv = rsqrtf(ss * (1.f / D) + EPS);
    {
        LAS float* lw = lgt + F.wave * 16 * 37;
#pragma unroll
        for (int reg = 0; reg < 4; ++reg) { const float rv = __shfl(rinv, 4 * fq + reg); const int tk = 4 * fq + reg;
            lw[tk * 37 + fr] = D0[reg] * rv + biasL[fr]; lw[tk * 37 + 16 + fr] = D1[reg] * rv + biasL[16 + fr];
            if (fr < 4) lw[tk * 37 + 32 + fr] = D2[reg] * rv + biasL[32 + fr]; }
    }
    {
        bf16_t* o = WSP(bf16_t, WS_H2) + (size_t)r * D + 8 * fq;
        for (int kb = 0; kb < 4; ++kb) {
            f32x4 xa[8][2];
#pragma unroll
            for (int i = 0; i < 8; ++i) { xa[i][0] = *(const f32x4*)(xr + 32 * (8 * kb + i)); xa[i][1] = *(const f32x4*)(xr + 32 * (8 * kb + i) + 4); }
#pragma unroll
            for (int i = 0; i < 8; ++i) { const int k0 = 32 * (8 * kb + i) + 8 * fq;
                const f32x4 h0 = xa[i][0] * rinv * *(const LAS f32x4*)(gsL + k0) + *(const LAS f32x4*)(shL + k0), h1 = xa[i][1] * rinv * *(const LAS f32x4*)(gsL + k0 + 4) + *(const LAS f32x4*)(shL + k0 + 4);
                *(u32x4*)(o + 32 * (8 * kb + i)) = pack8v(h0, h1); }
        }
    }
    if (F.lane < 16) {
        const int t = row0 + F.lane; const LAS float* lw = lgt + (F.wave * 16 + F.lane) * 37;
        float lg[36];
#pragma unroll
        for (int jj = 0; jj < 36; ++jj) lg[jj] = lw[jj];
        int gi = 0; float gm = lg[0];
#pragma unroll
        for (int i = 1; i < 4; ++i) if (lg[i] > gm) { gm = lg[i]; gi = i; }
        float den = 0.f;
#pragma unroll
        for (int i = 0; i < 4; ++i) den += __expf(lg[i] - gm);
        const float gw_ = 1.f / den;
        float v1 = -INFINITY, v2 = -INFINITY; int e1 = 0, e2 = 0;
#pragma unroll
        for (int i = 0; i < 8; ++i) { const float el = (gi == 0) ? lg[4 + i] : (gi == 1) ? lg[12 + i] : (gi == 2) ? lg[20 + i] : lg[28 + i];
            const bool c1 = el > v1, c2 = el > v2;
            v2 = c1 ? v1 : (c2 ? el : v2); e2 = c1 ? e1 : (c2 ? i : e2); v1 = c1 ? el : v1; e1 = c1 ? i : e1; }
        const float p1 = 1.f / (1.f + __expf(v2 - v1)), p2 = 1.f - p1;
        const int id1 = gi * 8 + e1, id2 = gi * 8 + e2;
        const int la = 2 * (F.wave * 16 + F.lane);
        eidL[la] = id1; eidL[la + 1] = id2; ewL[la] = p1 * gw_; ewL[la + 1] = p2 * gw_;
        lds_add(&cnt[id1], 1); lds_add(&cnt[id2], 1);
    }
    __syncthreads();
    if (F.tid < 32) { baseL[F.tid] = (int)__hip_atomic_fetch_add(WSP(unsigned, WS_CTL) + CW_GCNT + 64 * F.tid, (unsigned)cnt[F.tid], __ATOMIC_RELAXED, __HIP_MEMORY_SCOPE_AGENT); runL[F.tid] = 0; }
    __syncthreads();
    if (F.tid < 256) { const int e = eidL[F.tid]; const int pos = baseL[e] + lds_add(&runL[e], 1);
        WSP(int, WS_LINFO)[(size_t)e * 65536 + pos] = 2 * (blockIdx.x * 128) + F.tid; WSP(float, WS_LW)[(size_t)e * 65536 + pos] = ewL[F.tid]; }
}

__device__ __forceinline__ void s7_lists(Frame& F) {
    LAS int* sm = (LAS int*)F.lds;
    const int* bc = WSP(int, WS_BCNT);
    if (F.tid < 32) { int tot = 0, base = 0; for (int bb = 0; bb < 256; ++bb) { const int c = bc[bb * 32 + F.tid]; if (bb < (int)blockIdx.x) base += c; tot += c; }
        sm[F.tid] = tot; sm[32 + F.tid] = base; sm[96 + F.tid] = 0; }
    __syncthreads();
    if (F.tid == 0) { int ps = 0; for (int e = 0; e < 32; ++e) { sm[64 + e] = ps; ps += (sm[e] + 255) & ~255; }
        if (blockIdx.x == 0) { int* te = WSP(int, WS_TILEE); int pm = 0; for (int e = 0; e < 32; ++e) { const int n = (sm[e] + 255) >> 8; for (int i = 0; i < n; ++i) te[1 + pm++] = e; } te[0] = pm; } }
    __syncthreads();
    int* atok = WSP(int, WS_ATOK); int* ainfo = WSP(int, WS_AINFO); float* aw = WSP(float, WS_AW);
    if (F.tid < 256) { const int a = blockIdx.x * 256 + F.tid;
        const int e = WSP(int, WS_EID)[a]; const int rank = lds_add(&sm[96 + e], 1); const int pos = sm[64 + e] + sm[32 + e] + rank;
        atok[pos] = a >> 1; ainfo[pos] = a; aw[pos] = WSP(float, WS_EW)[a]; }
    if (blockIdx.x < 32) { const int e = blockIdx.x; const int lo = sm[64 + e] + sm[e], hi = sm[64 + e] + ((sm[e] + 255) & ~255);
        for (int p = lo + F.tid; p < hi; p += NTHREADS) { atok[p] = 0; ainfo[p] = -1; aw[p] = 0.f; } }
}

struct RowsGather { const bf16_t* base; const int* idx; __device__ __forceinline__ const bf16_t* operator()(int r) const { return base + (size_t)idx[r] * 1024; } };
__device__ __forceinline__ void s8_simple(Frame& F) {
    LAS float* tile = (LAS float*)F.lds; LAS float* tile2 = tile + 64 * 65;
    const int* te = WSP(int, WS_TILEE); const int nmt = te[0];
    const int row = F.tid >> 3, seg = F.tid & 7;
    for (int it = blockIdx.x; it < nmt * 4 * 8; it += F.G) {
        const int rt = it >> 3, ct = it & 7, e = te[1 + (rt >> 2)], pos0 = 64 * rt, hc = 64 * ct;
        const RowsGather ar{WSP(bf16_t, WS_H2), WSP(int, WS_ATOK) + pos0};
        const bf16_t* wb = WSP(bf16_t, WS_W13_T) + ((size_t)e * 1024 + 256 * (hc >> 7) + (hc & 127)) * 1024;
        const RowsLinear b1{wb, 1024}, b3{wb + (size_t)128 * 1024, 1024};
        sgemm_tile(tile, 1024, ar, b1, F.wave, F.lane); sgemm_tile(tile2, 1024, ar, b3, F.wave, F.lane); __syncthreads();
        const float wt = WSP(float, WS_AW)[pos0 + row]; float v[8];
#pragma unroll
        for (int e8 = 0; e8 < 8; ++e8) { const float a = tile[row * 65 + 8 * seg + e8], c = tile2[row * 65 + 8 * seg + e8]; v[e8] = (a / (1.f + __expf(-a))) * c * wt; }
        *(u32x4*)(WSP(bf16_t, WS_HID) + (size_t)(pos0 + row) * 512 + hc + 8 * seg) = pack8(v);
        __syncthreads();
    }
}
__device__ __forceinline__ void s9_simple(Frame& F) {
    LAS float* tile = (LAS float*)F.lds;
    const int* te = WSP(int, WS_TILEE); const int nmt = te[0];
    const int row = F.tid >> 3, seg = F.tid & 7;
    for (int it = blockIdx.x; it < nmt * 4 * 16; it += F.G) {
        const int rt = it >> 4, ct = it & 15, e = te[1 + (rt >> 2)], pos0 = 64 * rt;
        const RowsLinear ar{WSP(bf16_t, WS_HID) + (size_t)pos0 * 512, 512};
        const RowsLinear br{WSP(bf16_t, WS_W2_T) + ((size_t)e * 1024 + 64 * ct) * 512, 512};
        sgemm_tile(tile, 512, ar, br, F.wave, F.lane); __syncthreads();
        const int info = WSP(int, WS_AINFO)[pos0 + row];
        if (info >= 0) { float v[8];
#pragma unroll
            for (int e8 = 0; e8 < 8; ++e8) v[e8] = tile[row * 65 + 8 * seg + e8];
            *(u32x4*)(WSP(bf16_t, WS_YSLOT) + (size_t)info * 1024 + 64 * ct + 8 * seg) = pack8(v); }
        __syncthreads();
    }
}
__device__ __forceinline__ void s10_combine(Frame& F) {
    const bf16_t* Y = WSP(bf16_t, WS_YSLOT);
    for (int i = blockIdx.x * NTHREADS + F.tid; i < T * 128; i += F.G * NTHREADS) {
        const int t = i >> 7, c0 = (i & 127) * 8, b = t / S;
        float y0[8], y1[8]; unpack8(*(const u32x4*)(Y + (size_t)(2 * t) * 1024 + c0), y0); unpack8(*(const u32x4*)(Y + (size_t)(2 * t + 1) * 1024 + c0), y1);
        const float* ga2 = WSP(float, WS_MOD) + (size_t)b * NMOD + 5120 + c0; float* o = F.out + (size_t)t * D + c0;
#pragma unroll
        for (int e4 = 0; e4 < 2; ++e4) { f32x4 xv = *(const f32x4*)(o + 4 * e4); const f32x4 gv = *(const f32x4*)(ga2 + 4 * e4);
#pragma unroll
            for (int e = 0; e < 4; ++e) xv[e] += gv[e] * (y0[4 * e4 + e] + y1[4 * e4 + e]);
            *(f32x4*)(o + 4 * e4) = xv; }
    }
}

constexpr int N_PHASES = 11;
struct Args { const float* in[21]; float* out; unsigned char* ws; int ph_lo, ph_hi; };
__global__ void __launch_bounds__(NTHREADS, 2) mega_fwd(Args args) {
    extern __shared__ __attribute__((aligned(16))) unsigned char lds_raw[];
    Frame F;
    F.lds = (LAS unsigned char*)lds_raw;
    F.tid = threadIdx.x; F.lane = F.tid & 63; F.wave = __builtin_amdgcn_readfirstlane(F.tid >> 6); F.G = gridDim.x;
    F.x = args.in[0]; F.c = args.in[1]; F.w_ada = args.in[2]; F.b_ada = args.in[3]; F.g1 = args.in[4]; F.g2 = args.in[5]; F.w_in = args.in[6]; F.g_q = args.in[7]; F.g_k = args.in[8];
    F.conv_w = args.in[9]; F.conv_b = args.in[10]; F.w_pa = args.in[11]; F.w_pb = args.in[12]; F.w_o = args.in[13]; F.w_rg = args.in[14]; F.b_rg = args.in[15]; F.w_re = args.in[16]; F.b_re = args.in[17];
    F.w1 = args.in[18]; F.w3 = args.in[19]; F.w2 = args.in[20]; F.out = args.out; F.ws = args.ws;
    volatile LAS unsigned* MISC = (volatile LAS unsigned*)(F.lds + MISC_OFF);
    if (F.tid < 64) MISC[F.tid] = 0u;
    __syncthreads();
    XcdBarrier bar = xcd_barrier_post((unsigned*)(F.ws + WS_CTL) + CW_BAR, MISC + 8);
    const int lo = args.ph_lo, hi = args.ph_hi;
#ifndef REPEAT_MASK
#define REPEAT_MASK 0
#endif
#define PHASE(k, body) if (lo <= (k) && (k) < hi) { for (int rep_ = 0; rep_ < 1 + ((REPEAT_MASK >> (k)) & 1); ++rep_) { { int t_ = threadIdx.x; asm volatile("" : "+v"(t_)); F.tid = t_; F.lane = t_ & 63; } body; __syncthreads(); } if ((k) + 1 < hi) xcd_barrier(bar); }
    PHASE(0, s0_prologue(F); wait_mod(F); s1_norm1(F))
    PHASE(2, s2_fast(F))
    PHASE(3, s3_fast(F, (char*)lds_raw))
    PHASE(4, s4_fast(F))
    PHASE(5, s5_fast(F))
    PHASE(6, s6_router(F))
    PHASE(8, s8_fast(F))
    PHASE(9, s9_fast(F))
    PHASE(10, s10_combine(F))
#undef PHASE
}

extern "C" void kernel_launch(void* const* d_in, const int* in_sizes, int n_in, void* d_out, int out_size, void* d_ws, size_t ws_size, hipStream_t stream) {
    static int grid = 0;
    if (grid == 0) {
        if (n_in != 21 || in_sizes[0] != T * D || out_size != T * D || ws_size < WS_END) { fprintf(stderr, "kernel_launch: unexpected shapes (n_in %d, in0 %d, out %d, ws %zu); nothing launched\n", n_in, n_in > 0 ? in_sizes[0] : -1, out_size, ws_size); grid = -1; return; }
        int dev = 0, cus = 0, per_cu = 0;
        if (hipGetDevice(&dev) != hipSuccess || hipDeviceGetAttribute(&cus, hipDeviceAttributeMultiprocessorCount, dev) != hipSuccess) { grid = -1; return; }
        if (hipFuncSetAttribute((const void*)mega_fwd, hipFuncAttributeMaxDynamicSharedMemorySize, LDS_BYTES) != hipSuccess) { fprintf(stderr, "kernel_launch: hipFuncSetAttribute failed\n"); grid = -1; return; }
        if (hipOccupancyMaxActiveBlocksPerMultiprocessor(&per_cu, (const void*)mega_fwd, NTHREADS, LDS_BYTES) != hipSuccess || per_cu < 1) { fprintf(stderr, "kernel_launch: occupancy query says %d blocks per CU\n", per_cu); per_cu = 1; }
        (void)hipGetLastError();
        if (cus < 256) { fprintf(stderr, "kernel_launch: built for a 256-CU device, found %d CUs; nothing launched\n", cus); grid = -1; return; }
        grid = 256;
    }
    if (grid < 0) return;
    (void)hipMemsetAsync((char*)d_ws + WS_CTL, 0, CTL_ZERO_BYTES, stream);
    Args a{};
    for (int i = 0; i < 21; ++i) a.in[i] = (const float*)d_in[i];
    a.out = (float*)d_out; a.ws = (unsigned char*)d_ws; a.ph_lo = 0; a.ph_hi = N_PHASES;
    hipLaunchKernelGGL(mega_fwd, dim3(grid), dim3(NTHREADS), LDS_BYTES, stream, a);
}
```

```cpp
#include <hip/hip_runtime.h>
#include <hip/hip_bf16.h>
#include <cstdio>
#include <cstdint>

#define GAS __attribute__((address_space(1)))
#define LAS __attribute__((address_space(3)))
typedef unsigned short bf16_t;
typedef short bf16x8 __attribute__((ext_vector_type(8)));
typedef float f32x4 __attribute__((ext_vector_type(4)));
typedef unsigned u32x4 __attribute__((ext_vector_type(4)));
typedef unsigned u32x2 __attribute__((ext_vector_type(2)));

constexpr int T = 32768, D = 1024, NB = 8, S = 4096, NH = 8, DH = 64, NIN = 5120, NE = 32, DE = 512, NMOD = 6144;
constexpr int NTHREADS = 512, NWAVES = 8;
constexpr float EPS = 1e-6f;
constexpr float C2 = 0.125f * 1.4426950408889634f;
constexpr int MAX_MT = 288;
constexpr int NPAD = MAX_MT * 256;

constexpr size_t MiB = 1u << 20, KiB = 1024;
constexpr size_t WS_CTL = 0, CTL_ZERO_BYTES = 1 * MiB;
constexpr size_t WS_MOD = 1 * MiB;
constexpr size_t WS_ROPE = 1 * MiB + 256 * KiB;
constexpr size_t WS_KMEAN = 1 * MiB + 512 * KiB;
constexpr size_t WS_EID = 2 * MiB;
constexpr size_t WS_EW = 2 * MiB + 256 * KiB;
constexpr size_t WS_BCNT = 2 * MiB + 512 * KiB;
constexpr size_t WS_TILEE = 2 * MiB + 768 * KiB;
constexpr size_t WS_ATOK = 3 * MiB;
constexpr size_t WS_AINFO = 3 * MiB + 512 * KiB;
constexpr size_t WS_AW = 4 * MiB;
constexpr size_t WS_W36T = 5 * MiB;
constexpr size_t WS_WIN_T = 8 * MiB;
constexpr size_t WS_WP_T = 18 * MiB;
constexpr size_t WS_WO_T = 20 * MiB;
constexpr size_t WS_W13_T = 24 * MiB;
constexpr size_t WS_W2_T = 88 * MiB;
constexpr size_t WS_H = 120 * MiB;
constexpr size_t WS_YAB = 184 * MiB;
constexpr size_t WS_K = 248 * MiB;
constexpr size_t WS_V = 280 * MiB;
constexpr size_t WS_U = 312 * MiB;
constexpr size_t WS_BG = 344 * MiB;
constexpr size_t WS_GATES = 376 * MiB;
constexpr size_t WS_X1 = 184 * MiB;
constexpr size_t WS_H2 = 120 * MiB;
constexpr size_t WS_HID = 248 * MiB;
constexpr size_t WS_YSLOT = 320 * MiB;
constexpr size_t WS_LINFO = 448 * MiB;
constexpr size_t WS_LW = 456 * MiB;
constexpr size_t WS_END = 504 * MiB;
constexpr int CW_BAR = 4096, CW_MODCNT = 8192, CW_GCNT = 12288;

constexpr int LDS_BYTES = 159744;
constexpr int MISC_OFF = 147456;

__device__ __forceinline__ unsigned f2bf(float f) { unsigned u = __builtin_bit_cast(unsigned, f); return (u + 0x7fffu + ((u >> 16) & 1u)) >> 16; }
__device__ __forceinline__ float bf2f(unsigned h) { return __builtin_bit_cast(float, h << 16); }
__device__ __forceinline__ unsigned pk2(float lo, float hi) { return f2bf(lo) | (f2bf(hi) << 16); }
__device__ __forceinline__ void unpack8(const u32x4 w, float (&v)[8]) {
    v[0] = bf2f(w.x & 0xffffu); v[1] = bf2f(w.x >> 16); v[2] = bf2f(w.y & 0xffffu); v[3] = bf2f(w.y >> 16);
    v[4] = bf2f(w.z & 0xffffu); v[5] = bf2f(w.z >> 16); v[6] = bf2f(w.w & 0xffffu); v[7] = bf2f(w.w >> 16);
}
__device__ __forceinline__ u32x4 pack8(const float (&v)[8]) { u32x4 w; w.x = pk2(v[0], v[1]); w.y = pk2(v[2], v[3]); w.z = pk2(v[4], v[5]); w.w = pk2(v[6], v[7]); return w; }
__device__ __forceinline__ u32x4 pack8v(const f32x4 a, const f32x4 b) { u32x4 w; w.x = pk2(a.x, a.y); w.y = pk2(a.z, a.w); w.z = pk2(b.x, b.y); w.w = pk2(b.z, b.w); return w; }
__device__ __forceinline__ void unpack8v(const u32x4 w, f32x4& a, f32x4& b) {
    a.x = bf2f(w.x & 0xffffu); a.y = bf2f(w.x >> 16); a.z = bf2f(w.y & 0xffffu); a.w = bf2f(w.y >> 16);
    b.x = bf2f(w.z & 0xffffu); b.y = bf2f(w.z >> 16); b.z = bf2f(w.w & 0xffffu); b.w = bf2f(w.w >> 16); }
#ifndef WT_STORES
#define WT_STORES 0
#endif
__device__ __forceinline__ void st16(void* p, const u32x4 v) {
#if WT_STORES
    asm volatile("global_store_dwordx4 %0, %1, off sc1\n\ts_nop 1" :: "v"(p), "v"(v) : "memory");
#else
    *(u32x4*)p = v;
#endif
}
#define LDS_WAIT() asm volatile("s_waitcnt lgkmcnt(0)" ::: "memory")
__device__ __forceinline__ int lds_add(LAS int* p, int v) { return __hip_atomic_fetch_add(p, v, __ATOMIC_RELAXED, __HIP_MEMORY_SCOPE_WORKGROUP); }

#define XB_TMO      128
#define XB_XCNT(j)  (256  + 64 * (j))
#define XB_XSUB(j)  (1280 + 64 * (j))
#define XB_XGEN(j)  (2304 + 64 * (j))
#define XB_TOP      3328
#define XB_TOPGEN   3392
#define XCD_BAR_WORDS 3456
#define XB_SPIN_CAP (1u << 22)
__device__ __forceinline__ unsigned xb_ld(unsigned* p)              { return __hip_atomic_load(p, __ATOMIC_RELAXED, __HIP_MEMORY_SCOPE_AGENT); }
__device__ __forceinline__ unsigned xb_add(unsigned* p, unsigned v) { return __hip_atomic_fetch_add(p, v, __ATOMIC_RELAXED, __HIP_MEMORY_SCOPE_AGENT); }
__device__ __forceinline__ unsigned xb_xcc_id() { return (unsigned)__builtin_amdgcn_s_getreg((3 << 11) | 20) & 0xFu; }
#define XB_SPIN(cond, bar) do { unsigned _sp = 0; while (cond) { __builtin_amdgcn_s_sleep(1); \
    if ((++_sp & 255u) == 0u) { if (xb_ld(&(bar)[XB_TMO])) break; if (_sp > XB_SPIN_CAP) { atomicAdd(&(bar)[XB_TMO], 1u); break; } } } } while (0)
struct XcdBarrier { unsigned* bar; unsigned x; volatile LAS unsigned* st; };
__device__ __forceinline__ XcdBarrier xcd_barrier_post(unsigned* bar, volatile LAS unsigned* st) {
    XcdBarrier b; b.bar = bar; b.x = xb_xcc_id(); b.st = st;
    if (threadIdx.x == 0) (void)xb_add(&bar[XB_XCNT(b.x)], 1u);
    return b;
}
__device__ __forceinline__ void xcd_barrier_complete(unsigned* bar, unsigned x, unsigned& nloc, unsigned& nx) {
    const unsigned G = gridDim.x * gridDim.y * gridDim.z;
    unsigned sum, cnt, mine, sp = 0u;
    for (;;) {
        sum = 0u; cnt = 0u; mine = 0u;
#pragma unroll
        for (unsigned j = 0; j < 16; ++j) { const unsigned c = xb_ld(&bar[XB_XCNT(j)]); sum += c; cnt += (c > 0u) ? 1u : 0u; mine = (j == x) ? c : mine; }
        if (sum == G) break;
        __builtin_amdgcn_s_sleep(1);
        if ((++sp & 255u) == 0u) { if (xb_ld(&bar[XB_TMO])) break; if (sp > XB_SPIN_CAP) { atomicAdd(&bar[XB_TMO], 1u); break; } }
    }
    nloc = mine > 0u ? mine : 1u; nx = cnt > 0u ? cnt : 1u;
}
__device__ __forceinline__ void xcd_barrier(const XcdBarrier& b) {
    asm volatile("s_waitcnt vmcnt(0)" ::: "memory");
    __syncthreads();
    if (threadIdx.x == 0) {
        unsigned* bar = b.bar;
        __builtin_amdgcn_s_waitcnt(0);
        unsigned nloc = b.st[0], nx = b.st[1];
        if (nloc == 0u) { xcd_barrier_complete(bar, b.x, nloc, nx); b.st[0] = nloc; b.st[1] = nx; }
        const unsigned old = xb_add(&bar[XB_XSUB(b.x)], 1u);
        const unsigned gen = old / nloc;
        if (old + 1u == (gen + 1u) * nloc) {
            __builtin_amdgcn_fence(__ATOMIC_RELEASE, "agent");
            asm volatile("s_waitcnt vmcnt(0)" ::: "memory");
            const unsigned og = xb_add(&bar[XB_TOP], 1u);
            const unsigned tg = og / nx;
            if (og + 1u == (tg + 1u) * nx) xb_add(&bar[XB_TOPGEN], 1u);
            else XB_SPIN(xb_ld(&bar[XB_TOPGEN]) == tg, bar);
            __builtin_amdgcn_fence(__ATOMIC_ACQUIRE, "agent");
            xb_add(&bar[XB_XGEN(b.x)], 1u);
            asm volatile("s_waitcnt vmcnt(0)" ::: "memory");
        } else {
            XB_SPIN(xb_ld(&bar[XB_XGEN(b.x)]) == gen, bar);
            __builtin_amdgcn_fence(__ATOMIC_ACQUIRE, "agent");
            asm volatile("s_waitcnt vmcnt(0)" ::: "memory");
        }
    }
    __syncthreads();
}

struct Frame {
    LAS unsigned char* lds;
    int tid, lane, wave, G;
    const float *x, *c, *w_ada, *b_ada, *g1, *g2, *w_in, *g_q, *g_k, *conv_w, *conv_b, *w_pa, *w_pb, *w_o, *w_rg, *b_rg, *w_re, *b_re, *w1, *w3, *w2;
    float* out; unsigned char* ws;
};
#define WSP(type, off) ((type*)(F.ws + (off)))

__device__ __forceinline__ void transpose_item(const float* W, int N, int k0, int n0, bf16_t* dst  , int pitch, LAS float* scr, int lane) {
#pragma unroll 8
    for (int i = 0; i < 32; ++i) { const int kk = 2 * i + (lane >> 5); scr[kk * 33 + (lane & 31)] = W[(size_t)(k0 + kk) * N + n0 + (lane & 31)]; }
    LDS_WAIT(); asm volatile("" ::: "memory");
    const int c = lane & 7;
#pragma unroll
    for (int j = 0; j < 4; ++j) { const int n = (lane >> 3) + 8 * j; const LAS float* s = scr + (8 * c) * 33 + n;
        u32x4 o; o.x = pk2(s[0 * 33], s[1 * 33]); o.y = pk2(s[2 * 33], s[3 * 33]); o.z = pk2(s[4 * 33], s[5 * 33]); o.w = pk2(s[6 * 33], s[7 * 33]);
        st16(dst + (size_t)n * pitch + 8 * c, o); }
    LDS_WAIT(); asm volatile("" ::: "memory");
}
__device__ __forceinline__ int win_dest_row(int sc) {
    if (sc < 32) { const int isk = sc >> 4, s2 = sc & 15, hh = s2 >> 1, bj = s2 & 1; return 512 * isk + 256 * (hh >> 2) + 128 * bj + 32 * (hh & 3); }
    if (sc < 48) return 32 * sc;
    if (sc < 64) { const int cx = 32 * (sc - 48); return 256 * (6 + (cx >> 7)) + (cx & 127); }
    if (sc < 80) return 2560 + 32 * (sc - 64);
    if (sc < 96) { const int cx = 32 * (sc - 80); return 256 * (6 + (cx >> 7)) + 128 + (cx & 127); }
    return 3072 + 32 * (sc - 96);
}
__device__ __forceinline__ void s0_prologue(Frame& F) {
    const int gt = blockIdx.x * NTHREADS + F.tid;
    if (gt < NB * NH * 16 * 64) WSP(float, WS_KMEAN)[gt] = 0.f;
    if (gt < 36 * 1024) { const int jj = gt >> 10, k = gt & 1023; WSP(float, WS_W36T)[gt] = (jj < 4) ? F.w_rg[k * 4 + jj] : F.w_re[k * 32 + (jj - 4)]; }
    if (gt < S * 8) { const int pos = gt >> 3, i = gt & 7; const float inv = powf(500000.0f, -(float)(2 * i) / 16.0f); const float ang = (float)pos * inv;
        WSP(float2, WS_ROPE)[gt] = make_float2(cosf(ang), sinf(ang)); }
    if (blockIdx.x < 192) {
        LAS float* sc = (LAS float*)F.lds;
        for (int i = F.tid; i < NB * D; i += NTHREADS) { const float v = F.c[i]; sc[i] = v / (1.f + expf(-v)); }
        __syncthreads();
        const int j0 = blockIdx.x * 32, col = j0 + (F.lane & 31), kpar = F.lane >> 5;
        float acc[8];
#pragma unroll
        for (int b = 0; b < 8; ++b) acc[b] = 0.f;
        for (int i = 0; i < 64; ++i) { const int k = F.wave * 128 + 2 * i + kpar; const float w = F.w_ada[(size_t)k * NMOD + col];
#pragma unroll
            for (int b = 0; b < 8; ++b) acc[b] += sc[b * D + k] * w; }
#pragma unroll
        for (int b = 0; b < 8; ++b) acc[b] += __shfl_xor(acc[b], 32);
        LAS float* red = (LAS float*)(F.lds + 32768);
        if (F.lane < 32) {
#pragma unroll
            for (int b = 0; b < 8; ++b) red[(F.wave * 8 + b) * 32 + F.lane] = acc[b]; }
        __syncthreads();
        if (F.tid < 256) { const int b = F.tid >> 5, cc = F.tid & 31; float s = F.b_ada[j0 + cc];
#pragma unroll
            for (int w = 0; w < 8; ++w) s += red[(w * 8 + b) * 32 + cc];
            WSP(float, WS_MOD)[b * NMOD + j0 + cc] = s; }
        asm volatile("s_waitcnt vmcnt(0)" ::: "memory");
        __syncthreads();
        if (F.tid == 0) { __builtin_amdgcn_fence(__ATOMIC_RELEASE, "agent"); asm volatile("s_waitcnt vmcnt(0)" ::: "memory");
            __hip_atomic_fetch_add(WSP(unsigned, WS_CTL) + CW_MODCNT, 1u, __ATOMIC_RELAXED, __HIP_MEMORY_SCOPE_AGENT); }
    }
    LAS float* scr = (LAS float*)(F.lds + F.wave * 16384);
    const int gw = blockIdx.x * NWAVES + F.wave, NGW = F.G * NWAVES;
    constexpr int I_IN = 16 * 160, I_PA = 8 * 32, I_O = 16 * 32, I_E1 = 16 * 16, I_E2 = 8 * 32;
    constexpr int NITEMS = I_IN + 2 * I_PA + I_O + NE * (2 * I_E1 + I_E2);
    for (int it = gw; it < NITEMS; it += NGW) {
        int r = it;
        if (r < I_IN) { const int kb = r / 160, sc = r % 160; transpose_item(F.w_in, NIN, 64 * kb, 32 * sc, WSP(bf16_t, WS_WIN_T) + (size_t)win_dest_row(sc) * 1024 + 64 * kb, 1024, scr, F.lane); continue; } r -= I_IN;
        if (r < I_PA) { const int kb = r / 32, sc = r % 32; transpose_item(F.w_pa, 1024, 64 * kb, 32 * sc, WSP(bf16_t, WS_WP_T) + (size_t)(32 * sc) * 1024 + 64 * kb, 1024, scr, F.lane); continue; } r -= I_PA;
        if (r < I_PA) { const int kb = r / 32, sc = r % 32; transpose_item(F.w_pb, 1024, 64 * kb, 32 * sc, WSP(bf16_t, WS_WP_T) + (size_t)(32 * sc) * 1024 + 512 + 64 * kb, 1024, scr, F.lane); continue; } r -= I_PA;
        if (r < I_O) { const int kb = r / 32, sc = r % 32; transpose_item(F.w_o, 1024, 64 * kb, 32 * sc, WSP(bf16_t, WS_WO_T) + (size_t)(32 * sc) * 1024 + 64 * kb, 1024, scr, F.lane); continue; } r -= I_O;
        const int e = r / (2 * I_E1 + I_E2); r -= e * (2 * I_E1 + I_E2);
        if (r < 2 * I_E1) { const int is3 = r >= I_E1; if (is3) r -= I_E1; const int kb = r / 16, sc = r % 16;
            transpose_item((is3 ? F.w3 : F.w1) + (size_t)e * D * DE, DE, 64 * kb, 32 * sc, WSP(bf16_t, WS_W13_T) + ((size_t)e * 1024 + 256 * (sc >> 2) + 128 * is3 + 32 * (sc & 3)) * 1024 + 64 * kb, 1024, scr, F.lane); continue; }
        r -= 2 * I_E1;
        { const int kb = r / 32, sc = r % 32;
            transpose_item(F.w2 + (size_t)e * DE * D, D, 64 * kb, 32 * sc, WSP(bf16_t, WS_W2_T) + ((size_t)e * 1024 + 32 * sc) * 512 + 64 * kb, 512, scr, F.lane); }
    }
}

__device__ __forceinline__ void wait_mod(Frame& F) {
    if (F.tid == 0) { unsigned* c = WSP(unsigned, WS_CTL) + CW_MODCNT; unsigned sp = 0;
        while (__hip_atomic_load(c, __ATOMIC_RELAXED, __HIP_MEMORY_SCOPE_AGENT) < 192u) { __builtin_amdgcn_s_sleep(2); if (++sp > (1u << 24)) break; }
        __builtin_amdgcn_fence(__ATOMIC_ACQUIRE, "agent"); asm volatile("s_waitcnt vmcnt(0)" ::: "memory"); }
    __syncthreads();
}
template <int N> __device__ __forceinline__ float dpp_ror(float v) { return __builtin_bit_cast(float, __builtin_amdgcn_update_dpp(0, __builtin_bit_cast(int, v), 0x120 + N, 0xF, 0xF, false)); }
__device__ __forceinline__ float wave_sum(float v) {
#pragma unroll
    for (int o = 1; o < 64; o <<= 1) v += __shfl_xor(v, o);
    return v;
}
__device__ __forceinline__ void s1_norm1(Frame& F) {
    const int gw = blockIdx.x * NWAVES + F.wave;
    const int row0 = gw * 16, b = row0 / S;
    if (row0 >= T) return;
    const float* mod = WSP(float, WS_MOD) + (size_t)b * NMOD;
    f32x4 gs[4], sh[4];
#pragma unroll
    for (int j = 0; j < 4; ++j) { const int col = 4 * F.lane + 256 * j; const f32x4 g = *(const f32x4*)(F.g1 + col), s_ = *(const f32x4*)(mod + 1024 + col); gs[j] = g * (s_ + 1.0f); sh[j] = *(const f32x4*)(mod + col); }
    for (int r = 0; r < 16; r += 4) {
        f32x4 v[4][4]; float ss[4];
#pragma unroll
        for (int q = 0; q < 4; ++q) { const float* xr = F.x + (size_t)(row0 + r + q) * D;
#pragma unroll
            for (int j = 0; j < 4; ++j) v[q][j] = *(const f32x4*)(xr + 4 * F.lane + 256 * j); }
#pragma unroll
        for (int q = 0; q < 4; ++q) { ss[q] = 0.f;
#pragma unroll
            for (int j = 0; j < 4; ++j) ss[q] += (v[q][j].x * v[q][j].x + v[q][j].y * v[q][j].y) + (v[q][j].z * v[q][j].z + v[q][j].w * v[q][j].w); }
#pragma unroll
        for (int q = 0; q < 4; ++q) { const float rinv = rsqrtf(wave_sum(ss[q]) * (1.f / D) + EPS);
            bf16_t* o = WSP(bf16_t, WS_H) + (size_t)(row0 + r + q) * D;
#pragma unroll
            for (int j = 0; j < 4; ++j) { const f32x4 h = v[q][j] * rinv * gs[j] + sh[j]; u32x2 w; w.x = pk2(h.x, h.y); w.y = pk2(h.z, h.w); *(u32x2*)(o + 4 * F.lane + 256 * j) = w; } }
    }
}

struct RowsLinear { const bf16_t* base; size_t pitch; __device__ __forceinline__ const bf16_t* operator()(int r) const { return base + (size_t)r * pitch; } };
template <class AR, class BR>
__device__ __forceinline__ void sgemm_tile(LAS float* tile, int K, const AR& arow, const BR& brow, int wave, int lane) {
    const int fr = lane & 15, fq = lane >> 4, rb = 16 * (wave & 3), cb = 32 * (wave >> 2);
    const bf16_t* ap = arow(rb + fr) + 8 * fq;
    const bf16_t* bp0 = brow(cb + fr) + 8 * fq;
    const bf16_t* bp1 = brow(cb + 16 + fr) + 8 * fq;
    f32x4 acc0 = {0.f, 0.f, 0.f, 0.f}, acc1 = {0.f, 0.f, 0.f, 0.f};
#pragma unroll 4
    for (int k = 0; k < K; k += 32) {
        const bf16x8 a = *(const bf16x8*)(ap + k), b0 = *(const bf16x8*)(bp0 + k), b1 = *(const bf16x8*)(bp1 + k);
        acc0 = __builtin_amdgcn_mfma_f32_16x16x32_bf16(a, b0, acc0, 0, 0, 0);
        acc1 = __builtin_amdgcn_mfma_f32_16x16x32_bf16(a, b1, acc1, 0, 0, 0);
    }
#pragma unroll
    for (int j = 0; j < 4; ++j) { tile[(rb + fq * 4 + j) * 65 + cb + fr] = acc0[j]; tile[(rb + fq * 4 + j) * 65 + cb + 16 + fr] = acc1[j]; }
}

struct WinRowsHead { const bf16_t* base; int rb; __device__ __forceinline__ const bf16_t* operator()(int d) const { return base + (size_t)(rb + 128 * (d >> 5) + (d & 31)) * 1024; } };
__device__ __forceinline__ void s2_simple(Frame& F) {
    LAS float* tile = (LAS float*)F.lds; LAS float* tile2 = tile + 64 * 65;
    const bf16_t* H = WSP(bf16_t, WS_H); const bf16_t* WT = WSP(bf16_t, WS_WIN_T);
    const int row = F.tid >> 3, seg = F.tid & 7;
    for (int it = blockIdx.x; it < 512 * 72; it += F.G) {
        const int rt = it / 72, ct = it % 72, r0 = rt * 64, gr = r0 + row;
        const RowsLinear ar{H + (size_t)r0 * 1024, 1024};
        float v[8];
        if (ct < 16) {
            const int isk = ct >> 3, hh = ct & 7;
            const WinRowsHead br{WT, 512 * isk + 256 * (hh >> 2) + 32 * (hh & 3)};
            sgemm_tile(tile, 1024, ar, br, F.wave, F.lane); __syncthreads();
            float ss = 0.f;
#pragma unroll
            for (int e = 0; e < 8; ++e) { v[e] = tile[row * 65 + 8 * seg + e]; ss += v[e] * v[e]; }
            ss += __shfl_xor(ss, 1); ss += __shfl_xor(ss, 2); ss += __shfl_xor(ss, 4);
            const float rinv = rsqrtf(ss * (1.f / 64.f) + EPS);
            const float* g = isk ? F.g_k : F.g_q;
            const int pos = gr & (S - 1);
#pragma unroll
            for (int e = 0; e < 8; ++e) { v[e] = v[e] * rinv * g[8 * seg + e]; const float pv = __shfl_xor(v[e], 1);
                if (seg < 2) { const float2 cs = WSP(float2, WS_ROPE)[pos * 8 + e]; v[e] = (seg == 0) ? (v[e] * cs.x - pv * cs.y) : (v[e] * cs.x + pv * cs.y); } }
            if (!isk) {
#pragma unroll
                for (int e = 0; e < 8; ++e) v[e] *= C2;
                *(u32x4*)(WSP(bf16_t, WS_YAB) + (size_t)gr * 1024 + hh * 64 + 8 * seg) = pack8(v);
            } else {
                *(u32x4*)(WSP(bf16_t, WS_K) + (size_t)gr * 512 + hh * 64 + 8 * seg) = pack8(v);
#pragma unroll
                for (int e = 0; e < 8; ++e) tile[row * 65 + 8 * seg + e] = v[e];
                __syncthreads();
                if (F.tid < 64) { float s = 0.f; for (int r = 0; r < 64; ++r) s += tile[r * 65 + F.tid];
                    const int b = r0 / S, blk = (r0 & (S - 1)) >> 8;
                    atomicAdd(WSP(float, WS_KMEAN) + ((size_t)(b * NH + hh) * 16 + blk) * 64 + F.tid, s * (1.f / 256.f)); }
            }
        } else if (ct < 24) {
            const RowsLinear br{WT + (size_t)(1024 + 64 * (ct - 16)) * 1024, 1024};
            sgemm_tile(tile, 1024, ar, br, F.wave, F.lane); __syncthreads();
#pragma unroll
            for (int e = 0; e < 8; ++e) v[e] = tile[row * 65 + 8 * seg + e];
            *(u32x4*)(WSP(bf16_t, WS_V) + (size_t)gr * 512 + 64 * (ct - 16) + 8 * seg) = pack8(v);
        } else if (ct < 32) {
            const int cu = 64 * (ct - 24), rb = 256 * (6 + (cu >> 7)) + (cu & 127);
            const RowsLinear bx{WT + (size_t)rb * 1024, 1024}, bc{WT + (size_t)(rb + 128) * 1024, 1024};
            sgemm_tile(tile, 1024, ar, bx, F.wave, F.lane); sgemm_tile(tile2, 1024, ar, bc, F.wave, F.lane); __syncthreads();
#pragma unroll
            for (int e = 0; e < 8; ++e) v[e] = tile[row * 65 + 8 * seg + e] * tile2[row * 65 + 8 * seg + e];
            *(u32x4*)(WSP(bf16_t, WS_U) + (size_t)gr * 512 + cu + 8 * seg) = pack8(v);
        } else if (ct < 40) {
            const RowsLinear br{WT + (size_t)(2560 + 64 * (ct - 32)) * 1024, 1024};
            sgemm_tile(tile, 1024, ar, br, F.wave, F.lane); __syncthreads();
#pragma unroll
            for (int e = 0; e < 8; ++e) v[e] = tile[row * 65 + 8 * seg + e];
            *(u32x4*)(WSP(bf16_t, WS_BG) + (size_t)gr * 512 + 64 * (ct - 32) + 8 * seg) = pack8(v);
        } else {
            const RowsLinear br{WT + (size_t)(3072 + 64 * (ct - 40)) * 1024, 1024};
            sgemm_tile(tile, 1024, ar, br, F.wave, F.lane); __syncthreads();
#pragma unroll
            for (int e = 0; e < 8; ++e) v[e] = 1.f / (1.f + __expf(-tile[row * 65 + 8 * seg + e]));
            *(u32x4*)(WSP(bf16_t, WS_GATES) + (size_t)gr * 2048 + 64 * (ct - 40) + 8 * seg) = pack8(v);
        }
        __syncthreads();
    }
}

namespace pg8 {
constexpr int BM = 256, BK = 64, HALF = 128, HTB = HALF * BK * 2, STAGE_BYTES = 8 * HTB, NXCD = 8, WGM = 8;
__device__ __forceinline__ int lds_byte(int r, int c) { const int st = (r >> 4) * 2 + (c >> 5), rr = r & 15, cc = c & 31, ob = rr * 64 + cc * 2; return st * 1024 + (ob ^ (((ob >> 9) & 1) << 5)); }
__device__ __forceinline__ void stage_rc(int b, int& R, int& C) { const int st = b / 1024, sb = b % 1024, swz = sb ^ (((sb >> 9) & 1) << 5); R = (st >> 1) * 16 + swz / 64; C = (st & 1) * 32 + (swz % 64) / 2; }
__device__ __forceinline__ int perm32(int rho) { const int n = rho >> 4, i = rho & 15; return 8 * (i >> 2) + 4 * n + (i & 3); }
struct Unit { int pm, pn; const char* a; const char* b; int e, rbase; };
__device__ __forceinline__ bool static_unit(int i, int G, int c, int nM, int nN, int& pm, int& pn) {
    const int nwg = nM * nN; const long L = (long)i * G + c; if (L >= nwg) return false;
    int wgid = (int)L; { const int q = nwg / NXCD, r = nwg % NXCD, xcd = wgid % NXCD, off = wgid / NXCD; wgid = (xcd < r ? xcd * (q + 1) : r * (q + 1) + (xcd - r) * q) + off; }
    const int nig = WGM * nN, gid = wgid / nig, fm = gid * WGM, gsz = (nM - fm) < WGM ? (nM - fm) : WGM;
    pm = fm + ((wgid % nig) % gsz); pn = (wgid % nig) / gsz; return true;
}
struct DenseSched {
    static constexpr bool GATHER = false;
    const char* A; const char* Bt; int nM, nN, K, G, c;
    __device__ __forceinline__ bool next(int i, Unit& u) const { if (!static_unit(i, G, c, nM, nN, u.pm, u.pn)) return false;
        u.a = A + (size_t)u.pm * BM * K * 2; u.b = Bt + (size_t)u.pn * BM * K * 2; u.e = 0; u.rbase = 0; return true; }
    __device__ __forceinline__ int row_index(const Unit&, int) const { return 0; }
};

template <class Epi, class Sched>
__device__ __forceinline__ void gemm_phase(LAS unsigned char* lds, const int K, const Sched& S, const Epi& E) {
    const int tid = threadIdx.x, wid = __builtin_amdgcn_readfirstlane(tid >> 6), lane = tid & 63, wr = wid >> 2, wc = wid & 3, fr = lane & 15, fq = lane >> 4;
    const int nt = K / BK;
    unsigned voffB[2], vA[2][2], vN[2][2]; int Rr[2], Cc[2];
#pragma unroll
    for (int i = 0; i < 2; ++i) { int R, C; stage_rc(tid * 16 + i * 8192, R, C); const int Rb = (R & ~31) + perm32(R & 31);
        Rr[i] = R; Cc[i] = C; voffB[i] = (unsigned)(Rb * K + C) * 2u;
        vA[0][i] = (unsigned)(R * K + C) * 2u; vA[1][i] = (unsigned)((HALF + R) * K + C) * 2u; vN[0][i] = vA[0][i]; vN[1][i] = vA[1][i]; }
    const size_t kstep = (size_t)(BK * 2);
    const size_t hstep = (size_t)HALF * K * 2;
    const unsigned ldsw = (unsigned)wid * 1024u;
    const int aoff = lds_byte(wr * 64 + fr, fq * 8), boff = lds_byte(wc * 32 + fr, fq * 8);
#define PG8_SA(b, h) (((b) * 2 + (h)) * HTB)
#define PG8_SB(b, h) ((4 + (b) * 2 + (h)) * HTB)
#define PG8_STAGE(bufoff, gbase, voff) do { _Pragma("unroll") for (int _i = 0; _i < 2; ++_i) \
        __builtin_amdgcn_global_load_lds((const unsigned*)((const char*)(gbase) + (voff)[_i]), (LAS unsigned*)(lds + (bufoff) + ldsw + _i * 8192), 16, 0, 0); } while (0)
#define PG8_LDA(dst, b, h) do { _Pragma("unroll") for (int m = 0; m < 4; ++m) _Pragma("unroll") for (int k = 0; k < 2; ++k) dst[m][k] = *(const LAS bf16x8*)(lds + PG8_SA(b, h) + aoff + m * 2048 + k * 1024); } while (0)
#define PG8_LDB(dst, b, h) do { _Pragma("unroll") for (int n = 0; n < 2; ++n) _Pragma("unroll") for (int k = 0; k < 2; ++k) dst[n][k] = *(const LAS bf16x8*)(lds + PG8_SB(b, h) + boff + n * 2048 + k * 1024); } while (0)
#define PG8_MMA(ai, bj, At, Bt) do { __builtin_amdgcn_s_setprio(1); _Pragma("unroll") for (int m = 0; m < 4; ++m) _Pragma("unroll") for (int n = 0; n < 2; ++n) _Pragma("unroll") for (int k = 0; k < 2; ++k) \
        acc[ai][bj][m][n] = __builtin_amdgcn_mfma_f32_16x16x32_bf16(Bt[n][k], At[m][k], acc[ai][bj][m][n], 0, 0, 0); __builtin_amdgcn_s_setprio(0); } while (0)
#define PG8_WAIT_V(n) asm volatile("s_waitcnt vmcnt(" #n ")" ::: "memory")
#define PG8_WAIT_L(n) asm volatile("s_waitcnt lgkmcnt(" #n ")" ::: "memory")
#define PG8_BAR __builtin_amdgcn_s_barrier()
#define PG8_SCHED __builtin_amdgcn_sched_barrier(0)
#define PG8_AOFF(dst, u) do { _Pragma("unroll") for (int _h = 0; _h < 2; ++_h) _Pragma("unroll") for (int _i = 0; _i < 2; ++_i) \
        dst[_h][_i] = (unsigned)(S.row_index(u, _h * HALF + Rr[_i]) * K + Cc[_i]) * 2u; } while (0)
    Unit cur, nxt; int ui = 0;
    if (!S.next(0, cur)) return;
    if constexpr (Sched::GATHER) PG8_AOFF(vA, cur);
    f32x4 acc[2][2][4][2];
#pragma unroll
    for (int a = 0; a < 2; ++a)
#pragma unroll
        for (int b = 0; b < 2; ++b)
#pragma unroll
            for (int m = 0; m < 4; ++m)
#pragma unroll
                for (int n = 0; n < 2; ++n) acc[a][b][m][n] = (f32x4){0.f, 0.f, 0.f, 0.f};
    bf16x8 At[4][2], B0[2][2], B1[2][2];
    const char* cA = cur.a; const char* cB = cur.b;
    PG8_STAGE(PG8_SB(0, 0), cB, voffB); PG8_STAGE(PG8_SB(0, 1), cB + hstep, voffB); PG8_STAGE(PG8_SA(0, 0), cA, vA[0]); PG8_STAGE(PG8_SA(0, 1), cA, vA[1]);
    if (wr == 1) PG8_BAR;
    PG8_WAIT_V(2); PG8_BAR;
    PG8_STAGE(PG8_SB(1, 0), cB + kstep, voffB); PG8_STAGE(PG8_SA(1, 0), cA + kstep, vA[0]); PG8_STAGE(PG8_SB(1, 1), cB + hstep + kstep, voffB);
    PG8_WAIT_V(6); PG8_BAR;
    for (;;) {
        const bool has_next = S.next(ui + 1, nxt);
        const char* nA = has_next ? nxt.a : cA; const char* nB = has_next ? nxt.b : cB;
        if constexpr (Sched::GATHER) { if (has_next) PG8_AOFF(vN, nxt); else {
#pragma unroll
            for (int h = 0; h < 2; ++h)
#pragma unroll
                for (int i = 0; i < 2; ++i) vN[h][i] = vA[h][i]; } }
        for (int hk = 0; hk < (Epi::HAS_MID ? 2 : 1); ++hk) {
        if constexpr (Epi::HAS_MID) { if (hk == 1) E.mid(acc, cur, wr, wc, fr, fq); }
        const int tb = (Epi::HAS_MID && hk == 1) ? nt / 2 : 0, te = (Epi::HAS_MID && hk == 0) ? nt / 2 : nt;
        for (int t = tb; t < te; t += 2) {
            const bool last = (t == nt - 2);
            const char* a1 = cA + (size_t)(t + 1) * kstep;
            const char* a2 = last ? nA : cA + (size_t)(t + 2) * kstep; const char* b2 = last ? nB : cB + (size_t)(t + 2) * kstep;
            const char* a3 = a2 + kstep; const char* b3 = b2 + kstep;
            unsigned w0[2], w1[2];
#pragma unroll
            for (int i = 0; i < 2; ++i) { w0[i] = (Sched::GATHER && last) ? vN[0][i] : vA[0][i]; w1[i] = (Sched::GATHER && last) ? vN[1][i] : vA[1][i]; }
            PG8_LDB(B0, 0, 0); PG8_LDB(B1, 0, 1); PG8_SCHED; PG8_LDA(At, 0, 0); PG8_STAGE(PG8_SA(1, 1), a1, vA[1]);
            PG8_WAIT_V(8); PG8_WAIT_L(0); PG8_BAR; PG8_MMA(0, 0, At, B0); PG8_MMA(0, 1, At, B1); PG8_BAR; PG8_SCHED;
            PG8_LDA(At, 0, 1); PG8_STAGE(PG8_SB(0, 0), b2, voffB); PG8_STAGE(PG8_SB(0, 1), b2 + hstep, voffB); PG8_STAGE(PG8_SA(0, 0), a2, w0);
            PG8_WAIT_V(8); PG8_WAIT_L(0); PG8_BAR; PG8_MMA(1, 0, At, B0); PG8_MMA(1, 1, At, B1); PG8_BAR; PG8_SCHED;
            PG8_LDB(B0, 1, 0); PG8_LDB(B1, 1, 1); PG8_SCHED; PG8_LDA(At, 1, 0); PG8_STAGE(PG8_SA(0, 1), a2, w1);
            PG8_WAIT_V(8); PG8_WAIT_L(0); PG8_BAR; PG8_MMA(0, 0, At, B0); PG8_MMA(0, 1, At, B1); PG8_BAR; PG8_SCHED;
            PG8_LDA(At, 1, 1); PG8_STAGE(PG8_SB(1, 0), b3, voffB); PG8_STAGE(PG8_SB(1, 1), b3 + hstep, voffB); PG8_STAGE(PG8_SA(1, 0), a3, w0);
            PG8_WAIT_V(8); PG8_WAIT_L(0); PG8_BAR; PG8_MMA(1, 0, At, B0); PG8_MMA(1, 1, At, B1); PG8_BAR; PG8_SCHED;
        }
        }
        if (wr == 0) PG8_BAR;
        E(acc, cur, wr, wc, fr, fq);
        if (!has_next) break;
#pragma unroll
        for (int a = 0; a < 2; ++a)
#pragma unroll
            for (int b = 0; b < 2; ++b)
#pragma unroll
                for (int m = 0; m < 4; ++m)
#pragma unroll
                    for (int n = 0; n < 2; ++n) acc[a][b][m][n] = (f32x4){0.f, 0.f, 0.f, 0.f};
        cur = nxt; cA = nA; cB = nB; ++ui;
        if constexpr (Sched::GATHER) {
#pragma unroll
            for (int h = 0; h < 2; ++h)
#pragma unroll
                for (int i = 0; i < 2; ++i) vA[h][i] = vN[h][i]; }
        if (wr == 1) PG8_BAR;
    }
    PG8_WAIT_V(0);
    PG8_BAR;
#undef PG8_SA
#undef PG8_SB
#undef PG8_STAGE
#undef PG8_LDA
#undef PG8_LDB
#undef PG8_MMA
#undef PG8_WAIT_V
#undef PG8_WAIT_L
#undef PG8_BAR
#undef PG8_SCHED
#undef PG8_AOFF
}
}

typedef f32x4 Acc[2][2][4][2];
struct EpiG1 {
    static constexpr bool HAS_MID = false;
    unsigned char* ws; const float* g_q; const float* g_k;
    __device__ __forceinline__ void mid(Acc&, const pg8::Unit&, int, int, int, int) const {}
    __device__ __forceinline__ void operator()(Acc& acc, const pg8::Unit& u, int wr, int wc, int fr, int fq) const {
        const int pn = u.pn, row0 = u.pm * 256 + wr * 64 + fr;
        if (pn < 4) {
            const int isk = pn >> 1, hh = 4 * (pn & 1) + wc;
            const float* g = isk ? g_k : g_q;
            f32x4 gv[2][2];
#pragma unroll
            for (int bj = 0; bj < 2; ++bj)
#pragma unroll
                for (int n = 0; n < 2; ++n) gv[bj][n] = *(const f32x4*)(g + 32 * bj + 8 * fq + 4 * n);
            f32x4 cs_[2][2];
#pragma unroll
            for (int bj = 0; bj < 2; ++bj)
#pragma unroll
                for (int n = 0; n < 2; ++n) cs_[bj][n] = (f32x4){0.f, 0.f, 0.f, 0.f};
            const float2* rope = (const float2*)(ws + WS_ROPE);
            bf16_t* dst = isk ? (bf16_t*)(ws + WS_K) : (bf16_t*)(ws + WS_YAB);
            const int pitch = isk ? 512 : 1024;
#pragma unroll
            for (int ai = 0; ai < 2; ++ai)
#pragma unroll
                for (int m = 0; m < 4; ++m) {
                    const int r = row0 + 128 * ai + 16 * m, pos = r & (S - 1);
                    f32x4 v[2][2]; float ss = 0.f;
#pragma unroll
                    for (int bj = 0; bj < 2; ++bj)
#pragma unroll
                        for (int n = 0; n < 2; ++n) { v[bj][n] = acc[ai][bj][m][n]; ss += (v[bj][n].x * v[bj][n].x + v[bj][n].y * v[bj][n].y) + (v[bj][n].z * v[bj][n].z + v[bj][n].w * v[bj][n].w); }
                    ss += __shfl_xor(ss, 16); ss += __shfl_xor(ss, 32);
                    const float rinv = rsqrtf(ss * (1.f / 64.f) + EPS);
#pragma unroll
                    for (int bj = 0; bj < 2; ++bj)
#pragma unroll
                        for (int n = 0; n < 2; ++n) v[bj][n] = v[bj][n] * rinv * gv[bj][n];
#pragma unroll
                    for (int n = 0; n < 2; ++n)
#pragma unroll
                        for (int e = 0; e < 4; ++e) { const float pv = __shfl_xor(v[0][n][e], 16);
                            if (fq < 2) { const float2 cs = rope[pos * 8 + 4 * n + e]; v[0][n][e] = (fq == 0) ? (v[0][n][e] * cs.x - pv * cs.y) : (v[0][n][e] * cs.x + pv * cs.y); } }
                    if (isk) {
#pragma unroll
                        for (int bj = 0; bj < 2; ++bj)
#pragma unroll
                            for (int n = 0; n < 2; ++n) cs_[bj][n] += v[bj][n];
                    }
                    const float sc = isk ? 1.f : C2;
#pragma unroll
                    for (int bj = 0; bj < 2; ++bj) { u32x4 w; const f32x4 a = v[bj][0] * sc, b = v[bj][1] * sc;
                        w.x = pk2(a.x, a.y); w.y = pk2(a.z, a.w); w.z = pk2(b.x, b.y); w.w = pk2(b.z, b.w);
                        st16(dst + (size_t)r * pitch + hh * 64 + 32 * bj + 8 * fq, w); }
                }
            if (isk) {
                const int b = u.pm >> 4, blk = u.pm & 15;
                float* km = (float*)(ws + WS_KMEAN) + ((size_t)(b * NH + hh) * 16 + blk) * 64;
#pragma unroll
                for (int bj = 0; bj < 2; ++bj)
#pragma unroll
                    for (int n = 0; n < 2; ++n)
#pragma unroll
                        for (int e = 0; e < 4; ++e) { float s = cs_[bj][n][e]; s += __shfl_xor(s, 1); s += __shfl_xor(s, 2); s += __shfl_xor(s, 4); s += __shfl_xor(s, 8);
                            if (fr == 0) atomicAdd(km + 32 * bj + 8 * fq + 4 * n + e, s * (1.f / 256.f)); }
            }
        } else if (pn >= 6 && pn < 10) {
            bf16_t* dst = (bf16_t*)(ws + WS_U);
#pragma unroll
            for (int ai = 0; ai < 2; ++ai)
#pragma unroll
                for (int m = 0; m < 4; ++m) { const int r = row0 + 128 * ai + 16 * m;
                    const f32x4 a = acc[ai][0][m][0] * acc[ai][1][m][0], b = acc[ai][0][m][1] * acc[ai][1][m][1]; u32x4 w;
                    w.x = pk2(a.x, a.y); w.y = pk2(a.z, a.w); w.z = pk2(b.x, b.y); w.w = pk2(b.z, b.w);
                    st16(dst + (size_t)r * 512 + 128 * (pn - 6) + 32 * wc + 8 * fq, w); }
        } else {
            bf16_t* dst; int pitch, c0; bool sig = false;
            if (pn < 6) { dst = (bf16_t*)(ws + WS_V); pitch = 512; c0 = 256 * (pn - 4); }
            else if (pn < 12) { dst = (bf16_t*)(ws + WS_BG); pitch = 512; c0 = 256 * (pn - 10); }
            else { dst = (bf16_t*)(ws + WS_GATES); pitch = 2048; c0 = 256 * (pn - 12); sig = true; }
#pragma unroll
            for (int ai = 0; ai < 2; ++ai)
#pragma unroll
                for (int m = 0; m < 4; ++m) { const int r = row0 + 128 * ai + 16 * m;
#pragma unroll
                    for (int bj = 0; bj < 2; ++bj) { f32x4 a = acc[ai][bj][m][0], b = acc[ai][bj][m][1];
                        if (sig) {
#pragma unroll
                            for (int e = 0; e < 4; ++e) { a[e] = __builtin_amdgcn_rcpf(1.f + __expf(-a[e])); b[e] = __builtin_amdgcn_rcpf(1.f + __expf(-b[e])); } }
                        u32x4 w; w.x = pk2(a.x, a.y); w.y = pk2(a.z, a.w); w.z = pk2(b.x, b.y); w.w = pk2(b.z, b.w);
                        st16(dst + (size_t)r * pitch + c0 + 128 * bj + 32 * wc + 8 * fq, w); } }
        }
    }
};
__device__ __forceinline__ void s2_fast(Frame& F) {
    const pg8::DenseSched Sd{(const char*)(F.ws + WS_H), (const char*)(F.ws + WS_WIN_T), T / 256, NIN / 256, 1024, F.G, (int)blockIdx.x};
    const EpiG1 E{F.ws, F.g_q, F.g_k};
    pg8::gemm_phase<EpiG1, pg8::DenseSched>(F.lds, 1024, Sd, E);
}

constexpr float NEG_BIG = -1e30f;
__device__ __forceinline__ void s3_simple(Frame& F) {
    LAS float* tS = (LAS float*)F.lds;
    LAS bf16_t* Pb = (LAS bf16_t*)(F.lds + 16896);
    LAS bf16_t* Vt = (LAS bf16_t*)(F.lds + 16896 + 9216);
    LAS float* mrow = (LAS float*)(F.lds + 16896 + 18432);
    LAS float* lrow = mrow + 64; LAS float* arow_ = mrow + 128; LAS int* sel = (LAS int*)(mrow + 192); LAS int* um = sel + 64;
    bf16_t* YAB = WSP(bf16_t, WS_YAB); const bf16_t* Kb = WSP(bf16_t, WS_K); const bf16_t* Vb = WSP(bf16_t, WS_V);
    const float* kmean = WSP(float, WS_KMEAN);
    const int row = F.tid >> 3, seg = F.tid & 7, fr = F.lane & 15, fq = F.lane >> 4, rb = 16 * (F.wave & 3), cb = 32 * (F.wave >> 2);
    for (int it = blockIdx.x; it < NB * NH * 64; it += F.G) {
        const int qc = it & 63, h = (it >> 6) & 7, b = it >> 9, cur = qc >> 2, t0 = 64 * qc;
        const size_t tb = (size_t)b * S;
        if (F.tid < 64) {
            float q[64];
            const bf16_t* qp = YAB + (tb + t0 + F.tid) * 1024 + h * 64;
#pragma unroll
            for (int i = 0; i < 8; ++i) { float t8[8]; unpack8(*(const u32x4*)(qp + 8 * i), t8);
#pragma unroll
                for (int e = 0; e < 8; ++e) q[8 * i + e] = t8[e]; }
            float b0 = -INFINITY, b1 = -INFINITY, b2 = -INFINITY; int i0 = -1, i1 = -1, i2 = -1;
            for (int j = 0; j < cur; ++j) { const float* km = kmean + ((size_t)(b * NH + h) * 16 + j) * 64; float s = 0.f;
#pragma unroll
                for (int d = 0; d < 64; ++d) s += q[d] * km[d];
                if (s > b0) { b2 = b1; i2 = i1; b1 = b0; i1 = i0; b0 = s; i0 = j; } else if (s > b1) { b2 = b1; i2 = i1; b1 = s; i1 = j; } else if (s > b2) { b2 = s; i2 = j; } }
            int m = 0; if (i0 >= 0) m |= 1 << i0; if (i1 >= 0) m |= 1 << i1; if (i2 >= 0) m |= 1 << i2;
            sel[F.tid] = m; mrow[F.tid] = NEG_BIG; lrow[F.tid] = 0.f;
            int u = m;
#pragma unroll
            for (int o = 1; o < 64; o <<= 1) u |= __shfl_xor(u, o);
            if (F.tid == 0) um[0] = u;
        }
        __syncthreads();
        const int umask = um[0];
        f32x4 o0 = {0.f, 0.f, 0.f, 0.f}, o1 = {0.f, 0.f, 0.f, 0.f};
        const RowsLinear aq{YAB + (tb + t0) * 1024 + h * 64, 1024};
        for (int j = 0; j <= cur; ++j) {
            if (j < cur && !((umask >> j) & 1)) continue;
            const int nkt = (j == cur) ? ((qc & 3) + 1) : 4;
            for (int kt = 0; kt < nkt; ++kt) {
                const int kbase = 256 * j + 64 * kt;
                const RowsLinear bk{Kb + (tb + kbase) * 512 + h * 64, 512};
                sgemm_tile(tS, 64, aq, bk, F.wave, F.lane);
                { float vv[8]; unpack8(*(const u32x4*)(Vb + (tb + kbase + row) * 512 + h * 64 + 8 * seg), vv);
#pragma unroll
                    for (int e = 0; e < 8; ++e) Vt[(8 * seg + e) * 72 + row] = (bf16_t)f2bf(vv[e]); }
                __syncthreads();
                {
                    float s[8]; float mx = NEG_BIG;
                    const bool rowsel = (j == cur) || ((sel[row] >> j) & 1);
#pragma unroll
                    for (int e = 0; e < 8; ++e) { const int c = 8 * seg + e; float x = tS[row * 65 + c];
                        if (!rowsel || (j == cur && kbase + c > t0 + row)) x = NEG_BIG; s[e] = x; mx = fmaxf(mx, x); }
                    mx = fmaxf(mx, __shfl_xor(mx, 1)); mx = fmaxf(mx, __shfl_xor(mx, 2)); mx = fmaxf(mx, __shfl_xor(mx, 4));
                    const float mold = mrow[row], mnew = fmaxf(mold, mx);
                    float alpha = 1.f, ps = 0.f; float p[8];
                    if (mnew <= NEG_BIG) {
#pragma unroll
                        for (int e = 0; e < 8; ++e) p[e] = 0.f;
                    } else { alpha = exp2f(mold - mnew);
#pragma unroll
                        for (int e = 0; e < 8; ++e) { p[e] = (s[e] <= NEG_BIG) ? 0.f : exp2f(s[e] - mnew); ps += p[e]; } }
                    ps += __shfl_xor(ps, 1); ps += __shfl_xor(ps, 2); ps += __shfl_xor(ps, 4);
                    const float lold = lrow[row];
                    *(LAS u32x4*)(Pb + row * 72 + 8 * seg) = pack8(p);
                    if (seg == 0) { mrow[row] = mnew; lrow[row] = lold * alpha + ps; arow_[row] = alpha; }
                }
                __syncthreads();
                {
#pragma unroll
                    for (int r = 0; r < 4; ++r) { const float a = arow_[rb + fq * 4 + r]; o0[r] *= a; o1[r] *= a; }
#pragma unroll
                    for (int ks = 0; ks < 2; ++ks) {
                        const bf16x8 a = *(const LAS bf16x8*)(Pb + (rb + fr) * 72 + 32 * ks + 8 * fq);
                        const bf16x8 v0 = *(const LAS bf16x8*)(Vt + (cb + fr) * 72 + 32 * ks + 8 * fq);
                        const bf16x8 v1 = *(const LAS bf16x8*)(Vt + (cb + 16 + fr) * 72 + 32 * ks + 8 * fq);
                        o0 = __builtin_amdgcn_mfma_f32_16x16x32_bf16(a, v0, o0, 0, 0, 0);
                        o1 = __builtin_amdgcn_mfma_f32_16x16x32_bf16(a, v1, o1, 0, 0, 0);
                    }
                }
                __syncthreads();
            }
        }
#pragma unroll
        for (int r = 0; r < 4; ++r) { const float li = 1.f / lrow[rb + fq * 4 + r]; tS[(rb + fq * 4 + r) * 65 + cb + fr] = o0[r] * li; tS[(rb + fq * 4 + r) * 65 + cb + 16 + fr] = o1[r] * li; }
        __syncthreads();
        { float v[8];
#pragma unroll
            for (int e = 0; e < 8; ++e) v[e] = tS[row * 65 + 8 * seg + e];
            *(u32x4*)(YAB + (tb + t0 + row) * 1024 + h * 64 + 8 * seg) = pack8(v); }
        __syncthreads();
    }
    const bf16_t* U = WSP(bf16_t, WS_U); const bf16_t* BG = WSP(bf16_t, WS_BG);
    for (int i = blockIdx.x * NTHREADS + F.tid; i < T * 64; i += F.G * NTHREADS) {
        const int t = i >> 6, c0 = (i & 63) * 8, pos = t & (S - 1);
        float u0[8], u1[8], u2[8], bg[8], y[8];
        unpack8(*(const u32x4*)(U + (size_t)t * 512 + c0), u2); unpack8(*(const u32x4*)(BG + (size_t)t * 512 + c0), bg);
        if (pos >= 1) unpack8(*(const u32x4*)(U + (size_t)(t - 1) * 512 + c0), u1); else {
#pragma unroll
            for (int e = 0; e < 8; ++e) u1[e] = 0.f; }
        if (pos >= 2) unpack8(*(const u32x4*)(U + (size_t)(t - 2) * 512 + c0), u0); else {
#pragma unroll
            for (int e = 0; e < 8; ++e) u0[e] = 0.f; }
#pragma unroll
        for (int e = 0; e < 8; ++e) y[e] = bg[e] * (F.conv_w[c0 + e] * u0[e] + F.conv_w[512 + c0 + e] * u1[e] + F.conv_w[1024 + c0 + e] * u2[e] + F.conv_b[c0 + e]);
        *(u32x4*)(YAB + (size_t)t * 1024 + 512 + c0) = pack8(y);
    }
}

namespace attn_body {
using bf16x8 = __attribute__((ext_vector_type(8))) short;
using s16x4 = __attribute__((ext_vector_type(4))) short;
using f32x16 = __attribute__((ext_vector_type(16))) float;
using u32x4 = __attribute__((ext_vector_type(4))) unsigned;
constexpr int SEQ = 4096, D = 64, DMQ = 1024, DMK = 512;
constexpr int NW = 8, QBLK = 32, QB = QBLK * NW, KVBLK = 64;
constexpr float NEGB = -1e30f;
__device__ __forceinline__ int crow(int r, int hi) { return (r & 3) + 8 * (r >> 2) + 4 * hi; }
#define SBAR() __builtin_amdgcn_sched_barrier(0)
__device__ __forceinline__ void cmask(f32x16& p0, f32x16& p1, int jb, int qrel, int hi) {
  const float NEG = -INFINITY; int kb = 64 * jb + 4 * hi;
  #pragma unroll
  for (int r = 0; r < 16; ++r) { int kv = kb + (r & 3) + 8 * (r >> 2); if (kv > qrel) p0[r] = NEG; if (kv + 32 > qrel) p1[r] = NEG; }
}
constexpr int NSLOT = 3, SLOTB = 8192;
constexpr int LDS_K = 0, LDS_V = NSLOT * SLOTB, LDS_WS = 2 * NSLOT * SLOTB, LDS_OST = LDS_WS + NW * 128 * 4, LDS_BYTES_A = LDS_OST + NW * 4096;
__device__ __forceinline__ void glds16(const void* gsrc, unsigned lds_dst) { unsigned keep;
  asm volatile("s_mov_b32 %0, m0\n\ts_mov_b32 m0, %2\n\ts_nop 0\n\tglobal_load_lds_dwordx4 %1, off\n\ts_mov_b32 m0, %0" : "=&s"(keep) : "v"(gsrc), "s"(lds_dst) : "memory"); }
__device__ __forceinline__ float max3f(float a, float b, float c) { float r; asm("v_max3_f32 %0, %1, %2, %3" : "=v"(r) : "v"(a), "v"(b), "v"(c)); return r; }
__device__ __forceinline__ float max2f(float a, float b) { float r; asm("v_max_f32_e32 %0, %1, %2" : "=v"(r) : "v"(a), "v"(b)); return r; }
__device__ __forceinline__ float fadd_s(float a, float b) { float r; asm("v_add_f32_e32 %0, %1, %2" : "=v"(r) : "v"(a), "v"(b)); return r; }
__device__ __forceinline__ float fsub_s(float a, float b) { float r; asm("v_sub_f32_e32 %0, %1, %2" : "=v"(r) : "v"(a), "v"(b)); return r; }
typedef float f32x2_t __attribute__((ext_vector_type(2))); typedef __bf16 bf16x2_t __attribute__((ext_vector_type(2)));
__device__ __forceinline__ unsigned cvtpk_s(float lo, float hi) { f32x2_t v = {lo, hi}; bf16x2_t b = __builtin_convertvector(v, bf16x2_t); return __builtin_bit_cast(unsigned, b); }
#define WAIT_BAR(N) asm volatile("s_waitcnt vmcnt(" #N ") lgkmcnt(0)\n\ts_barrier" ::: "memory")
__device__ __forceinline__ void qkt(f32x16& p0, f32x16& p1, const char* Kslot, const bf16x8* qr, const f32x16& negm, int r32, int hi) {
  const char* kb = Kslot + hi * 1024 + r32 * 16;
  #pragma unroll
  for (int d0 = 0; d0 < 4; ++d0) {
    const bf16x8 b0 = *reinterpret_cast<const bf16x8*>(kb + d0 * 2048);
    const bf16x8 b1 = *reinterpret_cast<const bf16x8*>(kb + d0 * 2048 + 512);
    if (d0 == 0) { p0 = __builtin_amdgcn_mfma_f32_32x32x16_bf16(b0, qr[0], negm, 0, 0, 0); p1 = __builtin_amdgcn_mfma_f32_32x32x16_bf16(b1, qr[0], negm, 0, 0, 0); }
    else { p0 = __builtin_amdgcn_mfma_f32_32x32x16_bf16(b0, qr[d0], p0, 0, 0, 0); p1 = __builtin_amdgcn_mfma_f32_32x32x16_bf16(b1, qr[d0], p1, 0, 0, 0); } }
}
typedef __attribute__((address_space(3))) const char* lds_cptr;
typedef __attribute__((address_space(3))) char* lds_ptr;
typedef short v4i16_t __attribute__((ext_vector_type(4)));
__device__ __forceinline__ void kload8(bf16x8* kf, lds_cptr kp) {
  kf[0] = *(const __attribute__((address_space(3))) bf16x8*)(kp);        kf[1] = *(const __attribute__((address_space(3))) bf16x8*)(kp + 512);
  kf[2] = *(const __attribute__((address_space(3))) bf16x8*)(kp + 2048); kf[3] = *(const __attribute__((address_space(3))) bf16x8*)(kp + 2560);
  kf[4] = *(const __attribute__((address_space(3))) bf16x8*)(kp + 4096); kf[5] = *(const __attribute__((address_space(3))) bf16x8*)(kp + 4608);
  kf[6] = *(const __attribute__((address_space(3))) bf16x8*)(kp + 6144); kf[7] = *(const __attribute__((address_space(3))) bf16x8*)(kp + 6656);
}
__device__ __forceinline__ void kload2(bf16x8* kf, lds_cptr kp, int j) { kf[2 * j] = *(const __attribute__((address_space(3))) bf16x8*)(kp + j * 2048); kf[2 * j + 1] = *(const __attribute__((address_space(3))) bf16x8*)(kp + j * 2048 + 512); }
__device__ __forceinline__ s16x4 vtr(lds_cptr p) { return __builtin_bit_cast(s16x4, __builtin_amdgcn_ds_read_tr16_b64_v4i16((__attribute__((address_space(3))) v4i16_t*)p)); }
__device__ __forceinline__ float rowmax(const f32x16& p0, const f32x16& p1) {
  float a = max3f(p0[0], p0[1], p1[0]), b = max3f(p0[2], p0[3], p1[1]); a = max3f(a, p1[2], p1[3]);
  #pragma unroll
  for (int r = 4; r < 16; r += 4) { a = max3f(a, p0[r], p0[r + 1]); b = max3f(b, p0[r + 2], p0[r + 3]); a = max3f(a, p1[r], p1[r + 1]); b = max3f(b, p1[r + 2], p1[r + 3]); }
  const float m = max2f(a, b);
  auto rr = __builtin_amdgcn_permlane32_swap(__float_as_uint(m), __float_as_uint(m), false, false);
  return max2f(__uint_as_float(rr[0]), __uint_as_float(rr[1]));
}
__device__ __forceinline__ void pv(f32x16* o, int vb, bf16x8 pa0, bf16x8 pa1, bf16x8 pa2, bf16x8 pa3) {
  #pragma unroll
  for (int d0 = 0; d0 < 2; ++d0) { s16x4 lo[4], hi[4];
    #pragma unroll
    for (int ks = 0; ks < 4; ++ks) {
      asm volatile("ds_read_b64_tr_b16 %0,%1 offset:%c2" : "=&v"(lo[ks]) : "v"(vb), "i"(d0 * 4096 + ks * 1024) : "memory");
      asm volatile("ds_read_b64_tr_b16 %0,%1 offset:%c2" : "=&v"(hi[ks]) : "v"(vb), "i"(d0 * 4096 + ks * 1024 + 512) : "memory"); }
    asm volatile("s_waitcnt lgkmcnt(0)" ::: "memory"); SBAR();
    #define PK(k) (bf16x8){lo[k][0], lo[k][1], lo[k][2], lo[k][3], hi[k][0], hi[k][1], hi[k][2], hi[k][3]}
    o[d0] = __builtin_amdgcn_mfma_f32_32x32x16_bf16(pa0, PK(0), o[d0], 0, 0, 0);
    o[d0] = __builtin_amdgcn_mfma_f32_32x32x16_bf16(pa1, PK(1), o[d0], 0, 0, 0);
    o[d0] = __builtin_amdgcn_mfma_f32_32x32x16_bf16(pa2, PK(2), o[d0], 0, 0, 0);
    o[d0] = __builtin_amdgcn_mfma_f32_32x32x16_bf16(pa3, PK(3), o[d0], 0, 0, 0);
    #undef PK
  }
}
#define ATTN_STORE16(p, v) st16((p), (v))
template <int THRL> __device__ __forceinline__ void attn_unit(int b, int h, int qb, const bf16_t* QO, bf16_t* Ob, const bf16_t* __restrict__ K, const bf16_t* __restrict__ V, const float* __restrict__ kmean, char* shm) {
  int tid_ = threadIdx.x; asm volatile("" : "+v"(tid_));
  const int tid = tid_, lane = tid & 63, r32 = lane & 31, hi = lane >> 5; const int wid = __builtin_amdgcn_readfirstlane(tid >> 6);
  const long rowbase = (long)b * SEQ; const int q0 = qb * QB;
  const bf16_t* Qw = QO + (rowbase + q0 + wid * QBLK) * DMQ + h * D;
  const bf16_t* Kh = K + rowbase * DMK + h * D, *Vh = V + rowbase * DMK + h * D;
  const unsigned lds0 = (unsigned)(uintptr_t)shm;
  float* wsf = (float*)(shm + LDS_WS) + wid * 128;
  const bf16_t* ksrc = Kh + (long)lane * DMK + wid * 8;
  const bf16_t* vsrc = Vh + (long)(16 * (wid & 3) + (lane >> 2)) * DMK + (wid >> 2) * 32 + (lane & 3) * 8;
  const unsigned kdst = lds0 + LDS_K + wid * 1024, vdst = lds0 + LDS_V + wid * 1024;
  #define DMA_K(t, slot) glds16(ksrc + (long)(t) * KVBLK * DMK, (unsigned)__builtin_amdgcn_readfirstlane(kdst + (slot)))
  #define DMA_V(t, slot) glds16(vsrc + (long)(t) * KVBLK * DMK, (unsigned)__builtin_amdgcn_readfirstlane(vdst + (slot)))
  DMA_K(0, 0); DMA_V(0, 0); DMA_K(1, SLOTB);
  bf16x8 qr[4];
  #pragma unroll
  for (int d0 = 0; d0 < 4; ++d0) qr[d0] = *reinterpret_cast<const bf16x8*>(&Qw[(long)r32 * DMQ + d0 * 16 + hi * 8]);
  unsigned selm = 0u;
  if (qb > 0) {
    float* kmL = (float*)(shm + LDS_OST);
    const float* kmg = kmean + ((size_t)(b * 8 + h) * 16) * 64;
    for (int i = tid; i < qb * 64; i += 512) kmL[i] = kmg[i];
    asm volatile("s_waitcnt vmcnt(0) lgkmcnt(0)\n\ts_barrier" ::: "memory");
    float qf[32];
    #pragma unroll
    for (int d0 = 0; d0 < 4; ++d0)
      #pragma unroll
      for (int e = 0; e < 8; ++e) qf[8 * d0 + e] = __uint_as_float(((unsigned)(unsigned short)qr[d0][e]) << 16);
    float b0 = -INFINITY, b1 = -INFINITY, b2 = -INFINITY; int i0 = -1, i1 = -1, i2 = -1;
    for (int j = 0; j < qb; ++j) {
      const float* km = kmL + j * 64 + 8 * hi; float sc = 0.f;
      #pragma unroll
      for (int d0 = 0; d0 < 4; ++d0)
        #pragma unroll
        for (int e = 0; e < 8; ++e) sc += qf[8 * d0 + e] * km[16 * d0 + e];
      sc += __shfl_xor(sc, 32);
      if (sc > b0) { b2 = b1; i2 = i1; b1 = b0; i1 = i0; b0 = sc; i0 = j; } else if (sc > b1) { b2 = b1; i2 = i1; b1 = sc; i1 = j; } else if (sc > b2) { b2 = sc; i2 = j; }
    }
    if (i0 >= 0) selm |= 1u << i0; if (i1 >= 0) selm |= 1u << i1; if (i2 >= 0) selm |= 1u << i2;
    asm volatile("s_waitcnt lgkmcnt(0)\n\ts_barrier" ::: "memory");
  }
  if (hi == 0) ((unsigned*)wsf)[64 + r32] = selm;
  { const lds_ptr qst = (lds_ptr)shm + LDS_OST + wid * 4096 + lane * 16;
    #pragma unroll
    for (int d0 = 0; d0 < 4; ++d0) *(__attribute__((address_space(3))) bf16x8*)(qst + d0 * 1024) = qr[d0]; }
  #define SELROW(j) (((j) >= qb) || ((((const unsigned*)wsf)[64 + r32] >> (j)) & 1u))
  #define NEGM_SET(blk) do { const float nv_ = SELROW(blk) ? -mhat : NEGB; _Pragma("unroll") for (int r = 0; r < 16; ++r) negm[r] = nv_; asm volatile("" : "+v"(negm)); } while (0)
  const int vb0 = (int)(lds0 + LDS_V) + ((lane >> 4) & 1) * 32 + (lane & 3) * 8 + (4 * hi + ((lane & 15) >> 2)) * 64;
  const char* Kbase = shm + LDS_K; bf16x8 kf[8];
  const lds_cptr qp0 = (lds_cptr)shm + LDS_OST + wid * 4096 + lane * 16;
  const lds_cptr shm3 = (lds_cptr)shm; const lds_cptr kp0 = shm3 + LDS_K + hi * 1024 + r32 * 16; const lds_cptr vp0 = shm3 + LDS_V + ((lane >> 4) & 1) * 32 + (lane & 3) * 8 + (4 * hi + ((lane & 15) >> 2)) * 64;
  const int NT = (q0 + QB) / KVBLK;
  float mhat = 0.f, l_reg = 0.f; f32x16 o[2]; o[0] = f32x16{}; o[1] = f32x16{}; f32x16 negm;
  NEGM_SET(0);
  const int qrel = wid * QBLK + r32;
  #define CMASK(P0, P1, t) do { int jb_ = (t) - (NT - 4); if (jb_ >= 0) cmask(P0, P1, jb_, qrel, hi); } while (0)
  bool resc = false;
  #define START(P0, P1) do { const float rm = rowmax(P0, P1); resc = false; \
    { const float dl = SELROW(0) ? rm : 0.f; mhat = fadd_s(mhat, dl); \
      _Pragma("unroll") for (int r = 0; r < 16; ++r) { P0[r] = fsub_s(P0[r], dl); P1[r] = fsub_s(P1[r], dl); } \
      NEGM_SET(0); } \
    _Pragma("unroll") for (int r = 0; r < 16; ++r) P0[r] = __builtin_amdgcn_exp2f(P0[r]); } while (0)
  #define RESC() do { if (resc) { asm volatile("s_waitcnt lgkmcnt(0)" ::: "memory"); \
      _Pragma("unroll") for (int d_ = 0; d_ < 2; ++d_) _Pragma("unroll") for (int r = 0; r < 16; ++r) o[d_][r] *= wsf[crow(r, hi)]; } } while (0)
  f32x16 pA0, pA1, pB0, pB1;
  int sl_prev = 0, sl_cur = 0, sl_next = SLOTB;
  #define ROT() do { sl_prev = sl_cur; sl_cur = sl_next; sl_next = (sl_next == (NSLOT - 1) * SLOTB) ? 0 : sl_next + SLOTB; } while (0)
  DMA_K(2, 2 * SLOTB);
  WAIT_BAR(3);
  qkt(pA0, pA1, Kbase, qr, negm, r32, hi); asm volatile("s_nop 15\n\ts_nop 7" : "+v"(pA0), "+v"(pA1)); CMASK(pA0, pA1, 0);
  START(pA0, pA1);
  _Pragma("unroll") for (int r = 0; r < 16; ++r) pA1[r] = __builtin_amdgcn_exp2f(pA1[r]);
  WAIT_BAR(0);
  DMA_K(3, 0); DMA_V(1, SLOTB);
  ROT();
  kload8(kf, kp0 + sl_cur);
  WAIT_BAR(2);
  s16x4 vlo[8], vhi[8]; u32x4 pw0, pw1, pw2, pw3; bf16x8 q0_, q1_, q2_, q3_;
  #define QRD(d) do { q##d##_ = *(const __attribute__((address_space(3))) bf16x8*)(qp0 + (d) * 1024); } while (0)
  QRD(0); QRD(1);
  #define PKW(P, B) cvtpk_s(P[B], P[B + 1])
  #define PAF(k) __builtin_bit_cast(bf16x8, pw##k)
  #define VFR(i) (bf16x8){vlo[i][0], vlo[i][1], vlo[i][2], vlo[i][3], vhi[i][0], vhi[i][1], vhi[i][2], vhi[i][3]}
  #define PIN(x) asm volatile("" : "+v"(x))
  #define MX3(a, b, c) __builtin_fmaxf(__builtin_fmaxf((a), (b)), (c))
  #define GAPA(MF, A0, A1, A2, A3, W0, W1, PW) do { MF; sacc += A0; sacc += A1; sacc += A2; sacc += A3; PIN(sacc); W0; W1; PIN(PW); SBAR(); } while (0)
  #define EX(v) __builtin_amdgcn_exp2f(v)
  #define GAPB(MF, X, B) do { MF; X[B] = EX(X[B]); X[B + 1] = EX(X[B + 1]); X[B + 2] = EX(X[B + 2]); X[B + 3] = EX(X[B + 3]); PIN(X); SBAR(); } while (0)
  #define VRD(i) do { vlo[i] = vtr(vp_ + (((i) >> 2) * 4096 + ((i) & 3) * 1024)); vhi[i] = vtr(vp_ + (((i) >> 2) * 4096 + ((i) & 3) * 1024 + 512)); } while (0)
  #define KRD(G, j) do { if (G) { kload2(kf, kp0 + sl_next, j); SBAR(); } } while (0)
  #define STEP(C0, C1, P0, P1, t, GK, GV, GL) do { SBAR(); \
    const lds_cptr vp_ = vp0 + sl_prev; \
    VRD(0); SBAR(); float sacc = (P0[0] + P0[1]); \
    GAPA(C0 = __builtin_amdgcn_mfma_f32_32x32x16_bf16(kf[0], q0_, negm, 0, 0, 0), P0[2], P0[3], P0[4], P0[5],     pw0[0] = PKW(P0, 0), pw0[1] = PKW(P0, 2), pw0); \
    VRD(4); SBAR(); GAPA(C1 = __builtin_amdgcn_mfma_f32_32x32x16_bf16(kf[1], q0_, negm, 0, 0, 0), P0[6], P0[7], P0[8], P0[9],     pw0[2] = PKW(P0, 4), pw0[3] = PKW(P0, 6), pw0); \
    QRD(2); SBAR(); \
    VRD(1); SBAR(); GAPA(C0 = __builtin_amdgcn_mfma_f32_32x32x16_bf16(kf[2], q1_, C0, 0, 0, 0),   P0[10], P0[11], P0[12], P0[13], pw1[0] = PKW(P0, 8), pw1[1] = PKW(P0, 10), pw1); \
    VRD(5); SBAR(); GAPA(C1 = __builtin_amdgcn_mfma_f32_32x32x16_bf16(kf[3], q1_, C1, 0, 0, 0),   P0[14], P0[15], P1[0], P1[1],   pw1[2] = PKW(P0, 12), pw1[3] = PKW(P0, 14), pw1); \
    QRD(3); SBAR(); \
    VRD(2); SBAR(); GAPA(C0 = __builtin_amdgcn_mfma_f32_32x32x16_bf16(kf[4], q2_, C0, 0, 0, 0),   P1[2], P1[3], P1[4], P1[5],     pw2[0] = PKW(P1, 0), pw2[1] = PKW(P1, 2), pw2); \
    VRD(6); SBAR(); GAPA(C1 = __builtin_amdgcn_mfma_f32_32x32x16_bf16(kf[5], q2_, C1, 0, 0, 0),   P1[6], P1[7], P1[8], P1[9],     pw2[2] = PKW(P1, 4), pw2[3] = PKW(P1, 6), pw2); \
    VRD(3); SBAR(); GAPA(C0 = __builtin_amdgcn_mfma_f32_32x32x16_bf16(kf[6], q3_, C0, 0, 0, 0),   P1[10], P1[11], P1[12], P1[13], pw3[0] = PKW(P1, 8), pw3[1] = PKW(P1, 10), pw3); \
    VRD(7); SBAR(); GAPA(C1 = __builtin_amdgcn_mfma_f32_32x32x16_bf16(kf[7], q3_, C1, 0, 0, 0),   P1[14], P1[15], 0.f, 0.f,       pw3[2] = PKW(P1, 12), pw3[3] = PKW(P1, 14), pw3); \
    l_reg += sacc; \
    if (GK) { DMA_K((t) + 3, sl_cur); } if (GV) { DMA_V((t) + 1, sl_next); } \
    CMASK(C0, C1, t); \
    { float a = MX3(C0[0], C0[1], C1[0]), b = MX3(C0[2], C0[3], C1[1]); a = MX3(a, C1[2], C1[3]); \
      _Pragma("unroll") for (int r = 4; r < 16; r += 4) { a = MX3(a, C0[r], C0[r + 1]); b = MX3(b, C0[r + 2], C0[r + 3]); a = MX3(a, C1[r], C1[r + 1]); b = MX3(b, C1[r + 2], C1[r + 3]); } \
      float rm = __builtin_fmaxf(a, b); { auto rr = __builtin_amdgcn_permlane32_swap(__float_as_uint(rm), __float_as_uint(rm), false, false); rm = __builtin_fmaxf(__uint_as_float(rr[0]), __uint_as_float(rr[1])); } \
      resc = false; \
      if (__builtin_expect(__any(rm > (float)THRL), 0)) { const float dl = __builtin_fmaxf(rm, 0.f); mhat += dl; \
        _Pragma("unroll") for (int r = 0; r < 16; ++r) { C0[r] -= dl; C1[r] -= dl; } \
        NEGM_SET(((t) + 1) >> 2); \
        const float f = __builtin_amdgcn_exp2f(-dl); l_reg *= f; if (hi == 0) wsf[r32] = f; resc = true; } \
      else if ((((t) + 1) & 3) == 0) { NEGM_SET(((t) + 1) >> 2); } } \
    SBAR(); \
    GAPB(o[0] = __builtin_amdgcn_mfma_f32_32x32x16_bf16(PAF(0), VFR(0), o[0], 0, 0, 0), C0, 0); \
    GAPB(o[1] = __builtin_amdgcn_mfma_f32_32x32x16_bf16(PAF(0), VFR(4), o[1], 0, 0, 0), C0, 4); \
    KRD(GL, 0); GAPB(o[0] = __builtin_amdgcn_mfma_f32_32x32x16_bf16(PAF(1), VFR(1), o[0], 0, 0, 0), C0, 8); \
    KRD(GL, 1); GAPB(o[1] = __builtin_amdgcn_mfma_f32_32x32x16_bf16(PAF(1), VFR(5), o[1], 0, 0, 0), C0, 12); \
    KRD(GL, 2); GAPB(o[0] = __builtin_amdgcn_mfma_f32_32x32x16_bf16(PAF(2), VFR(2), o[0], 0, 0, 0), C1, 0); \
    KRD(GL, 3); GAPB(o[1] = __builtin_amdgcn_mfma_f32_32x32x16_bf16(PAF(2), VFR(6), o[1], 0, 0, 0), C1, 4); \
    GAPB(o[0] = __builtin_amdgcn_mfma_f32_32x32x16_bf16(PAF(3), VFR(3), o[0], 0, 0, 0), C1, 8); \
    GAPB(o[1] = __builtin_amdgcn_mfma_f32_32x32x16_bf16(PAF(3), VFR(7), o[1], 0, 0, 0), C1, 12); \
    QRD(0); QRD(1); SBAR(); \
    } while (0)
  int t = 1;
  #undef CMASK
  #define CMASK(P0, P1, t) do {} while (0)
  for (; t + 5 < NT; t += 2) {
    STEP(pB0, pB1, pA0, pA1, t, true, true, true);     WAIT_BAR(2); RESC(); ROT();
    STEP(pA0, pA1, pB0, pB1, t + 1, true, true, true); WAIT_BAR(2); RESC(); ROT();
  }
  #undef CMASK
  #define CMASK(P0, P1, t) do { int jb_ = (t) - (NT - 4); if (jb_ >= 0) cmask(P0, P1, jb_, qrel, hi); } while (0)
  #define ENDW(tt) do { if ((tt) + 3 < NT) { WAIT_BAR(2); } else if ((tt) + 2 < NT) { WAIT_BAR(1); } else { WAIT_BAR(0); } } while (0)
  for (; t + 1 < NT; t += 2) {
    STEP(pB0, pB1, pA0, pA1, t, (t + 3 < NT), (t + 1 < NT), (t + 1 < NT));       ENDW(t);     RESC(); ROT();
    STEP(pA0, pA1, pB0, pB1, t + 1, (t + 4 < NT), (t + 2 < NT), (t + 2 < NT));   ENDW(t + 1); RESC(); ROT();
  }
  STEP(pB0, pB1, pA0, pA1, NT - 1, false, false, false); RESC();
  { float sacc = pB0[0] + pB0[1]; _Pragma("unroll") for (int r = 2; r < 16; ++r) sacc += pB0[r]; _Pragma("unroll") for (int r = 0; r < 16; ++r) sacc += pB1[r]; l_reg += sacc;
    pw0 = (u32x4){PKW(pB0, 0), PKW(pB0, 2), PKW(pB0, 4), PKW(pB0, 6)}; pw1 = (u32x4){PKW(pB0, 8), PKW(pB0, 10), PKW(pB0, 12), PKW(pB0, 14)}; pw2 = (u32x4){PKW(pB1, 0), PKW(pB1, 2), PKW(pB1, 4), PKW(pB1, 6)}; pw3 = (u32x4){PKW(pB1, 8), PKW(pB1, 10), PKW(pB1, 12), PKW(pB1, 14)};
    SBAR(); pv(o, vb0 + sl_cur, PAF(0), PAF(1), PAF(2), PAF(3)); }
  #undef PKW
  #undef PAF
  #undef VFR
  #undef PIN
  #undef MX3
  #undef GAPA
  #undef GAPB
  #undef EX
  #undef VRD
  #undef KRD
  #undef QRD
  #undef STEP
  #undef ENDW
  { auto rr = __builtin_amdgcn_permlane32_swap(__float_as_uint(l_reg), __float_as_uint(l_reg), false, false); l_reg = __uint_as_float(rr[0]) + __uint_as_float(rr[1]); }
  if (hi == 0) wsf[32 + r32] = l_reg; asm volatile("s_waitcnt lgkmcnt(0)" ::: "memory");
  float rli[16];
  #pragma unroll
  for (int r = 0; r < 16; ++r) rli[r] = __builtin_amdgcn_rcpf(wsf[32 + crow(r, hi)]);
  bf16_t* Ow = Ob + (rowbase + q0 + wid * QBLK) * DMQ + h * D;
  { bf16_t* stg = (bf16_t*)(shm + LDS_OST) + wid * 2048;
    #pragma unroll
    for (int r = 0; r < 16; ++r) { const int orow = crow(r, hi);
      #pragma unroll
      for (int d0 = 0; d0 < 2; ++d0) stg[orow * 64 + d0 * 32 + r32] = (bf16_t)f2bf(o[d0][r] * rli[r]); }
    asm volatile("s_waitcnt lgkmcnt(0)" ::: "memory");
    #pragma unroll
    for (int i = 0; i < 4; ++i) { const int row = i * 8 + (lane >> 3), ch = lane & 7; const u32x4 v = *(const u32x4*)(stg + row * 64 + ch * 8); ATTN_STORE16(Ow + (long)row * DMQ + ch * 8, v); } }
  asm volatile("s_waitcnt lgkmcnt(0)\n\ts_barrier" ::: "memory");
  #undef DMA_K
  #undef DMA_V
  #undef CMASK
  #undef START
  #undef RESC
  #undef ROT
  #undef SELROW
  #undef NEGM_SET
}
#undef SBAR
#undef WAIT_BAR
}
__device__ __forceinline__ void conv_pass(Frame& F) {
    bf16_t* YAB = WSP(bf16_t, WS_YAB); const bf16_t* U = WSP(bf16_t, WS_U); const bf16_t* BG = WSP(bf16_t, WS_BG);
    const int stride = F.G * NTHREADS;
    for (int i0 = blockIdx.x * NTHREADS + F.tid; i0 < T * 64; i0 += 2 * stride) {
        u32x4 r2[2], r1[2], r0[2], rb[2];
#pragma unroll
        for (int q = 0; q < 2; ++q) { const int i = i0 + q * stride; const int t = i >> 6, c0 = (i & 63) * 8, pos = t & (S - 1);
            r2[q] = *(const u32x4*)(U + (size_t)t * 512 + c0); rb[q] = *(const u32x4*)(BG + (size_t)t * 512 + c0);
            r1[q] = (pos >= 1) ? *(const u32x4*)(U + (size_t)(t - 1) * 512 + c0) : (u32x4){0u, 0u, 0u, 0u};
            r0[q] = (pos >= 2) ? *(const u32x4*)(U + (size_t)(t - 2) * 512 + c0) : (u32x4){0u, 0u, 0u, 0u}; }
#pragma unroll
        for (int q = 0; q < 2; ++q) { const int i = i0 + q * stride; const int t = i >> 6, c0 = (i & 63) * 8;
            float u0[8], u1[8], u2[8], bg[8], y[8]; unpack8(r2[q], u2); unpack8(r1[q], u1); unpack8(r0[q], u0); unpack8(rb[q], bg);
#pragma unroll
            for (int e4 = 0; e4 < 2; ++e4) { const f32x4 w0 = *(const f32x4*)(F.conv_w + c0 + 4 * e4), w1 = *(const f32x4*)(F.conv_w + 512 + c0 + 4 * e4), w2 = *(const f32x4*)(F.conv_w + 1024 + c0 + 4 * e4), cb = *(const f32x4*)(F.conv_b + c0 + 4 * e4);
#pragma unroll
                for (int e = 0; e < 4; ++e) y[4 * e4 + e] = bg[4 * e4 + e] * (w0[e] * u0[4 * e4 + e] + w1[e] * u1[4 * e4 + e] + w2[e] * u2[4 * e4 + e] + cb[e]); }
            st16(YAB + (size_t)t * 1024 + 512 + c0, pack8(y)); }
    }
}
__device__ __forceinline__ void s3_attn(Frame& F, char* lds_gen, bf16_t* obase) {
    const int vcu = (blockIdx.x % 8) * (F.G / 8) + blockIdx.x / 8;
    const int s = vcu & 7, pr = vcu >> 3;
    for (int i = 0; i < 4; ++i) {
        const int bh = 2 * pr + (i >> 1), qb = (i & 1) ? 15 - s : s;
        attn_body::attn_unit<8>(bh >> 3, bh & 7, qb, WSP(bf16_t, WS_YAB), obase, WSP(bf16_t, WS_K), WSP(bf16_t, WS_V), WSP(float, WS_KMEAN), lds_gen);
    }
}
__device__ __forceinline__ void s3_fast(Frame& F, char* lds_gen) { s3_attn(F, lds_gen, WSP(bf16_t, WS_YAB)); conv_pass(F); }

__device__ __forceinline__ void s4_simple(Frame& F) {
    LAS float* tile = (LAS float*)F.lds; LAS float* tile2 = tile + 64 * 65;
    const bf16_t* YAB = WSP(bf16_t, WS_YAB); const bf16_t* WP = WSP(bf16_t, WS_WP_T); const bf16_t* GT = WSP(bf16_t, WS_GATES);
    const int row = F.tid >> 3, seg = F.tid & 7;
    for (int it = blockIdx.x; it < 512 * 16; it += F.G) {
        const int rt = it >> 4, ct = it & 15, r0 = rt * 64, gr = r0 + row;
        const RowsLinear aa{YAB + (size_t)r0 * 1024, 1024}, ab{YAB + (size_t)r0 * 1024 + 512, 1024};
        const RowsLinear ba{WP + (size_t)(64 * ct) * 1024, 1024}, bb{WP + (size_t)(64 * ct) * 1024 + 512, 1024};
        sgemm_tile(tile, 512, aa, ba, F.wave, F.lane); sgemm_tile(tile2, 512, ab, bb, F.wave, F.lane); __syncthreads();
        float ga[8], gb[8], v[8];
        unpack8(*(const u32x4*)(GT + (size_t)gr * 2048 + 64 * ct + 8 * seg), ga); unpack8(*(const u32x4*)(GT + (size_t)gr * 2048 + 1024 + 64 * ct + 8 * seg), gb);
#pragma unroll
        for (int e = 0; e < 8; ++e) v[e] = ga[e] * tile[row * 65 + 8 * seg + e] + gb[e] * tile2[row * 65 + 8 * seg + e];
        *(u32x4*)(WSP(bf16_t, WS_H) + (size_t)gr * 1024 + 64 * ct + 8 * seg) = pack8(v);
        __syncthreads();
    }
}
__device__ __forceinline__ void s5_simple(Frame& F) {
    LAS float* tile = (LAS float*)F.lds;
    const bf16_t* MG = WSP(bf16_t, WS_H); const bf16_t* WO = WSP(bf16_t, WS_WO_T);
    const int row = F.tid >> 3, seg = F.tid & 7;
    for (int it = blockIdx.x; it < 512 * 16; it += F.G) {
        const int rt = it >> 4, ct = it & 15, r0 = rt * 64, gr = r0 + row, b = r0 / S;
        const RowsLinear aa{MG + (size_t)r0 * 1024, 1024}, bb{WO + (size_t)(64 * ct) * 1024, 1024};
        sgemm_tile(tile, 1024, aa, bb, F.wave, F.lane); __syncthreads();
        const float* ga1 = WSP(float, WS_MOD) + (size_t)b * NMOD + 2048 + 64 * ct + 8 * seg;
        const float* xr = F.x + (size_t)gr * D + 64 * ct + 8 * seg; float* orow = F.out + (size_t)gr * D + 64 * ct + 8 * seg;
#pragma unroll
        for (int e4 = 0; e4 < 2; ++e4) { const f32x4 xv = *(const f32x4*)(xr + 4 * e4), gv = *(const f32x4*)(ga1 + 4 * e4); f32x4 o;
#pragma unroll
            for (int e = 0; e < 4; ++e) o[e] = xv[e] + gv[e] * tile[row * 65 + 8 * seg + 4 * e4 + e];
            *(f32x4*)(orow + 4 * e4) = o; }
        __syncthreads();
    }
}

struct EpiG2 {
    static constexpr bool HAS_MID = true;
    const bf16_t* gates; bf16_t* merged;
    __device__ __forceinline__ void mid(Acc& acc, const pg8::Unit& u, int wr, int wc, int fr, int fq) const {
        int row0 = u.pm * 256 + wr * 64 + fr; const int c0 = u.pn * 256 + 32 * wc + 8 * fq; asm volatile("" : "+v"(row0));
#pragma unroll
        for (int ai = 0; ai < 2; ++ai)
#pragma unroll
            for (int m = 0; m < 4; ++m) { const bf16_t* gp = gates + (size_t)(row0 + 128 * ai + 16 * m) * 2048 + c0;
#pragma unroll
                for (int bj = 0; bj < 2; ++bj) { f32x4 a0, a1, b0, b1; unpack8v(*(const u32x4*)(gp + 128 * bj), a0, a1); unpack8v(*(const u32x4*)(gp + 1024 + 128 * bj), b0, b1);
#pragma unroll
                    for (int e = 0; e < 4; ++e) { acc[ai][bj][m][0][e] *= a0[e] * __builtin_amdgcn_rcpf(fmaxf(b0[e], 1e-12f)); acc[ai][bj][m][1][e] *= a1[e] * __builtin_amdgcn_rcpf(fmaxf(b1[e], 1e-12f)); }
 }
                if (m & 1) asm volatile("" ::: "memory"); }
    }
    __device__ __forceinline__ void operator()(Acc& acc, const pg8::Unit& u, int wr, int wc, int fr, int fq) const {
        int row0 = u.pm * 256 + wr * 64 + fr; const int c0 = u.pn * 256 + 32 * wc + 8 * fq; asm volatile("" : "+v"(row0));
#pragma unroll
        for (int ai = 0; ai < 2; ++ai)
#pragma unroll
            for (int m = 0; m < 4; ++m) { const size_t r = (size_t)(row0 + 128 * ai + 16 * m);
#pragma unroll
                for (int bj = 0; bj < 2; ++bj) { f32x4 b0, b1; unpack8v(*(const u32x4*)(gates + r * 2048 + 1024 + c0 + 128 * bj), b0, b1);
                    st16(merged + r * 1024 + c0 + 128 * bj, pack8v(acc[ai][bj][m][0] * b0, acc[ai][bj][m][1] * b1)); }
                if (m & 1) asm volatile("" ::: "memory"); }
    }
};
__device__ __forceinline__ void s4_fast(Frame& F) {
    const pg8::DenseSched Sd{(const char*)(F.ws + WS_YAB), (const char*)(F.ws + WS_WP_T), T / 256, 4, 1024, F.G, (int)blockIdx.x};
    const EpiG2 E{WSP(bf16_t, WS_GATES), WSP(bf16_t, WS_H)};
    pg8::gemm_phase<EpiG2, pg8::DenseSched>(F.lds, 1024, Sd, E);
}
struct EpiG3 {
    static constexpr bool HAS_MID = false;
    const float* x; bf16_t* x1; const float* mod;
    __device__ __forceinline__ void mid(Acc&, const pg8::Unit&, int, int, int, int) const {}
    __device__ __forceinline__ void operator()(Acc& acc, const pg8::Unit& u, int wr, int wc, int fr, int fq) const {
        int row0 = u.pm * 256 + wr * 64 + fr; const int c0 = u.pn * 256 + 32 * wc + 8 * fq, b = u.pm >> 4; asm volatile("" : "+v"(row0));
        f32x4 gv[2][2];
#pragma unroll
        for (int bj = 0; bj < 2; ++bj)
#pragma unroll
            for (int n = 0; n < 2; ++n) gv[bj][n] = *(const f32x4*)(mod + (size_t)b * NMOD + 2048 + c0 + 128 * bj + 4 * n);
#pragma unroll
        for (int ai = 0; ai < 2; ++ai)
#pragma unroll
            for (int m = 0; m < 4; ++m) { const size_t off = (size_t)(row0 + 128 * ai + 16 * m) * D + c0;
#pragma unroll
                for (int bj = 0; bj < 2; ++bj) { const f32x4 x0 = *(const f32x4*)(x + off + 128 * bj), x1v = *(const f32x4*)(x + off + 128 * bj + 4);
                    st16(x1 + off + 128 * bj, pack8v(x0 + gv[bj][0] * acc[ai][bj][m][0], x1v + gv[bj][1] * acc[ai][bj][m][1])); }
                if (m == 3) asm volatile("" ::: "memory"); }
    }
};
__device__ __forceinline__ void s5_fast(Frame& F) {
    const pg8::DenseSched Sd{(const char*)(F.ws + WS_H), (const char*)(F.ws + WS_WO_T), T / 256, 4, 1024, F.G, (int)blockIdx.x};
    const EpiG3 E{F.x, WSP(bf16_t, WS_X1), WSP(float, WS_MOD)};
    pg8::gemm_phase<EpiG3, pg8::DenseSched>(F.lds, 1024, Sd, E);
}
struct MoeTab { const LAS int* cnt; const LAS int* tstart; const LAS int* tile_e; int nM; };
__device__ __forceinline__ MoeTab moe_table(Frame& F) {
    LAS int* cntL = (LAS int*)(F.lds + MISC_OFF + 1024); LAS int* ts = cntL + 32; LAS int* te = cntL + 96;
    if (F.tid < 32) cntL[F.tid] = (int)__hip_atomic_load(WSP(unsigned, WS_CTL) + CW_GCNT + 64 * F.tid, __ATOMIC_RELAXED, __HIP_MEMORY_SCOPE_AGENT);
    __syncthreads();
    if (F.tid == 0) { int pm = 0; for (int e = 0; e < 32; ++e) { ts[e] = pm; const int n = (cntL[e] + 255) >> 8; for (int i = 0; i < n; ++i) te[pm++] = e; } ts[32] = pm; }
    __syncthreads();
    return MoeTab{cntL, ts, te, ts[32]};
}
struct MoeUpSched {
    static constexpr bool GATHER = true;
    const char* h2; const char* w13; MoeTab tb; const int* linfo; int G, c;
    __device__ __forceinline__ bool next(int i, pg8::Unit& u) const { if (!pg8::static_unit(i, G, c, tb.nM, 4, u.pm, u.pn)) return false;
        u.e = tb.tile_e[u.pm]; u.rbase = (u.pm - tb.tstart[u.e]) * 256; u.a = h2; u.b = w13 + ((size_t)u.e * 1024 + 256 * u.pn) * 1024 * 2; return true; }
    __device__ __forceinline__ int row_index(const pg8::Unit& u, int r) const { const int rank = u.rbase + r; return rank < tb.cnt[u.e] ? (linfo[(size_t)u.e * 65536 + rank] >> 1) : 0; }
};
struct EpiUp {
    static constexpr bool HAS_MID = false;
    bf16_t* hid; const float* lw; const LAS int* cnt;
    __device__ __forceinline__ void mid(Acc&, const pg8::Unit&, int, int, int, int) const {}
    __device__ __forceinline__ void operator()(Acc& acc, const pg8::Unit& u, int wr, int wc, int fr, int fq) const {
        const int rl0 = wr * 64 + fr, c0 = u.pn * 128 + 32 * wc + 8 * fq, n_e = cnt[u.e];
#pragma unroll
        for (int ai = 0; ai < 2; ++ai)
#pragma unroll
            for (int m = 0; m < 4; ++m) { const int rl = rl0 + 128 * ai + 16 * m, rank = u.rbase + rl; const float wt = rank < n_e ? lw[(size_t)u.e * 65536 + rank] : 0.f; f32x4 o[2];
#pragma unroll
                for (int n = 0; n < 2; ++n)
#pragma unroll
                    for (int e = 0; e < 4; ++e) { const float a = acc[ai][0][m][n][e], c = acc[ai][1][m][n][e]; o[n][e] = a * __builtin_amdgcn_rcpf(1.f + __expf(-a)) * c * wt; }
                st16(hid + (size_t)(u.pm * 256 + rl) * 512 + c0, pack8v(o[0], o[1])); }
    }
};
__device__ __forceinline__ void s8_fast(Frame& F) {
    const MoeTab tb = moe_table(F);
    const MoeUpSched Sd{(const char*)(F.ws + WS_H2), (const char*)(F.ws + WS_W13_T), tb, WSP(int, WS_LINFO), F.G, (int)blockIdx.x};
    const EpiUp E{WSP(bf16_t, WS_HID), WSP(float, WS_LW), tb.cnt};
    pg8::gemm_phase<EpiUp, MoeUpSched>(F.lds, 1024, Sd, E);
}
struct MoeDownSched {
    static constexpr bool GATHER = false;
    const char* hid; const char* w2; MoeTab tb; int G, c;
    __device__ __forceinline__ bool next(int i, pg8::Unit& u) const { if (!pg8::static_unit(i, G, c, tb.nM, 4, u.pm, u.pn)) return false;
        u.e = tb.tile_e[u.pm]; u.rbase = (u.pm - tb.tstart[u.e]) * 256; u.a = hid + (size_t)u.pm * 256 * 512 * 2; u.b = w2 + ((size_t)u.e * 1024 + 256 * u.pn) * 512 * 2; return true; }
    __device__ __forceinline__ int row_index(const pg8::Unit&, int) const { return 0; }
};
struct EpiDown {
    static constexpr bool HAS_MID = false;
    bf16_t* yslot; const int* linfo; const LAS int* cnt;
    __device__ __forceinline__ void mid(Acc&, const pg8::Unit&, int, int, int, int) const {}
    __device__ __forceinline__ void operator()(Acc& acc, const pg8::Unit& u, int wr, int wc, int fr, int fq) const {
        const int rl0 = wr * 64 + fr, c0 = u.pn * 256 + 32 * wc + 8 * fq, n_e = cnt[u.e];
#pragma unroll
        for (int ai = 0; ai < 2; ++ai)
#pragma unroll
            for (int m = 0; m < 4; ++m) { const int rank = u.rbase + rl0 + 128 * ai + 16 * m;
                if (rank < n_e) { const int info = linfo[(size_t)u.e * 65536 + rank];
#pragma unroll
                    for (int bj = 0; bj < 2; ++bj) st16(yslot + (size_t)info * 1024 + c0 + 128 * bj, pack8v(acc[ai][bj][m][0], acc[ai][bj][m][1])); } }
    }
};
__device__ __forceinline__ void s9_fast(Frame& F) {
    const MoeTab tb = moe_table(F);
    const MoeDownSched Sd{(const char*)(F.ws + WS_HID), (const char*)(F.ws + WS_W2_T), tb, F.G, (int)blockIdx.x};
    const EpiDown E{WSP(bf16_t, WS_YSLOT), WSP(int, WS_LINFO), tb.cnt};
    pg8::gemm_phase<EpiDown, MoeDownSched>(F.lds, 512, Sd, E);
}

__device__ __forceinline__ void s6_router(Frame& F) {
    constexpr int WROW = 1032;
    LAS bf16_t* WT = (LAS bf16_t*)F.lds;
    LAS float* gsL = (LAS float*)(F.lds + 48 * WROW * 2);
    LAS float* shL = gsL + 1024;
    LAS float* biasL = shL + 1024;
    LAS float* lgt = biasL + 64;
    LAS int* cnt = (LAS int*)(F.lds + MISC_OFF + 256);
    LAS int* baseL = cnt + 32; LAS int* runL = cnt + 64; LAS int* eidL = cnt + 128; LAS float* ewL = (LAS float*)(cnt + 384);
    const int b = blockIdx.x >> 5;
    const float* mod = WSP(float, WS_MOD) + (size_t)b * NMOD;
    const float* W36 = WSP(float, WS_W36T);
    for (int i = F.tid; i < 36 * 256; i += NTHREADS) { const int jj = i >> 8, k4 = (i & 255) * 4; const f32x4 w = *(const f32x4*)(W36 + jj * 1024 + k4);
        u32x2 p; p.x = pk2(w.x, w.y); p.y = pk2(w.z, w.w); *(LAS u32x2*)(WT + jj * WROW + k4) = p; }
    for (int i = F.tid; i < 12 * 256; i += NTHREADS) { const int jj = 36 + (i >> 8), k4 = (i & 255) * 4; *(LAS u32x2*)(WT + jj * WROW + k4) = (u32x2){0u, 0u}; }
    if (F.tid < 256) { const int col = 4 * F.tid; const f32x4 g = *(const f32x4*)(F.g2 + col), s_ = *(const f32x4*)(mod + 4096 + col); *(LAS f32x4*)(gsL + col) = g * (s_ + 1.0f); *(LAS f32x4*)(shL + col) = *(const f32x4*)(mod + 3072 + col); }
    if (F.tid < 32) cnt[F.tid] = 0;
    __syncthreads();
    for (int jj = F.wave; jj < 36; jj += NWAVES) { float a = 0.f;
#pragma unroll
        for (int i = 0; i < 16; ++i) a += shL[F.lane + 64 * i] * W36[jj * 1024 + F.lane + 64 * i];
        a = wave_sum(a); if (F.lane == 0) biasL[jj] = a + ((jj < 4) ? F.b_rg[jj] : F.b_re[jj - 4]); }
    __syncthreads();
    const int fr = F.lane & 15, fq = F.lane >> 4, row0 = (blockIdx.x * NWAVES + F.wave) * 16, r = row0 + fr;
    const bf16_t* xr = WSP(bf16_t, WS_X1) + (size_t)r * D + 8 * fq;
    f32x4 D0 = {0.f, 0.f, 0.f, 0.f}, D1 = D0, D2 = D0; float ss = 0.f;
#pragma unroll 1
    for (int kb = 0; kb < 8; ++kb) {
        u32x4 xa[4];
#pragma unroll
        for (int i = 0; i < 4; ++i) xa[i] = *(const u32x4*)(xr + 32 * (4 * kb + i));
#pragma unroll
        for (int i = 0; i < 4; ++i) { const int k0 = 32 * (4 * kb + i) + 8 * fq;
            f32x4 a0, a1; unpack8v(xa[i], a0, a1);
            ss += (a0.x * a0.x + a0.y * a0.y) + (a0.z * a0.z + a0.w * a0.w) + (a1.x * a1.x + a1.y * a1.y) + (a1.z * a1.z + a1.w * a1.w);
            a0 *= *(const LAS f32x4*)(gsL + k0); a1 *= *(const LAS f32x4*)(gsL + k0 + 4);
            const bf16x8 A = __builtin_bit_cast(bf16x8, pack8v(a0, a1));
            const bf16x8 B0 = *(const LAS bf16x8*)(WT + fr * WROW + k0), B1 = *(const LAS bf16x8*)(WT + (16 + fr) * WROW + k0), B2 = *(const LAS bf16x8*)(WT + (32 + fr) * WROW + k0);
            D0 = __builtin_amdgcn_mfma_f32_16x16x32_bf16(A, B0, D0, 0, 0, 0);
            D1 = __builtin_amdgcn_mfma_f32_16x16x32_bf16(A, B1, D1, 0, 0, 0);
            D2 = __builtin_amdgcn_mfma_f32_16x16x32_bf16(A, B2, D2, 0, 0, 0); }
    }
    ss += __shfl_xor(ss, 16); ss += __shfl_xor(ss, 32);
    const float rinv = rsqrtf(ss * (1.f / D) + EPS);
    { int t2 = threadIdx.x; asm volatile("" : "+v"(t2)); F.lane = t2 & 63; }
    const int fr_ = F.lane & 15, fq_ = F.lane >> 4;
    {
        LAS float* lw = lgt + F.wave * 16 * 37;
#pragma unroll
        for (int reg = 0; reg < 4; ++reg) { const float rv = __shfl(rinv, 4 * fq_ + reg); const int tk = 4 * fq_ + reg;
            lw[tk * 37 + fr_] = D0[reg] * rv + biasL[fr_]; lw[tk * 37 + 16 + fr_] = D1[reg] * rv + biasL[16 + fr_];
            if (fr_ < 4) lw[tk * 37 + 32 + fr_] = D2[reg] * rv + biasL[32 + fr_]; }
    }
    {
        const int r_ = row0 + fr_; const bf16_t* xr_ = WSP(bf16_t, WS_X1) + (size_t)r_ * D + 8 * fq_;
        bf16_t* o = WSP(bf16_t, WS_H2) + (size_t)r_ * D + 8 * fq_;
#pragma unroll 1
        for (int kb = 0; kb < 8; ++kb) {
            u32x4 xa[4];
#pragma unroll
            for (int i = 0; i < 4; ++i) xa[i] = *(const u32x4*)(xr_ + 32 * (4 * kb + i));
#pragma unroll
            for (int i = 0; i < 4; ++i) { const int k0 = 32 * (4 * kb + i) + 8 * fq_; f32x4 a0, a1; unpack8v(xa[i], a0, a1);
                const f32x4 h0 = a0 * rinv * *(const LAS f32x4*)(gsL + k0) + *(const LAS f32x4*)(shL + k0), h1 = a1 * rinv * *(const LAS f32x4*)(gsL + k0 + 4) + *(const LAS f32x4*)(shL + k0 + 4);
                st16(o + 32 * (4 * kb + i), pack8v(h0, h1)); }
        }
    }
    if (F.lane < 16) {
        const int t = row0 + F.lane; const LAS float* lw = lgt + (F.wave * 16 + F.lane) * 37;
        float lg[36];
#pragma unroll
        for (int jj = 0; jj < 36; ++jj) lg[jj] = lw[jj];
        int gi = 0; float gm = lg[0];
#pragma unroll
        for (int i = 1; i < 4; ++i) if (lg[i] > gm) { gm = lg[i]; gi = i; }
        float den = 0.f;
#pragma unroll
        for (int i = 0; i < 4; ++i) den += __expf(lg[i] - gm);
        const float gw_ = 1.f / den;
        float v1 = -INFINITY, v2 = -INFINITY; int e1 = 0, e2 = 0;
#pragma unroll
        for (int i = 0; i < 8; ++i) { const float el = (gi == 0) ? lg[4 + i] : (gi == 1) ? lg[12 + i] : (gi == 2) ? lg[20 + i] : lg[28 + i];
            const bool c1 = el > v1, c2 = el > v2;
            v2 = c1 ? v1 : (c2 ? el : v2); e2 = c1 ? e1 : (c2 ? i : e2); v1 = c1 ? el : v1; e1 = c1 ? i : e1; }
        const float p1 = 1.f / (1.f + __expf(v2 - v1)), p2 = 1.f - p1;
        const int id1 = gi * 8 + e1, id2 = gi * 8 + e2;
        const int la = 2 * (F.wave * 16 + F.lane);
        eidL[la] = id1; eidL[la + 1] = id2; ewL[la] = p1 * gw_; ewL[la + 1] = p2 * gw_;
        lds_add(&cnt[id1], 1); lds_add(&cnt[id2], 1);
    }
    __syncthreads();
    if (F.tid < 32) { baseL[F.tid] = (int)__hip_atomic_fetch_add(WSP(unsigned, WS_CTL) + CW_GCNT + 64 * F.tid, (unsigned)cnt[F.tid], __ATOMIC_RELAXED, __HIP_MEMORY_SCOPE_AGENT); runL[F.tid] = 0; }
    __syncthreads();
    if (F.tid < 256) { const int e = eidL[F.tid]; const int pos = baseL[e] + lds_add(&runL[e], 1);
        WSP(int, WS_LINFO)[(size_t)e * 65536 + pos] = 2 * (blockIdx.x * 128) + F.tid; WSP(float, WS_LW)[(size_t)e * 65536 + pos] = ewL[F.tid]; }
}

__device__ __forceinline__ void s7_lists(Frame& F) {
    LAS int* sm = (LAS int*)F.lds;
    const int* bc = WSP(int, WS_BCNT);
    if (F.tid < 32) { int tot = 0, base = 0; for (int bb = 0; bb < 256; ++bb) { const int c = bc[bb * 32 + F.tid]; if (bb < (int)blockIdx.x) base += c; tot += c; }
        sm[F.tid] = tot; sm[32 + F.tid] = base; sm[96 + F.tid] = 0; }
    __syncthreads();
    if (F.tid == 0) { int ps = 0; for (int e = 0; e < 32; ++e) { sm[64 + e] = ps; ps += (sm[e] + 255) & ~255; }
        if (blockIdx.x == 0) { int* te = WSP(int, WS_TILEE); int pm = 0; for (int e = 0; e < 32; ++e) { const int n = (sm[e] + 255) >> 8; for (int i = 0; i < n; ++i) te[1 + pm++] = e; } te[0] = pm; } }
    __syncthreads();
    int* atok = WSP(int, WS_ATOK); int* ainfo = WSP(int, WS_AINFO); float* aw = WSP(float, WS_AW);
    if (F.tid < 256) { const int a = blockIdx.x * 256 + F.tid;
        const int e = WSP(int, WS_EID)[a]; const int rank = lds_add(&sm[96 + e], 1); const int pos = sm[64 + e] + sm[32 + e] + rank;
        atok[pos] = a >> 1; ainfo[pos] = a; aw[pos] = WSP(float, WS_EW)[a]; }
    if (blockIdx.x < 32) { const int e = blockIdx.x; const int lo = sm[64 + e] + sm[e], hi = sm[64 + e] + ((sm[e] + 255) & ~255);
        for (int p = lo + F.tid; p < hi; p += NTHREADS) { atok[p] = 0; ainfo[p] = -1; aw[p] = 0.f; } }
}

struct RowsGather { const bf16_t* base; const int* idx; __device__ __forceinline__ const bf16_t* operator()(int r) const { return base + (size_t)idx[r] * 1024; } };
__device__ __forceinline__ void s8_simple(Frame& F) {
    LAS float* tile = (LAS float*)F.lds; LAS float* tile2 = tile + 64 * 65;
    const int* te = WSP(int, WS_TILEE); const int nmt = te[0];
    const int row = F.tid >> 3, seg = F.tid & 7;
    for (int it = blockIdx.x; it < nmt * 4 * 8; it += F.G) {
        const int rt = it >> 3, ct = it & 7, e = te[1 + (rt >> 2)], pos0 = 64 * rt, hc = 64 * ct;
        const RowsGather ar{WSP(bf16_t, WS_H2), WSP(int, WS_ATOK) + pos0};
        const bf16_t* wb = WSP(bf16_t, WS_W13_T) + ((size_t)e * 1024 + 256 * (hc >> 7) + (hc & 127)) * 1024;
        const RowsLinear b1{wb, 1024}, b3{wb + (size_t)128 * 1024, 1024};
        sgemm_tile(tile, 1024, ar, b1, F.wave, F.lane); sgemm_tile(tile2, 1024, ar, b3, F.wave, F.lane); __syncthreads();
        const float wt = WSP(float, WS_AW)[pos0 + row]; float v[8];
#pragma unroll
        for (int e8 = 0; e8 < 8; ++e8) { const float a = tile[row * 65 + 8 * seg + e8], c = tile2[row * 65 + 8 * seg + e8]; v[e8] = (a / (1.f + __expf(-a))) * c * wt; }
        *(u32x4*)(WSP(bf16_t, WS_HID) + (size_t)(pos0 + row) * 512 + hc + 8 * seg) = pack8(v);
        __syncthreads();
    }
}
__device__ __forceinline__ void s9_simple(Frame& F) {
    LAS float* tile = (LAS float*)F.lds;
    const int* te = WSP(int, WS_TILEE); const int nmt = te[0];
    const int row = F.tid >> 3, seg = F.tid & 7;
    for (int it = blockIdx.x; it < nmt * 4 * 16; it += F.G) {
        const int rt = it >> 4, ct = it & 15, e = te[1 + (rt >> 2)], pos0 = 64 * rt;
        const RowsLinear ar{WSP(bf16_t, WS_HID) + (size_t)pos0 * 512, 512};
        const RowsLinear br{WSP(bf16_t, WS_W2_T) + ((size_t)e * 1024 + 64 * ct) * 512, 512};
        sgemm_tile(tile, 512, ar, br, F.wave, F.lane); __syncthreads();
        const int info = WSP(int, WS_AINFO)[pos0 + row];
        if (info >= 0) { float v[8];
#pragma unroll
            for (int e8 = 0; e8 < 8; ++e8) v[e8] = tile[row * 65 + 8 * seg + e8];
            *(u32x4*)(WSP(bf16_t, WS_YSLOT) + (size_t)info * 1024 + 64 * ct + 8 * seg) = pack8(v); }
        __syncthreads();
    }
}
__device__ __forceinline__ void s10_combine(Frame& F) {
    const bf16_t* Y = WSP(bf16_t, WS_YSLOT); const bf16_t* X1 = WSP(bf16_t, WS_X1);
    const int stride = F.G * NTHREADS;
    for (int i0 = blockIdx.x * NTHREADS + F.tid; i0 < T * 128; i0 += 2 * stride) {
        u32x4 ya[2], yb[2], xx[2]; f32x4 g0[2], g1[2];
#pragma unroll
        for (int q = 0; q < 2; ++q) { const int i = i0 + q * stride; const int t = i >> 7, c0 = (i & 127) * 8, b = t / S;
            ya[q] = *(const u32x4*)(Y + (size_t)(2 * t) * 1024 + c0); yb[q] = *(const u32x4*)(Y + (size_t)(2 * t + 1) * 1024 + c0); xx[q] = *(const u32x4*)(X1 + (size_t)t * D + c0);
            const float* ga2 = WSP(float, WS_MOD) + (size_t)b * NMOD + 5120 + c0; g0[q] = *(const f32x4*)ga2; g1[q] = *(const f32x4*)(ga2 + 4); }
#pragma unroll
        for (int q = 0; q < 2; ++q) { const int i = i0 + q * stride; const int t = i >> 7, c0 = (i & 127) * 8;
            f32x4 y0a, y0b, y1a, y1b, xa, xb; unpack8v(ya[q], y0a, y0b); unpack8v(yb[q], y1a, y1b); unpack8v(xx[q], xa, xb);
            float* o = F.out + (size_t)t * D + c0;
            *(f32x4*)o = xa + g0[q] * (y0a + y1a); *(f32x4*)(o + 4) = xb + g1[q] * (y0b + y1b); }
    }
}

constexpr int N_PHASES = 11;
struct Args { const float* in[21]; float* out; unsigned char* ws; int ph_lo, ph_hi; };
__global__ void __launch_bounds__(NTHREADS, 2) mega_fwd(Args args) {
    extern __shared__ __attribute__((aligned(16))) unsigned char lds_raw[];
    Frame F;
    F.lds = (LAS unsigned char*)lds_raw;
    F.tid = threadIdx.x; F.lane = F.tid & 63; F.wave = __builtin_amdgcn_readfirstlane(F.tid >> 6); F.G = gridDim.x;
    F.x = args.in[0]; F.c = args.in[1]; F.w_ada = args.in[2]; F.b_ada = args.in[3]; F.g1 = args.in[4]; F.g2 = args.in[5]; F.w_in = args.in[6]; F.g_q = args.in[7]; F.g_k = args.in[8];
    F.conv_w = args.in[9]; F.conv_b = args.in[10]; F.w_pa = args.in[11]; F.w_pb = args.in[12]; F.w_o = args.in[13]; F.w_rg = args.in[14]; F.b_rg = args.in[15]; F.w_re = args.in[16]; F.b_re = args.in[17];
    F.w1 = args.in[18]; F.w3 = args.in[19]; F.w2 = args.in[20]; F.out = args.out; F.ws = args.ws;
    volatile LAS unsigned* MISC = (volatile LAS unsigned*)(F.lds + MISC_OFF);
    if (F.tid < 64) MISC[F.tid] = 0u;
    __syncthreads();
    XcdBarrier bar = xcd_barrier_post((unsigned*)(F.ws + WS_CTL) + CW_BAR, MISC + 8);
    const int lo = args.ph_lo, hi = args.ph_hi;
#ifndef REPEAT_MASK
#define REPEAT_MASK 0
#endif
#define PHASE(k, body) if (lo <= (k) && (k) < hi) { for (int rep_ = 0; rep_ < 1 + ((REPEAT_MASK >> (k)) & 1); ++rep_) { { int t_ = threadIdx.x; asm volatile("" : "+v"(t_)); F.tid = t_; F.lane = t_ & 63; } body; __syncthreads(); } if ((k) + 1 < hi) xcd_barrier(bar); }
    PHASE(0, s0_prologue(F); wait_mod(F); s1_norm1(F))
    PHASE(2, s2_fast(F))
    PHASE(3, s3_fast(F, (char*)lds_raw))
    PHASE(4, s4_fast(F))
    PHASE(5, s5_fast(F))
    PHASE(6, s6_router(F))
    PHASE(8, s8_fast(F))
    PHASE(9, s9_fast(F))
    PHASE(10, s10_combine(F))
#undef PHASE
}

extern "C" void kernel_launch(void* const* d_in, const int* in_sizes, int n_in, void* d_out, int out_size, void* d_ws, size_t ws_size, hipStream_t stream) {
    static int grid = 0;
    if (grid == 0) {
        if (n_in != 21 || in_sizes[0] != T * D || out_size != T * D || ws_size < WS_END) { fprintf(stderr, "kernel_launch: unexpected shapes (n_in %d, in0 %d, out %d, ws %zu); nothing launched\n", n_in, n_in > 0 ? in_sizes[0] : -1, out_size, ws_size); grid = -1; return; }
        int dev = 0, cus = 0, per_cu = 0;
        if (hipGetDevice(&dev) != hipSuccess || hipDeviceGetAttribute(&cus, hipDeviceAttributeMultiprocessorCount, dev) != hipSuccess) { grid = -1; return; }
        if (hipFuncSetAttribute((const void*)mega_fwd, hipFuncAttributeMaxDynamicSharedMemorySize, LDS_BYTES) != hipSuccess) { fprintf(stderr, "kernel_launch: hipFuncSetAttribute failed\n"); grid = -1; return; }
        if (hipOccupancyMaxActiveBlocksPerMultiprocessor(&per_cu, (const void*)mega_fwd, NTHREADS, LDS_BYTES) != hipSuccess || per_cu < 1) { fprintf(stderr, "kernel_launch: occupancy query says %d blocks per CU\n", per_cu); per_cu = 1; }
        (void)hipGetLastError();
        if (cus < 256) { fprintf(stderr, "kernel_launch: built for a 256-CU device, found %d CUs; nothing launched\n", cus); grid = -1; return; }
        grid = 256;
    }
    if (grid < 0) return;
    (void)hipMemsetAsync((char*)d_ws + WS_CTL, 0, CTL_ZERO_BYTES, stream);
    Args a{};
    for (int i = 0; i < 21; ++i) a.in[i] = (const float*)d_in[i];
    a.out = (float*)d_out; a.ws = (unsigned char*)d_ws; a.ph_lo = 0; a.ph_hi = N_PHASES;
    hipLaunchKernelGGL(mega_fwd, dim3(grid), dim3(NTHREADS), LDS_BYTES, stream, a);
}
```

```cpp
#include <hip/hip_runtime.h>
#include <hip/hip_bf16.h>
#include <cstdio>
#include <cstdint>

#define GAS __attribute__((address_space(1)))
#define LAS __attribute__((address_space(3)))
typedef unsigned short bf16_t;
typedef short bf16x8 __attribute__((ext_vector_type(8)));
typedef float f32x4 __attribute__((ext_vector_type(4)));
typedef unsigned u32x4 __attribute__((ext_vector_type(4)));
typedef unsigned u32x2 __attribute__((ext_vector_type(2)));

constexpr int T = 32768, D = 1024, NB = 8, S = 4096, NH = 8, DH = 64, NIN = 5120, NE = 32, DE = 512, NMOD = 6144;
constexpr int NTHREADS = 512, NWAVES = 8;
constexpr float EPS = 1e-6f;
constexpr float C2 = 0.125f * 1.4426950408889634f;
constexpr int MAX_MT = 288;
constexpr int NPAD = MAX_MT * 256;

constexpr size_t MiB = 1u << 20, KiB = 1024;
constexpr size_t WS_CTL = 0, CTL_ZERO_BYTES = 1 * MiB;
constexpr size_t WS_MOD = 1 * MiB;
constexpr size_t WS_ROPE = 1 * MiB + 256 * KiB;
constexpr size_t WS_KMEAN = 1 * MiB + 512 * KiB;
constexpr size_t WS_EID = 2 * MiB;
constexpr size_t WS_EW = 2 * MiB + 256 * KiB;
constexpr size_t WS_BCNT = 2 * MiB + 512 * KiB;
constexpr size_t WS_TILEE = 2 * MiB + 768 * KiB;
constexpr size_t WS_ATOK = 3 * MiB;
constexpr size_t WS_AINFO = 3 * MiB + 512 * KiB;
constexpr size_t WS_AW = 4 * MiB;
constexpr size_t WS_W36T = 5 * MiB;
constexpr size_t WS_WIN_T = 8 * MiB;
constexpr size_t WS_WIN8 = 14 * MiB;
constexpr size_t WS_H8 = 56 * MiB;
constexpr size_t WS_WP_T = 18 * MiB;
constexpr size_t WS_WO_T = 20 * MiB;
constexpr size_t WS_W13_T = 24 * MiB;
constexpr size_t WS_W2_T = 88 * MiB;
constexpr size_t WS_H = 120 * MiB;
constexpr size_t WS_YAB = 184 * MiB;
constexpr size_t WS_K = 248 * MiB;
constexpr size_t WS_V = 280 * MiB;
constexpr size_t WS_U = 312 * MiB;
constexpr size_t WS_BG = 344 * MiB;
constexpr size_t WS_GATES = 376 * MiB;
constexpr size_t WS_X1 = 184 * MiB;
constexpr size_t WS_H2 = 120 * MiB;
constexpr size_t WS_HID = 248 * MiB;
constexpr size_t WS_YSLOT = 320 * MiB;
constexpr size_t WS_LINFO = 448 * MiB;
constexpr size_t WS_LW = 456 * MiB;
constexpr size_t WS_END = 504 * MiB;
constexpr int CW_BAR = 4096, CW_MODCNT = 8192, CW_GCNT = 12288;

constexpr int LDS_BYTES = 159744;
constexpr int MISC_OFF = 147456;

__device__ __forceinline__ unsigned f2bf(float f) { unsigned u = __builtin_bit_cast(unsigned, f); return (u + 0x7fffu + ((u >> 16) & 1u)) >> 16; }
__device__ __forceinline__ float bf2f(unsigned h) { return __builtin_bit_cast(float, h << 16); }
__device__ __forceinline__ unsigned pk2(float lo, float hi) { return f2bf(lo) | (f2bf(hi) << 16); }
__device__ __forceinline__ void unpack8(const u32x4 w, float (&v)[8]) {
    v[0] = bf2f(w.x & 0xffffu); v[1] = bf2f(w.x >> 16); v[2] = bf2f(w.y & 0xffffu); v[3] = bf2f(w.y >> 16);
    v[4] = bf2f(w.z & 0xffffu); v[5] = bf2f(w.z >> 16); v[6] = bf2f(w.w & 0xffffu); v[7] = bf2f(w.w >> 16);
}
__device__ __forceinline__ u32x4 pack8(const float (&v)[8]) { u32x4 w; w.x = pk2(v[0], v[1]); w.y = pk2(v[2], v[3]); w.z = pk2(v[4], v[5]); w.w = pk2(v[6], v[7]); return w; }
__device__ __forceinline__ u32x4 pack8v(const f32x4 a, const f32x4 b) { u32x4 w; w.x = pk2(a.x, a.y); w.y = pk2(a.z, a.w); w.z = pk2(b.x, b.y); w.w = pk2(b.z, b.w); return w; }
__device__ __forceinline__ void unpack8v(const u32x4 w, f32x4& a, f32x4& b) {
    a.x = bf2f(w.x & 0xffffu); a.y = bf2f(w.x >> 16); a.z = bf2f(w.y & 0xffffu); a.w = bf2f(w.y >> 16);
    b.x = bf2f(w.z & 0xffffu); b.y = bf2f(w.z >> 16); b.z = bf2f(w.w & 0xffffu); b.w = bf2f(w.w >> 16); }
#ifndef WT_STORES
#define WT_STORES 0
#endif
__device__ __forceinline__ void st16(void* p, const u32x4 v) {
#if WT_STORES
    asm volatile("global_store_dwordx4 %0, %1, off sc1\n\ts_nop 1" :: "v"(p), "v"(v) : "memory");
#else
    *(u32x4*)p = v;
#endif
}
typedef int i32x8 __attribute__((ext_vector_type(8)));
__device__ __forceinline__ u32x2 pack8_fp8(const f32x4 a, const f32x4 b) {
    int lo = 0, hi = 0;
    lo = __builtin_amdgcn_cvt_pk_fp8_f32(a.x, a.y, lo, false); lo = __builtin_amdgcn_cvt_pk_fp8_f32(a.z, a.w, lo, true);
    hi = __builtin_amdgcn_cvt_pk_fp8_f32(b.x, b.y, hi, false); hi = __builtin_amdgcn_cvt_pk_fp8_f32(b.z, b.w, hi, true);
    return (u32x2){(unsigned)lo, (unsigned)hi};
}
constexpr float W8_SCALE = 64.f;
#define LDS_WAIT() asm volatile("s_waitcnt lgkmcnt(0)" ::: "memory")
__device__ __forceinline__ int lds_add(LAS int* p, int v) { return __hip_atomic_fetch_add(p, v, __ATOMIC_RELAXED, __HIP_MEMORY_SCOPE_WORKGROUP); }

#define XB_TMO      128
#define XB_XCNT(j)  (256  + 64 * (j))
#define XB_XSUB(j)  (1280 + 64 * (j))
#define XB_XGEN(j)  (2304 + 64 * (j))
#define XB_TOP      3328
#define XB_TOPGEN   3392
#define XCD_BAR_WORDS 3456
#define XB_SPIN_CAP (1u << 22)
__device__ __forceinline__ unsigned xb_ld(unsigned* p)              { return __hip_atomic_load(p, __ATOMIC_RELAXED, __HIP_MEMORY_SCOPE_AGENT); }
__device__ __forceinline__ unsigned xb_add(unsigned* p, unsigned v) { return __hip_atomic_fetch_add(p, v, __ATOMIC_RELAXED, __HIP_MEMORY_SCOPE_AGENT); }
__device__ __forceinline__ unsigned xb_xcc_id() { return (unsigned)__builtin_amdgcn_s_getreg((3 << 11) | 20) & 0xFu; }
#define XB_SPIN(cond, bar) do { unsigned _sp = 0; while (cond) { __builtin_amdgcn_s_sleep(1); \
    if ((++_sp & 255u) == 0u) { if (xb_ld(&(bar)[XB_TMO])) break; if (_sp > XB_SPIN_CAP) { atomicAdd(&(bar)[XB_TMO], 1u); break; } } } } while (0)
struct XcdBarrier { unsigned* bar; unsigned x; volatile LAS unsigned* st; };
__device__ __forceinline__ XcdBarrier xcd_barrier_post(unsigned* bar, volatile LAS unsigned* st) {
    XcdBarrier b; b.bar = bar; b.x = xb_xcc_id(); b.st = st;
    if (threadIdx.x == 0) (void)xb_add(&bar[XB_XCNT(b.x)], 1u);
    return b;
}
__device__ __forceinline__ void xcd_barrier_complete(unsigned* bar, unsigned x, unsigned& nloc, unsigned& nx) {
    const unsigned G = gridDim.x * gridDim.y * gridDim.z;
    unsigned sum, cnt, mine, sp = 0u;
    for (;;) {
        sum = 0u; cnt = 0u; mine = 0u;
#pragma unroll
        for (unsigned j = 0; j < 16; ++j) { const unsigned c = xb_ld(&bar[XB_XCNT(j)]); sum += c; cnt += (c > 0u) ? 1u : 0u; mine = (j == x) ? c : mine; }
        if (sum == G) break;
        __builtin_amdgcn_s_sleep(1);
        if ((++sp & 255u) == 0u) { if (xb_ld(&bar[XB_TMO])) break; if (sp > XB_SPIN_CAP) { atomicAdd(&bar[XB_TMO], 1u); break; } }
    }
    nloc = mine > 0u ? mine : 1u; nx = cnt > 0u ? cnt : 1u;
}
__device__ __forceinline__ void xcd_barrier(const XcdBarrier& b) {
    asm volatile("s_waitcnt vmcnt(0)" ::: "memory");
    __syncthreads();
    if (threadIdx.x == 0) {
        unsigned* bar = b.bar;
        __builtin_amdgcn_s_waitcnt(0);
        unsigned nloc = b.st[0], nx = b.st[1];
        if (nloc == 0u) { xcd_barrier_complete(bar, b.x, nloc, nx); b.st[0] = nloc; b.st[1] = nx; }
        const unsigned old = xb_add(&bar[XB_XSUB(b.x)], 1u);
        const unsigned gen = old / nloc;
        if (old + 1u == (gen + 1u) * nloc) {
            __builtin_amdgcn_fence(__ATOMIC_RELEASE, "agent");
            asm volatile("s_waitcnt vmcnt(0)" ::: "memory");
            const unsigned og = xb_add(&bar[XB_TOP], 1u);
            const unsigned tg = og / nx;
            if (og + 1u == (tg + 1u) * nx) xb_add(&bar[XB_TOPGEN], 1u);
            else XB_SPIN(xb_ld(&bar[XB_TOPGEN]) == tg, bar);
            __builtin_amdgcn_fence(__ATOMIC_ACQUIRE, "agent");
            xb_add(&bar[XB_XGEN(b.x)], 1u);
            asm volatile("s_waitcnt vmcnt(0)" ::: "memory");
        } else {
            XB_SPIN(xb_ld(&bar[XB_XGEN(b.x)]) == gen, bar);
            __builtin_amdgcn_fence(__ATOMIC_ACQUIRE, "agent");
            asm volatile("s_waitcnt vmcnt(0)" ::: "memory");
        }
    }
    __syncthreads();
}

struct Frame {
    LAS unsigned char* lds;
    int tid, lane, wave, G;
    const float *x, *c, *w_ada, *b_ada, *g1, *g2, *w_in, *g_q, *g_k, *conv_w, *conv_b, *w_pa, *w_pb, *w_o, *w_rg, *b_rg, *w_re, *b_re, *w1, *w3, *w2;
    float* out; unsigned char* ws;
};
#define WSP(type, off) ((type*)(F.ws + (off)))

__device__ __forceinline__ void transpose_item(const float* W, int N, int k0, int n0, bf16_t* dst  , int pitch, LAS float* scr, int lane) {
#pragma unroll 8
    for (int i = 0; i < 32; ++i) { const int kk = 2 * i + (lane >> 5); scr[kk * 33 + (lane & 31)] = W[(size_t)(k0 + kk) * N + n0 + (lane & 31)]; }
    LDS_WAIT(); asm volatile("" ::: "memory");
    const int c = lane & 7;
#pragma unroll
    for (int j = 0; j < 4; ++j) { const int n = (lane >> 3) + 8 * j; const LAS float* s = scr + (8 * c) * 33 + n;
        u32x4 o; o.x = pk2(s[0 * 33], s[1 * 33]); o.y = pk2(s[2 * 33], s[3 * 33]); o.z = pk2(s[4 * 33], s[5 * 33]); o.w = pk2(s[6 * 33], s[7 * 33]);
        st16(dst + (size_t)n * pitch + 8 * c, o); }
    LDS_WAIT(); asm volatile("" ::: "memory");
}
__device__ __forceinline__ void transpose_item_fp8(const float* W, int N, int k0, int n0, unsigned char* dst  , int pitch, LAS float* scr, int lane) {
#pragma unroll 8
    for (int i = 0; i < 32; ++i) { const int kk = 2 * i + (lane >> 5); scr[kk * 33 + (lane & 31)] = W[(size_t)(k0 + kk) * N + n0 + (lane & 31)] * W8_SCALE; }
    LDS_WAIT(); asm volatile("" ::: "memory");
    const int n = lane >> 1, kh = lane & 1; const LAS float* sp = scr + (32 * kh) * 33 + n;
#pragma unroll
    for (int p = 0; p < 2; ++p) { u32x4 o;
#pragma unroll
        for (int w = 0; w < 4; ++w) { const LAS float* q = sp + (16 * p + 4 * w) * 33; int v = 0;
            v = __builtin_amdgcn_cvt_pk_fp8_f32(q[0], q[33], v, false); v = __builtin_amdgcn_cvt_pk_fp8_f32(q[66], q[99], v, true); o[w] = (unsigned)v; }
        *(u32x4*)(dst + (size_t)n * pitch + 32 * kh + 16 * p) = o; }
    LDS_WAIT(); asm volatile("" ::: "memory");
}
__device__ __forceinline__ int win_dest_row(int sc) {
    if (sc < 32) { const int isk = sc >> 4, s2 = sc & 15, hh = s2 >> 1, bj = s2 & 1; return 512 * isk + 256 * (hh >> 2) + 128 * bj + 32 * (hh & 3); }
    if (sc < 48) return 32 * sc;
    if (sc < 64) { const int cx = 32 * (sc - 48); return 256 * (6 + (cx >> 7)) + (cx & 127); }
    if (sc < 80) return 2560 + 32 * (sc - 64);
    if (sc < 96) { const int cx = 32 * (sc - 80); return 256 * (6 + (cx >> 7)) + 128 + (cx & 127); }
    return 3072 + 32 * (sc - 96);
}
__device__ __forceinline__ void s0_prologue(Frame& F) {
    const int gt = blockIdx.x * NTHREADS + F.tid;
    if (gt < NB * NH * 16 * 64) WSP(float, WS_KMEAN)[gt] = 0.f;
    if (gt < 36 * 1024) { const int jj = gt >> 10, k = gt & 1023; WSP(float, WS_W36T)[gt] = (jj < 4) ? F.w_rg[k * 4 + jj] : F.w_re[k * 32 + (jj - 4)]; }
    if (gt < S * 8) { const int pos = gt >> 3, i = gt & 7; const float inv = powf(500000.0f, -(float)(2 * i) / 16.0f); const float ang = (float)pos * inv;
        WSP(float2, WS_ROPE)[gt] = make_float2(cosf(ang), sinf(ang)); }
    if (blockIdx.x < 192) {
        LAS float* sc = (LAS float*)F.lds;
        for (int i = F.tid; i < NB * D; i += NTHREADS) { const float v = F.c[i]; sc[i] = v / (1.f + expf(-v)); }
        __syncthreads();
        const int j0 = blockIdx.x * 32, col = j0 + (F.lane & 31), kpar = F.lane >> 5;
        float acc[8];
#pragma unroll
        for (int b = 0; b < 8; ++b) acc[b] = 0.f;
        for (int i = 0; i < 64; ++i) { const int k = F.wave * 128 + 2 * i + kpar; const float w = F.w_ada[(size_t)k * NMOD + col];
#pragma unroll
            for (int b = 0; b < 8; ++b) acc[b] += sc[b * D + k] * w; }
#pragma unroll
        for (int b = 0; b < 8; ++b) acc[b] += __shfl_xor(acc[b], 32);
        LAS float* red = (LAS float*)(F.lds + 32768);
        if (F.lane < 32) {
#pragma unroll
            for (int b = 0; b < 8; ++b) red[(F.wave * 8 + b) * 32 + F.lane] = acc[b]; }
        __syncthreads();
        if (F.tid < 256) { const int b = F.tid >> 5, cc = F.tid & 31; float s = F.b_ada[j0 + cc];
#pragma unroll
            for (int w = 0; w < 8; ++w) s += red[(w * 8 + b) * 32 + cc];
            WSP(float, WS_MOD)[b * NMOD + j0 + cc] = s; }
        asm volatile("s_waitcnt vmcnt(0)" ::: "memory");
        __syncthreads();
        if (F.tid == 0) { __builtin_amdgcn_fence(__ATOMIC_RELEASE, "agent"); asm volatile("s_waitcnt vmcnt(0)" ::: "memory");
            __hip_atomic_fetch_add(WSP(unsigned, WS_CTL) + CW_MODCNT, 1u, __ATOMIC_RELAXED, __HIP_MEMORY_SCOPE_AGENT); }
    }
    LAS float* scr = (LAS float*)(F.lds + F.wave * 16384);
    const int gw = blockIdx.x * NWAVES + F.wave, NGW = F.G * NWAVES;
    constexpr int I_IN = 16 * 160, I_PA = 8 * 32, I_O = 16 * 32, I_E1 = 16 * 16, I_E2 = 8 * 32;
    constexpr int NITEMS = I_IN + 2 * I_PA + I_O + NE * (2 * I_E1 + I_E2);
    for (int it = gw; it < NITEMS; it += NGW) {
        int r = it;
        if (r < I_IN) { const int kb = r / 160, sc = r % 160;
            if (sc < 96) transpose_item(F.w_in, NIN, 64 * kb, 32 * sc, WSP(bf16_t, WS_WIN_T) + (size_t)win_dest_row(sc) * 1024 + 64 * kb, 1024, scr, F.lane);
            else transpose_item_fp8(F.w_in, NIN, 64 * kb, 32 * sc, WSP(unsigned char, WS_WIN8) + (size_t)(32 * (sc - 96)) * 1024 + 64 * kb, 1024, scr, F.lane);
            continue; } r -= I_IN;
        if (r < I_PA) { const int kb = r / 32, sc = r % 32; transpose_item(F.w_pa, 1024, 64 * kb, 32 * sc, WSP(bf16_t, WS_WP_T) + (size_t)(32 * sc) * 1024 + 64 * kb, 1024, scr, F.lane); continue; } r -= I_PA;
        if (r < I_PA) { const int kb = r / 32, sc = r % 32; transpose_item(F.w_pb, 1024, 64 * kb, 32 * sc, WSP(bf16_t, WS_WP_T) + (size_t)(32 * sc) * 1024 + 512 + 64 * kb, 1024, scr, F.lane); continue; } r -= I_PA;
        if (r < I_O) { const int kb = r / 32, sc = r % 32; transpose_item(F.w_o, 1024, 64 * kb, 32 * sc, WSP(bf16_t, WS_WO_T) + (size_t)(32 * sc) * 1024 + 64 * kb, 1024, scr, F.lane); continue; } r -= I_O;
        const int e = r / (2 * I_E1 + I_E2); r -= e * (2 * I_E1 + I_E2);
        if (r < 2 * I_E1) { const int is3 = r >= I_E1; if (is3) r -= I_E1; const int kb = r / 16, sc = r % 16;
            transpose_item_fp8((is3 ? F.w3 : F.w1) + (size_t)e * D * DE, DE, 64 * kb, 32 * sc, WSP(unsigned char, WS_W13_T) + ((size_t)e * 1024 + 256 * (sc >> 2) + 128 * is3 + 32 * (sc & 3)) * 1024 + 64 * kb, 1024, scr, F.lane); continue; }
        r -= 2 * I_E1;
        { const int kb = r / 32, sc = r % 32;
            transpose_item_fp8(F.w2 + (size_t)e * DE * D, D, 64 * kb, 32 * sc, WSP(unsigned char, WS_W2_T) + ((size_t)e * 1024 + 32 * sc) * 512 + 64 * kb, 512, scr, F.lane); }
    }
}

__device__ __forceinline__ void wait_mod(Frame& F) {
    if (F.tid == 0) { unsigned* c = WSP(unsigned, WS_CTL) + CW_MODCNT; unsigned sp = 0;
        while (__hip_atomic_load(c, __ATOMIC_RELAXED, __HIP_MEMORY_SCOPE_AGENT) < 192u) { __builtin_amdgcn_s_sleep(2); if (++sp > (1u << 24)) break; }
        __builtin_amdgcn_fence(__ATOMIC_ACQUIRE, "agent"); asm volatile("s_waitcnt vmcnt(0)" ::: "memory"); }
    __syncthreads();
}
template <int N> __device__ __forceinline__ float dpp_ror(float v) { return __builtin_bit_cast(float, __builtin_amdgcn_update_dpp(0, __builtin_bit_cast(int, v), 0x120 + N, 0xF, 0xF, false)); }
__device__ __forceinline__ float wave_sum(float v) {
#pragma unroll
    for (int o = 1; o < 64; o <<= 1) v += __shfl_xor(v, o);
    return v;
}
__device__ __forceinline__ void s1_norm1(Frame& F) {
    const int gw = blockIdx.x * NWAVES + F.wave;
    const int row0 = gw * 16, b = row0 / S;
    if (row0 >= T) return;
    const float* mod = WSP(float, WS_MOD) + (size_t)b * NMOD;
    f32x4 gs[4], sh[4];
#pragma unroll
    for (int j = 0; j < 4; ++j) { const int col = 4 * F.lane + 256 * j; const f32x4 g = *(const f32x4*)(F.g1 + col), s_ = *(const f32x4*)(mod + 1024 + col); gs[j] = g * (s_ + 1.0f); sh[j] = *(const f32x4*)(mod + col); }
    for (int r = 0; r < 16; r += 4) {
        f32x4 v[4][4]; float ss[4];
#pragma unroll
        for (int q = 0; q < 4; ++q) { const float* xr = F.x + (size_t)(row0 + r + q) * D;
#pragma unroll
            for (int j = 0; j < 4; ++j) v[q][j] = *(const f32x4*)(xr + 4 * F.lane + 256 * j); }
#pragma unroll
        for (int q = 0; q < 4; ++q) { ss[q] = 0.f;
#pragma unroll
            for (int j = 0; j < 4; ++j) ss[q] += (v[q][j].x * v[q][j].x + v[q][j].y * v[q][j].y) + (v[q][j].z * v[q][j].z + v[q][j].w * v[q][j].w); }
#pragma unroll
        for (int q = 0; q < 4; ++q) { const float rinv = rsqrtf(wave_sum(ss[q]) * (1.f / D) + EPS);
            bf16_t* o = WSP(bf16_t, WS_H) + (size_t)(row0 + r + q) * D;
#pragma unroll
            for (int j = 0; j < 4; ++j) { const f32x4 h = v[q][j] * rinv * gs[j] + sh[j]; u32x2 w; w.x = pk2(h.x, h.y); w.y = pk2(h.z, h.w); *(u32x2*)(o + 4 * F.lane + 256 * j) = w;
                int p8 = 0; p8 = __builtin_amdgcn_cvt_pk_fp8_f32(h.x, h.y, p8, false); p8 = __builtin_amdgcn_cvt_pk_fp8_f32(h.z, h.w, p8, true);
                *(int*)(WSP(unsigned char, WS_H8) + (size_t)(row0 + r + q) * D + 4 * F.lane + 256 * j) = p8; } }
    }
}

struct RowsLinear { const bf16_t* base; size_t pitch; __device__ __forceinline__ const bf16_t* operator()(int r) const { return base + (size_t)r * pitch; } };
template <class AR, class BR>
__device__ __forceinline__ void sgemm_tile(LAS float* tile, int K, const AR& arow, const BR& brow, int wave, int lane) {
    const int fr = lane & 15, fq = lane >> 4, rb = 16 * (wave & 3), cb = 32 * (wave >> 2);
    const bf16_t* ap = arow(rb + fr) + 8 * fq;
    const bf16_t* bp0 = brow(cb + fr) + 8 * fq;
    const bf16_t* bp1 = brow(cb + 16 + fr) + 8 * fq;
    f32x4 acc0 = {0.f, 0.f, 0.f, 0.f}, acc1 = {0.f, 0.f, 0.f, 0.f};
#pragma unroll 4
    for (int k = 0; k < K; k += 32) {
        const bf16x8 a = *(const bf16x8*)(ap + k), b0 = *(const bf16x8*)(bp0 + k), b1 = *(const bf16x8*)(bp1 + k);
        acc0 = __builtin_amdgcn_mfma_f32_16x16x32_bf16(a, b0, acc0, 0, 0, 0);
        acc1 = __builtin_amdgcn_mfma_f32_16x16x32_bf16(a, b1, acc1, 0, 0, 0);
    }
#pragma unroll
    for (int j = 0; j < 4; ++j) { tile[(rb + fq * 4 + j) * 65 + cb + fr] = acc0[j]; tile[(rb + fq * 4 + j) * 65 + cb + 16 + fr] = acc1[j]; }
}

struct WinRowsHead { const bf16_t* base; int rb; __device__ __forceinline__ const bf16_t* operator()(int d) const { return base + (size_t)(rb + 128 * (d >> 5) + (d & 31)) * 1024; } };
__device__ __forceinline__ void s2_simple(Frame& F) {
    LAS float* tile = (LAS float*)F.lds; LAS float* tile2 = tile + 64 * 65;
    const bf16_t* H = WSP(bf16_t, WS_H); const bf16_t* WT = WSP(bf16_t, WS_WIN_T);
    const int row = F.tid >> 3, seg = F.tid & 7;
    for (int it = blockIdx.x; it < 512 * 72; it += F.G) {
        const int rt = it / 72, ct = it % 72, r0 = rt * 64, gr = r0 + row;
        const RowsLinear ar{H + (size_t)r0 * 1024, 1024};
        float v[8];
        if (ct < 16) {
            const int isk = ct >> 3, hh = ct & 7;
            const WinRowsHead br{WT, 512 * isk + 256 * (hh >> 2) + 32 * (hh & 3)};
            sgemm_tile(tile, 1024, ar, br, F.wave, F.lane); __syncthreads();
            float ss = 0.f;
#pragma unroll
            for (int e = 0; e < 8; ++e) { v[e] = tile[row * 65 + 8 * seg + e]; ss += v[e] * v[e]; }
            ss += __shfl_xor(ss, 1); ss += __shfl_xor(ss, 2); ss += __shfl_xor(ss, 4);
            const float rinv = rsqrtf(ss * (1.f / 64.f) + EPS);
            const float* g = isk ? F.g_k : F.g_q;
            const int pos = gr & (S - 1);
#pragma unroll
            for (int e = 0; e < 8; ++e) { v[e] = v[e] * rinv * g[8 * seg + e]; const float pv = __shfl_xor(v[e], 1);
                if (seg < 2) { const float2 cs = WSP(float2, WS_ROPE)[pos * 8 + e]; v[e] = (seg == 0) ? (v[e] * cs.x - pv * cs.y) : (v[e] * cs.x + pv * cs.y); } }
            if (!isk) {
#pragma unroll
                for (int e = 0; e < 8; ++e) v[e] *= C2;
                *(u32x4*)(WSP(bf16_t, WS_YAB) + (size_t)gr * 1024 + hh * 64 + 8 * seg) = pack8(v);
            } else {
                *(u32x4*)(WSP(bf16_t, WS_K) + (size_t)gr * 512 + hh * 64 + 8 * seg) = pack8(v);
#pragma unroll
                for (int e = 0; e < 8; ++e) tile[row * 65 + 8 * seg + e] = v[e];
                __syncthreads();
                if (F.tid < 64) { float s = 0.f; for (int r = 0; r < 64; ++r) s += tile[r * 65 + F.tid];
                    const int b = r0 / S, blk = (r0 & (S - 1)) >> 8;
                    atomicAdd(WSP(float, WS_KMEAN) + ((size_t)(b * NH + hh) * 16 + blk) * 64 + F.tid, s * (1.f / 256.f)); }
            }
        } else if (ct < 24) {
            const RowsLinear br{WT + (size_t)(1024 + 64 * (ct - 16)) * 1024, 1024};
            sgemm_tile(tile, 1024, ar, br, F.wave, F.lane); __syncthreads();
#pragma unroll
            for (int e = 0; e < 8; ++e) v[e] = tile[row * 65 + 8 * seg + e];
            *(u32x4*)(WSP(bf16_t, WS_V) + (size_t)gr * 512 + 64 * (ct - 16) + 8 * seg) = pack8(v);
        } else if (ct < 32) {
            const int cu = 64 * (ct - 24), rb = 256 * (6 + (cu >> 7)) + (cu & 127);
            const RowsLinear bx{WT + (size_t)rb * 1024, 1024}, bc{WT + (size_t)(rb + 128) * 1024, 1024};
            sgemm_tile(tile, 1024, ar, bx, F.wave, F.lane); sgemm_tile(tile2, 1024, ar, bc, F.wave, F.lane); __syncthreads();
#pragma unroll
            for (int e = 0; e < 8; ++e) v[e] = tile[row * 65 + 8 * seg + e] * tile2[row * 65 + 8 * seg + e];
            *(u32x4*)(WSP(bf16_t, WS_U) + (size_t)gr * 512 + cu + 8 * seg) = pack8(v);
        } else if (ct < 40) {
            const RowsLinear br{WT + (size_t)(2560 + 64 * (ct - 32)) * 1024, 1024};
            sgemm_tile(tile, 1024, ar, br, F.wave, F.lane); __syncthreads();
#pragma unroll
            for (int e = 0; e < 8; ++e) v[e] = tile[row * 65 + 8 * seg + e];
            *(u32x4*)(WSP(bf16_t, WS_BG) + (size_t)gr * 512 + 64 * (ct - 32) + 8 * seg) = pack8(v);
        } else {
            const RowsLinear br{WT + (size_t)(3072 + 64 * (ct - 40)) * 1024, 1024};
            sgemm_tile(tile, 1024, ar, br, F.wave, F.lane); __syncthreads();
#pragma unroll
            for (int e = 0; e < 8; ++e) v[e] = 1.f / (1.f + __expf(-tile[row * 65 + 8 * seg + e]));
            *(u32x4*)(WSP(bf16_t, WS_GATES) + (size_t)gr * 2048 + 64 * (ct - 40) + 8 * seg) = pack8(v);
        }
        __syncthreads();
    }
}

namespace pg8 {
constexpr int BM = 256, BK = 64, HALF = 128, HTB = HALF * BK * 2, STAGE_BYTES = 8 * HTB, NXCD = 8, WGM = 8;
constexpr int VN_STASH = 147456 + 4096;
__device__ __forceinline__ int lds_byte(int r, int c) { const int st = (r >> 4) * 2 + (c >> 5), rr = r & 15, cc = c & 31, ob = rr * 64 + cc * 2; return st * 1024 + (ob ^ (((ob >> 9) & 1) << 5)); }
__device__ __forceinline__ void stage_rc(int b, int& R, int& C) { const int st = b / 1024, sb = b % 1024, swz = sb ^ (((sb >> 9) & 1) << 5); R = (st >> 1) * 16 + swz / 64; C = (st & 1) * 32 + (swz % 64) / 2; }
__device__ __forceinline__ int perm32(int rho) { const int n = rho >> 4, i = rho & 15; return 8 * (i >> 2) + 4 * n + (i & 3); }
struct Unit { int pm, pn; const char* a; const char* b; int e, rbase; };
__device__ __forceinline__ bool static_unit(int i, int G, int c, int nM, int nN, int& pm, int& pn) {
    const int nwg = nM * nN; const long L = (long)i * G + c; if (L >= nwg) return false;
    int wgid = (int)L; { const int q = nwg / NXCD, r = nwg % NXCD, xcd = wgid % NXCD, off = wgid / NXCD; wgid = (xcd < r ? xcd * (q + 1) : r * (q + 1) + (xcd - r) * q) + off; }
    const int nig = WGM * nN, gid = wgid / nig, fm = gid * WGM, gsz = (nM - fm) < WGM ? (nM - fm) : WGM;
    pm = fm + ((wgid % nig) % gsz); pn = (wgid % nig) / gsz; return true;
}
struct DenseSched {
    static constexpr bool GATHER = false, FP8 = false;
    const char* A; const char* Bt; int nM, nN, K, G, c;
    __device__ __forceinline__ bool next(int i, Unit& u) const { if (!static_unit(i, G, c, nM, nN, u.pm, u.pn)) return false;
        u.a = A + (size_t)u.pm * BM * K * 2; u.b = Bt + (size_t)u.pn * BM * K * 2; u.e = 0; u.rbase = 0; return true; }
    __device__ __forceinline__ int row_index(const Unit&, int) const { return 0; }
};

struct DenseSched8 {
    static constexpr bool GATHER = false, FP8 = true;
    const char* A; const char* Bt; int nM, nN, K, G, c;
    __device__ __forceinline__ bool next(int i, Unit& u) const { if (!static_unit(i, G, c, nM, nN, u.pm, u.pn)) return false;
        u.a = A + (size_t)u.pm * BM * K; u.b = Bt + (size_t)u.pn * BM * K; u.e = 0; u.rbase = 0; return true; }
    __device__ __forceinline__ int row_index(const Unit&, int) const { return 0; }
};
template <class Epi, class Sched>
__device__ __forceinline__ void gemm_phase(LAS unsigned char* lds, const int K, const Sched& S, const Epi& E) {
    const int tid = threadIdx.x, wid = __builtin_amdgcn_readfirstlane(tid >> 6), lane = tid & 63, wr = wid >> 2, wc = wid & 3, fr = lane & 15, fq = lane >> 4;
    constexpr bool FP8 = Sched::FP8;
    const int nt = FP8 ? K / 128 : K / BK;
    const int PB = FP8 ? K : 2 * K;
    unsigned voffB[2], vA[2][2], vN[2][2];
#pragma unroll
    for (int i = 0; i < 2; ++i) { int R, C; stage_rc(tid * 16 + i * 8192, R, C); const int Rb = (R & ~31) + perm32(R & 31);
        voffB[i] = (unsigned)(Rb * PB + C * 2);
        vA[0][i] = (unsigned)(R * PB + C * 2); vA[1][i] = (unsigned)((HALF + R) * PB + C * 2); vN[0][i] = vA[0][i]; vN[1][i] = vA[1][i]; }
    const size_t kstep = (size_t)(BK * 2);
    const size_t hstep = (size_t)HALF * PB;
    const unsigned ldsw = (unsigned)wid * 1024u;
    const int aoff = lds_byte(wr * 64 + fr, fq * 8), boff = lds_byte(wc * 32 + fr, fq * 8);
    const int aoff8a = lds_byte(wr * 64 + fr, fq * 16), aoff8b = lds_byte(wr * 64 + fr, fq * 16 + 8), boff8a = lds_byte(wc * 32 + fr, fq * 16), boff8b = lds_byte(wc * 32 + fr, fq * 16 + 8);
#define PG8_SA(b, h) (((b) * 2 + (h)) * HTB)
#define PG8_SB(b, h) ((4 + (b) * 2 + (h)) * HTB)
#define PG8_STAGE(bufoff, gbase, voff) do { _Pragma("unroll") for (int _i = 0; _i < 2; ++_i) \
        __builtin_amdgcn_global_load_lds((const unsigned*)((const char*)(gbase) + (voff)[_i]), (LAS unsigned*)(lds + (bufoff) + ldsw + _i * 8192), 16, 0, 0); } while (0)
#define PG8_LD16(off) (*(const LAS u32x4*)(lds + (off)))
#define PG8_LDA(dst, b, h) do { _Pragma("unroll") for (int m = 0; m < 4; ++m) { if constexpr (FP8) { dst##8[m] = __builtin_bit_cast(i32x8, __builtin_shufflevector(PG8_LD16(PG8_SA(b, h) + aoff8a + m * 2048), PG8_LD16(PG8_SA(b, h) + aoff8b + m * 2048), 0, 1, 2, 3, 4, 5, 6, 7)); } \
        else { _Pragma("unroll") for (int k = 0; k < 2; ++k) dst[m][k] = *(const LAS bf16x8*)(lds + PG8_SA(b, h) + aoff + m * 2048 + k * 1024); } } } while (0)
#define PG8_LDB(dst, b, h) do { _Pragma("unroll") for (int n = 0; n < 2; ++n) { if constexpr (FP8) { dst##8[n] = __builtin_bit_cast(i32x8, __builtin_shufflevector(PG8_LD16(PG8_SB(b, h) + boff8a + n * 2048), PG8_LD16(PG8_SB(b, h) + boff8b + n * 2048), 0, 1, 2, 3, 4, 5, 6, 7)); } \
        else { _Pragma("unroll") for (int k = 0; k < 2; ++k) dst[n][k] = *(const LAS bf16x8*)(lds + PG8_SB(b, h) + boff + n * 2048 + k * 1024); } } } while (0)
#define PG8_MMA(ai, bj, At, Bt) do { __builtin_amdgcn_s_setprio(1); _Pragma("unroll") for (int m = 0; m < 4; ++m) _Pragma("unroll") for (int n = 0; n < 2; ++n) { \
        if constexpr (FP8) { asm volatile("s_nop 1\n\tv_mfma_scale_f32_16x16x128_f8f6f4 %0, %1, %2, %0, %3, %3 op_sel_hi:[0,0,0]" : "+v"(acc[ai][bj][m][n]) : "v"(Bt##8[n]), "v"(At##8[m]), "v"(sc127)); } \
        else { _Pragma("unroll") for (int k = 0; k < 2; ++k) acc[ai][bj][m][n] = __builtin_amdgcn_mfma_f32_16x16x32_bf16(Bt[n][k], At[m][k], acc[ai][bj][m][n], 0, 0, 0); } } __builtin_amdgcn_s_setprio(0); } while (0)
#define PG8_WAIT_V(n) asm volatile("s_waitcnt vmcnt(" #n ")" ::: "memory")
#define PG8_WAIT_L(n) asm volatile("s_waitcnt lgkmcnt(" #n ")" ::: "memory")
#define PG8_BAR __builtin_amdgcn_s_barrier()
#define PG8_SCHED __builtin_amdgcn_sched_barrier(0)
#define PG8_AOFF(dst, u) do { int _t = threadIdx.x; asm volatile("" : "+v"(_t)); _Pragma("unroll") for (int _i = 0; _i < 2; ++_i) { int _R, _C; stage_rc(_t * 16 + _i * 8192, _R, _C); \
        _Pragma("unroll") for (int _h = 0; _h < 2; ++_h) dst[_h][_i] = (unsigned)(S.row_index(u, _h * HALF + _R) * PB + _C * 2); } } while (0)
    Unit cur, nxt; int ui = 0;
    if (!S.next(0, cur)) return;
    if constexpr (Sched::GATHER) PG8_AOFF(vA, cur);
    f32x4 acc[2][2][4][2];
#pragma unroll
    for (int a = 0; a < 2; ++a)
#pragma unroll
        for (int b = 0; b < 2; ++b)
#pragma unroll
            for (int m = 0; m < 4; ++m)
#pragma unroll
                for (int n = 0; n < 2; ++n) acc[a][b][m][n] = (f32x4){0.f, 0.f, 0.f, 0.f};
    const int sc127 = 127;
    bf16x8 At[4][2], B0[2][2], B1[2][2]; i32x8 At8[4], B08[2], B18[2];
    const char* cA = cur.a; const char* cB = cur.b;
    PG8_STAGE(PG8_SB(0, 0), cB, voffB); PG8_STAGE(PG8_SB(0, 1), cB + hstep, voffB); PG8_STAGE(PG8_SA(0, 0), cA, vA[0]); PG8_STAGE(PG8_SA(0, 1), cA, vA[1]);
    if (wr == 1) PG8_BAR;
    PG8_WAIT_V(2); PG8_BAR;
    PG8_STAGE(PG8_SB(1, 0), cB + kstep, voffB); PG8_STAGE(PG8_SA(1, 0), cA + kstep, vA[0]); PG8_STAGE(PG8_SB(1, 1), cB + hstep + kstep, voffB);
    PG8_WAIT_V(6); PG8_BAR;
    for (;;) {
        const bool has_next = S.next(ui + 1, nxt);
        const char* nA = has_next ? nxt.a : cA; const char* nB = has_next ? nxt.b : cB;
        if constexpr (Sched::GATHER) { if (has_next) PG8_AOFF(vN, nxt); else {
#pragma unroll
            for (int h = 0; h < 2; ++h)
#pragma unroll
                for (int i = 0; i < 2; ++i) vN[h][i] = vA[h][i]; }
            *(LAS u32x4*)(lds + VN_STASH + tid * 16) = (u32x4){vN[0][0], vN[0][1], vN[1][0], vN[1][1]}; }
        for (int hk = 0; hk < (Epi::HAS_MID ? 2 : 1); ++hk) {
        if constexpr (Epi::HAS_MID) { if (hk == 1) E.mid(acc, cur, wr, wc, fr, fq); }
        const int tb = (Epi::HAS_MID && hk == 1) ? nt / 2 : 0, te = (Epi::HAS_MID && hk == 0) ? nt / 2 : nt;
#pragma unroll 1
        for (int t = tb; t < te; t += 2) {
            const bool last = (t == nt - 2);
            const char* a1 = cA + (size_t)(t + 1) * kstep;
            const char* a2 = last ? nA : cA + (size_t)(t + 2) * kstep; const char* b2 = last ? nB : cB + (size_t)(t + 2) * kstep;
            const char* a3 = a2 + kstep; const char* b3 = b2 + kstep;
            unsigned w0[2], w1[2];
#pragma unroll
            for (int i = 0; i < 2; ++i) { w0[i] = vA[0][i]; w1[i] = vA[1][i]; }
            if constexpr (Sched::GATHER) { if (last) { const u32x4 q = *(const LAS u32x4*)(lds + VN_STASH + tid * 16); w0[0] = q.x; w0[1] = q.y; w1[0] = q.z; w1[1] = q.w; } }
            PG8_LDB(B0, 0, 0); PG8_LDB(B1, 0, 1); PG8_SCHED; PG8_LDA(At, 0, 0); PG8_STAGE(PG8_SA(1, 1), a1, vA[1]);
            PG8_WAIT_V(8); PG8_WAIT_L(0); PG8_BAR; PG8_MMA(0, 0, At, B0); PG8_MMA(0, 1, At, B1); PG8_BAR; PG8_SCHED;
            PG8_LDA(At, 0, 1); PG8_STAGE(PG8_SB(0, 0), b2, voffB); PG8_STAGE(PG8_SB(0, 1), b2 + hstep, voffB); PG8_STAGE(PG8_SA(0, 0), a2, w0);
            PG8_WAIT_V(8); PG8_WAIT_L(0); PG8_BAR; PG8_MMA(1, 0, At, B0); PG8_MMA(1, 1, At, B1); PG8_BAR; PG8_SCHED;
            PG8_LDB(B0, 1, 0); PG8_LDB(B1, 1, 1); PG8_SCHED; PG8_LDA(At, 1, 0); PG8_STAGE(PG8_SA(0, 1), a2, w1);
            PG8_WAIT_V(8); PG8_WAIT_L(0); PG8_BAR; PG8_MMA(0, 0, At, B0); PG8_MMA(0, 1, At, B1); PG8_BAR; PG8_SCHED;
            PG8_LDA(At, 1, 1); PG8_STAGE(PG8_SB(1, 0), b3, voffB); PG8_STAGE(PG8_SB(1, 1), b3 + hstep, voffB); PG8_STAGE(PG8_SA(1, 0), a3, w0);
            PG8_WAIT_V(8); PG8_WAIT_L(0); PG8_BAR; PG8_MMA(1, 0, At, B0); PG8_MMA(1, 1, At, B1); PG8_BAR; PG8_SCHED;
        }
        }
        if (wr == 0) PG8_BAR;
        if constexpr (FP8) asm volatile("s_nop 15\n\ts_nop 7" ::: "memory");
        E(acc, cur, wr, wc, fr, fq);
        if (!has_next) break;
#pragma unroll
        for (int a = 0; a < 2; ++a)
#pragma unroll
            for (int b = 0; b < 2; ++b)
#pragma unroll
                for (int m = 0; m < 4; ++m)
#pragma unroll
                    for (int n = 0; n < 2; ++n) acc[a][b][m][n] = (f32x4){0.f, 0.f, 0.f, 0.f};
        cur = nxt; cA = nA; cB = nB; ++ui;
        if constexpr (Sched::GATHER) { const u32x4 q = *(const LAS u32x4*)(lds + VN_STASH + tid * 16); vA[0][0] = q.x; vA[0][1] = q.y; vA[1][0] = q.z; vA[1][1] = q.w; }
        if (wr == 1) PG8_BAR;
    }
    PG8_WAIT_V(0);
    PG8_BAR;
#undef PG8_SA
#undef PG8_SB
#undef PG8_STAGE
#undef PG8_LDA
#undef PG8_LDB
#undef PG8_MMA
#undef PG8_LD16
#undef PG8_WAIT_V
#undef PG8_WAIT_L
#undef PG8_BAR
#undef PG8_SCHED
#undef PG8_AOFF
}
}

typedef f32x4 Acc[2][2][4][2];
struct EpiG1 {
    static constexpr bool HAS_MID = false;
    unsigned char* ws; const float* g_q; const float* g_k;
    __device__ __forceinline__ void mid(Acc&, const pg8::Unit&, int, int, int, int) const {}
    __device__ __forceinline__ void operator()(Acc& acc, const pg8::Unit& u, int wr, int wc, int fr, int fq) const {
        const int pn = u.pn, row0 = u.pm * 256 + wr * 64 + fr;
        if (pn < 4) {
            const int isk = pn >> 1, hh = 4 * (pn & 1) + wc;
            const float* g = isk ? g_k : g_q;
            f32x4 gv[2][2];
#pragma unroll
            for (int bj = 0; bj < 2; ++bj)
#pragma unroll
                for (int n = 0; n < 2; ++n) gv[bj][n] = *(const f32x4*)(g + 32 * bj + 8 * fq + 4 * n);
            f32x4 cs_[2][2];
#pragma unroll
            for (int bj = 0; bj < 2; ++bj)
#pragma unroll
                for (int n = 0; n < 2; ++n) cs_[bj][n] = (f32x4){0.f, 0.f, 0.f, 0.f};
            const float2* rope = (const float2*)(ws + WS_ROPE);
            bf16_t* dst = isk ? (bf16_t*)(ws + WS_K) : (bf16_t*)(ws + WS_YAB);
            const int pitch = isk ? 512 : 1024;
#pragma unroll
            for (int ai = 0; ai < 2; ++ai)
#pragma unroll
                for (int m = 0; m < 4; ++m) {
                    const int r = row0 + 128 * ai + 16 * m, pos = r & (S - 1);
                    f32x4 v[2][2]; float ss = 0.f;
#pragma unroll
                    for (int bj = 0; bj < 2; ++bj)
#pragma unroll
                        for (int n = 0; n < 2; ++n) { v[bj][n] = acc[ai][bj][m][n]; ss += (v[bj][n].x * v[bj][n].x + v[bj][n].y * v[bj][n].y) + (v[bj][n].z * v[bj][n].z + v[bj][n].w * v[bj][n].w); }
                    ss += __shfl_xor(ss, 16); ss += __shfl_xor(ss, 32);
                    const float rinv = rsqrtf(ss * (1.f / 64.f) + EPS);
#pragma unroll
                    for (int bj = 0; bj < 2; ++bj)
#pragma unroll
                        for (int n = 0; n < 2; ++n) v[bj][n] = v[bj][n] * rinv * gv[bj][n];
#pragma unroll
                    for (int n = 0; n < 2; ++n)
#pragma unroll
                        for (int e = 0; e < 4; ++e) { const float pv = __shfl_xor(v[0][n][e], 16);
                            if (fq < 2) { const float2 cs = rope[pos * 8 + 4 * n + e]; v[0][n][e] = (fq == 0) ? (v[0][n][e] * cs.x - pv * cs.y) : (v[0][n][e] * cs.x + pv * cs.y); } }
                    if (isk) {
#pragma unroll
                        for (int bj = 0; bj < 2; ++bj)
#pragma unroll
                            for (int n = 0; n < 2; ++n) cs_[bj][n] += v[bj][n];
                    }
                    const float sc = isk ? 1.f : C2;
#pragma unroll
                    for (int bj = 0; bj < 2; ++bj) { u32x4 w; const f32x4 a = v[bj][0] * sc, b = v[bj][1] * sc;
                        w.x = pk2(a.x, a.y); w.y = pk2(a.z, a.w); w.z = pk2(b.x, b.y); w.w = pk2(b.z, b.w);
                        st16(dst + (size_t)r * pitch + hh * 64 + 32 * bj + 8 * fq, w); }
                }
            if (isk) {
                const int b = u.pm >> 4, blk = u.pm & 15;
                float* km = (float*)(ws + WS_KMEAN) + ((size_t)(b * NH + hh) * 16 + blk) * 64;
#pragma unroll
                for (int bj = 0; bj < 2; ++bj)
#pragma unroll
                    for (int n = 0; n < 2; ++n)
#pragma unroll
                        for (int e = 0; e < 4; ++e) { float s = cs_[bj][n][e]; s += __shfl_xor(s, 1); s += __shfl_xor(s, 2); s += __shfl_xor(s, 4); s += __shfl_xor(s, 8);
                            if (fr == 0) atomicAdd(km + 32 * bj + 8 * fq + 4 * n + e, s * (1.f / 256.f)); }
            }
        } else if (pn >= 6 && pn < 10) {
            bf16_t* dst = (bf16_t*)(ws + WS_U);
#pragma unroll
            for (int ai = 0; ai < 2; ++ai)
#pragma unroll
                for (int m = 0; m < 4; ++m) { const int r = row0 + 128 * ai + 16 * m;
                    const f32x4 a = acc[ai][0][m][0] * acc[ai][1][m][0], b = acc[ai][0][m][1] * acc[ai][1][m][1]; u32x4 w;
                    w.x = pk2(a.x, a.y); w.y = pk2(a.z, a.w); w.z = pk2(b.x, b.y); w.w = pk2(b.z, b.w);
                    st16(dst + (size_t)r * 512 + 128 * (pn - 6) + 32 * wc + 8 * fq, w); }
        } else {
            bf16_t* dst; int pitch, c0; bool sig = false;
            if (pn < 6) { dst = (bf16_t*)(ws + WS_V); pitch = 512; c0 = 256 * (pn - 4); }
            else if (pn < 12) { dst = (bf16_t*)(ws + WS_BG); pitch = 512; c0 = 256 * (pn - 10); }
            else { dst = (bf16_t*)(ws + WS_GATES); pitch = 2048; c0 = 256 * (pn - 12); sig = true; }
#pragma unroll
            for (int ai = 0; ai < 2; ++ai)
#pragma unroll
                for (int m = 0; m < 4; ++m) { const int r = row0 + 128 * ai + 16 * m;
#pragma unroll
                    for (int bj = 0; bj < 2; ++bj) { f32x4 a = acc[ai][bj][m][0], b = acc[ai][bj][m][1];
                        if (sig) {
#pragma unroll
                            for (int e = 0; e < 4; ++e) { a[e] = __builtin_amdgcn_rcpf(1.f + __expf(-a[e])); b[e] = __builtin_amdgcn_rcpf(1.f + __expf(-b[e])); } }
                        u32x4 w; w.x = pk2(a.x, a.y); w.y = pk2(a.z, a.w); w.z = pk2(b.x, b.y); w.w = pk2(b.z, b.w);
                        st16(dst + (size_t)r * pitch + c0 + 128 * bj + 32 * wc + 8 * fq, w); } }
        }
    }
};
struct EpiGate {
    static constexpr bool HAS_MID = false;
    bf16_t* gates;
    __device__ __forceinline__ void mid(Acc&, const pg8::Unit&, int, int, int, int) const {}
    __device__ __forceinline__ void operator()(Acc& acc, const pg8::Unit& u, int wr, int wc, int fr, int fq) const {
        int row0 = u.pm * 256 + wr * 64 + fr; const int c0 = u.pn * 256 + 32 * wc + 8 * fq; asm volatile("" : "+v"(row0));
#pragma unroll
        for (int ai = 0; ai < 2; ++ai)
#pragma unroll
            for (int m = 0; m < 4; ++m) { const size_t r = (size_t)(row0 + 128 * ai + 16 * m);
#pragma unroll
                for (int bj = 0; bj < 2; ++bj) { f32x4 a = acc[ai][bj][m][0], b = acc[ai][bj][m][1];
#pragma unroll
                    for (int e = 0; e < 4; ++e) { a[e] = __builtin_amdgcn_rcpf(1.f + __expf(a[e] * (-1.f / W8_SCALE))); b[e] = __builtin_amdgcn_rcpf(1.f + __expf(b[e] * (-1.f / W8_SCALE))); }
                    st16(gates + r * 2048 + c0 + 128 * bj, pack8v(a, b)); } }
    }
};
__device__ __forceinline__ void s2_fast(Frame& F) {
    {
        const pg8::DenseSched Sd{(const char*)(F.ws + WS_H), (const char*)(F.ws + WS_WIN_T), T / 256, 12, 1024, F.G, (int)blockIdx.x};
        const EpiG1 E{F.ws, F.g_q, F.g_k};
        pg8::gemm_phase<EpiG1, pg8::DenseSched>(F.lds, 1024, Sd, E); }
    {
        const pg8::DenseSched8 Sd{(const char*)(F.ws + WS_H8), (const char*)(F.ws + WS_WIN8), T / 256, 8, 1024, F.G, (int)blockIdx.x};
        const EpiGate E{WSP(bf16_t, WS_GATES)};
        int Kg = D; asm volatile("" : "+s"(Kg));
        pg8::gemm_phase<EpiGate, pg8::DenseSched8>(F.lds, Kg, Sd, E); }
}

constexpr float NEG_BIG = -1e30f;
__device__ __forceinline__ void s3_simple(Frame& F) {
    LAS float* tS = (LAS float*)F.lds;
    LAS bf16_t* Pb = (LAS bf16_t*)(F.lds + 16896);
    LAS bf16_t* Vt = (LAS bf16_t*)(F.lds + 16896 + 9216);
    LAS float* mrow = (LAS float*)(F.lds + 16896 + 18432);
    LAS float* lrow = mrow + 64; LAS float* arow_ = mrow + 128; LAS int* sel = (LAS int*)(mrow + 192); LAS int* um = sel + 64;
    bf16_t* YAB = WSP(bf16_t, WS_YAB); const bf16_t* Kb = WSP(bf16_t, WS_K); const bf16_t* Vb = WSP(bf16_t, WS_V);
    const float* kmean = WSP(float, WS_KMEAN);
    const int row = F.tid >> 3, seg = F.tid & 7, fr = F.lane & 15, fq = F.lane >> 4, rb = 16 * (F.wave & 3), cb = 32 * (F.wave >> 2);
    for (int it = blockIdx.x; it < NB * NH * 64; it += F.G) {
        const int qc = it & 63, h = (it >> 6) & 7, b = it >> 9, cur = qc >> 2, t0 = 64 * qc;
        const size_t tb = (size_t)b * S;
        if (F.tid < 64) {
            float q[64];
            const bf16_t* qp = YAB + (tb + t0 + F.tid) * 1024 + h * 64;
#pragma unroll
            for (int i = 0; i < 8; ++i) { float t8[8]; unpack8(*(const u32x4*)(qp + 8 * i), t8);
#pragma unroll
                for (int e = 0; e < 8; ++e) q[8 * i + e] = t8[e]; }
            float b0 = -INFINITY, b1 = -INFINITY, b2 = -INFINITY; int i0 = -1, i1 = -1, i2 = -1;
            for (int j = 0; j < cur; ++j) { const float* km = kmean + ((size_t)(b * NH + h) * 16 + j) * 64; float s = 0.f;
#pragma unroll
                for (int d = 0; d < 64; ++d) s += q[d] * km[d];
                if (s > b0) { b2 = b1; i2 = i1; b1 = b0; i1 = i0; b0 = s; i0 = j; } else if (s > b1) { b2 = b1; i2 = i1; b1 = s; i1 = j; } else if (s > b2) { b2 = s; i2 = j; } }
            int m = 0; if (i0 >= 0) m |= 1 << i0; if (i1 >= 0) m |= 1 << i1; if (i2 >= 0) m |= 1 << i2;
            sel[F.tid] = m; mrow[F.tid] = NEG_BIG; lrow[F.tid] = 0.f;
            int u = m;
#pragma unroll
            for (int o = 1; o < 64; o <<= 1) u |= __shfl_xor(u, o);
            if (F.tid == 0) um[0] = u;
        }
        __syncthreads();
        const int umask = um[0];
        f32x4 o0 = {0.f, 0.f, 0.f, 0.f}, o1 = {0.f, 0.f, 0.f, 0.f};
        const RowsLinear aq{YAB + (tb + t0) * 1024 + h * 64, 1024};
        for (int j = 0; j <= cur; ++j) {
            if (j < cur && !((umask >> j) & 1)) continue;
            const int nkt = (j == cur) ? ((qc & 3) + 1) : 4;
            for (int kt = 0; kt < nkt; ++kt) {
                const int kbase = 256 * j + 64 * kt;
                const RowsLinear bk{Kb + (tb + kbase) * 512 + h * 64, 512};
                sgemm_tile(tS, 64, aq, bk, F.wave, F.lane);
                { float vv[8]; unpack8(*(const u32x4*)(Vb + (tb + kbase + row) * 512 + h * 64 + 8 * seg), vv);
#pragma unroll
                    for (int e = 0; e < 8; ++e) Vt[(8 * seg + e) * 72 + row] = (bf16_t)f2bf(vv[e]); }
                __syncthreads();
                {
                    float s[8]; float mx = NEG_BIG;
                    const bool rowsel = (j == cur) || ((sel[row] >> j) & 1);
#pragma unroll
                    for (int e = 0; e < 8; ++e) { const int c = 8 * seg + e; float x = tS[row * 65 + c];
                        if (!rowsel || (j == cur && kbase + c > t0 + row)) x = NEG_BIG; s[e] = x; mx = fmaxf(mx, x); }
                    mx = fmaxf(mx, __shfl_xor(mx, 1)); mx = fmaxf(mx, __shfl_xor(mx, 2)); mx = fmaxf(mx, __shfl_xor(mx, 4));
                    const float mold = mrow[row], mnew = fmaxf(mold, mx);
                    float alpha = 1.f, ps = 0.f; float p[8];
                    if (mnew <= NEG_BIG) {
#pragma unroll
                        for (int e = 0; e < 8; ++e) p[e] = 0.f;
                    } else { alpha = exp2f(mold - mnew);
#pragma unroll
                        for (int e = 0; e < 8; ++e) { p[e] = (s[e] <= NEG_BIG) ? 0.f : exp2f(s[e] - mnew); ps += p[e]; } }
                    ps += __shfl_xor(ps, 1); ps += __shfl_xor(ps, 2); ps += __shfl_xor(ps, 4);
                    const float lold = lrow[row];
                    *(LAS u32x4*)(Pb + row * 72 + 8 * seg) = pack8(p);
                    if (seg == 0) { mrow[row] = mnew; lrow[row] = lold * alpha + ps; arow_[row] = alpha; }
                }
                __syncthreads();
                {
#pragma unroll
                    for (int r = 0; r < 4; ++r) { const float a = arow_[rb + fq * 4 + r]; o0[r] *= a; o1[r] *= a; }
#pragma unroll
                    for (int ks = 0; ks < 2; ++ks) {
                        const bf16x8 a = *(const LAS bf16x8*)(Pb + (rb + fr) * 72 + 32 * ks + 8 * fq);
                        const bf16x8 v0 = *(const LAS bf16x8*)(Vt + (cb + fr) * 72 + 32 * ks + 8 * fq);
                        const bf16x8 v1 = *(const LAS bf16x8*)(Vt + (cb + 16 + fr) * 72 + 32 * ks + 8 * fq);
                        o0 = __builtin_amdgcn_mfma_f32_16x16x32_bf16(a, v0, o0, 0, 0, 0);
                        o1 = __builtin_amdgcn_mfma_f32_16x16x32_bf16(a, v1, o1, 0, 0, 0);
                    }
                }
                __syncthreads();
            }
        }
#pragma unroll
        for (int r = 0; r < 4; ++r) { const float li = 1.f / lrow[rb + fq * 4 + r]; tS[(rb + fq * 4 + r) * 65 + cb + fr] = o0[r] * li; tS[(rb + fq * 4 + r) * 65 + cb + 16 + fr] = o1[r] * li; }
        __syncthreads();
        { float v[8];
#pragma unroll
            for (int e = 0; e < 8; ++e) v[e] = tS[row * 65 + 8 * seg + e];
            *(u32x4*)(YAB + (tb + t0 + row) * 1024 + h * 64 + 8 * seg) = pack8(v); }
        __syncthreads();
    }
    const bf16_t* U = WSP(bf16_t, WS_U); const bf16_t* BG = WSP(bf16_t, WS_BG);
    for (int i = blockIdx.x * NTHREADS + F.tid; i < T * 64; i += F.G * NTHREADS) {
        const int t = i >> 6, c0 = (i & 63) * 8, pos = t & (S - 1);
        float u0[8], u1[8], u2[8], bg[8], y[8];
        unpack8(*(const u32x4*)(U + (size_t)t * 512 + c0), u2); unpack8(*(const u32x4*)(BG + (size_t)t * 512 + c0), bg);
        if (pos >= 1) unpack8(*(const u32x4*)(U + (size_t)(t - 1) * 512 + c0), u1); else {
#pragma unroll
            for (int e = 0; e < 8; ++e) u1[e] = 0.f; }
        if (pos >= 2) unpack8(*(const u32x4*)(U + (size_t)(t - 2) * 512 + c0), u0); else {
#pragma unroll
            for (int e = 0; e < 8; ++e) u0[e] = 0.f; }
#pragma unroll
        for (int e = 0; e < 8; ++e) y[e] = bg[e] * (F.conv_w[c0 + e] * u0[e] + F.conv_w[512 + c0 + e] * u1[e] + F.conv_w[1024 + c0 + e] * u2[e] + F.conv_b[c0 + e]);
        *(u32x4*)(YAB + (size_t)t * 1024 + 512 + c0) = pack8(y);
    }
}

namespace attn_body {
using bf16x8 = __attribute__((ext_vector_type(8))) short;
using s16x4 = __attribute__((ext_vector_type(4))) short;
using f32x16 = __attribute__((ext_vector_type(16))) float;
using u32x4 = __attribute__((ext_vector_type(4))) unsigned;
constexpr int SEQ = 4096, D = 64, DMQ = 1024, DMK = 512;
constexpr int NW = 8, QBLK = 32, QB = QBLK * NW, KVBLK = 64;
constexpr float NEGB = -1e30f;
__device__ __forceinline__ int crow(int r, int hi) { return (r & 3) + 8 * (r >> 2) + 4 * hi; }
#define SBAR() __builtin_amdgcn_sched_barrier(0)
__device__ __forceinline__ void cmask(f32x16& p0, f32x16& p1, int jb, int qrel, int hi) {
  const float NEG = -INFINITY; int kb = 64 * jb + 4 * hi;
  #pragma unroll
  for (int r = 0; r < 16; ++r) { int kv = kb + (r & 3) + 8 * (r >> 2); if (kv > qrel) p0[r] = NEG; if (kv + 32 > qrel) p1[r] = NEG; }
}
constexpr int NSLOT = 3, SLOTB = 8192;
constexpr int LDS_K = 0, LDS_V = NSLOT * SLOTB, LDS_WS = 2 * NSLOT * SLOTB, LDS_OST = LDS_WS + NW * 128 * 4, LDS_BYTES_A = LDS_OST + NW * 4096;
__device__ __forceinline__ void glds16(const void* gsrc, unsigned lds_dst) { unsigned keep;
  asm volatile("s_mov_b32 %0, m0\n\ts_mov_b32 m0, %2\n\ts_nop 0\n\tglobal_load_lds_dwordx4 %1, off\n\ts_mov_b32 m0, %0" : "=&s"(keep) : "v"(gsrc), "s"(lds_dst) : "memory"); }
__device__ __forceinline__ float max3f(float a, float b, float c) { float r; asm("v_max3_f32 %0, %1, %2, %3" : "=v"(r) : "v"(a), "v"(b), "v"(c)); return r; }
__device__ __forceinline__ float max2f(float a, float b) { float r; asm("v_max_f32_e32 %0, %1, %2" : "=v"(r) : "v"(a), "v"(b)); return r; }
__device__ __forceinline__ float fadd_s(float a, float b) { float r; asm("v_add_f32_e32 %0, %1, %2" : "=v"(r) : "v"(a), "v"(b)); return r; }
__device__ __forceinline__ float fsub_s(float a, float b) { float r; asm("v_sub_f32_e32 %0, %1, %2" : "=v"(r) : "v"(a), "v"(b)); return r; }
typedef float f32x2_t __attribute__((ext_vector_type(2))); typedef __bf16 bf16x2_t __attribute__((ext_vector_type(2)));
__device__ __forceinline__ unsigned cvtpk_s(float lo, float hi) { f32x2_t v = {lo, hi}; bf16x2_t b = __builtin_convertvector(v, bf16x2_t); return __builtin_bit_cast(unsigned, b); }
#define WAIT_BAR(N) asm volatile("s_waitcnt vmcnt(" #N ") lgkmcnt(0)\n\ts_barrier" ::: "memory")
__device__ __forceinline__ void qkt(f32x16& p0, f32x16& p1, const char* Kslot, const bf16x8* qr, const f32x16& negm, int r32, int hi) {
  const char* kb = Kslot + hi * 1024 + r32 * 16;
  #pragma unroll
  for (int d0 = 0; d0 < 4; ++d0) {
    const bf16x8 b0 = *reinterpret_cast<const bf16x8*>(kb + d0 * 2048);
    const bf16x8 b1 = *reinterpret_cast<const bf16x8*>(kb + d0 * 2048 + 512);
    if (d0 == 0) { p0 = __builtin_amdgcn_mfma_f32_32x32x16_bf16(b0, qr[0], negm, 0, 0, 0); p1 = __builtin_amdgcn_mfma_f32_32x32x16_bf16(b1, qr[0], negm, 0, 0, 0); }
    else { p0 = __builtin_amdgcn_mfma_f32_32x32x16_bf16(b0, qr[d0], p0, 0, 0, 0); p1 = __builtin_amdgcn_mfma_f32_32x32x16_bf16(b1, qr[d0], p1, 0, 0, 0); } }
}
typedef __attribute__((address_space(3))) const char* lds_cptr;
typedef __attribute__((address_space(3))) char* lds_ptr;
typedef short v4i16_t __attribute__((ext_vector_type(4)));
__device__ __forceinline__ void kload8(bf16x8* kf, lds_cptr kp) {
  kf[0] = *(const __attribute__((address_space(3))) bf16x8*)(kp);        kf[1] = *(const __attribute__((address_space(3))) bf16x8*)(kp + 512);
  kf[2] = *(const __attribute__((address_space(3))) bf16x8*)(kp + 2048); kf[3] = *(const __attribute__((address_space(3))) bf16x8*)(kp + 2560);
  kf[4] = *(const __attribute__((address_space(3))) bf16x8*)(kp + 4096); kf[5] = *(const __attribute__((address_space(3))) bf16x8*)(kp + 4608);
  kf[6] = *(const __attribute__((address_space(3))) bf16x8*)(kp + 6144); kf[7] = *(const __attribute__((address_space(3))) bf16x8*)(kp + 6656);
}
__device__ __forceinline__ void kload2(bf16x8* kf, lds_cptr kp, int j) { kf[2 * j] = *(const __attribute__((address_space(3))) bf16x8*)(kp + j * 2048); kf[2 * j + 1] = *(const __attribute__((address_space(3))) bf16x8*)(kp + j * 2048 + 512); }
__device__ __forceinline__ s16x4 vtr(lds_cptr p) { return __builtin_bit_cast(s16x4, __builtin_amdgcn_ds_read_tr16_b64_v4i16((__attribute__((address_space(3))) v4i16_t*)p)); }
__device__ __forceinline__ float rowmax(const f32x16& p0, const f32x16& p1) {
  float a = max3f(p0[0], p0[1], p1[0]), b = max3f(p0[2], p0[3], p1[1]); a = max3f(a, p1[2], p1[3]);
  #pragma unroll
  for (int r = 4; r < 16; r += 4) { a = max3f(a, p0[r], p0[r + 1]); b = max3f(b, p0[r + 2], p0[r + 3]); a = max3f(a, p1[r], p1[r + 1]); b = max3f(b, p1[r + 2], p1[r + 3]); }
  const float m = max2f(a, b);
  auto rr = __builtin_amdgcn_permlane32_swap(__float_as_uint(m), __float_as_uint(m), false, false);
  return max2f(__uint_as_float(rr[0]), __uint_as_float(rr[1]));
}
__device__ __forceinline__ void pv(f32x16* o, int vb, bf16x8 pa0, bf16x8 pa1, bf16x8 pa2, bf16x8 pa3) {
  #pragma unroll
  for (int d0 = 0; d0 < 2; ++d0) { s16x4 lo[4], hi[4];
    #pragma unroll
    for (int ks = 0; ks < 4; ++ks) {
      asm volatile("ds_read_b64_tr_b16 %0,%1 offset:%c2" : "=&v"(lo[ks]) : "v"(vb), "i"(d0 * 4096 + ks * 1024) : "memory");
      asm volatile("ds_read_b64_tr_b16 %0,%1 offset:%c2" : "=&v"(hi[ks]) : "v"(vb), "i"(d0 * 4096 + ks * 1024 + 512) : "memory"); }
    asm volatile("s_waitcnt lgkmcnt(0)" ::: "memory"); SBAR();
    #define PK(k) (bf16x8){lo[k][0], lo[k][1], lo[k][2], lo[k][3], hi[k][0], hi[k][1], hi[k][2], hi[k][3]}
    o[d0] = __builtin_amdgcn_mfma_f32_32x32x16_bf16(pa0, PK(0), o[d0], 0, 0, 0);
    o[d0] = __builtin_amdgcn_mfma_f32_32x32x16_bf16(pa1, PK(1), o[d0], 0, 0, 0);
    o[d0] = __builtin_amdgcn_mfma_f32_32x32x16_bf16(pa2, PK(2), o[d0], 0, 0, 0);
    o[d0] = __builtin_amdgcn_mfma_f32_32x32x16_bf16(pa3, PK(3), o[d0], 0, 0, 0);
    #undef PK
  }
}
#define ATTN_STORE16(p, v) st16((p), (v))
template <int THRL> __device__ __forceinline__ void attn_unit(int b, int h, int qb, const bf16_t* QO, bf16_t* Ob, const bf16_t* __restrict__ K, const bf16_t* __restrict__ V, const float* __restrict__ kmean, char* shm) {
  int tid_ = threadIdx.x; asm volatile("" : "+v"(tid_));
  const int tid = tid_, lane = tid & 63, r32 = lane & 31, hi = lane >> 5; const int wid = __builtin_amdgcn_readfirstlane(tid >> 6);
  const long rowbase = (long)b * SEQ; const int q0 = qb * QB;
  const bf16_t* Qw = QO + (rowbase + q0 + wid * QBLK) * DMQ + h * D;
  const bf16_t* Kh = K + rowbase * DMK + h * D, *Vh = V + rowbase * DMK + h * D;
  const unsigned lds0 = (unsigned)(uintptr_t)shm;
  float* wsf = (float*)(shm + LDS_WS) + wid * 128;
  const bf16_t* ksrc = Kh + (long)lane * DMK + wid * 8;
  const bf16_t* vsrc = Vh + (long)(16 * (wid & 3) + (lane >> 2)) * DMK + (wid >> 2) * 32 + (lane & 3) * 8;
  const unsigned kdst = lds0 + LDS_K + wid * 1024, vdst = lds0 + LDS_V + wid * 1024;
  #define DMA_K(t, slot) glds16(ksrc + (long)(t) * KVBLK * DMK, (unsigned)__builtin_amdgcn_readfirstlane(kdst + (slot)))
  #define DMA_V(t, slot) glds16(vsrc + (long)(t) * KVBLK * DMK, (unsigned)__builtin_amdgcn_readfirstlane(vdst + (slot)))
  DMA_K(0, 0); DMA_V(0, 0); DMA_K(1, SLOTB);
  bf16x8 qr[4];
  #pragma unroll
  for (int d0 = 0; d0 < 4; ++d0) qr[d0] = *reinterpret_cast<const bf16x8*>(&Qw[(long)r32 * DMQ + d0 * 16 + hi * 8]);
  unsigned selm = 0u;
  if (qb > 0) {
    float* kmL = (float*)(shm + LDS_OST);
    const float* kmg = kmean + ((size_t)(b * 8 + h) * 16) * 64;
    for (int i = tid; i < qb * 64; i += 512) kmL[i] = kmg[i];
    asm volatile("s_waitcnt vmcnt(0) lgkmcnt(0)\n\ts_barrier" ::: "memory");
    float qf[32];
    #pragma unroll
    for (int d0 = 0; d0 < 4; ++d0)
      #pragma unroll
      for (int e = 0; e < 8; ++e) qf[8 * d0 + e] = __uint_as_float(((unsigned)(unsigned short)qr[d0][e]) << 16);
    float b0 = -INFINITY, b1 = -INFINITY, b2 = -INFINITY; int i0 = -1, i1 = -1, i2 = -1;
    for (int j = 0; j < qb; ++j) {
      const float* km = kmL + j * 64 + 8 * hi; float sc = 0.f;
      #pragma unroll
      for (int d0 = 0; d0 < 4; ++d0)
        #pragma unroll
        for (int e = 0; e < 8; ++e) sc += qf[8 * d0 + e] * km[16 * d0 + e];
      sc += __shfl_xor(sc, 32);
      if (sc > b0) { b2 = b1; i2 = i1; b1 = b0; i1 = i0; b0 = sc; i0 = j; } else if (sc > b1) { b2 = b1; i2 = i1; b1 = sc; i1 = j; } else if (sc > b2) { b2 = sc; i2 = j; }
    }
    if (i0 >= 0) selm |= 1u << i0; if (i1 >= 0) selm |= 1u << i1; if (i2 >= 0) selm |= 1u << i2;
    asm volatile("s_waitcnt lgkmcnt(0)\n\ts_barrier" ::: "memory");
  }
  if (hi == 0) ((unsigned*)wsf)[64 + r32] = selm;
  { const lds_ptr qst = (lds_ptr)shm + LDS_OST + wid * 4096 + lane * 16;
    #pragma unroll
    for (int d0 = 0; d0 < 4; ++d0) *(__attribute__((address_space(3))) bf16x8*)(qst + d0 * 1024) = qr[d0]; }
  #define SELROW(j) (((j) >= qb) || ((((const unsigned*)wsf)[64 + r32] >> (j)) & 1u))
  #define NEGM_SET(blk) do { const float nv_ = SELROW(blk) ? -mhat : NEGB; _Pragma("unroll") for (int r = 0; r < 16; ++r) negm[r] = nv_; asm volatile("" : "+v"(negm)); } while (0)
  const int vb0 = (int)(lds0 + LDS_V) + ((lane >> 4) & 1) * 32 + (lane & 3) * 8 + (4 * hi + ((lane & 15) >> 2)) * 64;
  const char* Kbase = shm + LDS_K; bf16x8 kf[8];
  const lds_cptr qp0 = (lds_cptr)shm + LDS_OST + wid * 4096 + lane * 16;
  const lds_cptr shm3 = (lds_cptr)shm; const lds_cptr kp0 = shm3 + LDS_K + hi * 1024 + r32 * 16; const lds_cptr vp0 = shm3 + LDS_V + ((lane >> 4) & 1) * 32 + (lane & 3) * 8 + (4 * hi + ((lane & 15) >> 2)) * 64;
  const int NT = (q0 + QB) / KVBLK;
  float mhat = 0.f, l_reg = 0.f; f32x16 o[2]; o[0] = f32x16{}; o[1] = f32x16{}; f32x16 negm;
  NEGM_SET(0);
  const int qrel = wid * QBLK + r32;
  #define CMASK(P0, P1, t) do { int jb_ = (t) - (NT - 4); if (jb_ >= 0) cmask(P0, P1, jb_, qrel, hi); } while (0)
  bool resc = false;
  #define START(P0, P1) do { const float rm = rowmax(P0, P1); resc = false; \
    { const float dl = SELROW(0) ? rm : 0.f; mhat = fadd_s(mhat, dl); \
      _Pragma("unroll") for (int r = 0; r < 16; ++r) { P0[r] = fsub_s(P0[r], dl); P1[r] = fsub_s(P1[r], dl); } \
      NEGM_SET(0); } \
    _Pragma("unroll") for (int r = 0; r < 16; ++r) P0[r] = __builtin_amdgcn_exp2f(P0[r]); } while (0)
  #define RESC() do { if (resc) { asm volatile("s_waitcnt lgkmcnt(0)" ::: "memory"); \
      _Pragma("unroll") for (int d_ = 0; d_ < 2; ++d_) _Pragma("unroll") for (int r = 0; r < 16; ++r) o[d_][r] *= wsf[crow(r, hi)]; } } while (0)
  f32x16 pA0, pA1, pB0, pB1;
  int sl_prev = 0, sl_cur = 0, sl_next = SLOTB;
  #define ROT() do { sl_prev = sl_cur; sl_cur = sl_next; sl_next = (sl_next == (NSLOT - 1) * SLOTB) ? 0 : sl_next + SLOTB; } while (0)
  DMA_K(2, 2 * SLOTB);
  WAIT_BAR(3);
  qkt(pA0, pA1, Kbase, qr, negm, r32, hi); asm volatile("s_nop 15\n\ts_nop 7" : "+v"(pA0), "+v"(pA1)); CMASK(pA0, pA1, 0);
  START(pA0, pA1);
  _Pragma("unroll") for (int r = 0; r < 16; ++r) pA1[r] = __builtin_amdgcn_exp2f(pA1[r]);
  WAIT_BAR(0);
  DMA_K(3, 0); DMA_V(1, SLOTB);
  ROT();
  kload8(kf, kp0 + sl_cur);
  WAIT_BAR(2);
  s16x4 vlo[8], vhi[8]; u32x4 pw0, pw1, pw2, pw3; bf16x8 q0_, q1_, q2_, q3_;
  #define QRD(d) do { q##d##_ = *(const __attribute__((address_space(3))) bf16x8*)(qp0 + (d) * 1024); } while (0)
  QRD(0); QRD(1);
  #define PKW(P, B) cvtpk_s(P[B], P[B + 1])
  #define PAF(k) __builtin_bit_cast(bf16x8, pw##k)
  #define VFR(i) (bf16x8){vlo[i][0], vlo[i][1], vlo[i][2], vlo[i][3], vhi[i][0], vhi[i][1], vhi[i][2], vhi[i][3]}
  #define PIN(x) asm volatile("" : "+v"(x))
  #define MX3(a, b, c) __builtin_fmaxf(__builtin_fmaxf((a), (b)), (c))
  #define GAPA(MF, A0, A1, A2, A3, W0, W1, PW) do { MF; sacc += A0; sacc += A1; sacc += A2; sacc += A3; PIN(sacc); W0; W1; PIN(PW); SBAR(); } while (0)
  #define EX(v) __builtin_amdgcn_exp2f(v)
  #define GAPB(MF, X, B) do { MF; X[B] = EX(X[B]); X[B + 1] = EX(X[B + 1]); X[B + 2] = EX(X[B + 2]); X[B + 3] = EX(X[B + 3]); PIN(X); SBAR(); } while (0)
  #define VRD(i) do { vlo[i] = vtr(vp_ + (((i) >> 2) * 4096 + ((i) & 3) * 1024)); vhi[i] = vtr(vp_ + (((i) >> 2) * 4096 + ((i) & 3) * 1024 + 512)); } while (0)
  #define KRD(G, j) do { if (G) { kload2(kf, kp0 + sl_next, j); SBAR(); } } while (0)
  #define STEP(C0, C1, P0, P1, t, GK, GV, GL) do { SBAR(); \
    const lds_cptr vp_ = vp0 + sl_prev; \
    VRD(0); SBAR(); float sacc = (P0[0] + P0[1]); \
    GAPA(C0 = __builtin_amdgcn_mfma_f32_32x32x16_bf16(kf[0], q0_, negm, 0, 0, 0), P0[2], P0[3], P0[4], P0[5],     pw0[0] = PKW(P0, 0), pw0[1] = PKW(P0, 2), pw0); \
    VRD(4); SBAR(); GAPA(C1 = __builtin_amdgcn_mfma_f32_32x32x16_bf16(kf[1], q0_, negm, 0, 0, 0), P0[6], P0[7], P0[8], P0[9],     pw0[2] = PKW(P0, 4), pw0[3] = PKW(P0, 6), pw0); \
    QRD(2); SBAR(); \
    VRD(1); SBAR(); GAPA(C0 = __builtin_amdgcn_mfma_f32_32x32x16_bf16(kf[2], q1_, C0, 0, 0, 0),   P0[10], P0[11], P0[12], P0[13], pw1[0] = PKW(P0, 8), pw1[1] = PKW(P0, 10), pw1); \
    VRD(5); SBAR(); GAPA(C1 = __builtin_amdgcn_mfma_f32_32x32x16_bf16(kf[3], q1_, C1, 0, 0, 0),   P0[14], P0[15], P1[0], P1[1],   pw1[2] = PKW(P0, 12), pw1[3] = PKW(P0, 14), pw1); \
    QRD(3); SBAR(); \
    VRD(2); SBAR(); GAPA(C0 = __builtin_amdgcn_mfma_f32_32x32x16_bf16(kf[4], q2_, C0, 0, 0, 0),   P1[2], P1[3], P1[4], P1[5],     pw2[0] = PKW(P1, 0), pw2[1] = PKW(P1, 2), pw2); \
    VRD(6); SBAR(); GAPA(C1 = __builtin_amdgcn_mfma_f32_32x32x16_bf16(kf[5], q2_, C1, 0, 0, 0),   P1[6], P1[7], P1[8], P1[9],     pw2[2] = PKW(P1, 4), pw2[3] = PKW(P1, 6), pw2); \
    VRD(3); SBAR(); GAPA(C0 = __builtin_amdgcn_mfma_f32_32x32x16_bf16(kf[6], q3_, C0, 0, 0, 0),   P1[10], P1[11], P1[12], P1[13], pw3[0] = PKW(P1, 8), pw3[1] = PKW(P1, 10), pw3); \
    VRD(7); SBAR(); GAPA(C1 = __builtin_amdgcn_mfma_f32_32x32x16_bf16(kf[7], q3_, C1, 0, 0, 0),   P1[14], P1[15], 0.f, 0.f,       pw3[2] = PKW(P1, 12), pw3[3] = PKW(P1, 14), pw3); \
    l_reg += sacc; \
    if (GK) { DMA_K((t) + 3, sl_cur); } if (GV) { DMA_V((t) + 1, sl_next); } \
    CMASK(C0, C1, t); \
    { float a = MX3(C0[0], C0[1], C1[0]), b = MX3(C0[2], C0[3], C1[1]); a = MX3(a, C1[2], C1[3]); \
      _Pragma("unroll") for (int r = 4; r < 16; r += 4) { a = MX3(a, C0[r], C0[r + 1]); b = MX3(b, C0[r + 2], C0[r + 3]); a = MX3(a, C1[r], C1[r + 1]); b = MX3(b, C1[r + 2], C1[r + 3]); } \
      float rm = __builtin_fmaxf(a, b); { auto rr = __builtin_amdgcn_permlane32_swap(__float_as_uint(rm), __float_as_uint(rm), false, false); rm = __builtin_fmaxf(__uint_as_float(rr[0]), __uint_as_float(rr[1])); } \
      resc = false; \
      if (__builtin_expect(__any(rm > (float)THRL), 0)) { const float dl = __builtin_fmaxf(rm, 0.f); mhat += dl; \
        _Pragma("unroll") for (int r = 0; r < 16; ++r) { C0[r] -= dl; C1[r] -= dl; } \
        NEGM_SET(((t) + 1) >> 2); \
        const float f = __builtin_amdgcn_exp2f(-dl); l_reg *= f; if (hi == 0) wsf[r32] = f; resc = true; } \
      else if ((((t) + 1) & 3) == 0) { NEGM_SET(((t) + 1) >> 2); } } \
    SBAR(); \
    GAPB(o[0] = __builtin_amdgcn_mfma_f32_32x32x16_bf16(PAF(0), VFR(0), o[0], 0, 0, 0), C0, 0); \
    GAPB(o[1] = __builtin_amdgcn_mfma_f32_32x32x16_bf16(PAF(0), VFR(4), o[1], 0, 0, 0), C0, 4); \
    KRD(GL, 0); GAPB(o[0] = __builtin_amdgcn_mfma_f32_32x32x16_bf16(PAF(1), VFR(1), o[0], 0, 0, 0), C0, 8); \
    KRD(GL, 1); GAPB(o[1] = __builtin_amdgcn_mfma_f32_32x32x16_bf16(PAF(1), VFR(5), o[1], 0, 0, 0), C0, 12); \
    KRD(GL, 2); GAPB(o[0] = __builtin_amdgcn_mfma_f32_32x32x16_bf16(PAF(2), VFR(2), o[0], 0, 0, 0), C1, 0); \
    KRD(GL, 3); GAPB(o[1] = __builtin_amdgcn_mfma_f32_32x32x16_bf16(PAF(2), VFR(6), o[1], 0, 0, 0), C1, 4); \
    GAPB(o[0] = __builtin_amdgcn_mfma_f32_32x32x16_bf16(PAF(3), VFR(3), o[0], 0, 0, 0), C1, 8); \
    GAPB(o[1] = __builtin_amdgcn_mfma_f32_32x32x16_bf16(PAF(3), VFR(7), o[1], 0, 0, 0), C1, 12); \
    QRD(0); QRD(1); SBAR(); \
    } while (0)
  int t = 1;
  #undef CMASK
  #define CMASK(P0, P1, t) do {} while (0)
  for (; t + 5 < NT; t += 2) {
    STEP(pB0, pB1, pA0, pA1, t, true, true, true);     WAIT_BAR(2); RESC(); ROT();
    STEP(pA0, pA1, pB0, pB1, t + 1, true, true, true); WAIT_BAR(2); RESC(); ROT();
  }
  #undef CMASK
  #define CMASK(P0, P1, t) do { int jb_ = (t) - (NT - 4); if (jb_ >= 0) cmask(P0, P1, jb_, qrel, hi); } while (0)
  #define ENDW(tt) do { if ((tt) + 3 < NT) { WAIT_BAR(2); } else if ((tt) + 2 < NT) { WAIT_BAR(1); } else { WAIT_BAR(0); } } while (0)
  for (; t + 1 < NT; t += 2) {
    STEP(pB0, pB1, pA0, pA1, t, (t + 3 < NT), (t + 1 < NT), (t + 1 < NT));       ENDW(t);     RESC(); ROT();
    STEP(pA0, pA1, pB0, pB1, t + 1, (t + 4 < NT), (t + 2 < NT), (t + 2 < NT));   ENDW(t + 1); RESC(); ROT();
  }
  STEP(pB0, pB1, pA0, pA1, NT - 1, false, false, false); RESC();
  { float sacc = pB0[0] + pB0[1]; _Pragma("unroll") for (int r = 2; r < 16; ++r) sacc += pB0[r]; _Pragma("unroll") for (int r = 0; r < 16; ++r) sacc += pB1[r]; l_reg += sacc;
    pw0 = (u32x4){PKW(pB0, 0), PKW(pB0, 2), PKW(pB0, 4), PKW(pB0, 6)}; pw1 = (u32x4){PKW(pB0, 8), PKW(pB0, 10), PKW(pB0, 12), PKW(pB0, 14)}; pw2 = (u32x4){PKW(pB1, 0), PKW(pB1, 2), PKW(pB1, 4), PKW(pB1, 6)}; pw3 = (u32x4){PKW(pB1, 8), PKW(pB1, 10), PKW(pB1, 12), PKW(pB1, 14)};
    SBAR(); pv(o, vb0 + sl_cur, PAF(0), PAF(1), PAF(2), PAF(3)); }
  #undef PKW
  #undef PAF
  #undef VFR
  #undef PIN
  #undef MX3
  #undef GAPA
  #undef GAPB
  #undef EX
  #undef VRD
  #undef KRD
  #undef QRD
  #undef STEP
  #undef ENDW
  { auto rr = __builtin_amdgcn_permlane32_swap(__float_as_uint(l_reg), __float_as_uint(l_reg), false, false); l_reg = __uint_as_float(rr[0]) + __uint_as_float(rr[1]); }
  if (hi == 0) wsf[32 + r32] = l_reg; asm volatile("s_waitcnt lgkmcnt(0)" ::: "memory");
  float rli[16];
  #pragma unroll
  for (int r = 0; r < 16; ++r) rli[r] = __builtin_amdgcn_rcpf(wsf[32 + crow(r, hi)]);
  bf16_t* Ow = Ob + (rowbase + q0 + wid * QBLK) * DMQ + h * D;
  { bf16_t* stg = (bf16_t*)(shm + LDS_OST) + wid * 2048;
    #pragma unroll
    for (int r = 0; r < 16; ++r) { const int orow = crow(r, hi);
      #pragma unroll
      for (int d0 = 0; d0 < 2; ++d0) stg[orow * 64 + d0 * 32 + r32] = (bf16_t)f2bf(o[d0][r] * rli[r]); }
    asm volatile("s_waitcnt lgkmcnt(0)" ::: "memory");
    #pragma unroll
    for (int i = 0; i < 4; ++i) { const int row = i * 8 + (lane >> 3), ch = lane & 7; const u32x4 v = *(const u32x4*)(stg + row * 64 + ch * 8); ATTN_STORE16(Ow + (long)row * DMQ + ch * 8, v); } }
  asm volatile("s_waitcnt lgkmcnt(0)\n\ts_barrier" ::: "memory");
  #undef DMA_K
  #undef DMA_V
  #undef CMASK
  #undef START
  #undef RESC
  #undef ROT
  #undef SELROW
  #undef NEGM_SET
}
#undef SBAR
#undef WAIT_BAR
}
__device__ __forceinline__ void conv_pass(Frame& F) {
    bf16_t* YAB = WSP(bf16_t, WS_YAB); const bf16_t* U = WSP(bf16_t, WS_U); const bf16_t* BG = WSP(bf16_t, WS_BG);
    const int stride = F.G * NTHREADS;
    for (int i0 = blockIdx.x * NTHREADS + F.tid; i0 < T * 64; i0 += 2 * stride) {
        u32x4 r2[2], r1[2], r0[2], rb[2];
#pragma unroll
        for (int q = 0; q < 2; ++q) { const int i = i0 + q * stride; const int t = i >> 6, c0 = (i & 63) * 8, pos = t & (S - 1);
            r2[q] = *(const u32x4*)(U + (size_t)t * 512 + c0); rb[q] = *(const u32x4*)(BG + (size_t)t * 512 + c0);
            r1[q] = (pos >= 1) ? *(const u32x4*)(U + (size_t)(t - 1) * 512 + c0) : (u32x4){0u, 0u, 0u, 0u};
            r0[q] = (pos >= 2) ? *(const u32x4*)(U + (size_t)(t - 2) * 512 + c0) : (u32x4){0u, 0u, 0u, 0u}; }
#pragma unroll
        for (int q = 0; q < 2; ++q) { const int i = i0 + q * stride; const int t = i >> 6, c0 = (i & 63) * 8;
            float u0[8], u1[8], u2[8], bg[8], y[8]; unpack8(r2[q], u2); unpack8(r1[q], u1); unpack8(r0[q], u0); unpack8(rb[q], bg);
#pragma unroll
            for (int e4 = 0; e4 < 2; ++e4) { const f32x4 w0 = *(const f32x4*)(F.conv_w + c0 + 4 * e4), w1 = *(const f32x4*)(F.conv_w + 512 + c0 + 4 * e4), w2 = *(const f32x4*)(F.conv_w + 1024 + c0 + 4 * e4), cb = *(const f32x4*)(F.conv_b + c0 + 4 * e4);
#pragma unroll
                for (int e = 0; e < 4; ++e) y[4 * e4 + e] = bg[4 * e4 + e] * (w0[e] * u0[4 * e4 + e] + w1[e] * u1[4 * e4 + e] + w2[e] * u2[4 * e4 + e] + cb[e]); }
            st16(YAB + (size_t)t * 1024 + 512 + c0, pack8(y)); }
    }
}
__device__ __forceinline__ void s3_attn(Frame& F, char* lds_gen, bf16_t* obase) {
    const int vcu = (blockIdx.x % 8) * (F.G / 8) + blockIdx.x / 8;
    const int s = vcu & 7, pr = vcu >> 3;
    for (int i = 0; i < 4; ++i) {
        const int bh = 2 * pr + (i >> 1), qb = (i & 1) ? 15 - s : s;
        attn_body::attn_unit<8>(bh >> 3, bh & 7, qb, WSP(bf16_t, WS_YAB), obase, WSP(bf16_t, WS_K), WSP(bf16_t, WS_V), WSP(float, WS_KMEAN), lds_gen);
    }
}
__device__ __forceinline__ void s3_fast(Frame& F, char* lds_gen) { s3_attn(F, lds_gen, WSP(bf16_t, WS_YAB)); conv_pass(F); }

__device__ __forceinline__ void s4_simple(Frame& F) {
    LAS float* tile = (LAS float*)F.lds; LAS float* tile2 = tile + 64 * 65;
    const bf16_t* YAB = WSP(bf16_t, WS_YAB); const bf16_t* WP = WSP(bf16_t, WS_WP_T); const bf16_t* GT = WSP(bf16_t, WS_GATES);
    const int row = F.tid >> 3, seg = F.tid & 7;
    for (int it = blockIdx.x; it < 512 * 16; it += F.G) {
        const int rt = it >> 4, ct = it & 15, r0 = rt * 64, gr = r0 + row;
        const RowsLinear aa{YAB + (size_t)r0 * 1024, 1024}, ab{YAB + (size_t)r0 * 1024 + 512, 1024};
        const RowsLinear ba{WP + (size_t)(64 * ct) * 1024, 1024}, bb{WP + (size_t)(64 * ct) * 1024 + 512, 1024};
        sgemm_tile(tile, 512, aa, ba, F.wave, F.lane); sgemm_tile(tile2, 512, ab, bb, F.wave, F.lane); __syncthreads();
        float ga[8], gb[8], v[8];
        unpack8(*(const u32x4*)(GT + (size_t)gr * 2048 + 64 * ct + 8 * seg), ga); unpack8(*(const u32x4*)(GT + (size_t)gr * 2048 + 1024 + 64 * ct + 8 * seg), gb);
#pragma unroll
        for (int e = 0; e < 8; ++e) v[e] = ga[e] * tile[row * 65 + 8 * seg + e] + gb[e] * tile2[row * 65 + 8 * seg + e];
        *(u32x4*)(WSP(bf16_t, WS_H) + (size_t)gr * 1024 + 64 * ct + 8 * seg) = pack8(v);
        __syncthreads();
    }
}
__device__ __forceinline__ void s5_simple(Frame& F) {
    LAS float* tile = (LAS float*)F.lds;
    const bf16_t* MG = WSP(bf16_t, WS_H); const bf16_t* WO = WSP(bf16_t, WS_WO_T);
    const int row = F.tid >> 3, seg = F.tid & 7;
    for (int it = blockIdx.x; it < 512 * 16; it += F.G) {
        const int rt = it >> 4, ct = it & 15, r0 = rt * 64, gr = r0 + row, b = r0 / S;
        const RowsLinear aa{MG + (size_t)r0 * 1024, 1024}, bb{WO + (size_t)(64 * ct) * 1024, 1024};
        sgemm_tile(tile, 1024, aa, bb, F.wave, F.lane); __syncthreads();
        const float* ga1 = WSP(float, WS_MOD) + (size_t)b * NMOD + 2048 + 64 * ct + 8 * seg;
        const float* xr = F.x + (size_t)gr * D + 64 * ct + 8 * seg; float* orow = F.out + (size_t)gr * D + 64 * ct + 8 * seg;
#pragma unroll
        for (int e4 = 0; e4 < 2; ++e4) { const f32x4 xv = *(const f32x4*)(xr + 4 * e4), gv = *(const f32x4*)(ga1 + 4 * e4); f32x4 o;
#pragma unroll
            for (int e = 0; e < 4; ++e) o[e] = xv[e] + gv[e] * tile[row * 65 + 8 * seg + 4 * e4 + e];
            *(f32x4*)(orow + 4 * e4) = o; }
        __syncthreads();
    }
}

struct EpiG2 {
    static constexpr bool HAS_MID = true;
    const bf16_t* gates; bf16_t* merged;
    __device__ __forceinline__ void mid(Acc& acc, const pg8::Unit& u, int wr, int wc, int fr, int fq) const {
        int row0 = u.pm * 256 + wr * 64 + fr; const int c0 = u.pn * 256 + 32 * wc + 8 * fq; asm volatile("" : "+v"(row0));
#pragma unroll
        for (int ai = 0; ai < 2; ++ai)
#pragma unroll
            for (int m = 0; m < 4; ++m) { const bf16_t* gp = gates + (size_t)(row0 + 128 * ai + 16 * m) * 2048 + c0;
#pragma unroll
                for (int bj = 0; bj < 2; ++bj) { f32x4 a0, a1, b0, b1; unpack8v(*(const u32x4*)(gp + 128 * bj), a0, a1); unpack8v(*(const u32x4*)(gp + 1024 + 128 * bj), b0, b1);
#pragma unroll
                    for (int e = 0; e < 4; ++e) { acc[ai][bj][m][0][e] *= a0[e] * __builtin_amdgcn_rcpf(fmaxf(b0[e], 1e-12f)); acc[ai][bj][m][1][e] *= a1[e] * __builtin_amdgcn_rcpf(fmaxf(b1[e], 1e-12f)); }
 }
                if (m & 1) asm volatile("" ::: "memory"); }
    }
    __device__ __forceinline__ void operator()(Acc& acc, const pg8::Unit& u, int wr, int wc, int fr, int fq) const {
        int row0 = u.pm * 256 + wr * 64 + fr; const int c0 = u.pn * 256 + 32 * wc + 8 * fq; asm volatile("" : "+v"(row0));
#pragma unroll
        for (int ai = 0; ai < 2; ++ai)
#pragma unroll
            for (int m = 0; m < 4; ++m) { const size_t r = (size_t)(row0 + 128 * ai + 16 * m);
#pragma unroll
                for (int bj = 0; bj < 2; ++bj) { f32x4 b0, b1; unpack8v(*(const u32x4*)(gates + r * 2048 + 1024 + c0 + 128 * bj), b0, b1);
                    st16(merged + r * 1024 + c0 + 128 * bj, pack8v(acc[ai][bj][m][0] * b0, acc[ai][bj][m][1] * b1)); }
                if (m & 1) asm volatile("" ::: "memory"); }
    }
};
__device__ __forceinline__ void s4_fast(Frame& F) {
    const pg8::DenseSched Sd{(const char*)(F.ws + WS_YAB), (const char*)(F.ws + WS_WP_T), T / 256, 4, 1024, F.G, (int)blockIdx.x};
    const EpiG2 E{WSP(bf16_t, WS_GATES), WSP(bf16_t, WS_H)};
    pg8::gemm_phase<EpiG2, pg8::DenseSched>(F.lds, 1024, Sd, E);
}
struct EpiG3 {
    static constexpr bool HAS_MID = false;
    const float* x; bf16_t* x1; const float* mod;
    __device__ __forceinline__ void mid(Acc&, const pg8::Unit&, int, int, int, int) const {}
    __device__ __forceinline__ void operator()(Acc& acc, const pg8::Unit& u, int wr, int wc, int fr, int fq) const {
        int row0 = u.pm * 256 + wr * 64 + fr; const int c0 = u.pn * 256 + 32 * wc + 8 * fq, b = u.pm >> 4; asm volatile("" : "+v"(row0));
        f32x4 gv[2][2];
#pragma unroll
        for (int bj = 0; bj < 2; ++bj)
#pragma unroll
            for (int n = 0; n < 2; ++n) gv[bj][n] = *(const f32x4*)(mod + (size_t)b * NMOD + 2048 + c0 + 128 * bj + 4 * n);
#pragma unroll
        for (int ai = 0; ai < 2; ++ai)
#pragma unroll
            for (int m = 0; m < 4; ++m) { const size_t off = (size_t)(row0 + 128 * ai + 16 * m) * D + c0;
#pragma unroll
                for (int bj = 0; bj < 2; ++bj) { const f32x4 x0 = *(const f32x4*)(x + off + 128 * bj), x1v = *(const f32x4*)(x + off + 128 * bj + 4);
                    st16(x1 + off + 128 * bj, pack8v(x0 + gv[bj][0] * acc[ai][bj][m][0], x1v + gv[bj][1] * acc[ai][bj][m][1])); }
                if (m == 3) asm volatile("" ::: "memory"); }
    }
};
__device__ __forceinline__ void s5_fast(Frame& F) {
    const pg8::DenseSched Sd{(const char*)(F.ws + WS_H), (const char*)(F.ws + WS_WO_T), T / 256, 4, 1024, F.G, (int)blockIdx.x};
    const EpiG3 E{F.x, WSP(bf16_t, WS_X1), WSP(float, WS_MOD)};
    pg8::gemm_phase<EpiG3, pg8::DenseSched>(F.lds, 1024, Sd, E);
}
struct MoeTab { const LAS int* cnt; const LAS int* tstart; const LAS int* tile_e; int nM; };
__device__ __forceinline__ MoeTab moe_table(Frame& F) {
    LAS int* cntL = (LAS int*)(F.lds + MISC_OFF + 1024); LAS int* ts = cntL + 32; LAS int* te = cntL + 96;
    if (F.tid < 32) cntL[F.tid] = (int)__hip_atomic_load(WSP(unsigned, WS_CTL) + CW_GCNT + 64 * F.tid, __ATOMIC_RELAXED, __HIP_MEMORY_SCOPE_AGENT);
    __syncthreads();
    if (F.tid == 0) { int pm = 0; for (int e = 0; e < 32; ++e) { ts[e] = pm; const int n = (cntL[e] + 255) >> 8; for (int i = 0; i < n; ++i) te[pm++] = e; } ts[32] = pm; }
    __syncthreads();
    return MoeTab{cntL, ts, te, ts[32]};
}
struct MoeUpSched {
    static constexpr bool GATHER = true, FP8 = true;
    const char* h2; const char* w13; MoeTab tb; const int* linfo; int G, c;
    __device__ __forceinline__ bool next(int i, pg8::Unit& u) const { if (!pg8::static_unit(i, G, c, tb.nM, 4, u.pm, u.pn)) return false;
        u.e = tb.tile_e[u.pm]; u.rbase = (u.pm - tb.tstart[u.e]) * 256; u.a = h2; u.b = w13 + ((size_t)u.e * 1024 + 256 * u.pn) * 1024; return true; }
    __device__ __forceinline__ int row_index(const pg8::Unit& u, int r) const { const int rank = u.rbase + r; return rank < tb.cnt[u.e] ? (linfo[(size_t)u.e * 65536 + rank] >> 1) : 0; }
};
struct EpiUp {
    static constexpr bool HAS_MID = false;
    bf16_t* hid; const float* lw; const LAS int* cnt;
    __device__ __forceinline__ void mid(Acc&, const pg8::Unit&, int, int, int, int) const {}
    __device__ __forceinline__ void operator()(Acc& acc, const pg8::Unit& u, int wr, int wc, int fr, int fq) const {
        int rl0 = wr * 64 + fr; const int c0 = u.pn * 128 + 32 * wc + 8 * fq, n_e = cnt[u.e]; asm volatile("" : "+v"(rl0));
#pragma unroll
        for (int ai = 0; ai < 2; ++ai)
#pragma unroll
            for (int m = 0; m < 4; ++m) { const int rl = rl0 + 128 * ai + 16 * m, rank = u.rbase + rl; const float wt = rank < n_e ? 1.f : 0.f; f32x4 o[2];
#pragma unroll
                for (int n = 0; n < 2; ++n)
#pragma unroll
                    for (int e = 0; e < 4; ++e) { const float a = acc[ai][0][m][n][e] * (1.f / W8_SCALE), c = acc[ai][1][m][n][e] * (1.f / W8_SCALE); o[n][e] = a * __builtin_amdgcn_rcpf(1.f + __expf(-a)) * c * wt; }
                *(u32x2*)((unsigned char*)hid + (size_t)(u.pm * 256 + rl) * 512 + c0) = pack8_fp8(o[0], o[1]); }
    }
};
__device__ __forceinline__ void s8_fast(Frame& F) {
    const MoeTab tb = moe_table(F);
    const MoeUpSched Sd{(const char*)(F.ws + WS_H2), (const char*)(F.ws + WS_W13_T), tb, WSP(int, WS_LINFO), F.G, (int)blockIdx.x};
    const EpiUp E{WSP(bf16_t, WS_HID), WSP(float, WS_LW), tb.cnt};
    int Ku = D; asm volatile("" : "+s"(Ku));
    pg8::gemm_phase<EpiUp, MoeUpSched>(F.lds, Ku, Sd, E);
}
struct MoeDownSched {
    static constexpr bool GATHER = false, FP8 = true;
    const char* hid; const char* w2; MoeTab tb; int G, c;
    __device__ __forceinline__ bool next(int i, pg8::Unit& u) const { if (!pg8::static_unit(i, G, c, tb.nM, 4, u.pm, u.pn)) return false;
        u.e = tb.tile_e[u.pm]; u.rbase = (u.pm - tb.tstart[u.e]) * 256; u.a = hid + (size_t)u.pm * 256 * 512; u.b = w2 + ((size_t)u.e * 1024 + 256 * u.pn) * 512; return true; }
    __device__ __forceinline__ int row_index(const pg8::Unit&, int) const { return 0; }
};
struct EpiDown {
    static constexpr bool HAS_MID = false;
    bf16_t* yslot; const int* linfo; const float* lw; const LAS int* cnt;
    __device__ __forceinline__ void mid(Acc&, const pg8::Unit&, int, int, int, int) const {}
    __device__ __forceinline__ void operator()(Acc& acc, const pg8::Unit& u, int wr, int wc, int fr, int fq) const {
        int rl0 = wr * 64 + fr; const int c0 = u.pn * 256 + 32 * wc + 8 * fq, n_e = cnt[u.e]; asm volatile("" : "+v"(rl0));
#pragma unroll
        for (int ai = 0; ai < 2; ++ai)
#pragma unroll
            for (int m = 0; m < 4; ++m) { const int rank = u.rbase + rl0 + 128 * ai + 16 * m;
                if (rank < n_e) { const int info = linfo[(size_t)u.e * 65536 + rank]; const float wt = lw[(size_t)u.e * 65536 + rank] * (1.f / W8_SCALE);
#pragma unroll
                    for (int bj = 0; bj < 2; ++bj) st16(yslot + (size_t)info * 1024 + c0 + 128 * bj, pack8v(acc[ai][bj][m][0] * wt, acc[ai][bj][m][1] * wt)); } }
    }
};
__device__ __forceinline__ void s9_fast(Frame& F) {
    const MoeTab tb = moe_table(F);
    const MoeDownSched Sd{(const char*)(F.ws + WS_HID), (const char*)(F.ws + WS_W2_T), tb, F.G, (int)blockIdx.x};
    const EpiDown E{WSP(bf16_t, WS_YSLOT), WSP(int, WS_LINFO), WSP(float, WS_LW), tb.cnt};
    int Kd = DE; asm volatile("" : "+s"(Kd));
    pg8::gemm_phase<EpiDown, MoeDownSched>(F.lds, Kd, Sd, E);
}

__device__ __forceinline__ void s6_router(Frame& F) {
    constexpr int WROW = 1032;
    LAS bf16_t* WT = (LAS bf16_t*)F.lds;
    LAS float* gsL = (LAS float*)(F.lds + 48 * WROW * 2);
    LAS float* shL = gsL + 1024;
    LAS float* biasL = shL + 1024;
    LAS float* lgt = biasL + 64;
    LAS int* cnt = (LAS int*)(F.lds + MISC_OFF + 256);
    LAS int* baseL = cnt + 32; LAS int* runL = cnt + 64; LAS int* eidL = cnt + 128; LAS float* ewL = (LAS float*)(cnt + 384);
    const int b = blockIdx.x >> 5;
    const float* mod = WSP(float, WS_MOD) + (size_t)b * NMOD;
    const float* W36 = WSP(float, WS_W36T);
    for (int i = F.tid; i < 36 * 256; i += NTHREADS) { const int jj = i >> 8, k4 = (i & 255) * 4; const f32x4 w = *(const f32x4*)(W36 + jj * 1024 + k4);
        u32x2 p; p.x = pk2(w.x, w.y); p.y = pk2(w.z, w.w); *(LAS u32x2*)(WT + jj * WROW + k4) = p; }
    for (int i = F.tid; i < 12 * 256; i += NTHREADS) { const int jj = 36 + (i >> 8), k4 = (i & 255) * 4; *(LAS u32x2*)(WT + jj * WROW + k4) = (u32x2){0u, 0u}; }
    if (F.tid < 256) { const int col = 4 * F.tid; const f32x4 g = *(const f32x4*)(F.g2 + col), s_ = *(const f32x4*)(mod + 4096 + col); *(LAS f32x4*)(gsL + col) = g * (s_ + 1.0f); *(LAS f32x4*)(shL + col) = *(const f32x4*)(mod + 3072 + col); }
    if (F.tid < 32) cnt[F.tid] = 0;
    __syncthreads();
    for (int jj = F.wave; jj < 36; jj += NWAVES) { float a = 0.f;
#pragma unroll
        for (int i = 0; i < 16; ++i) a += shL[F.lane + 64 * i] * W36[jj * 1024 + F.lane + 64 * i];
        a = wave_sum(a); if (F.lane == 0) biasL[jj] = a + ((jj < 4) ? F.b_rg[jj] : F.b_re[jj - 4]); }
    __syncthreads();
    const int fr = F.lane & 15, fq = F.lane >> 4, row0 = (blockIdx.x * NWAVES + F.wave) * 16, r = row0 + fr;
    const bf16_t* xr = WSP(bf16_t, WS_X1) + (size_t)r * D + 8 * fq;
    f32x4 D0 = {0.f, 0.f, 0.f, 0.f}, D1 = D0, D2 = D0; float ss = 0.f;
#pragma unroll 1
    for (int kb = 0; kb < 8; ++kb) {
        u32x4 xa[4];
#pragma unroll
        for (int i = 0; i < 4; ++i) xa[i] = *(const u32x4*)(xr + 32 * (4 * kb + i));
#pragma unroll
        for (int i = 0; i < 4; ++i) { const int k0 = 32 * (4 * kb + i) + 8 * fq;
            f32x4 a0, a1; unpack8v(xa[i], a0, a1);
            ss += (a0.x * a0.x + a0.y * a0.y) + (a0.z * a0.z + a0.w * a0.w) + (a1.x * a1.x + a1.y * a1.y) + (a1.z * a1.z + a1.w * a1.w);
            a0 *= *(const LAS f32x4*)(gsL + k0); a1 *= *(const LAS f32x4*)(gsL + k0 + 4);
            const bf16x8 A = __builtin_bit_cast(bf16x8, pack8v(a0, a1));
            const bf16x8 B0 = *(const LAS bf16x8*)(WT + fr * WROW + k0), B1 = *(const LAS bf16x8*)(WT + (16 + fr) * WROW + k0), B2 = *(const LAS bf16x8*)(WT + (32 + fr) * WROW + k0);
            D0 = __builtin_amdgcn_mfma_f32_16x16x32_bf16(A, B0, D0, 0, 0, 0);
            D1 = __builtin_amdgcn_mfma_f32_16x16x32_bf16(A, B1, D1, 0, 0, 0);
            D2 = __builtin_amdgcn_mfma_f32_16x16x32_bf16(A, B2, D2, 0, 0, 0); }
    }
    ss += __shfl_xor(ss, 16); ss += __shfl_xor(ss, 32);
    const float rinv = rsqrtf(ss * (1.f / D) + EPS);
    { int t2 = threadIdx.x; asm volatile("" : "+v"(t2)); F.lane = t2 & 63; }
    const int fr_ = F.lane & 15, fq_ = F.lane >> 4;
    {
        LAS float* lw = lgt + F.wave * 16 * 37;
#pragma unroll
        for (int reg = 0; reg < 4; ++reg) { const float rv = __shfl(rinv, 4 * fq_ + reg); const int tk = 4 * fq_ + reg;
            lw[tk * 37 + fr_] = D0[reg] * rv + biasL[fr_]; lw[tk * 37 + 16 + fr_] = D1[reg] * rv + biasL[16 + fr_];
            if (fr_ < 4) lw[tk * 37 + 32 + fr_] = D2[reg] * rv + biasL[32 + fr_]; }
    }
    {
        const int r_ = row0 + fr_; const bf16_t* xr_ = WSP(bf16_t, WS_X1) + (size_t)r_ * D + 8 * fq_;
        unsigned char* o = WSP(unsigned char, WS_H2) + (size_t)r_ * D + 8 * fq_;
#pragma unroll 1
        for (int kb = 0; kb < 8; ++kb) {
            u32x4 xa[4];
#pragma unroll
            for (int i = 0; i < 4; ++i) xa[i] = *(const u32x4*)(xr_ + 32 * (4 * kb + i));
#pragma unroll
            for (int i = 0; i < 4; ++i) { const int k0 = 32 * (4 * kb + i) + 8 * fq_; f32x4 a0, a1; unpack8v(xa[i], a0, a1);
                const f32x4 h0 = a0 * rinv * *(const LAS f32x4*)(gsL + k0) + *(const LAS f32x4*)(shL + k0), h1 = a1 * rinv * *(const LAS f32x4*)(gsL + k0 + 4) + *(const LAS f32x4*)(shL + k0 + 4);
                *(u32x2*)(o + 32 * (4 * kb + i)) = pack8_fp8(h0, h1); }
        }
    }
    if (F.lane < 16) {
        const int t = row0 + F.lane; const LAS float* lw = lgt + (F.wave * 16 + F.lane) * 37;
        float lg[36];
#pragma unroll
        for (int jj = 0; jj < 36; ++jj) lg[jj] = lw[jj];
        int gi = 0; float gm = lg[0];
#pragma unroll
        for (int i = 1; i < 4; ++i) if (lg[i] > gm) { gm = lg[i]; gi = i; }
        float den = 0.f;
#pragma unroll
        for (int i = 0; i < 4; ++i) den += __expf(lg[i] - gm);
        const float gw_ = 1.f / den;
        float v1 = -INFINITY, v2 = -INFINITY; int e1 = 0, e2 = 0;
#pragma unroll
        for (int i = 0; i < 8; ++i) { const float el = (gi == 0) ? lg[4 + i] : (gi == 1) ? lg[12 + i] : (gi == 2) ? lg[20 + i] : lg[28 + i];
            const bool c1 = el > v1, c2 = el > v2;
            v2 = c1 ? v1 : (c2 ? el : v2); e2 = c1 ? e1 : (c2 ? i : e2); v1 = c1 ? el : v1; e1 = c1 ? i : e1; }
        const float p1 = 1.f / (1.f + __expf(v2 - v1)), p2 = 1.f - p1;
        const int id1 = gi * 8 + e1, id2 = gi * 8 + e2;
        const int la = 2 * (F.wave * 16 + F.lane);
        eidL[la] = id1; eidL[la + 1] = id2; ewL[la] = p1 * gw_; ewL[la + 1] = p2 * gw_;
        lds_add(&cnt[id1], 1); lds_add(&cnt[id2], 1);
    }
    __syncthreads();
    if (F.tid < 32) { baseL[F.tid] = (int)__hip_atomic_fetch_add(WSP(unsigned, WS_CTL) + CW_GCNT + 64 * F.tid, (unsigned)cnt[F.tid], __ATOMIC_RELAXED, __HIP_MEMORY_SCOPE_AGENT); runL[F.tid] = 0; }
    __syncthreads();
    if (F.tid < 256) { const int e = eidL[F.tid]; const int pos = baseL[e] + lds_add(&runL[e], 1);
        WSP(int, WS_LINFO)[(size_t)e * 65536 + pos] = 2 * (blockIdx.x * 128) + F.tid; WSP(float, WS_LW)[(size_t)e * 65536 + pos] = ewL[F.tid]; }
}

__device__ __forceinline__ void s7_lists(Frame& F) {
    LAS int* sm = (LAS int*)F.lds;
    const int* bc = WSP(int, WS_BCNT);
    if (F.tid < 32) { int tot = 0, base = 0; for (int bb = 0; bb < 256; ++bb) { const int c = bc[bb * 32 + F.tid]; if (bb < (int)blockIdx.x) base += c; tot += c; }
        sm[F.tid] = tot; sm[32 + F.tid] = base; sm[96 + F.tid] = 0; }
    __syncthreads();
    if (F.tid == 0) { int ps = 0; for (int e = 0; e < 32; ++e) { sm[64 + e] = ps; ps += (sm[e] + 255) & ~255; }
        if (blockIdx.x == 0) { int* te = WSP(int, WS_TILEE); int pm = 0; for (int e = 0; e < 32; ++e) { const int n = (sm[e] + 255) >> 8; for (int i = 0; i < n; ++i) te[1 + pm++] = e; } te[0] = pm; } }
    __syncthreads();
    int* atok = WSP(int, WS_ATOK); int* ainfo = WSP(int, WS_AINFO); float* aw = WSP(float, WS_AW);
    if (F.tid < 256) { const int a = blockIdx.x * 256 + F.tid;
        const int e = WSP(int, WS_EID)[a]; const int rank = lds_add(&sm[96 + e], 1); const int pos = sm[64 + e] + sm[32 + e] + rank;
        atok[pos] = a >> 1; ainfo[pos] = a; aw[pos] = WSP(float, WS_EW)[a]; }
    if (blockIdx.x < 32) { const int e = blockIdx.x; const int lo = sm[64 + e] + sm[e], hi = sm[64 + e] + ((sm[e] + 255) & ~255);
        for (int p = lo + F.tid; p < hi; p += NTHREADS) { atok[p] = 0; ainfo[p] = -1; aw[p] = 0.f; } }
}

struct RowsGather { const bf16_t* base; const int* idx; __device__ __forceinline__ const bf16_t* operator()(int r) const { return base + (size_t)idx[r] * 1024; } };
__device__ __forceinline__ void s8_simple(Frame& F) {
    LAS float* tile = (LAS float*)F.lds; LAS float* tile2 = tile + 64 * 65;
    const int* te = WSP(int, WS_TILEE); const int nmt = te[0];
    const int row = F.tid >> 3, seg = F.tid & 7;
    for (int it = blockIdx.x; it < nmt * 4 * 8; it += F.G) {
        const int rt = it >> 3, ct = it & 7, e = te[1 + (rt >> 2)], pos0 = 64 * rt, hc = 64 * ct;
        const RowsGather ar{WSP(bf16_t, WS_H2), WSP(int, WS_ATOK) + pos0};
        const bf16_t* wb = WSP(bf16_t, WS_W13_T) + ((size_t)e * 1024 + 256 * (hc >> 7) + (hc & 127)) * 1024;
        const RowsLinear b1{wb, 1024}, b3{wb + (size_t)128 * 1024, 1024};
        sgemm_tile(tile, 1024, ar, b1, F.wave, F.lane); sgemm_tile(tile2, 1024, ar, b3, F.wave, F.lane); __syncthreads();
        const float wt = WSP(float, WS_AW)[pos0 + row]; float v[8];
#pragma unroll
        for (int e8 = 0; e8 < 8; ++e8) { const float a = tile[row * 65 + 8 * seg + e8], c = tile2[row * 65 + 8 * seg + e8]; v[e8] = (a / (1.f + __expf(-a))) * c * wt; }
        *(u32x4*)(WSP(bf16_t, WS_HID) + (size_t)(pos0 + row) * 512 + hc + 8 * seg) = pack8(v);
        __syncthreads();
    }
}
__device__ __forceinline__ void s9_simple(Frame& F) {
    LAS float* tile = (LAS float*)F.lds;
    const int* te = WSP(int, WS_TILEE); const int nmt = te[0];
    const int row = F.tid >> 3, seg = F.tid & 7;
    for (int it = blockIdx.x; it < nmt * 4 * 16; it += F.G) {
        const int rt = it >> 4, ct = it & 15, e = te[1 + (rt >> 2)], pos0 = 64 * rt;
        const RowsLinear ar{WSP(bf16_t, WS_HID) + (size_t)pos0 * 512, 512};
        const RowsLinear br{WSP(bf16_t, WS_W2_T) + ((size_t)e * 1024 + 64 * ct) * 512, 512};
        sgemm_tile(tile, 512, ar, br, F.wave, F.lane); __syncthreads();
        const int info = WSP(int, WS_AINFO)[pos0 + row];
        if (info >= 0) { float v[8];
#pragma unroll
            for (int e8 = 0; e8 < 8; ++e8) v[e8] = tile[row * 65 + 8 * seg + e8];
            *(u32x4*)(WSP(bf16_t, WS_YSLOT) + (size_t)info * 1024 + 64 * ct + 8 * seg) = pack8(v); }
        __syncthreads();
    }
}
__device__ __forceinline__ void s10_combine(Frame& F) {
    const bf16_t* Y = WSP(bf16_t, WS_YSLOT); const bf16_t* X1 = WSP(bf16_t, WS_X1);
    const int stride = F.G * NTHREADS;
    for (int i0 = blockIdx.x * NTHREADS + F.tid; i0 < T * 128; i0 += 2 * stride) {
        u32x4 ya[2], yb[2], xx[2]; f32x4 g0[2], g1[2];
#pragma unroll
        for (int q = 0; q < 2; ++q) { const int i = i0 + q * stride; const int t = i >> 7, c0 = (i & 127) * 8, b = t / S;
            ya[q] = *(const u32x4*)(Y + (size_t)(2 * t) * 1024 + c0); yb[q] = *(const u32x4*)(Y + (size_t)(2 * t + 1) * 1024 + c0); xx[q] = *(const u32x4*)(X1 + (size_t)t * D + c0);
            const float* ga2 = WSP(float, WS_MOD) + (size_t)b * NMOD + 5120 + c0; g0[q] = *(const f32x4*)ga2; g1[q] = *(const f32x4*)(ga2 + 4); }
#pragma unroll
        for (int q = 0; q < 2; ++q) { const int i = i0 + q * stride; const int t = i >> 7, c0 = (i & 127) * 8;
            f32x4 y0a, y0b, y1a, y1b, xa, xb; unpack8v(ya[q], y0a, y0b); unpack8v(yb[q], y1a, y1b); unpack8v(xx[q], xa, xb);
            float* o = F.out + (size_t)t * D + c0;
            *(f32x4*)o = xa + g0[q] * (y0a + y1a); *(f32x4*)(o + 4) = xb + g1[q] * (y0b + y1b); }
    }
}

constexpr int N_PHASES = 11;
struct Args { const float* in[21]; float* out; unsigned char* ws; int ph_lo, ph_hi; };
__global__ void __launch_bounds__(NTHREADS, 2) mega_fwd(Args args) {
    extern __shared__ __attribute__((aligned(16))) unsigned char lds_raw[];
    Frame F;
    F.lds = (LAS unsigned char*)lds_raw;
    F.tid = threadIdx.x; F.lane = F.tid & 63; F.wave = __builtin_amdgcn_readfirstlane(F.tid >> 6); F.G = gridDim.x;
    F.x = args.in[0]; F.c = args.in[1]; F.w_ada = args.in[2]; F.b_ada = args.in[3]; F.g1 = args.in[4]; F.g2 = args.in[5]; F.w_in = args.in[6]; F.g_q = args.in[7]; F.g_k = args.in[8];
    F.conv_w = args.in[9]; F.conv_b = args.in[10]; F.w_pa = args.in[11]; F.w_pb = args.in[12]; F.w_o = args.in[13]; F.w_rg = args.in[14]; F.b_rg = args.in[15]; F.w_re = args.in[16]; F.b_re = args.in[17];
    F.w1 = args.in[18]; F.w3 = args.in[19]; F.w2 = args.in[20]; F.out = args.out; F.ws = args.ws;
    volatile LAS unsigned* MISC = (volatile LAS unsigned*)(F.lds + MISC_OFF);
    if (F.tid < 64) MISC[F.tid] = 0u;
    __syncthreads();
    XcdBarrier bar = xcd_barrier_post((unsigned*)(F.ws + WS_CTL) + CW_BAR, MISC + 8);
    const int lo = args.ph_lo, hi = args.ph_hi;
#ifndef REPEAT_MASK
#define REPEAT_MASK 0
#endif
#define PHASE(k, body) if (lo <= (k) && (k) < hi) { for (int rep_ = 0; rep_ < 1 + ((REPEAT_MASK >> (k)) & 1); ++rep_) { { int t_ = threadIdx.x; asm volatile("" : "+v"(t_)); F.tid = t_; F.lane = t_ & 63; } body; __syncthreads(); } if ((k) + 1 < hi) xcd_barrier(bar); }
    PHASE(0, s0_prologue(F); wait_mod(F); s1_norm1(F))
    PHASE(2, s2_fast(F))
    PHASE(3, s3_fast(F, (char*)lds_raw))
    PHASE(4, s4_fast(F))
    PHASE(5, s5_fast(F))
    PHASE(6, s6_router(F))
    PHASE(8, s8_fast(F))
    PHASE(9, s9_fast(F))
    PHASE(10, s10_combine(F))
#undef PHASE
}

extern "C" void kernel_launch(void* const* d_in, const int* in_sizes, int n_in, void* d_out, int out_size, void* d_ws, size_t ws_size, hipStream_t stream) {
    static int grid = 0;
    if (grid == 0) {
        if (n_in != 21 || in_sizes[0] != T * D || out_size != T * D || ws_size < WS_END) { fprintf(stderr, "kernel_launch: unexpected shapes (n_in %d, in0 %d, out %d, ws %zu); nothing launched\n", n_in, n_in > 0 ? in_sizes[0] : -1, out_size, ws_size); grid = -1; return; }
        int dev = 0, cus = 0, per_cu = 0;
        if (hipGetDevice(&dev) != hipSuccess || hipDeviceGetAttribute(&cus, hipDeviceAttributeMultiprocessorCount, dev) != hipSuccess) { grid = -1; return; }
        if (hipFuncSetAttribute((const void*)mega_fwd, hipFuncAttributeMaxDynamicSharedMemorySize, LDS_BYTES) != hipSuccess) { fprintf(stderr, "kernel_launch: hipFuncSetAttribute failed\n"); grid = -1; return; }
        if (hipOccupancyMaxActiveBlocksPerMultiprocessor(&per_cu, (const void*)mega_fwd, NTHREADS, LDS_BYTES) != hipSuccess || per_cu < 1) { fprintf(stderr, "kernel_launch: occupancy query says %d blocks per CU\n", per_cu); per_cu = 1; }
        (void)hipGetLastError();
        if (cus < 256) { fprintf(stderr, "kernel_launch: built for a 256-CU device, found %d CUs; nothing launched\n", cus); grid = -1; return; }
        grid = 256;
    }
    if (grid < 0) return;
    (void)hipMemsetAsync((char*)d_ws + WS_CTL, 0, CTL_ZERO_BYTES, stream);
    Args a{};
    for (int i = 0; i < 21; ++i) a.in[i] = (const float*)d_in[i];
    a.out = (float*)d_out; a.ws = (unsigned char*)d_ws; a.ph_lo = 0; a.ph_hi = N_PHASES;
    hipLaunchKernelGGL(mega_fwd, dim3(grid), dim3(NTHREADS), LDS_BYTES, stream, a);
}
```

```cpp
#include <hip/hip_runtime.h>
#include <hip/hip_bf16.h>
#include <cstdio>
#include <cstdint>

#ifndef REPEAT_MASK
#define REPEAT_MASK 0
#endif
#ifndef PROBE_PHASE
#define PROBE_PHASE -1
#endif
#define GAS __attribute__((address_space(1)))
#define LAS __attribute__((address_space(3)))
typedef unsigned short bf16_t;
typedef short bf16x8 __attribute__((ext_vector_type(8)));
typedef float f32x4 __attribute__((ext_vector_type(4)));
typedef unsigned u32x4 __attribute__((ext_vector_type(4)));
typedef unsigned u32x2 __attribute__((ext_vector_type(2)));

constexpr int T = 32768, D = 1024, NB = 8, S = 4096, NH = 8, DH = 64, NIN = 5120, NE = 32, DE = 512, NMOD = 6144;
constexpr int NTHREADS = 512, NWAVES = 8;
constexpr float EPS = 1e-6f;
constexpr float C2 = 0.125f * 1.4426950408889634f;
constexpr int MAX_MT = 288;
constexpr int NPAD = MAX_MT * 256;

constexpr size_t MiB = 1u << 20, KiB = 1024;
constexpr size_t WS_CTL = 0, CTL_ZERO_BYTES = 64 * KiB;
constexpr size_t WS_MOD = 1 * MiB;
constexpr size_t WS_ROPE = 1 * MiB + 256 * KiB;
constexpr size_t WS_KMEAN = 1 * MiB + 512 * KiB;
constexpr size_t WS_EID = 2 * MiB;
constexpr size_t WS_EW = 2 * MiB + 256 * KiB;
constexpr size_t WS_BCNT = 2 * MiB + 512 * KiB;
constexpr size_t WS_TILEE = 2 * MiB + 768 * KiB;
constexpr size_t WS_ATOK = 3 * MiB;
constexpr size_t WS_AINFO = 3 * MiB + 512 * KiB;
constexpr size_t WS_AW = 4 * MiB;
constexpr size_t WS_W36T = 5 * MiB;
constexpr size_t WS_WIN_T = 8 * MiB;
constexpr size_t WS_WIN8 = 14 * MiB;
constexpr size_t WS_H8 = 56 * MiB;
constexpr size_t WS_WP_T = 18 * MiB;
constexpr size_t WS_WO_T = 20 * MiB;
constexpr size_t WS_W13_T = 24 * MiB;
constexpr size_t WS_W2_T = 88 * MiB;
constexpr size_t WS_H = 120 * MiB;
constexpr size_t WS_YAB = 184 * MiB;
constexpr size_t WS_K = 248 * MiB;
constexpr size_t WS_V = 280 * MiB;
constexpr size_t WS_U = 312 * MiB;
constexpr size_t WS_BG = 344 * MiB;
constexpr size_t WS_GATES = 376 * MiB;
constexpr size_t WS_X1 = 184 * MiB;
constexpr size_t WS_H2 = 120 * MiB;
constexpr size_t WS_HID = 248 * MiB;
constexpr size_t WS_YSLOT = 320 * MiB;
constexpr size_t WS_LINFO = 448 * MiB;
constexpr size_t WS_LW = 456 * MiB;
constexpr size_t WS_END = 504 * MiB;
constexpr int CW_BAR = 4096, CW_MODCNT = 8192, CW_GCNT = 12288;

constexpr int LDS_BYTES = 159744;
constexpr int MISC_OFF = 147456;

__device__ __forceinline__ unsigned f2bf(float f) { unsigned u = __builtin_bit_cast(unsigned, f); return (u + 0x7fffu + ((u >> 16) & 1u)) >> 16; }
__device__ __forceinline__ float bf2f(unsigned h) { return __builtin_bit_cast(float, h << 16); }
__device__ __forceinline__ unsigned pk2(float lo, float hi) { return f2bf(lo) | (f2bf(hi) << 16); }
__device__ __forceinline__ void unpack8(const u32x4 w, float (&v)[8]) {
    v[0] = bf2f(w.x & 0xffffu); v[1] = bf2f(w.x >> 16); v[2] = bf2f(w.y & 0xffffu); v[3] = bf2f(w.y >> 16);
    v[4] = bf2f(w.z & 0xffffu); v[5] = bf2f(w.z >> 16); v[6] = bf2f(w.w & 0xffffu); v[7] = bf2f(w.w >> 16);
}
__device__ __forceinline__ u32x4 pack8(const float (&v)[8]) { u32x4 w; w.x = pk2(v[0], v[1]); w.y = pk2(v[2], v[3]); w.z = pk2(v[4], v[5]); w.w = pk2(v[6], v[7]); return w; }
__device__ __forceinline__ u32x4 pack8v(const f32x4 a, const f32x4 b) { u32x4 w; w.x = pk2(a.x, a.y); w.y = pk2(a.z, a.w); w.z = pk2(b.x, b.y); w.w = pk2(b.z, b.w); return w; }
__device__ __forceinline__ void unpack8v(const u32x4 w, f32x4& a, f32x4& b) {
    a.x = bf2f(w.x & 0xffffu); a.y = bf2f(w.x >> 16); a.z = bf2f(w.y & 0xffffu); a.w = bf2f(w.y >> 16);
    b.x = bf2f(w.z & 0xffffu); b.y = bf2f(w.z >> 16); b.z = bf2f(w.w & 0xffffu); b.w = bf2f(w.w >> 16); }
#ifndef WT_STORES
#define WT_STORES 0
#endif
__device__ __forceinline__ void st16(void* p, const u32x4 v) {
#if WT_STORES
    asm volatile("global_store_dwordx4 %0, %1, off sc1\n\ts_nop 1" :: "v"(p), "v"(v) : "memory");
#else
    *(u32x4*)p = v;
#endif
}
typedef int i32x8 __attribute__((ext_vector_type(8)));
__device__ __forceinline__ u32x2 pack8_fp8(const f32x4 a, const f32x4 b) {
    int lo = 0, hi = 0;
    lo = __builtin_amdgcn_cvt_pk_fp8_f32(a.x, a.y, lo, false); lo = __builtin_amdgcn_cvt_pk_fp8_f32(a.z, a.w, lo, true);
    hi = __builtin_amdgcn_cvt_pk_fp8_f32(b.x, b.y, hi, false); hi = __builtin_amdgcn_cvt_pk_fp8_f32(b.z, b.w, hi, true);
    return (u32x2){(unsigned)lo, (unsigned)hi};
}
constexpr float W8_SCALE = 64.f;
#define LDS_WAIT() asm volatile("s_waitcnt lgkmcnt(0)" ::: "memory")
__device__ __forceinline__ int lds_add(LAS int* p, int v) { return __hip_atomic_fetch_add(p, v, __ATOMIC_RELAXED, __HIP_MEMORY_SCOPE_WORKGROUP); }

#define XB_TMO      128
#define XB_XCNT(j)  (256  + 64 * (j))
#define XB_XSUB(j)  (1280 + 64 * (j))
#define XB_XGEN(j)  (2304 + 64 * (j))
#define XB_TOP      3328
#define XB_TOPGEN   3392
#define XCD_BAR_WORDS 3456
#define XB_SPIN_CAP (1u << 22)
__device__ __forceinline__ unsigned xb_ld(unsigned* p)              { return __hip_atomic_load(p, __ATOMIC_RELAXED, __HIP_MEMORY_SCOPE_AGENT); }
__device__ __forceinline__ unsigned xb_add(unsigned* p, unsigned v) { return __hip_atomic_fetch_add(p, v, __ATOMIC_RELAXED, __HIP_MEMORY_SCOPE_AGENT); }
__device__ __forceinline__ unsigned xb_xcc_id() { return (unsigned)__builtin_amdgcn_s_getreg((3 << 11) | 20) & 0xFu; }
#define XB_SPIN(cond, bar) do { unsigned _sp = 0; while (cond) { __builtin_amdgcn_s_sleep(1); \
    if ((++_sp & 255u) == 0u) { if (xb_ld(&(bar)[XB_TMO])) break; if (_sp > XB_SPIN_CAP) { atomicAdd(&(bar)[XB_TMO], 1u); break; } } } } while (0)
struct XcdBarrier { unsigned* bar; unsigned x; volatile LAS unsigned* st; };
__device__ __forceinline__ XcdBarrier xcd_barrier_post(unsigned* bar, volatile LAS unsigned* st) {
    XcdBarrier b; b.bar = bar; b.x = xb_xcc_id(); b.st = st;
    if (threadIdx.x == 0) (void)xb_add(&bar[XB_XCNT(b.x)], 1u);
    return b;
}
__device__ __forceinline__ void xcd_barrier_complete(unsigned* bar, unsigned x, unsigned& nloc, unsigned& nx) {
    const unsigned G = gridDim.x * gridDim.y * gridDim.z;
    unsigned sum, cnt, mine, sp = 0u;
    for (;;) {
        sum = 0u; cnt = 0u; mine = 0u;
#pragma unroll
        for (unsigned j = 0; j < 16; ++j) { const unsigned c = xb_ld(&bar[XB_XCNT(j)]); sum += c; cnt += (c > 0u) ? 1u : 0u; mine = (j == x) ? c : mine; }
        if (sum == G) break;
        __builtin_amdgcn_s_sleep(1);
        if ((++sp & 255u) == 0u) { if (xb_ld(&bar[XB_TMO])) break; if (sp > XB_SPIN_CAP) { atomicAdd(&bar[XB_TMO], 1u); break; } }
    }
    nloc = mine > 0u ? mine : 1u; nx = cnt > 0u ? cnt : 1u;
}
__device__ __forceinline__ void xcd_barrier(const XcdBarrier& b) {
    asm volatile("s_waitcnt vmcnt(0)" ::: "memory");
    __syncthreads();
    if (threadIdx.x == 0) {
        unsigned* bar = b.bar;
        __builtin_amdgcn_s_waitcnt(0);
        unsigned nloc = b.st[0], nx = b.st[1];
        if (nloc == 0u) { xcd_barrier_complete(bar, b.x, nloc, nx); b.st[0] = nloc; b.st[1] = nx; }
        const unsigned old = xb_add(&bar[XB_XSUB(b.x)], 1u);
        const unsigned gen = old / nloc;
        if (old + 1u == (gen + 1u) * nloc) {
            __builtin_amdgcn_fence(__ATOMIC_RELEASE, "agent");
            asm volatile("s_waitcnt vmcnt(0)" ::: "memory");
            const unsigned og = xb_add(&bar[XB_TOP], 1u);
            const unsigned tg = og / nx;
            if (og + 1u == (tg + 1u) * nx) xb_add(&bar[XB_TOPGEN], 1u);
            else XB_SPIN(xb_ld(&bar[XB_TOPGEN]) == tg, bar);
            __builtin_amdgcn_fence(__ATOMIC_ACQUIRE, "agent");
            xb_add(&bar[XB_XGEN(b.x)], 1u);
            asm volatile("s_waitcnt vmcnt(0)" ::: "memory");
        } else {
            XB_SPIN(xb_ld(&bar[XB_XGEN(b.x)]) == gen, bar);
            __builtin_amdgcn_fence(__ATOMIC_ACQUIRE, "agent");
            asm volatile("s_waitcnt vmcnt(0)" ::: "memory");
        }
    }
    __syncthreads();
}

struct Frame {
    LAS unsigned char* lds;
    int tid, lane, wave, G;
    const float *x, *c, *w_ada, *b_ada, *g1, *g2, *w_in, *g_q, *g_k, *conv_w, *conv_b, *w_pa, *w_pb, *w_o, *w_rg, *b_rg, *w_re, *b_re, *w1, *w3, *w2;
    float* out; unsigned char* ws;
};
#define WSP(type, off) ((type*)(F.ws + (off)))

struct XItem { const float* src; unsigned char* dst; int N, pitch, fp8; };
__device__ __forceinline__ void xitem_load(const XItem& it, f32x4 (&v)[8], int lane) {
    const int r8 = lane >> 3, c4 = lane & 7;
#pragma unroll
    for (int i = 0; i < 8; ++i) v[i] = __builtin_nontemporal_load((const f32x4*)(it.src + (size_t)(8 * i + r8) * it.N + 4 * c4));
}
__device__ __forceinline__ void xitem_store(const XItem& it, const f32x4 (&v)[8], LAS float* scr, int lane) {
    const int r8 = lane >> 3, c4 = lane & 7; const float scale = it.fp8 ? W8_SCALE : 1.f;
#pragma unroll
    for (int i = 0; i < 8; ++i) { LAS float* p = scr + (8 * i + r8) * 33 + 4 * c4; p[0] = v[i].x * scale; p[1] = v[i].y * scale; p[2] = v[i].z * scale; p[3] = v[i].w * scale; }
    LDS_WAIT(); asm volatile("" ::: "memory");
    if (it.fp8) {
        const int n = lane >> 1, kh = lane & 1; const LAS float* sp = scr + (32 * kh) * 33 + n;
#pragma unroll
        for (int p = 0; p < 2; ++p) { u32x4 o;
#pragma unroll
            for (int w = 0; w < 4; ++w) { const LAS float* q = sp + (16 * p + 4 * w) * 33; int x = 0;
                x = __builtin_amdgcn_cvt_pk_fp8_f32(q[0], q[33], x, false); x = __builtin_amdgcn_cvt_pk_fp8_f32(q[66], q[99], x, true); o[w] = (unsigned)x; }
            *(u32x4*)(it.dst + (size_t)n * it.pitch + 32 * kh + 16 * p) = o; }
    } else {
        const int c = lane & 7;
#pragma unroll
        for (int j = 0; j < 4; ++j) { const int n = (lane >> 3) + 8 * j; const LAS float* q = scr + (8 * c) * 33 + n;
            u32x4 o; o.x = pk2(q[0 * 33], q[1 * 33]); o.y = pk2(q[2 * 33], q[3 * 33]); o.z = pk2(q[4 * 33], q[5 * 33]); o.w = pk2(q[6 * 33], q[7 * 33]);
            *(u32x4*)(it.dst + ((size_t)n * it.pitch + 8 * c) * 2) = o; }
    }
    LDS_WAIT(); asm volatile("" ::: "memory");
}
__device__ __forceinline__ int win_dest_row(int sc) {
    if (sc < 32) { const int isk = sc >> 4, s2 = sc & 15, hh = s2 >> 1, bj = s2 & 1; return 512 * isk + 256 * (hh >> 2) + 128 * bj + 32 * (hh & 3); }
    if (sc < 48) return 0;
    if (sc < 64) { const int cx = 32 * (sc - 48); return 256 * (4 + (cx >> 7)) + (cx & 127); }
    if (sc < 80) return 2048 + 32 * (sc - 64);
    if (sc < 96) { const int cx = 32 * (sc - 80); return 256 * (4 + (cx >> 7)) + 128 + (cx & 127); }
    return 3072 + 32 * (sc - 96);
}
constexpr int X_NONEXP = 16 * 160 + 2 * (8 * 32) + 16 * 32, X_W2 = X_NONEXP + NE * 512, X_END = X_W2 + NE * 256;
__device__ __forceinline__ void convert_items(Frame& F, const int item_lo, const int item_hi, const int gw, const int NGW) {
    LAS float* scr = (LAS float*)(F.lds + F.wave * 16384);
    constexpr int I_IN = 16 * 160, I_PA = 8 * 32, I_O = 16 * 32, I_E1 = 16 * 16, I_E2 = 8 * 32;
    constexpr int NITEMS = I_IN + 2 * I_PA + I_O + NE * (2 * I_E1 + I_E2);
    auto decode = [&](int r) -> XItem {
        XItem x;
        if (r < I_IN) { const int kb = r / 160, sc = r % 160; x.src = F.w_in + (size_t)(64 * kb) * NIN + 32 * sc; x.N = NIN; x.pitch = 1024;
            if (sc < 96 && !(sc >= 32 && sc < 48)) { x.fp8 = 0; x.dst = (unsigned char*)(WSP(bf16_t, WS_WIN_T) + (size_t)win_dest_row(sc) * 1024 + 64 * kb); }
            else { x.fp8 = 1; const int g = 32 * (sc - 96), cx = g & 1023;
                x.dst = WSP(unsigned char, WS_WIN8) + (size_t)(sc >= 96 ? 256 * (cx >> 7) + (g >= 1024 ? 128 : 0) + (cx & 127) : 2048 + 32 * (sc - 32)) * 1024 + 64 * kb; }
            return x; } r -= I_IN;
        if (r < I_PA) { const int kb = r / 32, sc = r % 32; x.src = F.w_pa + (size_t)(64 * kb) * 1024 + 32 * sc; x.N = 1024; x.pitch = 1024; x.fp8 = 0; x.dst = (unsigned char*)(WSP(bf16_t, WS_WP_T) + (size_t)(32 * sc) * 1024 + 64 * kb); return x; } r -= I_PA;
        if (r < I_PA) { const int kb = r / 32, sc = r % 32; x.src = F.w_pb + (size_t)(64 * kb) * 1024 + 32 * sc; x.N = 1024; x.pitch = 1024; x.fp8 = 0; x.dst = (unsigned char*)(WSP(bf16_t, WS_WP_T) + (size_t)(32 * sc) * 1024 + 512 + 64 * kb); return x; } r -= I_PA;
        if (r < I_O) { const int kb = r / 32, sc = r % 32; x.src = F.w_o + (size_t)(64 * kb) * 1024 + 32 * sc; x.N = 1024; x.pitch = 1024; x.fp8 = 0; x.dst = (unsigned char*)(WSP(bf16_t, WS_WO_T) + (size_t)(32 * sc) * 1024 + 64 * kb); return x; } r -= I_O;
        x.fp8 = 1;
        if (r < NE * 2 * I_E1) { const int e = r / (2 * I_E1); r -= e * (2 * I_E1); const int is3 = r >= I_E1; if (is3) r -= I_E1; const int kb = r / 16, sc = r % 16;
            x.src = (is3 ? F.w3 : F.w1) + (size_t)e * D * DE + (size_t)(64 * kb) * DE + 32 * sc; x.N = DE; x.pitch = 1024;
            x.dst = WSP(unsigned char, WS_W13_T) + ((size_t)e * 1024 + 256 * (sc >> 2) + 128 * is3 + 32 * (sc & 3)) * 1024 + 64 * kb; return x; }
        r -= NE * 2 * I_E1;
        { const int e = r / I_E2; r -= e * I_E2; const int kb = r / 32, sc = r % 32;
            x.src = F.w2 + (size_t)e * DE * D + (size_t)(64 * kb) * D + 32 * sc; x.N = D; x.pitch = 512; x.dst = WSP(unsigned char, WS_W2_T) + ((size_t)e * 1024 + 32 * sc) * 512 + 64 * kb; }
        return x;
    };
    const int ihi = (item_hi < NITEMS) ? item_hi : NITEMS;
    if (item_lo + gw < ihi) {
        XItem cur = decode(item_lo + gw); f32x4 va[8], vb[8]; xitem_load(cur, va, F.lane);
        for (int it = item_lo + gw; it < ihi; it += 2 * NGW) {
            const int n1 = it + NGW, n2 = it + 2 * NGW; XItem nx1 = cur, nx2 = cur;
            if (n1 < ihi) { nx1 = decode(n1); xitem_load(nx1, vb, F.lane); }
            xitem_store(cur, va, scr, F.lane);
            if (n1 < ihi) { if (n2 < ihi) { nx2 = decode(n2); xitem_load(nx2, va, F.lane); }
                xitem_store(nx1, vb, scr, F.lane); cur = nx2; }
        }
    }
}

__device__ __forceinline__ void s0_prologue(Frame& F) {
    if (F.tid < 256) WSP(float, WS_KMEAN)[blockIdx.x * 256 + F.tid] = 0.f;
    if (F.tid < 144) { const int gt = blockIdx.x * 144 + F.tid; const int jj = gt >> 10, k = gt & 1023; WSP(float, WS_W36T)[gt] = (jj < 4) ? F.w_rg[k * 4 + jj] : F.w_re[k * 32 + (jj - 4)]; }
    if (F.tid < 128) { const int gt = blockIdx.x * 128 + F.tid; const int pos = gt >> 3, i = gt & 7; const float inv = powf(500000.0f, -(float)(2 * i) / 16.0f); const float ang = (float)pos * inv;
        WSP(float2, WS_ROPE)[gt] = make_float2(cosf(ang), sinf(ang)); }
    {
        LAS float* sc = (LAS float*)F.lds;
        for (int i = F.tid; i < NB * D; i += NTHREADS) { const float v = F.c[i]; sc[i] = v / (1.f + expf(-v)); }
        __syncthreads();
        const int j0 = blockIdx.x * 24, cl = F.lane & 31, col = j0 + (cl < 24 ? cl : 0), kpar = F.lane >> 5;
        float acc[8];
#pragma unroll
        for (int b = 0; b < 8; ++b) acc[b] = 0.f;
#pragma unroll
        for (int i0 = 0; i0 < 64; i0 += 32) { float wv[32];
#pragma unroll
            for (int i = 0; i < 32; ++i) wv[i] = F.w_ada[(size_t)(F.wave * 128 + 2 * (i0 + i) + kpar) * NMOD + col];
#pragma unroll
            for (int i = 0; i < 32; ++i) { const int k = F.wave * 128 + 2 * (i0 + i) + kpar;
#pragma unroll
                for (int b = 0; b < 8; ++b) acc[b] += sc[b * D + k] * wv[i]; } }
#pragma unroll
        for (int b = 0; b < 8; ++b) acc[b] += __shfl_xor(acc[b], 32);
        LAS float* red = (LAS float*)(F.lds + 32768);
        if (F.lane < 32) {
#pragma unroll
            for (int b = 0; b < 8; ++b) red[(F.wave * 8 + b) * 32 + F.lane] = acc[b]; }
        __syncthreads();
        if (F.tid < 256 && (F.tid & 31) < 24) { const int b = F.tid >> 5, cc = F.tid & 31; float s = F.b_ada[j0 + cc];
#pragma unroll
            for (int w = 0; w < 8; ++w) s += red[(w * 8 + b) * 32 + cc];
            WSP(float, WS_MOD)[b * NMOD + j0 + cc] = s; }
        asm volatile("s_waitcnt vmcnt(0)" ::: "memory");
        __syncthreads();
        if (F.tid == 0) { __builtin_amdgcn_fence(__ATOMIC_RELEASE, "agent"); asm volatile("s_waitcnt vmcnt(0)" ::: "memory");
            __hip_atomic_fetch_add(WSP(unsigned, WS_CTL) + CW_MODCNT, 1u, __ATOMIC_RELAXED, __HIP_MEMORY_SCOPE_AGENT); }
    }
    convert_items(F, 0, X_NONEXP, blockIdx.x * NWAVES + F.wave, F.G * NWAVES);
}

__device__ __forceinline__ void wait_mod(Frame& F) {
    if (F.tid == 0) { unsigned* c = WSP(unsigned, WS_CTL) + CW_MODCNT; unsigned sp = 0;
        while (__hip_atomic_load(c, __ATOMIC_RELAXED, __HIP_MEMORY_SCOPE_AGENT) < 256u) { __builtin_amdgcn_s_sleep(2); if (++sp > (1u << 24)) break; }
        __builtin_amdgcn_fence(__ATOMIC_ACQUIRE, "agent"); asm volatile("s_waitcnt vmcnt(0)" ::: "memory"); }
    __syncthreads();
}
template <int N> __device__ __forceinline__ float dpp_ror(float v) { return __builtin_bit_cast(float, __builtin_amdgcn_update_dpp(0, __builtin_bit_cast(int, v), 0x120 + N, 0xF, 0xF, false)); }
__device__ __forceinline__ float wave_sum(float v) {
#pragma unroll
    for (int o = 1; o < 64; o <<= 1) v += __shfl_xor(v, o);
    return v;
}
__device__ __forceinline__ void s1_norm1(Frame& F) {
    const int gw = blockIdx.x * NWAVES + F.wave;
    const int row0 = gw * 16, b = row0 / S;
    if (row0 >= T) return;
    const float* mod = WSP(float, WS_MOD) + (size_t)b * NMOD;
    f32x4 gs[4], sh[4];
#pragma unroll
    for (int j = 0; j < 4; ++j) { const int col = 4 * F.lane + 256 * j; const f32x4 g = *(const f32x4*)(F.g1 + col), s_ = *(const f32x4*)(mod + 1024 + col); gs[j] = g * (s_ + 1.0f); sh[j] = *(const f32x4*)(mod + col); }
    for (int r = 0; r < 16; r += 4) {
        f32x4 v[4][4]; float ss[4];
#pragma unroll
        for (int q = 0; q < 4; ++q) { const float* xr = F.x + (size_t)(row0 + r + q) * D;
#pragma unroll
            for (int j = 0; j < 4; ++j) v[q][j] = __builtin_nontemporal_load((const f32x4*)(xr + 4 * F.lane + 256 * j)); }
#pragma unroll
        for (int q = 0; q < 4; ++q) { ss[q] = 0.f;
#pragma unroll
            for (int j = 0; j < 4; ++j) ss[q] += (v[q][j].x * v[q][j].x + v[q][j].y * v[q][j].y) + (v[q][j].z * v[q][j].z + v[q][j].w * v[q][j].w); }
#pragma unroll
        for (int q = 0; q < 4; ++q) { const float rinv = rsqrtf(wave_sum(ss[q]) * (1.f / D) + EPS);
            bf16_t* o = WSP(bf16_t, WS_H) + (size_t)(row0 + r + q) * D;
#pragma unroll
            for (int j = 0; j < 4; ++j) { const f32x4 h = v[q][j] * rinv * gs[j] + sh[j]; u32x2 w; w.x = pk2(h.x, h.y); w.y = pk2(h.z, h.w); *(u32x2*)(o + 4 * F.lane + 256 * j) = w;
                int p8 = 0; p8 = __builtin_amdgcn_cvt_pk_fp8_f32(h.x, h.y, p8, false); p8 = __builtin_amdgcn_cvt_pk_fp8_f32(h.z, h.w, p8, true);
                *(int*)(WSP(unsigned char, WS_H8) + (size_t)(row0 + r + q) * D + 4 * F.lane + 256 * j) = p8; } }
    }
}

struct RowsLinear { const bf16_t* base; size_t pitch; __device__ __forceinline__ const bf16_t* operator()(int r) const { return base + (size_t)r * pitch; } };
template <class AR, class BR>
__device__ __forceinline__ void sgemm_tile(LAS float* tile, int K, const AR& arow, const BR& brow, int wave, int lane) {
    const int fr = lane & 15, fq = lane >> 4, rb = 16 * (wave & 3), cb = 32 * (wave >> 2);
    const bf16_t* ap = arow(rb + fr) + 8 * fq;
    const bf16_t* bp0 = brow(cb + fr) + 8 * fq;
    const bf16_t* bp1 = brow(cb + 16 + fr) + 8 * fq;
    f32x4 acc0 = {0.f, 0.f, 0.f, 0.f}, acc1 = {0.f, 0.f, 0.f, 0.f};
#pragma unroll 4
    for (int k = 0; k < K; k += 32) {
        const bf16x8 a = *(const bf16x8*)(ap + k), b0 = *(const bf16x8*)(bp0 + k), b1 = *(const bf16x8*)(bp1 + k);
        acc0 = __builtin_amdgcn_mfma_f32_16x16x32_bf16(a, b0, acc0, 0, 0, 0);
        acc1 = __builtin_amdgcn_mfma_f32_16x16x32_bf16(a, b1, acc1, 0, 0, 0);
    }
#pragma unroll
    for (int j = 0; j < 4; ++j) { tile[(rb + fq * 4 + j) * 65 + cb + fr] = acc0[j]; tile[(rb + fq * 4 + j) * 65 + cb + 16 + fr] = acc1[j]; }
}

struct WinRowsHead { const bf16_t* base; int rb; __device__ __forceinline__ const bf16_t* operator()(int d) const { return base + (size_t)(rb + 128 * (d >> 5) + (d & 31)) * 1024; } };
__device__ __forceinline__ void s2_simple(Frame& F) {
    LAS float* tile = (LAS float*)F.lds; LAS float* tile2 = tile + 64 * 65;
    const bf16_t* H = WSP(bf16_t, WS_H); const bf16_t* WT = WSP(bf16_t, WS_WIN_T);
    const int row = F.tid >> 3, seg = F.tid & 7;
    for (int it = blockIdx.x; it < 512 * 72; it += F.G) {
        const int rt = it / 72, ct = it % 72, r0 = rt * 64, gr = r0 + row;
        const RowsLinear ar{H + (size_t)r0 * 1024, 1024};
        float v[8];
        if (ct < 16) {
            const int isk = ct >> 3, hh = ct & 7;
            const WinRowsHead br{WT, 512 * isk + 256 * (hh >> 2) + 32 * (hh & 3)};
            sgemm_tile(tile, 1024, ar, br, F.wave, F.lane); __syncthreads();
            float ss = 0.f;
#pragma unroll
            for (int e = 0; e < 8; ++e) { v[e] = tile[row * 65 + 8 * seg + e]; ss += v[e] * v[e]; }
            ss += __shfl_xor(ss, 1); ss += __shfl_xor(ss, 2); ss += __shfl_xor(ss, 4);
            const float rinv = rsqrtf(ss * (1.f / 64.f) + EPS);
            const float* g = isk ? F.g_k : F.g_q;
            const int pos = gr & (S - 1);
#pragma unroll
            for (int e = 0; e < 8; ++e) { v[e] = v[e] * rinv * g[8 * seg + e]; const float pv = __shfl_xor(v[e], 1);
                if (seg < 2) { const float2 cs = WSP(float2, WS_ROPE)[pos * 8 + e]; v[e] = (seg == 0) ? (v[e] * cs.x - pv * cs.y) : (v[e] * cs.x + pv * cs.y); } }
            if (!isk) {
#pragma unroll
                for (int e = 0; e < 8; ++e) v[e] *= C2;
                *(u32x4*)(WSP(bf16_t, WS_YAB) + (size_t)gr * 1024 + hh * 64 + 8 * seg) = pack8(v);
            } else {
                *(u32x4*)(WSP(bf16_t, WS_K) + (size_t)gr * 512 + hh * 64 + 8 * seg) = pack8(v);
#pragma unroll
                for (int e = 0; e < 8; ++e) tile[row * 65 + 8 * seg + e] = v[e];
                __syncthreads();
                if (F.tid < 64) { float s = 0.f; for (int r = 0; r < 64; ++r) s += tile[r * 65 + F.tid];
                    const int b = r0 / S, blk = (r0 & (S - 1)) >> 8;
                    atomicAdd(WSP(float, WS_KMEAN) + ((size_t)(b * NH + hh) * 16 + blk) * 64 + F.tid, s * (1.f / 256.f)); }
            }
        } else if (ct < 24) {
            const RowsLinear br{WT + (size_t)(1024 + 64 * (ct - 16)) * 1024, 1024};
            sgemm_tile(tile, 1024, ar, br, F.wave, F.lane); __syncthreads();
#pragma unroll
            for (int e = 0; e < 8; ++e) v[e] = tile[row * 65 + 8 * seg + e];
            *(u32x4*)(WSP(bf16_t, WS_V) + (size_t)gr * 512 + 64 * (ct - 16) + 8 * seg) = pack8(v);
        } else if (ct < 32) {
            const int cu = 64 * (ct - 24), rb = 256 * (6 + (cu >> 7)) + (cu & 127);
            const RowsLinear bx{WT + (size_t)rb * 1024, 1024}, bc{WT + (size_t)(rb + 128) * 1024, 1024};
            sgemm_tile(tile, 1024, ar, bx, F.wave, F.lane); sgemm_tile(tile2, 1024, ar, bc, F.wave, F.lane); __syncthreads();
#pragma unroll
            for (int e = 0; e < 8; ++e) v[e] = tile[row * 65 + 8 * seg + e] * tile2[row * 65 + 8 * seg + e];
            *(u32x4*)(WSP(bf16_t, WS_U) + (size_t)gr * 512 + cu + 8 * seg) = pack8(v);
        } else if (ct < 40) {
            const RowsLinear br{WT + (size_t)(2560 + 64 * (ct - 32)) * 1024, 1024};
            sgemm_tile(tile, 1024, ar, br, F.wave, F.lane); __syncthreads();
#pragma unroll
            for (int e = 0; e < 8; ++e) v[e] = tile[row * 65 + 8 * seg + e];
            *(u32x4*)(WSP(bf16_t, WS_BG) + (size_t)gr * 512 + 64 * (ct - 32) + 8 * seg) = pack8(v);
        } else {
            const RowsLinear br{WT + (size_t)(3072 + 64 * (ct - 40)) * 1024, 1024};
            sgemm_tile(tile, 1024, ar, br, F.wave, F.lane); __syncthreads();
#pragma unroll
            for (int e = 0; e < 8; ++e) v[e] = 1.f / (1.f + __expf(-tile[row * 65 + 8 * seg + e]));
            *(u32x4*)(WSP(bf16_t, WS_GATES) + (size_t)gr * 2048 + 64 * (ct - 40) + 8 * seg) = pack8(v);
        }
        __syncthreads();
    }
}

namespace pg8 {
constexpr int BM = 256, BK = 64, HALF = 128, HTB = HALF * BK * 2, STAGE_BYTES = 8 * HTB, NXCD = 8, WGM = 4;
constexpr int VN_STASH = 147456 + 4096;
__device__ __forceinline__ int lds_byte(int r, int c) { const int st = (r >> 4) * 2 + (c >> 5), rr = r & 15, cc = c & 31, ob = rr * 64 + cc * 2; return st * 1024 + (ob ^ (((ob >> 9) & 1) << 5)); }
__device__ __forceinline__ void stage_rc(int b, int& R, int& C) { const int st = b / 1024, sb = b % 1024, swz = sb ^ (((sb >> 9) & 1) << 5); R = (st >> 1) * 16 + swz / 64; C = (st & 1) * 32 + (swz % 64) / 2; }
__device__ __forceinline__ int perm32(int rho) { const int n = rho >> 4, i = rho & 15; return 8 * (i >> 2) + 4 * n + (i & 3); }
struct Unit { int pm, pn; const char* a; const char* b; int e, rbase; };
__device__ __forceinline__ bool static_unit(int i, int G, int c, int nM, int nN, int& pm, int& pn) {
    const int nwg = nM * nN; const long L = (long)i * G + c; if (L >= nwg) return false;
    int wgid = (int)L; { const int q = nwg / NXCD, r = nwg % NXCD, xcd = wgid % NXCD, off = wgid / NXCD; wgid = (xcd < r ? xcd * (q + 1) : r * (q + 1) + (xcd - r) * q) + off; }
    const int nig = WGM * nN, gid = wgid / nig, fm = gid * WGM, gsz = (nM - fm) < WGM ? (nM - fm) : WGM;
    pm = fm + ((wgid % nig) % gsz); pn = (wgid % nig) / gsz; return true;
}
struct DenseSched {
    static constexpr bool GATHER = false, FP8 = false;
    const char* A; const char* Bt; int nM, nN, K, G, c;
    __device__ __forceinline__ bool next(int i, Unit& u) const { if (!static_unit(i, G, c, nM, nN, u.pm, u.pn)) return false;
        u.a = A + (size_t)u.pm * BM * K * 2; u.b = Bt + (size_t)u.pn * BM * K * 2; u.e = 0; u.rbase = 0; return true; }
    __device__ __forceinline__ int row_index(const Unit&, int) const { return 0; }
};

struct DenseSched8 {
    static constexpr bool GATHER = false, FP8 = true;
    const char* A; const char* Bt; int nM, nN, K, G, c;
    __device__ __forceinline__ bool next(int i, Unit& u) const { if (!static_unit(i, G, c, nM, nN, u.pm, u.pn)) return false;
        u.a = A + (size_t)u.pm * BM * K; u.b = Bt + (size_t)u.pn * BM * K; u.e = 0; u.rbase = 0; return true; }
    __device__ __forceinline__ int row_index(const Unit&, int) const { return 0; }
};
template <class Epi, class Sched>
__device__ __forceinline__ void gemm_phase(LAS unsigned char* lds, const int K, const Sched& S, const Epi& E) {
    const int tid = threadIdx.x, wid = __builtin_amdgcn_readfirstlane(tid >> 6), lane = tid & 63, wr = wid >> 2, wc = wid & 3, fr = lane & 15, fq = lane >> 4;
    constexpr bool FP8 = Sched::FP8;
    const int nt = FP8 ? K / 128 : K / BK;
    const int PB = FP8 ? K : 2 * K;
    unsigned voffB[2], vA[2][2], vN[2][2];
#pragma unroll
    for (int i = 0; i < 2; ++i) { int R, C; stage_rc(tid * 16 + i * 8192, R, C); const int Rb = (R & ~31) + perm32(R & 31);
        voffB[i] = (unsigned)(Rb * PB + C * 2);
        vA[0][i] = (unsigned)(R * PB + C * 2); vA[1][i] = (unsigned)((HALF + R) * PB + C * 2); vN[0][i] = vA[0][i]; vN[1][i] = vA[1][i]; }
    const size_t kstep = (size_t)(BK * 2);
    const size_t hstep = (size_t)HALF * PB;
    const unsigned ldsw = (unsigned)wid * 1024u;
    const int aoff = lds_byte(wr * 64 + fr, fq * 8), boff = lds_byte(wc * 32 + fr, fq * 8);
    const int aoff8a = lds_byte(wr * 64 + fr, fq * 16), aoff8b = lds_byte(wr * 64 + fr, fq * 16 + 8), boff8a = lds_byte(wc * 32 + fr, fq * 16), boff8b = lds_byte(wc * 32 + fr, fq * 16 + 8);
#define PG8_SA(b, h) (((b) * 2 + (h)) * HTB)
#define PG8_SB(b, h) ((4 + (b) * 2 + (h)) * HTB)
#define PG8_STAGE(bufoff, gbase, voff) do { _Pragma("unroll") for (int _i = 0; _i < 2; ++_i) \
        __builtin_amdgcn_global_load_lds((const unsigned*)((const char*)(gbase) + (voff)[_i]), (LAS unsigned*)(lds + (bufoff) + ldsw + _i * 8192), 16, 0, 0); } while (0)
#define PG8_LD16(off) (*(const LAS u32x4*)(lds + (off)))
#define PG8_LDA(dst, b, h) do { _Pragma("unroll") for (int m = 0; m < 4; ++m) { if constexpr (FP8) { dst##8[m] = __builtin_bit_cast(i32x8, __builtin_shufflevector(PG8_LD16(PG8_SA(b, h) + aoff8a + m * 2048), PG8_LD16(PG8_SA(b, h) + aoff8b + m * 2048), 0, 1, 2, 3, 4, 5, 6, 7)); } \
        else { _Pragma("unroll") for (int k = 0; k < 2; ++k) dst[m][k] = *(const LAS bf16x8*)(lds + PG8_SA(b, h) + aoff + m * 2048 + k * 1024); } } } while (0)
#define PG8_LDB(dst, b, h) do { _Pragma("unroll") for (int n = 0; n < 2; ++n) { if constexpr (FP8) { dst##8[n] = __builtin_bit_cast(i32x8, __builtin_shufflevector(PG8_LD16(PG8_SB(b, h) + boff8a + n * 2048), PG8_LD16(PG8_SB(b, h) + boff8b + n * 2048), 0, 1, 2, 3, 4, 5, 6, 7)); } \
        else { _Pragma("unroll") for (int k = 0; k < 2; ++k) dst[n][k] = *(const LAS bf16x8*)(lds + PG8_SB(b, h) + boff + n * 2048 + k * 1024); } } } while (0)
#define PG8_MMA(ai, bj, At, Bt) do { __builtin_amdgcn_s_setprio(1); _Pragma("unroll") for (int m = 0; m < 4; ++m) _Pragma("unroll") for (int n = 0; n < 2; ++n) { \
        if constexpr (FP8) { asm volatile("s_nop 1\n\tv_mfma_scale_f32_16x16x128_f8f6f4 %0, %1, %2, %0, %3, %3 op_sel_hi:[0,0,0]" : "+v"(acc[ai][bj][m][n]) : "v"(Bt##8[n]), "v"(At##8[m]), "v"(sc127)); } \
        else { _Pragma("unroll") for (int k = 0; k < 2; ++k) acc[ai][bj][m][n] = __builtin_amdgcn_mfma_f32_16x16x32_bf16(Bt[n][k], At[m][k], acc[ai][bj][m][n], 0, 0, 0); } } __builtin_amdgcn_s_setprio(0); } while (0)
#define PG8_WAIT_V(n) asm volatile("s_waitcnt vmcnt(" #n ")" ::: "memory")
#define PG8_WAIT_L(n) asm volatile("s_waitcnt lgkmcnt(" #n ")" ::: "memory")
#define PG8_BAR __builtin_amdgcn_s_barrier()
#define PG8_SCHED __builtin_amdgcn_sched_barrier(0)
#define PG8_AOFF(dst, u) do { int _t = threadIdx.x; asm volatile("" : "+v"(_t)); _Pragma("unroll") for (int _i = 0; _i < 2; ++_i) { int _R, _C; stage_rc(_t * 16 + _i * 8192, _R, _C); \
        _Pragma("unroll") for (int _h = 0; _h < 2; ++_h) dst[_h][_i] = (unsigned)(S.row_index(u, _h * HALF + _R) * PB + _C * 2); } } while (0)
    Unit cur, nxt; int ui = 0;
    if (!S.next(0, cur)) return;
    if constexpr (Sched::GATHER) PG8_AOFF(vA, cur);
    f32x4 acc[2][2][4][2];
#pragma unroll
    for (int a = 0; a < 2; ++a)
#pragma unroll
        for (int b = 0; b < 2; ++b)
#pragma unroll
            for (int m = 0; m < 4; ++m)
#pragma unroll
                for (int n = 0; n < 2; ++n) acc[a][b][m][n] = (f32x4){0.f, 0.f, 0.f, 0.f};
    const int sc127 = 127;
    bf16x8 At[4][2], B0[2][2], B1[2][2]; i32x8 At8[4], B08[2], B18[2];
    const char* cA = cur.a; const char* cB = cur.b;
    PG8_STAGE(PG8_SB(0, 0), cB, voffB); PG8_STAGE(PG8_SB(0, 1), cB + hstep, voffB); PG8_STAGE(PG8_SA(0, 0), cA, vA[0]); PG8_STAGE(PG8_SA(0, 1), cA, vA[1]);
    if (wr == 1) PG8_BAR;
    PG8_WAIT_V(2); PG8_BAR;
    PG8_STAGE(PG8_SB(1, 0), cB + kstep, voffB); PG8_STAGE(PG8_SA(1, 0), cA + kstep, vA[0]); PG8_STAGE(PG8_SB(1, 1), cB + hstep + kstep, voffB);
    PG8_WAIT_V(6); PG8_BAR;
    for (;;) {
        const bool has_next = S.next(ui + 1, nxt);
        const char* nA = has_next ? nxt.a : cA; const char* nB = has_next ? nxt.b : cB;
        if constexpr (Sched::GATHER) { if (has_next) PG8_AOFF(vN, nxt); else {
#pragma unroll
            for (int h = 0; h < 2; ++h)
#pragma unroll
                for (int i = 0; i < 2; ++i) vN[h][i] = vA[h][i]; }
            *(LAS u32x4*)(lds + VN_STASH + tid * 16) = (u32x4){vN[0][0], vN[0][1], vN[1][0], vN[1][1]}; }
        for (int hk = 0; hk < (Epi::HAS_MID ? 2 : 1); ++hk) {
        if constexpr (Epi::HAS_MID) { if (hk == 1) E.mid(acc, cur, wr, wc, fr, fq); }
        const int tb = (Epi::HAS_MID && hk == 1) ? nt / 2 : 0, te = (Epi::HAS_MID && hk == 0) ? nt / 2 : nt;
#pragma unroll 1
        for (int t = tb; t < te; t += 2) {
            const bool last = (t == nt - 2);
            const char* a1 = cA + (size_t)(t + 1) * kstep;
            const char* a2 = last ? nA : cA + (size_t)(t + 2) * kstep; const char* b2 = last ? nB : cB + (size_t)(t + 2) * kstep;
            const char* a3 = a2 + kstep; const char* b3 = b2 + kstep;
            unsigned w0[2], w1[2];
#pragma unroll
            for (int i = 0; i < 2; ++i) { w0[i] = vA[0][i]; w1[i] = vA[1][i]; }
            if constexpr (Sched::GATHER) { if (last) { const u32x4 q = *(const LAS u32x4*)(lds + VN_STASH + tid * 16); w0[0] = q.x; w0[1] = q.y; w1[0] = q.z; w1[1] = q.w; } }
            PG8_LDB(B0, 0, 0); PG8_LDB(B1, 0, 1); PG8_SCHED; PG8_LDA(At, 0, 0); PG8_STAGE(PG8_SA(1, 1), a1, vA[1]);
            PG8_WAIT_V(8); PG8_WAIT_L(0); PG8_BAR; PG8_MMA(0, 0, At, B0); PG8_MMA(0, 1, At, B1); PG8_BAR; PG8_SCHED;
            PG8_LDA(At, 0, 1); PG8_STAGE(PG8_SB(0, 0), b2, voffB); PG8_STAGE(PG8_SB(0, 1), b2 + hstep, voffB); PG8_STAGE(PG8_SA(0, 0), a2, w0);
            PG8_WAIT_V(8); PG8_WAIT_L(0); PG8_BAR; PG8_MMA(1, 0, At, B0); PG8_MMA(1, 1, At, B1); PG8_BAR; PG8_SCHED;
            PG8_LDB(B0, 1, 0); PG8_LDB(B1, 1, 1); PG8_SCHED; PG8_LDA(At, 1, 0); PG8_STAGE(PG8_SA(0, 1), a2, w1);
            PG8_WAIT_V(8); PG8_WAIT_L(0); PG8_BAR; PG8_MMA(0, 0, At, B0); PG8_MMA(0, 1, At, B1); PG8_BAR; PG8_SCHED;
            PG8_LDA(At, 1, 1); PG8_STAGE(PG8_SB(1, 0), b3, voffB); PG8_STAGE(PG8_SB(1, 1), b3 + hstep, voffB); PG8_STAGE(PG8_SA(1, 0), a3, w0);
            PG8_WAIT_V(8); PG8_WAIT_L(0); PG8_BAR; PG8_MMA(1, 0, At, B0); PG8_MMA(1, 1, At, B1); PG8_BAR; PG8_SCHED;
        }
        }
        if (wr == 0) PG8_BAR;
        if constexpr (FP8) asm volatile("s_nop 15\n\ts_nop 7" ::: "memory");
        E(acc, cur, wr, wc, fr, fq);
        if (!has_next) break;
#pragma unroll
        for (int a = 0; a < 2; ++a)
#pragma unroll
            for (int b = 0; b < 2; ++b)
#pragma unroll
                for (int m = 0; m < 4; ++m)
#pragma unroll
                    for (int n = 0; n < 2; ++n) acc[a][b][m][n] = (f32x4){0.f, 0.f, 0.f, 0.f};
        cur = nxt; cA = nA; cB = nB; ++ui;
        if constexpr (Sched::GATHER) { const u32x4 q = *(const LAS u32x4*)(lds + VN_STASH + tid * 16); vA[0][0] = q.x; vA[0][1] = q.y; vA[1][0] = q.z; vA[1][1] = q.w; }
        if (wr == 1) PG8_BAR;
    }
    PG8_WAIT_V(0);
    PG8_BAR;
#undef PG8_SA
#undef PG8_SB
#undef PG8_STAGE
#undef PG8_LDA
#undef PG8_LDB
#undef PG8_MMA
#undef PG8_LD16
#undef PG8_WAIT_V
#undef PG8_WAIT_L
#undef PG8_BAR
#undef PG8_SCHED
#undef PG8_AOFF
}
}

typedef f32x4 Acc[2][2][4][2];
struct EpiG1 {
    static constexpr bool HAS_MID = false;
    unsigned char* ws; const float* g_q; const float* g_k;
    __device__ __forceinline__ void mid(Acc&, const pg8::Unit&, int, int, int, int) const {}
    __device__ __forceinline__ void operator()(Acc& acc, const pg8::Unit& u, int wr, int wc, int fr, int fq) const {
        const int pn = u.pn, row0 = u.pm * 256 + wr * 64 + fr;
        if (pn < 4) {
            const int isk = pn >> 1, hh = 4 * (pn & 1) + wc;
            const float* g = isk ? g_k : g_q;
            f32x4 gv[2][2];
#pragma unroll
            for (int bj = 0; bj < 2; ++bj)
#pragma unroll
                for (int n = 0; n < 2; ++n) gv[bj][n] = *(const f32x4*)(g + 32 * bj + 8 * fq + 4 * n);
            f32x4 cs_[2][2];
#pragma unroll
            for (int bj = 0; bj < 2; ++bj)
#pragma unroll
                for (int n = 0; n < 2; ++n) cs_[bj][n] = (f32x4){0.f, 0.f, 0.f, 0.f};
            const float2* rope = (const float2*)(ws + WS_ROPE);
            bf16_t* dst = isk ? (bf16_t*)(ws + WS_K) : (bf16_t*)(ws + WS_YAB);
            const int pitch = isk ? 512 : 1024;
#pragma unroll
            for (int ai = 0; ai < 2; ++ai)
#pragma unroll
                for (int m = 0; m < 4; ++m) {
                    const int r = row0 + 128 * ai + 16 * m, pos = r & (S - 1);
                    f32x4 v[2][2]; float ss = 0.f;
#pragma unroll
                    for (int bj = 0; bj < 2; ++bj)
#pragma unroll
                        for (int n = 0; n < 2; ++n) { v[bj][n] = acc[ai][bj][m][n]; ss += (v[bj][n].x * v[bj][n].x + v[bj][n].y * v[bj][n].y) + (v[bj][n].z * v[bj][n].z + v[bj][n].w * v[bj][n].w); }
                    ss += __shfl_xor(ss, 16); ss += __shfl_xor(ss, 32);
                    const float rinv = rsqrtf(ss * (1.f / 64.f) + EPS);
#pragma unroll
                    for (int bj = 0; bj < 2; ++bj)
#pragma unroll
                        for (int n = 0; n < 2; ++n) v[bj][n] = v[bj][n] * rinv * gv[bj][n];
#pragma unroll
                    for (int n = 0; n < 2; ++n)
#pragma unroll
                        for (int e = 0; e < 4; ++e) { const float pv = __shfl_xor(v[0][n][e], 16);
                            if (fq < 2) { const float2 cs = rope[pos * 8 + 4 * n + e]; v[0][n][e] = (fq == 0) ? (v[0][n][e] * cs.x - pv * cs.y) : (v[0][n][e] * cs.x + pv * cs.y); } }
                    if (isk) {
#pragma unroll
                        for (int bj = 0; bj < 2; ++bj)
#pragma unroll
                            for (int n = 0; n < 2; ++n) cs_[bj][n] += v[bj][n];
                    }
                    const float sc = isk ? 1.f : C2;
#pragma unroll
                    for (int bj = 0; bj < 2; ++bj) { u32x4 w; const f32x4 a = v[bj][0] * sc, b = v[bj][1] * sc;
                        w.x = pk2(a.x, a.y); w.y = pk2(a.z, a.w); w.z = pk2(b.x, b.y); w.w = pk2(b.z, b.w);
                        st16(dst + (size_t)r * pitch + hh * 64 + 32 * bj + 8 * fq, w); }
                }
            if (isk) {
                const int b = u.pm >> 4, blk = u.pm & 15;
                float* km = (float*)(ws + WS_KMEAN) + ((size_t)(b * NH + hh) * 16 + blk) * 64;
#pragma unroll
                for (int bj = 0; bj < 2; ++bj)
#pragma unroll
                    for (int n = 0; n < 2; ++n)
#pragma unroll
                        for (int e = 0; e < 4; ++e) { float s = cs_[bj][n][e]; s += __shfl_xor(s, 1); s += __shfl_xor(s, 2); s += __shfl_xor(s, 4); s += __shfl_xor(s, 8);
                            if (fr == 0) atomicAdd(km + 32 * bj + 8 * fq + 4 * n + e, s * (1.f / 256.f)); }
            }
        } else if (pn < 8) {
            bf16_t* dst = (bf16_t*)(ws + WS_U);
#pragma unroll
            for (int ai = 0; ai < 2; ++ai)
#pragma unroll
                for (int m = 0; m < 4; ++m) { const int r = row0 + 128 * ai + 16 * m;
                    const f32x4 a = acc[ai][0][m][0] * acc[ai][1][m][0], b = acc[ai][0][m][1] * acc[ai][1][m][1]; u32x4 w;
                    w.x = pk2(a.x, a.y); w.y = pk2(a.z, a.w); w.z = pk2(b.x, b.y); w.w = pk2(b.z, b.w);
                    st16(dst + (size_t)r * 512 + 128 * (pn - 4) + 32 * wc + 8 * fq, w); }
        } else {
            bf16_t* dst = (bf16_t*)(ws + WS_BG); const int pitch = 512, c0 = 256 * (pn - 8); const bool sig = false;
#pragma unroll
            for (int ai = 0; ai < 2; ++ai)
#pragma unroll
                for (int m = 0; m < 4; ++m) { const int r = row0 + 128 * ai + 16 * m;
#pragma unroll
                    for (int bj = 0; bj < 2; ++bj) { f32x4 a = acc[ai][bj][m][0], b = acc[ai][bj][m][1];
                        if (sig) {
#pragma unroll
                            for (int e = 0; e < 4; ++e) { a[e] = __builtin_amdgcn_rcpf(1.f + __expf(-a[e])); b[e] = __builtin_amdgcn_rcpf(1.f + __expf(-b[e])); } }
                        u32x4 w; w.x = pk2(a.x, a.y); w.y = pk2(a.z, a.w); w.z = pk2(b.x, b.y); w.w = pk2(b.z, b.w);
                        st16(dst + (size_t)r * pitch + c0 + 128 * bj + 32 * wc + 8 * fq, w); } }
        }
    }
};
struct EpiGate {
    static constexpr bool HAS_MID = false;
    bf16_t* gates; bf16_t* vout;
    __device__ __forceinline__ void mid(Acc&, const pg8::Unit&, int, int, int, int) const {}
    __device__ __forceinline__ void operator()(Acc& acc, const pg8::Unit& u, int wr, int wc, int fr, int fq) const {
        int row0 = u.pm * 256 + wr * 64 + fr; const int c0 = u.pn * 256 + 32 * wc + 8 * fq; asm volatile("" : "+v"(row0));
#pragma unroll
        for (int ai = 0; ai < 2; ++ai)
#pragma unroll
            for (int m = 0; m < 4; ++m) { const size_t r = (size_t)(row0 + 128 * ai + 16 * m);
                if (u.pn < 8) {
                    f32x4 ra[2], gb[2];
#pragma unroll
                    for (int n = 0; n < 2; ++n)
#pragma unroll
                        for (int e = 0; e < 4; ++e) { const float ea = __expf(acc[ai][0][m][n][e] * (-1.f / W8_SCALE)), eb = __expf(acc[ai][1][m][n][e] * (-1.f / W8_SCALE));
                            gb[n][e] = __builtin_amdgcn_rcpf(1.f + eb); ra[n][e] = fminf((1.f + eb) * __builtin_amdgcn_rcpf(1.f + ea), 3e4f); }
                    const size_t gc = r * 2048 + 128 * u.pn + 32 * wc + 8 * fq;
                    st16(gates + gc, pack8v(ra[0], ra[1])); st16(gates + gc + 1024, pack8v(gb[0], gb[1]));
                } else {
#pragma unroll
                    for (int bj = 0; bj < 2; ++bj) st16(vout + r * 512 + (c0 - 2048) + 128 * bj, pack8v(acc[ai][bj][m][0] * (1.f / W8_SCALE), acc[ai][bj][m][1] * (1.f / W8_SCALE))); } }
    }
};
__device__ __forceinline__ void s2_fast(Frame& F) {
    {
        const pg8::DenseSched Sd{(const char*)(F.ws + WS_H), (const char*)(F.ws + WS_WIN_T), T / 256, 10, 1024, F.G, (int)blockIdx.x};
        const EpiG1 E{F.ws, F.g_q, F.g_k};
        pg8::gemm_phase<EpiG1, pg8::DenseSched>(F.lds, 1024, Sd, E); }
    {
        const pg8::DenseSched8 Sd{(const char*)(F.ws + WS_H8), (const char*)(F.ws + WS_WIN8), T / 256, 10, 1024, F.G, (int)blockIdx.x};
        const EpiGate E{WSP(bf16_t, WS_GATES), WSP(bf16_t, WS_V)};
        int Kg = D; asm volatile("" : "+s"(Kg));
        pg8::gemm_phase<EpiGate, pg8::DenseSched8>(F.lds, Kg, Sd, E); }
}

constexpr float NEG_BIG = -1e30f;
__device__ __forceinline__ void s3_simple(Frame& F) {
    LAS float* tS = (LAS float*)F.lds;
    LAS bf16_t* Pb = (LAS bf16_t*)(F.lds + 16896);
    LAS bf16_t* Vt = (LAS bf16_t*)(F.lds + 16896 + 9216);
    LAS float* mrow = (LAS float*)(F.lds + 16896 + 18432);
    LAS float* lrow = mrow + 64; LAS float* arow_ = mrow + 128; LAS int* sel = (LAS int*)(mrow + 192); LAS int* um = sel + 64;
    bf16_t* YAB = WSP(bf16_t, WS_YAB); const bf16_t* Kb = WSP(bf16_t, WS_K); const bf16_t* Vb = WSP(bf16_t, WS_V);
    const float* kmean = WSP(float, WS_KMEAN);
    const int row = F.tid >> 3, seg = F.tid & 7, fr = F.lane & 15, fq = F.lane >> 4, rb = 16 * (F.wave & 3), cb = 32 * (F.wave >> 2);
    for (int it = blockIdx.x; it < NB * NH * 64; it += F.G) {
        const int qc = it & 63, h = (it >> 6) & 7, b = it >> 9, cur = qc >> 2, t0 = 64 * qc;
        const size_t tb = (size_t)b * S;
        if (F.tid < 64) {
            float q[64];
            const bf16_t* qp = YAB + (tb + t0 + F.tid) * 1024 + h * 64;
#pragma unroll
            for (int i = 0; i < 8; ++i) { float t8[8]; unpack8(*(const u32x4*)(qp + 8 * i), t8);
#pragma unroll
                for (int e = 0; e < 8; ++e) q[8 * i + e] = t8[e]; }
            float b0 = -INFINITY, b1 = -INFINITY, b2 = -INFINITY; int i0 = -1, i1 = -1, i2 = -1;
            for (int j = 0; j < cur; ++j) { const float* km = kmean + ((size_t)(b * NH + h) * 16 + j) * 64; float s = 0.f;
#pragma unroll
                for (int d = 0; d < 64; ++d) s += q[d] * km[d];
                if (s > b0) { b2 = b1; i2 = i1; b1 = b0; i1 = i0; b0 = s; i0 = j; } else if (s > b1) { b2 = b1; i2 = i1; b1 = s; i1 = j; } else if (s > b2) { b2 = s; i2 = j; } }
            int m = 0; if (i0 >= 0) m |= 1 << i0; if (i1 >= 0) m |= 1 << i1; if (i2 >= 0) m |= 1 << i2;
            sel[F.tid] = m; mrow[F.tid] = NEG_BIG; lrow[F.tid] = 0.f;
            int u = m;
#pragma unroll
            for (int o = 1; o < 64; o <<= 1) u |= __shfl_xor(u, o);
            if (F.tid == 0) um[0] = u;
        }
        __syncthreads();
        const int umask = um[0];
        f32x4 o0 = {0.f, 0.f, 0.f, 0.f}, o1 = {0.f, 0.f, 0.f, 0.f};
        const RowsLinear aq{YAB + (tb + t0) * 1024 + h * 64, 1024};
        for (int j = 0; j <= cur; ++j) {
            if (j < cur && !((umask >> j) & 1)) continue;
            const int nkt = (j == cur) ? ((qc & 3) + 1) : 4;
            for (int kt = 0; kt < nkt; ++kt) {
                const int kbase = 256 * j + 64 * kt;
                const RowsLinear bk{Kb + (tb + kbase) * 512 + h * 64, 512};
                sgemm_tile(tS, 64, aq, bk, F.wave, F.lane);
                { float vv[8]; unpack8(*(const u32x4*)(Vb + (tb + kbase + row) * 512 + h * 64 + 8 * seg), vv);
#pragma unroll
                    for (int e = 0; e < 8; ++e) Vt[(8 * seg + e) * 72 + row] = (bf16_t)f2bf(vv[e]); }
                __syncthreads();
                {
                    float s[8]; float mx = NEG_BIG;
                    const bool rowsel = (j == cur) || ((sel[row] >> j) & 1);
#pragma unroll
                    for (int e = 0; e < 8; ++e) { const int c = 8 * seg + e; float x = tS[row * 65 + c];
                        if (!rowsel || (j == cur && kbase + c > t0 + row)) x = NEG_BIG; s[e] = x; mx = fmaxf(mx, x); }
                    mx = fmaxf(mx, __shfl_xor(mx, 1)); mx = fmaxf(mx, __shfl_xor(mx, 2)); mx = fmaxf(mx, __shfl_xor(mx, 4));
                    const float mold = mrow[row], mnew = fmaxf(mold, mx);
                    float alpha = 1.f, ps = 0.f; float p[8];
                    if (mnew <= NEG_BIG) {
#pragma unroll
                        for (int e = 0; e < 8; ++e) p[e] = 0.f;
                    } else { alpha = exp2f(mold - mnew);
#pragma unroll
                        for (int e = 0; e < 8; ++e) { p[e] = (s[e] <= NEG_BIG) ? 0.f : exp2f(s[e] - mnew); ps += p[e]; } }
                    ps += __shfl_xor(ps, 1); ps += __shfl_xor(ps, 2); ps += __shfl_xor(ps, 4);
                    const float lold = lrow[row];
                    *(LAS u32x4*)(Pb + row * 72 + 8 * seg) = pack8(p);
                    if (seg == 0) { mrow[row] = mnew; lrow[row] = lold * alpha + ps; arow_[row] = alpha; }
                }
                __syncthreads();
                {
#pragma unroll
                    for (int r = 0; r < 4; ++r) { const float a = arow_[rb + fq * 4 + r]; o0[r] *= a; o1[r] *= a; }
#pragma unroll
                    for (int ks = 0; ks < 2; ++ks) {
                        const bf16x8 a = *(const LAS bf16x8*)(Pb + (rb + fr) * 72 + 32 * ks + 8 * fq);
                        const bf16x8 v0 = *(const LAS bf16x8*)(Vt + (cb + fr) * 72 + 32 * ks + 8 * fq);
                        const bf16x8 v1 = *(const LAS bf16x8*)(Vt + (cb + 16 + fr) * 72 + 32 * ks + 8 * fq);
                        o0 = __builtin_amdgcn_mfma_f32_16x16x32_bf16(a, v0, o0, 0, 0, 0);
                        o1 = __builtin_amdgcn_mfma_f32_16x16x32_bf16(a, v1, o1, 0, 0, 0);
                    }
                }
                __syncthreads();
            }
        }
#pragma unroll
        for (int r = 0; r < 4; ++r) { const float li = 1.f / lrow[rb + fq * 4 + r]; tS[(rb + fq * 4 + r) * 65 + cb + fr] = o0[r] * li; tS[(rb + fq * 4 + r) * 65 + cb + 16 + fr] = o1[r] * li; }
        __syncthreads();
        { float v[8];
#pragma unroll
            for (int e = 0; e < 8; ++e) v[e] = tS[row * 65 + 8 * seg + e];
            *(u32x4*)(YAB + (tb + t0 + row) * 1024 + h * 64 + 8 * seg) = pack8(v); }
        __syncthreads();
    }
    const bf16_t* U = WSP(bf16_t, WS_U); const bf16_t* BG = WSP(bf16_t, WS_BG);
    for (int i = blockIdx.x * NTHREADS + F.tid; i < T * 64; i += F.G * NTHREADS) {
        const int t = i >> 6, c0 = (i & 63) * 8, pos = t & (S - 1);
        float u0[8], u1[8], u2[8], bg[8], y[8];
        unpack8(*(const u32x4*)(U + (size_t)t * 512 + c0), u2); unpack8(*(const u32x4*)(BG + (size_t)t * 512 + c0), bg);
        if (pos >= 1) unpack8(*(const u32x4*)(U + (size_t)(t - 1) * 512 + c0), u1); else {
#pragma unroll
            for (int e = 0; e < 8; ++e) u1[e] = 0.f; }
        if (pos >= 2) unpack8(*(const u32x4*)(U + (size_t)(t - 2) * 512 + c0), u0); else {
#pragma unroll
            for (int e = 0; e < 8; ++e) u0[e] = 0.f; }
#pragma unroll
        for (int e = 0; e < 8; ++e) y[e] = bg[e] * (F.conv_w[c0 + e] * u0[e] + F.conv_w[512 + c0 + e] * u1[e] + F.conv_w[1024 + c0 + e] * u2[e] + F.conv_b[c0 + e]);
        *(u32x4*)(YAB + (size_t)t * 1024 + 512 + c0) = pack8(y);
    }
}

namespace attn_body {
using bf16x8 = __attribute__((ext_vector_type(8))) short;
using s16x4 = __attribute__((ext_vector_type(4))) short;
using f32x16 = __attribute__((ext_vector_type(16))) float;
using u32x4 = __attribute__((ext_vector_type(4))) unsigned;
constexpr int SEQ = 4096, D = 64, DMQ = 1024, DMK = 512;
constexpr int NW = 8, QBLK = 32, QB = QBLK * NW, KVBLK = 64;
constexpr float NEGB = -1e30f;
__device__ __forceinline__ int crow(int r, int hi) { return (r & 3) + 8 * (r >> 2) + 4 * hi; }
#define SBAR() __builtin_amdgcn_sched_barrier(0)
__device__ __forceinline__ void cmask(f32x16& p0, f32x16& p1, int jb, int qrel, int hi) {
  const float NEG = -INFINITY; int kb = 64 * jb + 4 * hi;
  #pragma unroll
  for (int r = 0; r < 16; ++r) { int kv = kb + (r & 3) + 8 * (r >> 2); if (kv > qrel) p0[r] = NEG; if (kv + 32 > qrel) p1[r] = NEG; }
}
constexpr int NSLOT = 3, SLOTB = 8192;
constexpr int LDS_K = 0, LDS_V = NSLOT * SLOTB, LDS_WS = 2 * NSLOT * SLOTB, LDS_OST = LDS_WS + NW * 128 * 4, LDS_BYTES_A = LDS_OST + NW * 4096;
__device__ __forceinline__ void glds16(const void* gsrc, unsigned lds_dst) { unsigned keep;
  asm volatile("s_mov_b32 %0, m0\n\ts_mov_b32 m0, %2\n\ts_nop 0\n\tglobal_load_lds_dwordx4 %1, off\n\ts_mov_b32 m0, %0" : "=&s"(keep) : "v"(gsrc), "s"(lds_dst) : "memory"); }
__device__ __forceinline__ float max3f(float a, float b, float c) { float r; asm("v_max3_f32 %0, %1, %2, %3" : "=v"(r) : "v"(a), "v"(b), "v"(c)); return r; }
__device__ __forceinline__ float max2f(float a, float b) { float r; asm("v_max_f32_e32 %0, %1, %2" : "=v"(r) : "v"(a), "v"(b)); return r; }
__device__ __forceinline__ float fadd_s(float a, float b) { float r; asm("v_add_f32_e32 %0, %1, %2" : "=v"(r) : "v"(a), "v"(b)); return r; }
__device__ __forceinline__ float fsub_s(float a, float b) { float r; asm("v_sub_f32_e32 %0, %1, %2" : "=v"(r) : "v"(a), "v"(b)); return r; }
typedef float f32x2_t __attribute__((ext_vector_type(2))); typedef __bf16 bf16x2_t __attribute__((ext_vector_type(2)));
__device__ __forceinline__ unsigned cvtpk_s(float lo, float hi) { f32x2_t v = {lo, hi}; bf16x2_t b = __builtin_convertvector(v, bf16x2_t); return __builtin_bit_cast(unsigned, b); }
#define WAIT_BAR(N) asm volatile("s_waitcnt vmcnt(" #N ") lgkmcnt(0)\n\ts_barrier" ::: "memory")
__device__ __forceinline__ void qkt(f32x16& p0, f32x16& p1, const char* Kslot, const bf16x8* qr, const f32x16& negm, int r32, int hi) {
  const char* kb = Kslot + hi * 1024 + r32 * 16;
  #pragma unroll
  for (int d0 = 0; d0 < 4; ++d0) {
    const bf16x8 b0 = *reinterpret_cast<const bf16x8*>(kb + d0 * 2048);
    const bf16x8 b1 = *reinterpret_cast<const bf16x8*>(kb + d0 * 2048 + 512);
    if (d0 == 0) { p0 = __builtin_amdgcn_mfma_f32_32x32x16_bf16(b0, qr[0], negm, 0, 0, 0); p1 = __builtin_amdgcn_mfma_f32_32x32x16_bf16(b1, qr[0], negm, 0, 0, 0); }
    else { p0 = __builtin_amdgcn_mfma_f32_32x32x16_bf16(b0, qr[d0], p0, 0, 0, 0); p1 = __builtin_amdgcn_mfma_f32_32x32x16_bf16(b1, qr[d0], p1, 0, 0, 0); } }
}
typedef __attribute__((address_space(3))) const char* lds_cptr;
typedef __attribute__((address_space(3))) char* lds_ptr;
typedef short v4i16_t __attribute__((ext_vector_type(4)));
__device__ __forceinline__ void kload8(bf16x8* kf, lds_cptr kp) {
  kf[0] = *(const __attribute__((address_space(3))) bf16x8*)(kp);        kf[1] = *(const __attribute__((address_space(3))) bf16x8*)(kp + 512);
  kf[2] = *(const __attribute__((address_space(3))) bf16x8*)(kp + 2048); kf[3] = *(const __attribute__((address_space(3))) bf16x8*)(kp + 2560);
  kf[4] = *(const __attribute__((address_space(3))) bf16x8*)(kp + 4096); kf[5] = *(const __attribute__((address_space(3))) bf16x8*)(kp + 4608);
  kf[6] = *(const __attribute__((address_space(3))) bf16x8*)(kp + 6144); kf[7] = *(const __attribute__((address_space(3))) bf16x8*)(kp + 6656);
}
__device__ __forceinline__ void kload2(bf16x8* kf, lds_cptr kp, int j) { kf[2 * j] = *(const __attribute__((address_space(3))) bf16x8*)(kp + j * 2048); kf[2 * j + 1] = *(const __attribute__((address_space(3))) bf16x8*)(kp + j * 2048 + 512); }
__device__ __forceinline__ s16x4 vtr(lds_cptr p) { return __builtin_bit_cast(s16x4, __builtin_amdgcn_ds_read_tr16_b64_v4i16((__attribute__((address_space(3))) v4i16_t*)p)); }
__device__ __forceinline__ float rowmax(const f32x16& p0, const f32x16& p1) {
  float a = max3f(p0[0], p0[1], p1[0]), b = max3f(p0[2], p0[3], p1[1]); a = max3f(a, p1[2], p1[3]);
  #pragma unroll
  for (int r = 4; r < 16; r += 4) { a = max3f(a, p0[r], p0[r + 1]); b = max3f(b, p0[r + 2], p0[r + 3]); a = max3f(a, p1[r], p1[r + 1]); b = max3f(b, p1[r + 2], p1[r + 3]); }
  const float m = max2f(a, b);
  auto rr = __builtin_amdgcn_permlane32_swap(__float_as_uint(m), __float_as_uint(m), false, false);
  return max2f(__uint_as_float(rr[0]), __uint_as_float(rr[1]));
}
__device__ __forceinline__ void pv(f32x16* o, int vb, bf16x8 pa0, bf16x8 pa1, bf16x8 pa2, bf16x8 pa3) {
  #pragma unroll
  for (int d0 = 0; d0 < 2; ++d0) { s16x4 lo[4], hi[4];
    #pragma unroll
    for (int ks = 0; ks < 4; ++ks) {
      asm volatile("ds_read_b64_tr_b16 %0,%1 offset:%c2" : "=&v"(lo[ks]) : "v"(vb), "i"(d0 * 4096 + ks * 1024) : "memory");
      asm volatile("ds_read_b64_tr_b16 %0,%1 offset:%c2" : "=&v"(hi[ks]) : "v"(vb), "i"(d0 * 4096 + ks * 1024 + 512) : "memory"); }
    asm volatile("s_waitcnt lgkmcnt(0)" ::: "memory"); SBAR();
    #define PK(k) (bf16x8){lo[k][0], lo[k][1], lo[k][2], lo[k][3], hi[k][0], hi[k][1], hi[k][2], hi[k][3]}
    o[d0] = __builtin_amdgcn_mfma_f32_32x32x16_bf16(pa0, PK(0), o[d0], 0, 0, 0);
    o[d0] = __builtin_amdgcn_mfma_f32_32x32x16_bf16(pa1, PK(1), o[d0], 0, 0, 0);
    o[d0] = __builtin_amdgcn_mfma_f32_32x32x16_bf16(pa2, PK(2), o[d0], 0, 0, 0);
    o[d0] = __builtin_amdgcn_mfma_f32_32x32x16_bf16(pa3, PK(3), o[d0], 0, 0, 0);
    #undef PK
  }
}
#define ATTN_STORE16(p, v) st16((p), (v))
template <int THRL> __device__ __forceinline__ void attn_unit(int b, int h, int qb, const bf16_t* QO, bf16_t* Ob, const bf16_t* __restrict__ K, const bf16_t* __restrict__ V, const float* __restrict__ kmean, char* shm) {
  int tid_ = threadIdx.x; asm volatile("" : "+v"(tid_));
  const int tid = tid_, lane = tid & 63, r32 = lane & 31, hi = lane >> 5; const int wid = __builtin_amdgcn_readfirstlane(tid >> 6);
  const long rowbase = (long)b * SEQ; const int q0 = qb * QB;
  const bf16_t* Qw = QO + (rowbase + q0 + wid * QBLK) * DMQ + h * D;
  const bf16_t* Kh = K + rowbase * DMK + h * D, *Vh = V + rowbase * DMK + h * D;
  const unsigned lds0 = (unsigned)(uintptr_t)shm;
  float* wsf = (float*)(shm + LDS_WS) + wid * 128;
  const bf16_t* ksrc = Kh + (long)lane * DMK + wid * 8;
  const bf16_t* vsrc = Vh + (long)(16 * (wid & 3) + (lane >> 2)) * DMK + (wid >> 2) * 32 + (lane & 3) * 8;
  const unsigned kdst = lds0 + LDS_K + wid * 1024, vdst = lds0 + LDS_V + wid * 1024;
  #define DMA_K(t, slot) glds16(ksrc + (long)(t) * KVBLK * DMK, (unsigned)__builtin_amdgcn_readfirstlane(kdst + (slot)))
  #define DMA_V(t, slot) glds16(vsrc + (long)(t) * KVBLK * DMK, (unsigned)__builtin_amdgcn_readfirstlane(vdst + (slot)))
  DMA_K(0, 0); DMA_V(0, 0); DMA_K(1, SLOTB);
  bf16x8 qr[4];
  #pragma unroll
  for (int d0 = 0; d0 < 4; ++d0) qr[d0] = *reinterpret_cast<const bf16x8*>(&Qw[(long)r32 * DMQ + d0 * 16 + hi * 8]);
  unsigned selm = 0u;
  if (qb > 0) {
    float* kmL = (float*)(shm + LDS_OST);
    const float* kmg = kmean + ((size_t)(b * 8 + h) * 16) * 64;
    for (int i = tid; i < qb * 64; i += 512) kmL[i] = kmg[i];
    asm volatile("s_waitcnt vmcnt(0) lgkmcnt(0)\n\ts_barrier" ::: "memory");
    float qf[32];
    #pragma unroll
    for (int d0 = 0; d0 < 4; ++d0)
      #pragma unroll
      for (int e = 0; e < 8; ++e) qf[8 * d0 + e] = __uint_as_float(((unsigned)(unsigned short)qr[d0][e]) << 16);
    float b0 = -INFINITY, b1 = -INFINITY, b2 = -INFINITY; int i0 = -1, i1 = -1, i2 = -1;
    for (int j = 0; j < qb; ++j) {
      const float* km = kmL + j * 64 + 8 * hi; float sc = 0.f;
      #pragma unroll
      for (int d0 = 0; d0 < 4; ++d0)
        #pragma unroll
        for (int e = 0; e < 8; ++e) sc += qf[8 * d0 + e] * km[16 * d0 + e];
      sc += __shfl_xor(sc, 32);
      if (sc > b0) { b2 = b1; i2 = i1; b1 = b0; i1 = i0; b0 = sc; i0 = j; } else if (sc > b1) { b2 = b1; i2 = i1; b1 = sc; i1 = j; } else if (sc > b2) { b2 = sc; i2 = j; }
    }
    if (i0 >= 0) selm |= 1u << i0; if (i1 >= 0) selm |= 1u << i1; if (i2 >= 0) selm |= 1u << i2;
    asm volatile("s_waitcnt lgkmcnt(0)\n\ts_barrier" ::: "memory");
  }
  if (hi == 0) ((unsigned*)wsf)[64 + r32] = selm;
  { const lds_ptr qst = (lds_ptr)shm + LDS_OST + wid * 4096 + lane * 16;
    #pragma unroll
    for (int d0 = 0; d0 < 4; ++d0) *(__attribute__((address_space(3))) bf16x8*)(qst + d0 * 1024) = qr[d0]; }
  #define SELROW(j) (((j) >= qb) || ((((const unsigned*)wsf)[64 + r32] >> (j)) & 1u))
  #define NEGM_SET(blk) do { const float nv_ = SELROW(blk) ? -mhat : NEGB; _Pragma("unroll") for (int r = 0; r < 16; ++r) negm[r] = nv_; asm volatile("" : "+v"(negm)); } while (0)
  const int vb0 = (int)(lds0 + LDS_V) + ((lane >> 4) & 1) * 32 + (lane & 3) * 8 + (4 * hi + ((lane & 15) >> 2)) * 64;
  const char* Kbase = shm + LDS_K; bf16x8 kf[8];
  const lds_cptr qp0 = (lds_cptr)shm + LDS_OST + wid * 4096 + lane * 16;
  const lds_cptr shm3 = (lds_cptr)shm; const lds_cptr kp0 = shm3 + LDS_K + hi * 1024 + r32 * 16; const lds_cptr vp0 = shm3 + LDS_V + ((lane >> 4) & 1) * 32 + (lane & 3) * 8 + (4 * hi + ((lane & 15) >> 2)) * 64;
  const int NT = (q0 + QB) / KVBLK;
  float mhat = 0.f, l_reg = 0.f; f32x16 o[2]; o[0] = f32x16{}; o[1] = f32x16{}; f32x16 negm;
  NEGM_SET(0);
  const int qrel = wid * QBLK + r32;
  #define CMASK(P0, P1, t) do { int jb_ = (t) - (NT - 4); if (jb_ >= 0) cmask(P0, P1, jb_, qrel, hi); } while (0)
  bool resc = false;
  #define START(P0, P1) do { const float rm = rowmax(P0, P1); resc = false; \
    { const float dl = SELROW(0) ? rm : 0.f; mhat = fadd_s(mhat, dl); \
      _Pragma("unroll") for (int r = 0; r < 16; ++r) { P0[r] = fsub_s(P0[r], dl); P1[r] = fsub_s(P1[r], dl); } \
      NEGM_SET(0); } \
    _Pragma("unroll") for (int r = 0; r < 16; ++r) P0[r] = __builtin_amdgcn_exp2f(P0[r]); } while (0)
  #define RESC() do { if (resc) { asm volatile("s_waitcnt lgkmcnt(0)" ::: "memory"); \
      _Pragma("unroll") for (int d_ = 0; d_ < 2; ++d_) _Pragma("unroll") for (int r = 0; r < 16; ++r) o[d_][r] *= wsf[crow(r, hi)]; } } while (0)
  f32x16 pA0, pA1, pB0, pB1;
  int sl_prev = 0, sl_cur = 0, sl_next = SLOTB;
  #define ROT() do { sl_prev = sl_cur; sl_cur = sl_next; sl_next = (sl_next == (NSLOT - 1) * SLOTB) ? 0 : sl_next + SLOTB; } while (0)
  DMA_K(2, 2 * SLOTB);
  WAIT_BAR(3);
  qkt(pA0, pA1, Kbase, qr, negm, r32, hi); asm volatile("s_nop 15\n\ts_nop 7" : "+v"(pA0), "+v"(pA1)); CMASK(pA0, pA1, 0);
  START(pA0, pA1);
  _Pragma("unroll") for (int r = 0; r < 16; ++r) pA1[r] = __builtin_amdgcn_exp2f(pA1[r]);
  WAIT_BAR(0);
  DMA_K(3, 0); DMA_V(1, SLOTB);
  ROT();
  kload8(kf, kp0 + sl_cur);
  WAIT_BAR(2);
  s16x4 vlo[8], vhi[8]; u32x4 pw0, pw1, pw2, pw3; bf16x8 q0_, q1_, q2_, q3_;
  #define QRD(d) do { q##d##_ = *(const __attribute__((address_space(3))) bf16x8*)(qp0 + (d) * 1024); } while (0)
  QRD(0); QRD(1);
  #define PKW(P, B) cvtpk_s(P[B], P[B + 1])
  #define PAF(k) __builtin_bit_cast(bf16x8, pw##k)
  #define VFR(i) (bf16x8){vlo[i][0], vlo[i][1], vlo[i][2], vlo[i][3], vhi[i][0], vhi[i][1], vhi[i][2], vhi[i][3]}
  #define PIN(x) asm volatile("" : "+v"(x))
  #define MX3(a, b, c) __builtin_fmaxf(__builtin_fmaxf((a), (b)), (c))
  #define GAPA(MF, A0, A1, A2, A3, W0, W1, PW) do { MF; sacc += A0; sacc += A1; sacc += A2; sacc += A3; PIN(sacc); W0; W1; PIN(PW); SBAR(); } while (0)
  #define EX(v) __builtin_amdgcn_exp2f(v)
  #define GAPB(MF, X, B) do { MF; X[B] = EX(X[B]); X[B + 1] = EX(X[B + 1]); X[B + 2] = EX(X[B + 2]); X[B + 3] = EX(X[B + 3]); PIN(X); SBAR(); } while (0)
  #define VRD(i) do { vlo[i] = vtr(vp_ + (((i) >> 2) * 4096 + ((i) & 3) * 1024)); vhi[i] = vtr(vp_ + (((i) >> 2) * 4096 + ((i) & 3) * 1024 + 512)); } while (0)
  #define KRD(G, j) do { if (G) { kload2(kf, kp0 + sl_next, j); SBAR(); } } while (0)
  #define STEP(C0, C1, P0, P1, t, GK, GV, GL) do { SBAR(); \
    const lds_cptr vp_ = vp0 + sl_prev; \
    VRD(0); SBAR(); float sacc = (P0[0] + P0[1]); \
    GAPA(C0 = __builtin_amdgcn_mfma_f32_32x32x16_bf16(kf[0], q0_, negm, 0, 0, 0), P0[2], P0[3], P0[4], P0[5],     pw0[0] = PKW(P0, 0), pw0[1] = PKW(P0, 2), pw0); \
    VRD(4); SBAR(); GAPA(C1 = __builtin_amdgcn_mfma_f32_32x32x16_bf16(kf[1], q0_, negm, 0, 0, 0), P0[6], P0[7], P0[8], P0[9],     pw0[2] = PKW(P0, 4), pw0[3] = PKW(P0, 6), pw0); \
    QRD(2); SBAR(); \
    VRD(1); SBAR(); GAPA(C0 = __builtin_amdgcn_mfma_f32_32x32x16_bf16(kf[2], q1_, C0, 0, 0, 0),   P0[10], P0[11], P0[12], P0[13], pw1[0] = PKW(P0, 8), pw1[1] = PKW(P0, 10), pw1); \
    VRD(5); SBAR(); GAPA(C1 = __builtin_amdgcn_mfma_f32_32x32x16_bf16(kf[3], q1_, C1, 0, 0, 0),   P0[14], P0[15], P1[0], P1[1],   pw1[2] = PKW(P0, 12), pw1[3] = PKW(P0, 14), pw1); \
    QRD(3); SBAR(); \
    VRD(2); SBAR(); GAPA(C0 = __builtin_amdgcn_mfma_f32_32x32x16_bf16(kf[4], q2_, C0, 0, 0, 0),   P1[2], P1[3], P1[4], P1[5],     pw2[0] = PKW(P1, 0), pw2[1] = PKW(P1, 2), pw2); \
    VRD(6); SBAR(); GAPA(C1 = __builtin_amdgcn_mfma_f32_32x32x16_bf16(kf[5], q2_, C1, 0, 0, 0),   P1[6], P1[7], P1[8], P1[9],     pw2[2] = PKW(P1, 4), pw2[3] = PKW(P1, 6), pw2); \
    VRD(3); SBAR(); GAPA(C0 = __builtin_amdgcn_mfma_f32_32x32x16_bf16(kf[6], q3_, C0, 0, 0, 0),   P1[10], P1[11], P1[12], P1[13], pw3[0] = PKW(P1, 8), pw3[1] = PKW(P1, 10), pw3); \
    VRD(7); SBAR(); GAPA(C1 = __builtin_amdgcn_mfma_f32_32x32x16_bf16(kf[7], q3_, C1, 0, 0, 0),   P1[14], P1[15], 0.f, 0.f,       pw3[2] = PKW(P1, 12), pw3[3] = PKW(P1, 14), pw3); \
    l_reg += sacc; \
    if (GK) { DMA_K((t) + 3, sl_cur); } if (GV) { DMA_V((t) + 1, sl_next); } \
    CMASK(C0, C1, t); \
    { float a = MX3(C0[0], C0[1], C1[0]), b = MX3(C0[2], C0[3], C1[1]); a = MX3(a, C1[2], C1[3]); \
      _Pragma("unroll") for (int r = 4; r < 16; r += 4) { a = MX3(a, C0[r], C0[r + 1]); b = MX3(b, C0[r + 2], C0[r + 3]); a = MX3(a, C1[r], C1[r + 1]); b = MX3(b, C1[r + 2], C1[r + 3]); } \
      float rm = __builtin_fmaxf(a, b); { auto rr = __builtin_amdgcn_permlane32_swap(__float_as_uint(rm), __float_as_uint(rm), false, false); rm = __builtin_fmaxf(__uint_as_float(rr[0]), __uint_as_float(rr[1])); } \
      resc = false; \
      if (__builtin_expect(__any(rm > (float)THRL), 0)) { const float dl = __builtin_fmaxf(rm, 0.f); mhat += dl; \
        _Pragma("unroll") for (int r = 0; r < 16; ++r) { C0[r] -= dl; C1[r] -= dl; } \
        NEGM_SET(((t) + 1) >> 2); \
        const float f = __builtin_amdgcn_exp2f(-dl); l_reg *= f; if (hi == 0) wsf[r32] = f; resc = true; } \
      else if ((((t) + 1) & 3) == 0) { NEGM_SET(((t) + 1) >> 2); } } \
    SBAR(); \
    GAPB(o[0] = __builtin_amdgcn_mfma_f32_32x32x16_bf16(PAF(0), VFR(0), o[0], 0, 0, 0), C0, 0); \
    GAPB(o[1] = __builtin_amdgcn_mfma_f32_32x32x16_bf16(PAF(0), VFR(4), o[1], 0, 0, 0), C0, 4); \
    KRD(GL, 0); GAPB(o[0] = __builtin_amdgcn_mfma_f32_32x32x16_bf16(PAF(1), VFR(1), o[0], 0, 0, 0), C0, 8); \
    KRD(GL, 1); GAPB(o[1] = __builtin_amdgcn_mfma_f32_32x32x16_bf16(PAF(1), VFR(5), o[1], 0, 0, 0), C0, 12); \
    KRD(GL, 2); GAPB(o[0] = __builtin_amdgcn_mfma_f32_32x32x16_bf16(PAF(2), VFR(2), o[0], 0, 0, 0), C1, 0); \
    KRD(GL, 3); GAPB(o[1] = __builtin_amdgcn_mfma_f32_32x32x16_bf16(PAF(2), VFR(6), o[1], 0, 0, 0), C1, 4); \
    GAPB(o[0] = __builtin_amdgcn_mfma_f32_32x32x16_bf16(PAF(3), VFR(3), o[0], 0, 0, 0), C1, 8); \
    GAPB(o[1] = __builtin_amdgcn_mfma_f32_32x32x16_bf16(PAF(3), VFR(7), o[1], 0, 0, 0), C1, 12); \
    QRD(0); QRD(1); SBAR(); \
    } while (0)
  int t = 1;
  #undef CMASK
  #define CMASK(P0, P1, t) do {} while (0)
  for (; t + 5 < NT; t += 2) {
    STEP(pB0, pB1, pA0, pA1, t, true, true, true);     WAIT_BAR(2); RESC(); ROT();
    STEP(pA0, pA1, pB0, pB1, t + 1, true, true, true); WAIT_BAR(2); RESC(); ROT();
  }
  #undef CMASK
  #define CMASK(P0, P1, t) do { int jb_ = (t) - (NT - 4); if (jb_ >= 0) cmask(P0, P1, jb_, qrel, hi); } while (0)
  #define ENDW(tt) do { if ((tt) + 3 < NT) { WAIT_BAR(2); } else if ((tt) + 2 < NT) { WAIT_BAR(1); } else { WAIT_BAR(0); } } while (0)
  for (; t + 1 < NT; t += 2) {
    STEP(pB0, pB1, pA0, pA1, t, (t + 3 < NT), (t + 1 < NT), (t + 1 < NT));       ENDW(t);     RESC(); ROT();
    STEP(pA0, pA1, pB0, pB1, t + 1, (t + 4 < NT), (t + 2 < NT), (t + 2 < NT));   ENDW(t + 1); RESC(); ROT();
  }
  STEP(pB0, pB1, pA0, pA1, NT - 1, false, false, false); RESC();
  { float sacc = pB0[0] + pB0[1]; _Pragma("unroll") for (int r = 2; r < 16; ++r) sacc += pB0[r]; _Pragma("unroll") for (int r = 0; r < 16; ++r) sacc += pB1[r]; l_reg += sacc;
    pw0 = (u32x4){PKW(pB0, 0), PKW(pB0, 2), PKW(pB0, 4), PKW(pB0, 6)}; pw1 = (u32x4){PKW(pB0, 8), PKW(pB0, 10), PKW(pB0, 12), PKW(pB0, 14)}; pw2 = (u32x4){PKW(pB1, 0), PKW(pB1, 2), PKW(pB1, 4), PKW(pB1, 6)}; pw3 = (u32x4){PKW(pB1, 8), PKW(pB1, 10), PKW(pB1, 12), PKW(pB1, 14)};
    SBAR(); pv(o, vb0 + sl_cur, PAF(0), PAF(1), PAF(2), PAF(3)); }
  #undef PKW
  #undef PAF
  #undef VFR
  #undef PIN
  #undef MX3
  #undef GAPA
  #undef GAPB
  #undef EX
  #undef VRD
  #undef KRD
  #undef QRD
  #undef STEP
  #undef ENDW
  { auto rr = __builtin_amdgcn_permlane32_swap(__float_as_uint(l_reg), __float_as_uint(l_reg), false, false); l_reg = __uint_as_float(rr[0]) + __uint_as_float(rr[1]); }
  if (hi == 0) wsf[32 + r32] = l_reg; asm volatile("s_waitcnt lgkmcnt(0)" ::: "memory");
  float rli[16];
  #pragma unroll
  for (int r = 0; r < 16; ++r) rli[r] = __builtin_amdgcn_rcpf(wsf[32 + crow(r, hi)]);
  bf16_t* Ow = Ob + (rowbase + q0 + wid * QBLK) * DMQ + h * D;
  { bf16_t* stg = (bf16_t*)(shm + LDS_OST) + wid * 2048;
    #pragma unroll
    for (int r = 0; r < 16; ++r) { const int orow = crow(r, hi);
      #pragma unroll
      for (int d0 = 0; d0 < 2; ++d0) stg[orow * 64 + d0 * 32 + r32] = (bf16_t)f2bf(o[d0][r] * rli[r]); }
    asm volatile("s_waitcnt lgkmcnt(0)" ::: "memory");
    #pragma unroll
    for (int i = 0; i < 4; ++i) { const int row = i * 8 + (lane >> 3), ch = lane & 7; const u32x4 v = *(const u32x4*)(stg + row * 64 + ch * 8); ATTN_STORE16(Ow + (long)row * DMQ + ch * 8, v); } }
  asm volatile("s_waitcnt lgkmcnt(0)\n\ts_barrier" ::: "memory");
  #undef DMA_K
  #undef DMA_V
  #undef CMASK
  #undef START
  #undef RESC
  #undef ROT
  #undef SELROW
  #undef NEGM_SET
}
#undef SBAR
#undef WAIT_BAR
}
__device__ __forceinline__ void conv_pass(Frame& F) {
    bf16_t* YAB = WSP(bf16_t, WS_YAB); const bf16_t* U = WSP(bf16_t, WS_U); const bf16_t* BG = WSP(bf16_t, WS_BG);
    const int stride = F.G * NTHREADS;
    for (int i0 = blockIdx.x * NTHREADS + F.tid; i0 < T * 64; i0 += 2 * stride) {
        u32x4 r2[2], r1[2], r0[2], rb[2];
#pragma unroll
        for (int q = 0; q < 2; ++q) { const int i = i0 + q * stride; const int t = i >> 6, c0 = (i & 63) * 8, pos = t & (S - 1);
            r2[q] = *(const u32x4*)(U + (size_t)t * 512 + c0); rb[q] = __builtin_nontemporal_load((const u32x4*)(BG + (size_t)t * 512 + c0));
            r1[q] = (pos >= 1) ? *(const u32x4*)(U + (size_t)(t - 1) * 512 + c0) : (u32x4){0u, 0u, 0u, 0u};
            r0[q] = (pos >= 2) ? *(const u32x4*)(U + (size_t)(t - 2) * 512 + c0) : (u32x4){0u, 0u, 0u, 0u}; }
#pragma unroll
        for (int q = 0; q < 2; ++q) { const int i = i0 + q * stride; const int t = i >> 6, c0 = (i & 63) * 8;
            float u0[8], u1[8], u2[8], bg[8], y[8]; unpack8(r2[q], u2); unpack8(r1[q], u1); unpack8(r0[q], u0); unpack8(rb[q], bg);
#pragma unroll
            for (int e4 = 0; e4 < 2; ++e4) { const f32x4 w0 = *(const f32x4*)(F.conv_w + c0 + 4 * e4), w1 = *(const f32x4*)(F.conv_w + 512 + c0 + 4 * e4), w2 = *(const f32x4*)(F.conv_w + 1024 + c0 + 4 * e4), cb = *(const f32x4*)(F.conv_b + c0 + 4 * e4);
#pragma unroll
                for (int e = 0; e < 4; ++e) y[4 * e4 + e] = bg[4 * e4 + e] * (w0[e] * u0[4 * e4 + e] + w1[e] * u1[4 * e4 + e] + w2[e] * u2[4 * e4 + e] + cb[e]); }
            st16(YAB + (size_t)t * 1024 + 512 + c0, pack8(y)); }
    }
}
__device__ __forceinline__ void s3_attn(Frame& F, char* lds_gen, bf16_t* obase) {
    const int vcu = (blockIdx.x % 8) * (F.G / 8) + blockIdx.x / 8;
    const int s = vcu & 7, pr = vcu >> 3;
    for (int i = 0; i < 4; ++i) {
        const int bh = 2 * pr + (i >> 1), qb = (i & 1) ? 15 - s : s;
        attn_body::attn_unit<8>(bh >> 3, bh & 7, qb, WSP(bf16_t, WS_YAB), obase, WSP(bf16_t, WS_K), WSP(bf16_t, WS_V), WSP(float, WS_KMEAN), lds_gen);
    }
}
__device__ __forceinline__ void s3_fast(Frame& F, char* lds_gen) { s3_attn(F, lds_gen, WSP(bf16_t, WS_YAB)); conv_pass(F); }

__device__ __forceinline__ void s4_simple(Frame& F) {
    LAS float* tile = (LAS float*)F.lds; LAS float* tile2 = tile + 64 * 65;
    const bf16_t* YAB = WSP(bf16_t, WS_YAB); const bf16_t* WP = WSP(bf16_t, WS_WP_T); const bf16_t* GT = WSP(bf16_t, WS_GATES);
    const int row = F.tid >> 3, seg = F.tid & 7;
    for (int it = blockIdx.x; it < 512 * 16; it += F.G) {
        const int rt = it >> 4, ct = it & 15, r0 = rt * 64, gr = r0 + row;
        const RowsLinear aa{YAB + (size_t)r0 * 1024, 1024}, ab{YAB + (size_t)r0 * 1024 + 512, 1024};
        const RowsLinear ba{WP + (size_t)(64 * ct) * 1024, 1024}, bb{WP + (size_t)(64 * ct) * 1024 + 512, 1024};
        sgemm_tile(tile, 512, aa, ba, F.wave, F.lane); sgemm_tile(tile2, 512, ab, bb, F.wave, F.lane); __syncthreads();
        float ga[8], gb[8], v[8];
        unpack8(*(const u32x4*)(GT + (size_t)gr * 2048 + 64 * ct + 8 * seg), ga); unpack8(*(const u32x4*)(GT + (size_t)gr * 2048 + 1024 + 64 * ct + 8 * seg), gb);
#pragma unroll
        for (int e = 0; e < 8; ++e) v[e] = ga[e] * tile[row * 65 + 8 * seg + e] + gb[e] * tile2[row * 65 + 8 * seg + e];
        *(u32x4*)(WSP(bf16_t, WS_H) + (size_t)gr * 1024 + 64 * ct + 8 * seg) = pack8(v);
        __syncthreads();
    }
}
__device__ __forceinline__ void s5_simple(Frame& F) {
    LAS float* tile = (LAS float*)F.lds;
    const bf16_t* MG = WSP(bf16_t, WS_H); const bf16_t* WO = WSP(bf16_t, WS_WO_T);
    const int row = F.tid >> 3, seg = F.tid & 7;
    for (int it = blockIdx.x; it < 512 * 16; it += F.G) {
        const int rt = it >> 4, ct = it & 15, r0 = rt * 64, gr = r0 + row, b = r0 / S;
        const RowsLinear aa{MG + (size_t)r0 * 1024, 1024}, bb{WO + (size_t)(64 * ct) * 1024, 1024};
        sgemm_tile(tile, 1024, aa, bb, F.wave, F.lane); __syncthreads();
        const float* ga1 = WSP(float, WS_MOD) + (size_t)b * NMOD + 2048 + 64 * ct + 8 * seg;
        const float* xr = F.x + (size_t)gr * D + 64 * ct + 8 * seg; float* orow = F.out + (size_t)gr * D + 64 * ct + 8 * seg;
#pragma unroll
        for (int e4 = 0; e4 < 2; ++e4) { const f32x4 xv = *(const f32x4*)(xr + 4 * e4), gv = *(const f32x4*)(ga1 + 4 * e4); f32x4 o;
#pragma unroll
            for (int e = 0; e < 4; ++e) o[e] = xv[e] + gv[e] * tile[row * 65 + 8 * seg + 4 * e4 + e];
            *(f32x4*)(orow + 4 * e4) = o; }
        __syncthreads();
    }
}

struct EpiG2 {
    static constexpr bool HAS_MID = true;
    const bf16_t* gates; bf16_t* merged;
    __device__ __forceinline__ void mid(Acc& acc, const pg8::Unit& u, int wr, int wc, int fr, int fq) const {
        int row0 = u.pm * 256 + wr * 64 + fr; const int c0 = u.pn * 256 + 32 * wc + 8 * fq; asm volatile("" : "+v"(row0));
#pragma unroll
        for (int ai = 0; ai < 2; ++ai)
#pragma unroll
            for (int m = 0; m < 4; ++m) { const bf16_t* gp = gates + (size_t)(row0 + 128 * ai + 16 * m) * 2048 + c0;
#pragma unroll
                for (int bj = 0; bj < 2; ++bj) { f32x4 a0, a1; unpack8v(__builtin_nontemporal_load((const u32x4*)(gp + 128 * bj)), a0, a1);
                    acc[ai][bj][m][0] *= a0; acc[ai][bj][m][1] *= a1; }
                if (m & 1) asm volatile("" ::: "memory"); }
    }
    __device__ __forceinline__ void operator()(Acc& acc, const pg8::Unit& u, int wr, int wc, int fr, int fq) const {
        int row0 = u.pm * 256 + wr * 64 + fr; const int c0 = u.pn * 256 + 32 * wc + 8 * fq; asm volatile("" : "+v"(row0));
#pragma unroll
        for (int ai = 0; ai < 2; ++ai)
#pragma unroll
            for (int m = 0; m < 4; ++m) { const size_t r = (size_t)(row0 + 128 * ai + 16 * m);
#pragma unroll
                for (int bj = 0; bj < 2; ++bj) { f32x4 b0, b1; unpack8v(__builtin_nontemporal_load((const u32x4*)(gates + r * 2048 + 1024 + c0 + 128 * bj)), b0, b1);
                    st16(merged + r * 1024 + c0 + 128 * bj, pack8v(acc[ai][bj][m][0] * b0, acc[ai][bj][m][1] * b1)); }
                if (m & 1) asm volatile("" ::: "memory"); }
    }
};
__device__ __forceinline__ void s4_fast(Frame& F) {
    const pg8::DenseSched Sd{(const char*)(F.ws + WS_YAB), (const char*)(F.ws + WS_WP_T), T / 256, 4, 1024, F.G, (int)blockIdx.x};
    const EpiG2 E{WSP(bf16_t, WS_GATES), WSP(bf16_t, WS_H)};
    pg8::gemm_phase<EpiG2, pg8::DenseSched>(F.lds, 1024, Sd, E);
}
struct EpiG3 {
    static constexpr bool HAS_MID = false;
    const float* x; bf16_t* x1; const float* mod;
    __device__ __forceinline__ void mid(Acc&, const pg8::Unit&, int, int, int, int) const {}
    __device__ __forceinline__ void operator()(Acc& acc, const pg8::Unit& u, int wr, int wc, int fr, int fq) const {
        int row0 = u.pm * 256 + wr * 64 + fr; const int c0 = u.pn * 256 + 32 * wc + 8 * fq, b = u.pm >> 4; asm volatile("" : "+v"(row0));
        f32x4 gv[2][2];
#pragma unroll
        for (int bj = 0; bj < 2; ++bj)
#pragma unroll
            for (int n = 0; n < 2; ++n) gv[bj][n] = *(const f32x4*)(mod + (size_t)b * NMOD + 2048 + c0 + 128 * bj + 4 * n);
#pragma unroll
        for (int ai = 0; ai < 2; ++ai)
#pragma unroll
            for (int m = 0; m < 4; ++m) { const size_t off = (size_t)(row0 + 128 * ai + 16 * m) * D + c0;
#pragma unroll
                for (int bj = 0; bj < 2; ++bj) { const f32x4 x0 = __builtin_nontemporal_load((const f32x4*)(x + off + 128 * bj)), x1v = __builtin_nontemporal_load((const f32x4*)(x + off + 128 * bj + 4));
                    st16(x1 + off + 128 * bj, pack8v(x0 + gv[bj][0] * acc[ai][bj][m][0], x1v + gv[bj][1] * acc[ai][bj][m][1])); }
                if (m == 3) asm volatile("" ::: "memory"); }
    }
};
__device__ __forceinline__ void s5_fast(Frame& F) {
    const pg8::DenseSched Sd{(const char*)(F.ws + WS_H), (const char*)(F.ws + WS_WO_T), T / 256, 4, 1024, F.G, (int)blockIdx.x};
    const EpiG3 E{F.x, WSP(bf16_t, WS_X1), WSP(float, WS_MOD)};
    pg8::gemm_phase<EpiG3, pg8::DenseSched>(F.lds, 1024, Sd, E);
}
struct MoeTab { const LAS int* cnt; const LAS int* tstart; const LAS int* tile_e; int nM; };
__device__ __forceinline__ MoeTab moe_table(Frame& F) {
    LAS int* cntL = (LAS int*)(F.lds + MISC_OFF + 1024); LAS int* ts = cntL + 32; LAS int* te = cntL + 96;
    if (F.tid < 32) cntL[F.tid] = (int)__hip_atomic_load(WSP(unsigned, WS_CTL) + CW_GCNT + 64 * F.tid, __ATOMIC_RELAXED, __HIP_MEMORY_SCOPE_AGENT);
    __syncthreads();
    if (F.tid == 0) { int pm = 0; for (int e = 0; e < 32; ++e) { ts[e] = pm; const int n = (cntL[e] + 255) >> 8; for (int i = 0; i < n; ++i) te[pm++] = e; } ts[32] = pm; }
    __syncthreads();
    return MoeTab{cntL, ts, te, ts[32]};
}
struct MoeUpSched {
    static constexpr bool GATHER = true, FP8 = true;
    const char* h2; const char* w13; MoeTab tb; const int* linfo; int G, c;
    __device__ __forceinline__ bool next(int i, pg8::Unit& u) const { if (!pg8::static_unit(i, G, c, tb.nM, 4, u.pm, u.pn)) return false;
        u.e = tb.tile_e[u.pm]; u.rbase = (u.pm - tb.tstart[u.e]) * 256; u.a = h2; u.b = w13 + ((size_t)u.e * 1024 + 256 * u.pn) * 1024; return true; }
    __device__ __forceinline__ int row_index(const pg8::Unit& u, int r) const { const int rank = u.rbase + r; return rank < tb.cnt[u.e] ? (linfo[(size_t)u.e * 65536 + rank] >> 1) : 0; }
};
struct EpiUp {
    static constexpr bool HAS_MID = false;
    bf16_t* hid; const float* lw; const LAS int* cnt;
    __device__ __forceinline__ void mid(Acc&, const pg8::Unit&, int, int, int, int) const {}
    __device__ __forceinline__ void operator()(Acc& acc, const pg8::Unit& u, int wr, int wc, int fr, int fq) const {
        int rl0 = wr * 64 + fr; const int c0 = u.pn * 128 + 32 * wc + 8 * fq, n_e = cnt[u.e]; asm volatile("" : "+v"(rl0));
#pragma unroll
        for (int ai = 0; ai < 2; ++ai)
#pragma unroll
            for (int m = 0; m < 4; ++m) { const int rl = rl0 + 128 * ai + 16 * m, rank = u.rbase + rl; const float wt = rank < n_e ? 1.f : 0.f; f32x4 o[2];
#pragma unroll
                for (int n = 0; n < 2; ++n)
#pragma unroll
                    for (int e = 0; e < 4; ++e) { const float a = acc[ai][0][m][n][e] * (1.f / W8_SCALE), c = acc[ai][1][m][n][e] * (1.f / W8_SCALE); o[n][e] = a * __builtin_amdgcn_rcpf(1.f + __expf(-a)) * c * wt; }
                *(u32x2*)((unsigned char*)hid + (size_t)(u.pm * 256 + rl) * 512 + c0) = pack8_fp8(o[0], o[1]); }
    }
};
__device__ __forceinline__ void s8_fast(Frame& F) {
    const MoeTab tb = moe_table(F);
    const MoeUpSched Sd{(const char*)(F.ws + WS_H2), (const char*)(F.ws + WS_W13_T), tb, WSP(int, WS_LINFO), F.G, (int)blockIdx.x};
    const EpiUp E{WSP(bf16_t, WS_HID), WSP(float, WS_LW), tb.cnt};
    int Ku = D; asm volatile("" : "+s"(Ku));
    pg8::gemm_phase<EpiUp, MoeUpSched>(F.lds, Ku, Sd, E);
    { int t_ = threadIdx.x; asm volatile("" : "+v"(t_)); F.tid = t_; F.lane = t_ & 63; }
    { const int units = tb.nM * 4, rem = units % F.G, nidle = (rem == 0) ? F.G : F.G - rem, me = (rem == 0) ? (int)blockIdx.x : (int)blockIdx.x - rem;
        if (me >= 0) convert_items(F, X_W2, X_END, me * NWAVES + F.wave, nidle * NWAVES); }
}
struct MoeDownSched {
    static constexpr bool GATHER = false, FP8 = true;
    const char* hid; const char* w2; MoeTab tb; int G, c;
    __device__ __forceinline__ bool next(int i, pg8::Unit& u) const { if (!pg8::static_unit(i, G, c, tb.nM, 4, u.pm, u.pn)) return false;
        u.e = tb.tile_e[u.pm]; u.rbase = (u.pm - tb.tstart[u.e]) * 256; u.a = hid + (size_t)u.pm * 256 * 512; u.b = w2 + ((size_t)u.e * 1024 + 256 * u.pn) * 512; return true; }
    __device__ __forceinline__ int row_index(const pg8::Unit&, int) const { return 0; }
};
struct EpiDown {
    static constexpr bool HAS_MID = false;
    bf16_t* yslot; const int* linfo; const float* lw; const LAS int* cnt;
    __device__ __forceinline__ void mid(Acc&, const pg8::Unit&, int, int, int, int) const {}
    __device__ __forceinline__ void operator()(Acc& acc, const pg8::Unit& u, int wr, int wc, int fr, int fq) const {
        int rl0 = wr * 64 + fr; const int c0 = u.pn * 256 + 32 * wc + 8 * fq, n_e = cnt[u.e]; asm volatile("" : "+v"(rl0));
#pragma unroll
        for (int ai = 0; ai < 2; ++ai)
#pragma unroll
            for (int m = 0; m < 4; ++m) { const int rank = u.rbase + rl0 + 128 * ai + 16 * m;
                if (rank < n_e) { const int info = linfo[(size_t)u.e * 65536 + rank]; const float wt = lw[(size_t)u.e * 65536 + rank] * (1.f / W8_SCALE);
#pragma unroll
                    for (int bj = 0; bj < 2; ++bj) st16(yslot + (size_t)info * 1024 + c0 + 128 * bj, pack8v(acc[ai][bj][m][0] * wt, acc[ai][bj][m][1] * wt)); } }
    }
};
__device__ __forceinline__ void s9_fast(Frame& F) {
    const MoeTab tb = moe_table(F);
    const MoeDownSched Sd{(const char*)(F.ws + WS_HID), (const char*)(F.ws + WS_W2_T), tb, F.G, (int)blockIdx.x};
    const EpiDown E{WSP(bf16_t, WS_YSLOT), WSP(int, WS_LINFO), WSP(float, WS_LW), tb.cnt};
    int Kd = DE; asm volatile("" : "+s"(Kd));
    pg8::gemm_phase<EpiDown, MoeDownSched>(F.lds, Kd, Sd, E);
}

__device__ __forceinline__ void s6_router(Frame& F) {
    constexpr int WROW = 1032;
    LAS bf16_t* WT = (LAS bf16_t*)F.lds;
    LAS float* gsL = (LAS float*)(F.lds + 48 * WROW * 2);
    LAS float* shL = gsL + 1024;
    LAS float* biasL = shL + 1024;
    LAS float* lgt = biasL + 64;
    LAS int* cnt = (LAS int*)(F.lds + MISC_OFF + 256);
    LAS int* baseL = cnt + 32; LAS int* runL = cnt + 64; LAS int* eidL = cnt + 128; LAS float* ewL = (LAS float*)(cnt + 384);
    const int b = blockIdx.x >> 5;
    const float* mod = WSP(float, WS_MOD) + (size_t)b * NMOD;
    const float* W36 = WSP(float, WS_W36T);
    for (int i = F.tid; i < 36 * 256; i += NTHREADS) { const int jj = i >> 8, k4 = (i & 255) * 4; const f32x4 w = *(const f32x4*)(W36 + jj * 1024 + k4);
        u32x2 p; p.x = pk2(w.x, w.y); p.y = pk2(w.z, w.w); *(LAS u32x2*)(WT + jj * WROW + k4) = p; }
    for (int i = F.tid; i < 12 * 256; i += NTHREADS) { const int jj = 36 + (i >> 8), k4 = (i & 255) * 4; *(LAS u32x2*)(WT + jj * WROW + k4) = (u32x2){0u, 0u}; }
    if (F.tid < 256) { const int col = 4 * F.tid; const f32x4 g = *(const f32x4*)(F.g2 + col), s_ = *(const f32x4*)(mod + 4096 + col); *(LAS f32x4*)(gsL + col) = g * (s_ + 1.0f); *(LAS f32x4*)(shL + col) = *(const f32x4*)(mod + 3072 + col); }
    if (F.tid < 32) cnt[F.tid] = 0;
    __syncthreads();
    for (int jj = F.wave; jj < 36; jj += NWAVES) { float a = 0.f;
#pragma unroll
        for (int i = 0; i < 16; ++i) a += shL[F.lane + 64 * i] * W36[jj * 1024 + F.lane + 64 * i];
        a = wave_sum(a); if (F.lane == 0) biasL[jj] = a + ((jj < 4) ? F.b_rg[jj] : F.b_re[jj - 4]); }
    __syncthreads();
    const int fr = F.lane & 15, fq = F.lane >> 4, row0 = (blockIdx.x * NWAVES + F.wave) * 16, r = row0 + fr;
    const bf16_t* xr = WSP(bf16_t, WS_X1) + (size_t)r * D + 8 * fq;
    f32x4 D0 = {0.f, 0.f, 0.f, 0.f}, D1 = D0, D2 = D0; float ss = 0.f;
#pragma unroll 1
    for (int kb = 0; kb < 8; ++kb) {
        u32x4 xa[4];
#pragma unroll
        for (int i = 0; i < 4; ++i) xa[i] = *(const u32x4*)(xr + 32 * (4 * kb + i));
#pragma unroll
        for (int i = 0; i < 4; ++i) { const int k0 = 32 * (4 * kb + i) + 8 * fq;
            f32x4 a0, a1; unpack8v(xa[i], a0, a1);
            ss += (a0.x * a0.x + a0.y * a0.y) + (a0.z * a0.z + a0.w * a0.w) + (a1.x * a1.x + a1.y * a1.y) + (a1.z * a1.z + a1.w * a1.w);
            a0 *= *(const LAS f32x4*)(gsL + k0); a1 *= *(const LAS f32x4*)(gsL + k0 + 4);
            const bf16x8 A = __builtin_bit_cast(bf16x8, pack8v(a0, a1));
            const bf16x8 B0 = *(const LAS bf16x8*)(WT + fr * WROW + k0), B1 = *(const LAS bf16x8*)(WT + (16 + fr) * WROW + k0), B2 = *(const LAS bf16x8*)(WT + (32 + fr) * WROW + k0);
            D0 = __builtin_amdgcn_mfma_f32_16x16x32_bf16(A, B0, D0, 0, 0, 0);
            D1 = __builtin_amdgcn_mfma_f32_16x16x32_bf16(A, B1, D1, 0, 0, 0);
            D2 = __builtin_amdgcn_mfma_f32_16x16x32_bf16(A, B2, D2, 0, 0, 0); }
    }
    ss += __shfl_xor(ss, 16); ss += __shfl_xor(ss, 32);
    const float rinv = rsqrtf(ss * (1.f / D) + EPS);
    { int t2 = threadIdx.x; asm volatile("" : "+v"(t2)); F.lane = t2 & 63; }
    const int fr_ = F.lane & 15, fq_ = F.lane >> 4;
    {
        LAS float* lw = lgt + F.wave * 16 * 37;
#pragma unroll
        for (int reg = 0; reg < 4; ++reg) { const float rv = __shfl(rinv, 4 * fq_ + reg); const int tk = 4 * fq_ + reg;
            lw[tk * 37 + fr_] = D0[reg] * rv + biasL[fr_]; lw[tk * 37 + 16 + fr_] = D1[reg] * rv + biasL[16 + fr_];
            if (fr_ < 4) lw[tk * 37 + 32 + fr_] = D2[reg] * rv + biasL[32 + fr_]; }
    }
    {
        const int r_ = row0 + fr_; const bf16_t* xr_ = WSP(bf16_t, WS_X1) + (size_t)r_ * D + 8 * fq_;
        unsigned char* o = WSP(unsigned char, WS_H2) + (size_t)r_ * D + 8 * fq_;
#pragma unroll 1
        for (int kb = 0; kb < 8; ++kb) {
            u32x4 xa[4];
#pragma unroll
            for (int i = 0; i < 4; ++i) xa[i] = *(const u32x4*)(xr_ + 32 * (4 * kb + i));
#pragma unroll
            for (int i = 0; i < 4; ++i) { const int k0 = 32 * (4 * kb + i) + 8 * fq_; f32x4 a0, a1; unpack8v(xa[i], a0, a1);
                const f32x4 h0 = a0 * rinv * *(const LAS f32x4*)(gsL + k0) + *(const LAS f32x4*)(shL + k0), h1 = a1 * rinv * *(const LAS f32x4*)(gsL + k0 + 4) + *(const LAS f32x4*)(shL + k0 + 4);
                *(u32x2*)(o + 32 * (4 * kb + i)) = pack8_fp8(h0, h1); }
        }
    }
    if (F.lane < 16) {
        const int t = row0 + F.lane; const LAS float* lw = lgt + (F.wave * 16 + F.lane) * 37;
        float lg[36];
#pragma unroll
        for (int jj = 0; jj < 36; ++jj) lg[jj] = lw[jj];
        int gi = 0; float gm = lg[0];
#pragma unroll
        for (int i = 1; i < 4; ++i) if (lg[i] > gm) { gm = lg[i]; gi = i; }
        float den = 0.f;
#pragma unroll
        for (int i = 0; i < 4; ++i) den += __expf(lg[i] - gm);
        const float gw_ = 1.f / den;
        float v1 = -INFINITY, v2 = -INFINITY; int e1 = 0, e2 = 0;
#pragma unroll
        for (int i = 0; i < 8; ++i) { const float el = (gi == 0) ? lg[4 + i] : (gi == 1) ? lg[12 + i] : (gi == 2) ? lg[20 + i] : lg[28 + i];
            const bool c1 = el > v1, c2 = el > v2;
            v2 = c1 ? v1 : (c2 ? el : v2); e2 = c1 ? e1 : (c2 ? i : e2); v1 = c1 ? el : v1; e1 = c1 ? i : e1; }
        const float p1 = 1.f / (1.f + __expf(v2 - v1)), p2 = 1.f - p1;
        const int id1 = gi * 8 + e1, id2 = gi * 8 + e2;
        const int la = 2 * (F.wave * 16 + F.lane);
        eidL[la] = id1; eidL[la + 1] = id2; ewL[la] = p1 * gw_; ewL[la + 1] = p2 * gw_;
        lds_add(&cnt[id1], 1); lds_add(&cnt[id2], 1);
    }
    __syncthreads();
    if (F.tid < 32) { baseL[F.tid] = (int)__hip_atomic_fetch_add(WSP(unsigned, WS_CTL) + CW_GCNT + 64 * F.tid, (unsigned)cnt[F.tid], __ATOMIC_RELAXED, __HIP_MEMORY_SCOPE_AGENT); runL[F.tid] = 0; }
    __syncthreads();
    if (F.tid < 256) { const int e = eidL[F.tid]; const int pos = baseL[e] + lds_add(&runL[e], 1);
        WSP(int, WS_LINFO)[(size_t)e * 65536 + pos] = 2 * (blockIdx.x * 128) + F.tid; WSP(float, WS_LW)[(size_t)e * 65536 + pos] = ewL[F.tid]; }
    __syncthreads();
    convert_items(F, X_NONEXP, X_W2, blockIdx.x * NWAVES + F.wave, F.G * NWAVES);
}

__device__ __forceinline__ void s7_lists(Frame& F) {
    LAS int* sm = (LAS int*)F.lds;
    const int* bc = WSP(int, WS_BCNT);
    if (F.tid < 32) { int tot = 0, base = 0; for (int bb = 0; bb < 256; ++bb) { const int c = bc[bb * 32 + F.tid]; if (bb < (int)blockIdx.x) base += c; tot += c; }
        sm[F.tid] = tot; sm[32 + F.tid] = base; sm[96 + F.tid] = 0; }
    __syncthreads();
    if (F.tid == 0) { int ps = 0; for (int e = 0; e < 32; ++e) { sm[64 + e] = ps; ps += (sm[e] + 255) & ~255; }
        if (blockIdx.x == 0) { int* te = WSP(int, WS_TILEE); int pm = 0; for (int e = 0; e < 32; ++e) { const int n = (sm[e] + 255) >> 8; for (int i = 0; i < n; ++i) te[1 + pm++] = e; } te[0] = pm; } }
    __syncthreads();
    int* atok = WSP(int, WS_ATOK); int* ainfo = WSP(int, WS_AINFO); float* aw = WSP(float, WS_AW);
    if (F.tid < 256) { const int a = blockIdx.x * 256 + F.tid;
        const int e = WSP(int, WS_EID)[a]; const int rank = lds_add(&sm[96 + e], 1); const int pos = sm[64 + e] + sm[32 + e] + rank;
        atok[pos] = a >> 1; ainfo[pos] = a; aw[pos] = WSP(float, WS_EW)[a]; }
    if (blockIdx.x < 32) { const int e = blockIdx.x; const int lo = sm[64 + e] + sm[e], hi = sm[64 + e] + ((sm[e] + 255) & ~255);
        for (int p = lo + F.tid; p < hi; p += NTHREADS) { atok[p] = 0; ainfo[p] = -1; aw[p] = 0.f; } }
}

struct RowsGather { const bf16_t* base; const int* idx; __device__ __forceinline__ const bf16_t* operator()(int r) const { return base + (size_t)idx[r] * 1024; } };
__device__ __forceinline__ void s8_simple(Frame& F) {
    LAS float* tile = (LAS float*)F.lds; LAS float* tile2 = tile + 64 * 65;
    const int* te = WSP(int, WS_TILEE); const int nmt = te[0];
    const int row = F.tid >> 3, seg = F.tid & 7;
    for (int it = blockIdx.x; it < nmt * 4 * 8; it += F.G) {
        const int rt = it >> 3, ct = it & 7, e = te[1 + (rt >> 2)], pos0 = 64 * rt, hc = 64 * ct;
        const RowsGather ar{WSP(bf16_t, WS_H2), WSP(int, WS_ATOK) + pos0};
        const bf16_t* wb = WSP(bf16_t, WS_W13_T) + ((size_t)e * 1024 + 256 * (hc >> 7) + (hc & 127)) * 1024;
        const RowsLinear b1{wb, 1024}, b3{wb + (size_t)128 * 1024, 1024};
        sgemm_tile(tile, 1024, ar, b1, F.wave, F.lane); sgemm_tile(tile2, 1024, ar, b3, F.wave, F.lane); __syncthreads();
        const float wt = WSP(float, WS_AW)[pos0 + row]; float v[8];
#pragma unroll
        for (int e8 = 0; e8 < 8; ++e8) { const float a = tile[row * 65 + 8 * seg + e8], c = tile2[row * 65 + 8 * seg + e8]; v[e8] = (a / (1.f + __expf(-a))) * c * wt; }
        *(u32x4*)(WSP(bf16_t, WS_HID) + (size_t)(pos0 + row) * 512 + hc + 8 * seg) = pack8(v);
        __syncthreads();
    }
}
__device__ __forceinline__ void s9_simple(Frame& F) {
    LAS float* tile = (LAS float*)F.lds;
    const int* te = WSP(int, WS_TILEE); const int nmt = te[0];
    const int row = F.tid >> 3, seg = F.tid & 7;
    for (int it = blockIdx.x; it < nmt * 4 * 16; it += F.G) {
        const int rt = it >> 4, ct = it & 15, e = te[1 + (rt >> 2)], pos0 = 64 * rt;
        const RowsLinear ar{WSP(bf16_t, WS_HID) + (size_t)pos0 * 512, 512};
        const RowsLinear br{WSP(bf16_t, WS_W2_T) + ((size_t)e * 1024 + 64 * ct) * 512, 512};
        sgemm_tile(tile, 512, ar, br, F.wave, F.lane); __syncthreads();
        const int info = WSP(int, WS_AINFO)[pos0 + row];
        if (info >= 0) { float v[8];
#pragma unroll
            for (int e8 = 0; e8 < 8; ++e8) v[e8] = tile[row * 65 + 8 * seg + e8];
            *(u32x4*)(WSP(bf16_t, WS_YSLOT) + (size_t)info * 1024 + 64 * ct + 8 * seg) = pack8(v); }
        __syncthreads();
    }
}
__device__ __forceinline__ void s10_combine(Frame& F) {
    const bf16_t* Y = WSP(bf16_t, WS_YSLOT); const bf16_t* X1 = WSP(bf16_t, WS_X1);
    const int stride = F.G * NTHREADS;
    for (int i0 = blockIdx.x * NTHREADS + F.tid; i0 < T * 128; i0 += 2 * stride) {
        u32x4 ya[2], yb[2], xx[2]; f32x4 g0[2], g1[2];
#pragma unroll
        for (int q = 0; q < 2; ++q) { const int i = i0 + q * stride; const int t = i >> 7, c0 = (i & 127) * 8, b = t / S;
            ya[q] = __builtin_nontemporal_load((const u32x4*)(Y + (size_t)(2 * t) * 1024 + c0)); yb[q] = __builtin_nontemporal_load((const u32x4*)(Y + (size_t)(2 * t + 1) * 1024 + c0)); xx[q] = __builtin_nontemporal_load((const u32x4*)(X1 + (size_t)t * D + c0));
            const float* ga2 = WSP(float, WS_MOD) + (size_t)b * NMOD + 5120 + c0; g0[q] = *(const f32x4*)ga2; g1[q] = *(const f32x4*)(ga2 + 4); }
#pragma unroll
        for (int q = 0; q < 2; ++q) { const int i = i0 + q * stride; const int t = i >> 7, c0 = (i & 127) * 8;
            f32x4 y0a, y0b, y1a, y1b, xa, xb; unpack8v(ya[q], y0a, y0b); unpack8v(yb[q], y1a, y1b); unpack8v(xx[q], xa, xb);
            float* o = F.out + (size_t)t * D + c0;
            __builtin_nontemporal_store(xa + g0[q] * (y0a + y1a), (f32x4*)o); __builtin_nontemporal_store(xb + g1[q] * (y0b + y1b), (f32x4*)(o + 4)); }
    }
}

constexpr int N_PHASES = 11;
struct Args { const float* in[21]; float* out; unsigned char* ws; int ph_lo, ph_hi; };
__global__ void __launch_bounds__(NTHREADS, 2) mega_fwd(Args args) {
    extern __shared__ __attribute__((aligned(16))) unsigned char lds_raw[];
    Frame F;
    F.lds = (LAS unsigned char*)lds_raw;
    F.tid = threadIdx.x; F.lane = F.tid & 63; F.wave = __builtin_amdgcn_readfirstlane(F.tid >> 6); F.G = gridDim.x;
    F.x = args.in[0]; F.c = args.in[1]; F.w_ada = args.in[2]; F.b_ada = args.in[3]; F.g1 = args.in[4]; F.g2 = args.in[5]; F.w_in = args.in[6]; F.g_q = args.in[7]; F.g_k = args.in[8];
    F.conv_w = args.in[9]; F.conv_b = args.in[10]; F.w_pa = args.in[11]; F.w_pb = args.in[12]; F.w_o = args.in[13]; F.w_rg = args.in[14]; F.b_rg = args.in[15]; F.w_re = args.in[16]; F.b_re = args.in[17];
    F.w1 = args.in[18]; F.w3 = args.in[19]; F.w2 = args.in[20]; F.out = args.out; F.ws = args.ws;
    volatile LAS unsigned* MISC = (volatile LAS unsigned*)(F.lds + MISC_OFF);
    if (F.tid < 64) MISC[F.tid] = 0u;
    __syncthreads();
    XcdBarrier bar = xcd_barrier_post((unsigned*)(F.ws + WS_CTL) + CW_BAR, MISC + 8);
    const int lo = args.ph_lo, hi = args.ph_hi;
    unsigned long long pst0 = 0, pst1 = 0;
#define PHASE(k, body) if (lo <= (k) && (k) < hi) { if (PROBE_PHASE == (k)) pst0 = __builtin_amdgcn_s_memrealtime(); for (int rep_ = 0; rep_ < 1 + ((REPEAT_MASK >> (k)) & 1); ++rep_) { { int t_ = threadIdx.x; asm volatile("" : "+v"(t_)); F.tid = t_; F.lane = t_ & 63; } body; __syncthreads(); } if ((k) + 1 < hi) xcd_barrier(bar); if (PROBE_PHASE == (k)) pst1 = __builtin_amdgcn_s_memrealtime(); }
    PHASE(0, s0_prologue(F); wait_mod(F); s1_norm1(F))
    PHASE(2, s2_fast(F))
    PHASE(3, s3_fast(F, (char*)lds_raw))
    PHASE(4, s4_fast(F))
    PHASE(5, s5_fast(F))
    PHASE(6, s6_router(F))
    PHASE(8, s8_fast(F))
    PHASE(9, s9_fast(F))
    PHASE(10, s10_combine(F))
#undef PHASE
    if (PROBE_PHASE >= 0 && blockIdx.x == 0) { const unsigned long long t0 = __builtin_amdgcn_s_memrealtime(), dt = pst1 - pst0; while (__builtin_amdgcn_s_memrealtime() - t0 < dt) __builtin_amdgcn_s_sleep(8); }
}

extern "C" void kernel_launch(void* const* d_in, const int* in_sizes, int n_in, void* d_out, int out_size, void* d_ws, size_t ws_size, hipStream_t stream) {
    static int grid = 0;
    if (grid == 0) {
        if (n_in != 21 || in_sizes[0] != T * D || out_size != T * D || ws_size < WS_END) { fprintf(stderr, "kernel_launch: unexpected shapes (n_in %d, in0 %d, out %d, ws %zu); nothing launched\n", n_in, n_in > 0 ? in_sizes[0] : -1, out_size, ws_size); grid = -1; return; }
        int dev = 0, cus = 0, per_cu = 0;
        if (hipGetDevice(&dev) != hipSuccess || hipDeviceGetAttribute(&cus, hipDeviceAttributeMultiprocessorCount, dev) != hipSuccess) { grid = -1; return; }
        if (hipFuncSetAttribute((const void*)mega_fwd, hipFuncAttributeMaxDynamicSharedMemorySize, LDS_BYTES) != hipSuccess) { fprintf(stderr, "kernel_launch: hipFuncSetAttribute failed\n"); grid = -1; return; }
        if (hipOccupancyMaxActiveBlocksPerMultiprocessor(&per_cu, (const void*)mega_fwd, NTHREADS, LDS_BYTES) != hipSuccess || per_cu < 1) { fprintf(stderr, "kernel_launch: occupancy query says %d blocks per CU\n", per_cu); per_cu = 1; }
        (void)hipGetLastError();
        if (cus < 256) { fprintf(stderr, "kernel_launch: built for a 256-CU device, found %d CUs; nothing launched\n", cus); grid = -1; return; }
        grid = 256;
    }
    if (grid < 0) return;
    (void)hipMemsetAsync((char*)d_ws + WS_CTL, 0, CTL_ZERO_BYTES, stream);
    Args a{};
    for (int i = 0; i < 21; ++i) a.in[i] = (const float*)d_in[i];
    a.out = (float*)d_out; a.ws = (unsigned char*)d_ws; a.ph_lo = 0; a.ph_hi = N_PHASES;
    hipLaunchKernelGGL(mega_fwd, dim3(grid), dim3(NTHREADS), LDS_BYTES, stream, a);
}
```

```cpp
#include <hip/hip_runtime.h>
#include <hip/hip_bf16.h>
#include <cstdio>
#include <cstdint>

#ifndef REPEAT_MASK
#define REPEAT_MASK 0
#define NOEPI_MASK 0
#endif
#ifndef PROBE_PHASE
#define PROBE_PHASE -1
#endif
#define GAS __attribute__((address_space(1)))
#define LAS __attribute__((address_space(3)))
typedef unsigned short bf16_t;
typedef short bf16x8 __attribute__((ext_vector_type(8)));
typedef float f32x4 __attribute__((ext_vector_type(4)));
typedef unsigned u32x4 __attribute__((ext_vector_type(4)));
typedef unsigned u32x2 __attribute__((ext_vector_type(2)));

constexpr int T = 32768, D = 1024, NB = 8, S = 4096, NH = 8, DH = 64, NIN = 5120, NE = 32, DE = 512, NMOD = 6144;
constexpr int NTHREADS = 512, NWAVES = 8;
constexpr float EPS = 1e-6f;
constexpr float C2 = 0.125f * 1.4426950408889634f;
constexpr int MAX_MT = 288;
constexpr int NPAD = MAX_MT * 256;

constexpr size_t MiB = 1u << 20, KiB = 1024;
constexpr size_t WS_CTL = 0, CTL_ZERO_BYTES = 64 * KiB;
constexpr size_t WS_MOD = 1 * MiB;
constexpr size_t WS_ROPE = 1 * MiB + 256 * KiB;
constexpr size_t WS_KMEAN = 1 * MiB + 512 * KiB;
constexpr size_t WS_EID = 2 * MiB;
constexpr size_t WS_EW = 2 * MiB + 256 * KiB;
constexpr size_t WS_BCNT = 2 * MiB + 512 * KiB;
constexpr size_t WS_TILEE = 2 * MiB + 768 * KiB;
constexpr size_t WS_ATOK = 3 * MiB;
constexpr size_t WS_AINFO = 3 * MiB + 512 * KiB;
constexpr size_t WS_AW = 4 * MiB;
constexpr size_t WS_W36T = 5 * MiB;
constexpr size_t WS_WIN_T = 8 * MiB;
constexpr size_t WS_WIN8 = 14 * MiB;
constexpr size_t WS_H8 = 56 * MiB;
constexpr size_t WS_WP_T = 18 * MiB;
constexpr size_t WS_WO_T = 20 * MiB;
constexpr size_t WS_W13_T = 24 * MiB;
constexpr size_t WS_W2_T = 88 * MiB;
constexpr size_t WS_H = 120 * MiB;
constexpr size_t WS_YAB = 184 * MiB;
constexpr size_t WS_K = 248 * MiB;
constexpr size_t WS_V = 280 * MiB;
constexpr size_t WS_U = 312 * MiB;
constexpr size_t WS_BG = 344 * MiB;
constexpr size_t WS_GATES = 376 * MiB;
constexpr size_t WS_X1 = 184 * MiB;
constexpr size_t WS_H2 = 120 * MiB;
constexpr size_t WS_HID = 248 * MiB;
constexpr size_t WS_YSLOT = 320 * MiB;
constexpr size_t WS_LINFO = 448 * MiB;
constexpr size_t WS_LW = 456 * MiB;
constexpr size_t WS_END = 504 * MiB;
constexpr int CW_BAR = 4096, CW_MODCNT = 8192, CW_GCNT = 12288;

constexpr int LDS_BYTES = 159744;
constexpr int MISC_OFF = 147456;

__device__ __forceinline__ unsigned f2bf(float f) { unsigned u = __builtin_bit_cast(unsigned, f); return (u + 0x7fffu + ((u >> 16) & 1u)) >> 16; }
__device__ __forceinline__ float bf2f(unsigned h) { return __builtin_bit_cast(float, h << 16); }
typedef float f32x2_h __attribute__((ext_vector_type(2)));
typedef __bf16 bf16x2_h __attribute__((ext_vector_type(2)));
__device__ __forceinline__ unsigned pk2(float lo, float hi) { const f32x2_h v = {lo, hi}; return __builtin_bit_cast(unsigned, __builtin_convertvector(v, bf16x2_h)); }
__device__ __forceinline__ void unpack8(const u32x4 w, float (&v)[8]) {
    v[0] = bf2f(w.x & 0xffffu); v[1] = bf2f(w.x >> 16); v[2] = bf2f(w.y & 0xffffu); v[3] = bf2f(w.y >> 16);
    v[4] = bf2f(w.z & 0xffffu); v[5] = bf2f(w.z >> 16); v[6] = bf2f(w.w & 0xffffu); v[7] = bf2f(w.w >> 16);
}
__device__ __forceinline__ u32x4 pack8(const float (&v)[8]) { u32x4 w; w.x = pk2(v[0], v[1]); w.y = pk2(v[2], v[3]); w.z = pk2(v[4], v[5]); w.w = pk2(v[6], v[7]); return w; }
__device__ __forceinline__ u32x4 pack8v(const f32x4 a, const f32x4 b) { u32x4 w; w.x = pk2(a.x, a.y); w.y = pk2(a.z, a.w); w.z = pk2(b.x, b.y); w.w = pk2(b.z, b.w); return w; }
__device__ __forceinline__ void unpack8v(const u32x4 w, f32x4& a, f32x4& b) {
    a.x = bf2f(w.x & 0xffffu); a.y = bf2f(w.x >> 16); a.z = bf2f(w.y & 0xffffu); a.w = bf2f(w.y >> 16);
    b.x = bf2f(w.z & 0xffffu); b.y = bf2f(w.z >> 16); b.z = bf2f(w.w & 0xffffu); b.w = bf2f(w.w >> 16); }
#ifndef WT_STORES
#define WT_STORES 0
#endif
__device__ __forceinline__ void st16(void* p, const u32x4 v) {
#if WT_STORES
    asm volatile("global_store_dwordx4 %0, %1, off sc1\n\ts_nop 1" :: "v"(p), "v"(v) : "memory");
#else
    *(u32x4*)p = v;
#endif
}
typedef int i32x8 __attribute__((ext_vector_type(8)));
__device__ __forceinline__ u32x2 pack8_fp8(const f32x4 a, const f32x4 b) {
    int lo = 0, hi = 0;
    lo = __builtin_amdgcn_cvt_pk_fp8_f32(a.x, a.y, lo, false); lo = __builtin_amdgcn_cvt_pk_fp8_f32(a.z, a.w, lo, true);
    hi = __builtin_amdgcn_cvt_pk_fp8_f32(b.x, b.y, hi, false); hi = __builtin_amdgcn_cvt_pk_fp8_f32(b.z, b.w, hi, true);
    return (u32x2){(unsigned)lo, (unsigned)hi};
}
constexpr float W8_SCALE = 64.f;
#define LDS_WAIT() asm volatile("s_waitcnt lgkmcnt(0)" ::: "memory")
__device__ __forceinline__ int lds_add(LAS int* p, int v) { return __hip_atomic_fetch_add(p, v, __ATOMIC_RELAXED, __HIP_MEMORY_SCOPE_WORKGROUP); }

#define XB_TMO      128
#define XB_XCNT(j)  (256  + 64 * (j))
#define XB_XSUB(j)  (1280 + 64 * (j))
#define XB_XGEN(j)  (2304 + 64 * (j))
#define XB_TOP      3328
#define XB_TOPGEN   3392
#define XCD_BAR_WORDS 3456
#define XB_SPIN_CAP (1u << 22)
__device__ __forceinline__ unsigned xb_ld(unsigned* p)              { return __hip_atomic_load(p, __ATOMIC_RELAXED, __HIP_MEMORY_SCOPE_AGENT); }
__device__ __forceinline__ unsigned xb_add(unsigned* p, unsigned v) { return __hip_atomic_fetch_add(p, v, __ATOMIC_RELAXED, __HIP_MEMORY_SCOPE_AGENT); }
__device__ __forceinline__ unsigned xb_xcc_id() { return (unsigned)__builtin_amdgcn_s_getreg((3 << 11) | 20) & 0xFu; }
#define XB_SPIN(cond, bar) do { unsigned _sp = 0; while (cond) { __builtin_amdgcn_s_sleep(1); \
    if ((++_sp & 255u) == 0u) { if (xb_ld(&(bar)[XB_TMO])) break; if (_sp > XB_SPIN_CAP) { atomicAdd(&(bar)[XB_TMO], 1u); break; } } } } while (0)
struct XcdBarrier { unsigned* bar; unsigned x; volatile LAS unsigned* st; };
__device__ __forceinline__ XcdBarrier xcd_barrier_post(unsigned* bar, volatile LAS unsigned* st) {
    XcdBarrier b; b.bar = bar; b.x = xb_xcc_id(); b.st = st;
    if (threadIdx.x == 0) (void)xb_add(&bar[XB_XCNT(b.x)], 1u);
    return b;
}
__device__ __forceinline__ void xcd_barrier_complete(unsigned* bar, unsigned x, unsigned& nloc, unsigned& nx) {
    const unsigned G = gridDim.x * gridDim.y * gridDim.z;
    unsigned sum, cnt, mine, sp = 0u;
    for (;;) {
        sum = 0u; cnt = 0u; mine = 0u;
#pragma unroll
        for (unsigned j = 0; j < 16; ++j) { const unsigned c = xb_ld(&bar[XB_XCNT(j)]); sum += c; cnt += (c > 0u) ? 1u : 0u; mine = (j == x) ? c : mine; }
        if (sum == G) break;
        __builtin_amdgcn_s_sleep(1);
        if ((++sp & 255u) == 0u) { if (xb_ld(&bar[XB_TMO])) break; if (sp > XB_SPIN_CAP) { atomicAdd(&bar[XB_TMO], 1u); break; } }
    }
    nloc = mine > 0u ? mine : 1u; nx = cnt > 0u ? cnt : 1u;
}
__device__ __forceinline__ void xcd_barrier(const XcdBarrier& b) {
    asm volatile("s_waitcnt vmcnt(0)" ::: "memory");
    __syncthreads();
    if (threadIdx.x == 0) {
        unsigned* bar = b.bar;
        __builtin_amdgcn_s_waitcnt(0);
        unsigned nloc = b.st[0], nx = b.st[1];
        if (nloc == 0u) { xcd_barrier_complete(bar, b.x, nloc, nx); b.st[0] = nloc; b.st[1] = nx; }
        const unsigned old = xb_add(&bar[XB_XSUB(b.x)], 1u);
        const unsigned gen = old / nloc;
        if (old + 1u == (gen + 1u) * nloc) {
            __builtin_amdgcn_fence(__ATOMIC_RELEASE, "agent");
            asm volatile("s_waitcnt vmcnt(0)" ::: "memory");
            const unsigned og = xb_add(&bar[XB_TOP], 1u);
            const unsigned tg = og / nx;
            if (og + 1u == (tg + 1u) * nx) xb_add(&bar[XB_TOPGEN], 1u);
            else XB_SPIN(xb_ld(&bar[XB_TOPGEN]) == tg, bar);
            __builtin_amdgcn_fence(__ATOMIC_ACQUIRE, "agent");
            xb_add(&bar[XB_XGEN(b.x)], 1u);
            asm volatile("s_waitcnt vmcnt(0)" ::: "memory");
        } else {
            XB_SPIN(xb_ld(&bar[XB_XGEN(b.x)]) == gen, bar);
            __builtin_amdgcn_fence(__ATOMIC_ACQUIRE, "agent");
            asm volatile("s_waitcnt vmcnt(0)" ::: "memory");
        }
    }
    __syncthreads();
}

struct Frame {
    LAS unsigned char* lds;
    int tid, lane, wave, G, skip;
    const float *x, *c, *w_ada, *b_ada, *g1, *g2, *w_in, *g_q, *g_k, *conv_w, *conv_b, *w_pa, *w_pb, *w_o, *w_rg, *b_rg, *w_re, *b_re, *w1, *w3, *w2;
    float* out; unsigned char* ws;
};
#define WSP(type, off) ((type*)(F.ws + (off)))

struct XItem { const float* src; unsigned char* dst; int N, pitch, fp8, swz; };
__device__ __forceinline__ void xitem_load(const XItem& it, f32x4 (&v)[8], int lane) {
    const int r8 = lane >> 3, c4 = lane & 7;
#pragma unroll
    for (int i = 0; i < 8; ++i) v[i] = __builtin_nontemporal_load((const f32x4*)(it.src + (size_t)(8 * i + r8) * it.N + 4 * c4));
}
__device__ __forceinline__ void xitem_store(const XItem& it, const f32x4 (&v)[8], LAS float* scr, int lane) {
    const int r8 = lane >> 3, c4 = lane & 7; const float scale = it.fp8 ? W8_SCALE : 1.f;
#pragma unroll
    for (int i = 0; i < 8; ++i) { LAS float* p = scr + (8 * i + r8) * 33 + 4 * c4; p[0] = v[i].x * scale; p[1] = v[i].y * scale; p[2] = v[i].z * scale; p[3] = v[i].w * scale; }
    LDS_WAIT(); asm volatile("" ::: "memory");
    if (it.fp8) {
        const int n = lane >> 1, kh = lane & 1; const LAS float* sp = scr + (32 * kh) * 33 + n;
#pragma unroll
        for (int p = 0; p < 2; ++p) { u32x4 o;
#pragma unroll
            for (int w = 0; w < 4; ++w) { const LAS float* q = sp + (16 * p + 4 * w) * 33; int x = 0;
                x = __builtin_amdgcn_cvt_pk_fp8_f32(q[0], q[33], x, false); x = __builtin_amdgcn_cvt_pk_fp8_f32(q[66], q[99], x, true); o[w] = (unsigned)x; }
            *(u32x4*)(it.dst + (size_t)n * it.pitch + 32 * kh + 16 * p) = o; }
    } else {
        const int c = lane & 7;
#pragma unroll
        for (int j = 0; j < 4; ++j) { const int n = (lane >> 3) + 8 * j; const LAS float* q = scr + (8 * c) * 33 + n;
            u32x4 o; o.x = pk2(q[0 * 33], q[1 * 33]); o.y = pk2(q[2 * 33], q[3 * 33]); o.z = pk2(q[4 * 33], q[5 * 33]); o.w = pk2(q[6 * 33], q[7 * 33]);
            const int nd = (it.swz && ((n >> 2) == 1 || (n >> 2) == 2)) ? (n ^ 12) : n;
            *(u32x4*)(it.dst + ((size_t)nd * it.pitch + 8 * c) * 2) = o; }
    }
    LDS_WAIT(); asm volatile("" ::: "memory");
}
__device__ __forceinline__ int win_dest_row(int sc) {
    if (sc < 32) { const int isk = sc >> 4, s2 = sc & 15, hh = s2 >> 1, bj = s2 & 1; return 512 * isk + 256 * (hh >> 2) + 128 * bj + 32 * (hh & 3); }
    if (sc < 48) return 0;
    if (sc < 64) { const int cx = 32 * (sc - 48); return 256 * (4 + (cx >> 7)) + (cx & 127); }
    if (sc < 80) return 2048 + 32 * (sc - 64);
    if (sc < 96) { const int cx = 32 * (sc - 80); return 256 * (4 + (cx >> 7)) + 128 + (cx & 127); }
    return 3072 + 32 * (sc - 96);
}
constexpr int X_NONEXP = 16 * 160 + 2 * (8 * 32) + 16 * 32, X_W2 = X_NONEXP + NE * 512, X_END = X_W2 + NE * 256;
__device__ __forceinline__ void convert_items(Frame& F, const int item_lo, const int item_hi, const int gw, const int NGW) {
    LAS float* scr = (LAS float*)(F.lds + F.wave * 16384);
    constexpr int I_IN = 16 * 160, I_PA = 8 * 32, I_O = 16 * 32, I_E1 = 16 * 16, I_E2 = 8 * 32;
    constexpr int NITEMS = I_IN + 2 * I_PA + I_O + NE * (2 * I_E1 + I_E2);
    auto decode = [&](int r) -> XItem {
        XItem x; x.swz = 0;
        if (r < I_IN) { const int kb = r / 160, sc = r % 160; x.src = F.w_in + (size_t)(64 * kb) * NIN + 32 * sc; x.N = NIN; x.pitch = 1024; x.swz = (sc < 32 && !(sc & 1)) ? 1 : 0;
            if (sc < 96 && !(sc >= 32 && sc < 48)) { x.fp8 = 0; x.dst = (unsigned char*)(WSP(bf16_t, WS_WIN_T) + (size_t)win_dest_row(sc) * 1024 + 64 * kb); }
            else { x.fp8 = 1; const int g = 32 * (sc - 96), cx = g & 1023;
                x.dst = WSP(unsigned char, WS_WIN8) + (size_t)(sc >= 96 ? 256 * (cx >> 7) + (g >= 1024 ? 128 : 0) + (cx & 127) : 2048 + 32 * (sc - 32)) * 1024 + 64 * kb; }
            return x; } r -= I_IN;
        if (r < I_PA) { const int kb = r / 32, sc = r % 32; x.src = F.w_pa + (size_t)(64 * kb) * 1024 + 32 * sc; x.N = 1024; x.pitch = 1024; x.fp8 = 0; x.dst = (unsigned char*)(WSP(bf16_t, WS_WP_T) + (size_t)(32 * sc) * 1024 + 64 * kb); return x; } r -= I_PA;
        if (r < I_PA) { const int kb = r / 32, sc = r % 32; x.src = F.w_pb + (size_t)(64 * kb) * 1024 + 32 * sc; x.N = 1024; x.pitch = 1024; x.fp8 = 0; x.dst = (unsigned char*)(WSP(bf16_t, WS_WP_T) + (size_t)(32 * sc) * 1024 + 512 + 64 * kb); return x; } r -= I_PA;
        if (r < I_O) { const int kb = r / 32, sc = r % 32; x.src = F.w_o + (size_t)(64 * kb) * 1024 + 32 * sc; x.N = 1024; x.pitch = 1024; x.fp8 = 0; x.dst = (unsigned char*)(WSP(bf16_t, WS_WO_T) + (size_t)(32 * sc) * 1024 + 64 * kb); return x; } r -= I_O;
        x.fp8 = 1;
        if (r < NE * 2 * I_E1) { const int e = r / (2 * I_E1); r -= e * (2 * I_E1); const int is3 = r >= I_E1; if (is3) r -= I_E1; const int kb = r / 16, sc = r % 16;
            x.src = (is3 ? F.w3 : F.w1) + (size_t)e * D * DE + (size_t)(64 * kb) * DE + 32 * sc; x.N = DE; x.pitch = 1024;
            x.dst = WSP(unsigned char, WS_W13_T) + ((size_t)e * 1024 + 256 * (sc >> 2) + 128 * is3 + 32 * (sc & 3)) * 1024 + 64 * kb; return x; }
        r -= NE * 2 * I_E1;
        { const int e = r / I_E2; r -= e * I_E2; const int kb = r / 32, sc = r % 32;
            x.src = F.w2 + (size_t)e * DE * D + (size_t)(64 * kb) * D + 32 * sc; x.N = D; x.pitch = 512; x.dst = WSP(unsigned char, WS_W2_T) + ((size_t)e * 1024 + 32 * sc) * 512 + 64 * kb; }
        return x;
    };
    const int ihi = (item_hi < NITEMS) ? item_hi : NITEMS;
    if (item_lo + gw < ihi) {
        XItem cur = decode(item_lo + gw); f32x4 va[8], vb[8]; xitem_load(cur, va, F.lane);
        for (int it = item_lo + gw; it < ihi; it += 2 * NGW) {
            const int n1 = it + NGW, n2 = it + 2 * NGW; XItem nx1 = cur, nx2 = cur;
            if (n1 < ihi) { nx1 = decode(n1); xitem_load(nx1, vb, F.lane); }
            xitem_store(cur, va, scr, F.lane);
            if (n1 < ihi) { if (n2 < ihi) { nx2 = decode(n2); xitem_load(nx2, va, F.lane); }
                xitem_store(nx1, vb, scr, F.lane); cur = nx2; }
        }
    }
}

__device__ __forceinline__ void s0_prologue(Frame& F) {
    if (F.tid < 256) WSP(float, WS_KMEAN)[blockIdx.x * 256 + F.tid] = 0.f;
    if (F.tid < 144) { const int gt = blockIdx.x * 144 + F.tid; const int jj = gt >> 10, k = gt & 1023; WSP(float, WS_W36T)[gt] = (jj < 4) ? F.w_rg[k * 4 + jj] : F.w_re[k * 32 + (jj - 4)]; }
    if (F.tid < 128) { const int gt = blockIdx.x * 128 + F.tid; const int pos = gt >> 3, i = gt & 7; const float inv = powf(500000.0f, -(float)(2 * i) / 16.0f); const float ang = (float)pos * inv;
        WSP(float2, WS_ROPE)[gt] = make_float2(cosf(ang), sinf(ang)); }
    if (blockIdx.x < 192) {
        LAS float* sc = (LAS float*)F.lds;
        for (int i = F.tid; i < NB * D; i += NTHREADS) { const float v = F.c[i]; sc[i] = v / (1.f + expf(-v)); }
        __syncthreads();
        const int j0 = blockIdx.x * 32, col = j0 + (F.lane & 31), kpar = F.lane >> 5;
        float acc[8];
#pragma unroll
        for (int b = 0; b < 8; ++b) acc[b] = 0.f;
#pragma unroll
        for (int i0 = 0; i0 < 64; i0 += 32) { float wv[32];
#pragma unroll
            for (int i = 0; i < 32; ++i) wv[i] = F.w_ada[(size_t)(F.wave * 128 + 2 * (i0 + i) + kpar) * NMOD + col];
#pragma unroll
            for (int i = 0; i < 32; ++i) { const int k = F.wave * 128 + 2 * (i0 + i) + kpar;
#pragma unroll
                for (int b = 0; b < 8; ++b) acc[b] += sc[b * D + k] * wv[i]; } }
#pragma unroll
        for (int b = 0; b < 8; ++b) acc[b] += __shfl_xor(acc[b], 32);
        LAS float* red = (LAS float*)(F.lds + 32768);
        if (F.lane < 32) {
#pragma unroll
            for (int b = 0; b < 8; ++b) red[(F.wave * 8 + b) * 32 + F.lane] = acc[b]; }
        __syncthreads();
        if (F.tid < 256) { const int b = F.tid >> 5, cc = F.tid & 31; float s = F.b_ada[j0 + cc];
#pragma unroll
            for (int w = 0; w < 8; ++w) s += red[(w * 8 + b) * 32 + cc];
            WSP(float, WS_MOD)[b * NMOD + j0 + cc] = s; }
        asm volatile("s_waitcnt vmcnt(0)" ::: "memory");
        __syncthreads();
        if (F.tid == 0) { __builtin_amdgcn_fence(__ATOMIC_RELEASE, "agent"); asm volatile("s_waitcnt vmcnt(0)" ::: "memory");
            __hip_atomic_fetch_add(WSP(unsigned, WS_CTL) + CW_MODCNT, 1u, __ATOMIC_RELAXED, __HIP_MEMORY_SCOPE_AGENT); }
    }
    convert_items(F, 0, X_NONEXP, F.G * NWAVES - 1 - (blockIdx.x * NWAVES + F.wave), F.G * NWAVES);
}

__device__ __forceinline__ void wait_mod(Frame& F) {
    if (F.tid == 0) { unsigned* c = WSP(unsigned, WS_CTL) + CW_MODCNT; unsigned sp = 0;
        while (__hip_atomic_load(c, __ATOMIC_RELAXED, __HIP_MEMORY_SCOPE_AGENT) < 192u) { __builtin_amdgcn_s_sleep(2); if (++sp > (1u << 24)) break; }
        __builtin_amdgcn_fence(__ATOMIC_ACQUIRE, "agent"); asm volatile("s_waitcnt vmcnt(0)" ::: "memory"); }
    __syncthreads();
}
template <int N> __device__ __forceinline__ float dpp_ror(float v) { return __builtin_bit_cast(float, __builtin_amdgcn_update_dpp(0, __builtin_bit_cast(int, v), 0x120 + N, 0xF, 0xF, false)); }
__device__ __forceinline__ float xrow16_sum(float x) {
    float a = x, b = x;
    asm volatile("s_nop 1\n\tv_permlane16_swap_b32 %0, %1" : "+v"(a), "+v"(b));
    a += b; b = a;
    asm volatile("s_nop 1\n\tv_permlane32_swap_b32 %0, %1" : "+v"(a), "+v"(b));
    return a + b;
}
__device__ __forceinline__ float wave_sum(float v) {
#pragma unroll
    for (int o = 1; o < 64; o <<= 1) v += __shfl_xor(v, o);
    return v;
}
__device__ __forceinline__ void s1_norm1(Frame& F) {
    const int gw = blockIdx.x * NWAVES + F.wave;
    const int row0 = gw * 16, b = row0 / S;
    if (row0 >= T) return;
    const float* mod = WSP(float, WS_MOD) + (size_t)b * NMOD;
    f32x4 gs[4], sh[4];
#pragma unroll
    for (int j = 0; j < 4; ++j) { const int col = 4 * F.lane + 256 * j; const f32x4 g = *(const f32x4*)(F.g1 + col), s_ = *(const f32x4*)(mod + 1024 + col); gs[j] = g * (s_ + 1.0f); sh[j] = *(const f32x4*)(mod + col); }
    for (int r = 0; r < 16; r += 4) {
        f32x4 v[4][4]; float ss[4];
#pragma unroll
        for (int q = 0; q < 4; ++q) { const float* xr = F.x + (size_t)(row0 + r + q) * D;
#pragma unroll
            for (int j = 0; j < 4; ++j) v[q][j] = __builtin_nontemporal_load((const f32x4*)(xr + 4 * F.lane + 256 * j)); }
#pragma unroll
        for (int q = 0; q < 4; ++q) { ss[q] = 0.f;
#pragma unroll
            for (int j = 0; j < 4; ++j) ss[q] += (v[q][j].x * v[q][j].x + v[q][j].y * v[q][j].y) + (v[q][j].z * v[q][j].z + v[q][j].w * v[q][j].w); }
#pragma unroll
        for (int q = 0; q < 4; ++q) { const float rinv = rsqrtf(wave_sum(ss[q]) * (1.f / D) + EPS);
            bf16_t* o = WSP(bf16_t, WS_H) + (size_t)(row0 + r + q) * D;
#pragma unroll
            for (int j = 0; j < 4; ++j) { const f32x4 h = v[q][j] * rinv * gs[j] + sh[j]; u32x2 w; w.x = pk2(h.x, h.y); w.y = pk2(h.z, h.w); *(u32x2*)(o + 4 * F.lane + 256 * j) = w;
                int p8 = 0; p8 = __builtin_amdgcn_cvt_pk_fp8_f32(h.x, h.y, p8, false); p8 = __builtin_amdgcn_cvt_pk_fp8_f32(h.z, h.w, p8, true);
                *(int*)(WSP(unsigned char, WS_H8) + (size_t)(row0 + r + q) * D + 4 * F.lane + 256 * j) = p8; } }
    }
}

struct RowsLinear { const bf16_t* base; size_t pitch; __device__ __forceinline__ const bf16_t* operator()(int r) const { return base + (size_t)r * pitch; } };
template <class AR, class BR>
__device__ __forceinline__ void sgemm_tile(LAS float* tile, int K, const AR& arow, const BR& brow, int wave, int lane) {
    const int fr = lane & 15, fq = lane >> 4, rb = 16 * (wave & 3), cb = 32 * (wave >> 2);
    const bf16_t* ap = arow(rb + fr) + 8 * fq;
    const bf16_t* bp0 = brow(cb + fr) + 8 * fq;
    const bf16_t* bp1 = brow(cb + 16 + fr) + 8 * fq;
    f32x4 acc0 = {0.f, 0.f, 0.f, 0.f}, acc1 = {0.f, 0.f, 0.f, 0.f};
#pragma unroll 4
    for (int k = 0; k < K; k += 32) {
        const bf16x8 a = *(const bf16x8*)(ap + k), b0 = *(const bf16x8*)(bp0 + k), b1 = *(const bf16x8*)(bp1 + k);
        acc0 = __builtin_amdgcn_mfma_f32_16x16x32_bf16(a, b0, acc0, 0, 0, 0);
        acc1 = __builtin_amdgcn_mfma_f32_16x16x32_bf16(a, b1, acc1, 0, 0, 0);
    }
#pragma unroll
    for (int j = 0; j < 4; ++j) { tile[(rb + fq * 4 + j) * 65 + cb + fr] = acc0[j]; tile[(rb + fq * 4 + j) * 65 + cb + 16 + fr] = acc1[j]; }
}

struct WinRowsHead { const bf16_t* base; int rb; __device__ __forceinline__ const bf16_t* operator()(int d) const { return base + (size_t)(rb + 128 * (d >> 5) + (d & 31)) * 1024; } };
__device__ __forceinline__ void s2_simple(Frame& F) {
    LAS float* tile = (LAS float*)F.lds; LAS float* tile2 = tile + 64 * 65;
    const bf16_t* H = WSP(bf16_t, WS_H); const bf16_t* WT = WSP(bf16_t, WS_WIN_T);
    const int row = F.tid >> 3, seg = F.tid & 7;
    for (int it = blockIdx.x; it < 512 * 72; it += F.G) {
        const int rt = it / 72, ct = it % 72, r0 = rt * 64, gr = r0 + row;
        const RowsLinear ar{H + (size_t)r0 * 1024, 1024};
        float v[8];
        if (ct < 16) {
            const int isk = ct >> 3, hh = ct & 7;
            const WinRowsHead br{WT, 512 * isk + 256 * (hh >> 2) + 32 * (hh & 3)};
            sgemm_tile(tile, 1024, ar, br, F.wave, F.lane); __syncthreads();
            float ss = 0.f;
#pragma unroll
            for (int e = 0; e < 8; ++e) { v[e] = tile[row * 65 + 8 * seg + e]; ss += v[e] * v[e]; }
            ss += __shfl_xor(ss, 1); ss += __shfl_xor(ss, 2); ss += __shfl_xor(ss, 4);
            const float rinv = rsqrtf(ss * (1.f / 64.f) + EPS);
            const float* g = isk ? F.g_k : F.g_q;
            const int pos = gr & (S - 1);
#pragma unroll
            for (int e = 0; e < 8; ++e) { v[e] = v[e] * rinv * g[8 * seg + e]; const float pv = __shfl_xor(v[e], 1);
                if (seg < 2) { const float2 cs = WSP(float2, WS_ROPE)[pos * 8 + e]; v[e] = (seg == 0) ? (v[e] * cs.x - pv * cs.y) : (v[e] * cs.x + pv * cs.y); } }
            if (!isk) {
#pragma unroll
                for (int e = 0; e < 8; ++e) v[e] *= C2;
                *(u32x4*)(WSP(bf16_t, WS_YAB) + (size_t)gr * 1024 + hh * 64 + 8 * seg) = pack8(v);
            } else {
                *(u32x4*)(WSP(bf16_t, WS_K) + (size_t)gr * 512 + hh * 64 + 8 * seg) = pack8(v);
#pragma unroll
                for (int e = 0; e < 8; ++e) tile[row * 65 + 8 * seg + e] = v[e];
                __syncthreads();
                if (F.tid < 64) { float s = 0.f; for (int r = 0; r < 64; ++r) s += tile[r * 65 + F.tid];
                    const int b = r0 / S, blk = (r0 & (S - 1)) >> 8;
                    atomicAdd(WSP(float, WS_KMEAN) + ((size_t)(b * NH + hh) * 16 + blk) * 64 + F.tid, s * (1.f / 256.f)); }
            }
        } else if (ct < 24) {
            const RowsLinear br{WT + (size_t)(1024 + 64 * (ct - 16)) * 1024, 1024};
            sgemm_tile(tile, 1024, ar, br, F.wave, F.lane); __syncthreads();
#pragma unroll
            for (int e = 0; e < 8; ++e) v[e] = tile[row * 65 + 8 * seg + e];
            *(u32x4*)(WSP(bf16_t, WS_V) + (size_t)gr * 512 + 64 * (ct - 16) + 8 * seg) = pack8(v);
        } else if (ct < 32) {
            const int cu = 64 * (ct - 24), rb = 256 * (6 + (cu >> 7)) + (cu & 127);
            const RowsLinear bx{WT + (size_t)rb * 1024, 1024}, bc{WT + (size_t)(rb + 128) * 1024, 1024};
            sgemm_tile(tile, 1024, ar, bx, F.wave, F.lane); sgemm_tile(tile2, 1024, ar, bc, F.wave, F.lane); __syncthreads();
#pragma unroll
            for (int e = 0; e < 8; ++e) v[e] = tile[row * 65 + 8 * seg + e] * tile2[row * 65 + 8 * seg + e];
            *(u32x4*)(WSP(bf16_t, WS_U) + (size_t)gr * 512 + cu + 8 * seg) = pack8(v);
        } else if (ct < 40) {
            const RowsLinear br{WT + (size_t)(2560 + 64 * (ct - 32)) * 1024, 1024};
            sgemm_tile(tile, 1024, ar, br, F.wave, F.lane); __syncthreads();
#pragma unroll
            for (int e = 0; e < 8; ++e) v[e] = tile[row * 65 + 8 * seg + e];
            *(u32x4*)(WSP(bf16_t, WS_BG) + (size_t)gr * 512 + 64 * (ct - 32) + 8 * seg) = pack8(v);
        } else {
            const RowsLinear br{WT + (size_t)(3072 + 64 * (ct - 40)) * 1024, 1024};
            sgemm_tile(tile, 1024, ar, br, F.wave, F.lane); __syncthreads();
#pragma unroll
            for (int e = 0; e < 8; ++e) v[e] = 1.f / (1.f + __expf(-tile[row * 65 + 8 * seg + e]));
            *(u32x4*)(WSP(bf16_t, WS_GATES) + (size_t)gr * 2048 + 64 * (ct - 40) + 8 * seg) = pack8(v);
        }
        __syncthreads();
    }
}

namespace pg8 {
constexpr int BM = 256, BK = 64, HALF = 128, HTB = HALF * BK * 2, STAGE_BYTES = 8 * HTB, NXCD = 8, WGM = 4;
constexpr int VN_STASH = 147456 + 4096;
__device__ __forceinline__ int lds_byte(int r, int c) { const int st = (r >> 4) * 2 + (c >> 5), rr = r & 15, cc = c & 31, ob = rr * 64 + cc * 2; return st * 1024 + (ob ^ (((ob >> 9) & 1) << 5)); }
__device__ __forceinline__ void stage_rc(int b, int& R, int& C) { const int st = b / 1024, sb = b % 1024, swz = sb ^ (((sb >> 9) & 1) << 5); R = (st >> 1) * 16 + swz / 64; C = (st & 1) * 32 + (swz % 64) / 2; }
__device__ __forceinline__ int perm32(int rho) { const int n = rho >> 4, i = rho & 15; return 8 * (i >> 2) + 4 * n + (i & 3); }
struct Unit { int pm, pn; const char* a; const char* b; int e, rbase; };
__device__ __forceinline__ bool static_unit(int i, int G, int c, int nM, int nN, int& pm, int& pn) {
    const int nwg = nM * nN; const long L = (long)i * G + c; if (L >= nwg) return false;
    int wgid = (int)L; { const int q = nwg / NXCD, r = nwg % NXCD, xcd = wgid % NXCD, off = wgid / NXCD; wgid = (xcd < r ? xcd * (q + 1) : r * (q + 1) + (xcd - r) * q) + off; }
    const int nig = WGM * nN, gid = wgid / nig, fm = gid * WGM, gsz = (nM - fm) < WGM ? (nM - fm) : WGM;
    pm = fm + ((wgid % nig) % gsz); pn = (wgid % nig) / gsz; return true;
}
struct DenseSched {
    static constexpr bool GATHER = false, FP8 = false;
    const char* A; const char* Bt; int nM, nN, K, G, c;
    __device__ __forceinline__ bool next(int i, Unit& u) const { if (!static_unit(i, G, c, nM, nN, u.pm, u.pn)) return false;
        u.a = A + (size_t)u.pm * BM * K * 2; u.b = Bt + (size_t)u.pn * BM * K * 2; u.e = 0; u.rbase = 0; return true; }
    __device__ __forceinline__ int row_index(const Unit&, int) const { return 0; }
};

struct DenseSched8 {
    static constexpr bool GATHER = false, FP8 = true;
    const char* A; const char* Bt; int nM, nN, K, G, c;
    __device__ __forceinline__ bool next(int i, Unit& u) const { if (!static_unit(i, G, c, nM, nN, u.pm, u.pn)) return false;
        u.a = A + (size_t)u.pm * BM * K; u.b = Bt + (size_t)u.pn * BM * K; u.e = 0; u.rbase = 0; return true; }
    __device__ __forceinline__ int row_index(const Unit&, int) const { return 0; }
};
template <class Epi, class Sched, bool skip = false>
__device__ __forceinline__ void gemm_phase(LAS unsigned char* lds, const int K, const Sched& S, const Epi& E) {
    int tid_ = threadIdx.x; asm volatile("" : "+v"(tid_));
    const int tid = tid_, wid = __builtin_amdgcn_readfirstlane(tid >> 6), lane = tid & 63, wr = wid >> 2, wc = wid & 3, fr = lane & 15, fq = lane >> 4;
    constexpr bool FP8 = Sched::FP8;
    const int nt = FP8 ? K / 128 : K / BK;
    const int PB = FP8 ? K : 2 * K;
    unsigned voffB[2], vA[2][2], vN[2][2];
#pragma unroll
    for (int i = 0; i < 2; ++i) { int R, C; stage_rc(tid * 16 + i * 8192, R, C); const int Rb = (R & ~31) + perm32(R & 31);
        voffB[i] = (unsigned)(Rb * PB + C * 2);
        vA[0][i] = (unsigned)(R * PB + C * 2); vA[1][i] = (unsigned)((HALF + R) * PB + C * 2); vN[0][i] = vA[0][i]; vN[1][i] = vA[1][i]; }
    const size_t kstep = (size_t)(BK * 2);
    const size_t hstep = (size_t)HALF * PB;
    const unsigned ldsw = (unsigned)wid * 1024u;
    const int aoff = lds_byte(wr * 64 + fr, fq * 8), boff = lds_byte(wc * 32 + fr, fq * 8);
    const int aoff8a = lds_byte(wr * 64 + fr, fq * 16), aoff8b = lds_byte(wr * 64 + fr, fq * 16 + 8), boff8a = lds_byte(wc * 32 + fr, fq * 16), boff8b = lds_byte(wc * 32 + fr, fq * 16 + 8);
#define PG8_SA(b, h) (((b) * 2 + (h)) * HTB)
#define PG8_SB(b, h) ((4 + (b) * 2 + (h)) * HTB)
#define PG8_STAGE(bufoff, gbase, voff) do { _Pragma("unroll") for (int _i = 0; _i < 2; ++_i) \
        __builtin_amdgcn_global_load_lds((const unsigned*)((const char*)(gbase) + (voff)[_i]), (LAS unsigned*)(lds + (bufoff) + ldsw + _i * 8192), 16, 0, 0); } while (0)
#define PG8_LD16(off) (*(const LAS u32x4*)(lds + (off)))
#define PG8_LDA(dst, b, h) do { _Pragma("unroll") for (int m = 0; m < 4; ++m) { if constexpr (FP8) { dst##8[m] = __builtin_bit_cast(i32x8, __builtin_shufflevector(PG8_LD16(PG8_SA(b, h) + aoff8a + m * 2048), PG8_LD16(PG8_SA(b, h) + aoff8b + m * 2048), 0, 1, 2, 3, 4, 5, 6, 7)); } \
        else { _Pragma("unroll") for (int k = 0; k < 2; ++k) dst[m][k] = *(const LAS bf16x8*)(lds + PG8_SA(b, h) + aoff + m * 2048 + k * 1024); } } } while (0)
#define PG8_LDB(dst, b, h) do { _Pragma("unroll") for (int n = 0; n < 2; ++n) { if constexpr (FP8) { dst##8[n] = __builtin_bit_cast(i32x8, __builtin_shufflevector(PG8_LD16(PG8_SB(b, h) + boff8a + n * 2048), PG8_LD16(PG8_SB(b, h) + boff8b + n * 2048), 0, 1, 2, 3, 4, 5, 6, 7)); } \
        else { _Pragma("unroll") for (int k = 0; k < 2; ++k) dst[n][k] = *(const LAS bf16x8*)(lds + PG8_SB(b, h) + boff + n * 2048 + k * 1024); } } } while (0)
#define PG8_MMA(ai, bj, At, Bt) do { __builtin_amdgcn_s_setprio(1); _Pragma("unroll") for (int m = 0; m < 4; ++m) _Pragma("unroll") for (int n = 0; n < 2; ++n) { \
        if constexpr (FP8) { asm volatile("s_nop 1\n\tv_mfma_scale_f32_16x16x128_f8f6f4 %0, %1, %2, %0, %3, %3 op_sel_hi:[0,0,0]" : "+v"(acc[ai][bj][m][n]) : "v"(Bt##8[n]), "v"(At##8[m]), "v"(sc127)); } \
        else { _Pragma("unroll") for (int k = 0; k < 2; ++k) acc[ai][bj][m][n] = __builtin_amdgcn_mfma_f32_16x16x32_bf16(Bt[n][k], At[m][k], acc[ai][bj][m][n], 0, 0, 0); } } __builtin_amdgcn_s_setprio(0); } while (0)
#define PG8_WAIT_V(n) asm volatile("s_waitcnt vmcnt(" #n ")" ::: "memory")
#define PG8_WAIT_L(n) asm volatile("s_waitcnt lgkmcnt(" #n ")" ::: "memory")
#define PG8_BAR __builtin_amdgcn_s_barrier()
#define PG8_SCHED __builtin_amdgcn_sched_barrier(0)
#define PG8_AOFF(dst, u) do { int _t = threadIdx.x; asm volatile("" : "+v"(_t)); _Pragma("unroll") for (int _i = 0; _i < 2; ++_i) { int _R, _C; stage_rc(_t * 16 + _i * 8192, _R, _C); \
        _Pragma("unroll") for (int _h = 0; _h < 2; ++_h) dst[_h][_i] = (unsigned)(S.row_index(u, _h * HALF + _R) * PB + _C * 2); } } while (0)
    Unit cur, nxt; int ui = 0;
    if (!S.next(0, cur)) return;
    if constexpr (Sched::GATHER) PG8_AOFF(vA, cur);
    f32x4 acc[2][2][4][2];
#pragma unroll
    for (int a = 0; a < 2; ++a)
#pragma unroll
        for (int b = 0; b < 2; ++b)
#pragma unroll
            for (int m = 0; m < 4; ++m)
#pragma unroll
                for (int n = 0; n < 2; ++n) acc[a][b][m][n] = (f32x4){0.f, 0.f, 0.f, 0.f};
    const int sc127 = 127;
    bf16x8 At[4][2], B0[2][2], B1[2][2]; i32x8 At8[4], B08[2], B18[2];
    const char* cA = cur.a; const char* cB = cur.b;
    PG8_STAGE(PG8_SB(0, 0), cB, voffB); PG8_STAGE(PG8_SB(0, 1), cB + hstep, voffB); PG8_STAGE(PG8_SA(0, 0), cA, vA[0]); PG8_STAGE(PG8_SA(0, 1), cA, vA[1]);
    if (wr == 1) PG8_BAR;
    PG8_WAIT_V(2); PG8_BAR;
    PG8_STAGE(PG8_SB(1, 0), cB + kstep, voffB); PG8_STAGE(PG8_SA(1, 0), cA + kstep, vA[0]); PG8_STAGE(PG8_SB(1, 1), cB + hstep + kstep, voffB);
    PG8_WAIT_V(6); PG8_BAR;
    for (;;) {
        const bool has_next = S.next(ui + 1, nxt);
        const char* nA = has_next ? nxt.a : cA; const char* nB = has_next ? nxt.b : cB;
        if constexpr (Sched::GATHER) { if (has_next) PG8_AOFF(vN, nxt); else {
#pragma unroll
            for (int h = 0; h < 2; ++h)
#pragma unroll
                for (int i = 0; i < 2; ++i) vN[h][i] = vA[h][i]; }
            *(LAS u32x4*)(lds + VN_STASH + tid * 16) = (u32x4){vN[0][0], vN[0][1], vN[1][0], vN[1][1]}; }
        for (int hk = 0; hk < (Epi::HAS_MID ? 2 : 1); ++hk) {
        if constexpr (Epi::HAS_MID) { if (hk == 1 && !skip) E.mid(acc, cur, wr, wc, fr, fq); }
        const int tb = (Epi::HAS_MID && hk == 1) ? nt / 2 : 0, te = (Epi::HAS_MID && hk == 0) ? nt / 2 : nt;
#pragma unroll 1
        for (int t = tb; t < te; t += 2) {
            const bool last = (t == nt - 2);
            const char* a1 = cA + (size_t)(t + 1) * kstep;
            const char* a2 = last ? nA : cA + (size_t)(t + 2) * kstep; const char* b2 = last ? nB : cB + (size_t)(t + 2) * kstep;
            const char* a3 = a2 + kstep; const char* b3 = b2 + kstep;
            unsigned w0[2], w1[2];
#pragma unroll
            for (int i = 0; i < 2; ++i) { w0[i] = vA[0][i]; w1[i] = vA[1][i]; }
            if constexpr (Sched::GATHER) { if (last) { const u32x4 q = *(const LAS u32x4*)(lds + VN_STASH + tid * 16); w0[0] = q.x; w0[1] = q.y; w1[0] = q.z; w1[1] = q.w; } }
            PG8_LDB(B0, 0, 0); PG8_LDB(B1, 0, 1); PG8_SCHED; PG8_LDA(At, 0, 0); PG8_STAGE(PG8_SA(1, 1), a1, vA[1]);
            PG8_WAIT_V(8); PG8_WAIT_L(0); PG8_BAR; PG8_MMA(0, 0, At, B0); PG8_MMA(0, 1, At, B1); PG8_BAR; PG8_SCHED;
            PG8_LDA(At, 0, 1); PG8_STAGE(PG8_SB(0, 0), b2, voffB); PG8_STAGE(PG8_SB(0, 1), b2 + hstep, voffB); PG8_STAGE(PG8_SA(0, 0), a2, w0);
            PG8_WAIT_V(8); PG8_WAIT_L(0); PG8_BAR; PG8_MMA(1, 0, At, B0); PG8_MMA(1, 1, At, B1); PG8_BAR; PG8_SCHED;
            PG8_LDB(B0, 1, 0); PG8_LDB(B1, 1, 1); PG8_SCHED; PG8_LDA(At, 1, 0); PG8_STAGE(PG8_SA(0, 1), a2, w1);
            PG8_WAIT_V(8); PG8_WAIT_L(0); PG8_BAR; PG8_MMA(0, 0, At, B0); PG8_MMA(0, 1, At, B1); PG8_BAR; PG8_SCHED;
            PG8_LDA(At, 1, 1); PG8_STAGE(PG8_SB(1, 0), b3, voffB); PG8_STAGE(PG8_SB(1, 1), b3 + hstep, voffB); PG8_STAGE(PG8_SA(1, 0), a3, w0);
            PG8_WAIT_V(8); PG8_WAIT_L(0); PG8_BAR; PG8_MMA(1, 0, At, B0); PG8_MMA(1, 1, At, B1); PG8_BAR; PG8_SCHED;
        }
        }
        if (wr == 0) PG8_BAR;
        if constexpr (FP8) asm volatile("s_nop 15\n\ts_nop 7" ::: "memory");
        if constexpr (!skip) E(acc, cur, wr, wc, fr, fq); else {
#pragma unroll
            for (int a = 0; a < 2; ++a)
#pragma unroll
                for (int b = 0; b < 2; ++b)
#pragma unroll
                    for (int m = 0; m < 4; ++m)
#pragma unroll
                        for (int n = 0; n < 2; ++n) asm volatile("" :: "v"(acc[a][b][m][n])); }
        if (!has_next) break;
#pragma unroll
        for (int a = 0; a < 2; ++a)
#pragma unroll
            for (int b = 0; b < 2; ++b)
#pragma unroll
                for (int m = 0; m < 4; ++m)
#pragma unroll
                    for (int n = 0; n < 2; ++n) acc[a][b][m][n] = (f32x4){0.f, 0.f, 0.f, 0.f};
        cur = nxt; cA = nA; cB = nB; ++ui;
        if constexpr (Sched::GATHER) { const u32x4 q = *(const LAS u32x4*)(lds + VN_STASH + tid * 16); vA[0][0] = q.x; vA[0][1] = q.y; vA[1][0] = q.z; vA[1][1] = q.w; }
        if (wr == 1) PG8_BAR;
    }
    PG8_WAIT_V(0);
    PG8_BAR;
#undef PG8_SA
#undef PG8_SB
#undef PG8_STAGE
#undef PG8_LDA
#undef PG8_LDB
#undef PG8_MMA
#undef PG8_LD16
#undef PG8_WAIT_V
#undef PG8_WAIT_L
#undef PG8_BAR
#undef PG8_SCHED
#undef PG8_AOFF
}
}

typedef f32x4 Acc[2][2][4][2];
struct EpiG1 {
    static constexpr bool HAS_MID = false;
    unsigned char* ws; const float* g_q; const float* g_k;
    __device__ __forceinline__ void mid(Acc&, const pg8::Unit&, int, int, int, int) const {}
    __device__ __forceinline__ void operator()(Acc& acc, const pg8::Unit& u, int wr, int wc, int fr, int fq) const {
        const int pn = u.pn, row0 = u.pm * 256 + wr * 64 + fr;
        if (pn < 4) {
            const int isk = pn >> 1, hh = 4 * (pn & 1) + wc;
            const float* g = isk ? g_k : g_q;
            f32x4 gv[2][2];
#pragma unroll
            for (int bj = 0; bj < 2; ++bj)
#pragma unroll
                for (int n = 0; n < 2; ++n) gv[bj][n] = *(const f32x4*)(g + ((bj == 0 && fq < 2) ? 8 * n + 4 * fq : 32 * bj + 8 * fq + 4 * n));
            f32x4 cs_[2][2];
#pragma unroll
            for (int bj = 0; bj < 2; ++bj)
#pragma unroll
                for (int n = 0; n < 2; ++n) cs_[bj][n] = (f32x4){0.f, 0.f, 0.f, 0.f};
            f32x4 rf;
#pragma unroll
            for (int e = 0; e < 4; ++e) { const float f0 = exp2f(-(float)e * (0.125f * 18.931568569324174f)) * 0.15915494309189535f, f1 = exp2f(-(float)(4 + e) * (0.125f * 18.931568569324174f)) * 0.15915494309189535f;
                rf[e] = fq == 0 ? f0 : (fq == 1 ? f1 : 0.f); }
            bf16_t* dst = isk ? (bf16_t*)(ws + WS_K) : (bf16_t*)(ws + WS_YAB);
            const int pitch = isk ? 512 : 1024;
            const float sc = isk ? 1.f : C2;
#pragma unroll
            for (int ai = 0; ai < 2; ++ai)
#pragma unroll
                for (int m = 0; m < 4; ++m) {
                    const int r = row0 + 128 * ai + 16 * m; const float pos = (float)(r & (S - 1));
                    f32x4 v[2][2]; float ss = 0.f;
#pragma unroll
                    for (int bj = 0; bj < 2; ++bj)
#pragma unroll
                        for (int n = 0; n < 2; ++n) { v[bj][n] = acc[ai][bj][m][n]; ss += (v[bj][n].x * v[bj][n].x + v[bj][n].y * v[bj][n].y) + (v[bj][n].z * v[bj][n].z + v[bj][n].w * v[bj][n].w); }
                    ss = xrow16_sum(ss);
                    const float rinv = rsqrtf(ss * (1.f / 64.f) + EPS);
#pragma unroll
                    for (int bj = 0; bj < 2; ++bj)
#pragma unroll
                        for (int n = 0; n < 2; ++n) v[bj][n] = v[bj][n] * rinv * gv[bj][n];
#pragma unroll
                    for (int e = 0; e < 4; ++e) { const float rev = __builtin_amdgcn_fractf(pos * rf[e]), c = __builtin_amdgcn_cosf(rev), sn = __builtin_amdgcn_sinf(rev);
                        const float x1 = v[0][0][e], x2 = v[0][1][e]; v[0][0][e] = x1 * c - x2 * sn; v[0][1][e] = x2 * c + x1 * sn; }
                    if (isk) {
#pragma unroll
                        for (int bj = 0; bj < 2; ++bj)
#pragma unroll
                            for (int n = 0; n < 2; ++n) cs_[bj][n] += v[bj][n];
                    }
#pragma unroll
                    for (int bj = 0; bj < 2; ++bj) st16(dst + (size_t)r * pitch + hh * 64 + 32 * bj + 8 * fq, pack8v(v[bj][0] * sc, v[bj][1] * sc));
                }
            if (isk) {
                const int b = u.pm >> 4, blk = u.pm & 15;
                float* km = (float*)(ws + WS_KMEAN) + ((size_t)(b * NH + hh) * 16 + blk) * 64;
#pragma unroll
                for (int bj = 0; bj < 2; ++bj)
#pragma unroll
                    for (int n = 0; n < 2; ++n)
#pragma unroll
                        for (int e = 0; e < 4; ++e) { float s = cs_[bj][n][e]; s += dpp_ror<8>(s); s += dpp_ror<4>(s); s += dpp_ror<2>(s); s += dpp_ror<1>(s);
                            if (fr == 0) atomicAdd(km + 32 * bj + 8 * fq + 4 * n + e, s * (1.f / 256.f)); }
            }
        } else if (pn < 8) {
            bf16_t* dst = (bf16_t*)(ws + WS_U);
#pragma unroll
            for (int ai = 0; ai < 2; ++ai)
#pragma unroll
                for (int m = 0; m < 4; ++m) { const int r = row0 + 128 * ai + 16 * m;
                    const f32x4 a = acc[ai][0][m][0] * acc[ai][1][m][0], b = acc[ai][0][m][1] * acc[ai][1][m][1]; u32x4 w;
                    w.x = pk2(a.x, a.y); w.y = pk2(a.z, a.w); w.z = pk2(b.x, b.y); w.w = pk2(b.z, b.w);
                    st16(dst + (size_t)r * 512 + 128 * (pn - 4) + 32 * wc + 8 * fq, w); }
        } else {
            bf16_t* dst = (bf16_t*)(ws + WS_BG); const int pitch = 512, c0 = 256 * (pn - 8); const bool sig = false;
#pragma unroll
            for (int ai = 0; ai < 2; ++ai)
#pragma unroll
                for (int m = 0; m < 4; ++m) { const int r = row0 + 128 * ai + 16 * m;
#pragma unroll
                    for (int bj = 0; bj < 2; ++bj) { f32x4 a = acc[ai][bj][m][0], b = acc[ai][bj][m][1];
                        if (sig) {
#pragma unroll
                            for (int e = 0; e < 4; ++e) { a[e] = __builtin_amdgcn_rcpf(1.f + __expf(-a[e])); b[e] = __builtin_amdgcn_rcpf(1.f + __expf(-b[e])); } }
                        u32x4 w; w.x = pk2(a.x, a.y); w.y = pk2(a.z, a.w); w.z = pk2(b.x, b.y); w.w = pk2(b.z, b.w);
                        st16(dst + (size_t)r * pitch + c0 + 128 * bj + 32 * wc + 8 * fq, w); } }
        }
    }
};
struct EpiGate {
    static constexpr bool HAS_MID = false;
    bf16_t* gates; bf16_t* vout;
    __device__ __forceinline__ void mid(Acc&, const pg8::Unit&, int, int, int, int) const {}
    __device__ __forceinline__ void operator()(Acc& acc, const pg8::Unit& u, int wr, int wc, int fr, int fq) const {
        int row0 = u.pm * 256 + wr * 64 + fr; const int c0 = u.pn * 256 + 32 * wc + 8 * fq; asm volatile("" : "+v"(row0));
#pragma unroll
        for (int ai = 0; ai < 2; ++ai)
#pragma unroll
            for (int m = 0; m < 4; ++m) { const size_t r = (size_t)(row0 + 128 * ai + 16 * m);
                if (u.pn < 8) {
                    f32x4 ra[2], gb[2];
#pragma unroll
                    for (int n = 0; n < 2; ++n)
#pragma unroll
                        for (int e = 0; e < 4; ++e) { const float ea = __expf(acc[ai][0][m][n][e] * (-1.f / W8_SCALE)), eb = __expf(acc[ai][1][m][n][e] * (-1.f / W8_SCALE));
                            gb[n][e] = __builtin_amdgcn_rcpf(1.f + eb); ra[n][e] = fminf((1.f + eb) * __builtin_amdgcn_rcpf(1.f + ea), 3e4f); }
                    const size_t gc = r * 2048 + 128 * u.pn + 32 * wc + 8 * fq;
                    st16(gates + gc, pack8v(ra[0], ra[1])); st16(gates + gc + 1024, pack8v(gb[0], gb[1]));
                } else {
#pragma unroll
                    for (int bj = 0; bj < 2; ++bj) st16(vout + r * 512 + (c0 - 2048) + 128 * bj, pack8v(acc[ai][bj][m][0] * (1.f / W8_SCALE), acc[ai][bj][m][1] * (1.f / W8_SCALE))); } }
    }
};
__device__ __forceinline__ void s2_fast(Frame& F) {
    {
        const pg8::DenseSched Sd{(const char*)(F.ws + WS_H), (const char*)(F.ws + WS_WIN_T), T / 256, 10, 1024, F.G, (int)blockIdx.x};
        const EpiG1 E{F.ws, F.g_q, F.g_k};
        if (F.skip) pg8::gemm_phase<EpiG1, pg8::DenseSched, true>(F.lds, 1024, Sd, E); else pg8::gemm_phase<EpiG1, pg8::DenseSched>(F.lds, 1024, Sd, E); }
    {
        const pg8::DenseSched8 Sd{(const char*)(F.ws + WS_H8), (const char*)(F.ws + WS_WIN8), T / 256, 10, 1024, F.G, (int)blockIdx.x};
        const EpiGate E{WSP(bf16_t, WS_GATES), WSP(bf16_t, WS_V)};
        int Kg = D; asm volatile("" : "+s"(Kg));
        if (F.skip) pg8::gemm_phase<EpiGate, pg8::DenseSched8, true>(F.lds, Kg, Sd, E); else pg8::gemm_phase<EpiGate, pg8::DenseSched8>(F.lds, Kg, Sd, E); }
}

constexpr float NEG_BIG = -1e30f;
__device__ __forceinline__ void s3_simple(Frame& F) {
    LAS float* tS = (LAS float*)F.lds;
    LAS bf16_t* Pb = (LAS bf16_t*)(F.lds + 16896);
    LAS bf16_t* Vt = (LAS bf16_t*)(F.lds + 16896 + 9216);
    LAS float* mrow = (LAS float*)(F.lds + 16896 + 18432);
    LAS float* lrow = mrow + 64; LAS float* arow_ = mrow + 128; LAS int* sel = (LAS int*)(mrow + 192); LAS int* um = sel + 64;
    bf16_t* YAB = WSP(bf16_t, WS_YAB); const bf16_t* Kb = WSP(bf16_t, WS_K); const bf16_t* Vb = WSP(bf16_t, WS_V);
    const float* kmean = WSP(float, WS_KMEAN);
    const int row = F.tid >> 3, seg = F.tid & 7, fr = F.lane & 15, fq = F.lane >> 4, rb = 16 * (F.wave & 3), cb = 32 * (F.wave >> 2);
    for (int it = blockIdx.x; it < NB * NH * 64; it += F.G) {
        const int qc = it & 63, h = (it >> 6) & 7, b = it >> 9, cur = qc >> 2, t0 = 64 * qc;
        const size_t tb = (size_t)b * S;
        if (F.tid < 64) {
            float q[64];
            const bf16_t* qp = YAB + (tb + t0 + F.tid) * 1024 + h * 64;
#pragma unroll
            for (int i = 0; i < 8; ++i) { float t8[8]; unpack8(*(const u32x4*)(qp + 8 * i), t8);
#pragma unroll
                for (int e = 0; e < 8; ++e) q[8 * i + e] = t8[e]; }
            float b0 = -INFINITY, b1 = -INFINITY, b2 = -INFINITY; int i0 = -1, i1 = -1, i2 = -1;
            for (int j = 0; j < cur; ++j) { const float* km = kmean + ((size_t)(b * NH + h) * 16 + j) * 64; float s = 0.f;
#pragma unroll
                for (int d = 0; d < 64; ++d) s += q[d] * km[d];
                if (s > b0) { b2 = b1; i2 = i1; b1 = b0; i1 = i0; b0 = s; i0 = j; } else if (s > b1) { b2 = b1; i2 = i1; b1 = s; i1 = j; } else if (s > b2) { b2 = s; i2 = j; } }
            int m = 0; if (i0 >= 0) m |= 1 << i0; if (i1 >= 0) m |= 1 << i1; if (i2 >= 0) m |= 1 << i2;
            sel[F.tid] = m; mrow[F.tid] = NEG_BIG; lrow[F.tid] = 0.f;
            int u = m;
#pragma unroll
            for (int o = 1; o < 64; o <<= 1) u |= __shfl_xor(u, o);
            if (F.tid == 0) um[0] = u;
        }
        __syncthreads();
        const int umask = um[0];
        f32x4 o0 = {0.f, 0.f, 0.f, 0.f}, o1 = {0.f, 0.f, 0.f, 0.f};
        const RowsLinear aq{YAB + (tb + t0) * 1024 + h * 64, 1024};
        for (int j = 0; j <= cur; ++j) {
            if (j < cur && !((umask >> j) & 1)) continue;
            const int nkt = (j == cur) ? ((qc & 3) + 1) : 4;
            for (int kt = 0; kt < nkt; ++kt) {
                const int kbase = 256 * j + 64 * kt;
                const RowsLinear bk{Kb + (tb + kbase) * 512 + h * 64, 512};
                sgemm_tile(tS, 64, aq, bk, F.wave, F.lane);
                { float vv[8]; unpack8(*(const u32x4*)(Vb + (tb + kbase + row) * 512 + h * 64 + 8 * seg), vv);
#pragma unroll
                    for (int e = 0; e < 8; ++e) Vt[(8 * seg + e) * 72 + row] = (bf16_t)f2bf(vv[e]); }
                __syncthreads();
                {
                    float s[8]; float mx = NEG_BIG;
                    const bool rowsel = (j == cur) || ((sel[row] >> j) & 1);
#pragma unroll
                    for (int e = 0; e < 8; ++e) { const int c = 8 * seg + e; float x = tS[row * 65 + c];
                        if (!rowsel || (j == cur && kbase + c > t0 + row)) x = NEG_BIG; s[e] = x; mx = fmaxf(mx, x); }
                    mx = fmaxf(mx, __shfl_xor(mx, 1)); mx = fmaxf(mx, __shfl_xor(mx, 2)); mx = fmaxf(mx, __shfl_xor(mx, 4));
                    const float mold = mrow[row], mnew = fmaxf(mold, mx);
                    float alpha = 1.f, ps = 0.f; float p[8];
                    if (mnew <= NEG_BIG) {
#pragma unroll
                        for (int e = 0; e < 8; ++e) p[e] = 0.f;
                    } else { alpha = exp2f(mold - mnew);
#pragma unroll
                        for (int e = 0; e < 8; ++e) { p[e] = (s[e] <= NEG_BIG) ? 0.f : exp2f(s[e] - mnew); ps += p[e]; } }
                    ps += __shfl_xor(ps, 1); ps += __shfl_xor(ps, 2); ps += __shfl_xor(ps, 4);
                    const float lold = lrow[row];
                    *(LAS u32x4*)(Pb + row * 72 + 8 * seg) = pack8(p);
                    if (seg == 0) { mrow[row] = mnew; lrow[row] = lold * alpha + ps; arow_[row] = alpha; }
                }
                __syncthreads();
                {
#pragma unroll
                    for (int r = 0; r < 4; ++r) { const float a = arow_[rb + fq * 4 + r]; o0[r] *= a; o1[r] *= a; }
#pragma unroll
                    for (int ks = 0; ks < 2; ++ks) {
                        const bf16x8 a = *(const LAS bf16x8*)(Pb + (rb + fr) * 72 + 32 * ks + 8 * fq);
                        const bf16x8 v0 = *(const LAS bf16x8*)(Vt + (cb + fr) * 72 + 32 * ks + 8 * fq);
                        const bf16x8 v1 = *(const LAS bf16x8*)(Vt + (cb + 16 + fr) * 72 + 32 * ks + 8 * fq);
                        o0 = __builtin_amdgcn_mfma_f32_16x16x32_bf16(a, v0, o0, 0, 0, 0);
                        o1 = __builtin_amdgcn_mfma_f32_16x16x32_bf16(a, v1, o1, 0, 0, 0);
                    }
                }
                __syncthreads();
            }
        }
#pragma unroll
        for (int r = 0; r < 4; ++r) { const float li = 1.f / lrow[rb + fq * 4 + r]; tS[(rb + fq * 4 + r) * 65 + cb + fr] = o0[r] * li; tS[(rb + fq * 4 + r) * 65 + cb + 16 + fr] = o1[r] * li; }
        __syncthreads();
        { float v[8];
#pragma unroll
            for (int e = 0; e < 8; ++e) v[e] = tS[row * 65 + 8 * seg + e];
            *(u32x4*)(YAB + (tb + t0 + row) * 1024 + h * 64 + 8 * seg) = pack8(v); }
        __syncthreads();
    }
    const bf16_t* U = WSP(bf16_t, WS_U); const bf16_t* BG = WSP(bf16_t, WS_BG);
    for (int i = blockIdx.x * NTHREADS + F.tid; i < T * 64; i += F.G * NTHREADS) {
        const int t = i >> 6, c0 = (i & 63) * 8, pos = t & (S - 1);
        float u0[8], u1[8], u2[8], bg[8], y[8];
        unpack8(*(const u32x4*)(U + (size_t)t * 512 + c0), u2); unpack8(*(const u32x4*)(BG + (size_t)t * 512 + c0), bg);
        if (pos >= 1) unpack8(*(const u32x4*)(U + (size_t)(t - 1) * 512 + c0), u1); else {
#pragma unroll
            for (int e = 0; e < 8; ++e) u1[e] = 0.f; }
        if (pos >= 2) unpack8(*(const u32x4*)(U + (size_t)(t - 2) * 512 + c0), u0); else {
#pragma unroll
            for (int e = 0; e < 8; ++e) u0[e] = 0.f; }
#pragma unroll
        for (int e = 0; e < 8; ++e) y[e] = bg[e] * (F.conv_w[c0 + e] * u0[e] + F.conv_w[512 + c0 + e] * u1[e] + F.conv_w[1024 + c0 + e] * u2[e] + F.conv_b[c0 + e]);
        *(u32x4*)(YAB + (size_t)t * 1024 + 512 + c0) = pack8(y);
    }
}

namespace attn_body {
using bf16x8 = __attribute__((ext_vector_type(8))) short;
using s16x4 = __attribute__((ext_vector_type(4))) short;
using f32x16 = __attribute__((ext_vector_type(16))) float;
using u32x4 = __attribute__((ext_vector_type(4))) unsigned;
constexpr int SEQ = 4096, D = 64, DMQ = 1024, DMK = 512;
constexpr int NW = 8, QBLK = 32, QB = QBLK * NW, KVBLK = 64;
constexpr float NEGB = -1e30f;
__device__ __forceinline__ int crow(int r, int hi) { return (r & 3) + 8 * (r >> 2) + 4 * hi; }
#define SBAR() __builtin_amdgcn_sched_barrier(0)
__device__ __forceinline__ void cmask(f32x16& p0, f32x16& p1, int jb, int qrel, int hi) {
  const float NEG = -INFINITY; int kb = 64 * jb + 4 * hi;
  #pragma unroll
  for (int r = 0; r < 16; ++r) { int kv = kb + (r & 3) + 8 * (r >> 2); if (kv > qrel) p0[r] = NEG; if (kv + 32 > qrel) p1[r] = NEG; }
}
constexpr int NSLOT = 3, SLOTB = 8192;
constexpr int LDS_K = 0, LDS_V = NSLOT * SLOTB, LDS_WS = 2 * NSLOT * SLOTB, LDS_OST = LDS_WS + NW * 128 * 4, LDS_BYTES_A = LDS_OST + NW * 4096;
__device__ __forceinline__ void glds16(const void* gsrc, unsigned lds_dst) { unsigned keep;
  asm volatile("s_mov_b32 %0, m0\n\ts_mov_b32 m0, %2\n\ts_nop 0\n\tglobal_load_lds_dwordx4 %1, off\n\ts_mov_b32 m0, %0" : "=&s"(keep) : "v"(gsrc), "s"(lds_dst) : "memory"); }
__device__ __forceinline__ float max3f(float a, float b, float c) { float r; asm("v_max3_f32 %0, %1, %2, %3" : "=v"(r) : "v"(a), "v"(b), "v"(c)); return r; }
__device__ __forceinline__ float max2f(float a, float b) { float r; asm("v_max_f32_e32 %0, %1, %2" : "=v"(r) : "v"(a), "v"(b)); return r; }
__device__ __forceinline__ float fadd_s(float a, float b) { float r; asm("v_add_f32_e32 %0, %1, %2" : "=v"(r) : "v"(a), "v"(b)); return r; }
__device__ __forceinline__ float fsub_s(float a, float b) { float r; asm("v_sub_f32_e32 %0, %1, %2" : "=v"(r) : "v"(a), "v"(b)); return r; }
typedef float f32x2_t __attribute__((ext_vector_type(2))); typedef __bf16 bf16x2_t __attribute__((ext_vector_type(2)));
__device__ __forceinline__ unsigned cvtpk_s(float lo, float hi) { f32x2_t v = {lo, hi}; bf16x2_t b = __builtin_convertvector(v, bf16x2_t); return __builtin_bit_cast(unsigned, b); }
#define WAIT_BAR(N) asm volatile("s_waitcnt vmcnt(" #N ") lgkmcnt(0)\n\ts_barrier" ::: "memory")
__device__ __forceinline__ void qkt(f32x16& p0, f32x16& p1, const char* Kslot, const bf16x8* qr, const f32x16& negm, int r32, int hi) {
  const char* kb = Kslot + hi * 1024 + r32 * 16;
  #pragma unroll
  for (int d0 = 0; d0 < 4; ++d0) {
    const bf16x8 b0 = *reinterpret_cast<const bf16x8*>(kb + d0 * 2048);
    const bf16x8 b1 = *reinterpret_cast<const bf16x8*>(kb + d0 * 2048 + 512);
    if (d0 == 0) { p0 = __builtin_amdgcn_mfma_f32_32x32x16_bf16(b0, qr[0], negm, 0, 0, 0); p1 = __builtin_amdgcn_mfma_f32_32x32x16_bf16(b1, qr[0], negm, 0, 0, 0); }
    else { p0 = __builtin_amdgcn_mfma_f32_32x32x16_bf16(b0, qr[d0], p0, 0, 0, 0); p1 = __builtin_amdgcn_mfma_f32_32x32x16_bf16(b1, qr[d0], p1, 0, 0, 0); } }
}
typedef __attribute__((address_space(3))) const char* lds_cptr;
typedef __attribute__((address_space(3))) char* lds_ptr;
typedef short v4i16_t __attribute__((ext_vector_type(4)));
__device__ __forceinline__ void kload8(bf16x8* kf, lds_cptr kp) {
  kf[0] = *(const __attribute__((address_space(3))) bf16x8*)(kp);        kf[1] = *(const __attribute__((address_space(3))) bf16x8*)(kp + 512);
  kf[2] = *(const __attribute__((address_space(3))) bf16x8*)(kp + 2048); kf[3] = *(const __attribute__((address_space(3))) bf16x8*)(kp + 2560);
  kf[4] = *(const __attribute__((address_space(3))) bf16x8*)(kp + 4096); kf[5] = *(const __attribute__((address_space(3))) bf16x8*)(kp + 4608);
  kf[6] = *(const __attribute__((address_space(3))) bf16x8*)(kp + 6144); kf[7] = *(const __attribute__((address_space(3))) bf16x8*)(kp + 6656);
}
__device__ __forceinline__ void kload2(bf16x8* kf, lds_cptr kp, int j) { kf[2 * j] = *(const __attribute__((address_space(3))) bf16x8*)(kp + j * 2048); kf[2 * j + 1] = *(const __attribute__((address_space(3))) bf16x8*)(kp + j * 2048 + 512); }
__device__ __forceinline__ s16x4 vtr(lds_cptr p) { return __builtin_bit_cast(s16x4, __builtin_amdgcn_ds_read_tr16_b64_v4i16((__attribute__((address_space(3))) v4i16_t*)p)); }
__device__ __forceinline__ float rowmax(const f32x16& p0, const f32x16& p1) {
  float a = max3f(p0[0], p0[1], p1[0]), b = max3f(p0[2], p0[3], p1[1]); a = max3f(a, p1[2], p1[3]);
  #pragma unroll
  for (int r = 4; r < 16; r += 4) { a = max3f(a, p0[r], p0[r + 1]); b = max3f(b, p0[r + 2], p0[r + 3]); a = max3f(a, p1[r], p1[r + 1]); b = max3f(b, p1[r + 2], p1[r + 3]); }
  const float m = max2f(a, b);
  auto rr = __builtin_amdgcn_permlane32_swap(__float_as_uint(m), __float_as_uint(m), false, false);
  return max2f(__uint_as_float(rr[0]), __uint_as_float(rr[1]));
}
__device__ __forceinline__ void pv(f32x16* o, int vb, bf16x8 pa0, bf16x8 pa1, bf16x8 pa2, bf16x8 pa3) {
  #pragma unroll
  for (int d0 = 0; d0 < 2; ++d0) { s16x4 lo[4], hi[4];
    #pragma unroll
    for (int ks = 0; ks < 4; ++ks) {
      asm volatile("ds_read_b64_tr_b16 %0,%1 offset:%c2" : "=&v"(lo[ks]) : "v"(vb), "i"(d0 * 4096 + ks * 1024) : "memory");
      asm volatile("ds_read_b64_tr_b16 %0,%1 offset:%c2" : "=&v"(hi[ks]) : "v"(vb), "i"(d0 * 4096 + ks * 1024 + 512) : "memory"); }
    asm volatile("s_waitcnt lgkmcnt(0)" ::: "memory"); SBAR();
    #define PK(k) (bf16x8){lo[k][0], lo[k][1], lo[k][2], lo[k][3], hi[k][0], hi[k][1], hi[k][2], hi[k][3]}
    o[d0] = __builtin_amdgcn_mfma_f32_32x32x16_bf16(pa0, PK(0), o[d0], 0, 0, 0);
    o[d0] = __builtin_amdgcn_mfma_f32_32x32x16_bf16(pa1, PK(1), o[d0], 0, 0, 0);
    o[d0] = __builtin_amdgcn_mfma_f32_32x32x16_bf16(pa2, PK(2), o[d0], 0, 0, 0);
    o[d0] = __builtin_amdgcn_mfma_f32_32x32x16_bf16(pa3, PK(3), o[d0], 0, 0, 0);
    #undef PK
  }
}
#define ATTN_STORE16(p, v) st16((p), (v))
template <int THRL> __device__ __forceinline__ void attn_unit(int b, int h, int qb, const bf16_t* QO, bf16_t* Ob, const bf16_t* __restrict__ K, const bf16_t* __restrict__ V, const float* __restrict__ kmean, char* shm) {
  int tid_ = threadIdx.x; asm volatile("" : "+v"(tid_));
  const int tid = tid_, lane = tid & 63, r32 = lane & 31, hi = lane >> 5; const int wid = __builtin_amdgcn_readfirstlane(tid >> 6);
  const long rowbase = (long)b * SEQ; const int q0 = qb * QB;
  const bf16_t* Qw = QO + (rowbase + q0 + wid * QBLK) * DMQ + h * D;
  const bf16_t* Kh = K + rowbase * DMK + h * D, *Vh = V + rowbase * DMK + h * D;
  const unsigned lds0 = (unsigned)(uintptr_t)shm;
  float* wsf = (float*)(shm + LDS_WS) + wid * 128;
  const bf16_t* ksrc = Kh + (long)lane * DMK + wid * 8;
  const bf16_t* vsrc = Vh + (long)(16 * (wid & 3) + (lane >> 2)) * DMK + (wid >> 2) * 32 + (lane & 3) * 8;
  const unsigned kdst = lds0 + LDS_K + wid * 1024, vdst = lds0 + LDS_V + wid * 1024;
  #define DMA_K(t, slot) glds16(ksrc + (long)(t) * KVBLK * DMK, (unsigned)__builtin_amdgcn_readfirstlane(kdst + (slot)))
  #define DMA_V(t, slot) glds16(vsrc + (long)(t) * KVBLK * DMK, (unsigned)__builtin_amdgcn_readfirstlane(vdst + (slot)))
  DMA_K(0, 0); DMA_V(0, 0); DMA_K(1, SLOTB);
  bf16x8 qr[4];
  #pragma unroll
  for (int d0 = 0; d0 < 4; ++d0) qr[d0] = *reinterpret_cast<const bf16x8*>(&Qw[(long)r32 * DMQ + d0 * 16 + hi * 8]);
  unsigned selm = 0u;
  if (qb > 0) {
    float* kmL = (float*)(shm + LDS_OST);
    const float* kmg = kmean + ((size_t)(b * 8 + h) * 16) * 64;
    for (int i = tid; i < qb * 64; i += 512) kmL[i] = kmg[i];
    asm volatile("s_waitcnt vmcnt(0) lgkmcnt(0)\n\ts_barrier" ::: "memory");
    float qf[32];
    #pragma unroll
    for (int d0 = 0; d0 < 4; ++d0)
      #pragma unroll
      for (int e = 0; e < 8; ++e) qf[8 * d0 + e] = __uint_as_float(((unsigned)(unsigned short)qr[d0][e]) << 16);
    float b0 = -INFINITY, b1 = -INFINITY, b2 = -INFINITY; int i0 = -1, i1 = -1, i2 = -1;
    for (int j = 0; j < qb; ++j) {
      const float* km = kmL + j * 64 + 8 * hi; float sc = 0.f;
      #pragma unroll
      for (int d0 = 0; d0 < 4; ++d0)
        #pragma unroll
        for (int e = 0; e < 8; ++e) sc += qf[8 * d0 + e] * km[16 * d0 + e];
      sc += __shfl_xor(sc, 32);
      if (sc > b0) { b2 = b1; i2 = i1; b1 = b0; i1 = i0; b0 = sc; i0 = j; } else if (sc > b1) { b2 = b1; i2 = i1; b1 = sc; i1 = j; } else if (sc > b2) { b2 = sc; i2 = j; }
    }
    if (i0 >= 0) selm |= 1u << i0; if (i1 >= 0) selm |= 1u << i1; if (i2 >= 0) selm |= 1u << i2;
    asm volatile("s_waitcnt lgkmcnt(0)\n\ts_barrier" ::: "memory");
  }
  if (hi == 0) ((unsigned*)wsf)[64 + r32] = selm;
  { const lds_ptr qst = (lds_ptr)shm + LDS_OST + wid * 4096 + lane * 16;
    #pragma unroll
    for (int d0 = 0; d0 < 4; ++d0) *(__attribute__((address_space(3))) bf16x8*)(qst + d0 * 1024) = qr[d0]; }
  #define SELROW(j) (((j) >= qb) || ((((const unsigned*)wsf)[64 + r32] >> (j)) & 1u))
  #define NEGM_SET(blk) do { const float nv_ = SELROW(blk) ? -mhat : NEGB; _Pragma("unroll") for (int r = 0; r < 16; ++r) negm[r] = nv_; asm volatile("" : "+v"(negm)); } while (0)
  const int vb0 = (int)(lds0 + LDS_V) + ((lane >> 4) & 1) * 32 + (lane & 3) * 8 + (4 * hi + ((lane & 15) >> 2)) * 64;
  const char* Kbase = shm + LDS_K; bf16x8 kf[8];
  const lds_cptr qp0 = (lds_cptr)shm + LDS_OST + wid * 4096 + lane * 16;
  const lds_cptr shm3 = (lds_cptr)shm; const lds_cptr kp0 = shm3 + LDS_K + hi * 1024 + r32 * 16; const lds_cptr vp0 = shm3 + LDS_V + ((lane >> 4) & 1) * 32 + (lane & 3) * 8 + (4 * hi + ((lane & 15) >> 2)) * 64;
  const int NT = (q0 + QB) / KVBLK;
  float mhat = 0.f, l_reg = 0.f; f32x16 o[2]; o[0] = f32x16{}; o[1] = f32x16{}; f32x16 negm;
  NEGM_SET(0);
  const int qrel = wid * QBLK + r32;
  #define CMASK(P0, P1, t) do { int jb_ = (t) - (NT - 4); if (jb_ >= 0) cmask(P0, P1, jb_, qrel, hi); } while (0)
  bool resc = false;
  #define START(P0, P1) do { const float rm = rowmax(P0, P1); resc = false; \
    { const float dl = SELROW(0) ? rm : 0.f; mhat = fadd_s(mhat, dl); \
      _Pragma("unroll") for (int r = 0; r < 16; ++r) { P0[r] = fsub_s(P0[r], dl); P1[r] = fsub_s(P1[r], dl); } \
      NEGM_SET(0); } \
    _Pragma("unroll") for (int r = 0; r < 16; ++r) P0[r] = __builtin_amdgcn_exp2f(P0[r]); } while (0)
  #define RESC() do { if (resc) { asm volatile("s_waitcnt lgkmcnt(0)" ::: "memory"); \
      _Pragma("unroll") for (int d_ = 0; d_ < 2; ++d_) _Pragma("unroll") for (int r = 0; r < 16; ++r) o[d_][r] *= wsf[crow(r, hi)]; } } while (0)
  f32x16 pA0, pA1, pB0, pB1;
  int sl_prev = 0, sl_cur = 0, sl_next = SLOTB;
  #define ROT() do { sl_prev = sl_cur; sl_cur = sl_next; sl_next = (sl_next == (NSLOT - 1) * SLOTB) ? 0 : sl_next + SLOTB; } while (0)
  DMA_K(2, 2 * SLOTB);
  WAIT_BAR(3);
  qkt(pA0, pA1, Kbase, qr, negm, r32, hi); asm volatile("s_nop 15\n\ts_nop 7" : "+v"(pA0), "+v"(pA1)); CMASK(pA0, pA1, 0);
  START(pA0, pA1);
  _Pragma("unroll") for (int r = 0; r < 16; ++r) pA1[r] = __builtin_amdgcn_exp2f(pA1[r]);
  WAIT_BAR(0);
  DMA_K(3, 0); DMA_V(1, SLOTB);
  ROT();
  kload8(kf, kp0 + sl_cur);
  WAIT_BAR(2);
  s16x4 vlo[8], vhi[8]; u32x4 pw0, pw1, pw2, pw3; bf16x8 q0_, q1_, q2_, q3_;
  #define QRD(d) do { q##d##_ = *(const __attribute__((address_space(3))) bf16x8*)(qp0 + (d) * 1024); } while (0)
  QRD(0); QRD(1);
  #define PKW(P, B) cvtpk_s(P[B], P[B + 1])
  #define PAF(k) __builtin_bit_cast(bf16x8, pw##k)
  #define VFR(i) (bf16x8){vlo[i][0], vlo[i][1], vlo[i][2], vlo[i][3], vhi[i][0], vhi[i][1], vhi[i][2], vhi[i][3]}
  #define PIN(x) asm volatile("" : "+v"(x))
  #define MX3(a, b, c) __builtin_fmaxf(__builtin_fmaxf((a), (b)), (c))
  #define GAPA(MF, A0, A1, A2, A3, W0, W1, PW) do { MF; sacc += A0; sacc += A1; sacc += A2; sacc += A3; PIN(sacc); W0; W1; PIN(PW); SBAR(); } while (0)
  #define EX(v) __builtin_amdgcn_exp2f(v)
  #define GAPB(MF, X, B) do { MF; X[B] = EX(X[B]); X[B + 1] = EX(X[B + 1]); X[B + 2] = EX(X[B + 2]); X[B + 3] = EX(X[B + 3]); PIN(X); SBAR(); } while (0)
  #define VRD(i) do { vlo[i] = vtr(vp_ + (((i) >> 2) * 4096 + ((i) & 3) * 1024)); vhi[i] = vtr(vp_ + (((i) >> 2) * 4096 + ((i) & 3) * 1024 + 512)); } while (0)
  #define KRD(G, j) do { if (G) { kload2(kf, kp0 + sl_next, j); SBAR(); } } while (0)
  #define STEP(C0, C1, P0, P1, t, GK, GV, GL) do { SBAR(); \
    const lds_cptr vp_ = vp0 + sl_prev; \
    VRD(0); SBAR(); float sacc = (P0[0] + P0[1]); \
    GAPA(C0 = __builtin_amdgcn_mfma_f32_32x32x16_bf16(kf[0], q0_, negm, 0, 0, 0), P0[2], P0[3], P0[4], P0[5],     pw0[0] = PKW(P0, 0), pw0[1] = PKW(P0, 2), pw0); \
    VRD(4); SBAR(); GAPA(C1 = __builtin_amdgcn_mfma_f32_32x32x16_bf16(kf[1], q0_, negm, 0, 0, 0), P0[6], P0[7], P0[8], P0[9],     pw0[2] = PKW(P0, 4), pw0[3] = PKW(P0, 6), pw0); \
    QRD(2); SBAR(); \
    VRD(1); SBAR(); GAPA(C0 = __builtin_amdgcn_mfma_f32_32x32x16_bf16(kf[2], q1_, C0, 0, 0, 0),   P0[10], P0[11], P0[12], P0[13], pw1[0] = PKW(P0, 8), pw1[1] = PKW(P0, 10), pw1); \
    VRD(5); SBAR(); GAPA(C1 = __builtin_amdgcn_mfma_f32_32x32x16_bf16(kf[3], q1_, C1, 0, 0, 0),   P0[14], P0[15], P1[0], P1[1],   pw1[2] = PKW(P0, 12), pw1[3] = PKW(P0, 14), pw1); \
    QRD(3); SBAR(); \
    VRD(2); SBAR(); GAPA(C0 = __builtin_amdgcn_mfma_f32_32x32x16_bf16(kf[4], q2_, C0, 0, 0, 0),   P1[2], P1[3], P1[4], P1[5],     pw2[0] = PKW(P1, 0), pw2[1] = PKW(P1, 2), pw2); \
    VRD(6); SBAR(); GAPA(C1 = __builtin_amdgcn_mfma_f32_32x32x16_bf16(kf[5], q2_, C1, 0, 0, 0),   P1[6], P1[7], P1[8], P1[9],     pw2[2] = PKW(P1, 4), pw2[3] = PKW(P1, 6), pw2); \
    VRD(3); SBAR(); GAPA(C0 = __builtin_amdgcn_mfma_f32_32x32x16_bf16(kf[6], q3_, C0, 0, 0, 0),   P1[10], P1[11], P1[12], P1[13], pw3[0] = PKW(P1, 8), pw3[1] = PKW(P1, 10), pw3); \
    VRD(7); SBAR(); GAPA(C1 = __builtin_amdgcn_mfma_f32_32x32x16_bf16(kf[7], q3_, C1, 0, 0, 0),   P1[14], P1[15], 0.f, 0.f,       pw3[2] = PKW(P1, 12), pw3[3] = PKW(P1, 14), pw3); \
    l_reg += sacc; \
    if (GK) { DMA_K((t) + 3, sl_cur); } if (GV) { DMA_V((t) + 1, sl_next); } \
    CMASK(C0, C1, t); \
    { float a = MX3(C0[0], C0[1], C1[0]), b = MX3(C0[2], C0[3], C1[1]); a = MX3(a, C1[2], C1[3]); \
      _Pragma("unroll") for (int r = 4; r < 16; r += 4) { a = MX3(a, C0[r], C0[r + 1]); b = MX3(b, C0[r + 2], C0[r + 3]); a = MX3(a, C1[r], C1[r + 1]); b = MX3(b, C1[r + 2], C1[r + 3]); } \
      float rm = __builtin_fmaxf(a, b); { auto rr = __builtin_amdgcn_permlane32_swap(__float_as_uint(rm), __float_as_uint(rm), false, false); rm = __builtin_fmaxf(__uint_as_float(rr[0]), __uint_as_float(rr[1])); } \
      resc = false; \
      if (__builtin_expect(__any(rm > (float)THRL), 0)) { const float dl = __builtin_fmaxf(rm, 0.f); mhat += dl; \
        _Pragma("unroll") for (int r = 0; r < 16; ++r) { C0[r] -= dl; C1[r] -= dl; } \
        NEGM_SET(((t) + 1) >> 2); \
        const float f = __builtin_amdgcn_exp2f(-dl); l_reg *= f; if (hi == 0) wsf[r32] = f; resc = true; } \
      else if ((((t) + 1) & 3) == 0) { NEGM_SET(((t) + 1) >> 2); } } \
    SBAR(); \
    GAPB(o[0] = __builtin_amdgcn_mfma_f32_32x32x16_bf16(PAF(0), VFR(0), o[0], 0, 0, 0), C0, 0); \
    GAPB(o[1] = __builtin_amdgcn_mfma_f32_32x32x16_bf16(PAF(0), VFR(4), o[1], 0, 0, 0), C0, 4); \
    KRD(GL, 0); GAPB(o[0] = __builtin_amdgcn_mfma_f32_32x32x16_bf16(PAF(1), VFR(1), o[0], 0, 0, 0), C0, 8); \
    KRD(GL, 1); GAPB(o[1] = __builtin_amdgcn_mfma_f32_32x32x16_bf16(PAF(1), VFR(5), o[1], 0, 0, 0), C0, 12); \
    KRD(GL, 2); GAPB(o[0] = __builtin_amdgcn_mfma_f32_32x32x16_bf16(PAF(2), VFR(2), o[0], 0, 0, 0), C1, 0); \
    KRD(GL, 3); GAPB(o[1] = __builtin_amdgcn_mfma_f32_32x32x16_bf16(PAF(2), VFR(6), o[1], 0, 0, 0), C1, 4); \
    GAPB(o[0] = __builtin_amdgcn_mfma_f32_32x32x16_bf16(PAF(3), VFR(3), o[0], 0, 0, 0), C1, 8); \
    GAPB(o[1] = __builtin_amdgcn_mfma_f32_32x32x16_bf16(PAF(3), VFR(7), o[1], 0, 0, 0), C1, 12); \
    QRD(0); QRD(1); SBAR(); \
    } while (0)
  int t = 1;
  #undef CMASK
  #define CMASK(P0, P1, t) do {} while (0)
  for (; t + 5 < NT; t += 2) {
    STEP(pB0, pB1, pA0, pA1, t, true, true, true);     WAIT_BAR(2); RESC(); ROT();
    STEP(pA0, pA1, pB0, pB1, t + 1, true, true, true); WAIT_BAR(2); RESC(); ROT();
  }
  #undef CMASK
  #define CMASK(P0, P1, t) do { int jb_ = (t) - (NT - 4); if (jb_ >= 0) cmask(P0, P1, jb_, qrel, hi); } while (0)
  #define ENDW(tt) do { if ((tt) + 3 < NT) { WAIT_BAR(2); } else if ((tt) + 2 < NT) { WAIT_BAR(1); } else { WAIT_BAR(0); } } while (0)
  for (; t + 1 < NT; t += 2) {
    STEP(pB0, pB1, pA0, pA1, t, (t + 3 < NT), (t + 1 < NT), (t + 1 < NT));       ENDW(t);     RESC(); ROT();
    STEP(pA0, pA1, pB0, pB1, t + 1, (t + 4 < NT), (t + 2 < NT), (t + 2 < NT));   ENDW(t + 1); RESC(); ROT();
  }
  STEP(pB0, pB1, pA0, pA1, NT - 1, false, false, false); RESC();
  { float sacc = pB0[0] + pB0[1]; _Pragma("unroll") for (int r = 2; r < 16; ++r) sacc += pB0[r]; _Pragma("unroll") for (int r = 0; r < 16; ++r) sacc += pB1[r]; l_reg += sacc;
    pw0 = (u32x4){PKW(pB0, 0), PKW(pB0, 2), PKW(pB0, 4), PKW(pB0, 6)}; pw1 = (u32x4){PKW(pB0, 8), PKW(pB0, 10), PKW(pB0, 12), PKW(pB0, 14)}; pw2 = (u32x4){PKW(pB1, 0), PKW(pB1, 2), PKW(pB1, 4), PKW(pB1, 6)}; pw3 = (u32x4){PKW(pB1, 8), PKW(pB1, 10), PKW(pB1, 12), PKW(pB1, 14)};
    SBAR(); pv(o, vb0 + sl_cur, PAF(0), PAF(1), PAF(2), PAF(3)); }
  #undef PKW
  #undef PAF
  #undef VFR
  #undef PIN
  #undef MX3
  #undef GAPA
  #undef GAPB
  #undef EX
  #undef VRD
  #undef KRD
  #undef QRD
  #undef STEP
  #undef ENDW
  { auto rr = __builtin_amdgcn_permlane32_swap(__float_as_uint(l_reg), __float_as_uint(l_reg), false, false); l_reg = __uint_as_float(rr[0]) + __uint_as_float(rr[1]); }
  if (hi == 0) wsf[32 + r32] = l_reg; asm volatile("s_waitcnt lgkmcnt(0)" ::: "memory");
  float rli[16];
  #pragma unroll
  for (int r = 0; r < 16; ++r) rli[r] = __builtin_amdgcn_rcpf(wsf[32 + crow(r, hi)]);
  bf16_t* Ow = Ob + (rowbase + q0 + wid * QBLK) * DMQ + h * D;
  { bf16_t* stg = (bf16_t*)(shm + LDS_OST) + wid * 2048;
    #pragma unroll
    for (int r = 0; r < 16; ++r) { const int orow = crow(r, hi);
      #pragma unroll
      for (int d0 = 0; d0 < 2; ++d0) stg[orow * 64 + d0 * 32 + r32] = (bf16_t)f2bf(o[d0][r] * rli[r]); }
    asm volatile("s_waitcnt lgkmcnt(0)" ::: "memory");
    #pragma unroll
    for (int i = 0; i < 4; ++i) { const int row = i * 8 + (lane >> 3), ch = lane & 7; const u32x4 v = *(const u32x4*)(stg + row * 64 + ch * 8); ATTN_STORE16(Ow + (long)row * DMQ + ch * 8, v); } }
  asm volatile("s_waitcnt lgkmcnt(0)\n\ts_barrier" ::: "memory");
  #undef DMA_K
  #undef DMA_V
  #undef CMASK
  #undef START
  #undef RESC
  #undef ROT
  #undef SELROW
  #undef NEGM_SET
}
#undef SBAR
#undef WAIT_BAR
}
__device__ __forceinline__ void conv_pass(Frame& F) {
    bf16_t* YAB = WSP(bf16_t, WS_YAB); const bf16_t* U = WSP(bf16_t, WS_U); const bf16_t* BG = WSP(bf16_t, WS_BG);
    const int stride = F.G * NTHREADS;
    for (int i0 = blockIdx.x * NTHREADS + F.tid; i0 < T * 64; i0 += 2 * stride) {
        u32x4 r2[2], r1[2], r0[2], rb[2];
#pragma unroll
        for (int q = 0; q < 2; ++q) { const int i = i0 + q * stride; const int t = i >> 6, c0 = (i & 63) * 8, pos = t & (S - 1);
            r2[q] = *(const u32x4*)(U + (size_t)t * 512 + c0); rb[q] = __builtin_nontemporal_load((const u32x4*)(BG + (size_t)t * 512 + c0));
            r1[q] = (pos >= 1) ? *(const u32x4*)(U + (size_t)(t - 1) * 512 + c0) : (u32x4){0u, 0u, 0u, 0u};
            r0[q] = (pos >= 2) ? *(const u32x4*)(U + (size_t)(t - 2) * 512 + c0) : (u32x4){0u, 0u, 0u, 0u}; }
#pragma unroll
        for (int q = 0; q < 2; ++q) { const int i = i0 + q * stride; const int t = i >> 6, c0 = (i & 63) * 8;
            float u0[8], u1[8], u2[8], bg[8], y[8]; unpack8(r2[q], u2); unpack8(r1[q], u1); unpack8(r0[q], u0); unpack8(rb[q], bg);
#pragma unroll
            for (int e4 = 0; e4 < 2; ++e4) { const f32x4 w0 = *(const f32x4*)(F.conv_w + c0 + 4 * e4), w1 = *(const f32x4*)(F.conv_w + 512 + c0 + 4 * e4), w2 = *(const f32x4*)(F.conv_w + 1024 + c0 + 4 * e4), cb = *(const f32x4*)(F.conv_b + c0 + 4 * e4);
#pragma unroll
                for (int e = 0; e < 4; ++e) y[4 * e4 + e] = bg[4 * e4 + e] * (w0[e] * u0[4 * e4 + e] + w1[e] * u1[4 * e4 + e] + w2[e] * u2[4 * e4 + e] + cb[e]); }
            st16(YAB + (size_t)t * 1024 + 512 + c0, pack8(y)); }
    }
}
__device__ __forceinline__ void s3_attn(Frame& F, char* lds_gen, bf16_t* obase) {
    const int vcu = (blockIdx.x % 8) * (F.G / 8) + blockIdx.x / 8;
    const int s = vcu & 7, pr = vcu >> 3;
    for (int i = 0; i < 4; ++i) {
        const int bh = 2 * pr + (i >> 1), qb = (i & 1) ? 15 - s : s;
        attn_body::attn_unit<8>(bh >> 3, bh & 7, qb, WSP(bf16_t, WS_YAB), obase, WSP(bf16_t, WS_K), WSP(bf16_t, WS_V), WSP(float, WS_KMEAN), lds_gen);
    }
}
__device__ __forceinline__ void s3_fast(Frame& F, char* lds_gen) { s3_attn(F, lds_gen, WSP(bf16_t, WS_YAB)); conv_pass(F); }

__device__ __forceinline__ void s4_simple(Frame& F) {
    LAS float* tile = (LAS float*)F.lds; LAS float* tile2 = tile + 64 * 65;
    const bf16_t* YAB = WSP(bf16_t, WS_YAB); const bf16_t* WP = WSP(bf16_t, WS_WP_T); const bf16_t* GT = WSP(bf16_t, WS_GATES);
    const int row = F.tid >> 3, seg = F.tid & 7;
    for (int it = blockIdx.x; it < 512 * 16; it += F.G) {
        const int rt = it >> 4, ct = it & 15, r0 = rt * 64, gr = r0 + row;
        const RowsLinear aa{YAB + (size_t)r0 * 1024, 1024}, ab{YAB + (size_t)r0 * 1024 + 512, 1024};
        const RowsLinear ba{WP + (size_t)(64 * ct) * 1024, 1024}, bb{WP + (size_t)(64 * ct) * 1024 + 512, 1024};
        sgemm_tile(tile, 512, aa, ba, F.wave, F.lane); sgemm_tile(tile2, 512, ab, bb, F.wave, F.lane); __syncthreads();
        float ga[8], gb[8], v[8];
        unpack8(*(const u32x4*)(GT + (size_t)gr * 2048 + 64 * ct + 8 * seg), ga); unpack8(*(const u32x4*)(GT + (size_t)gr * 2048 + 1024 + 64 * ct + 8 * seg), gb);
#pragma unroll
        for (int e = 0; e < 8; ++e) v[e] = ga[e] * tile[row * 65 + 8 * seg + e] + gb[e] * tile2[row * 65 + 8 * seg + e];
        *(u32x4*)(WSP(bf16_t, WS_H) + (size_t)gr * 1024 + 64 * ct + 8 * seg) = pack8(v);
        __syncthreads();
    }
}
__device__ __forceinline__ void s5_simple(Frame& F) {
    LAS float* tile = (LAS float*)F.lds;
    const bf16_t* MG = WSP(bf16_t, WS_H); const bf16_t* WO = WSP(bf16_t, WS_WO_T);
    const int row = F.tid >> 3, seg = F.tid & 7;
    for (int it = blockIdx.x; it < 512 * 16; it += F.G) {
        const int rt = it >> 4, ct = it & 15, r0 = rt * 64, gr = r0 + row, b = r0 / S;
        const RowsLinear aa{MG + (size_t)r0 * 1024, 1024}, bb{WO + (size_t)(64 * ct) * 1024, 1024};
        sgemm_tile(tile, 1024, aa, bb, F.wave, F.lane); __syncthreads();
        const float* ga1 = WSP(float, WS_MOD) + (size_t)b * NMOD + 2048 + 64 * ct + 8 * seg;
        const float* xr = F.x + (size_t)gr * D + 64 * ct + 8 * seg; float* orow = F.out + (size_t)gr * D + 64 * ct + 8 * seg;
#pragma unroll
        for (int e4 = 0; e4 < 2; ++e4) { const f32x4 xv = *(const f32x4*)(xr + 4 * e4), gv = *(const f32x4*)(ga1 + 4 * e4); f32x4 o;
#pragma unroll
            for (int e = 0; e < 4; ++e) o[e] = xv[e] + gv[e] * tile[row * 65 + 8 * seg + 4 * e4 + e];
            *(f32x4*)(orow + 4 * e4) = o; }
        __syncthreads();
    }
}

struct EpiG2 {
    static constexpr bool HAS_MID = true;
    const bf16_t* gates; bf16_t* merged;
    __device__ __forceinline__ void mid(Acc& acc, const pg8::Unit& u, int wr, int wc, int fr, int fq) const {
        int row0 = u.pm * 256 + wr * 64 + fr; const int c0 = u.pn * 256 + 32 * wc + 8 * fq; asm volatile("" : "+v"(row0));
#pragma unroll
        for (int ai = 0; ai < 2; ++ai)
#pragma unroll
            for (int m = 0; m < 4; ++m) { const bf16_t* gp = gates + (size_t)(row0 + 128 * ai + 16 * m) * 2048 + c0;
#pragma unroll
                for (int bj = 0; bj < 2; ++bj) { f32x4 a0, a1; unpack8v(__builtin_nontemporal_load((const u32x4*)(gp + 128 * bj)), a0, a1);
                    acc[ai][bj][m][0] *= a0; acc[ai][bj][m][1] *= a1; } }
    }
    __device__ __forceinline__ void operator()(Acc& acc, const pg8::Unit& u, int wr, int wc, int fr, int fq) const {
        int row0 = u.pm * 256 + wr * 64 + fr; const int c0 = u.pn * 256 + 32 * wc + 8 * fq; asm volatile("" : "+v"(row0));
#pragma unroll
        for (int ai = 0; ai < 2; ++ai)
#pragma unroll
            for (int m = 0; m < 4; ++m) { const size_t r = (size_t)(row0 + 128 * ai + 16 * m);
#pragma unroll
                for (int bj = 0; bj < 2; ++bj) { f32x4 b0, b1; unpack8v(__builtin_nontemporal_load((const u32x4*)(gates + r * 2048 + 1024 + c0 + 128 * bj)), b0, b1);
                    st16(merged + r * 1024 + c0 + 128 * bj, pack8v(acc[ai][bj][m][0] * b0, acc[ai][bj][m][1] * b1)); } }
    }
};
__device__ __forceinline__ void s4_fast(Frame& F) {
    const pg8::DenseSched Sd{(const char*)(F.ws + WS_YAB), (const char*)(F.ws + WS_WP_T), T / 256, 4, 1024, F.G, (int)blockIdx.x};
    const EpiG2 E{WSP(bf16_t, WS_GATES), WSP(bf16_t, WS_H)};
    if (F.skip) pg8::gemm_phase<EpiG2, pg8::DenseSched, true>(F.lds, 1024, Sd, E); else pg8::gemm_phase<EpiG2, pg8::DenseSched>(F.lds, 1024, Sd, E);
}
struct EpiG3 {
    static constexpr bool HAS_MID = false;
    const float* x; bf16_t* x1; const float* mod;
    __device__ __forceinline__ void mid(Acc&, const pg8::Unit&, int, int, int, int) const {}
    __device__ __forceinline__ void operator()(Acc& acc, const pg8::Unit& u, int wr, int wc, int fr, int fq) const {
        int row0 = u.pm * 256 + wr * 64 + fr; const int c0 = u.pn * 256 + 32 * wc + 8 * fq, b = u.pm >> 4; asm volatile("" : "+v"(row0));
        f32x4 gv[2][2];
#pragma unroll
        for (int bj = 0; bj < 2; ++bj)
#pragma unroll
            for (int n = 0; n < 2; ++n) gv[bj][n] = *(const f32x4*)(mod + (size_t)b * NMOD + 2048 + c0 + 128 * bj + 4 * n);
#pragma unroll
        for (int ai = 0; ai < 2; ++ai)
#pragma unroll
            for (int m = 0; m < 4; ++m) { const size_t off = (size_t)(row0 + 128 * ai + 16 * m) * D + c0;
#pragma unroll
                for (int bj = 0; bj < 2; ++bj) { const f32x4 x0 = __builtin_nontemporal_load((const f32x4*)(x + off + 128 * bj)), x1v = __builtin_nontemporal_load((const f32x4*)(x + off + 128 * bj + 4));
                    st16(x1 + off + 128 * bj, pack8v(x0 + gv[bj][0] * acc[ai][bj][m][0], x1v + gv[bj][1] * acc[ai][bj][m][1])); }
                if (m == 3) asm volatile("" ::: "memory"); }
    }
};
__device__ __forceinline__ void s5_fast(Frame& F) {
    const pg8::DenseSched Sd{(const char*)(F.ws + WS_H), (const char*)(F.ws + WS_WO_T), T / 256, 4, 1024, F.G, (int)blockIdx.x};
    const EpiG3 E{F.x, WSP(bf16_t, WS_X1), WSP(float, WS_MOD)};
    if (F.skip) pg8::gemm_phase<EpiG3, pg8::DenseSched, true>(F.lds, 1024, Sd, E); else pg8::gemm_phase<EpiG3, pg8::DenseSched>(F.lds, 1024, Sd, E);
}
struct MoeTab { const LAS int* cnt; const LAS int* tstart; const LAS int* tile_e; int nM; };
__device__ __forceinline__ MoeTab moe_table(Frame& F) {
    LAS int* cntL = (LAS int*)(F.lds + MISC_OFF + 1024); LAS int* ts = cntL + 32; LAS int* te = cntL + 96;
    if (F.tid < 32) cntL[F.tid] = (int)__hip_atomic_load(WSP(unsigned, WS_CTL) + CW_GCNT + 64 * F.tid, __ATOMIC_RELAXED, __HIP_MEMORY_SCOPE_AGENT);
    __syncthreads();
    if (F.tid == 0) { int pm = 0; for (int e = 0; e < 32; ++e) { ts[e] = pm; const int n = (cntL[e] + 255) >> 8; for (int i = 0; i < n; ++i) te[pm++] = e; } ts[32] = pm; }
    __syncthreads();
    return MoeTab{cntL, ts, te, ts[32]};
}
struct MoeUpSched {
    static constexpr bool GATHER = true, FP8 = true;
    const char* h2; const char* w13; MoeTab tb; const int* linfo; int G, c;
    __device__ __forceinline__ bool next(int i, pg8::Unit& u) const { if (!pg8::static_unit(i, G, c, tb.nM, 4, u.pm, u.pn)) return false;
        u.e = tb.tile_e[u.pm]; u.rbase = (u.pm - tb.tstart[u.e]) * 256; u.a = h2; u.b = w13 + ((size_t)u.e * 1024 + 256 * u.pn) * 1024; return true; }
    __device__ __forceinline__ int row_index(const pg8::Unit& u, int r) const { const int rank = u.rbase + r; return rank < tb.cnt[u.e] ? (linfo[(size_t)u.e * 65536 + rank] >> 1) : 0; }
};
struct EpiUp {
    static constexpr bool HAS_MID = false;
    bf16_t* hid; const float* lw; const LAS int* cnt;
    __device__ __forceinline__ void mid(Acc&, const pg8::Unit&, int, int, int, int) const {}
    __device__ __forceinline__ void operator()(Acc& acc, const pg8::Unit& u, int wr, int wc, int fr, int fq) const {
        int rl0 = wr * 64 + fr; const int c0 = u.pn * 128 + 32 * wc + 8 * fq, n_e = cnt[u.e]; asm volatile("" : "+v"(rl0));
#pragma unroll
        for (int ai = 0; ai < 2; ++ai)
#pragma unroll
            for (int m = 0; m < 4; ++m) { const int rl = rl0 + 128 * ai + 16 * m, rank = u.rbase + rl; const float wt = rank < n_e ? 1.f : 0.f; f32x4 o[2];
#pragma unroll
                for (int n = 0; n < 2; ++n)
#pragma unroll
                    for (int e = 0; e < 4; ++e) { const float a = acc[ai][0][m][n][e] * (1.f / W8_SCALE), c = acc[ai][1][m][n][e] * (1.f / W8_SCALE); o[n][e] = a * __builtin_amdgcn_rcpf(1.f + __expf(-a)) * c * wt; }
                *(u32x2*)((unsigned char*)hid + (size_t)(u.pm * 256 + rl) * 512 + c0) = pack8_fp8(o[0], o[1]); }
    }
};
__device__ __forceinline__ void s8_fast(Frame& F) {
    const MoeTab tb = moe_table(F);
    const MoeUpSched Sd{(const char*)(F.ws + WS_H2), (const char*)(F.ws + WS_W13_T), tb, WSP(int, WS_LINFO), F.G, (int)blockIdx.x};
    const EpiUp E{WSP(bf16_t, WS_HID), WSP(float, WS_LW), tb.cnt};
    int Ku = D; asm volatile("" : "+s"(Ku));
    if (F.skip) pg8::gemm_phase<EpiUp, MoeUpSched, true>(F.lds, Ku, Sd, E); else pg8::gemm_phase<EpiUp, MoeUpSched>(F.lds, Ku, Sd, E);
    { int t_ = threadIdx.x; asm volatile("" : "+v"(t_)); F.tid = t_; F.lane = t_ & 63; }
    { const int units = tb.nM * 4, rem = units % F.G, nidle = (rem == 0) ? F.G : F.G - rem, me = (rem == 0) ? (int)blockIdx.x : (int)blockIdx.x - rem;
        if (me >= 0 && !F.skip) convert_items(F, X_W2, X_END, me * NWAVES + F.wave, nidle * NWAVES); }
}
struct MoeDownSched {
    static constexpr bool GATHER = false, FP8 = true;
    const char* hid; const char* w2; MoeTab tb; int G, c;
    __device__ __forceinline__ bool next(int i, pg8::Unit& u) const { if (!pg8::static_unit(i, G, c, tb.nM, 4, u.pm, u.pn)) return false;
        u.e = tb.tile_e[u.pm]; u.rbase = (u.pm - tb.tstart[u.e]) * 256; u.a = hid + (size_t)u.pm * 256 * 512; u.b = w2 + ((size_t)u.e * 1024 + 256 * u.pn) * 512; return true; }
    __device__ __forceinline__ int row_index(const pg8::Unit&, int) const { return 0; }
};
struct EpiDown {
    static constexpr bool HAS_MID = false;
    bf16_t* yslot; const int* linfo; const float* lw; const LAS int* cnt;
    __device__ __forceinline__ void mid(Acc&, const pg8::Unit&, int, int, int, int) const {}
    __device__ __forceinline__ void operator()(Acc& acc, const pg8::Unit& u, int wr, int wc, int fr, int fq) const {
        int rl0 = wr * 64 + fr; const int c0 = u.pn * 256 + 32 * wc + 8 * fq, n_e = cnt[u.e]; asm volatile("" : "+v"(rl0));
        int info[2][4]; float wt[2][4];
#pragma unroll
        for (int ai = 0; ai < 2; ++ai)
#pragma unroll
            for (int m = 0; m < 4; ++m) { const int rank = u.rbase + rl0 + 128 * ai + 16 * m, rc = rank < n_e ? rank : 0;
                info[ai][m] = linfo[(size_t)u.e * 65536 + rc]; wt[ai][m] = lw[(size_t)u.e * 65536 + rc] * (1.f / W8_SCALE); }
#pragma unroll
        for (int ai = 0; ai < 2; ++ai)
#pragma unroll
            for (int m = 0; m < 4; ++m) { const int rank = u.rbase + rl0 + 128 * ai + 16 * m;
                if (rank < n_e) {
#pragma unroll
                    for (int bj = 0; bj < 2; ++bj) st16(yslot + (size_t)info[ai][m] * 1024 + c0 + 128 * bj, pack8v(acc[ai][bj][m][0] * wt[ai][m], acc[ai][bj][m][1] * wt[ai][m])); } }
    }
};
__device__ __forceinline__ void s9_fast(Frame& F) {
    const MoeTab tb = moe_table(F);
    const MoeDownSched Sd{(const char*)(F.ws + WS_HID), (const char*)(F.ws + WS_W2_T), tb, F.G, (int)blockIdx.x};
    const EpiDown E{WSP(bf16_t, WS_YSLOT), WSP(int, WS_LINFO), WSP(float, WS_LW), tb.cnt};
    int Kd = DE; asm volatile("" : "+s"(Kd));
    if (F.skip) pg8::gemm_phase<EpiDown, MoeDownSched, true>(F.lds, Kd, Sd, E); else pg8::gemm_phase<EpiDown, MoeDownSched>(F.lds, Kd, Sd, E);
}

__device__ __forceinline__ void s6_router(Frame& F) {
    constexpr int WROW = 1032;
    LAS bf16_t* WT = (LAS bf16_t*)F.lds;
    LAS float* gsL = (LAS float*)(F.lds + 48 * WROW * 2);
    LAS float* shL = gsL + 1024;
    LAS float* biasL = shL + 1024;
    LAS float* lgt = biasL + 64;
    LAS int* cnt = (LAS int*)(F.lds + MISC_OFF + 256);
    LAS int* baseL = cnt + 32; LAS int* runL = cnt + 64; LAS int* eidL = cnt + 128; LAS float* ewL = (LAS float*)(cnt + 384);
    const int b = blockIdx.x >> 5;
    const float* mod = WSP(float, WS_MOD) + (size_t)b * NMOD;
    const float* W36 = WSP(float, WS_W36T);
    for (int i = F.tid; i < 36 * 256; i += NTHREADS) { const int jj = i >> 8, k4 = (i & 255) * 4; const f32x4 w = *(const f32x4*)(W36 + jj * 1024 + k4);
        u32x2 p; p.x = pk2(w.x, w.y); p.y = pk2(w.z, w.w); *(LAS u32x2*)(WT + jj * WROW + k4) = p; }
    for (int i = F.tid; i < 12 * 256; i += NTHREADS) { const int jj = 36 + (i >> 8), k4 = (i & 255) * 4; *(LAS u32x2*)(WT + jj * WROW + k4) = (u32x2){0u, 0u}; }
    if (F.tid < 256) { const int col = 4 * F.tid; const f32x4 g = *(const f32x4*)(F.g2 + col), s_ = *(const f32x4*)(mod + 4096 + col); *(LAS f32x4*)(gsL + col) = g * (s_ + 1.0f); *(LAS f32x4*)(shL + col) = *(const f32x4*)(mod + 3072 + col); }
    if (F.tid < 32) cnt[F.tid] = 0;
    __syncthreads();
    for (int jj = F.wave; jj < 36; jj += NWAVES) { float a = 0.f;
#pragma unroll
        for (int i = 0; i < 16; ++i) a += shL[F.lane + 64 * i] * W36[jj * 1024 + F.lane + 64 * i];
        a = wave_sum(a); if (F.lane == 0) biasL[jj] = a + ((jj < 4) ? F.b_rg[jj] : F.b_re[jj - 4]); }
    __syncthreads();
    const int fr = F.lane & 15, fq = F.lane >> 4, row0 = (blockIdx.x * NWAVES + F.wave) * 16, r = row0 + fr;
    const bf16_t* xr = WSP(bf16_t, WS_X1) + (size_t)r * D + 8 * fq;
    f32x4 D0 = {0.f, 0.f, 0.f, 0.f}, D1 = D0, D2 = D0; float ss = 0.f;
#pragma unroll 1
    for (int kb = 0; kb < 8; ++kb) {
        u32x4 xa[4];
#pragma unroll
        for (int i = 0; i < 4; ++i) xa[i] = *(const u32x4*)(xr + 32 * (4 * kb + i));
#pragma unroll
        for (int i = 0; i < 4; ++i) { const int k0 = 32 * (4 * kb + i) + 8 * fq;
            f32x4 a0, a1; unpack8v(xa[i], a0, a1);
            ss += (a0.x * a0.x + a0.y * a0.y) + (a0.z * a0.z + a0.w * a0.w) + (a1.x * a1.x + a1.y * a1.y) + (a1.z * a1.z + a1.w * a1.w);
            a0 *= *(const LAS f32x4*)(gsL + k0); a1 *= *(const LAS f32x4*)(gsL + k0 + 4);
            const bf16x8 A = __builtin_bit_cast(bf16x8, pack8v(a0, a1));
            const bf16x8 B0 = *(const LAS bf16x8*)(WT + fr * WROW + k0), B1 = *(const LAS bf16x8*)(WT + (16 + fr) * WROW + k0), B2 = *(const LAS bf16x8*)(WT + (32 + fr) * WROW + k0);
            D0 = __builtin_amdgcn_mfma_f32_16x16x32_bf16(A, B0, D0, 0, 0, 0);
            D1 = __builtin_amdgcn_mfma_f32_16x16x32_bf16(A, B1, D1, 0, 0, 0);
            D2 = __builtin_amdgcn_mfma_f32_16x16x32_bf16(A, B2, D2, 0, 0, 0); }
    }
    ss += __shfl_xor(ss, 16); ss += __shfl_xor(ss, 32);
    const float rinv = rsqrtf(ss * (1.f / D) + EPS);
    { int t2 = threadIdx.x; asm volatile("" : "+v"(t2)); F.lane = t2 & 63; }
    const int fr_ = F.lane & 15, fq_ = F.lane >> 4;
    {
        LAS float* lw = lgt + F.wave * 16 * 37;
#pragma unroll
        for (int reg = 0; reg < 4; ++reg) { const float rv = __shfl(rinv, 4 * fq_ + reg); const int tk = 4 * fq_ + reg;
            lw[tk * 37 + fr_] = D0[reg] * rv + biasL[fr_]; lw[tk * 37 + 16 + fr_] = D1[reg] * rv + biasL[16 + fr_];
            if (fr_ < 4) lw[tk * 37 + 32 + fr_] = D2[reg] * rv + biasL[32 + fr_]; }
    }
    {
        const int r_ = row0 + fr_; const bf16_t* xr_ = WSP(bf16_t, WS_X1) + (size_t)r_ * D + 8 * fq_;
        unsigned char* o = WSP(unsigned char, WS_H2) + (size_t)r_ * D + 8 * fq_;
#pragma unroll 1
        for (int kb = 0; kb < 8; ++kb) {
            u32x4 xa[4];
#pragma unroll
            for (int i = 0; i < 4; ++i) xa[i] = *(const u32x4*)(xr_ + 32 * (4 * kb + i));
#pragma unroll
            for (int i = 0; i < 4; ++i) { const int k0 = 32 * (4 * kb + i) + 8 * fq_; f32x4 a0, a1; unpack8v(xa[i], a0, a1);
                const f32x4 h0 = a0 * rinv * *(const LAS f32x4*)(gsL + k0) + *(const LAS f32x4*)(shL + k0), h1 = a1 * rinv * *(const LAS f32x4*)(gsL + k0 + 4) + *(const LAS f32x4*)(shL + k0 + 4);
                *(u32x2*)(o + 32 * (4 * kb + i)) = pack8_fp8(h0, h1); }
        }
    }
    if (F.lane < 16) {
        const int t = row0 + F.lane; const LAS float* lw = lgt + (F.wave * 16 + F.lane) * 37;
        float lg[36];
#pragma unroll
        for (int jj = 0; jj < 36; ++jj) lg[jj] = lw[jj];
        int gi = 0; float gm = lg[0];
#pragma unroll
        for (int i = 1; i < 4; ++i) if (lg[i] > gm) { gm = lg[i]; gi = i; }
        float den = 0.f;
#pragma unroll
        for (int i = 0; i < 4; ++i) den += __expf(lg[i] - gm);
        const float gw_ = 1.f / den;
        float v1 = -INFINITY, v2 = -INFINITY; int e1 = 0, e2 = 0;
#pragma unroll
        for (int i = 0; i < 8; ++i) { const float el = (gi == 0) ? lg[4 + i] : (gi == 1) ? lg[12 + i] : (gi == 2) ? lg[20 + i] : lg[28 + i];
            const bool c1 = el > v1, c2 = el > v2;
            v2 = c1 ? v1 : (c2 ? el : v2); e2 = c1 ? e1 : (c2 ? i : e2); v1 = c1 ? el : v1; e1 = c1 ? i : e1; }
        const float p1 = 1.f / (1.f + __expf(v2 - v1)), p2 = 1.f - p1;
        const int id1 = gi * 8 + e1, id2 = gi * 8 + e2;
        const int la = 2 * (F.wave * 16 + F.lane);
        eidL[la] = id1; eidL[la + 1] = id2; ewL[la] = p1 * gw_; ewL[la + 1] = p2 * gw_;
        lds_add(&cnt[id1], 1); lds_add(&cnt[id2], 1);
    }
    __syncthreads();
    if (F.tid < 32) { baseL[F.tid] = (int)__hip_atomic_fetch_add(WSP(unsigned, WS_CTL) + CW_GCNT + 64 * F.tid, (unsigned)cnt[F.tid], __ATOMIC_RELAXED, __HIP_MEMORY_SCOPE_AGENT); runL[F.tid] = 0; }
    __syncthreads();
    if (F.tid < 256) { const int e = eidL[F.tid]; const int pos = baseL[e] + lds_add(&runL[e], 1);
        WSP(int, WS_LINFO)[(size_t)e * 65536 + pos] = 2 * (blockIdx.x * 128) + F.tid; WSP(float, WS_LW)[(size_t)e * 65536 + pos] = ewL[F.tid]; }
    __syncthreads();
    convert_items(F, X_NONEXP, X_W2, blockIdx.x * NWAVES + F.wave, F.G * NWAVES);
}

__device__ __forceinline__ void s7_lists(Frame& F) {
    LAS int* sm = (LAS int*)F.lds;
    const int* bc = WSP(int, WS_BCNT);
    if (F.tid < 32) { int tot = 0, base = 0; for (int bb = 0; bb < 256; ++bb) { const int c = bc[bb * 32 + F.tid]; if (bb < (int)blockIdx.x) base += c; tot += c; }
        sm[F.tid] = tot; sm[32 + F.tid] = base; sm[96 + F.tid] = 0; }
    __syncthreads();
    if (F.tid == 0) { int ps = 0; for (int e = 0; e < 32; ++e) { sm[64 + e] = ps; ps += (sm[e] + 255) & ~255; }
        if (blockIdx.x == 0) { int* te = WSP(int, WS_TILEE); int pm = 0; for (int e = 0; e < 32; ++e) { const int n = (sm[e] + 255) >> 8; for (int i = 0; i < n; ++i) te[1 + pm++] = e; } te[0] = pm; } }
    __syncthreads();
    int* atok = WSP(int, WS_ATOK); int* ainfo = WSP(int, WS_AINFO); float* aw = WSP(float, WS_AW);
    if (F.tid < 256) { const int a = blockIdx.x * 256 + F.tid;
        const int e = WSP(int, WS_EID)[a]; const int rank = lds_add(&sm[96 + e], 1); const int pos = sm[64 + e] + sm[32 + e] + rank;
        atok[pos] = a >> 1; ainfo[pos] = a; aw[pos] = WSP(float, WS_EW)[a]; }
    if (blockIdx.x < 32) { const int e = blockIdx.x; const int lo = sm[64 + e] + sm[e], hi = sm[64 + e] + ((sm[e] + 255) & ~255);
        for (int p = lo + F.tid; p < hi; p += NTHREADS) { atok[p] = 0; ainfo[p] = -1; aw[p] = 0.f; } }
}

struct RowsGather { const bf16_t* base; const int* idx; __device__ __forceinline__ const bf16_t* operator()(int r) const { return base + (size_t)idx[r] * 1024; } };
__device__ __forceinline__ void s8_simple(Frame& F) {
    LAS float* tile = (LAS float*)F.lds; LAS float* tile2 = tile + 64 * 65;
    const int* te = WSP(int, WS_TILEE); const int nmt = te[0];
    const int row = F.tid >> 3, seg = F.tid & 7;
    for (int it = blockIdx.x; it < nmt * 4 * 8; it += F.G) {
        const int rt = it >> 3, ct = it & 7, e = te[1 + (rt >> 2)], pos0 = 64 * rt, hc = 64 * ct;
        const RowsGather ar{WSP(bf16_t, WS_H2), WSP(int, WS_ATOK) + pos0};
        const bf16_t* wb = WSP(bf16_t, WS_W13_T) + ((size_t)e * 1024 + 256 * (hc >> 7) + (hc & 127)) * 1024;
        const RowsLinear b1{wb, 1024}, b3{wb + (size_t)128 * 1024, 1024};
        sgemm_tile(tile, 1024, ar, b1, F.wave, F.lane); sgemm_tile(tile2, 1024, ar, b3, F.wave, F.lane); __syncthreads();
        const float wt = WSP(float, WS_AW)[pos0 + row]; float v[8];
#pragma unroll
        for (int e8 = 0; e8 < 8; ++e8) { const float a = tile[row * 65 + 8 * seg + e8], c = tile2[row * 65 + 8 * seg + e8]; v[e8] = (a / (1.f + __expf(-a))) * c * wt; }
        *(u32x4*)(WSP(bf16_t, WS_HID) + (size_t)(pos0 + row) * 512 + hc + 8 * seg) = pack8(v);
        __syncthreads();
    }
}
__device__ __forceinline__ void s9_simple(Frame& F) {
    LAS float* tile = (LAS float*)F.lds;
    const int* te = WSP(int, WS_TILEE); const int nmt = te[0];
    const int row = F.tid >> 3, seg = F.tid & 7;
    for (int it = blockIdx.x; it < nmt * 4 * 16; it += F.G) {
        const int rt = it >> 4, ct = it & 15, e = te[1 + (rt >> 2)], pos0 = 64 * rt;
        const RowsLinear ar{WSP(bf16_t, WS_HID) + (size_t)pos0 * 512, 512};
        const RowsLinear br{WSP(bf16_t, WS_W2_T) + ((size_t)e * 1024 + 64 * ct) * 512, 512};
        sgemm_tile(tile, 512, ar, br, F.wave, F.lane); __syncthreads();
        const int info = WSP(int, WS_AINFO)[pos0 + row];
        if (info >= 0) { float v[8];
#pragma unroll
            for (int e8 = 0; e8 < 8; ++e8) v[e8] = tile[row * 65 + 8 * seg + e8];
            *(u32x4*)(WSP(bf16_t, WS_YSLOT) + (size_t)info * 1024 + 64 * ct + 8 * seg) = pack8(v); }
        __syncthreads();
    }
}
__device__ __forceinline__ void s10_combine(Frame& F) {
    const bf16_t* Y = WSP(bf16_t, WS_YSLOT); const bf16_t* X1 = WSP(bf16_t, WS_X1);
    const int stride = F.G * NTHREADS;
    for (int i0 = blockIdx.x * NTHREADS + F.tid; i0 < T * 128; i0 += 2 * stride) {
        u32x4 ya[2], yb[2], xx[2]; f32x4 g0[2], g1[2];
#pragma unroll
        for (int q = 0; q < 2; ++q) { const int i = i0 + q * stride; const int t = i >> 7, c0 = (i & 127) * 8, b = t / S;
            ya[q] = __builtin_nontemporal_load((const u32x4*)(Y + (size_t)(2 * t) * 1024 + c0)); yb[q] = __builtin_nontemporal_load((const u32x4*)(Y + (size_t)(2 * t + 1) * 1024 + c0)); xx[q] = __builtin_nontemporal_load((const u32x4*)(X1 + (size_t)t * D + c0));
            const float* ga2 = WSP(float, WS_MOD) + (size_t)b * NMOD + 5120 + c0; g0[q] = *(const f32x4*)ga2; g1[q] = *(const f32x4*)(ga2 + 4); }
#pragma unroll
        for (int q = 0; q < 2; ++q) { const int i = i0 + q * stride; const int t = i >> 7, c0 = (i & 127) * 8;
            f32x4 y0a, y0b, y1a, y1b, xa, xb; unpack8v(ya[q], y0a, y0b); unpack8v(yb[q], y1a, y1b); unpack8v(xx[q], xa, xb);
            float* o = F.out + (size_t)t * D + c0;
            __builtin_nontemporal_store(xa + g0[q] * (y0a + y1a), (f32x4*)o); __builtin_nontemporal_store(xb + g1[q] * (y0b + y1b), (f32x4*)(o + 4)); }
    }
}

constexpr int N_PHASES = 11;
struct Args { const float* in[21]; float* out; unsigned char* ws; int ph_lo, ph_hi; };
__global__ void __launch_bounds__(NTHREADS, 2) mega_fwd(Args args) {
    extern __shared__ __attribute__((aligned(16))) unsigned char lds_raw[];
    Frame F;
    F.lds = (LAS unsigned char*)lds_raw;
    F.tid = threadIdx.x; F.lane = F.tid & 63; F.wave = __builtin_amdgcn_readfirstlane(F.tid >> 6); F.G = gridDim.x; F.skip = 0;
    F.x = args.in[0]; F.c = args.in[1]; F.w_ada = args.in[2]; F.b_ada = args.in[3]; F.g1 = args.in[4]; F.g2 = args.in[5]; F.w_in = args.in[6]; F.g_q = args.in[7]; F.g_k = args.in[8];
    F.conv_w = args.in[9]; F.conv_b = args.in[10]; F.w_pa = args.in[11]; F.w_pb = args.in[12]; F.w_o = args.in[13]; F.w_rg = args.in[14]; F.b_rg = args.in[15]; F.w_re = args.in[16]; F.b_re = args.in[17];
    F.w1 = args.in[18]; F.w3 = args.in[19]; F.w2 = args.in[20]; F.out = args.out; F.ws = args.ws;
    volatile LAS unsigned* MISC = (volatile LAS unsigned*)(F.lds + MISC_OFF);
    if (F.tid < 64) MISC[F.tid] = 0u;
    __syncthreads();
    XcdBarrier bar = xcd_barrier_post((unsigned*)(F.ws + WS_CTL) + CW_BAR, MISC + 8);
    const int lo = args.ph_lo, hi = args.ph_hi;
    unsigned long long pst0 = 0, pst1 = 0;
#define PHASE(k, body) if (lo <= (k) && (k) < hi) { if (PROBE_PHASE == (k)) pst0 = __builtin_amdgcn_s_memrealtime(); for (int rep_ = 0; rep_ < 1 + ((REPEAT_MASK >> (k)) & 1); ++rep_) { { int t_ = threadIdx.x; asm volatile("" : "+v"(t_)); F.tid = t_; F.lane = t_ & 63; } body; __syncthreads(); } if ((NOEPI_MASK >> (k)) & 1) { int s_ = 1; asm volatile("" : "+s"(s_)); F.skip = s_; { int t_ = threadIdx.x; asm volatile("" : "+v"(t_)); F.tid = t_; F.lane = t_ & 63; } body; __syncthreads(); F.skip = 0; } if ((k) + 1 < hi) xcd_barrier(bar); if (PROBE_PHASE == (k)) pst1 = __builtin_amdgcn_s_memrealtime(); }
    PHASE(0, s0_prologue(F); wait_mod(F); s1_norm1(F))
    PHASE(2, s2_fast(F))
    PHASE(3, s3_fast(F, (char*)lds_raw))
    PHASE(4, s4_fast(F))
    PHASE(5, s5_fast(F))
    PHASE(6, s6_router(F))
    PHASE(8, s8_fast(F))
    PHASE(9, s9_fast(F))
    PHASE(10, s10_combine(F))
#undef PHASE
    if (PROBE_PHASE >= 0 && blockIdx.x == 0) { const unsigned long long t0 = __builtin_amdgcn_s_memrealtime(), dt = pst1 - pst0; while (__builtin_amdgcn_s_memrealtime() - t0 < dt) __builtin_amdgcn_s_sleep(8); }
}

extern "C" void kernel_launch(void* const* d_in, const int* in_sizes, int n_in, void* d_out, int out_size, void* d_ws, size_t ws_size, hipStream_t stream) {
    static int grid = 0;
    if (grid == 0) {
        if (n_in != 21 || in_sizes[0] != T * D || out_size != T * D || ws_size < WS_END) { fprintf(stderr, "kernel_launch: unexpected shapes (n_in %d, in0 %d, out %d, ws %zu); nothing launched\n", n_in, n_in > 0 ? in_sizes[0] : -1, out_size, ws_size); grid = -1; return; }
        int dev = 0, cus = 0, per_cu = 0;
        if (hipGetDevice(&dev) != hipSuccess || hipDeviceGetAttribute(&cus, hipDeviceAttributeMultiprocessorCount, dev) != hipSuccess) { grid = -1; return; }
        if (hipFuncSetAttribute((const void*)mega_fwd, hipFuncAttributeMaxDynamicSharedMemorySize, LDS_BYTES) != hipSuccess) { fprintf(stderr, "kernel_launch: hipFuncSetAttribute failed\n"); grid = -1; return; }
        if (hipOccupancyMaxActiveBlocksPerMultiprocessor(&per_cu, (const void*)mega_fwd, NTHREADS, LDS_BYTES) != hipSuccess || per_cu < 1) { fprintf(stderr, "kernel_launch: occupancy query says %d blocks per CU\n", per_cu); per_cu = 1; }
        (void)hipGetLastError();
        if (cus < 256) { fprintf(stderr, "kernel_launch: built for a 256-CU device, found %d CUs; nothing launched\n", cus); grid = -1; return; }
        grid = 256;
    }
    if (grid < 0) return;
    (void)hipMemsetAsync((char*)d_ws + WS_CTL, 0, CTL_ZERO_BYTES, stream);
    Args a{};
    for (int i = 0; i < 21; ++i) a.in[i] = (const float*)d_in[i];
    a.out = (float*)d_out; a.ws = (unsigned char*)d_ws; a.ph_lo = 0; a.ph_hi = N_PHASES;
    hipLaunchKernelGGL(mega_fwd, dim3(grid), dim3(NTHREADS), LDS_BYTES, stream, a);
}
```

```cpp
#include <hip/hip_runtime.h>
#include <hip/hip_bf16.h>
#include <cstdio>
#include <cstdint>

#ifndef REPEAT_MASK
#define REPEAT_MASK 0
#define NOEPI_MASK 0
#endif
#ifndef PROBE_PHASE
#define PROBE_PHASE -1
#endif
#define GAS __attribute__((address_space(1)))
#define LAS __attribute__((address_space(3)))
typedef unsigned short bf16_t;
typedef short bf16x8 __attribute__((ext_vector_type(8)));
typedef float f32x4 __attribute__((ext_vector_type(4)));
typedef unsigned u32x4 __attribute__((ext_vector_type(4)));
typedef unsigned u32x2 __attribute__((ext_vector_type(2)));

constexpr int T = 32768, D = 1024, NB = 8, S = 4096, NH = 8, DH = 64, NIN = 5120, NE = 32, DE = 512, NMOD = 6144;
constexpr int NTHREADS = 512, NWAVES = 8;
constexpr float EPS = 1e-6f;
constexpr float C2 = 0.125f * 1.4426950408889634f;
constexpr int MAX_MT = 288;
constexpr int NPAD = MAX_MT * 256;

constexpr size_t MiB = 1u << 20, KiB = 1024;
constexpr size_t WS_CTL = 0, CTL_ZERO_BYTES = 64 * KiB;
constexpr size_t WS_MOD = 1 * MiB;
constexpr size_t WS_ROPE = 1 * MiB + 256 * KiB;
constexpr size_t WS_KMEAN = 1 * MiB + 512 * KiB;
constexpr size_t WS_EID = 2 * MiB;
constexpr size_t WS_EW = 2 * MiB + 256 * KiB;
constexpr size_t WS_BCNT = 2 * MiB + 512 * KiB;
constexpr size_t WS_TILEE = 2 * MiB + 768 * KiB;
constexpr size_t WS_ATOK = 3 * MiB;
constexpr size_t WS_AINFO = 3 * MiB + 512 * KiB;
constexpr size_t WS_AW = 4 * MiB;
constexpr size_t WS_W36T = 5 * MiB;
constexpr size_t WS_WIN_T = 8 * MiB;
constexpr size_t WS_WIN8 = 14 * MiB;
constexpr size_t WS_H8 = 56 * MiB;
constexpr size_t WS_WP_T = 18 * MiB;
constexpr size_t WS_WO_T = 20 * MiB;
constexpr size_t WS_W13_T = 24 * MiB;
constexpr size_t WS_W2_T = 88 * MiB;
constexpr size_t WS_H = 120 * MiB;
constexpr size_t WS_YAB = 184 * MiB;
constexpr size_t WS_K = 248 * MiB;
constexpr size_t WS_V = 280 * MiB;
constexpr size_t WS_U = 312 * MiB;
constexpr size_t WS_BG = 344 * MiB;
constexpr size_t WS_GATES = 376 * MiB;
constexpr size_t WS_X1 = 184 * MiB;
constexpr size_t WS_H2 = 120 * MiB;
constexpr size_t WS_HID = 248 * MiB;
constexpr size_t WS_YSLOT = 320 * MiB;
constexpr size_t WS_LINFO = 448 * MiB;
constexpr size_t WS_LW = 456 * MiB;
constexpr size_t WS_END = 504 * MiB;
constexpr int CW_BAR = 4096, CW_MODCNT = 8192, CW_GCNT = 12288;

constexpr int LDS_BYTES = 159744;
constexpr int MISC_OFF = 147456;

__device__ __forceinline__ unsigned f2bf(float f) { unsigned u = __builtin_bit_cast(unsigned, f); return (u + 0x7fffu + ((u >> 16) & 1u)) >> 16; }
__device__ __forceinline__ float bf2f(unsigned h) { return __builtin_bit_cast(float, h << 16); }
typedef float f32x2_h __attribute__((ext_vector_type(2)));
typedef __bf16 bf16x2_h __attribute__((ext_vector_type(2)));
__device__ __forceinline__ unsigned pk2(float lo, float hi) { const f32x2_h v = {lo, hi}; return __builtin_bit_cast(unsigned, __builtin_convertvector(v, bf16x2_h)); }
__device__ __forceinline__ void unpack8(const u32x4 w, float (&v)[8]) {
    v[0] = bf2f(w.x & 0xffffu); v[1] = bf2f(w.x >> 16); v[2] = bf2f(w.y & 0xffffu); v[3] = bf2f(w.y >> 16);
    v[4] = bf2f(w.z & 0xffffu); v[5] = bf2f(w.z >> 16); v[6] = bf2f(w.w & 0xffffu); v[7] = bf2f(w.w >> 16);
}
__device__ __forceinline__ u32x4 pack8(const float (&v)[8]) { u32x4 w; w.x = pk2(v[0], v[1]); w.y = pk2(v[2], v[3]); w.z = pk2(v[4], v[5]); w.w = pk2(v[6], v[7]); return w; }
__device__ __forceinline__ u32x4 pack8v(const f32x4 a, const f32x4 b) { u32x4 w; w.x = pk2(a.x, a.y); w.y = pk2(a.z, a.w); w.z = pk2(b.x, b.y); w.w = pk2(b.z, b.w); return w; }
__device__ __forceinline__ void unpack8v(const u32x4 w, f32x4& a, f32x4& b) {
    a.x = bf2f(w.x & 0xffffu); a.y = bf2f(w.x >> 16); a.z = bf2f(w.y & 0xffffu); a.w = bf2f(w.y >> 16);
    b.x = bf2f(w.z & 0xffffu); b.y = bf2f(w.z >> 16); b.z = bf2f(w.w & 0xffffu); b.w = bf2f(w.w >> 16); }
#ifndef WT_STORES
#define WT_STORES 0
#define NT_STORES 1
#endif
__device__ __forceinline__ void st16(void* p, const u32x4 v) {
#if WT_STORES
    asm volatile("global_store_dwordx4 %0, %1, off sc1\n\ts_nop 1" :: "v"(p), "v"(v) : "memory");
#elif NT_STORES
    __builtin_nontemporal_store(v, (u32x4*)p);
#else
    *(u32x4*)p = v;
#endif
}
typedef int i32x8 __attribute__((ext_vector_type(8)));
__device__ __forceinline__ u32x2 pack8_fp8(const f32x4 a, const f32x4 b) {
    int lo = 0, hi = 0;
    lo = __builtin_amdgcn_cvt_pk_fp8_f32(a.x, a.y, lo, false); lo = __builtin_amdgcn_cvt_pk_fp8_f32(a.z, a.w, lo, true);
    hi = __builtin_amdgcn_cvt_pk_fp8_f32(b.x, b.y, hi, false); hi = __builtin_amdgcn_cvt_pk_fp8_f32(b.z, b.w, hi, true);
    return (u32x2){(unsigned)lo, (unsigned)hi};
}
constexpr float W8_SCALE = 64.f;
#define LDS_WAIT() asm volatile("s_waitcnt lgkmcnt(0)" ::: "memory")
__device__ __forceinline__ int lds_add(LAS int* p, int v) { return __hip_atomic_fetch_add(p, v, __ATOMIC_RELAXED, __HIP_MEMORY_SCOPE_WORKGROUP); }

#define XB_TMO      128
#define XB_XCNT(j)  (256  + 64 * (j))
#define XB_XSUB(j)  (1280 + 64 * (j))
#define XB_XGEN(j)  (2304 + 64 * (j))
#define XB_TOP      3328
#define XB_TOPGEN   3392
#define XCD_BAR_WORDS 3456
#define XB_SPIN_CAP (1u << 22)
__device__ __forceinline__ unsigned xb_ld(unsigned* p)              { return __hip_atomic_load(p, __ATOMIC_RELAXED, __HIP_MEMORY_SCOPE_AGENT); }
__device__ __forceinline__ unsigned xb_add(unsigned* p, unsigned v) { return __hip_atomic_fetch_add(p, v, __ATOMIC_RELAXED, __HIP_MEMORY_SCOPE_AGENT); }
__device__ __forceinline__ unsigned xb_xcc_id() { return (unsigned)__builtin_amdgcn_s_getreg((3 << 11) | 20) & 0xFu; }
#define XB_SPIN(cond, bar) do { unsigned _sp = 0; while (cond) { __builtin_amdgcn_s_sleep(1); \
    if ((++_sp & 255u) == 0u) { if (xb_ld(&(bar)[XB_TMO])) break; if (_sp > XB_SPIN_CAP) { atomicAdd(&(bar)[XB_TMO], 1u); break; } } } } while (0)
struct XcdBarrier { unsigned* bar; unsigned x; volatile LAS unsigned* st; };
__device__ __forceinline__ XcdBarrier xcd_barrier_post(unsigned* bar, volatile LAS unsigned* st) {
    XcdBarrier b; b.bar = bar; b.x = xb_xcc_id(); b.st = st;
    if (threadIdx.x == 0) (void)xb_add(&bar[XB_XCNT(b.x)], 1u);
    return b;
}
__device__ __forceinline__ void xcd_barrier_complete(unsigned* bar, unsigned x, unsigned& nloc, unsigned& nx) {
    const unsigned G = gridDim.x * gridDim.y * gridDim.z;
    unsigned sum, cnt, mine, sp = 0u;
    for (;;) {
        sum = 0u; cnt = 0u; mine = 0u;
#pragma unroll
        for (unsigned j = 0; j < 16; ++j) { const unsigned c = xb_ld(&bar[XB_XCNT(j)]); sum += c; cnt += (c > 0u) ? 1u : 0u; mine = (j == x) ? c : mine; }
        if (sum == G) break;
        __builtin_amdgcn_s_sleep(1);
        if ((++sp & 255u) == 0u) { if (xb_ld(&bar[XB_TMO])) break; if (sp > XB_SPIN_CAP) { atomicAdd(&bar[XB_TMO], 1u); break; } }
    }
    nloc = mine > 0u ? mine : 1u; nx = cnt > 0u ? cnt : 1u;
}
__device__ __forceinline__ void xcd_barrier(const XcdBarrier& b) {
    asm volatile("s_waitcnt vmcnt(0)" ::: "memory");
    __syncthreads();
    if (threadIdx.x == 0) {
        unsigned* bar = b.bar;
        __builtin_amdgcn_s_waitcnt(0);
        unsigned nloc = b.st[0], nx = b.st[1];
        if (nloc == 0u) { xcd_barrier_complete(bar, b.x, nloc, nx); b.st[0] = nloc; b.st[1] = nx; }
        const unsigned old = xb_add(&bar[XB_XSUB(b.x)], 1u);
        const unsigned gen = old / nloc;
        if (old + 1u == (gen + 1u) * nloc) {
            __builtin_amdgcn_fence(__ATOMIC_RELEASE, "agent");
            asm volatile("s_waitcnt vmcnt(0)" ::: "memory");
            const unsigned og = xb_add(&bar[XB_TOP], 1u);
            const unsigned tg = og / nx;
            if (og + 1u == (tg + 1u) * nx) xb_add(&bar[XB_TOPGEN], 1u);
            else XB_SPIN(xb_ld(&bar[XB_TOPGEN]) == tg, bar);
            __builtin_amdgcn_fence(__ATOMIC_ACQUIRE, "agent");
            xb_add(&bar[XB_XGEN(b.x)], 1u);
            asm volatile("s_waitcnt vmcnt(0)" ::: "memory");
        } else {
            XB_SPIN(xb_ld(&bar[XB_XGEN(b.x)]) == gen, bar);
            __builtin_amdgcn_fence(__ATOMIC_ACQUIRE, "agent");
            asm volatile("s_waitcnt vmcnt(0)" ::: "memory");
        }
    }
    __syncthreads();
}

struct Frame {
    LAS unsigned char* lds;
    int tid, lane, wave, G, skip;
    const float *x, *c, *w_ada, *b_ada, *g1, *g2, *w_in, *g_q, *g_k, *conv_w, *conv_b, *w_pa, *w_pb, *w_o, *w_rg, *b_rg, *w_re, *b_re, *w1, *w3, *w2;
    float* out; unsigned char* ws;
};
#define WSP(type, off) ((type*)(F.ws + (off)))

struct XItem { const float* src; unsigned char* dst; int N, pitch, fp8, swz; };
__device__ __forceinline__ void xitem_load(const XItem& it, f32x4 (&v)[8], int lane) {
    const int r8 = lane >> 3, c4 = lane & 7;
#pragma unroll
    for (int i = 0; i < 8; ++i) v[i] = __builtin_nontemporal_load((const f32x4*)(it.src + (size_t)(8 * i + r8) * it.N + 4 * c4));
}
__device__ __forceinline__ void xitem_store(const XItem& it, const f32x4 (&v)[8], LAS float* scr, int lane) {
    const int r8 = lane >> 3, c4 = lane & 7; const float scale = it.fp8 ? W8_SCALE : 1.f;
#pragma unroll
    for (int i = 0; i < 8; ++i) { LAS float* p = scr + (8 * i + r8) * 33 + 4 * c4; p[0] = v[i].x * scale; p[1] = v[i].y * scale; p[2] = v[i].z * scale; p[3] = v[i].w * scale; }
    LDS_WAIT(); asm volatile("" ::: "memory");
    if (it.fp8) {
        const int n = lane >> 1, kh = lane & 1; const LAS float* sp = scr + (32 * kh) * 33 + n;
#pragma unroll
        for (int p = 0; p < 2; ++p) { u32x4 o;
#pragma unroll
            for (int w = 0; w < 4; ++w) { const LAS float* q = sp + (16 * p + 4 * w) * 33; int x = 0;
                x = __builtin_amdgcn_cvt_pk_fp8_f32(q[0], q[33], x, false); x = __builtin_amdgcn_cvt_pk_fp8_f32(q[66], q[99], x, true); o[w] = (unsigned)x; }
            *(u32x4*)(it.dst + (size_t)n * it.pitch + 32 * kh + 16 * p) = o; }
    } else {
        const int c = lane & 7;
#pragma unroll
        for (int j = 0; j < 4; ++j) { const int n = (lane >> 3) + 8 * j; const LAS float* q = scr + (8 * c) * 33 + n;
            u32x4 o; o.x = pk2(q[0 * 33], q[1 * 33]); o.y = pk2(q[2 * 33], q[3 * 33]); o.z = pk2(q[4 * 33], q[5 * 33]); o.w = pk2(q[6 * 33], q[7 * 33]);
            const int nd = (it.swz && ((n >> 2) == 1 || (n >> 2) == 2)) ? (n ^ 12) : n;
            *(u32x4*)(it.dst + ((size_t)nd * it.pitch + 8 * c) * 2) = o; }
    }
    LDS_WAIT(); asm volatile("" ::: "memory");
}
__device__ __forceinline__ int win_dest_row(int sc) {
    if (sc < 32) { const int isk = sc >> 4, s2 = sc & 15, hh = s2 >> 1, bj = s2 & 1; return 512 * isk + 256 * (hh >> 2) + 128 * bj + 32 * (hh & 3); }
    if (sc < 48) return 0;
    if (sc < 64) { const int cx = 32 * (sc - 48); return 256 * (4 + (cx >> 7)) + (cx & 127); }
    if (sc < 80) return 2048 + 32 * (sc - 64);
    if (sc < 96) { const int cx = 32 * (sc - 80); return 256 * (4 + (cx >> 7)) + 128 + (cx & 127); }
    return 3072 + 32 * (sc - 96);
}
constexpr int X_NONEXP = 16 * 160 + 2 * (8 * 32) + 16 * 32, X_W2 = X_NONEXP + NE * 512, X_END = X_W2 + NE * 256;
__device__ __forceinline__ void convert_items(Frame& F, const int item_lo, const int item_hi, const int gw, const int NGW) {
    LAS float* scr = (LAS float*)(F.lds + F.wave * 16384);
    constexpr int I_IN = 16 * 160, I_PA = 8 * 32, I_O = 16 * 32, I_E1 = 16 * 16, I_E2 = 8 * 32;
    constexpr int NITEMS = I_IN + 2 * I_PA + I_O + NE * (2 * I_E1 + I_E2);
    auto decode = [&](int r) -> XItem {
        XItem x; x.swz = 0;
        if (r < I_IN) { const int kb = r / 160, sc = r % 160; x.src = F.w_in + (size_t)(64 * kb) * NIN + 32 * sc; x.N = NIN; x.pitch = 1024; x.swz = (sc < 32 && !(sc & 1)) ? 1 : 0;
            if (sc < 96 && !(sc >= 32 && sc < 48)) { x.fp8 = 0; x.dst = (unsigned char*)(WSP(bf16_t, WS_WIN_T) + (size_t)win_dest_row(sc) * 1024 + 64 * kb); }
            else { x.fp8 = 1; const int g = 32 * (sc - 96), cx = g & 1023;
                x.dst = WSP(unsigned char, WS_WIN8) + (size_t)(sc >= 96 ? 256 * (cx >> 7) + (g >= 1024 ? 128 : 0) + (cx & 127) : 2048 + 32 * (sc - 32)) * 1024 + 64 * kb; }
            return x; } r -= I_IN;
        if (r < I_PA) { const int kb = r / 32, sc = r % 32; x.src = F.w_pa + (size_t)(64 * kb) * 1024 + 32 * sc; x.N = 1024; x.pitch = 1024; x.fp8 = 0; x.dst = (unsigned char*)(WSP(bf16_t, WS_WP_T) + (size_t)(32 * sc) * 1024 + 64 * kb); return x; } r -= I_PA;
        if (r < I_PA) { const int kb = r / 32, sc = r % 32; x.src = F.w_pb + (size_t)(64 * kb) * 1024 + 32 * sc; x.N = 1024; x.pitch = 1024; x.fp8 = 0; x.dst = (unsigned char*)(WSP(bf16_t, WS_WP_T) + (size_t)(32 * sc) * 1024 + 512 + 64 * kb); return x; } r -= I_PA;
        if (r < I_O) { const int kb = r / 32, sc = r % 32; x.src = F.w_o + (size_t)(64 * kb) * 1024 + 32 * sc; x.N = 1024; x.pitch = 1024; x.fp8 = 0; x.dst = (unsigned char*)(WSP(bf16_t, WS_WO_T) + (size_t)(32 * sc) * 1024 + 64 * kb); return x; } r -= I_O;
        x.fp8 = 1;
        if (r < NE * 2 * I_E1) { const int e = r / (2 * I_E1); r -= e * (2 * I_E1); const int is3 = r >= I_E1; if (is3) r -= I_E1; const int kb = r / 16, sc = r % 16;
            x.src = (is3 ? F.w3 : F.w1) + (size_t)e * D * DE + (size_t)(64 * kb) * DE + 32 * sc; x.N = DE; x.pitch = 1024;
            x.dst = WSP(unsigned char, WS_W13_T) + ((size_t)e * 1024 + 256 * (sc >> 2) + 128 * is3 + 32 * (sc & 3)) * 1024 + 64 * kb; return x; }
        r -= NE * 2 * I_E1;
        { const int e = r / I_E2; r -= e * I_E2; const int kb = r / 32, sc = r % 32;
            x.src = F.w2 + (size_t)e * DE * D + (size_t)(64 * kb) * D + 32 * sc; x.N = D; x.pitch = 512; x.dst = WSP(unsigned char, WS_W2_T) + ((size_t)e * 1024 + 32 * sc) * 512 + 64 * kb; }
        return x;
    };
    const int ihi = (item_hi < NITEMS) ? item_hi : NITEMS;
    if (item_lo + gw < ihi) {
        XItem cur = decode(item_lo + gw); f32x4 va[8], vb[8]; xitem_load(cur, va, F.lane);
        for (int it = item_lo + gw; it < ihi; it += 2 * NGW) {
            const int n1 = it + NGW, n2 = it + 2 * NGW; XItem nx1 = cur, nx2 = cur;
            if (n1 < ihi) { nx1 = decode(n1); xitem_load(nx1, vb, F.lane); }
            xitem_store(cur, va, scr, F.lane);
            if (n1 < ihi) { if (n2 < ihi) { nx2 = decode(n2); xitem_load(nx2, va, F.lane); }
                xitem_store(nx1, vb, scr, F.lane); cur = nx2; }
        }
    }
}

__device__ __forceinline__ void s0_prologue(Frame& F) {
    if (F.tid < 256) WSP(float, WS_KMEAN)[blockIdx.x * 256 + F.tid] = 0.f;
    if (F.tid < 144) { const int gt = blockIdx.x * 144 + F.tid; const int jj = gt >> 10, k = gt & 1023; WSP(float, WS_W36T)[gt] = (jj < 4) ? F.w_rg[k * 4 + jj] : F.w_re[k * 32 + (jj - 4)]; }
    if (F.tid < 128) { const int gt = blockIdx.x * 128 + F.tid; const int pos = gt >> 3, i = gt & 7; const float inv = powf(500000.0f, -(float)(2 * i) / 16.0f); const float ang = (float)pos * inv;
        WSP(float2, WS_ROPE)[gt] = make_float2(cosf(ang), sinf(ang)); }
    if (blockIdx.x < 192) {
        LAS float* sc = (LAS float*)F.lds;
        for (int i = F.tid; i < NB * D; i += NTHREADS) { const float v = F.c[i]; sc[i] = v / (1.f + expf(-v)); }
        __syncthreads();
        const int j0 = blockIdx.x * 32, col = j0 + (F.lane & 31), kpar = F.lane >> 5;
        float acc[8];
#pragma unroll
        for (int b = 0; b < 8; ++b) acc[b] = 0.f;
#pragma unroll
        for (int i0 = 0; i0 < 64; i0 += 32) { float wv[32];
#pragma unroll
            for (int i = 0; i < 32; ++i) wv[i] = F.w_ada[(size_t)(F.wave * 128 + 2 * (i0 + i) + kpar) * NMOD + col];
#pragma unroll
            for (int i = 0; i < 32; ++i) { const int k = F.wave * 128 + 2 * (i0 + i) + kpar;
#pragma unroll
                for (int b = 0; b < 8; ++b) acc[b] += sc[b * D + k] * wv[i]; } }
#pragma unroll
        for (int b = 0; b < 8; ++b) acc[b] += __shfl_xor(acc[b], 32);
        LAS float* red = (LAS float*)(F.lds + 32768);
        if (F.lane < 32) {
#pragma unroll
            for (int b = 0; b < 8; ++b) red[(F.wave * 8 + b) * 32 + F.lane] = acc[b]; }
        __syncthreads();
        if (F.tid < 256) { const int b = F.tid >> 5, cc = F.tid & 31; float s = F.b_ada[j0 + cc];
#pragma unroll
            for (int w = 0; w < 8; ++w) s += red[(w * 8 + b) * 32 + cc];
            WSP(float, WS_MOD)[b * NMOD + j0 + cc] = s; }
        asm volatile("s_waitcnt vmcnt(0)" ::: "memory");
        __syncthreads();
        if (F.tid == 0) { __builtin_amdgcn_fence(__ATOMIC_RELEASE, "agent"); asm volatile("s_waitcnt vmcnt(0)" ::: "memory");
            __hip_atomic_fetch_add(WSP(unsigned, WS_CTL) + CW_MODCNT, 1u, __ATOMIC_RELAXED, __HIP_MEMORY_SCOPE_AGENT); }
    }
    convert_items(F, 0, X_NONEXP, F.G * NWAVES - 1 - (blockIdx.x * NWAVES + F.wave), F.G * NWAVES);
}

__device__ __forceinline__ void wait_mod(Frame& F) {
    if (F.tid == 0) { unsigned* c = WSP(unsigned, WS_CTL) + CW_MODCNT; unsigned sp = 0;
        while (__hip_atomic_load(c, __ATOMIC_RELAXED, __HIP_MEMORY_SCOPE_AGENT) < 192u) { __builtin_amdgcn_s_sleep(2); if (++sp > (1u << 24)) break; }
        __builtin_amdgcn_fence(__ATOMIC_ACQUIRE, "agent"); asm volatile("s_waitcnt vmcnt(0)" ::: "memory"); }
    __syncthreads();
}
template <int N> __device__ __forceinline__ float dpp_ror(float v) { return __builtin_bit_cast(float, __builtin_amdgcn_update_dpp(0, __builtin_bit_cast(int, v), 0x120 + N, 0xF, 0xF, false)); }
__device__ __forceinline__ float xrow16_sum(float x) {
    float a = x, b = x;
    asm volatile("s_nop 1\n\tv_permlane16_swap_b32 %0, %1" : "+v"(a), "+v"(b));
    a += b; b = a;
    asm volatile("s_nop 1\n\tv_permlane32_swap_b32 %0, %1" : "+v"(a), "+v"(b));
    return a + b;
}
__device__ __forceinline__ float wave_sum(float v) {
#pragma unroll
    for (int o = 1; o < 64; o <<= 1) v += __shfl_xor(v, o);
    return v;
}
__device__ __forceinline__ void s1_norm1(Frame& F) {
    const int gw = blockIdx.x * NWAVES + F.wave;
    const int row0 = gw * 16, b = row0 / S;
    if (row0 >= T) return;
    const float* mod = WSP(float, WS_MOD) + (size_t)b * NMOD;
    f32x4 gs[4], sh[4];
#pragma unroll
    for (int j = 0; j < 4; ++j) { const int col = 4 * F.lane + 256 * j; const f32x4 g = *(const f32x4*)(F.g1 + col), s_ = *(const f32x4*)(mod + 1024 + col); gs[j] = g * (s_ + 1.0f); sh[j] = *(const f32x4*)(mod + col); }
    for (int r = 0; r < 16; r += 4) {
        f32x4 v[4][4]; float ss[4];
#pragma unroll
        for (int q = 0; q < 4; ++q) { const float* xr = F.x + (size_t)(row0 + r + q) * D;
#pragma unroll
            for (int j = 0; j < 4; ++j) v[q][j] = __builtin_nontemporal_load((const f32x4*)(xr + 4 * F.lane + 256 * j)); }
#pragma unroll
        for (int q = 0; q < 4; ++q) { ss[q] = 0.f;
#pragma unroll
            for (int j = 0; j < 4; ++j) ss[q] += (v[q][j].x * v[q][j].x + v[q][j].y * v[q][j].y) + (v[q][j].z * v[q][j].z + v[q][j].w * v[q][j].w); }
#pragma unroll
        for (int q = 0; q < 4; ++q) { const float rinv = rsqrtf(wave_sum(ss[q]) * (1.f / D) + EPS);
            bf16_t* o = WSP(bf16_t, WS_H) + (size_t)(row0 + r + q) * D;
#pragma unroll
            for (int j = 0; j < 4; ++j) { const f32x4 h = v[q][j] * rinv * gs[j] + sh[j]; u32x2 w; w.x = pk2(h.x, h.y); w.y = pk2(h.z, h.w); *(u32x2*)(o + 4 * F.lane + 256 * j) = w;
                int p8 = 0; p8 = __builtin_amdgcn_cvt_pk_fp8_f32(h.x, h.y, p8, false); p8 = __builtin_amdgcn_cvt_pk_fp8_f32(h.z, h.w, p8, true);
                *(int*)(WSP(unsigned char, WS_H8) + (size_t)(row0 + r + q) * D + 4 * F.lane + 256 * j) = p8; } }
    }
}

struct RowsLinear { const bf16_t* base; size_t pitch; __device__ __forceinline__ const bf16_t* operator()(int r) const { return base + (size_t)r * pitch; } };
template <class AR, class BR>
__device__ __forceinline__ void sgemm_tile(LAS float* tile, int K, const AR& arow, const BR& brow, int wave, int lane) {
    const int fr = lane & 15, fq = lane >> 4, rb = 16 * (wave & 3), cb = 32 * (wave >> 2);
    const bf16_t* ap = arow(rb + fr) + 8 * fq;
    const bf16_t* bp0 = brow(cb + fr) + 8 * fq;
    const bf16_t* bp1 = brow(cb + 16 + fr) + 8 * fq;
    f32x4 acc0 = {0.f, 0.f, 0.f, 0.f}, acc1 = {0.f, 0.f, 0.f, 0.f};
#pragma unroll 4
    for (int k = 0; k < K; k += 32) {
        const bf16x8 a = *(const bf16x8*)(ap + k), b0 = *(const bf16x8*)(bp0 + k), b1 = *(const bf16x8*)(bp1 + k);
        acc0 = __builtin_amdgcn_mfma_f32_16x16x32_bf16(a, b0, acc0, 0, 0, 0);
        acc1 = __builtin_amdgcn_mfma_f32_16x16x32_bf16(a, b1, acc1, 0, 0, 0);
    }
#pragma unroll
    for (int j = 0; j < 4; ++j) { tile[(rb + fq * 4 + j) * 65 + cb + fr] = acc0[j]; tile[(rb + fq * 4 + j) * 65 + cb + 16 + fr] = acc1[j]; }
}

struct WinRowsHead { const bf16_t* base; int rb; __device__ __forceinline__ const bf16_t* operator()(int d) const { return base + (size_t)(rb + 128 * (d >> 5) + (d & 31)) * 1024; } };
__device__ __forceinline__ void s2_simple(Frame& F) {
    LAS float* tile = (LAS float*)F.lds; LAS float* tile2 = tile + 64 * 65;
    const bf16_t* H = WSP(bf16_t, WS_H); const bf16_t* WT = WSP(bf16_t, WS_WIN_T);
    const int row = F.tid >> 3, seg = F.tid & 7;
    for (int it = blockIdx.x; it < 512 * 72; it += F.G) {
        const int rt = it / 72, ct = it % 72, r0 = rt * 64, gr = r0 + row;
        const RowsLinear ar{H + (size_t)r0 * 1024, 1024};
        float v[8];
        if (ct < 16) {
            const int isk = ct >> 3, hh = ct & 7;
            const WinRowsHead br{WT, 512 * isk + 256 * (hh >> 2) + 32 * (hh & 3)};
            sgemm_tile(tile, 1024, ar, br, F.wave, F.lane); __syncthreads();
            float ss = 0.f;
#pragma unroll
            for (int e = 0; e < 8; ++e) { v[e] = tile[row * 65 + 8 * seg + e]; ss += v[e] * v[e]; }
            ss += __shfl_xor(ss, 1); ss += __shfl_xor(ss, 2); ss += __shfl_xor(ss, 4);
            const float rinv = rsqrtf(ss * (1.f / 64.f) + EPS);
            const float* g = isk ? F.g_k : F.g_q;
            const int pos = gr & (S - 1);
#pragma unroll
            for (int e = 0; e < 8; ++e) { v[e] = v[e] * rinv * g[8 * seg + e]; const float pv = __shfl_xor(v[e], 1);
                if (seg < 2) { const float2 cs = WSP(float2, WS_ROPE)[pos * 8 + e]; v[e] = (seg == 0) ? (v[e] * cs.x - pv * cs.y) : (v[e] * cs.x + pv * cs.y); } }
            if (!isk) {
#pragma unroll
                for (int e = 0; e < 8; ++e) v[e] *= C2;
                *(u32x4*)(WSP(bf16_t, WS_YAB) + (size_t)gr * 1024 + hh * 64 + 8 * seg) = pack8(v);
            } else {
                *(u32x4*)(WSP(bf16_t, WS_K) + (size_t)gr * 512 + hh * 64 + 8 * seg) = pack8(v);
#pragma unroll
                for (int e = 0; e < 8; ++e) tile[row * 65 + 8 * seg + e] = v[e];
                __syncthreads();
                if (F.tid < 64) { float s = 0.f; for (int r = 0; r < 64; ++r) s += tile[r * 65 + F.tid];
                    const int b = r0 / S, blk = (r0 & (S - 1)) >> 8;
                    atomicAdd(WSP(float, WS_KMEAN) + ((size_t)(b * NH + hh) * 16 + blk) * 64 + F.tid, s * (1.f / 256.f)); }
            }
        } else if (ct < 24) {
            const RowsLinear br{WT + (size_t)(1024 + 64 * (ct - 16)) * 1024, 1024};
            sgemm_tile(tile, 1024, ar, br, F.wave, F.lane); __syncthreads();
#pragma unroll
            for (int e = 0; e < 8; ++e) v[e] = tile[row * 65 + 8 * seg + e];
            *(u32x4*)(WSP(bf16_t, WS_V) + (size_t)gr * 512 + 64 * (ct - 16) + 8 * seg) = pack8(v);
        } else if (ct < 32) {
            const int cu = 64 * (ct - 24), rb = 256 * (6 + (cu >> 7)) + (cu & 127);
            const RowsLinear bx{WT + (size_t)rb * 1024, 1024}, bc{WT + (size_t)(rb + 128) * 1024, 1024};
            sgemm_tile(tile, 1024, ar, bx, F.wave, F.lane); sgemm_tile(tile2, 1024, ar, bc, F.wave, F.lane); __syncthreads();
#pragma unroll
            for (int e = 0; e < 8; ++e) v[e] = tile[row * 65 + 8 * seg + e] * tile2[row * 65 + 8 * seg + e];
            *(u32x4*)(WSP(bf16_t, WS_U) + (size_t)gr * 512 + cu + 8 * seg) = pack8(v);
        } else if (ct < 40) {
            const RowsLinear br{WT + (size_t)(2560 + 64 * (ct - 32)) * 1024, 1024};
            sgemm_tile(tile, 1024, ar, br, F.wave, F.lane); __syncthreads();
#pragma unroll
            for (int e = 0; e < 8; ++e) v[e] = tile[row * 65 + 8 * seg + e];
            *(u32x4*)(WSP(bf16_t, WS_BG) + (size_t)gr * 512 + 64 * (ct - 32) + 8 * seg) = pack8(v);
        } else {
            const RowsLinear br{WT + (size_t)(3072 + 64 * (ct - 40)) * 1024, 1024};
            sgemm_tile(tile, 1024, ar, br, F.wave, F.lane); __syncthreads();
#pragma unroll
            for (int e = 0; e < 8; ++e) v[e] = 1.f / (1.f + __expf(-tile[row * 65 + 8 * seg + e]));
            *(u32x4*)(WSP(bf16_t, WS_GATES) + (size_t)gr * 2048 + 64 * (ct - 40) + 8 * seg) = pack8(v);
        }
        __syncthreads();
    }
}

namespace pg8 {
constexpr int BM = 256, BK = 64, HALF = 128, HTB = HALF * BK * 2, STAGE_BYTES = 8 * HTB, NXCD = 8, WGM = 4;
constexpr int VN_STASH = 147456 + 4096;
__device__ __forceinline__ int lds_byte(int r, int c) { const int st = (r >> 4) * 2 + (c >> 5), rr = r & 15, cc = c & 31, ob = rr * 64 + cc * 2; return st * 1024 + (ob ^ (((ob >> 9) & 1) << 5)); }
__device__ __forceinline__ void stage_rc(int b, int& R, int& C) { const int st = b / 1024, sb = b % 1024, swz = sb ^ (((sb >> 9) & 1) << 5); R = (st >> 1) * 16 + swz / 64; C = (st & 1) * 32 + (swz % 64) / 2; }
__device__ __forceinline__ int perm32(int rho) { const int n = rho >> 4, i = rho & 15; return 8 * (i >> 2) + 4 * n + (i & 3); }
struct Unit { int pm, pn; const char* a; const char* b; int e, rbase; };
__device__ __forceinline__ bool static_unit(int i, int G, int c, int nM, int nN, int& pm, int& pn) {
    const int nwg = nM * nN; const long L = (long)i * G + c; if (L >= nwg) return false;
    int wgid = (int)L; { const int q = nwg / NXCD, r = nwg % NXCD, xcd = wgid % NXCD, off = wgid / NXCD; wgid = (xcd < r ? xcd * (q + 1) : r * (q + 1) + (xcd - r) * q) + off; }
    const int nig = WGM * nN, gid = wgid / nig, fm = gid * WGM, gsz = (nM - fm) < WGM ? (nM - fm) : WGM;
    pm = fm + ((wgid % nig) % gsz); pn = (wgid % nig) / gsz; return true;
}
struct DenseSched {
    static constexpr bool GATHER = false, FP8 = false;
    const char* A; const char* Bt; int nM, nN, K, G, c;
    __device__ __forceinline__ bool next(int i, Unit& u) const { if (!static_unit(i, G, c, nM, nN, u.pm, u.pn)) return false;
        u.a = A + (size_t)u.pm * BM * K * 2; u.b = Bt + (size_t)u.pn * BM * K * 2; u.e = 0; u.rbase = 0; return true; }
    __device__ __forceinline__ int row_index(const Unit&, int) const { return 0; }
};

struct DenseSched8 {
    static constexpr bool GATHER = false, FP8 = true;
    const char* A; const char* Bt; int nM, nN, K, G, c;
    __device__ __forceinline__ bool next(int i, Unit& u) const { if (!static_unit(i, G, c, nM, nN, u.pm, u.pn)) return false;
        u.a = A + (size_t)u.pm * BM * K; u.b = Bt + (size_t)u.pn * BM * K; u.e = 0; u.rbase = 0; return true; }
    __device__ __forceinline__ int row_index(const Unit&, int) const { return 0; }
};
template <class Epi, class Sched, bool skip = false>
__device__ __forceinline__ void gemm_phase(LAS unsigned char* lds, const int K, const Sched& S, const Epi& E) {
    int tid_ = threadIdx.x; asm volatile("" : "+v"(tid_));
    const int tid = tid_, wid = __builtin_amdgcn_readfirstlane(tid >> 6), lane = tid & 63, wr = wid >> 2, wc = wid & 3, fr = lane & 15, fq = lane >> 4;
    constexpr bool FP8 = Sched::FP8;
    const int nt = FP8 ? K / 128 : K / BK;
    const int PB = FP8 ? K : 2 * K;
    unsigned voffB[2], vA[2][2], vN[2][2];
#pragma unroll
    for (int i = 0; i < 2; ++i) { int R, C; stage_rc(tid * 16 + i * 8192, R, C); const int Rb = (R & ~31) + perm32(R & 31);
        voffB[i] = (unsigned)(Rb * PB + C * 2);
        vA[0][i] = (unsigned)(R * PB + C * 2); vA[1][i] = (unsigned)((HALF + R) * PB + C * 2); vN[0][i] = vA[0][i]; vN[1][i] = vA[1][i]; }
    const size_t kstep = (size_t)(BK * 2);
    const size_t hstep = (size_t)HALF * PB;
    const unsigned ldsw = (unsigned)wid * 1024u;
    const int aoff = lds_byte(wr * 64 + fr, fq * 8), boff = lds_byte(wc * 32 + fr, fq * 8);
    const int aoff8a = lds_byte(wr * 64 + fr, fq * 16), aoff8b = lds_byte(wr * 64 + fr, fq * 16 + 8), boff8a = lds_byte(wc * 32 + fr, fq * 16), boff8b = lds_byte(wc * 32 + fr, fq * 16 + 8);
#define PG8_SA(b, h) (((b) * 2 + (h)) * HTB)
#define PG8_SB(b, h) ((4 + (b) * 2 + (h)) * HTB)
#define PG8_STAGE(bufoff, gbase, voff) do { _Pragma("unroll") for (int _i = 0; _i < 2; ++_i) \
        __builtin_amdgcn_global_load_lds((const unsigned*)((const char*)(gbase) + (voff)[_i]), (LAS unsigned*)(lds + (bufoff) + ldsw + _i * 8192), 16, 0, 0); } while (0)
#define PG8_LD16(off) (*(const LAS u32x4*)(lds + (off)))
#define PG8_LDA(dst, b, h) do { _Pragma("unroll") for (int m = 0; m < 4; ++m) { if constexpr (FP8) { dst##8[m] = __builtin_bit_cast(i32x8, __builtin_shufflevector(PG8_LD16(PG8_SA(b, h) + aoff8a + m * 2048), PG8_LD16(PG8_SA(b, h) + aoff8b + m * 2048), 0, 1, 2, 3, 4, 5, 6, 7)); } \
        else { _Pragma("unroll") for (int k = 0; k < 2; ++k) dst[m][k] = *(const LAS bf16x8*)(lds + PG8_SA(b, h) + aoff + m * 2048 + k * 1024); } } } while (0)
#define PG8_LDB(dst, b, h) do { _Pragma("unroll") for (int n = 0; n < 2; ++n) { if constexpr (FP8) { dst##8[n] = __builtin_bit_cast(i32x8, __builtin_shufflevector(PG8_LD16(PG8_SB(b, h) + boff8a + n * 2048), PG8_LD16(PG8_SB(b, h) + boff8b + n * 2048), 0, 1, 2, 3, 4, 5, 6, 7)); } \
        else { _Pragma("unroll") for (int k = 0; k < 2; ++k) dst[n][k] = *(const LAS bf16x8*)(lds + PG8_SB(b, h) + boff + n * 2048 + k * 1024); } } } while (0)
#define PG8_MMA(ai, bj, At, Bt) do { __builtin_amdgcn_s_setprio(1); _Pragma("unroll") for (int m = 0; m < 4; ++m) _Pragma("unroll") for (int n = 0; n < 2; ++n) { \
        if constexpr (FP8) { asm volatile("s_nop 1\n\tv_mfma_scale_f32_16x16x128_f8f6f4 %0, %1, %2, %0, %3, %3 op_sel_hi:[0,0,0]" : "+v"(acc[ai][bj][m][n]) : "v"(Bt##8[n]), "v"(At##8[m]), "v"(sc127)); } \
        else { _Pragma("unroll") for (int k = 0; k < 2; ++k) acc[ai][bj][m][n] = __builtin_amdgcn_mfma_f32_16x16x32_bf16(Bt[n][k], At[m][k], acc[ai][bj][m][n], 0, 0, 0); } } __builtin_amdgcn_s_setprio(0); } while (0)
#define PG8_WAIT_V(n) asm volatile("s_waitcnt vmcnt(" #n ")" ::: "memory")
#define PG8_WAIT_L(n) asm volatile("s_waitcnt lgkmcnt(" #n ")" ::: "memory")
#define PG8_BAR __builtin_amdgcn_s_barrier()
#define PG8_SCHED __builtin_amdgcn_sched_barrier(0)
#define PG8_AOFF(dst, u) do { int _t = threadIdx.x; asm volatile("" : "+v"(_t)); _Pragma("unroll") for (int _i = 0; _i < 2; ++_i) { int _R, _C; stage_rc(_t * 16 + _i * 8192, _R, _C); \
        _Pragma("unroll") for (int _h = 0; _h < 2; ++_h) dst[_h][_i] = (unsigned)(S.row_index(u, _h * HALF + _R) * PB + _C * 2); } } while (0)
    Unit cur, nxt; int ui = 0;
    if (!S.next(0, cur)) return;
    if constexpr (Sched::GATHER) PG8_AOFF(vA, cur);
    f32x4 acc[2][2][4][2];
#pragma unroll
    for (int a = 0; a < 2; ++a)
#pragma unroll
        for (int b = 0; b < 2; ++b)
#pragma unroll
            for (int m = 0; m < 4; ++m)
#pragma unroll
                for (int n = 0; n < 2; ++n) acc[a][b][m][n] = (f32x4){0.f, 0.f, 0.f, 0.f};
    const int sc127 = 127;
    bf16x8 At[4][2], B0[2][2], B1[2][2]; i32x8 At8[4], B08[2], B18[2];
    const char* cA = cur.a; const char* cB = cur.b;
    PG8_STAGE(PG8_SB(0, 0), cB, voffB); PG8_STAGE(PG8_SB(0, 1), cB + hstep, voffB); PG8_STAGE(PG8_SA(0, 0), cA, vA[0]); PG8_STAGE(PG8_SA(0, 1), cA, vA[1]);
    if (wr == 1) PG8_BAR;
    PG8_WAIT_V(2); PG8_BAR;
    PG8_STAGE(PG8_SB(1, 0), cB + kstep, voffB); PG8_STAGE(PG8_SA(1, 0), cA + kstep, vA[0]); PG8_STAGE(PG8_SB(1, 1), cB + hstep + kstep, voffB);
    PG8_WAIT_V(6); PG8_BAR;
    for (;;) {
        const bool has_next = S.next(ui + 1, nxt);
        const char* nA = has_next ? nxt.a : cA; const char* nB = has_next ? nxt.b : cB;
        if constexpr (Sched::GATHER) { if (has_next) PG8_AOFF(vN, nxt); else {
#pragma unroll
            for (int h = 0; h < 2; ++h)
#pragma unroll
                for (int i = 0; i < 2; ++i) vN[h][i] = vA[h][i]; }
            *(LAS u32x4*)(lds + VN_STASH + tid * 16) = (u32x4){vN[0][0], vN[0][1], vN[1][0], vN[1][1]}; }
        for (int hk = 0; hk < (Epi::HAS_MID ? 2 : 1); ++hk) {
        if constexpr (Epi::HAS_MID) { if (hk == 1 && !skip) E.mid(acc, cur, wr, wc, fr, fq); }
        const int tb = (Epi::HAS_MID && hk == 1) ? nt / 2 : 0, te = (Epi::HAS_MID && hk == 0) ? nt / 2 : nt;
#pragma unroll 1
        for (int t = tb; t < te; t += 2) {
            const bool last = (t == nt - 2);
            const char* a1 = cA + (size_t)(t + 1) * kstep;
            const char* a2 = last ? nA : cA + (size_t)(t + 2) * kstep; const char* b2 = last ? nB : cB + (size_t)(t + 2) * kstep;
            const char* a3 = a2 + kstep; const char* b3 = b2 + kstep;
            unsigned w0[2], w1[2];
#pragma unroll
            for (int i = 0; i < 2; ++i) { w0[i] = vA[0][i]; w1[i] = vA[1][i]; }
            if constexpr (Sched::GATHER) { if (last) { const u32x4 q = *(const LAS u32x4*)(lds + VN_STASH + tid * 16); w0[0] = q.x; w0[1] = q.y; w1[0] = q.z; w1[1] = q.w; } }
            PG8_LDB(B0, 0, 0); PG8_LDB(B1, 0, 1); PG8_SCHED; PG8_LDA(At, 0, 0); PG8_STAGE(PG8_SA(1, 1), a1, vA[1]);
            PG8_WAIT_V(8); PG8_WAIT_L(0); PG8_BAR; PG8_MMA(0, 0, At, B0); PG8_MMA(0, 1, At, B1); PG8_BAR; PG8_SCHED;
            PG8_LDA(At, 0, 1); PG8_STAGE(PG8_SB(0, 0), b2, voffB); PG8_STAGE(PG8_SB(0, 1), b2 + hstep, voffB); PG8_STAGE(PG8_SA(0, 0), a2, w0);
            PG8_WAIT_V(8); PG8_WAIT_L(0); PG8_BAR; PG8_MMA(1, 0, At, B0); PG8_MMA(1, 1, At, B1); PG8_BAR; PG8_SCHED;
            PG8_LDB(B0, 1, 0); PG8_LDB(B1, 1, 1); PG8_SCHED; PG8_LDA(At, 1, 0); PG8_STAGE(PG8_SA(0, 1), a2, w1);
            PG8_WAIT_V(8); PG8_WAIT_L(0); PG8_BAR; PG8_MMA(0, 0, At, B0); PG8_MMA(0, 1, At, B1); PG8_BAR; PG8_SCHED;
            PG8_LDA(At, 1, 1); PG8_STAGE(PG8_SB(1, 0), b3, voffB); PG8_STAGE(PG8_SB(1, 1), b3 + hstep, voffB); PG8_STAGE(PG8_SA(1, 0), a3, w0);
            PG8_WAIT_V(8); PG8_WAIT_L(0); PG8_BAR; PG8_MMA(1, 0, At, B0); PG8_MMA(1, 1, At, B1); PG8_BAR; PG8_SCHED;
        }
        }
        if (wr == 0) PG8_BAR;
        if constexpr (FP8) asm volatile("s_nop 15\n\ts_nop 7" ::: "memory");
        if constexpr (!skip) E(acc, cur, wr, wc, fr, fq); else {
#pragma unroll
            for (int a = 0; a < 2; ++a)
#pragma unroll
                for (int b = 0; b < 2; ++b)
#pragma unroll
                    for (int m = 0; m < 4; ++m)
#pragma unroll
                        for (int n = 0; n < 2; ++n) asm volatile("" :: "v"(acc[a][b][m][n])); }
        if (!has_next) break;
#pragma unroll
        for (int a = 0; a < 2; ++a)
#pragma unroll
            for (int b = 0; b < 2; ++b)
#pragma unroll
                for (int m = 0; m < 4; ++m)
#pragma unroll
                    for (int n = 0; n < 2; ++n) acc[a][b][m][n] = (f32x4){0.f, 0.f, 0.f, 0.f};
        cur = nxt; cA = nA; cB = nB; ++ui;
        if constexpr (Sched::GATHER) { const u32x4 q = *(const LAS u32x4*)(lds + VN_STASH + tid * 16); vA[0][0] = q.x; vA[0][1] = q.y; vA[1][0] = q.z; vA[1][1] = q.w; }
        if (wr == 1) PG8_BAR;
    }
    PG8_WAIT_V(0);
    PG8_BAR;
#undef PG8_SA
#undef PG8_SB
#undef PG8_STAGE
#undef PG8_LDA
#undef PG8_LDB
#undef PG8_MMA
#undef PG8_LD16
#undef PG8_WAIT_V
#undef PG8_WAIT_L
#undef PG8_BAR
#undef PG8_SCHED
#undef PG8_AOFF
}
}

typedef f32x4 Acc[2][2][4][2];
struct EpiG1 {
    static constexpr bool HAS_MID = false;
    unsigned char* ws; const float* g_q; const float* g_k;
    __device__ __forceinline__ void mid(Acc&, const pg8::Unit&, int, int, int, int) const {}
    __device__ __forceinline__ void operator()(Acc& acc, const pg8::Unit& u, int wr, int wc, int fr, int fq) const {
        const int pn = u.pn, row0 = u.pm * 256 + wr * 64 + fr;
        if (pn < 4) {
            const int isk = pn >> 1, hh = 4 * (pn & 1) + wc;
            const float* g = isk ? g_k : g_q;
            f32x4 gv[2][2];
#pragma unroll
            for (int bj = 0; bj < 2; ++bj)
#pragma unroll
                for (int n = 0; n < 2; ++n) gv[bj][n] = *(const f32x4*)(g + ((bj == 0 && fq < 2) ? 8 * n + 4 * fq : 32 * bj + 8 * fq + 4 * n));
            f32x4 cs_[2][2];
#pragma unroll
            for (int bj = 0; bj < 2; ++bj)
#pragma unroll
                for (int n = 0; n < 2; ++n) cs_[bj][n] = (f32x4){0.f, 0.f, 0.f, 0.f};
            f32x4 rf;
#pragma unroll
            for (int e = 0; e < 4; ++e) { const float f0 = exp2f(-(float)e * (0.125f * 18.931568569324174f)) * 0.15915494309189535f, f1 = exp2f(-(float)(4 + e) * (0.125f * 18.931568569324174f)) * 0.15915494309189535f;
                rf[e] = fq == 0 ? f0 : (fq == 1 ? f1 : 0.f); }
            bf16_t* dst = isk ? (bf16_t*)(ws + WS_K) : (bf16_t*)(ws + WS_YAB);
            const int pitch = isk ? 512 : 1024;
            const float sc = isk ? 1.f : C2;
#pragma unroll
            for (int ai = 0; ai < 2; ++ai)
#pragma unroll
                for (int m = 0; m < 4; ++m) {
                    const int r = row0 + 128 * ai + 16 * m; const float pos = (float)(r & (S - 1));
                    f32x4 v[2][2]; float ss = 0.f;
#pragma unroll
                    for (int bj = 0; bj < 2; ++bj)
#pragma unroll
                        for (int n = 0; n < 2; ++n) { v[bj][n] = acc[ai][bj][m][n]; ss += (v[bj][n].x * v[bj][n].x + v[bj][n].y * v[bj][n].y) + (v[bj][n].z * v[bj][n].z + v[bj][n].w * v[bj][n].w); }
                    ss = xrow16_sum(ss);
                    const float rinv = rsqrtf(ss * (1.f / 64.f) + EPS);
#pragma unroll
                    for (int bj = 0; bj < 2; ++bj)
#pragma unroll
                        for (int n = 0; n < 2; ++n) v[bj][n] = v[bj][n] * rinv * gv[bj][n];
#pragma unroll
                    for (int e = 0; e < 4; ++e) { const float rev = __builtin_amdgcn_fractf(pos * rf[e]), c = __builtin_amdgcn_cosf(rev), sn = __builtin_amdgcn_sinf(rev);
                        const float x1 = v[0][0][e], x2 = v[0][1][e]; v[0][0][e] = x1 * c - x2 * sn; v[0][1][e] = x2 * c + x1 * sn; }
                    if (isk) {
#pragma unroll
                        for (int bj = 0; bj < 2; ++bj)
#pragma unroll
                            for (int n = 0; n < 2; ++n) cs_[bj][n] += v[bj][n];
                    }
#pragma unroll
                    for (int bj = 0; bj < 2; ++bj) st16(dst + (size_t)r * pitch + hh * 64 + 32 * bj + 8 * fq, pack8v(v[bj][0] * sc, v[bj][1] * sc));
                }
            if (isk) {
                const int b = u.pm >> 4, blk = u.pm & 15;
                float* km = (float*)(ws + WS_KMEAN) + ((size_t)(b * NH + hh) * 16 + blk) * 64;
#pragma unroll
                for (int bj = 0; bj < 2; ++bj)
#pragma unroll
                    for (int n = 0; n < 2; ++n)
#pragma unroll
                        for (int e = 0; e < 4; ++e) { float s = cs_[bj][n][e]; s += dpp_ror<8>(s); s += dpp_ror<4>(s); s += dpp_ror<2>(s); s += dpp_ror<1>(s);
                            if (fr == 0) atomicAdd(km + 32 * bj + 8 * fq + 4 * n + e, s * (1.f / 256.f)); }
            }
        } else if (pn < 8) {
            bf16_t* dst = (bf16_t*)(ws + WS_U);
#pragma unroll
            for (int ai = 0; ai < 2; ++ai)
#pragma unroll
                for (int m = 0; m < 4; ++m) { const int r = row0 + 128 * ai + 16 * m;
                    const f32x4 a = acc[ai][0][m][0] * acc[ai][1][m][0], b = acc[ai][0][m][1] * acc[ai][1][m][1]; u32x4 w;
                    w.x = pk2(a.x, a.y); w.y = pk2(a.z, a.w); w.z = pk2(b.x, b.y); w.w = pk2(b.z, b.w);
                    st16(dst + (size_t)r * 512 + 128 * (pn - 4) + 32 * wc + 8 * fq, w); }
        } else {
            bf16_t* dst = (bf16_t*)(ws + WS_BG); const int pitch = 512, c0 = 256 * (pn - 8); const bool sig = false;
#pragma unroll
            for (int ai = 0; ai < 2; ++ai)
#pragma unroll
                for (int m = 0; m < 4; ++m) { const int r = row0 + 128 * ai + 16 * m;
#pragma unroll
                    for (int bj = 0; bj < 2; ++bj) { f32x4 a = acc[ai][bj][m][0], b = acc[ai][bj][m][1];
                        if (sig) {
#pragma unroll
                            for (int e = 0; e < 4; ++e) { a[e] = __builtin_amdgcn_rcpf(1.f + __expf(-a[e])); b[e] = __builtin_amdgcn_rcpf(1.f + __expf(-b[e])); } }
                        u32x4 w; w.x = pk2(a.x, a.y); w.y = pk2(a.z, a.w); w.z = pk2(b.x, b.y); w.w = pk2(b.z, b.w);
                        st16(dst + (size_t)r * pitch + c0 + 128 * bj + 32 * wc + 8 * fq, w); } }
        }
    }
};
struct EpiGate {
    static constexpr bool HAS_MID = false;
    bf16_t* gates; bf16_t* vout;
    __device__ __forceinline__ void mid(Acc&, const pg8::Unit&, int, int, int, int) const {}
    __device__ __forceinline__ void operator()(Acc& acc, const pg8::Unit& u, int wr, int wc, int fr, int fq) const {
        int row0 = u.pm * 256 + wr * 64 + fr; const int c0 = u.pn * 256 + 32 * wc + 8 * fq; asm volatile("" : "+v"(row0));
#pragma unroll
        for (int ai = 0; ai < 2; ++ai)
#pragma unroll
            for (int m = 0; m < 4; ++m) { const size_t r = (size_t)(row0 + 128 * ai + 16 * m);
                if (u.pn < 8) {
                    f32x4 ra[2], gb[2];
#pragma unroll
                    for (int n = 0; n < 2; ++n)
#pragma unroll
                        for (int e = 0; e < 4; ++e) { const float ea = __expf(acc[ai][0][m][n][e] * (-1.f / W8_SCALE)), eb = __expf(acc[ai][1][m][n][e] * (-1.f / W8_SCALE));
                            gb[n][e] = __builtin_amdgcn_rcpf(1.f + eb); ra[n][e] = fminf((1.f + eb) * __builtin_amdgcn_rcpf(1.f + ea), 3e4f); }
                    const size_t gc = r * 2048 + 128 * u.pn + 32 * wc + 8 * fq;
                    st16(gates + gc, pack8v(ra[0], ra[1])); st16(gates + gc + 1024, pack8v(gb[0], gb[1]));
                } else {
#pragma unroll
                    for (int bj = 0; bj < 2; ++bj) st16(vout + r * 512 + (c0 - 2048) + 128 * bj, pack8v(acc[ai][bj][m][0] * (1.f / W8_SCALE), acc[ai][bj][m][1] * (1.f / W8_SCALE))); } }
    }
};
__device__ __forceinline__ void s2_fast(Frame& F) {
    {
        const pg8::DenseSched Sd{(const char*)(F.ws + WS_H), (const char*)(F.ws + WS_WIN_T), T / 256, 10, 1024, F.G, (int)blockIdx.x};
        const EpiG1 E{F.ws, F.g_q, F.g_k};
        if (F.skip) pg8::gemm_phase<EpiG1, pg8::DenseSched, true>(F.lds, 1024, Sd, E); else pg8::gemm_phase<EpiG1, pg8::DenseSched>(F.lds, 1024, Sd, E); }
    {
        const pg8::DenseSched8 Sd{(const char*)(F.ws + WS_H8), (const char*)(F.ws + WS_WIN8), T / 256, 10, 1024, F.G, (int)blockIdx.x};
        const EpiGate E{WSP(bf16_t, WS_GATES), WSP(bf16_t, WS_V)};
        int Kg = D; asm volatile("" : "+s"(Kg));
        if (F.skip) pg8::gemm_phase<EpiGate, pg8::DenseSched8, true>(F.lds, Kg, Sd, E); else pg8::gemm_phase<EpiGate, pg8::DenseSched8>(F.lds, Kg, Sd, E); }
}

constexpr float NEG_BIG = -1e30f;
__device__ __forceinline__ void s3_simple(Frame& F) {
    LAS float* tS = (LAS float*)F.lds;
    LAS bf16_t* Pb = (LAS bf16_t*)(F.lds + 16896);
    LAS bf16_t* Vt = (LAS bf16_t*)(F.lds + 16896 + 9216);
    LAS float* mrow = (LAS float*)(F.lds + 16896 + 18432);
    LAS float* lrow = mrow + 64; LAS float* arow_ = mrow + 128; LAS int* sel = (LAS int*)(mrow + 192); LAS int* um = sel + 64;
    bf16_t* YAB = WSP(bf16_t, WS_YAB); const bf16_t* Kb = WSP(bf16_t, WS_K); const bf16_t* Vb = WSP(bf16_t, WS_V);
    const float* kmean = WSP(float, WS_KMEAN);
    const int row = F.tid >> 3, seg = F.tid & 7, fr = F.lane & 15, fq = F.lane >> 4, rb = 16 * (F.wave & 3), cb = 32 * (F.wave >> 2);
    for (int it = blockIdx.x; it < NB * NH * 64; it += F.G) {
        const int qc = it & 63, h = (it >> 6) & 7, b = it >> 9, cur = qc >> 2, t0 = 64 * qc;
        const size_t tb = (size_t)b * S;
        if (F.tid < 64) {
            float q[64];
            const bf16_t* qp = YAB + (tb + t0 + F.tid) * 1024 + h * 64;
#pragma unroll
            for (int i = 0; i < 8; ++i) { float t8[8]; unpack8(*(const u32x4*)(qp + 8 * i), t8);
#pragma unroll
                for (int e = 0; e < 8; ++e) q[8 * i + e] = t8[e]; }
            float b0 = -INFINITY, b1 = -INFINITY, b2 = -INFINITY; int i0 = -1, i1 = -1, i2 = -1;
            for (int j = 0; j < cur; ++j) { const float* km = kmean + ((size_t)(b * NH + h) * 16 + j) * 64; float s = 0.f;
#pragma unroll
                for (int d = 0; d < 64; ++d) s += q[d] * km[d];
                if (s > b0) { b2 = b1; i2 = i1; b1 = b0; i1 = i0; b0 = s; i0 = j; } else if (s > b1) { b2 = b1; i2 = i1; b1 = s; i1 = j; } else if (s > b2) { b2 = s; i2 = j; } }
            int m = 0; if (i0 >= 0) m |= 1 << i0; if (i1 >= 0) m |= 1 << i1; if (i2 >= 0) m |= 1 << i2;
            sel[F.tid] = m; mrow[F.tid] = NEG_BIG; lrow[F.tid] = 0.f;
            int u = m;
#pragma unroll
            for (int o = 1; o < 64; o <<= 1) u |= __shfl_xor(u, o);
            if (F.tid == 0) um[0] = u;
        }
        __syncthreads();
        const int umask = um[0];
        f32x4 o0 = {0.f, 0.f, 0.f, 0.f}, o1 = {0.f, 0.f, 0.f, 0.f};
        const RowsLinear aq{YAB + (tb + t0) * 1024 + h * 64, 1024};
        for (int j = 0; j <= cur; ++j) {
            if (j < cur && !((umask >> j) & 1)) continue;
            const int nkt = (j == cur) ? ((qc & 3) + 1) : 4;
            for (int kt = 0; kt < nkt; ++kt) {
                const int kbase = 256 * j + 64 * kt;
                const RowsLinear bk{Kb + (tb + kbase) * 512 + h * 64, 512};
                sgemm_tile(tS, 64, aq, bk, F.wave, F.lane);
                { float vv[8]; unpack8(*(const u32x4*)(Vb + (tb + kbase + row) * 512 + h * 64 + 8 * seg), vv);
#pragma unroll
                    for (int e = 0; e < 8; ++e) Vt[(8 * seg + e) * 72 + row] = (bf16_t)f2bf(vv[e]); }
                __syncthreads();
                {
                    float s[8]; float mx = NEG_BIG;
                    const bool rowsel = (j == cur) || ((sel[row] >> j) & 1);
#pragma unroll
                    for (int e = 0; e < 8; ++e) { const int c = 8 * seg + e; float x = tS[row * 65 + c];
                        if (!rowsel || (j == cur && kbase + c > t0 + row)) x = NEG_BIG; s[e] = x; mx = fmaxf(mx, x); }
                    mx = fmaxf(mx, __shfl_xor(mx, 1)); mx = fmaxf(mx, __shfl_xor(mx, 2)); mx = fmaxf(mx, __shfl_xor(mx, 4));
                    const float mold = mrow[row], mnew = fmaxf(mold, mx);
                    float alpha = 1.f, ps = 0.f; float p[8];
                    if (mnew <= NEG_BIG) {
#pragma unroll
                        for (int e = 0; e < 8; ++e) p[e] = 0.f;
                    } else { alpha = exp2f(mold - mnew);
#pragma unroll
                        for (int e = 0; e < 8; ++e) { p[e] = (s[e] <= NEG_BIG) ? 0.f : exp2f(s[e] - mnew); ps += p[e]; } }
                    ps += __shfl_xor(ps, 1); ps += __shfl_xor(ps, 2); ps += __shfl_xor(ps, 4);
                    const float lold = lrow[row];
                    *(LAS u32x4*)(Pb + row * 72 + 8 * seg) = pack8(p);
                    if (seg == 0) { mrow[row] = mnew; lrow[row] = lold * alpha + ps; arow_[row] = alpha; }
                }
                __syncthreads();
                {
#pragma unroll
                    for (int r = 0; r < 4; ++r) { const float a = arow_[rb + fq * 4 + r]; o0[r] *= a; o1[r] *= a; }
#pragma unroll
                    for (int ks = 0; ks < 2; ++ks) {
                        const bf16x8 a = *(const LAS bf16x8*)(Pb + (rb + fr) * 72 + 32 * ks + 8 * fq);
                        const bf16x8 v0 = *(const LAS bf16x8*)(Vt + (cb + fr) * 72 + 32 * ks + 8 * fq);
                        const bf16x8 v1 = *(const LAS bf16x8*)(Vt + (cb + 16 + fr) * 72 + 32 * ks + 8 * fq);
                        o0 = __builtin_amdgcn_mfma_f32_16x16x32_bf16(a, v0, o0, 0, 0, 0);
                        o1 = __builtin_amdgcn_mfma_f32_16x16x32_bf16(a, v1, o1, 0, 0, 0);
                    }
                }
                __syncthreads();
            }
        }
#pragma unroll
        for (int r = 0; r < 4; ++r) { const float li = 1.f / lrow[rb + fq * 4 + r]; tS[(rb + fq * 4 + r) * 65 + cb + fr] = o0[r] * li; tS[(rb + fq * 4 + r) * 65 + cb + 16 + fr] = o1[r] * li; }
        __syncthreads();
        { float v[8];
#pragma unroll
            for (int e = 0; e < 8; ++e) v[e] = tS[row * 65 + 8 * seg + e];
            *(u32x4*)(YAB + (tb + t0 + row) * 1024 + h * 64 + 8 * seg) = pack8(v); }
        __syncthreads();
    }
    const bf16_t* U = WSP(bf16_t, WS_U); const bf16_t* BG = WSP(bf16_t, WS_BG);
    for (int i = blockIdx.x * NTHREADS + F.tid; i < T * 64; i += F.G * NTHREADS) {
        const int t = i >> 6, c0 = (i & 63) * 8, pos = t & (S - 1);
        float u0[8], u1[8], u2[8], bg[8], y[8];
        unpack8(*(const u32x4*)(U + (size_t)t * 512 + c0), u2); unpack8(*(const u32x4*)(BG + (size_t)t * 512 + c0), bg);
        if (pos >= 1) unpack8(*(const u32x4*)(U + (size_t)(t - 1) * 512 + c0), u1); else {
#pragma unroll
            for (int e = 0; e < 8; ++e) u1[e] = 0.f; }
        if (pos >= 2) unpack8(*(const u32x4*)(U + (size_t)(t - 2) * 512 + c0), u0); else {
#pragma unroll
            for (int e = 0; e < 8; ++e) u0[e] = 0.f; }
#pragma unroll
        for (int e = 0; e < 8; ++e) y[e] = bg[e] * (F.conv_w[c0 + e] * u0[e] + F.conv_w[512 + c0 + e] * u1[e] + F.conv_w[1024 + c0 + e] * u2[e] + F.conv_b[c0 + e]);
        *(u32x4*)(YAB + (size_t)t * 1024 + 512 + c0) = pack8(y);
    }
}

namespace attn_body {
using bf16x8 = __attribute__((ext_vector_type(8))) short;
using s16x4 = __attribute__((ext_vector_type(4))) short;
using f32x16 = __attribute__((ext_vector_type(16))) float;
using u32x4 = __attribute__((ext_vector_type(4))) unsigned;
constexpr int SEQ = 4096, D = 64, DMQ = 1024, DMK = 512;
constexpr int NW = 8, QBLK = 32, QB = QBLK * NW, KVBLK = 64;
constexpr float NEGB = -1e30f;
__device__ __forceinline__ int crow(int r, int hi) { return (r & 3) + 8 * (r >> 2) + 4 * hi; }
#define SBAR() __builtin_amdgcn_sched_barrier(0)
__device__ __forceinline__ void cmask(f32x16& p0, f32x16& p1, int jb, int qrel, int hi) {
  const float NEG = -INFINITY; int kb = 64 * jb + 4 * hi;
  #pragma unroll
  for (int r = 0; r < 16; ++r) { int kv = kb + (r & 3) + 8 * (r >> 2); if (kv > qrel) p0[r] = NEG; if (kv + 32 > qrel) p1[r] = NEG; }
}
constexpr int NSLOT = 3, SLOTB = 8192;
constexpr int LDS_K = 0, LDS_V = NSLOT * SLOTB, LDS_WS = 2 * NSLOT * SLOTB, LDS_OST = LDS_WS + NW * 128 * 4, LDS_BYTES_A = LDS_OST + NW * 4096;
__device__ __forceinline__ void glds16(const void* gsrc, unsigned lds_dst) { unsigned keep;
  asm volatile("s_mov_b32 %0, m0\n\ts_mov_b32 m0, %2\n\ts_nop 0\n\tglobal_load_lds_dwordx4 %1, off\n\ts_mov_b32 m0, %0" : "=&s"(keep) : "v"(gsrc), "s"(lds_dst) : "memory"); }
__device__ __forceinline__ float max3f(float a, float b, float c) { float r; asm("v_max3_f32 %0, %1, %2, %3" : "=v"(r) : "v"(a), "v"(b), "v"(c)); return r; }
__device__ __forceinline__ float max2f(float a, float b) { float r; asm("v_max_f32_e32 %0, %1, %2" : "=v"(r) : "v"(a), "v"(b)); return r; }
__device__ __forceinline__ float fadd_s(float a, float b) { float r; asm("v_add_f32_e32 %0, %1, %2" : "=v"(r) : "v"(a), "v"(b)); return r; }
__device__ __forceinline__ float fsub_s(float a, float b) { float r; asm("v_sub_f32_e32 %0, %1, %2" : "=v"(r) : "v"(a), "v"(b)); return r; }
typedef float f32x2_t __attribute__((ext_vector_type(2))); typedef __bf16 bf16x2_t __attribute__((ext_vector_type(2)));
__device__ __forceinline__ unsigned cvtpk_s(float lo, float hi) { f32x2_t v = {lo, hi}; bf16x2_t b = __builtin_convertvector(v, bf16x2_t); return __builtin_bit_cast(unsigned, b); }
#define WAIT_BAR(N) asm volatile("s_waitcnt vmcnt(" #N ") lgkmcnt(0)\n\ts_barrier" ::: "memory")
__device__ __forceinline__ void qkt(f32x16& p0, f32x16& p1, const char* Kslot, const bf16x8* qr, const f32x16& negm, int r32, int hi) {
  const char* kb = Kslot + hi * 1024 + r32 * 16;
  #pragma unroll
  for (int d0 = 0; d0 < 4; ++d0) {
    const bf16x8 b0 = *reinterpret_cast<const bf16x8*>(kb + d0 * 2048);
    const bf16x8 b1 = *reinterpret_cast<const bf16x8*>(kb + d0 * 2048 + 512);
    if (d0 == 0) { p0 = __builtin_amdgcn_mfma_f32_32x32x16_bf16(b0, qr[0], negm, 0, 0, 0); p1 = __builtin_amdgcn_mfma_f32_32x32x16_bf16(b1, qr[0], negm, 0, 0, 0); }
    else { p0 = __builtin_amdgcn_mfma_f32_32x32x16_bf16(b0, qr[d0], p0, 0, 0, 0); p1 = __builtin_amdgcn_mfma_f32_32x32x16_bf16(b1, qr[d0], p1, 0, 0, 0); } }
}
typedef __attribute__((address_space(3))) const char* lds_cptr;
typedef __attribute__((address_space(3))) char* lds_ptr;
typedef short v4i16_t __attribute__((ext_vector_type(4)));
__device__ __forceinline__ void kload8(bf16x8* kf, lds_cptr kp) {
  kf[0] = *(const __attribute__((address_space(3))) bf16x8*)(kp);        kf[1] = *(const __attribute__((address_space(3))) bf16x8*)(kp + 512);
  kf[2] = *(const __attribute__((address_space(3))) bf16x8*)(kp + 2048); kf[3] = *(const __attribute__((address_space(3))) bf16x8*)(kp + 2560);
  kf[4] = *(const __attribute__((address_space(3))) bf16x8*)(kp + 4096); kf[5] = *(const __attribute__((address_space(3))) bf16x8*)(kp + 4608);
  kf[6] = *(const __attribute__((address_space(3))) bf16x8*)(kp + 6144); kf[7] = *(const __attribute__((address_space(3))) bf16x8*)(kp + 6656);
}
__device__ __forceinline__ void kload2(bf16x8* kf, lds_cptr kp, int j) { kf[2 * j] = *(const __attribute__((address_space(3))) bf16x8*)(kp + j * 2048); kf[2 * j + 1] = *(const __attribute__((address_space(3))) bf16x8*)(kp + j * 2048 + 512); }
__device__ __forceinline__ s16x4 vtr(lds_cptr p) { return __builtin_bit_cast(s16x4, __builtin_amdgcn_ds_read_tr16_b64_v4i16((__attribute__((address_space(3))) v4i16_t*)p)); }
__device__ __forceinline__ float rowmax(const f32x16& p0, const f32x16& p1) {
  float a = max3f(p0[0], p0[1], p1[0]), b = max3f(p0[2], p0[3], p1[1]); a = max3f(a, p1[2], p1[3]);
  #pragma unroll
  for (int r = 4; r < 16; r += 4) { a = max3f(a, p0[r], p0[r + 1]); b = max3f(b, p0[r + 2], p0[r + 3]); a = max3f(a, p1[r], p1[r + 1]); b = max3f(b, p1[r + 2], p1[r + 3]); }
  const float m = max2f(a, b);
  auto rr = __builtin_amdgcn_permlane32_swap(__float_as_uint(m), __float_as_uint(m), false, false);
  return max2f(__uint_as_float(rr[0]), __uint_as_float(rr[1]));
}
__device__ __forceinline__ void pv(f32x16* o, int vb, bf16x8 pa0, bf16x8 pa1, bf16x8 pa2, bf16x8 pa3) {
  #pragma unroll
  for (int d0 = 0; d0 < 2; ++d0) { s16x4 lo[4], hi[4];
    #pragma unroll
    for (int ks = 0; ks < 4; ++ks) {
      asm volatile("ds_read_b64_tr_b16 %0,%1 offset:%c2" : "=&v"(lo[ks]) : "v"(vb), "i"(d0 * 4096 + ks * 1024) : "memory");
      asm volatile("ds_read_b64_tr_b16 %0,%1 offset:%c2" : "=&v"(hi[ks]) : "v"(vb), "i"(d0 * 4096 + ks * 1024 + 512) : "memory"); }
    asm volatile("s_waitcnt lgkmcnt(0)" ::: "memory"); SBAR();
    #define PK(k) (bf16x8){lo[k][0], lo[k][1], lo[k][2], lo[k][3], hi[k][0], hi[k][1], hi[k][2], hi[k][3]}
    o[d0] = __builtin_amdgcn_mfma_f32_32x32x16_bf16(pa0, PK(0), o[d0], 0, 0, 0);
    o[d0] = __builtin_amdgcn_mfma_f32_32x32x16_bf16(pa1, PK(1), o[d0], 0, 0, 0);
    o[d0] = __builtin_amdgcn_mfma_f32_32x32x16_bf16(pa2, PK(2), o[d0], 0, 0, 0);
    o[d0] = __builtin_amdgcn_mfma_f32_32x32x16_bf16(pa3, PK(3), o[d0], 0, 0, 0);
    #undef PK
  }
}
#define ATTN_STORE16(p, v) st16((p), (v))
template <int THRL> __device__ __forceinline__ void attn_unit(int b, int h, int qb, const bf16_t* QO, bf16_t* Ob, const bf16_t* __restrict__ K, const bf16_t* __restrict__ V, const float* __restrict__ kmean, char* shm) {
  int tid_ = threadIdx.x; asm volatile("" : "+v"(tid_));
  const int tid = tid_, lane = tid & 63, r32 = lane & 31, hi = lane >> 5; const int wid = __builtin_amdgcn_readfirstlane(tid >> 6);
  const long rowbase = (long)b * SEQ; const int q0 = qb * QB;
  const bf16_t* Qw = QO + (rowbase + q0 + wid * QBLK) * DMQ + h * D;
  const bf16_t* Kh = K + rowbase * DMK + h * D, *Vh = V + rowbase * DMK + h * D;
  const unsigned lds0 = (unsigned)(uintptr_t)shm;
  float* wsf = (float*)(shm + LDS_WS) + wid * 128;
  const bf16_t* ksrc = Kh + (long)lane * DMK + wid * 8;
  const bf16_t* vsrc = Vh + (long)(16 * (wid & 3) + (lane >> 2)) * DMK + (wid >> 2) * 32 + (lane & 3) * 8;
  const unsigned kdst = lds0 + LDS_K + wid * 1024, vdst = lds0 + LDS_V + wid * 1024;
  #define DMA_K(t, slot) glds16(ksrc + (long)(t) * KVBLK * DMK, (unsigned)__builtin_amdgcn_readfirstlane(kdst + (slot)))
  #define DMA_V(t, slot) glds16(vsrc + (long)(t) * KVBLK * DMK, (unsigned)__builtin_amdgcn_readfirstlane(vdst + (slot)))
  DMA_K(0, 0); DMA_V(0, 0); DMA_K(1, SLOTB);
  bf16x8 qr[4];
  #pragma unroll
  for (int d0 = 0; d0 < 4; ++d0) qr[d0] = *reinterpret_cast<const bf16x8*>(&Qw[(long)r32 * DMQ + d0 * 16 + hi * 8]);
  unsigned selm = 0u;
  if (qb > 0) {
    float* kmL = (float*)(shm + LDS_OST);
    const float* kmg = kmean + ((size_t)(b * 8 + h) * 16) * 64;
    for (int i = tid; i < qb * 64; i += 512) kmL[i] = kmg[i];
    asm volatile("s_waitcnt vmcnt(0) lgkmcnt(0)\n\ts_barrier" ::: "memory");
    float qf[32];
    #pragma unroll
    for (int d0 = 0; d0 < 4; ++d0)
      #pragma unroll
      for (int e = 0; e < 8; ++e) qf[8 * d0 + e] = __uint_as_float(((unsigned)(unsigned short)qr[d0][e]) << 16);
    float b0 = -INFINITY, b1 = -INFINITY, b2 = -INFINITY; int i0 = -1, i1 = -1, i2 = -1;
    for (int j = 0; j < qb; ++j) {
      const float* km = kmL + j * 64 + 8 * hi; float sc = 0.f;
      #pragma unroll
      for (int d0 = 0; d0 < 4; ++d0)
        #pragma unroll
        for (int e = 0; e < 8; ++e) sc += qf[8 * d0 + e] * km[16 * d0 + e];
      sc += __shfl_xor(sc, 32);
      if (sc > b0) { b2 = b1; i2 = i1; b1 = b0; i1 = i0; b0 = sc; i0 = j; } else if (sc > b1) { b2 = b1; i2 = i1; b1 = sc; i1 = j; } else if (sc > b2) { b2 = sc; i2 = j; }
    }
    if (i0 >= 0) selm |= 1u << i0; if (i1 >= 0) selm |= 1u << i1; if (i2 >= 0) selm |= 1u << i2;
    asm volatile("s_waitcnt lgkmcnt(0)\n\ts_barrier" ::: "memory");
  }
  if (hi == 0) ((unsigned*)wsf)[64 + r32] = selm;
  { const lds_ptr qst = (lds_ptr)shm + LDS_OST + wid * 4096 + lane * 16;
    #pragma unroll
    for (int d0 = 0; d0 < 4; ++d0) *(__attribute__((address_space(3))) bf16x8*)(qst + d0 * 1024) = qr[d0]; }
  #define SELROW(j) (((j) >= qb) || ((((const unsigned*)wsf)[64 + r32] >> (j)) & 1u))
  #define NEGM_SET(blk) do { const float nv_ = SELROW(blk) ? -mhat : NEGB; _Pragma("unroll") for (int r = 0; r < 16; ++r) negm[r] = nv_; asm volatile("" : "+v"(negm)); } while (0)
  const int vb0 = (int)(lds0 + LDS_V) + ((lane >> 4) & 1) * 32 + (lane & 3) * 8 + (4 * hi + ((lane & 15) >> 2)) * 64;
  const char* Kbase = shm + LDS_K; bf16x8 kf[8];
  const lds_cptr qp0 = (lds_cptr)shm + LDS_OST + wid * 4096 + lane * 16;
  const lds_cptr shm3 = (lds_cptr)shm; const lds_cptr kp0 = shm3 + LDS_K + hi * 1024 + r32 * 16; const lds_cptr vp0 = shm3 + LDS_V + ((lane >> 4) & 1) * 32 + (lane & 3) * 8 + (4 * hi + ((lane & 15) >> 2)) * 64;
  const int NT = (q0 + QB) / KVBLK;
  float mhat = 0.f, l_reg = 0.f; f32x16 o[2]; o[0] = f32x16{}; o[1] = f32x16{}; f32x16 negm;
  NEGM_SET(0);
  const int qrel = wid * QBLK + r32;
  #define CMASK(P0, P1, t) do { int jb_ = (t) - (NT - 4); if (jb_ >= 0) cmask(P0, P1, jb_, qrel, hi); } while (0)
  bool resc = false;
  #define START(P0, P1) do { const float rm = rowmax(P0, P1); resc = false; \
    { const float dl = SELROW(0) ? rm : 0.f; mhat = fadd_s(mhat, dl); \
      _Pragma("unroll") for (int r = 0; r < 16; ++r) { P0[r] = fsub_s(P0[r], dl); P1[r] = fsub_s(P1[r], dl); } \
      NEGM_SET(0); } \
    _Pragma("unroll") for (int r = 0; r < 16; ++r) P0[r] = __builtin_amdgcn_exp2f(P0[r]); } while (0)
  #define RESC() do { if (resc) { asm volatile("s_waitcnt lgkmcnt(0)" ::: "memory"); \
      _Pragma("unroll") for (int d_ = 0; d_ < 2; ++d_) _Pragma("unroll") for (int r = 0; r < 16; ++r) o[d_][r] *= wsf[crow(r, hi)]; } } while (0)
  f32x16 pA0, pA1, pB0, pB1;
  int sl_prev = 0, sl_cur = 0, sl_next = SLOTB;
  #define ROT() do { sl_prev = sl_cur; sl_cur = sl_next; sl_next = (sl_next == (NSLOT - 1) * SLOTB) ? 0 : sl_next + SLOTB; } while (0)
  DMA_K(2, 2 * SLOTB);
  WAIT_BAR(3);
  qkt(pA0, pA1, Kbase, qr, negm, r32, hi); asm volatile("s_nop 15\n\ts_nop 7" : "+v"(pA0), "+v"(pA1)); CMASK(pA0, pA1, 0);
  START(pA0, pA1);
  _Pragma("unroll") for (int r = 0; r < 16; ++r) pA1[r] = __builtin_amdgcn_exp2f(pA1[r]);
  WAIT_BAR(0);
  DMA_K(3, 0); DMA_V(1, SLOTB);
  ROT();
  kload8(kf, kp0 + sl_cur);
  WAIT_BAR(2);
  s16x4 vlo[8], vhi[8]; u32x4 pw0, pw1, pw2, pw3; bf16x8 q0_, q1_, q2_, q3_;
  #define QRD(d) do { q##d##_ = *(const __attribute__((address_space(3))) bf16x8*)(qp0 + (d) * 1024); } while (0)
  QRD(0); QRD(1);
  #define PKW(P, B) cvtpk_s(P[B], P[B + 1])
  #define PAF(k) __builtin_bit_cast(bf16x8, pw##k)
  #define VFR(i) (bf16x8){vlo[i][0], vlo[i][1], vlo[i][2], vlo[i][3], vhi[i][0], vhi[i][1], vhi[i][2], vhi[i][3]}
  #define PIN(x) asm volatile("" : "+v"(x))
  #define MX3(a, b, c) __builtin_fmaxf(__builtin_fmaxf((a), (b)), (c))
  #define GAPA(MF, A0, A1, A2, A3, W0, W1, PW) do { MF; sacc += A0; sacc += A1; sacc += A2; sacc += A3; PIN(sacc); W0; W1; PIN(PW); SBAR(); } while (0)
  #define EX(v) __builtin_amdgcn_exp2f(v)
  #define GAPB(MF, X, B) do { MF; X[B] = EX(X[B]); X[B + 1] = EX(X[B + 1]); X[B + 2] = EX(X[B + 2]); X[B + 3] = EX(X[B + 3]); PIN(X); SBAR(); } while (0)
  #define VRD(i) do { vlo[i] = vtr(vp_ + (((i) >> 2) * 4096 + ((i) & 3) * 1024)); vhi[i] = vtr(vp_ + (((i) >> 2) * 4096 + ((i) & 3) * 1024 + 512)); } while (0)
  #define KRD(G, j) do { if (G) { kload2(kf, kp0 + sl_next, j); SBAR(); } } while (0)
  #define STEP(C0, C1, P0, P1, t, GK, GV, GL) do { SBAR(); \
    const lds_cptr vp_ = vp0 + sl_prev; \
    VRD(0); SBAR(); float sacc = (P0[0] + P0[1]); \
    GAPA(C0 = __builtin_amdgcn_mfma_f32_32x32x16_bf16(kf[0], q0_, negm, 0, 0, 0), P0[2], P0[3], P0[4], P0[5],     pw0[0] = PKW(P0, 0), pw0[1] = PKW(P0, 2), pw0); \
    VRD(4); SBAR(); GAPA(C1 = __builtin_amdgcn_mfma_f32_32x32x16_bf16(kf[1], q0_, negm, 0, 0, 0), P0[6], P0[7], P0[8], P0[9],     pw0[2] = PKW(P0, 4), pw0[3] = PKW(P0, 6), pw0); \
    QRD(2); SBAR(); \
    VRD(1); SBAR(); GAPA(C0 = __builtin_amdgcn_mfma_f32_32x32x16_bf16(kf[2], q1_, C0, 0, 0, 0),   P0[10], P0[11], P0[12], P0[13], pw1[0] = PKW(P0, 8), pw1[1] = PKW(P0, 10), pw1); \
    VRD(5); SBAR(); GAPA(C1 = __builtin_amdgcn_mfma_f32_32x32x16_bf16(kf[3], q1_, C1, 0, 0, 0),   P0[14], P0[15], P1[0], P1[1],   pw1[2] = PKW(P0, 12), pw1[3] = PKW(P0, 14), pw1); \
    QRD(3); SBAR(); \
    VRD(2); SBAR(); GAPA(C0 = __builtin_amdgcn_mfma_f32_32x32x16_bf16(kf[4], q2_, C0, 0, 0, 0),   P1[2], P1[3], P1[4], P1[5],     pw2[0] = PKW(P1, 0), pw2[1] = PKW(P1, 2), pw2); \
    VRD(6); SBAR(); GAPA(C1 = __builtin_amdgcn_mfma_f32_32x32x16_bf16(kf[5], q2_, C1, 0, 0, 0),   P1[6], P1[7], P1[8], P1[9],     pw2[2] = PKW(P1, 4), pw2[3] = PKW(P1, 6), pw2); \
    VRD(3); SBAR(); GAPA(C0 = __builtin_amdgcn_mfma_f32_32x32x16_bf16(kf[6], q3_, C0, 0, 0, 0),   P1[10], P1[11], P1[12], P1[13], pw3[0] = PKW(P1, 8), pw3[1] = PKW(P1, 10), pw3); \
    VRD(7); SBAR(); GAPA(C1 = __builtin_amdgcn_mfma_f32_32x32x16_bf16(kf[7], q3_, C1, 0, 0, 0),   P1[14], P1[15], 0.f, 0.f,       pw3[2] = PKW(P1, 12), pw3[3] = PKW(P1, 14), pw3); \
    l_reg += sacc; \
    if (GK) { DMA_K((t) + 3, sl_cur); } if (GV) { DMA_V((t) + 1, sl_next); } \
    CMASK(C0, C1, t); \
    { float a = MX3(C0[0], C0[1], C1[0]), b = MX3(C0[2], C0[3], C1[1]); a = MX3(a, C1[2], C1[3]); \
      _Pragma("unroll") for (int r = 4; r < 16; r += 4) { a = MX3(a, C0[r], C0[r + 1]); b = MX3(b, C0[r + 2], C0[r + 3]); a = MX3(a, C1[r], C1[r + 1]); b = MX3(b, C1[r + 2], C1[r + 3]); } \
      float rm = __builtin_fmaxf(a, b); { auto rr = __builtin_amdgcn_permlane32_swap(__float_as_uint(rm), __float_as_uint(rm), false, false); rm = __builtin_fmaxf(__uint_as_float(rr[0]), __uint_as_float(rr[1])); } \
      resc = false; \
      if (__builtin_expect(__any(rm > (float)THRL), 0)) { const float dl = __builtin_fmaxf(rm, 0.f); mhat += dl; \
        _Pragma("unroll") for (int r = 0; r < 16; ++r) { C0[r] -= dl; C1[r] -= dl; } \
        NEGM_SET(((t) + 1) >> 2); \
        const float f = __builtin_amdgcn_exp2f(-dl); l_reg *= f; if (hi == 0) wsf[r32] = f; resc = true; } \
      else if ((((t) + 1) & 3) == 0) { NEGM_SET(((t) + 1) >> 2); } } \
    SBAR(); \
    GAPB(o[0] = __builtin_amdgcn_mfma_f32_32x32x16_bf16(PAF(0), VFR(0), o[0], 0, 0, 0), C0, 0); \
    GAPB(o[1] = __builtin_amdgcn_mfma_f32_32x32x16_bf16(PAF(0), VFR(4), o[1], 0, 0, 0), C0, 4); \
    KRD(GL, 0); GAPB(o[0] = __builtin_amdgcn_mfma_f32_32x32x16_bf16(PAF(1), VFR(1), o[0], 0, 0, 0), C0, 8); \
    KRD(GL, 1); GAPB(o[1] = __builtin_amdgcn_mfma_f32_32x32x16_bf16(PAF(1), VFR(5), o[1], 0, 0, 0), C0, 12); \
    KRD(GL, 2); GAPB(o[0] = __builtin_amdgcn_mfma_f32_32x32x16_bf16(PAF(2), VFR(2), o[0], 0, 0, 0), C1, 0); \
    KRD(GL, 3); GAPB(o[1] = __builtin_amdgcn_mfma_f32_32x32x16_bf16(PAF(2), VFR(6), o[1], 0, 0, 0), C1, 4); \
    GAPB(o[0] = __builtin_amdgcn_mfma_f32_32x32x16_bf16(PAF(3), VFR(3), o[0], 0, 0, 0), C1, 8); \
    GAPB(o[1] = __builtin_amdgcn_mfma_f32_32x32x16_bf16(PAF(3), VFR(7), o[1], 0, 0, 0), C1, 12); \
    QRD(0); QRD(1); SBAR(); \
    } while (0)
  int t = 1;
  #undef CMASK
  #define CMASK(P0, P1, t) do {} while (0)
  for (; t + 5 < NT; t += 2) {
    STEP(pB0, pB1, pA0, pA1, t, true, true, true);     WAIT_BAR(2); RESC(); ROT();
    STEP(pA0, pA1, pB0, pB1, t + 1, true, true, true); WAIT_BAR(2); RESC(); ROT();
  }
  #undef CMASK
  #define CMASK(P0, P1, t) do { int jb_ = (t) - (NT - 4); if (jb_ >= 0) cmask(P0, P1, jb_, qrel, hi); } while (0)
  #define ENDW(tt) do { if ((tt) + 3 < NT) { WAIT_BAR(2); } else if ((tt) + 2 < NT) { WAIT_BAR(1); } else { WAIT_BAR(0); } } while (0)
  for (; t + 1 < NT; t += 2) {
    STEP(pB0, pB1, pA0, pA1, t, (t + 3 < NT), (t + 1 < NT), (t + 1 < NT));       ENDW(t);     RESC(); ROT();
    STEP(pA0, pA1, pB0, pB1, t + 1, (t + 4 < NT), (t + 2 < NT), (t + 2 < NT));   ENDW(t + 1); RESC(); ROT();
  }
  STEP(pB0, pB1, pA0, pA1, NT - 1, false, false, false); RESC();
  { float sacc = pB0[0] + pB0[1]; _Pragma("unroll") for (int r = 2; r < 16; ++r) sacc += pB0[r]; _Pragma("unroll") for (int r = 0; r < 16; ++r) sacc += pB1[r]; l_reg += sacc;
    pw0 = (u32x4){PKW(pB0, 0), PKW(pB0, 2), PKW(pB0, 4), PKW(pB0, 6)}; pw1 = (u32x4){PKW(pB0, 8), PKW(pB0, 10), PKW(pB0, 12), PKW(pB0, 14)}; pw2 = (u32x4){PKW(pB1, 0), PKW(pB1, 2), PKW(pB1, 4), PKW(pB1, 6)}; pw3 = (u32x4){PKW(pB1, 8), PKW(pB1, 10), PKW(pB1, 12), PKW(pB1, 14)};
    SBAR(); pv(o, vb0 + sl_cur, PAF(0), PAF(1), PAF(2), PAF(3)); }
  #undef PKW
  #undef PAF
  #undef VFR
  #undef PIN
  #undef MX3
  #undef GAPA
  #undef GAPB
  #undef EX
  #undef VRD
  #undef KRD
  #undef QRD
  #undef STEP
  #undef ENDW
  { auto rr = __builtin_amdgcn_permlane32_swap(__float_as_uint(l_reg), __float_as_uint(l_reg), false, false); l_reg = __uint_as_float(rr[0]) + __uint_as_float(rr[1]); }
  if (hi == 0) wsf[32 + r32] = l_reg; asm volatile("s_waitcnt lgkmcnt(0)" ::: "memory");
  float rli[16];
  #pragma unroll
  for (int r = 0; r < 16; ++r) rli[r] = __builtin_amdgcn_rcpf(wsf[32 + crow(r, hi)]);
  bf16_t* Ow = Ob + (rowbase + q0 + wid * QBLK) * DMQ + h * D;
  { bf16_t* stg = (bf16_t*)(shm + LDS_OST) + wid * 2048;
    #pragma unroll
    for (int r = 0; r < 16; ++r) { const int orow = crow(r, hi);
      #pragma unroll
      for (int d0 = 0; d0 < 2; ++d0) stg[orow * 64 + d0 * 32 + r32] = (bf16_t)f2bf(o[d0][r] * rli[r]); }
    asm volatile("s_waitcnt lgkmcnt(0)" ::: "memory");
    #pragma unroll
    for (int i = 0; i < 4; ++i) { const int row = i * 8 + (lane >> 3), ch = lane & 7; const u32x4 v = *(const u32x4*)(stg + row * 64 + ch * 8); ATTN_STORE16(Ow + (long)row * DMQ + ch * 8, v); } }
  asm volatile("s_waitcnt lgkmcnt(0)\n\ts_barrier" ::: "memory");
  #undef DMA_K
  #undef DMA_V
  #undef CMASK
  #undef START
  #undef RESC
  #undef ROT
  #undef SELROW
  #undef NEGM_SET
}
#undef SBAR
#undef WAIT_BAR
}
__device__ __forceinline__ void conv_pass(Frame& F) {
    bf16_t* YAB = WSP(bf16_t, WS_YAB); const bf16_t* U = WSP(bf16_t, WS_U); const bf16_t* BG = WSP(bf16_t, WS_BG);
    const int stride = F.G * NTHREADS;
    for (int i0 = blockIdx.x * NTHREADS + F.tid; i0 < T * 64; i0 += 2 * stride) {
        u32x4 r2[2], r1[2], r0[2], rb[2];
#pragma unroll
        for (int q = 0; q < 2; ++q) { const int i = i0 + q * stride; const int t = i >> 6, c0 = (i & 63) * 8, pos = t & (S - 1);
            r2[q] = *(const u32x4*)(U + (size_t)t * 512 + c0); rb[q] = __builtin_nontemporal_load((const u32x4*)(BG + (size_t)t * 512 + c0));
            r1[q] = (pos >= 1) ? *(const u32x4*)(U + (size_t)(t - 1) * 512 + c0) : (u32x4){0u, 0u, 0u, 0u};
            r0[q] = (pos >= 2) ? *(const u32x4*)(U + (size_t)(t - 2) * 512 + c0) : (u32x4){0u, 0u, 0u, 0u}; }
#pragma unroll
        for (int q = 0; q < 2; ++q) { const int i = i0 + q * stride; const int t = i >> 6, c0 = (i & 63) * 8;
            float u0[8], u1[8], u2[8], bg[8], y[8]; unpack8(r2[q], u2); unpack8(r1[q], u1); unpack8(r0[q], u0); unpack8(rb[q], bg);
#pragma unroll
            for (int e4 = 0; e4 < 2; ++e4) { const f32x4 w0 = *(const f32x4*)(F.conv_w + c0 + 4 * e4), w1 = *(const f32x4*)(F.conv_w + 512 + c0 + 4 * e4), w2 = *(const f32x4*)(F.conv_w + 1024 + c0 + 4 * e4), cb = *(const f32x4*)(F.conv_b + c0 + 4 * e4);
#pragma unroll
                for (int e = 0; e < 4; ++e) y[4 * e4 + e] = bg[4 * e4 + e] * (w0[e] * u0[4 * e4 + e] + w1[e] * u1[4 * e4 + e] + w2[e] * u2[4 * e4 + e] + cb[e]); }
            st16(YAB + (size_t)t * 1024 + 512 + c0, pack8(y)); }
    }
}
__device__ __forceinline__ void s3_attn(Frame& F, char* lds_gen, bf16_t* obase) {
    const int vcu = (blockIdx.x % 8) * (F.G / 8) + blockIdx.x / 8;
    const int s = vcu & 7, pr = vcu >> 3;
    for (int i = 0; i < 4; ++i) {
        const int bh = 2 * pr + (i >> 1), qb = (i & 1) ? 15 - s : s;
        attn_body::attn_unit<8>(bh >> 3, bh & 7, qb, WSP(bf16_t, WS_YAB), obase, WSP(bf16_t, WS_K), WSP(bf16_t, WS_V), WSP(float, WS_KMEAN), lds_gen);
    }
}
__device__ __forceinline__ void s3_fast(Frame& F, char* lds_gen) { s3_attn(F, lds_gen, WSP(bf16_t, WS_YAB)); conv_pass(F); }

__device__ __forceinline__ void s4_simple(Frame& F) {
    LAS float* tile = (LAS float*)F.lds; LAS float* tile2 = tile + 64 * 65;
    const bf16_t* YAB = WSP(bf16_t, WS_YAB); const bf16_t* WP = WSP(bf16_t, WS_WP_T); const bf16_t* GT = WSP(bf16_t, WS_GATES);
    const int row = F.tid >> 3, seg = F.tid & 7;
    for (int it = blockIdx.x; it < 512 * 16; it += F.G) {
        const int rt = it >> 4, ct = it & 15, r0 = rt * 64, gr = r0 + row;
        const RowsLinear aa{YAB + (size_t)r0 * 1024, 1024}, ab{YAB + (size_t)r0 * 1024 + 512, 1024};
        const RowsLinear ba{WP + (size_t)(64 * ct) * 1024, 1024}, bb{WP + (size_t)(64 * ct) * 1024 + 512, 1024};
        sgemm_tile(tile, 512, aa, ba, F.wave, F.lane); sgemm_tile(tile2, 512, ab, bb, F.wave, F.lane); __syncthreads();
        float ga[8], gb[8], v[8];
        unpack8(*(const u32x4*)(GT + (size_t)gr * 2048 + 64 * ct + 8 * seg), ga); unpack8(*(const u32x4*)(GT + (size_t)gr * 2048 + 1024 + 64 * ct + 8 * seg), gb);
#pragma unroll
        for (int e = 0; e < 8; ++e) v[e] = ga[e] * tile[row * 65 + 8 * seg + e] + gb[e] * tile2[row * 65 + 8 * seg + e];
        *(u32x4*)(WSP(bf16_t, WS_H) + (size_t)gr * 1024 + 64 * ct + 8 * seg) = pack8(v);
        __syncthreads();
    }
}
__device__ __forceinline__ void s5_simple(Frame& F) {
    LAS float* tile = (LAS float*)F.lds;
    const bf16_t* MG = WSP(bf16_t, WS_H); const bf16_t* WO = WSP(bf16_t, WS_WO_T);
    const int row = F.tid >> 3, seg = F.tid & 7;
    for (int it = blockIdx.x; it < 512 * 16; it += F.G) {
        const int rt = it >> 4, ct = it & 15, r0 = rt * 64, gr = r0 + row, b = r0 / S;
        const RowsLinear aa{MG + (size_t)r0 * 1024, 1024}, bb{WO + (size_t)(64 * ct) * 1024, 1024};
        sgemm_tile(tile, 1024, aa, bb, F.wave, F.lane); __syncthreads();
        const float* ga1 = WSP(float, WS_MOD) + (size_t)b * NMOD + 2048 + 64 * ct + 8 * seg;
        const float* xr = F.x + (size_t)gr * D + 64 * ct + 8 * seg; float* orow = F.out + (size_t)gr * D + 64 * ct + 8 * seg;
#pragma unroll
        for (int e4 = 0; e4 < 2; ++e4) { const f32x4 xv = *(const f32x4*)(xr + 4 * e4), gv = *(const f32x4*)(ga1 + 4 * e4); f32x4 o;
#pragma unroll
            for (int e = 0; e < 4; ++e) o[e] = xv[e] + gv[e] * tile[row * 65 + 8 * seg + 4 * e4 + e];
            *(f32x4*)(orow + 4 * e4) = o; }
        __syncthreads();
    }
}

struct EpiG2 {
    static constexpr bool HAS_MID = true;
    const bf16_t* gates; bf16_t* merged;
    __device__ __forceinline__ void mid(Acc& acc, const pg8::Unit& u, int wr, int wc, int fr, int fq) const {
        int row0 = u.pm * 256 + wr * 64 + fr; const int c0 = u.pn * 256 + 32 * wc + 8 * fq; asm volatile("" : "+v"(row0));
#pragma unroll
        for (int ai = 0; ai < 2; ++ai)
#pragma unroll
            for (int m = 0; m < 4; ++m) { const bf16_t* gp = gates + (size_t)(row0 + 128 * ai + 16 * m) * 2048 + c0;
#pragma unroll
                for (int bj = 0; bj < 2; ++bj) { f32x4 a0, a1; unpack8v(__builtin_nontemporal_load((const u32x4*)(gp + 128 * bj)), a0, a1);
                    acc[ai][bj][m][0] *= a0; acc[ai][bj][m][1] *= a1; } }
    }
    __device__ __forceinline__ void operator()(Acc& acc, const pg8::Unit& u, int wr, int wc, int fr, int fq) const {
        int row0 = u.pm * 256 + wr * 64 + fr; const int c0 = u.pn * 256 + 32 * wc + 8 * fq; asm volatile("" : "+v"(row0));
#pragma unroll
        for (int ai = 0; ai < 2; ++ai)
#pragma unroll
            for (int m = 0; m < 4; ++m) { const size_t r = (size_t)(row0 + 128 * ai + 16 * m);
#pragma unroll
                for (int bj = 0; bj < 2; ++bj) { f32x4 b0, b1; unpack8v(__builtin_nontemporal_load((const u32x4*)(gates + r * 2048 + 1024 + c0 + 128 * bj)), b0, b1);
                    st16(merged + r * 1024 + c0 + 128 * bj, pack8v(acc[ai][bj][m][0] * b0, acc[ai][bj][m][1] * b1)); } }
    }
};
__device__ __forceinline__ void s4_fast(Frame& F) {
    const pg8::DenseSched Sd{(const char*)(F.ws + WS_YAB), (const char*)(F.ws + WS_WP_T), T / 256, 4, 1024, F.G, (int)blockIdx.x};
    const EpiG2 E{WSP(bf16_t, WS_GATES), WSP(bf16_t, WS_H)};
    if (F.skip) pg8::gemm_phase<EpiG2, pg8::DenseSched, true>(F.lds, 1024, Sd, E); else pg8::gemm_phase<EpiG2, pg8::DenseSched>(F.lds, 1024, Sd, E);
}
struct EpiG3 {
    static constexpr bool HAS_MID = false;
    const float* x; bf16_t* x1; const float* mod;
    __device__ __forceinline__ void mid(Acc&, const pg8::Unit&, int, int, int, int) const {}
    __device__ __forceinline__ void operator()(Acc& acc, const pg8::Unit& u, int wr, int wc, int fr, int fq) const {
        int row0 = u.pm * 256 + wr * 64 + fr; const int c0 = u.pn * 256 + 32 * wc + 8 * fq, b = u.pm >> 4; asm volatile("" : "+v"(row0));
        f32x4 gv[2][2];
#pragma unroll
        for (int bj = 0; bj < 2; ++bj)
#pragma unroll
            for (int n = 0; n < 2; ++n) gv[bj][n] = *(const f32x4*)(mod + (size_t)b * NMOD + 2048 + c0 + 128 * bj + 4 * n);
#pragma unroll
        for (int ai = 0; ai < 2; ++ai)
#pragma unroll
            for (int m = 0; m < 4; ++m) { const size_t off = (size_t)(row0 + 128 * ai + 16 * m) * D + c0;
#pragma unroll
                for (int bj = 0; bj < 2; ++bj) { const f32x4 x0 = __builtin_nontemporal_load((const f32x4*)(x + off + 128 * bj)), x1v = __builtin_nontemporal_load((const f32x4*)(x + off + 128 * bj + 4));
                    st16(x1 + off + 128 * bj, pack8v(x0 + gv[bj][0] * acc[ai][bj][m][0], x1v + gv[bj][1] * acc[ai][bj][m][1])); }
                if (m == 3) asm volatile("" ::: "memory"); }
    }
};
__device__ __forceinline__ void s5_fast(Frame& F) {
    const pg8::DenseSched Sd{(const char*)(F.ws + WS_H), (const char*)(F.ws + WS_WO_T), T / 256, 4, 1024, F.G, (int)blockIdx.x};
    const EpiG3 E{F.x, WSP(bf16_t, WS_X1), WSP(float, WS_MOD)};
    if (F.skip) pg8::gemm_phase<EpiG3, pg8::DenseSched, true>(F.lds, 1024, Sd, E); else pg8::gemm_phase<EpiG3, pg8::DenseSched>(F.lds, 1024, Sd, E);
}
struct MoeTab { const LAS int* cnt; const LAS int* tstart; const LAS int* tile_e; int nM; };
__device__ __forceinline__ MoeTab moe_table(Frame& F) {
    LAS int* cntL = (LAS int*)(F.lds + MISC_OFF + 1024); LAS int* ts = cntL + 32; LAS int* te = cntL + 96;
    if (F.tid < 32) cntL[F.tid] = (int)__hip_atomic_load(WSP(unsigned, WS_CTL) + CW_GCNT + 64 * F.tid, __ATOMIC_RELAXED, __HIP_MEMORY_SCOPE_AGENT);
    __syncthreads();
    if (F.tid == 0) { int pm = 0; for (int e = 0; e < 32; ++e) { ts[e] = pm; const int n = (cntL[e] + 255) >> 8; for (int i = 0; i < n; ++i) te[pm++] = e; } ts[32] = pm; }
    __syncthreads();
    return MoeTab{cntL, ts, te, ts[32]};
}
struct MoeUpSched {
    static constexpr bool GATHER = true, FP8 = true;
    const char* h2; const char* w13; MoeTab tb; const int* linfo; int G, c;
    __device__ __forceinline__ bool next(int i, pg8::Unit& u) const { if (!pg8::static_unit(i, G, c, tb.nM, 4, u.pm, u.pn)) return false;
        u.e = tb.tile_e[u.pm]; u.rbase = (u.pm - tb.tstart[u.e]) * 256; u.a = h2; u.b = w13 + ((size_t)u.e * 1024 + 256 * u.pn) * 1024; return true; }
    __device__ __forceinline__ int row_index(const pg8::Unit& u, int r) const { const int rank = u.rbase + r; return rank < tb.cnt[u.e] ? (linfo[(size_t)u.e * 65536 + rank] >> 1) : 0; }
};
struct EpiUp {
    static constexpr bool HAS_MID = false;
    bf16_t* hid; const float* lw; const LAS int* cnt;
    __device__ __forceinline__ void mid(Acc&, const pg8::Unit&, int, int, int, int) const {}
    __device__ __forceinline__ void operator()(Acc& acc, const pg8::Unit& u, int wr, int wc, int fr, int fq) const {
        int rl0 = wr * 64 + fr; const int c0 = u.pn * 128 + 32 * wc + 8 * fq, n_e = cnt[u.e]; asm volatile("" : "+v"(rl0));
#pragma unroll
        for (int ai = 0; ai < 2; ++ai)
#pragma unroll
            for (int m = 0; m < 4; ++m) { const int rl = rl0 + 128 * ai + 16 * m, rank = u.rbase + rl; const float wt = rank < n_e ? 1.f : 0.f; f32x4 o[2];
#pragma unroll
                for (int n = 0; n < 2; ++n)
#pragma unroll
                    for (int e = 0; e < 4; ++e) { const float a = acc[ai][0][m][n][e] * (1.f / W8_SCALE), c = acc[ai][1][m][n][e] * (1.f / W8_SCALE); o[n][e] = a * __builtin_amdgcn_rcpf(1.f + __expf(-a)) * c * wt; }
                *(u32x2*)((unsigned char*)hid + (size_t)(u.pm * 256 + rl) * 512 + c0) = pack8_fp8(o[0], o[1]); }
    }
};
__device__ __forceinline__ void s8_fast(Frame& F) {
    const MoeTab tb = moe_table(F);
    const MoeUpSched Sd{(const char*)(F.ws + WS_H2), (const char*)(F.ws + WS_W13_T), tb, WSP(int, WS_LINFO), F.G, (int)blockIdx.x};
    const EpiUp E{WSP(bf16_t, WS_HID), WSP(float, WS_LW), tb.cnt};
    int Ku = D; asm volatile("" : "+s"(Ku));
    if (F.skip) pg8::gemm_phase<EpiUp, MoeUpSched, true>(F.lds, Ku, Sd, E); else pg8::gemm_phase<EpiUp, MoeUpSched>(F.lds, Ku, Sd, E);
    { int t_ = threadIdx.x; asm volatile("" : "+v"(t_)); F.tid = t_; F.lane = t_ & 63; }
    { const int units = tb.nM * 4, rem = units % F.G, nidle = (rem == 0) ? F.G : F.G - rem, me = (rem == 0) ? (int)blockIdx.x : (int)blockIdx.x - rem;
        if (me >= 0 && !F.skip) convert_items(F, X_W2, X_END, me * NWAVES + F.wave, nidle * NWAVES); }
}
struct MoeDownSched {
    static constexpr bool GATHER = false, FP8 = true;
    const char* hid; const char* w2; MoeTab tb; int G, c;
    __device__ __forceinline__ bool next(int i, pg8::Unit& u) const { if (!pg8::static_unit(i, G, c, tb.nM, 4, u.pm, u.pn)) return false;
        u.e = tb.tile_e[u.pm]; u.rbase = (u.pm - tb.tstart[u.e]) * 256; u.a = hid + (size_t)u.pm * 256 * 512; u.b = w2 + ((size_t)u.e * 1024 + 256 * u.pn) * 512; return true; }
    __device__ __forceinline__ int row_index(const pg8::Unit&, int) const { return 0; }
};
struct EpiDown {
    static constexpr bool HAS_MID = false;
    bf16_t* yslot; const int* linfo; const float* lw; const LAS int* cnt;
    __device__ __forceinline__ void mid(Acc&, const pg8::Unit&, int, int, int, int) const {}
    __device__ __forceinline__ void operator()(Acc& acc, const pg8::Unit& u, int wr, int wc, int fr, int fq) const {
        int rl0 = wr * 64 + fr; const int c0 = u.pn * 256 + 32 * wc + 8 * fq, n_e = cnt[u.e]; asm volatile("" : "+v"(rl0));
        int info[2][4]; float wt[2][4];
#pragma unroll
        for (int ai = 0; ai < 2; ++ai)
#pragma unroll
            for (int m = 0; m < 4; ++m) { const int rank = u.rbase + rl0 + 128 * ai + 16 * m, rc = rank < n_e ? rank : 0;
                info[ai][m] = linfo[(size_t)u.e * 65536 + rc]; wt[ai][m] = lw[(size_t)u.e * 65536 + rc] * (1.f / W8_SCALE); }
#pragma unroll
        for (int ai = 0; ai < 2; ++ai)
#pragma unroll
            for (int m = 0; m < 4; ++m) { const int rank = u.rbase + rl0 + 128 * ai + 16 * m;
                if (rank < n_e) {
#pragma unroll
                    for (int bj = 0; bj < 2; ++bj) st16(yslot + (size_t)info[ai][m] * 1024 + c0 + 128 * bj, pack8v(acc[ai][bj][m][0] * wt[ai][m], acc[ai][bj][m][1] * wt[ai][m])); } }
    }
};
__device__ __forceinline__ void s9_fast(Frame& F) {
    const MoeTab tb = moe_table(F);
    const MoeDownSched Sd{(const char*)(F.ws + WS_HID), (const char*)(F.ws + WS_W2_T), tb, F.G, (int)blockIdx.x};
    const EpiDown E{WSP(bf16_t, WS_YSLOT), WSP(int, WS_LINFO), WSP(float, WS_LW), tb.cnt};
    int Kd = DE; asm volatile("" : "+s"(Kd));
    if (F.skip) pg8::gemm_phase<EpiDown, MoeDownSched, true>(F.lds, Kd, Sd, E); else pg8::gemm_phase<EpiDown, MoeDownSched>(F.lds, Kd, Sd, E);
}

__device__ __forceinline__ void s6_router(Frame& F) {
    constexpr int WROW = 1032;
    LAS bf16_t* WT = (LAS bf16_t*)F.lds;
    LAS float* gsL = (LAS float*)(F.lds + 48 * WROW * 2);
    LAS float* shL = gsL + 1024;
    LAS float* biasL = shL + 1024;
    LAS float* lgt = biasL + 64;
    LAS int* cnt = (LAS int*)(F.lds + MISC_OFF + 256);
    LAS int* baseL = cnt + 32; LAS int* runL = cnt + 64; LAS int* eidL = cnt + 128; LAS float* ewL = (LAS float*)(cnt + 384);
    const int b = blockIdx.x >> 5;
    const float* mod = WSP(float, WS_MOD) + (size_t)b * NMOD;
    const float* W36 = WSP(float, WS_W36T);
    for (int i = F.tid; i < 36 * 256; i += NTHREADS) { const int jj = i >> 8, k4 = (i & 255) * 4; const f32x4 w = *(const f32x4*)(W36 + jj * 1024 + k4);
        u32x2 p; p.x = pk2(w.x, w.y); p.y = pk2(w.z, w.w); *(LAS u32x2*)(WT + jj * WROW + k4) = p; }
    for (int i = F.tid; i < 12 * 256; i += NTHREADS) { const int jj = 36 + (i >> 8), k4 = (i & 255) * 4; *(LAS u32x2*)(WT + jj * WROW + k4) = (u32x2){0u, 0u}; }
    if (F.tid < 256) { const int col = 4 * F.tid; const f32x4 g = *(const f32x4*)(F.g2 + col), s_ = *(const f32x4*)(mod + 4096 + col); *(LAS f32x4*)(gsL + col) = g * (s_ + 1.0f); *(LAS f32x4*)(shL + col) = *(const f32x4*)(mod + 3072 + col); }
    if (F.tid < 32) cnt[F.tid] = 0;
    __syncthreads();
    for (int jj = F.wave; jj < 36; jj += NWAVES) { float a = 0.f;
#pragma unroll
        for (int i = 0; i < 16; ++i) a += shL[F.lane + 64 * i] * W36[jj * 1024 + F.lane + 64 * i];
        a = wave_sum(a); if (F.lane == 0) biasL[jj] = a + ((jj < 4) ? F.b_rg[jj] : F.b_re[jj - 4]); }
    __syncthreads();
    const int fr = F.lane & 15, fq = F.lane >> 4, row0 = (blockIdx.x * NWAVES + F.wave) * 16, r = row0 + fr;
    const bf16_t* xr = WSP(bf16_t, WS_X1) + (size_t)r * D + 8 * fq;
    f32x4 D0 = {0.f, 0.f, 0.f, 0.f}, D1 = D0, D2 = D0; float ss = 0.f;
#pragma unroll 1
    for (int kb = 0; kb < 8; ++kb) {
        u32x4 xa[4];
#pragma unroll
        for (int i = 0; i < 4; ++i) xa[i] = *(const u32x4*)(xr + 32 * (4 * kb + i));
#pragma unroll
        for (int i = 0; i < 4; ++i) { const int k0 = 32 * (4 * kb + i) + 8 * fq;
            f32x4 a0, a1; unpack8v(xa[i], a0, a1);
            ss += (a0.x * a0.x + a0.y * a0.y) + (a0.z * a0.z + a0.w * a0.w) + (a1.x * a1.x + a1.y * a1.y) + (a1.z * a1.z + a1.w * a1.w);
            a0 *= *(const LAS f32x4*)(gsL + k0); a1 *= *(const LAS f32x4*)(gsL + k0 + 4);
            const bf16x8 A = __builtin_bit_cast(bf16x8, pack8v(a0, a1));
            const bf16x8 B0 = *(const LAS bf16x8*)(WT + fr * WROW + k0), B1 = *(const LAS bf16x8*)(WT + (16 + fr) * WROW + k0), B2 = *(const LAS bf16x8*)(WT + (32 + fr) * WROW + k0);
            D0 = __builtin_amdgcn_mfma_f32_16x16x32_bf16(A, B0, D0, 0, 0, 0);
            D1 = __builtin_amdgcn_mfma_f32_16x16x32_bf16(A, B1, D1, 0, 0, 0);
            D2 = __builtin_amdgcn_mfma_f32_16x16x32_bf16(A, B2, D2, 0, 0, 0); }
    }
    ss += __shfl_xor(ss, 16); ss += __shfl_xor(ss, 32);
    const float rinv = rsqrtf(ss * (1.f / D) + EPS);
    { int t2 = threadIdx.x; asm volatile("" : "+v"(t2)); F.lane = t2 & 63; }
    const int fr_ = F.lane & 15, fq_ = F.lane >> 4;
    {
        LAS float* lw = lgt + F.wave * 16 * 37;
#pragma unroll
        for (int reg = 0; reg < 4; ++reg) { const float rv = __shfl(rinv, 4 * fq_ + reg); const int tk = 4 * fq_ + reg;
            lw[tk * 37 + fr_] = D0[reg] * rv + biasL[fr_]; lw[tk * 37 + 16 + fr_] = D1[reg] * rv + biasL[16 + fr_];
            if (fr_ < 4) lw[tk * 37 + 32 + fr_] = D2[reg] * rv + biasL[32 + fr_]; }
    }
    {
        const int r_ = row0 + fr_; const bf16_t* xr_ = WSP(bf16_t, WS_X1) + (size_t)r_ * D + 8 * fq_;
        unsigned char* o = WSP(unsigned char, WS_H2) + (size_t)r_ * D + 8 * fq_;
#pragma unroll 1
        for (int kb = 0; kb < 8; ++kb) {
            u32x4 xa[4];
#pragma unroll
            for (int i = 0; i < 4; ++i) xa[i] = *(const u32x4*)(xr_ + 32 * (4 * kb + i));
#pragma unroll
            for (int i = 0; i < 4; ++i) { const int k0 = 32 * (4 * kb + i) + 8 * fq_; f32x4 a0, a1; unpack8v(xa[i], a0, a1);
                const f32x4 h0 = a0 * rinv * *(const LAS f32x4*)(gsL + k0) + *(const LAS f32x4*)(shL + k0), h1 = a1 * rinv * *(const LAS f32x4*)(gsL + k0 + 4) + *(const LAS f32x4*)(shL + k0 + 4);
                *(u32x2*)(o + 32 * (4 * kb + i)) = pack8_fp8(h0, h1); }
        }
    }
    if (F.lane < 16) {
        const int t = row0 + F.lane; const LAS float* lw = lgt + (F.wave * 16 + F.lane) * 37;
        float lg[36];
#pragma unroll
        for (int jj = 0; jj < 36; ++jj) lg[jj] = lw[jj];
        int gi = 0; float gm = lg[0];
#pragma unroll
        for (int i = 1; i < 4; ++i) if (lg[i] > gm) { gm = lg[i]; gi = i; }
        float den = 0.f;
#pragma unroll
        for (int i = 0; i < 4; ++i) den += __expf(lg[i] - gm);
        const float gw_ = 1.f / den;
        float v1 = -INFINITY, v2 = -INFINITY; int e1 = 0, e2 = 0;
#pragma unroll
        for (int i = 0; i < 8; ++i) { const float el = (gi == 0) ? lg[4 + i] : (gi == 1) ? lg[12 + i] : (gi == 2) ? lg[20 + i] : lg[28 + i];
            const bool c1 = el > v1, c2 = el > v2;
            v2 = c1 ? v1 : (c2 ? el : v2); e2 = c1 ? e1 : (c2 ? i : e2); v1 = c1 ? el : v1; e1 = c1 ? i : e1; }
        const float p1 = 1.f / (1.f + __expf(v2 - v1)), p2 = 1.f - p1;
        const int id1 = gi * 8 + e1, id2 = gi * 8 + e2;
        const int la = 2 * (F.wave * 16 + F.lane);
        eidL[la] = id1; eidL[la + 1] = id2; ewL[la] = p1 * gw_; ewL[la + 1] = p2 * gw_;
        lds_add(&cnt[id1], 1); lds_add(&cnt[id2], 1);
    }
    __syncthreads();
    if (F.tid < 32) { baseL[F.tid] = (int)__hip_atomic_fetch_add(WSP(unsigned, WS_CTL) + CW_GCNT + 64 * F.tid, (unsigned)cnt[F.tid], __ATOMIC_RELAXED, __HIP_MEMORY_SCOPE_AGENT); runL[F.tid] = 0; }
    __syncthreads();
    if (F.tid < 256) { const int e = eidL[F.tid]; const int pos = baseL[e] + lds_add(&runL[e], 1);
        WSP(int, WS_LINFO)[(size_t)e * 65536 + pos] = 2 * (blockIdx.x * 128) + F.tid; WSP(float, WS_LW)[(size_t)e * 65536 + pos] = ewL[F.tid]; }
    __syncthreads();
    convert_items(F, X_NONEXP, X_W2, blockIdx.x * NWAVES + F.wave, F.G * NWAVES);
}

__device__ __forceinline__ void s7_lists(Frame& F) {
    LAS int* sm = (LAS int*)F.lds;
    const int* bc = WSP(int, WS_BCNT);
    if (F.tid < 32) { int tot = 0, base = 0; for (int bb = 0; bb < 256; ++bb) { const int c = bc[bb * 32 + F.tid]; if (bb < (int)blockIdx.x) base += c; tot += c; }
        sm[F.tid] = tot; sm[32 + F.tid] = base; sm[96 + F.tid] = 0; }
    __syncthreads();
    if (F.tid == 0) { int ps = 0; for (int e = 0; e < 32; ++e) { sm[64 + e] = ps; ps += (sm[e] + 255) & ~255; }
        if (blockIdx.x == 0) { int* te = WSP(int, WS_TILEE); int pm = 0; for (int e = 0; e < 32; ++e) { const int n = (sm[e] + 255) >> 8; for (int i = 0; i < n; ++i) te[1 + pm++] = e; } te[0] = pm; } }
    __syncthreads();
    int* atok = WSP(int, WS_ATOK); int* ainfo = WSP(int, WS_AINFO); float* aw = WSP(float, WS_AW);
    if (F.tid < 256) { const int a = blockIdx.x * 256 + F.tid;
        const int e = WSP(int, WS_EID)[a]; const int rank = lds_add(&sm[96 + e], 1); const int pos = sm[64 + e] + sm[32 + e] + rank;
        atok[pos] = a >> 1; ainfo[pos] = a; aw[pos] = WSP(float, WS_EW)[a]; }
    if (blockIdx.x < 32) { const int e = blockIdx.x; const int lo = sm[64 + e] + sm[e], hi = sm[64 + e] + ((sm[e] + 255) & ~255);
        for (int p = lo + F.tid; p < hi; p += NTHREADS) { atok[p] = 0; ainfo[p] = -1; aw[p] = 0.f; } }
}

struct RowsGather { const bf16_t* base; const int* idx; __device__ __forceinline__ const bf16_t* operator()(int r) const { return base + (size_t)idx[r] * 1024; } };
__device__ __forceinline__ void s8_simple(Frame& F) {
    LAS float* tile = (LAS float*)F.lds; LAS float* tile2 = tile + 64 * 65;
    const int* te = WSP(int, WS_TILEE); const int nmt = te[0];
    const int row = F.tid >> 3, seg = F.tid & 7;
    for (int it = blockIdx.x; it < nmt * 4 * 8; it += F.G) {
        const int rt = it >> 3, ct = it & 7, e = te[1 + (rt >> 2)], pos0 = 64 * rt, hc = 64 * ct;
        const RowsGather ar{WSP(bf16_t, WS_H2), WSP(int, WS_ATOK) + pos0};
        const bf16_t* wb = WSP(bf16_t, WS_W13_T) + ((size_t)e * 1024 + 256 * (hc >> 7) + (hc & 127)) * 1024;
        const RowsLinear b1{wb, 1024}, b3{wb + (size_t)128 * 1024, 1024};
        sgemm_tile(tile, 1024, ar, b1, F.wave, F.lane); sgemm_tile(tile2, 1024, ar, b3, F.wave, F.lane); __syncthreads();
        const float wt = WSP(float, WS_AW)[pos0 + row]; float v[8];
#pragma unroll
        for (int e8 = 0; e8 < 8; ++e8) { const float a = tile[row * 65 + 8 * seg + e8], c = tile2[row * 65 + 8 * seg + e8]; v[e8] = (a / (1.f + __expf(-a))) * c * wt; }
        *(u32x4*)(WSP(bf16_t, WS_HID) + (size_t)(pos0 + row) * 512 + hc + 8 * seg) = pack8(v);
        __syncthreads();
    }
}
__device__ __forceinline__ void s9_simple(Frame& F) {
    LAS float* tile = (LAS float*)F.lds;
    const int* te = WSP(int, WS_TILEE); const int nmt = te[0];
    const int row = F.tid >> 3, seg = F.tid & 7;
    for (int it = blockIdx.x; it < nmt * 4 * 16; it += F.G) {
        const int rt = it >> 4, ct = it & 15, e = te[1 + (rt >> 2)], pos0 = 64 * rt;
        const RowsLinear ar{WSP(bf16_t, WS_HID) + (size_t)pos0 * 512, 512};
        const RowsLinear br{WSP(bf16_t, WS_W2_T) + ((size_t)e * 1024 + 64 * ct) * 512, 512};
        sgemm_tile(tile, 512, ar, br, F.wave, F.lane); __syncthreads();
        const int info = WSP(int, WS_AINFO)[pos0 + row];
        if (info >= 0) { float v[8];
#pragma unroll
            for (int e8 = 0; e8 < 8; ++e8) v[e8] = tile[row * 65 + 8 * seg + e8];
            *(u32x4*)(WSP(bf16_t, WS_YSLOT) + (size_t)info * 1024 + 64 * ct + 8 * seg) = pack8(v); }
        __syncthreads();
    }
}
__device__ __forceinline__ void s10_combine(Frame& F) {
    const bf16_t* Y = WSP(bf16_t, WS_YSLOT); const bf16_t* X1 = WSP(bf16_t, WS_X1);
    const int stride = F.G * NTHREADS;
    for (int i0 = blockIdx.x * NTHREADS + F.tid; i0 < T * 128; i0 += 2 * stride) {
        u32x4 ya[2], yb[2], xx[2]; f32x4 g0[2], g1[2];
#pragma unroll
        for (int q = 0; q < 2; ++q) { const int i = i0 + q * stride; const int t = i >> 7, c0 = (i & 127) * 8, b = t / S;
            ya[q] = __builtin_nontemporal_load((const u32x4*)(Y + (size_t)(2 * t) * 1024 + c0)); yb[q] = __builtin_nontemporal_load((const u32x4*)(Y + (size_t)(2 * t + 1) * 1024 + c0)); xx[q] = __builtin_nontemporal_load((const u32x4*)(X1 + (size_t)t * D + c0));
            const float* ga2 = WSP(float, WS_MOD) + (size_t)b * NMOD + 5120 + c0; g0[q] = *(const f32x4*)ga2; g1[q] = *(const f32x4*)(ga2 + 4); }
#pragma unroll
        for (int q = 0; q < 2; ++q) { const int i = i0 + q * stride; const int t = i >> 7, c0 = (i & 127) * 8;
            f32x4 y0a, y0b, y1a, y1b, xa, xb; unpack8v(ya[q], y0a, y0b); unpack8v(yb[q], y1a, y1b); unpack8v(xx[q], xa, xb);
            float* o = F.out + (size_t)t * D + c0;
            __builtin_nontemporal_store(xa + g0[q] * (y0a + y1a), (f32x4*)o); __builtin_nontemporal_store(xb + g1[q] * (y0b + y1b), (f32x4*)(o + 4)); }
    }
}

constexpr int N_PHASES = 11;
struct Args { const float* in[21]; float* out; unsigned char* ws; int ph_lo, ph_hi; };
__global__ void __launch_bounds__(NTHREADS, 2) mega_fwd(Args args) {
    extern __shared__ __attribute__((aligned(16))) unsigned char lds_raw[];
    Frame F;
    F.lds = (LAS unsigned char*)lds_raw;
    F.tid = threadIdx.x; F.lane = F.tid & 63; F.wave = __builtin_amdgcn_readfirstlane(F.tid >> 6); F.G = gridDim.x; F.skip = 0;
    F.x = args.in[0]; F.c = args.in[1]; F.w_ada = args.in[2]; F.b_ada = args.in[3]; F.g1 = args.in[4]; F.g2 = args.in[5]; F.w_in = args.in[6]; F.g_q = args.in[7]; F.g_k = args.in[8];
    F.conv_w = args.in[9]; F.conv_b = args.in[10]; F.w_pa = args.in[11]; F.w_pb = args.in[12]; F.w_o = args.in[13]; F.w_rg = args.in[14]; F.b_rg = args.in[15]; F.w_re = args.in[16]; F.b_re = args.in[17];
    F.w1 = args.in[18]; F.w3 = args.in[19]; F.w2 = args.in[20]; F.out = args.out; F.ws = args.ws;
    volatile LAS unsigned* MISC = (volatile LAS unsigned*)(F.lds + MISC_OFF);
    if (F.tid < 64) MISC[F.tid] = 0u;
    __syncthreads();
    XcdBarrier bar = xcd_barrier_post((unsigned*)(F.ws + WS_CTL) + CW_BAR, MISC + 8);
    const int lo = args.ph_lo, hi = args.ph_hi;
    unsigned long long pst0 = 0, pst1 = 0;
#define PHASE(k, body) if (lo <= (k) && (k) < hi) { if (PROBE_PHASE == (k)) pst0 = __builtin_amdgcn_s_memrealtime(); for (int rep_ = 0; rep_ < 1 + ((REPEAT_MASK >> (k)) & 1); ++rep_) { { int t_ = threadIdx.x; asm volatile("" : "+v"(t_)); F.tid = t_; F.lane = t_ & 63; } body; __syncthreads(); } if ((NOEPI_MASK >> (k)) & 1) { int s_ = 1; asm volatile("" : "+s"(s_)); F.skip = s_; { int t_ = threadIdx.x; asm volatile("" : "+v"(t_)); F.tid = t_; F.lane = t_ & 63; } body; __syncthreads(); F.skip = 0; } if ((k) + 1 < hi) xcd_barrier(bar); if (PROBE_PHASE == (k)) pst1 = __builtin_amdgcn_s_memrealtime(); }
    PHASE(0, s0_prologue(F); wait_mod(F); s1_norm1(F))
    PHASE(2, s2_fast(F))
    PHASE(3, s3_fast(F, (char*)lds_raw))
    PHASE(4, s4_fast(F))
    PHASE(5, s5_fast(F))
    PHASE(6, s6_router(F))
    PHASE(8, s8_fast(F))
    PHASE(9, s9_fast(F))
    PHASE(10, s10_combine(F))
#undef PHASE
    if (PROBE_PHASE >= 0 && blockIdx.x == 0) { const unsigned long long t0 = __builtin_amdgcn_s_memrealtime(), dt = pst1 - pst0; while (__builtin_amdgcn_s_memrealtime() - t0 < dt) __builtin_amdgcn_s_sleep(8); }
}

extern "C" void kernel_launch(void* const* d_in, const int* in_sizes, int n_in, void* d_out, int out_size, void* d_ws, size_t ws_size, hipStream_t stream) {
    static int grid = 0;
    if (grid == 0) {
        if (n_in != 21 || in_sizes[0] != T * D || out_size != T * D || ws_size < WS_END) { fprintf(stderr, "kernel_launch: unexpected shapes (n_in %d, in0 %d, out %d, ws %zu); nothing launched\n", n_in, n_in > 0 ? in_sizes[0] : -1, out_size, ws_size); grid = -1; return; }
        int dev = 0, cus = 0, per_cu = 0;
        if (hipGetDevice(&dev) != hipSuccess || hipDeviceGetAttribute(&cus, hipDeviceAttributeMultiprocessorCount, dev) != hipSuccess) { grid = -1; return; }
        if (hipFuncSetAttribute((const void*)mega_fwd, hipFuncAttributeMaxDynamicSharedMemorySize, LDS_BYTES) != hipSuccess) { fprintf(stderr, "kernel_launch: hipFuncSetAttribute failed\n"); grid = -1; return; }
        if (hipOccupancyMaxActiveBlocksPerMultiprocessor(&per_cu, (const void*)mega_fwd, NTHREADS, LDS_BYTES) != hipSuccess || per_cu < 1) { fprintf(stderr, "kernel_launch: occupancy query says %d blocks per CU\n", per_cu); per_cu = 1; }
        (void)hipGetLastError();
        if (cus < 256) { fprintf(stderr, "kernel_launch: built for a 256-CU device, found %d CUs; nothing launched\n", cus); grid = -1; return; }
        grid = 256;
    }
    if (grid < 0) return;
    (void)hipMemsetAsync((char*)d_ws + WS_CTL, 0, CTL_ZERO_BYTES, stream);
    Args a{};
    for (int i = 0; i < 21; ++i) a.in[i] = (const float*)d_in[i];
    a.out = (float*)d_out; a.ws = (unsigned char*)d_ws; a.ph_lo = 0; a.ph_hi = N_PHASES;
    hipLaunchKernelGGL(mega_fwd, dim3(grid), dim3(NTHREADS), LDS_BYTES, stream, a);
}
```

```cpp
#include <hip/hip_runtime.h>
#include <hip/hip_bf16.h>
#include <cstdio>
#include <cstdint>

#ifndef REPEAT_MASK
#define REPEAT_MASK 0
#define NOEPI_MASK 0
#endif
#ifndef PROBE_PHASE
#define PROBE_PHASE -1
#endif
#define GAS __attribute__((address_space(1)))
#define LAS __attribute__((address_space(3)))
typedef unsigned short bf16_t;
typedef short bf16x8 __attribute__((ext_vector_type(8)));
typedef float f32x4 __attribute__((ext_vector_type(4)));
typedef unsigned u32x4 __attribute__((ext_vector_type(4)));
typedef unsigned u32x2 __attribute__((ext_vector_type(2)));

constexpr int T = 32768, D = 1024, NB = 8, S = 4096, NH = 8, DH = 64, NIN = 5120, NE = 32, DE = 512, NMOD = 6144;
constexpr int NTHREADS = 512, NWAVES = 8;
constexpr float EPS = 1e-6f;
constexpr float C2 = 0.125f * 1.4426950408889634f;
constexpr int MAX_MT = 288;
constexpr int NPAD = MAX_MT * 256;

constexpr size_t MiB = 1u << 20, KiB = 1024;
constexpr size_t WS_CTL = 0, CTL_ZERO_BYTES = 64 * KiB;
constexpr size_t WS_MOD = 1 * MiB;
constexpr size_t WS_ROPE = 1 * MiB + 256 * KiB;
constexpr size_t WS_KMEAN = 1 * MiB + 512 * KiB;
constexpr size_t WS_EID = 2 * MiB;
constexpr size_t WS_EW = 2 * MiB + 256 * KiB;
constexpr size_t WS_BCNT = 2 * MiB + 512 * KiB;
constexpr size_t WS_TILEE = 2 * MiB + 768 * KiB;
constexpr size_t WS_ATOK = 3 * MiB;
constexpr size_t WS_AINFO = 3 * MiB + 512 * KiB;
constexpr size_t WS_AW = 4 * MiB;
constexpr size_t WS_W36T = 5 * MiB;
constexpr size_t WS_WIN_T = 8 * MiB;
constexpr size_t WS_WIN8 = 14 * MiB;
constexpr size_t WS_H8 = 56 * MiB;
constexpr size_t WS_WP_T = 18 * MiB;
constexpr size_t WS_WO_T = 20 * MiB;
constexpr size_t WS_W13_T = 24 * MiB;
constexpr size_t WS_W2_T = 88 * MiB;
constexpr size_t WS_H = 120 * MiB;
constexpr size_t WS_YAB = 184 * MiB;
constexpr size_t WS_K = 248 * MiB;
constexpr size_t WS_V = 280 * MiB;
constexpr size_t WS_U = 312 * MiB;
constexpr size_t WS_BG = 344 * MiB;
constexpr size_t WS_GATES = 376 * MiB;
constexpr size_t WS_X1 = 184 * MiB;
constexpr size_t WS_H2 = 120 * MiB;
constexpr size_t WS_HID = 248 * MiB;
constexpr size_t WS_YSLOT = 320 * MiB;
constexpr size_t WS_LINFO = 448 * MiB;
constexpr size_t WS_LW = 456 * MiB;
constexpr size_t WS_END = 504 * MiB;
constexpr int CW_BAR = 4096, CW_MODCNT = 8192, CW_GCNT = 12288;

constexpr int LDS_BYTES = 159744;
constexpr int MISC_OFF = 147456;

__device__ __forceinline__ unsigned f2bf(float f) { unsigned u = __builtin_bit_cast(unsigned, f); return (u + 0x7fffu + ((u >> 16) & 1u)) >> 16; }
__device__ __forceinline__ float bf2f(unsigned h) { return __builtin_bit_cast(float, h << 16); }
typedef float f32x2_h __attribute__((ext_vector_type(2)));
typedef __bf16 bf16x2_h __attribute__((ext_vector_type(2)));
__device__ __forceinline__ unsigned pk2(float lo, float hi) { const f32x2_h v = {lo, hi}; return __builtin_bit_cast(unsigned, __builtin_convertvector(v, bf16x2_h)); }
__device__ __forceinline__ void unpack8(const u32x4 w, float (&v)[8]) {
    v[0] = bf2f(w.x & 0xffffu); v[1] = bf2f(w.x >> 16); v[2] = bf2f(w.y & 0xffffu); v[3] = bf2f(w.y >> 16);
    v[4] = bf2f(w.z & 0xffffu); v[5] = bf2f(w.z >> 16); v[6] = bf2f(w.w & 0xffffu); v[7] = bf2f(w.w >> 16);
}
__device__ __forceinline__ u32x4 pack8(const float (&v)[8]) { u32x4 w; w.x = pk2(v[0], v[1]); w.y = pk2(v[2], v[3]); w.z = pk2(v[4], v[5]); w.w = pk2(v[6], v[7]); return w; }
__device__ __forceinline__ u32x4 pack8v(const f32x4 a, const f32x4 b) { u32x4 w; w.x = pk2(a.x, a.y); w.y = pk2(a.z, a.w); w.z = pk2(b.x, b.y); w.w = pk2(b.z, b.w); return w; }
__device__ __forceinline__ void unpack8v(const u32x4 w, f32x4& a, f32x4& b) {
    a.x = bf2f(w.x & 0xffffu); a.y = bf2f(w.x >> 16); a.z = bf2f(w.y & 0xffffu); a.w = bf2f(w.y >> 16);
    b.x = bf2f(w.z & 0xffffu); b.y = bf2f(w.z >> 16); b.z = bf2f(w.w & 0xffffu); b.w = bf2f(w.w >> 16); }
#ifndef WT_STORES
#define WT_STORES 0
#define NT_STORES 1
#endif
__device__ __forceinline__ void st16(void* p, const u32x4 v) {
#if WT_STORES
    asm volatile("global_store_dwordx4 %0, %1, off sc1\n\ts_nop 1" :: "v"(p), "v"(v) : "memory");
#elif NT_STORES
    __builtin_nontemporal_store(v, (u32x4*)p);
#else
    *(u32x4*)p = v;
#endif
}
typedef int i32x8 __attribute__((ext_vector_type(8)));
__device__ __forceinline__ u32x2 pack8_fp8(const f32x4 a, const f32x4 b) {
    int lo = 0, hi = 0;
    lo = __builtin_amdgcn_cvt_pk_fp8_f32(a.x, a.y, lo, false); lo = __builtin_amdgcn_cvt_pk_fp8_f32(a.z, a.w, lo, true);
    hi = __builtin_amdgcn_cvt_pk_fp8_f32(b.x, b.y, hi, false); hi = __builtin_amdgcn_cvt_pk_fp8_f32(b.z, b.w, hi, true);
    return (u32x2){(unsigned)lo, (unsigned)hi};
}
constexpr float W8_SCALE = 64.f;
#define LDS_WAIT() asm volatile("s_waitcnt lgkmcnt(0)" ::: "memory")
__device__ __forceinline__ int lds_add(LAS int* p, int v) { return __hip_atomic_fetch_add(p, v, __ATOMIC_RELAXED, __HIP_MEMORY_SCOPE_WORKGROUP); }

#define XB_TMO      128
#define XB_XCNT(j)  (256  + 64 * (j))
#define XB_XSUB(j)  (1280 + 64 * (j))
#define XB_XGEN(j)  (2304 + 64 * (j))
#define XB_TOP      3328
#define XB_TOPGEN   3392
#define XCD_BAR_WORDS 3456
#define XB_SPIN_CAP (1u << 22)
__device__ __forceinline__ unsigned xb_ld(unsigned* p)              { return __hip_atomic_load(p, __ATOMIC_RELAXED, __HIP_MEMORY_SCOPE_AGENT); }
__device__ __forceinline__ unsigned xb_add(unsigned* p, unsigned v) { return __hip_atomic_fetch_add(p, v, __ATOMIC_RELAXED, __HIP_MEMORY_SCOPE_AGENT); }
__device__ __forceinline__ unsigned xb_xcc_id() { return (unsigned)__builtin_amdgcn_s_getreg((3 << 11) | 20) & 0xFu; }
#define XB_SPIN(cond, bar) do { unsigned _sp = 0; while (cond) { __builtin_amdgcn_s_sleep(1); \
    if ((++_sp & 255u) == 0u) { if (xb_ld(&(bar)[XB_TMO])) break; if (_sp > XB_SPIN_CAP) { atomicAdd(&(bar)[XB_TMO], 1u); break; } } } } while (0)
struct XcdBarrier { unsigned* bar; unsigned x; volatile LAS unsigned* st; };
__device__ __forceinline__ XcdBarrier xcd_barrier_post(unsigned* bar, volatile LAS unsigned* st) {
    XcdBarrier b; b.bar = bar; b.x = xb_xcc_id(); b.st = st;
    if (threadIdx.x == 0) (void)xb_add(&bar[XB_XCNT(b.x)], 1u);
    return b;
}
__device__ __forceinline__ void xcd_barrier_complete(unsigned* bar, unsigned x, unsigned& nloc, unsigned& nx) {
    const unsigned G = gridDim.x * gridDim.y * gridDim.z;
    unsigned sum, cnt, mine, sp = 0u;
    for (;;) {
        sum = 0u; cnt = 0u; mine = 0u;
#pragma unroll
        for (unsigned j = 0; j < 16; ++j) { const unsigned c = xb_ld(&bar[XB_XCNT(j)]); sum += c; cnt += (c > 0u) ? 1u : 0u; mine = (j == x) ? c : mine; }
        if (sum == G) break;
        __builtin_amdgcn_s_sleep(1);
        if ((++sp & 255u) == 0u) { if (xb_ld(&bar[XB_TMO])) break; if (sp > XB_SPIN_CAP) { atomicAdd(&bar[XB_TMO], 1u); break; } }
    }
    nloc = mine > 0u ? mine : 1u; nx = cnt > 0u ? cnt : 1u;
}
__device__ __forceinline__ void xcd_barrier(const XcdBarrier& b) {
    asm volatile("s_waitcnt vmcnt(0)" ::: "memory");
    __syncthreads();
    if (threadIdx.x == 0) {
        unsigned* bar = b.bar;
        __builtin_amdgcn_s_waitcnt(0);
        unsigned nloc = b.st[0], nx = b.st[1];
        if (nloc == 0u) { xcd_barrier_complete(bar, b.x, nloc, nx); b.st[0] = nloc; b.st[1] = nx; }
        const unsigned old = xb_add(&bar[XB_XSUB(b.x)], 1u);
        const unsigned gen = old / nloc;
        if (old + 1u == (gen + 1u) * nloc) {
            __builtin_amdgcn_fence(__ATOMIC_RELEASE, "agent");
            asm volatile("s_waitcnt vmcnt(0)" ::: "memory");
            const unsigned og = xb_add(&bar[XB_TOP], 1u);
            const unsigned tg = og / nx;
            if (og + 1u == (tg + 1u) * nx) xb_add(&bar[XB_TOPGEN], 1u);
            else XB_SPIN(xb_ld(&bar[XB_TOPGEN]) == tg, bar);
            __builtin_amdgcn_fence(__ATOMIC_ACQUIRE, "agent");
            xb_add(&bar[XB_XGEN(b.x)], 1u);
            asm volatile("s_waitcnt vmcnt(0)" ::: "memory");
        } else {
            XB_SPIN(xb_ld(&bar[XB_XGEN(b.x)]) == gen, bar);
            __builtin_amdgcn_fence(__ATOMIC_ACQUIRE, "agent");
            asm volatile("s_waitcnt vmcnt(0)" ::: "memory");
        }
    }
    __syncthreads();
}

struct Frame {
    LAS unsigned char* lds;
    int tid, lane, wave, G, skip;
    const float *x, *c, *w_ada, *b_ada, *g1, *g2, *w_in, *g_q, *g_k, *conv_w, *conv_b, *w_pa, *w_pb, *w_o, *w_rg, *b_rg, *w_re, *b_re, *w1, *w3, *w2;
    float* out; unsigned char* ws;
};
#define WSP(type, off) ((type*)(F.ws + (off)))

struct XItem { const float* src; unsigned char* dst; int N, pitch, fp8, swz; };
__device__ __forceinline__ void xitem_load(const XItem& it, f32x4 (&v)[8], int lane) {
    const int r8 = lane >> 3, c4 = lane & 7;
#pragma unroll
    for (int i = 0; i < 8; ++i) v[i] = __builtin_nontemporal_load((const f32x4*)(it.src + (size_t)(8 * i + r8) * it.N + 4 * c4));
}
__device__ __forceinline__ void xitem_store(const XItem& it, const f32x4 (&v)[8], LAS float* scr, int lane) {
    const int r8 = lane >> 3, c4 = lane & 7; const float scale = it.fp8 ? W8_SCALE : 1.f;
#pragma unroll
    for (int i = 0; i < 8; ++i) { LAS float* p = scr + (8 * i + r8) * 33 + 4 * c4; p[0] = v[i].x * scale; p[1] = v[i].y * scale; p[2] = v[i].z * scale; p[3] = v[i].w * scale; }
    LDS_WAIT(); asm volatile("" ::: "memory");
    if (it.fp8) {
        const int n = lane >> 1, kh = lane & 1; const LAS float* sp = scr + (32 * kh) * 33 + n;
#pragma unroll
        for (int p = 0; p < 2; ++p) { u32x4 o;
#pragma unroll
            for (int w = 0; w < 4; ++w) { const LAS float* q = sp + (16 * p + 4 * w) * 33; int x = 0;
                x = __builtin_amdgcn_cvt_pk_fp8_f32(q[0], q[33], x, false); x = __builtin_amdgcn_cvt_pk_fp8_f32(q[66], q[99], x, true); o[w] = (unsigned)x; }
            *(u32x4*)(it.dst + (size_t)n * it.pitch + 32 * kh + 16 * p) = o; }
    } else {
        const int c = lane & 7;
#pragma unroll
        for (int j = 0; j < 4; ++j) { const int n = (lane >> 3) + 8 * j; const LAS float* q = scr + (8 * c) * 33 + n;
            u32x4 o; o.x = pk2(q[0 * 33], q[1 * 33]); o.y = pk2(q[2 * 33], q[3 * 33]); o.z = pk2(q[4 * 33], q[5 * 33]); o.w = pk2(q[6 * 33], q[7 * 33]);
            const int nd = (it.swz && ((n >> 2) == 1 || (n >> 2) == 2)) ? (n ^ 12) : n;
            *(u32x4*)(it.dst + ((size_t)nd * it.pitch + 8 * c) * 2) = o; }
    }
    LDS_WAIT(); asm volatile("" ::: "memory");
}
__device__ __forceinline__ int win_dest_row(int sc) {
    if (sc < 32) { const int isk = sc >> 4, s2 = sc & 15, hh = s2 >> 1, bj = s2 & 1; return 512 * isk + 256 * (hh >> 2) + 128 * bj + 32 * (hh & 3); }
    if (sc < 48) return 0;
    if (sc < 64) { const int cx = 32 * (sc - 48); return 256 * (4 + (cx >> 7)) + (cx & 127); }
    if (sc < 80) return 2048 + 32 * (sc - 64);
    if (sc < 96) { const int cx = 32 * (sc - 80); return 256 * (4 + (cx >> 7)) + 128 + (cx & 127); }
    return 3072 + 32 * (sc - 96);
}
constexpr int X_NONEXP = 16 * 160 + 2 * (8 * 32) + 16 * 32, X_W2 = X_NONEXP + NE * 512, X_END = X_W2 + NE * 256;
__device__ __forceinline__ void convert_items(Frame& F, const int item_lo, const int item_hi, const int gw, const int NGW) {
    LAS float* scr = (LAS float*)(F.lds + F.wave * 16384);
    constexpr int I_IN = 16 * 160, I_PA = 8 * 32, I_O = 16 * 32, I_E1 = 16 * 16, I_E2 = 8 * 32;
    constexpr int NITEMS = I_IN + 2 * I_PA + I_O + NE * (2 * I_E1 + I_E2);
    auto decode = [&](int r) -> XItem {
        XItem x; x.swz = 0;
        if (r < I_IN) { const int kb = r / 160, sc = r % 160; x.src = F.w_in + (size_t)(64 * kb) * NIN + 32 * sc; x.N = NIN; x.pitch = 1024; x.swz = (sc < 32 && !(sc & 1)) ? 1 : 0;
            if (sc < 96 && !(sc >= 32 && sc < 48)) { x.fp8 = 0; x.dst = (unsigned char*)(WSP(bf16_t, WS_WIN_T) + (size_t)win_dest_row(sc) * 1024 + 64 * kb); }
            else { x.fp8 = 1; const int g = 32 * (sc - 96), cx = g & 1023;
                x.dst = WSP(unsigned char, WS_WIN8) + (size_t)(sc >= 96 ? 256 * (cx >> 7) + (g >= 1024 ? 128 : 0) + (cx & 127) : 2048 + 32 * (sc - 32)) * 1024 + 64 * kb; }
            return x; } r -= I_IN;
        if (r < I_PA) { const int kb = r / 32, sc = r % 32; x.src = F.w_pa + (size_t)(64 * kb) * 1024 + 32 * sc; x.N = 1024; x.pitch = 1024; x.fp8 = 0; x.dst = (unsigned char*)(WSP(bf16_t, WS_WP_T) + (size_t)(32 * sc) * 1024 + 64 * kb); return x; } r -= I_PA;
        if (r < I_PA) { const int kb = r / 32, sc = r % 32; x.src = F.w_pb + (size_t)(64 * kb) * 1024 + 32 * sc; x.N = 1024; x.pitch = 1024; x.fp8 = 0; x.dst = (unsigned char*)(WSP(bf16_t, WS_WP_T) + (size_t)(32 * sc) * 1024 + 512 + 64 * kb); return x; } r -= I_PA;
        if (r < I_O) { const int kb = r / 32, sc = r % 32; x.src = F.w_o + (size_t)(64 * kb) * 1024 + 32 * sc; x.N = 1024; x.pitch = 1024; x.fp8 = 0; x.dst = (unsigned char*)(WSP(bf16_t, WS_WO_T) + (size_t)(32 * sc) * 1024 + 64 * kb); return x; } r -= I_O;
        x.fp8 = 1;
        if (r < NE * 2 * I_E1) { const int e = r / (2 * I_E1); r -= e * (2 * I_E1); const int is3 = r >= I_E1; if (is3) r -= I_E1; const int kb = r / 16, sc = r % 16;
            x.src = (is3 ? F.w3 : F.w1) + (size_t)e * D * DE + (size_t)(64 * kb) * DE + 32 * sc; x.N = DE; x.pitch = 1024;
            x.dst = WSP(unsigned char, WS_W13_T) + ((size_t)e * 1024 + 256 * (sc >> 2) + 128 * is3 + 32 * (sc & 3)) * 1024 + 64 * kb; return x; }
        r -= NE * 2 * I_E1;
        { const int e = r / I_E2; r -= e * I_E2; const int kb = r / 32, sc = r % 32;
            x.src = F.w2 + (size_t)e * DE * D + (size_t)(64 * kb) * D + 32 * sc; x.N = D; x.pitch = 512; x.dst = WSP(unsigned char, WS_W2_T) + ((size_t)e * 1024 + 32 * sc) * 512 + 64 * kb; }
        return x;
    };
    const int ihi = (item_hi < NITEMS) ? item_hi : NITEMS;
    if (item_lo + gw < ihi) {
        XItem cur = decode(item_lo + gw); f32x4 va[8], vb[8]; xitem_load(cur, va, F.lane);
        for (int it = item_lo + gw; it < ihi; it += 2 * NGW) {
            const int n1 = it + NGW, n2 = it + 2 * NGW; XItem nx1 = cur, nx2 = cur;
            if (n1 < ihi) { nx1 = decode(n1); xitem_load(nx1, vb, F.lane); }
            xitem_store(cur, va, scr, F.lane);
            if (n1 < ihi) { if (n2 < ihi) { nx2 = decode(n2); xitem_load(nx2, va, F.lane); }
                xitem_store(nx1, vb, scr, F.lane); cur = nx2; }
        }
    }
}

__device__ __forceinline__ void s0_prologue(Frame& F) {
    if (F.tid < 256) WSP(float, WS_KMEAN)[blockIdx.x * 256 + F.tid] = 0.f;
    if (F.tid < 144) { const int gt = blockIdx.x * 144 + F.tid; const int jj = gt >> 10, k = gt & 1023; WSP(float, WS_W36T)[gt] = (jj < 4) ? F.w_rg[k * 4 + jj] : F.w_re[k * 32 + (jj - 4)]; }
    if (F.tid < 128) { const int gt = blockIdx.x * 128 + F.tid; const int pos = gt >> 3, i = gt & 7; const float inv = powf(500000.0f, -(float)(2 * i) / 16.0f); const float ang = (float)pos * inv;
        WSP(float2, WS_ROPE)[gt] = make_float2(cosf(ang), sinf(ang)); }
    if (blockIdx.x < 192) {
        LAS float* sc = (LAS float*)F.lds;
        for (int i = F.tid; i < NB * D; i += NTHREADS) { const float v = F.c[i]; sc[i] = v / (1.f + expf(-v)); }
        __syncthreads();
        const int j0 = blockIdx.x * 32, col = j0 + (F.lane & 31), kpar = F.lane >> 5;
        float acc[8];
#pragma unroll
        for (int b = 0; b < 8; ++b) acc[b] = 0.f;
#pragma unroll
        for (int i0 = 0; i0 < 64; i0 += 32) { float wv[32];
#pragma unroll
            for (int i = 0; i < 32; ++i) wv[i] = F.w_ada[(size_t)(F.wave * 128 + 2 * (i0 + i) + kpar) * NMOD + col];
#pragma unroll
            for (int i = 0; i < 32; ++i) { const int k = F.wave * 128 + 2 * (i0 + i) + kpar;
#pragma unroll
                for (int b = 0; b < 8; ++b) acc[b] += sc[b * D + k] * wv[i]; } }
#pragma unroll
        for (int b = 0; b < 8; ++b) acc[b] += __shfl_xor(acc[b], 32);
        LAS float* red = (LAS float*)(F.lds + 32768);
        if (F.lane < 32) {
#pragma unroll
            for (int b = 0; b < 8; ++b) red[(F.wave * 8 + b) * 32 + F.lane] = acc[b]; }
        __syncthreads();
        if (F.tid < 256) { const int b = F.tid >> 5, cc = F.tid & 31; float s = F.b_ada[j0 + cc];
#pragma unroll
            for (int w = 0; w < 8; ++w) s += red[(w * 8 + b) * 32 + cc];
            WSP(float, WS_MOD)[b * NMOD + j0 + cc] = s; }
        asm volatile("s_waitcnt vmcnt(0)" ::: "memory");
        __syncthreads();
        if (F.tid == 0) { __builtin_amdgcn_fence(__ATOMIC_RELEASE, "agent"); asm volatile("s_waitcnt vmcnt(0)" ::: "memory");
            __hip_atomic_fetch_add(WSP(unsigned, WS_CTL) + CW_MODCNT, 1u, __ATOMIC_RELAXED, __HIP_MEMORY_SCOPE_AGENT); }
    }
    convert_items(F, 0, X_NONEXP, F.G * NWAVES - 1 - (blockIdx.x * NWAVES + F.wave), F.G * NWAVES);
}

__device__ __forceinline__ void wait_mod(Frame& F) {
    if (F.tid == 0) { unsigned* c = WSP(unsigned, WS_CTL) + CW_MODCNT; unsigned sp = 0;
        while (__hip_atomic_load(c, __ATOMIC_RELAXED, __HIP_MEMORY_SCOPE_AGENT) < 192u) { __builtin_amdgcn_s_sleep(2); if (++sp > (1u << 24)) break; }
        __builtin_amdgcn_fence(__ATOMIC_ACQUIRE, "agent"); asm volatile("s_waitcnt vmcnt(0)" ::: "memory"); }
    __syncthreads();
}
template <int N> __device__ __forceinline__ float dpp_ror(float v) { return __builtin_bit_cast(float, __builtin_amdgcn_update_dpp(0, __builtin_bit_cast(int, v), 0x120 + N, 0xF, 0xF, false)); }
__device__ __forceinline__ float xrow16_sum(float x) {
    float a = x, b = x;
    asm volatile("s_nop 1\n\tv_permlane16_swap_b32 %0, %1" : "+v"(a), "+v"(b));
    a += b; b = a;
    asm volatile("s_nop 1\n\tv_permlane32_swap_b32 %0, %1" : "+v"(a), "+v"(b));
    return a + b;
}
__device__ __forceinline__ float wave_sum(float v) {
#pragma unroll
    for (int o = 1; o < 64; o <<= 1) v += __shfl_xor(v, o);
    return v;
}
__device__ __forceinline__ void s1_norm1(Frame& F) {
    const int gw = blockIdx.x * NWAVES + F.wave;
    const int row0 = gw * 16, b = row0 / S;
    if (row0 >= T) return;
    const float* mod = WSP(float, WS_MOD) + (size_t)b * NMOD;
    f32x4 gs[4], sh[4];
#pragma unroll
    for (int j = 0; j < 4; ++j) { const int col = 4 * F.lane + 256 * j; const f32x4 g = *(const f32x4*)(F.g1 + col), s_ = *(const f32x4*)(mod + 1024 + col); gs[j] = g * (s_ + 1.0f); sh[j] = *(const f32x4*)(mod + col); }
    for (int r = 0; r < 16; r += 4) {
        f32x4 v[4][4]; float ss[4];
#pragma unroll
        for (int q = 0; q < 4; ++q) { const float* xr = F.x + (size_t)(row0 + r + q) * D;
#pragma unroll
            for (int j = 0; j < 4; ++j) v[q][j] = __builtin_nontemporal_load((const f32x4*)(xr + 4 * F.lane + 256 * j)); }
#pragma unroll
        for (int q = 0; q < 4; ++q) { ss[q] = 0.f;
#pragma unroll
            for (int j = 0; j < 4; ++j) ss[q] += (v[q][j].x * v[q][j].x + v[q][j].y * v[q][j].y) + (v[q][j].z * v[q][j].z + v[q][j].w * v[q][j].w); }
#pragma unroll
        for (int q = 0; q < 4; ++q) { const float rinv = rsqrtf(wave_sum(ss[q]) * (1.f / D) + EPS);
            bf16_t* o = WSP(bf16_t, WS_H) + (size_t)(row0 + r + q) * D;
#pragma unroll
            for (int j = 0; j < 4; ++j) { const f32x4 h = v[q][j] * rinv * gs[j] + sh[j]; u32x2 w; w.x = pk2(h.x, h.y); w.y = pk2(h.z, h.w); *(u32x2*)(o + 4 * F.lane + 256 * j) = w;
                int p8 = 0; p8 = __builtin_amdgcn_cvt_pk_fp8_f32(h.x, h.y, p8, false); p8 = __builtin_amdgcn_cvt_pk_fp8_f32(h.z, h.w, p8, true);
                *(int*)(WSP(unsigned char, WS_H8) + (size_t)(row0 + r + q) * D + 4 * F.lane + 256 * j) = p8; } }
    }
}

struct RowsLinear { const bf16_t* base; size_t pitch; __device__ __forceinline__ const bf16_t* operator()(int r) const { return base + (size_t)r * pitch; } };
template <class AR, class BR>
__device__ __forceinline__ void sgemm_tile(LAS float* tile, int K, const AR& arow, const BR& brow, int wave, int lane) {
    const int fr = lane & 15, fq = lane >> 4, rb = 16 * (wave & 3), cb = 32 * (wave >> 2);
    const bf16_t* ap = arow(rb + fr) + 8 * fq;
    const bf16_t* bp0 = brow(cb + fr) + 8 * fq;
    const bf16_t* bp1 = brow(cb + 16 + fr) + 8 * fq;
    f32x4 acc0 = {0.f, 0.f, 0.f, 0.f}, acc1 = {0.f, 0.f, 0.f, 0.f};
#pragma unroll 4
    for (int k = 0; k < K; k += 32) {
        const bf16x8 a = *(const bf16x8*)(ap + k), b0 = *(const bf16x8*)(bp0 + k), b1 = *(const bf16x8*)(bp1 + k);
        acc0 = __builtin_amdgcn_mfma_f32_16x16x32_bf16(a, b0, acc0, 0, 0, 0);
        acc1 = __builtin_amdgcn_mfma_f32_16x16x32_bf16(a, b1, acc1, 0, 0, 0);
    }
#pragma unroll
    for (int j = 0; j < 4; ++j) { tile[(rb + fq * 4 + j) * 65 + cb + fr] = acc0[j]; tile[(rb + fq * 4 + j) * 65 + cb + 16 + fr] = acc1[j]; }
}

struct WinRowsHead { const bf16_t* base; int rb; __device__ __forceinline__ const bf16_t* operator()(int d) const { return base + (size_t)(rb + 128 * (d >> 5) + (d & 31)) * 1024; } };
__device__ __forceinline__ void s2_simple(Frame& F) {
    LAS float* tile = (LAS float*)F.lds; LAS float* tile2 = tile + 64 * 65;
    const bf16_t* H = WSP(bf16_t, WS_H); const bf16_t* WT = WSP(bf16_t, WS_WIN_T);
    const int row = F.tid >> 3, seg = F.tid & 7;
    for (int it = blockIdx.x; it < 512 * 72; it += F.G) {
        const int rt = it / 72, ct = it % 72, r0 = rt * 64, gr = r0 + row;
        const RowsLinear ar{H + (size_t)r0 * 1024, 1024};
        float v[8];
        if (ct < 16) {
            const int isk = ct >> 3, hh = ct & 7;
            const WinRowsHead br{WT, 512 * isk + 256 * (hh >> 2) + 32 * (hh & 3)};
            sgemm_tile(tile, 1024, ar, br, F.wave, F.lane); __syncthreads();
            float ss = 0.f;
#pragma unroll
            for (int e = 0; e < 8; ++e) { v[e] = tile[row * 65 + 8 * seg + e]; ss += v[e] * v[e]; }
            ss += __shfl_xor(ss, 1); ss += __shfl_xor(ss, 2); ss += __shfl_xor(ss, 4);
            const float rinv = rsqrtf(ss * (1.f / 64.f) + EPS);
            const float* g = isk ? F.g_k : F.g_q;
            const int pos = gr & (S - 1);
#pragma unroll
            for (int e = 0; e < 8; ++e) { v[e] = v[e] * rinv * g[8 * seg + e]; const float pv = __shfl_xor(v[e], 1);
                if (seg < 2) { const float2 cs = WSP(float2, WS_ROPE)[pos * 8 + e]; v[e] = (seg == 0) ? (v[e] * cs.x - pv * cs.y) : (v[e] * cs.x + pv * cs.y); } }
            if (!isk) {
#pragma unroll
                for (int e = 0; e < 8; ++e) v[e] *= C2;
                *(u32x4*)(WSP(bf16_t, WS_YAB) + (size_t)gr * 1024 + hh * 64 + 8 * seg) = pack8(v);
            } else {
                *(u32x4*)(WSP(bf16_t, WS_K) + (size_t)gr * 512 + hh * 64 + 8 * seg) = pack8(v);
#pragma unroll
                for (int e = 0; e < 8; ++e) tile[row * 65 + 8 * seg + e] = v[e];
                __syncthreads();
                if (F.tid < 64) { float s = 0.f; for (int r = 0; r < 64; ++r) s += tile[r * 65 + F.tid];
                    const int b = r0 / S, blk = (r0 & (S - 1)) >> 8;
                    atomicAdd(WSP(float, WS_KMEAN) + ((size_t)(b * NH + hh) * 16 + blk) * 64 + F.tid, s * (1.f / 256.f)); }
            }
        } else if (ct < 24) {
            const RowsLinear br{WT + (size_t)(1024 + 64 * (ct - 16)) * 1024, 1024};
            sgemm_tile(tile, 1024, ar, br, F.wave, F.lane); __syncthreads();
#pragma unroll
            for (int e = 0; e < 8; ++e) v[e] = tile[row * 65 + 8 * seg + e];
            *(u32x4*)(WSP(bf16_t, WS_V) + (size_t)gr * 512 + 64 * (ct - 16) + 8 * seg) = pack8(v);
        } else if (ct < 32) {
            const int cu = 64 * (ct - 24), rb = 256 * (6 + (cu >> 7)) + (cu & 127);
            const RowsLinear bx{WT + (size_t)rb * 1024, 1024}, bc{WT + (size_t)(rb + 128) * 1024, 1024};
            sgemm_tile(tile, 1024, ar, bx, F.wave, F.lane); sgemm_tile(tile2, 1024, ar, bc, F.wave, F.lane); __syncthreads();
#pragma unroll
            for (int e = 0; e < 8; ++e) v[e] = tile[row * 65 + 8 * seg + e] * tile2[row * 65 + 8 * seg + e];
            *(u32x4*)(WSP(bf16_t, WS_U) + (size_t)gr * 512 + cu + 8 * seg) = pack8(v);
        } else if (ct < 40) {
            const RowsLinear br{WT + (size_t)(2560 + 64 * (ct - 32)) * 1024, 1024};
            sgemm_tile(tile, 1024, ar, br, F.wave, F.lane); __syncthreads();
#pragma unroll
            for (int e = 0; e < 8; ++e) v[e] = tile[row * 65 + 8 * seg + e];
            *(u32x4*)(WSP(bf16_t, WS_BG) + (size_t)gr * 512 + 64 * (ct - 32) + 8 * seg) = pack8(v);
        } else {
            const RowsLinear br{WT + (size_t)(3072 + 64 * (ct - 40)) * 1024, 1024};
            sgemm_tile(tile, 1024, ar, br, F.wave, F.lane); __syncthreads();
#pragma unroll
            for (int e = 0; e < 8; ++e) v[e] = 1.f / (1.f + __expf(-tile[row * 65 + 8 * seg + e]));
            *(u32x4*)(WSP(bf16_t, WS_GATES) + (size_t)gr * 2048 + 64 * (ct - 40) + 8 * seg) = pack8(v);
        }
        __syncthreads();
    }
}

namespace pg8 {
constexpr int BM = 256, BK = 64, HALF = 128, HTB = HALF * BK * 2, STAGE_BYTES = 8 * HTB, NXCD = 8, WGM = 4;
constexpr int VN_STASH = 147456 + 4096;
__device__ __forceinline__ int lds_byte(int r, int c) { const int st = (r >> 4) * 2 + (c >> 5), rr = r & 15, cc = c & 31, ob = rr * 64 + cc * 2; return st * 1024 + (ob ^ (((ob >> 9) & 1) << 5)); }
__device__ __forceinline__ void stage_rc(int b, int& R, int& C) { const int st = b / 1024, sb = b % 1024, swz = sb ^ (((sb >> 9) & 1) << 5); R = (st >> 1) * 16 + swz / 64; C = (st & 1) * 32 + (swz % 64) / 2; }
__device__ __forceinline__ int perm32(int rho) { const int n = rho >> 4, i = rho & 15; return 8 * (i >> 2) + 4 * n + (i & 3); }
struct Unit { int pm, pn; const char* a; const char* b; int e, rbase; };
__device__ __forceinline__ bool static_unit(int i, int G, int c, int nM, int nN, int& pm, int& pn) {
    const int nwg = nM * nN; const long L = (long)i * G + c; if (L >= nwg) return false;
    int wgid = (int)L; { const int q = nwg / NXCD, r = nwg % NXCD, xcd = wgid % NXCD, off = wgid / NXCD; wgid = (xcd < r ? xcd * (q + 1) : r * (q + 1) + (xcd - r) * q) + off; }
    const int nig = WGM * nN, gid = wgid / nig, fm = gid * WGM, gsz = (nM - fm) < WGM ? (nM - fm) : WGM;
    pm = fm + ((wgid % nig) % gsz); pn = (wgid % nig) / gsz; return true;
}
struct DenseSched {
    static constexpr bool GATHER = false, FP8 = false;
    const char* A; const char* Bt; int nM, nN, K, G, c;
    __device__ __forceinline__ bool next(int i, Unit& u) const { if (!static_unit(i, G, c, nM, nN, u.pm, u.pn)) return false;
        u.a = A + (size_t)u.pm * BM * K * 2; u.b = Bt + (size_t)u.pn * BM * K * 2; u.e = 0; u.rbase = 0; return true; }
    __device__ __forceinline__ int row_index(const Unit&, int) const { return 0; }
};

struct DenseSched8 {
    static constexpr bool GATHER = false, FP8 = true;
    const char* A; const char* Bt; int nM, nN, K, G, c;
    __device__ __forceinline__ bool next(int i, Unit& u) const { if (!static_unit(i, G, c, nM, nN, u.pm, u.pn)) return false;
        u.a = A + (size_t)u.pm * BM * K; u.b = Bt + (size_t)u.pn * BM * K; u.e = 0; u.rbase = 0; return true; }
    __device__ __forceinline__ int row_index(const Unit&, int) const { return 0; }
};
template <class Epi, class Sched, bool skip = false>
__device__ __forceinline__ void gemm_phase(LAS unsigned char* lds, const int K, const Sched& S, const Epi& E) {
    int tid_ = threadIdx.x; asm volatile("" : "+v"(tid_));
    const int tid = tid_, wid = __builtin_amdgcn_readfirstlane(tid >> 6), lane = tid & 63, wr = wid >> 2, wc = wid & 3, fr = lane & 15, fq = lane >> 4;
    constexpr bool FP8 = Sched::FP8;
    const int nt = FP8 ? K / 128 : K / BK;
    const int PB = FP8 ? K : 2 * K;
    unsigned voffB[2], vA[2][2], vN[2][2];
#pragma unroll
    for (int i = 0; i < 2; ++i) { int R, C; stage_rc(tid * 16 + i * 8192, R, C); const int Rb = (R & ~31) + perm32(R & 31);
        voffB[i] = (unsigned)(Rb * PB + C * 2);
        vA[0][i] = (unsigned)(R * PB + C * 2); vA[1][i] = (unsigned)((HALF + R) * PB + C * 2); vN[0][i] = vA[0][i]; vN[1][i] = vA[1][i]; }
    const size_t kstep = (size_t)(BK * 2);
    const size_t hstep = (size_t)HALF * PB;
    const unsigned ldsw = (unsigned)wid * 1024u;
    const int aoff = lds_byte(wr * 64 + fr, fq * 8), boff = lds_byte(wc * 32 + fr, fq * 8);
    const int aoff8a = lds_byte(wr * 64 + fr, fq * 16), aoff8b = lds_byte(wr * 64 + fr, fq * 16 + 8), boff8a = lds_byte(wc * 32 + fr, fq * 16), boff8b = lds_byte(wc * 32 + fr, fq * 16 + 8);
#define PG8_SA(b, h) (((b) * 2 + (h)) * HTB)
#define PG8_SB(b, h) ((4 + (b) * 2 + (h)) * HTB)
#define PG8_STAGE(bufoff, gbase, voff) do { _Pragma("unroll") for (int _i = 0; _i < 2; ++_i) \
        __builtin_amdgcn_global_load_lds((const unsigned*)((const char*)(gbase) + (voff)[_i]), (LAS unsigned*)(lds + (bufoff) + ldsw + _i * 8192), 16, 0, 0); } while (0)
#define PG8_LD16(off) (*(const LAS u32x4*)(lds + (off)))
#define PG8_LDA(dst, b, h) do { _Pragma("unroll") for (int m = 0; m < 4; ++m) { if constexpr (FP8) { dst##8[m] = __builtin_bit_cast(i32x8, __builtin_shufflevector(PG8_LD16(PG8_SA(b, h) + aoff8a + m * 2048), PG8_LD16(PG8_SA(b, h) + aoff8b + m * 2048), 0, 1, 2, 3, 4, 5, 6, 7)); } \
        else { _Pragma("unroll") for (int k = 0; k < 2; ++k) dst[m][k] = *(const LAS bf16x8*)(lds + PG8_SA(b, h) + aoff + m * 2048 + k * 1024); } } } while (0)
#define PG8_LDB(dst, b, h) do { _Pragma("unroll") for (int n = 0; n < 2; ++n) { if constexpr (FP8) { dst##8[n] = __builtin_bit_cast(i32x8, __builtin_shufflevector(PG8_LD16(PG8_SB(b, h) + boff8a + n * 2048), PG8_LD16(PG8_SB(b, h) + boff8b + n * 2048), 0, 1, 2, 3, 4, 5, 6, 7)); } \
        else { _Pragma("unroll") for (int k = 0; k < 2; ++k) dst[n][k] = *(const LAS bf16x8*)(lds + PG8_SB(b, h) + boff + n * 2048 + k * 1024); } } } while (0)
#define PG8_MMA(ai, bj, At, Bt) do { __builtin_amdgcn_s_setprio(1); _Pragma("unroll") for (int m = 0; m < 4; ++m) _Pragma("unroll") for (int n = 0; n < 2; ++n) { \
        if constexpr (FP8) { asm volatile("s_nop 1\n\tv_mfma_scale_f32_16x16x128_f8f6f4 %0, %1, %2, %0, %3, %3 op_sel_hi:[0,0,0]" : "+v"(acc[ai][bj][m][n]) : "v"(Bt##8[n]), "v"(At##8[m]), "v"(sc127)); } \
        else { _Pragma("unroll") for (int k = 0; k < 2; ++k) acc[ai][bj][m][n] = __builtin_amdgcn_mfma_f32_16x16x32_bf16(Bt[n][k], At[m][k], acc[ai][bj][m][n], 0, 0, 0); } } __builtin_amdgcn_s_setprio(0); } while (0)
#define PG8_WAIT_V(n) asm volatile("s_waitcnt vmcnt(" #n ")" ::: "memory")
#define PG8_WAIT_L(n) asm volatile("s_waitcnt lgkmcnt(" #n ")" ::: "memory")
#define PG8_BAR __builtin_amdgcn_s_barrier()
#define PG8_SCHED __builtin_amdgcn_sched_barrier(0)
#define PG8_AOFF(dst, u) do { int _t = threadIdx.x; asm volatile("" : "+v"(_t)); _Pragma("unroll") for (int _i = 0; _i < 2; ++_i) { int _R, _C; stage_rc(_t * 16 + _i * 8192, _R, _C); \
        _Pragma("unroll") for (int _h = 0; _h < 2; ++_h) dst[_h][_i] = (unsigned)(S.row_index(u, _h * HALF + _R) * PB + _C * 2); } } while (0)
    Unit cur, nxt; int ui = 0;
    if (!S.next(0, cur)) return;
    if constexpr (Sched::GATHER) PG8_AOFF(vA, cur);
    f32x4 acc[2][2][4][2];
#pragma unroll
    for (int a = 0; a < 2; ++a)
#pragma unroll
        for (int b = 0; b < 2; ++b)
#pragma unroll
            for (int m = 0; m < 4; ++m)
#pragma unroll
                for (int n = 0; n < 2; ++n) acc[a][b][m][n] = (f32x4){0.f, 0.f, 0.f, 0.f};
    const int sc127 = 127;
    bf16x8 At[4][2], B0[2][2], B1[2][2]; i32x8 At8[4], B08[2], B18[2];
    const char* cA = cur.a; const char* cB = cur.b;
    PG8_STAGE(PG8_SB(0, 0), cB, voffB); PG8_STAGE(PG8_SB(0, 1), cB + hstep, voffB); PG8_STAGE(PG8_SA(0, 0), cA, vA[0]); PG8_STAGE(PG8_SA(0, 1), cA, vA[1]);
    if (wr == 1) PG8_BAR;
    PG8_WAIT_V(2); PG8_BAR;
    PG8_STAGE(PG8_SB(1, 0), cB + kstep, voffB); PG8_STAGE(PG8_SA(1, 0), cA + kstep, vA[0]); PG8_STAGE(PG8_SB(1, 1), cB + hstep + kstep, voffB);
    PG8_WAIT_V(6); PG8_BAR;
    for (;;) {
        const bool has_next = S.next(ui + 1, nxt);
        const char* nA = has_next ? nxt.a : cA; const char* nB = has_next ? nxt.b : cB;
        if constexpr (Sched::GATHER) { if (has_next) PG8_AOFF(vN, nxt); else {
#pragma unroll
            for (int h = 0; h < 2; ++h)
#pragma unroll
                for (int i = 0; i < 2; ++i) vN[h][i] = vA[h][i]; }
            *(LAS u32x4*)(lds + VN_STASH + tid * 16) = (u32x4){vN[0][0], vN[0][1], vN[1][0], vN[1][1]}; }
        for (int hk = 0; hk < (Epi::HAS_MID ? 2 : 1); ++hk) {
        if constexpr (Epi::HAS_MID) { if (hk == 1 && !skip) E.mid(acc, cur, wr, wc, fr, fq); }
        const int tb = (Epi::HAS_MID && hk == 1) ? nt / 2 : 0, te = (Epi::HAS_MID && hk == 0) ? nt / 2 : nt;
#pragma unroll 1
        for (int t = tb; t < te; t += 2) {
            const bool last = (t == nt - 2);
            const char* a1 = cA + (size_t)(t + 1) * kstep;
            const char* a2 = last ? nA : cA + (size_t)(t + 2) * kstep; const char* b2 = last ? nB : cB + (size_t)(t + 2) * kstep;
            const char* a3 = a2 + kstep; const char* b3 = b2 + kstep;
            unsigned w0[2], w1[2];
#pragma unroll
            for (int i = 0; i < 2; ++i) { w0[i] = vA[0][i]; w1[i] = vA[1][i]; }
            if constexpr (Sched::GATHER) { if (last) { const u32x4 q = *(const LAS u32x4*)(lds + VN_STASH + tid * 16); w0[0] = q.x; w0[1] = q.y; w1[0] = q.z; w1[1] = q.w; } }
            PG8_LDB(B0, 0, 0); PG8_LDB(B1, 0, 1); PG8_SCHED; PG8_LDA(At, 0, 0); PG8_STAGE(PG8_SA(1, 1), a1, vA[1]);
            PG8_WAIT_V(8); PG8_WAIT_L(0); PG8_BAR; PG8_MMA(0, 0, At, B0); PG8_MMA(0, 1, At, B1); PG8_BAR; PG8_SCHED;
            PG8_LDA(At, 0, 1); PG8_STAGE(PG8_SB(0, 0), b2, voffB); PG8_STAGE(PG8_SB(0, 1), b2 + hstep, voffB); PG8_STAGE(PG8_SA(0, 0), a2, w0);
            PG8_WAIT_V(8); PG8_WAIT_L(0); PG8_BAR; PG8_MMA(1, 0, At, B0); PG8_MMA(1, 1, At, B1); PG8_BAR; PG8_SCHED;
            PG8_LDB(B0, 1, 0); PG8_LDB(B1, 1, 1); PG8_SCHED; PG8_LDA(At, 1, 0); PG8_STAGE(PG8_SA(0, 1), a2, w1);
            PG8_WAIT_V(8); PG8_WAIT_L(0); PG8_BAR; PG8_MMA(0, 0, At, B0); PG8_MMA(0, 1, At, B1); PG8_BAR; PG8_SCHED;
            PG8_LDA(At, 1, 1); PG8_STAGE(PG8_SB(1, 0), b3, voffB); PG8_STAGE(PG8_SB(1, 1), b3 + hstep, voffB); PG8_STAGE(PG8_SA(1, 0), a3, w0);
            PG8_WAIT_V(8); PG8_WAIT_L(0); PG8_BAR; PG8_MMA(1, 0, At, B0); PG8_MMA(1, 1, At, B1); PG8_BAR; PG8_SCHED;
        }
        }
        if (wr == 0) PG8_BAR;
        if constexpr (FP8) asm volatile("s_nop 15\n\ts_nop 7" ::: "memory");
        if constexpr (!skip) E(acc, cur, wr, wc, fr, fq); else {
#pragma unroll
            for (int a = 0; a < 2; ++a)
#pragma unroll
                for (int b = 0; b < 2; ++b)
#pragma unroll
                    for (int m = 0; m < 4; ++m)
#pragma unroll
                        for (int n = 0; n < 2; ++n) asm volatile("" :: "v"(acc[a][b][m][n])); }
        if (!has_next) break;
#pragma unroll
        for (int a = 0; a < 2; ++a)
#pragma unroll
            for (int b = 0; b < 2; ++b)
#pragma unroll
                for (int m = 0; m < 4; ++m)
#pragma unroll
                    for (int n = 0; n < 2; ++n) acc[a][b][m][n] = (f32x4){0.f, 0.f, 0.f, 0.f};
        cur = nxt; cA = nA; cB = nB; ++ui;
        if constexpr (Sched::GATHER) { const u32x4 q = *(const LAS u32x4*)(lds + VN_STASH + tid * 16); vA[0][0] = q.x; vA[0][1] = q.y; vA[1][0] = q.z; vA[1][1] = q.w; }
        if (wr == 1) PG8_BAR;
    }
    PG8_WAIT_V(0);
    PG8_BAR;
#undef PG8_SA
#undef PG8_SB
#undef PG8_STAGE
#undef PG8_LDA
#undef PG8_LDB
#undef PG8_MMA
#undef PG8_LD16
#undef PG8_WAIT_V
#undef PG8_WAIT_L
#undef PG8_BAR
#undef PG8_SCHED
#undef PG8_AOFF
}
}

typedef f32x4 Acc[2][2][4][2];
struct EpiG1 {
    static constexpr bool HAS_MID = false;
    unsigned char* ws; const float* g_q; const float* g_k;
    __device__ __forceinline__ void mid(Acc&, const pg8::Unit&, int, int, int, int) const {}
    __device__ __forceinline__ void operator()(Acc& acc, const pg8::Unit& u, int wr, int wc, int fr, int fq) const {
        const int pn = u.pn, row0 = u.pm * 256 + wr * 64 + fr;
        if (pn < 4) {
            const int isk = pn >> 1, hh = 4 * (pn & 1) + wc;
            const float* g = isk ? g_k : g_q;
            f32x4 gv[2][2];
#pragma unroll
            for (int bj = 0; bj < 2; ++bj)
#pragma unroll
                for (int n = 0; n < 2; ++n) gv[bj][n] = *(const f32x4*)(g + ((bj == 0 && fq < 2) ? 8 * n + 4 * fq : 32 * bj + 8 * fq + 4 * n));
            f32x4 cs_[2][2];
#pragma unroll
            for (int bj = 0; bj < 2; ++bj)
#pragma unroll
                for (int n = 0; n < 2; ++n) cs_[bj][n] = (f32x4){0.f, 0.f, 0.f, 0.f};
            f32x4 rf;
#pragma unroll
            for (int e = 0; e < 4; ++e) { const float f0 = exp2f(-(float)e * (0.125f * 18.931568569324174f)) * 0.15915494309189535f, f1 = exp2f(-(float)(4 + e) * (0.125f * 18.931568569324174f)) * 0.15915494309189535f;
                rf[e] = fq == 0 ? f0 : (fq == 1 ? f1 : 0.f); }
            bf16_t* dst = isk ? (bf16_t*)(ws + WS_K) : (bf16_t*)(ws + WS_YAB);
            const int pitch = isk ? 512 : 1024;
            const float sc = isk ? 1.f : C2;
#pragma unroll
            for (int ai = 0; ai < 2; ++ai)
#pragma unroll
                for (int m = 0; m < 4; ++m) {
                    const int r = row0 + 128 * ai + 16 * m; const float pos = (float)(r & (S - 1));
                    f32x4 v[2][2]; float ss = 0.f;
#pragma unroll
                    for (int bj = 0; bj < 2; ++bj)
#pragma unroll
                        for (int n = 0; n < 2; ++n) { v[bj][n] = acc[ai][bj][m][n]; ss += (v[bj][n].x * v[bj][n].x + v[bj][n].y * v[bj][n].y) + (v[bj][n].z * v[bj][n].z + v[bj][n].w * v[bj][n].w); }
                    ss = xrow16_sum(ss);
                    const float rinv = rsqrtf(ss * (1.f / 64.f) + EPS);
#pragma unroll
                    for (int bj = 0; bj < 2; ++bj)
#pragma unroll
                        for (int n = 0; n < 2; ++n) v[bj][n] = v[bj][n] * rinv * gv[bj][n];
#pragma unroll
                    for (int e = 0; e < 4; ++e) { const float rev = __builtin_amdgcn_fractf(pos * rf[e]), c = __builtin_amdgcn_cosf(rev), sn = __builtin_amdgcn_sinf(rev);
                        const float x1 = v[0][0][e], x2 = v[0][1][e]; v[0][0][e] = x1 * c - x2 * sn; v[0][1][e] = x2 * c + x1 * sn; }
                    if (isk) {
#pragma unroll
                        for (int bj = 0; bj < 2; ++bj)
#pragma unroll
                            for (int n = 0; n < 2; ++n) cs_[bj][n] += v[bj][n];
                    }
#pragma unroll
                    for (int bj = 0; bj < 2; ++bj) st16(dst + (size_t)r * pitch + hh * 64 + 32 * bj + 8 * fq, pack8v(v[bj][0] * sc, v[bj][1] * sc));
                }
            if (isk) {
                const int b = u.pm >> 4, blk = u.pm & 15;
                float* km = (float*)(ws + WS_KMEAN) + ((size_t)(b * NH + hh) * 16 + blk) * 64;
#pragma unroll
                for (int bj = 0; bj < 2; ++bj)
#pragma unroll
                    for (int n = 0; n < 2; ++n)
#pragma unroll
                        for (int e = 0; e < 4; ++e) { float s = cs_[bj][n][e]; s += dpp_ror<8>(s); s += dpp_ror<4>(s); s += dpp_ror<2>(s); s += dpp_ror<1>(s);
                            if (fr == 0) atomicAdd(km + 32 * bj + 8 * fq + 4 * n + e, s * (1.f / 256.f)); }
            }
        } else if (pn < 8) {
            bf16_t* dst = (bf16_t*)(ws + WS_U);
#pragma unroll
            for (int ai = 0; ai < 2; ++ai)
#pragma unroll
                for (int m = 0; m < 4; ++m) { const int r = row0 + 128 * ai + 16 * m;
                    const f32x4 a = acc[ai][0][m][0] * acc[ai][1][m][0], b = acc[ai][0][m][1] * acc[ai][1][m][1]; u32x4 w;
                    w.x = pk2(a.x, a.y); w.y = pk2(a.z, a.w); w.z = pk2(b.x, b.y); w.w = pk2(b.z, b.w);
                    st16(dst + (size_t)r * 512 + 128 * (pn - 4) + 32 * wc + 8 * fq, w); }
        } else {
            bf16_t* dst = (bf16_t*)(ws + WS_BG); const int pitch = 512, c0 = 256 * (pn - 8); const bool sig = false;
#pragma unroll
            for (int ai = 0; ai < 2; ++ai)
#pragma unroll
                for (int m = 0; m < 4; ++m) { const int r = row0 + 128 * ai + 16 * m;
#pragma unroll
                    for (int bj = 0; bj < 2; ++bj) { f32x4 a = acc[ai][bj][m][0], b = acc[ai][bj][m][1];
                        if (sig) {
#pragma unroll
                            for (int e = 0; e < 4; ++e) { a[e] = __builtin_amdgcn_rcpf(1.f + __expf(-a[e])); b[e] = __builtin_amdgcn_rcpf(1.f + __expf(-b[e])); } }
                        u32x4 w; w.x = pk2(a.x, a.y); w.y = pk2(a.z, a.w); w.z = pk2(b.x, b.y); w.w = pk2(b.z, b.w);
                        st16(dst + (size_t)r * pitch + c0 + 128 * bj + 32 * wc + 8 * fq, w); } }
        }
    }
};
struct EpiGate {
    static constexpr bool HAS_MID = false;
    bf16_t* gates; bf16_t* vout;
    __device__ __forceinline__ void mid(Acc&, const pg8::Unit&, int, int, int, int) const {}
    __device__ __forceinline__ void operator()(Acc& acc, const pg8::Unit& u, int wr, int wc, int fr, int fq) const {
        int row0 = u.pm * 256 + wr * 64 + fr; const int c0 = u.pn * 256 + 32 * wc + 8 * fq; asm volatile("" : "+v"(row0));
#pragma unroll
        for (int ai = 0; ai < 2; ++ai)
#pragma unroll
            for (int m = 0; m < 4; ++m) { const size_t r = (size_t)(row0 + 128 * ai + 16 * m);
                if (u.pn < 8) {
                    f32x4 ra[2], gb[2];
#pragma unroll
                    for (int n = 0; n < 2; ++n)
#pragma unroll
                        for (int e = 0; e < 4; ++e) { const float ea = __expf(acc[ai][0][m][n][e] * (-1.f / W8_SCALE)), eb = __expf(acc[ai][1][m][n][e] * (-1.f / W8_SCALE));
                            gb[n][e] = __builtin_amdgcn_rcpf(1.f + eb); ra[n][e] = fminf((1.f + eb) * __builtin_amdgcn_rcpf(1.f + ea), 3e4f); }
                    const size_t gc = r * 2048 + 128 * u.pn + 32 * wc + 8 * fq;
                    st16(gates + gc, pack8v(ra[0], ra[1])); st16(gates + gc + 1024, pack8v(gb[0], gb[1]));
                } else {
#pragma unroll
                    for (int bj = 0; bj < 2; ++bj) st16(vout + r * 512 + (c0 - 2048) + 128 * bj, pack8v(acc[ai][bj][m][0] * (1.f / W8_SCALE), acc[ai][bj][m][1] * (1.f / W8_SCALE))); } }
    }
};
__device__ __forceinline__ void s2_fast(Frame& F) {
    {
        const pg8::DenseSched Sd{(const char*)(F.ws + WS_H), (const char*)(F.ws + WS_WIN_T), T / 256, 10, 1024, F.G, (int)blockIdx.x};
        const EpiG1 E{F.ws, F.g_q, F.g_k};
        if (F.skip) pg8::gemm_phase<EpiG1, pg8::DenseSched, true>(F.lds, 1024, Sd, E); else pg8::gemm_phase<EpiG1, pg8::DenseSched>(F.lds, 1024, Sd, E); }
    {
        const pg8::DenseSched8 Sd{(const char*)(F.ws + WS_H8), (const char*)(F.ws + WS_WIN8), T / 256, 10, 1024, F.G, (int)blockIdx.x};
        const EpiGate E{WSP(bf16_t, WS_GATES), WSP(bf16_t, WS_V)};
        int Kg = D; asm volatile("" : "+s"(Kg));
        if (F.skip) pg8::gemm_phase<EpiGate, pg8::DenseSched8, true>(F.lds, Kg, Sd, E); else pg8::gemm_phase<EpiGate, pg8::DenseSched8>(F.lds, Kg, Sd, E); }
}

constexpr float NEG_BIG = -1e30f;
__device__ __forceinline__ void s3_simple(Frame& F) {
    LAS float* tS = (LAS float*)F.lds;
    LAS bf16_t* Pb = (LAS bf16_t*)(F.lds + 16896);
    LAS bf16_t* Vt = (LAS bf16_t*)(F.lds + 16896 + 9216);
    LAS float* mrow = (LAS float*)(F.lds + 16896 + 18432);
    LAS float* lrow = mrow + 64; LAS float* arow_ = mrow + 128; LAS int* sel = (LAS int*)(mrow + 192); LAS int* um = sel + 64;
    bf16_t* YAB = WSP(bf16_t, WS_YAB); const bf16_t* Kb = WSP(bf16_t, WS_K); const bf16_t* Vb = WSP(bf16_t, WS_V);
    const float* kmean = WSP(float, WS_KMEAN);
    const int row = F.tid >> 3, seg = F.tid & 7, fr = F.lane & 15, fq = F.lane >> 4, rb = 16 * (F.wave & 3), cb = 32 * (F.wave >> 2);
    for (int it = blockIdx.x; it < NB * NH * 64; it += F.G) {
        const int qc = it & 63, h = (it >> 6) & 7, b = it >> 9, cur = qc >> 2, t0 = 64 * qc;
        const size_t tb = (size_t)b * S;
        if (F.tid < 64) {
            float q[64];
            const bf16_t* qp = YAB + (tb + t0 + F.tid) * 1024 + h * 64;
#pragma unroll
            for (int i = 0; i < 8; ++i) { float t8[8]; unpack8(*(const u32x4*)(qp + 8 * i), t8);
#pragma unroll
                for (int e = 0; e < 8; ++e) q[8 * i + e] = t8[e]; }
            float b0 = -INFINITY, b1 = -INFINITY, b2 = -INFINITY; int i0 = -1, i1 = -1, i2 = -1;
            for (int j = 0; j < cur; ++j) { const float* km = kmean + ((size_t)(b * NH + h) * 16 + j) * 64; float s = 0.f;
#pragma unroll
                for (int d = 0; d < 64; ++d) s += q[d] * km[d];
                if (s > b0) { b2 = b1; i2 = i1; b1 = b0; i1 = i0; b0 = s; i0 = j; } else if (s > b1) { b2 = b1; i2 = i1; b1 = s; i1 = j; } else if (s > b2) { b2 = s; i2 = j; } }
            int m = 0; if (i0 >= 0) m |= 1 << i0; if (i1 >= 0) m |= 1 << i1; if (i2 >= 0) m |= 1 << i2;
            sel[F.tid] = m; mrow[F.tid] = NEG_BIG; lrow[F.tid] = 0.f;
            int u = m;
#pragma unroll
            for (int o = 1; o < 64; o <<= 1) u |= __shfl_xor(u, o);
            if (F.tid == 0) um[0] = u;
        }
        __syncthreads();
        const int umask = um[0];
        f32x4 o0 = {0.f, 0.f, 0.f, 0.f}, o1 = {0.f, 0.f, 0.f, 0.f};
        const RowsLinear aq{YAB + (tb + t0) * 1024 + h * 64, 1024};
        for (int j = 0; j <= cur; ++j) {
            if (j < cur && !((umask >> j) & 1)) continue;
            const int nkt = (j == cur) ? ((qc & 3) + 1) : 4;
            for (int kt = 0; kt < nkt; ++kt) {
                const int kbase = 256 * j + 64 * kt;
                const RowsLinear bk{Kb + (tb + kbase) * 512 + h * 64, 512};
                sgemm_tile(tS, 64, aq, bk, F.wave, F.lane);
                { float vv[8]; unpack8(*(const u32x4*)(Vb + (tb + kbase + row) * 512 + h * 64 + 8 * seg), vv);
#pragma unroll
                    for (int e = 0; e < 8; ++e) Vt[(8 * seg + e) * 72 + row] = (bf16_t)f2bf(vv[e]); }
                __syncthreads();
                {
                    float s[8]; float mx = NEG_BIG;
                    const bool rowsel = (j == cur) || ((sel[row] >> j) & 1);
#pragma unroll
                    for (int e = 0; e < 8; ++e) { const int c = 8 * seg + e; float x = tS[row * 65 + c];
                        if (!rowsel || (j == cur && kbase + c > t0 + row)) x = NEG_BIG; s[e] = x; mx = fmaxf(mx, x); }
                    mx = fmaxf(mx, __shfl_xor(mx, 1)); mx = fmaxf(mx, __shfl_xor(mx, 2)); mx = fmaxf(mx, __shfl_xor(mx, 4));
                    const float mold = mrow[row], mnew = fmaxf(mold, mx);
                    float alpha = 1.f, ps = 0.f; float p[8];
                    if (mnew <= NEG_BIG) {
#pragma unroll
                        for (int e = 0; e < 8; ++e) p[e] = 0.f;
                    } else { alpha = exp2f(mold - mnew);
#pragma unroll
                        for (int e = 0; e < 8; ++e) { p[e] = (s[e] <= NEG_BIG) ? 0.f : exp2f(s[e] - mnew); ps += p[e]; } }
                    ps += __shfl_xor(ps, 1); ps += __shfl_xor(ps, 2); ps += __shfl_xor(ps, 4);
                    const float lold = lrow[row];
                    *(LAS u32x4*)(Pb + row * 72 + 8 * seg) = pack8(p);
                    if (seg == 0) { mrow[row] = mnew; lrow[row] = lold * alpha + ps; arow_[row] = alpha; }
                }
                __syncthreads();
                {
#pragma unroll
                    for (int r = 0; r < 4; ++r) { const float a = arow_[rb + fq * 4 + r]; o0[r] *= a; o1[r] *= a; }
#pragma unroll
                    for (int ks = 0; ks < 2; ++ks) {
                        const bf16x8 a = *(const LAS bf16x8*)(Pb + (rb + fr) * 72 + 32 * ks + 8 * fq);
                        const bf16x8 v0 = *(const LAS bf16x8*)(Vt + (cb + fr) * 72 + 32 * ks + 8 * fq);
                        const bf16x8 v1 = *(const LAS bf16x8*)(Vt + (cb + 16 + fr) * 72 + 32 * ks + 8 * fq);
                        o0 = __builtin_amdgcn_mfma_f32_16x16x32_bf16(a, v0, o0, 0, 0, 0);
                        o1 = __builtin_amdgcn_mfma_f32_16x16x32_bf16(a, v1, o1, 0, 0, 0);
                    }
                }
                __syncthreads();
            }
        }
#pragma unroll
        for (int r = 0; r < 4; ++r) { const float li = 1.f / lrow[rb + fq * 4 + r]; tS[(rb + fq * 4 + r) * 65 + cb + fr] = o0[r] * li; tS[(rb + fq * 4 + r) * 65 + cb + 16 + fr] = o1[r] * li; }
        __syncthreads();
        { float v[8];
#pragma unroll
            for (int e = 0; e < 8; ++e) v[e] = tS[row * 65 + 8 * seg + e];
            *(u32x4*)(YAB + (tb + t0 + row) * 1024 + h * 64 + 8 * seg) = pack8(v); }
        __syncthreads();
    }
    const bf16_t* U = WSP(bf16_t, WS_U); const bf16_t* BG = WSP(bf16_t, WS_BG);
    for (int i = blockIdx.x * NTHREADS + F.tid; i < T * 64; i += F.G * NTHREADS) {
        const int t = i >> 6, c0 = (i & 63) * 8, pos = t & (S - 1);
        float u0[8], u1[8], u2[8], bg[8], y[8];
        unpack8(*(const u32x4*)(U + (size_t)t * 512 + c0), u2); unpack8(*(const u32x4*)(BG + (size_t)t * 512 + c0), bg);
        if (pos >= 1) unpack8(*(const u32x4*)(U + (size_t)(t - 1) * 512 + c0), u1); else {
#pragma unroll
            for (int e = 0; e < 8; ++e) u1[e] = 0.f; }
        if (pos >= 2) unpack8(*(const u32x4*)(U + (size_t)(t - 2) * 512 + c0), u0); else {
#pragma unroll
            for (int e = 0; e < 8; ++e) u0[e] = 0.f; }
#pragma unroll
        for (int e = 0; e < 8; ++e) y[e] = bg[e] * (F.conv_w[c0 + e] * u0[e] + F.conv_w[512 + c0 + e] * u1[e] + F.conv_w[1024 + c0 + e] * u2[e] + F.conv_b[c0 + e]);
        *(u32x4*)(YAB + (size_t)t * 1024 + 512 + c0) = pack8(y);
    }
}

namespace attn_body {
using bf16x8 = __attribute__((ext_vector_type(8))) short;
using s16x4 = __attribute__((ext_vector_type(4))) short;
using f32x16 = __attribute__((ext_vector_type(16))) float;
using u32x4 = __attribute__((ext_vector_type(4))) unsigned;
constexpr int SEQ = 4096, D = 64, DMQ = 1024, DMK = 512;
constexpr int NW = 8, QBLK = 32, QB = QBLK * NW, KVBLK = 64;
constexpr float NEGB = -1e30f;
__device__ __forceinline__ int crow(int r, int hi) { return (r & 3) + 8 * (r >> 2) + 4 * hi; }
#define SBAR() __builtin_amdgcn_sched_barrier(0)
__device__ __forceinline__ void cmask(f32x16& p0, f32x16& p1, int jb, int qrel, int hi) {
  const float NEG = -INFINITY; int kb = 64 * jb + 4 * hi;
  #pragma unroll
  for (int r = 0; r < 16; ++r) { int kv = kb + (r & 3) + 8 * (r >> 2); if (kv > qrel) p0[r] = NEG; if (kv + 32 > qrel) p1[r] = NEG; }
}
constexpr int NSLOT = 3, SLOTB = 8192;
constexpr int LDS_K = 0, LDS_V = NSLOT * SLOTB, LDS_WS = 2 * NSLOT * SLOTB, LDS_OST = LDS_WS + NW * 128 * 4, LDS_BYTES_A = LDS_OST + NW * 4096;
__device__ __forceinline__ void glds16(const void* gsrc, unsigned lds_dst) { unsigned keep;
  asm volatile("s_mov_b32 %0, m0\n\ts_mov_b32 m0, %2\n\ts_nop 0\n\tglobal_load_lds_dwordx4 %1, off\n\ts_mov_b32 m0, %0" : "=&s"(keep) : "v"(gsrc), "s"(lds_dst) : "memory"); }
__device__ __forceinline__ float max3f(float a, float b, float c) { float r; asm("v_max3_f32 %0, %1, %2, %3" : "=v"(r) : "v"(a), "v"(b), "v"(c)); return r; }
__device__ __forceinline__ float max2f(float a, float b) { float r; asm("v_max_f32_e32 %0, %1, %2" : "=v"(r) : "v"(a), "v"(b)); return r; }
__device__ __forceinline__ float fadd_s(float a, float b) { float r; asm("v_add_f32_e32 %0, %1, %2" : "=v"(r) : "v"(a), "v"(b)); return r; }
__device__ __forceinline__ float fsub_s(float a, float b) { float r; asm("v_sub_f32_e32 %0, %1, %2" : "=v"(r) : "v"(a), "v"(b)); return r; }
typedef float f32x2_t __attribute__((ext_vector_type(2))); typedef __bf16 bf16x2_t __attribute__((ext_vector_type(2)));
__device__ __forceinline__ unsigned cvtpk_s(float lo, float hi) { f32x2_t v = {lo, hi}; bf16x2_t b = __builtin_convertvector(v, bf16x2_t); return __builtin_bit_cast(unsigned, b); }
#define WAIT_BAR(N) asm volatile("s_waitcnt vmcnt(" #N ") lgkmcnt(0)\n\ts_barrier" ::: "memory")
__device__ __forceinline__ void qkt(f32x16& p0, f32x16& p1, const char* Kslot, const bf16x8* qr, const f32x16& negm, int r32, int hi) {
  const char* kb = Kslot + hi * 1024 + r32 * 16;
  #pragma unroll
  for (int d0 = 0; d0 < 4; ++d0) {
    const bf16x8 b0 = *reinterpret_cast<const bf16x8*>(kb + d0 * 2048);
    const bf16x8 b1 = *reinterpret_cast<const bf16x8*>(kb + d0 * 2048 + 512);
    if (d0 == 0) { p0 = __builtin_amdgcn_mfma_f32_32x32x16_bf16(b0, qr[0], negm, 0, 0, 0); p1 = __builtin_amdgcn_mfma_f32_32x32x16_bf16(b1, qr[0], negm, 0, 0, 0); }
    else { p0 = __builtin_amdgcn_mfma_f32_32x32x16_bf16(b0, qr[d0], p0, 0, 0, 0); p1 = __builtin_amdgcn_mfma_f32_32x32x16_bf16(b1, qr[d0], p1, 0, 0, 0); } }
}
typedef __attribute__((address_space(3))) const char* lds_cptr;
typedef __attribute__((address_space(3))) char* lds_ptr;
typedef short v4i16_t __attribute__((ext_vector_type(4)));
__device__ __forceinline__ void kload8(bf16x8* kf, lds_cptr kp) {
  kf[0] = *(const __attribute__((address_space(3))) bf16x8*)(kp);        kf[1] = *(const __attribute__((address_space(3))) bf16x8*)(kp + 512);
  kf[2] = *(const __attribute__((address_space(3))) bf16x8*)(kp + 2048); kf[3] = *(const __attribute__((address_space(3))) bf16x8*)(kp + 2560);
  kf[4] = *(const __attribute__((address_space(3))) bf16x8*)(kp + 4096); kf[5] = *(const __attribute__((address_space(3))) bf16x8*)(kp + 4608);
  kf[6] = *(const __attribute__((address_space(3))) bf16x8*)(kp + 6144); kf[7] = *(const __attribute__((address_space(3))) bf16x8*)(kp + 6656);
}
__device__ __forceinline__ void kload2(bf16x8* kf, lds_cptr kp, int j) { kf[2 * j] = *(const __attribute__((address_space(3))) bf16x8*)(kp + j * 2048); kf[2 * j + 1] = *(const __attribute__((address_space(3))) bf16x8*)(kp + j * 2048 + 512); }
__device__ __forceinline__ s16x4 vtr(lds_cptr p) { return __builtin_bit_cast(s16x4, __builtin_amdgcn_ds_read_tr16_b64_v4i16((__attribute__((address_space(3))) v4i16_t*)p)); }
__device__ __forceinline__ float rowmax(const f32x16& p0, const f32x16& p1) {
  float a = max3f(p0[0], p0[1], p1[0]), b = max3f(p0[2], p0[3], p1[1]); a = max3f(a, p1[2], p1[3]);
  #pragma unroll
  for (int r = 4; r < 16; r += 4) { a = max3f(a, p0[r], p0[r + 1]); b = max3f(b, p0[r + 2], p0[r + 3]); a = max3f(a, p1[r], p1[r + 1]); b = max3f(b, p1[r + 2], p1[r + 3]); }
  const float m = max2f(a, b);
  auto rr = __builtin_amdgcn_permlane32_swap(__float_as_uint(m), __float_as_uint(m), false, false);
  return max2f(__uint_as_float(rr[0]), __uint_as_float(rr[1]));
}
__device__ __forceinline__ void pv(f32x16* o, int vb, bf16x8 pa0, bf16x8 pa1, bf16x8 pa2, bf16x8 pa3) {
  #pragma unroll
  for (int d0 = 0; d0 < 2; ++d0) { s16x4 lo[4], hi[4];
    #pragma unroll
    for (int ks = 0; ks < 4; ++ks) {
      asm volatile("ds_read_b64_tr_b16 %0,%1 offset:%c2" : "=&v"(lo[ks]) : "v"(vb), "i"(d0 * 4096 + ks * 1024) : "memory");
      asm volatile("ds_read_b64_tr_b16 %0,%1 offset:%c2" : "=&v"(hi[ks]) : "v"(vb), "i"(d0 * 4096 + ks * 1024 + 512) : "memory"); }
    asm volatile("s_waitcnt lgkmcnt(0)" ::: "memory"); SBAR();
    #define PK(k) (bf16x8){lo[k][0], lo[k][1], lo[k][2], lo[k][3], hi[k][0], hi[k][1], hi[k][2], hi[k][3]}
    o[d0] = __builtin_amdgcn_mfma_f32_32x32x16_bf16(pa0, PK(0), o[d0], 0, 0, 0);
    o[d0] = __builtin_amdgcn_mfma_f32_32x32x16_bf16(pa1, PK(1), o[d0], 0, 0, 0);
    o[d0] = __builtin_amdgcn_mfma_f32_32x32x16_bf16(pa2, PK(2), o[d0], 0, 0, 0);
    o[d0] = __builtin_amdgcn_mfma_f32_32x32x16_bf16(pa3, PK(3), o[d0], 0, 0, 0);
    #undef PK
  }
}
#define ATTN_STORE16(p, v) st16((p), (v))
template <int THRL> __device__ __forceinline__ void attn_unit(int b, int h, int qb, const bf16_t* QO, bf16_t* Ob, const bf16_t* __restrict__ K, const bf16_t* __restrict__ V, const float* __restrict__ kmean, char* shm) {
  int tid_ = threadIdx.x; asm volatile("" : "+v"(tid_));
  const int tid = tid_, lane = tid & 63, r32 = lane & 31, hi = lane >> 5; const int wid = __builtin_amdgcn_readfirstlane(tid >> 6);
  const long rowbase = (long)b * SEQ; const int q0 = qb * QB;
  const bf16_t* Qw = QO + (rowbase + q0 + wid * QBLK) * DMQ + h * D;
  const bf16_t* Kh = K + rowbase * DMK + h * D, *Vh = V + rowbase * DMK + h * D;
  const unsigned lds0 = (unsigned)(uintptr_t)shm;
  float* wsf = (float*)(shm + LDS_WS) + wid * 128;
  const bf16_t* ksrc = Kh + (long)lane * DMK + wid * 8;
  const bf16_t* vsrc = Vh + (long)(16 * (wid & 3) + (lane >> 2)) * DMK + (wid >> 2) * 32 + (lane & 3) * 8;
  const unsigned kdst = lds0 + LDS_K + wid * 1024, vdst = lds0 + LDS_V + wid * 1024;
  #define DMA_K(t, slot) glds16(ksrc + (long)(t) * KVBLK * DMK, (unsigned)__builtin_amdgcn_readfirstlane(kdst + (slot)))
  #define DMA_V(t, slot) glds16(vsrc + (long)(t) * KVBLK * DMK, (unsigned)__builtin_amdgcn_readfirstlane(vdst + (slot)))
  DMA_K(0, 0); DMA_V(0, 0); DMA_K(1, SLOTB);
  bf16x8 qr[4];
  #pragma unroll
  for (int d0 = 0; d0 < 4; ++d0) qr[d0] = *reinterpret_cast<const bf16x8*>(&Qw[(long)r32 * DMQ + d0 * 16 + hi * 8]);
  unsigned selm = 0u;
  if (qb > 0) {
    float* kmL = (float*)(shm + LDS_OST);
    const float* kmg = kmean + ((size_t)(b * 8 + h) * 16) * 64;
    for (int i = tid; i < qb * 64; i += 512) kmL[i] = kmg[i];
    asm volatile("s_waitcnt vmcnt(0) lgkmcnt(0)\n\ts_barrier" ::: "memory");
    float qf[32];
    #pragma unroll
    for (int d0 = 0; d0 < 4; ++d0)
      #pragma unroll
      for (int e = 0; e < 8; ++e) qf[8 * d0 + e] = __uint_as_float(((unsigned)(unsigned short)qr[d0][e]) << 16);
    float b0 = -INFINITY, b1 = -INFINITY, b2 = -INFINITY; int i0 = -1, i1 = -1, i2 = -1;
    for (int j = 0; j < qb; ++j) {
      const float* km = kmL + j * 64 + 8 * hi; float sc = 0.f;
      #pragma unroll
      for (int d0 = 0; d0 < 4; ++d0)
        #pragma unroll
        for (int e = 0; e < 8; ++e) sc += qf[8 * d0 + e] * km[16 * d0 + e];
      sc += __shfl_xor(sc, 32);
      if (sc > b0) { b2 = b1; i2 = i1; b1 = b0; i1 = i0; b0 = sc; i0 = j; } else if (sc > b1) { b2 = b1; i2 = i1; b1 = sc; i1 = j; } else if (sc > b2) { b2 = sc; i2 = j; }
    }
    if (i0 >= 0) selm |= 1u << i0; if (i1 >= 0) selm |= 1u << i1; if (i2 >= 0) selm |= 1u << i2;
    asm volatile("s_waitcnt lgkmcnt(0)\n\ts_barrier" ::: "memory");
  }
  if (hi == 0) ((unsigned*)wsf)[64 + r32] = selm;
  { const lds_ptr qst = (lds_ptr)shm + LDS_OST + wid * 4096 + lane * 16;
    #pragma unroll
    for (int d0 = 0; d0 < 4; ++d0) *(__attribute__((address_space(3))) bf16x8*)(qst + d0 * 1024) = qr[d0]; }
  #define SELROW(j) (((j) >= qb) || ((((const unsigned*)wsf)[64 + r32] >> (j)) & 1u))
  #define NEGM_SET(blk) do { const float nv_ = SELROW(blk) ? -mhat : NEGB; _Pragma("unroll") for (int r = 0; r < 16; ++r) negm[r] = nv_; asm volatile("" : "+v"(negm)); } while (0)
  const int vb0 = (int)(lds0 + LDS_V) + ((lane >> 4) & 1) * 32 + (lane & 3) * 8 + (4 * hi + ((lane & 15) >> 2)) * 64;
  const char* Kbase = shm + LDS_K; bf16x8 kf[8];
  const lds_cptr qp0 = (lds_cptr)shm + LDS_OST + wid * 4096 + lane * 16;
  const lds_cptr shm3 = (lds_cptr)shm; const lds_cptr kp0 = shm3 + LDS_K + hi * 1024 + r32 * 16; const lds_cptr vp0 = shm3 + LDS_V + ((lane >> 4) & 1) * 32 + (lane & 3) * 8 + (4 * hi + ((lane & 15) >> 2)) * 64;
  const int NT = (q0 + QB) / KVBLK;
  float mhat = 0.f, l_reg = 0.f; f32x16 o[2]; o[0] = f32x16{}; o[1] = f32x16{}; f32x16 negm;
  NEGM_SET(0);
  const int qrel = wid * QBLK + r32;
  #define CMASK(P0, P1, t) do { int jb_ = (t) - (NT - 4); if (jb_ >= 0) cmask(P0, P1, jb_, qrel, hi); } while (0)
  bool resc = false;
  #define START(P0, P1) do { const float rm = rowmax(P0, P1); resc = false; \
    { const float dl = SELROW(0) ? rm : 0.f; mhat = fadd_s(mhat, dl); \
      _Pragma("unroll") for (int r = 0; r < 16; ++r) { P0[r] = fsub_s(P0[r], dl); P1[r] = fsub_s(P1[r], dl); } \
      NEGM_SET(0); } \
    _Pragma("unroll") for (int r = 0; r < 16; ++r) P0[r] = __builtin_amdgcn_exp2f(P0[r]); } while (0)
  #define RESC() do { if (resc) { asm volatile("s_waitcnt lgkmcnt(0)" ::: "memory"); \
      _Pragma("unroll") for (int d_ = 0; d_ < 2; ++d_) _Pragma("unroll") for (int r = 0; r < 16; ++r) o[d_][r] *= wsf[crow(r, hi)]; } } while (0)
  f32x16 pA0, pA1, pB0, pB1;
  int sl_prev = 0, sl_cur = 0, sl_next = SLOTB;
  #define ROT() do { sl_prev = sl_cur; sl_cur = sl_next; sl_next = (sl_next == (NSLOT - 1) * SLOTB) ? 0 : sl_next + SLOTB; } while (0)
  DMA_K(2, 2 * SLOTB);
  WAIT_BAR(3);
  qkt(pA0, pA1, Kbase, qr, negm, r32, hi); asm volatile("s_nop 15\n\ts_nop 7" : "+v"(pA0), "+v"(pA1)); CMASK(pA0, pA1, 0);
  START(pA0, pA1);
  _Pragma("unroll") for (int r = 0; r < 16; ++r) pA1[r] = __builtin_amdgcn_exp2f(pA1[r]);
  WAIT_BAR(0);
  DMA_K(3, 0); DMA_V(1, SLOTB);
  ROT();
  kload8(kf, kp0 + sl_cur);
  WAIT_BAR(2);
  s16x4 vlo[8], vhi[8]; u32x4 pw0, pw1, pw2, pw3; bf16x8 q0_, q1_, q2_, q3_;
  #define QRD(d) do { q##d##_ = *(const __attribute__((address_space(3))) bf16x8*)(qp0 + (d) * 1024); } while (0)
  QRD(0); QRD(1);
  #define PKW(P, B) cvtpk_s(P[B], P[B + 1])
  #define PAF(k) __builtin_bit_cast(bf16x8, pw##k)
  #define VFR(i) (bf16x8){vlo[i][0], vlo[i][1], vlo[i][2], vlo[i][3], vhi[i][0], vhi[i][1], vhi[i][2], vhi[i][3]}
  #define PIN(x) asm volatile("" : "+v"(x))
  #define MX3(a, b, c) __builtin_fmaxf(__builtin_fmaxf((a), (b)), (c))
  #define GAPA(MF, A0, A1, A2, A3, W0, W1, PW) do { MF; sacc += A0; sacc += A1; sacc += A2; sacc += A3; PIN(sacc); W0; W1; PIN(PW); SBAR(); } while (0)
  #define EX(v) __builtin_amdgcn_exp2f(v)
  #define GAPB(MF, X, B) do { MF; X[B] = EX(X[B]); X[B + 1] = EX(X[B + 1]); X[B + 2] = EX(X[B + 2]); X[B + 3] = EX(X[B + 3]); PIN(X); SBAR(); } while (0)
  #define VRD(i) do { vlo[i] = vtr(vp_ + (((i) >> 2) * 4096 + ((i) & 3) * 1024)); vhi[i] = vtr(vp_ + (((i) >> 2) * 4096 + ((i) & 3) * 1024 + 512)); } while (0)
  #define KRD(G, j) do { if (G) { kload2(kf, kp0 + sl_next, j); SBAR(); } } while (0)
  #define STEP(C0, C1, P0, P1, t, GK, GV, GL) do { SBAR(); \
    const lds_cptr vp_ = vp0 + sl_prev; \
    VRD(0); SBAR(); float sacc = (P0[0] + P0[1]); \
    GAPA(C0 = __builtin_amdgcn_mfma_f32_32x32x16_bf16(kf[0], q0_, negm, 0, 0, 0), P0[2], P0[3], P0[4], P0[5],     pw0[0] = PKW(P0, 0), pw0[1] = PKW(P0, 2), pw0); \
    VRD(4); SBAR(); GAPA(C1 = __builtin_amdgcn_mfma_f32_32x32x16_bf16(kf[1], q0_, negm, 0, 0, 0), P0[6], P0[7], P0[8], P0[9],     pw0[2] = PKW(P0, 4), pw0[3] = PKW(P0, 6), pw0); \
    QRD(2); SBAR(); \
    VRD(1); SBAR(); GAPA(C0 = __builtin_amdgcn_mfma_f32_32x32x16_bf16(kf[2], q1_, C0, 0, 0, 0),   P0[10], P0[11], P0[12], P0[13], pw1[0] = PKW(P0, 8), pw1[1] = PKW(P0, 10), pw1); \
    VRD(5); SBAR(); GAPA(C1 = __builtin_amdgcn_mfma_f32_32x32x16_bf16(kf[3], q1_, C1, 0, 0, 0),   P0[14], P0[15], P1[0], P1[1],   pw1[2] = PKW(P0, 12), pw1[3] = PKW(P0, 14), pw1); \
    QRD(3); SBAR(); \
    VRD(2); SBAR(); GAPA(C0 = __builtin_amdgcn_mfma_f32_32x32x16_bf16(kf[4], q2_, C0, 0, 0, 0),   P1[2], P1[3], P1[4], P1[5],     pw2[0] = PKW(P1, 0), pw2[1] = PKW(P1, 2), pw2); \
    VRD(6); SBAR(); GAPA(C1 = __builtin_amdgcn_mfma_f32_32x32x16_bf16(kf[5], q2_, C1, 0, 0, 0),   P1[6], P1[7], P1[8], P1[9],     pw2[2] = PKW(P1, 4), pw2[3] = PKW(P1, 6), pw2); \
    VRD(3); SBAR(); GAPA(C0 = __builtin_amdgcn_mfma_f32_32x32x16_bf16(kf[6], q3_, C0, 0, 0, 0),   P1[10], P1[11], P1[12], P1[13], pw3[0] = PKW(P1, 8), pw3[1] = PKW(P1, 10), pw3); \
    VRD(7); SBAR(); GAPA(C1 = __builtin_amdgcn_mfma_f32_32x32x16_bf16(kf[7], q3_, C1, 0, 0, 0),   P1[14], P1[15], 0.f, 0.f,       pw3[2] = PKW(P1, 12), pw3[3] = PKW(P1, 14), pw3); \
    l_reg += sacc; \
    if (GK) { DMA_K((t) + 3, sl_cur); } if (GV) { DMA_V((t) + 1, sl_next); } \
    CMASK(C0, C1, t); \
    { float a = MX3(C0[0], C0[1], C1[0]), b = MX3(C0[2], C0[3], C1[1]); a = MX3(a, C1[2], C1[3]); \
      _Pragma("unroll") for (int r = 4; r < 16; r += 4) { a = MX3(a, C0[r], C0[r + 1]); b = MX3(b, C0[r + 2], C0[r + 3]); a = MX3(a, C1[r], C1[r + 1]); b = MX3(b, C1[r + 2], C1[r + 3]); } \
      float rm = __builtin_fmaxf(a, b); { auto rr = __builtin_amdgcn_permlane32_swap(__float_as_uint(rm), __float_as_uint(rm), false, false); rm = __builtin_fmaxf(__uint_as_float(rr[0]), __uint_as_float(rr[1])); } \
      resc = false; \
      if (__builtin_expect(__any(rm > (float)THRL), 0)) { const float dl = __builtin_fmaxf(rm, 0.f); mhat += dl; \
        _Pragma("unroll") for (int r = 0; r < 16; ++r) { C0[r] -= dl; C1[r] -= dl; } \
        NEGM_SET(((t) + 1) >> 2); \
        const float f = __builtin_amdgcn_exp2f(-dl); l_reg *= f; if (hi == 0) wsf[r32] = f; resc = true; } \
      else if ((((t) + 1) & 3) == 0) { NEGM_SET(((t) + 1) >> 2); } } \
    SBAR(); \
    GAPB(o[0] = __builtin_amdgcn_mfma_f32_32x32x16_bf16(PAF(0), VFR(0), o[0], 0, 0, 0), C0, 0); \
    GAPB(o[1] = __builtin_amdgcn_mfma_f32_32x32x16_bf16(PAF(0), VFR(4), o[1], 0, 0, 0), C0, 4); \
    KRD(GL, 0); GAPB(o[0] = __builtin_amdgcn_mfma_f32_32x32x16_bf16(PAF(1), VFR(1), o[0], 0, 0, 0), C0, 8); \
    KRD(GL, 1); GAPB(o[1] = __builtin_amdgcn_mfma_f32_32x32x16_bf16(PAF(1), VFR(5), o[1], 0, 0, 0), C0, 12); \
    KRD(GL, 2); GAPB(o[0] = __builtin_amdgcn_mfma_f32_32x32x16_bf16(PAF(2), VFR(2), o[0], 0, 0, 0), C1, 0); \
    KRD(GL, 3); GAPB(o[1] = __builtin_amdgcn_mfma_f32_32x32x16_bf16(PAF(2), VFR(6), o[1], 0, 0, 0), C1, 4); \
    GAPB(o[0] = __builtin_amdgcn_mfma_f32_32x32x16_bf16(PAF(3), VFR(3), o[0], 0, 0, 0), C1, 8); \
    GAPB(o[1] = __builtin_amdgcn_mfma_f32_32x32x16_bf16(PAF(3), VFR(7), o[1], 0, 0, 0), C1, 12); \
    QRD(0); QRD(1); SBAR(); \
    } while (0)
  int t = 1;
  #undef CMASK
  #define CMASK(P0, P1, t) do {} while (0)
  for (; t + 5 < NT; t += 2) {
    STEP(pB0, pB1, pA0, pA1, t, true, true, true);     WAIT_BAR(2); RESC(); ROT();
    STEP(pA0, pA1, pB0, pB1, t + 1, true, true, true); WAIT_BAR(2); RESC(); ROT();
  }
  #undef CMASK
  #define CMASK(P0, P1, t) do { int jb_ = (t) - (NT - 4); if (jb_ >= 0) cmask(P0, P1, jb_, qrel, hi); } while (0)
  #define ENDW(tt) do { if ((tt) + 3 < NT) { WAIT_BAR(2); } else if ((tt) + 2 < NT) { WAIT_BAR(1); } else { WAIT_BAR(0); } } while (0)
  for (; t + 1 < NT; t += 2) {
    STEP(pB0, pB1, pA0, pA1, t, (t + 3 < NT), (t + 1 < NT), (t + 1 < NT));       ENDW(t);     RESC(); ROT();
    STEP(pA0, pA1, pB0, pB1, t + 1, (t + 4 < NT), (t + 2 < NT), (t + 2 < NT));   ENDW(t + 1); RESC(); ROT();
  }
  STEP(pB0, pB1, pA0, pA1, NT - 1, false, false, false); RESC();
  { float sacc = pB0[0] + pB0[1]; _Pragma("unroll") for (int r = 2; r < 16; ++r) sacc += pB0[r]; _Pragma("unroll") for (int r = 0; r < 16; ++r) sacc += pB1[r]; l_reg += sacc;
    pw0 = (u32x4){PKW(pB0, 0), PKW(pB0, 2), PKW(pB0, 4), PKW(pB0, 6)}; pw1 = (u32x4){PKW(pB0, 8), PKW(pB0, 10), PKW(pB0, 12), PKW(pB0, 14)}; pw2 = (u32x4){PKW(pB1, 0), PKW(pB1, 2), PKW(pB1, 4), PKW(pB1, 6)}; pw3 = (u32x4){PKW(pB1, 8), PKW(pB1, 10), PKW(pB1, 12), PKW(pB1, 14)};
    SBAR(); pv(o, vb0 + sl_cur, PAF(0), PAF(1), PAF(2), PAF(3)); }
  #undef PKW
  #undef PAF
  #undef VFR
  #undef PIN
  #undef MX3
  #undef GAPA
  #undef GAPB
  #undef EX
  #undef VRD
  #undef KRD
  #undef QRD
  #undef STEP
  #undef ENDW
  { auto rr = __builtin_amdgcn_permlane32_swap(__float_as_uint(l_reg), __float_as_uint(l_reg), false, false); l_reg = __uint_as_float(rr[0]) + __uint_as_float(rr[1]); }
  if (hi == 0) wsf[32 + r32] = l_reg; asm volatile("s_waitcnt lgkmcnt(0)" ::: "memory");
  float rli[16];
  #pragma unroll
  for (int r = 0; r < 16; ++r) rli[r] = __builtin_amdgcn_rcpf(wsf[32 + crow(r, hi)]);
  bf16_t* Ow = Ob + (rowbase + q0 + wid * QBLK) * DMQ + h * D;
  { bf16_t* stg = (bf16_t*)(shm + LDS_OST) + wid * 2048;
    #pragma unroll
    for (int r = 0; r < 16; ++r) { const int orow = crow(r, hi);
      #pragma unroll
      for (int d0 = 0; d0 < 2; ++d0) stg[orow * 64 + d0 * 32 + r32] = (bf16_t)f2bf(o[d0][r] * rli[r]); }
    asm volatile("s_waitcnt lgkmcnt(0)" ::: "memory");
    #pragma unroll
    for (int i = 0; i < 4; ++i) { const int row = i * 8 + (lane >> 3), ch = lane & 7; const u32x4 v = *(const u32x4*)(stg + row * 64 + ch * 8); ATTN_STORE16(Ow + (long)row * DMQ + ch * 8, v); } }
  asm volatile("s_waitcnt lgkmcnt(0)\n\ts_barrier" ::: "memory");
  #undef DMA_K
  #undef DMA_V
  #undef CMASK
  #undef START
  #undef RESC
  #undef ROT
  #undef SELROW
  #undef NEGM_SET
}
#undef SBAR
#undef WAIT_BAR
}
__device__ __forceinline__ void conv_pass(Frame& F) {
    bf16_t* YAB = WSP(bf16_t, WS_YAB); const bf16_t* U = WSP(bf16_t, WS_U); const bf16_t* BG = WSP(bf16_t, WS_BG);
    const int stride = F.G * NTHREADS;
    for (int i0 = blockIdx.x * NTHREADS + F.tid; i0 < T * 64; i0 += 2 * stride) {
        u32x4 r2[2], r1[2], r0[2], rb[2];
#pragma unroll
        for (int q = 0; q < 2; ++q) { const int i = i0 + q * stride; const int t = i >> 6, c0 = (i & 63) * 8, pos = t & (S - 1);
            r2[q] = *(const u32x4*)(U + (size_t)t * 512 + c0); rb[q] = __builtin_nontemporal_load((const u32x4*)(BG + (size_t)t * 512 + c0));
            r1[q] = (pos >= 1) ? *(const u32x4*)(U + (size_t)(t - 1) * 512 + c0) : (u32x4){0u, 0u, 0u, 0u};
            r0[q] = (pos >= 2) ? *(const u32x4*)(U + (size_t)(t - 2) * 512 + c0) : (u32x4){0u, 0u, 0u, 0u}; }
#pragma unroll
        for (int q = 0; q < 2; ++q) { const int i = i0 + q * stride; const int t = i >> 6, c0 = (i & 63) * 8;
            float u0[8], u1[8], u2[8], bg[8], y[8]; unpack8(r2[q], u2); unpack8(r1[q], u1); unpack8(r0[q], u0); unpack8(rb[q], bg);
#pragma unroll
            for (int e4 = 0; e4 < 2; ++e4) { const f32x4 w0 = *(const f32x4*)(F.conv_w + c0 + 4 * e4), w1 = *(const f32x4*)(F.conv_w + 512 + c0 + 4 * e4), w2 = *(const f32x4*)(F.conv_w + 1024 + c0 + 4 * e4), cb = *(const f32x4*)(F.conv_b + c0 + 4 * e4);
#pragma unroll
                for (int e = 0; e < 4; ++e) y[4 * e4 + e] = bg[4 * e4 + e] * (w0[e] * u0[4 * e4 + e] + w1[e] * u1[4 * e4 + e] + w2[e] * u2[4 * e4 + e] + cb[e]); }
            st16(YAB + (size_t)t * 1024 + 512 + c0, pack8(y)); }
    }
}
__device__ __forceinline__ void s3_attn(Frame& F, char* lds_gen, bf16_t* obase) {
    const int vcu = (blockIdx.x % 8) * (F.G / 8) + blockIdx.x / 8;
    const int s = vcu & 7, pr = vcu >> 3;
#pragma unroll 1
    for (int i = 0; i < 4; ++i) {
        const int bh = 2 * pr + (i >> 1), qb = (i & 1) ? 15 - s : s;
        attn_body::attn_unit<8>(bh >> 3, bh & 7, qb, WSP(bf16_t, WS_YAB), obase, WSP(bf16_t, WS_K), WSP(bf16_t, WS_V), WSP(float, WS_KMEAN), lds_gen);
        if (!(i & 1)) { { int t_ = threadIdx.x; asm volatile("" : "+v"(t_)); F.tid = t_; F.lane = t_ & 63; }
            const int lo = X_NONEXP + (i >> 1) * (NE * 256);
            convert_items(F, lo, lo + NE * 256, blockIdx.x * NWAVES + F.wave, F.G * NWAVES);
            __syncthreads(); }
    }
}
__device__ __forceinline__ void s3_fast(Frame& F, char* lds_gen) { s3_attn(F, lds_gen, WSP(bf16_t, WS_YAB)); conv_pass(F); }

__device__ __forceinline__ void s4_simple(Frame& F) {
    LAS float* tile = (LAS float*)F.lds; LAS float* tile2 = tile + 64 * 65;
    const bf16_t* YAB = WSP(bf16_t, WS_YAB); const bf16_t* WP = WSP(bf16_t, WS_WP_T); const bf16_t* GT = WSP(bf16_t, WS_GATES);
    const int row = F.tid >> 3, seg = F.tid & 7;
    for (int it = blockIdx.x; it < 512 * 16; it += F.G) {
        const int rt = it >> 4, ct = it & 15, r0 = rt * 64, gr = r0 + row;
        const RowsLinear aa{YAB + (size_t)r0 * 1024, 1024}, ab{YAB + (size_t)r0 * 1024 + 512, 1024};
        const RowsLinear ba{WP + (size_t)(64 * ct) * 1024, 1024}, bb{WP + (size_t)(64 * ct) * 1024 + 512, 1024};
        sgemm_tile(tile, 512, aa, ba, F.wave, F.lane); sgemm_tile(tile2, 512, ab, bb, F.wave, F.lane); __syncthreads();
        float ga[8], gb[8], v[8];
        unpack8(*(const u32x4*)(GT + (size_t)gr * 2048 + 64 * ct + 8 * seg), ga); unpack8(*(const u32x4*)(GT + (size_t)gr * 2048 + 1024 + 64 * ct + 8 * seg), gb);
#pragma unroll
        for (int e = 0; e < 8; ++e) v[e] = ga[e] * tile[row * 65 + 8 * seg + e] + gb[e] * tile2[row * 65 + 8 * seg + e];
        *(u32x4*)(WSP(bf16_t, WS_H) + (size_t)gr * 1024 + 64 * ct + 8 * seg) = pack8(v);
        __syncthreads();
    }
}
__device__ __forceinline__ void s5_simple(Frame& F) {
    LAS float* tile = (LAS float*)F.lds;
    const bf16_t* MG = WSP(bf16_t, WS_H); const bf16_t* WO = WSP(bf16_t, WS_WO_T);
    const int row = F.tid >> 3, seg = F.tid & 7;
    for (int it = blockIdx.x; it < 512 * 16; it += F.G) {
        const int rt = it >> 4, ct = it & 15, r0 = rt * 64, gr = r0 + row, b = r0 / S;
        const RowsLinear aa{MG + (size_t)r0 * 1024, 1024}, bb{WO + (size_t)(64 * ct) * 1024, 1024};
        sgemm_tile(tile, 1024, aa, bb, F.wave, F.lane); __syncthreads();
        const float* ga1 = WSP(float, WS_MOD) + (size_t)b * NMOD + 2048 + 64 * ct + 8 * seg;
        const float* xr = F.x + (size_t)gr * D + 64 * ct + 8 * seg; float* orow = F.out + (size_t)gr * D + 64 * ct + 8 * seg;
#pragma unroll
        for (int e4 = 0; e4 < 2; ++e4) { const f32x4 xv = *(const f32x4*)(xr + 4 * e4), gv = *(const f32x4*)(ga1 + 4 * e4); f32x4 o;
#pragma unroll
            for (int e = 0; e < 4; ++e) o[e] = xv[e] + gv[e] * tile[row * 65 + 8 * seg + 4 * e4 + e];
            *(f32x4*)(orow + 4 * e4) = o; }
        __syncthreads();
    }
}

struct EpiG2 {
    static constexpr bool HAS_MID = true;
    const bf16_t* gates; bf16_t* merged;
    __device__ __forceinline__ void mid(Acc& acc, const pg8::Unit& u, int wr, int wc, int fr, int fq) const {
        int row0 = u.pm * 256 + wr * 64 + fr; const int c0 = u.pn * 256 + 32 * wc + 8 * fq; asm volatile("" : "+v"(row0));
#pragma unroll
        for (int ai = 0; ai < 2; ++ai)
#pragma unroll
            for (int m = 0; m < 4; ++m) { const bf16_t* gp = gates + (size_t)(row0 + 128 * ai + 16 * m) * 2048 + c0;
#pragma unroll
                for (int bj = 0; bj < 2; ++bj) { f32x4 a0, a1; unpack8v(__builtin_nontemporal_load((const u32x4*)(gp + 128 * bj)), a0, a1);
                    acc[ai][bj][m][0] *= a0; acc[ai][bj][m][1] *= a1; } }
    }
    __device__ __forceinline__ void operator()(Acc& acc, const pg8::Unit& u, int wr, int wc, int fr, int fq) const {
        int row0 = u.pm * 256 + wr * 64 + fr; const int c0 = u.pn * 256 + 32 * wc + 8 * fq; asm volatile("" : "+v"(row0));
#pragma unroll
        for (int ai = 0; ai < 2; ++ai)
#pragma unroll
            for (int m = 0; m < 4; ++m) { const size_t r = (size_t)(row0 + 128 * ai + 16 * m);
#pragma unroll
                for (int bj = 0; bj < 2; ++bj) { f32x4 b0, b1; unpack8v(__builtin_nontemporal_load((const u32x4*)(gates + r * 2048 + 1024 + c0 + 128 * bj)), b0, b1);
                    st16(merged + r * 1024 + c0 + 128 * bj, pack8v(acc[ai][bj][m][0] * b0, acc[ai][bj][m][1] * b1)); } }
    }
};
__device__ __forceinline__ void s4_fast(Frame& F) {
    const pg8::DenseSched Sd{(const char*)(F.ws + WS_YAB), (const char*)(F.ws + WS_WP_T), T / 256, 4, 1024, F.G, (int)blockIdx.x};
    const EpiG2 E{WSP(bf16_t, WS_GATES), WSP(bf16_t, WS_H)};
    if (F.skip) pg8::gemm_phase<EpiG2, pg8::DenseSched, true>(F.lds, 1024, Sd, E); else pg8::gemm_phase<EpiG2, pg8::DenseSched>(F.lds, 1024, Sd, E);
}
struct EpiG3 {
    static constexpr bool HAS_MID = false;
    const float* x; bf16_t* x1; const float* mod;
    __device__ __forceinline__ void mid(Acc&, const pg8::Unit&, int, int, int, int) const {}
    __device__ __forceinline__ void operator()(Acc& acc, const pg8::Unit& u, int wr, int wc, int fr, int fq) const {
        int row0 = u.pm * 256 + wr * 64 + fr; const int c0 = u.pn * 256 + 32 * wc + 8 * fq, b = u.pm >> 4; asm volatile("" : "+v"(row0));
        f32x4 gv[2][2];
#pragma unroll
        for (int bj = 0; bj < 2; ++bj)
#pragma unroll
            for (int n = 0; n < 2; ++n) gv[bj][n] = *(const f32x4*)(mod + (size_t)b * NMOD + 2048 + c0 + 128 * bj + 4 * n);
#pragma unroll
        for (int ai = 0; ai < 2; ++ai)
#pragma unroll
            for (int m = 0; m < 4; ++m) { const size_t off = (size_t)(row0 + 128 * ai + 16 * m) * D + c0;
#pragma unroll
                for (int bj = 0; bj < 2; ++bj) { const f32x4 x0 = __builtin_nontemporal_load((const f32x4*)(x + off + 128 * bj)), x1v = __builtin_nontemporal_load((const f32x4*)(x + off + 128 * bj + 4));
                    st16(x1 + off + 128 * bj, pack8v(x0 + gv[bj][0] * acc[ai][bj][m][0], x1v + gv[bj][1] * acc[ai][bj][m][1])); }
                if (m == 3) asm volatile("" ::: "memory"); }
    }
};
__device__ __forceinline__ void s5_fast(Frame& F) {
    const pg8::DenseSched Sd{(const char*)(F.ws + WS_H), (const char*)(F.ws + WS_WO_T), T / 256, 4, 1024, F.G, (int)blockIdx.x};
    const EpiG3 E{F.x, WSP(bf16_t, WS_X1), WSP(float, WS_MOD)};
    if (F.skip) pg8::gemm_phase<EpiG3, pg8::DenseSched, true>(F.lds, 1024, Sd, E); else pg8::gemm_phase<EpiG3, pg8::DenseSched>(F.lds, 1024, Sd, E);
}
struct MoeTab { const LAS int* cnt; const LAS int* tstart; const LAS int* tile_e; int nM; };
__device__ __forceinline__ MoeTab moe_table(Frame& F) {
    LAS int* cntL = (LAS int*)(F.lds + MISC_OFF + 1024); LAS int* ts = cntL + 32; LAS int* te = cntL + 96;
    if (F.tid < 32) cntL[F.tid] = (int)__hip_atomic_load(WSP(unsigned, WS_CTL) + CW_GCNT + 64 * F.tid, __ATOMIC_RELAXED, __HIP_MEMORY_SCOPE_AGENT);
    __syncthreads();
    if (F.tid == 0) { int pm = 0; for (int e = 0; e < 32; ++e) { ts[e] = pm; const int n = (cntL[e] + 255) >> 8; for (int i = 0; i < n; ++i) te[pm++] = e; } ts[32] = pm; }
    __syncthreads();
    return MoeTab{cntL, ts, te, ts[32]};
}
struct MoeUpSched {
    static constexpr bool GATHER = true, FP8 = true;
    const char* h2; const char* w13; MoeTab tb; const int* linfo; int G, c;
    __device__ __forceinline__ bool next(int i, pg8::Unit& u) const { if (!pg8::static_unit(i, G, c, tb.nM, 4, u.pm, u.pn)) return false;
        u.e = tb.tile_e[u.pm]; u.rbase = (u.pm - tb.tstart[u.e]) * 256; u.a = h2; u.b = w13 + ((size_t)u.e * 1024 + 256 * u.pn) * 1024; return true; }
    __device__ __forceinline__ int row_index(const pg8::Unit& u, int r) const { const int rank = u.rbase + r; return rank < tb.cnt[u.e] ? (linfo[(size_t)u.e * 65536 + rank] >> 1) : 0; }
};
struct EpiUp {
    static constexpr bool HAS_MID = false;
    bf16_t* hid; const float* lw; const LAS int* cnt;
    __device__ __forceinline__ void mid(Acc&, const pg8::Unit&, int, int, int, int) const {}
    __device__ __forceinline__ void operator()(Acc& acc, const pg8::Unit& u, int wr, int wc, int fr, int fq) const {
        int rl0 = wr * 64 + fr; const int c0 = u.pn * 128 + 32 * wc + 8 * fq, n_e = cnt[u.e]; asm volatile("" : "+v"(rl0));
#pragma unroll
        for (int ai = 0; ai < 2; ++ai)
#pragma unroll
            for (int m = 0; m < 4; ++m) { const int rl = rl0 + 128 * ai + 16 * m, rank = u.rbase + rl; const float wt = rank < n_e ? 1.f : 0.f; f32x4 o[2];
#pragma unroll
                for (int n = 0; n < 2; ++n)
#pragma unroll
                    for (int e = 0; e < 4; ++e) { const float a = acc[ai][0][m][n][e] * (1.f / W8_SCALE), c = acc[ai][1][m][n][e] * (1.f / W8_SCALE); o[n][e] = a * __builtin_amdgcn_rcpf(1.f + __expf(-a)) * c * wt; }
                *(u32x2*)((unsigned char*)hid + (size_t)(u.pm * 256 + rl) * 512 + c0) = pack8_fp8(o[0], o[1]); }
    }
};
__device__ __forceinline__ void s8_fast(Frame& F) {
    const MoeTab tb = moe_table(F);
    const MoeUpSched Sd{(const char*)(F.ws + WS_H2), (const char*)(F.ws + WS_W13_T), tb, WSP(int, WS_LINFO), F.G, (int)blockIdx.x};
    const EpiUp E{WSP(bf16_t, WS_HID), WSP(float, WS_LW), tb.cnt};
    int Ku = D; asm volatile("" : "+s"(Ku));
    if (F.skip) pg8::gemm_phase<EpiUp, MoeUpSched, true>(F.lds, Ku, Sd, E); else pg8::gemm_phase<EpiUp, MoeUpSched>(F.lds, Ku, Sd, E);
    { int t_ = threadIdx.x; asm volatile("" : "+v"(t_)); F.tid = t_; F.lane = t_ & 63; }
    { const int units = tb.nM * 4, rem = units % F.G, nidle = (rem == 0) ? F.G : F.G - rem, me = (rem == 0) ? (int)blockIdx.x : (int)blockIdx.x - rem;
        if (me >= 0 && !F.skip) convert_items(F, X_W2, X_END, me * NWAVES + F.wave, nidle * NWAVES); }
}
struct MoeDownSched {
    static constexpr bool GATHER = false, FP8 = true;
    const char* hid; const char* w2; MoeTab tb; int G, c;
    __device__ __forceinline__ bool next(int i, pg8::Unit& u) const { if (!pg8::static_unit(i, G, c, tb.nM, 4, u.pm, u.pn)) return false;
        u.e = tb.tile_e[u.pm]; u.rbase = (u.pm - tb.tstart[u.e]) * 256; u.a = hid + (size_t)u.pm * 256 * 512; u.b = w2 + ((size_t)u.e * 1024 + 256 * u.pn) * 512; return true; }
    __device__ __forceinline__ int row_index(const pg8::Unit&, int) const { return 0; }
};
struct EpiDown {
    static constexpr bool HAS_MID = false;
    bf16_t* yslot; const int* linfo; const float* lw; const LAS int* cnt;
    __device__ __forceinline__ void mid(Acc&, const pg8::Unit&, int, int, int, int) const {}
    __device__ __forceinline__ void operator()(Acc& acc, const pg8::Unit& u, int wr, int wc, int fr, int fq) const {
        int rl0 = wr * 64 + fr; const int c0 = u.pn * 256 + 32 * wc + 8 * fq, n_e = cnt[u.e]; asm volatile("" : "+v"(rl0));
        int info[2][4]; float wt[2][4];
#pragma unroll
        for (int ai = 0; ai < 2; ++ai)
#pragma unroll
            for (int m = 0; m < 4; ++m) { const int rank = u.rbase + rl0 + 128 * ai + 16 * m, rc = rank < n_e ? rank : 0;
                info[ai][m] = linfo[(size_t)u.e * 65536 + rc]; wt[ai][m] = lw[(size_t)u.e * 65536 + rc] * (1.f / W8_SCALE); }
#pragma unroll
        for (int ai = 0; ai < 2; ++ai)
#pragma unroll
            for (int m = 0; m < 4; ++m) { const int rank = u.rbase + rl0 + 128 * ai + 16 * m;
                if (rank < n_e) {
#pragma unroll
                    for (int bj = 0; bj < 2; ++bj) st16(yslot + (size_t)info[ai][m] * 1024 + c0 + 128 * bj, pack8v(acc[ai][bj][m][0] * wt[ai][m], acc[ai][bj][m][1] * wt[ai][m])); } }
    }
};
__device__ __forceinline__ void s9_fast(Frame& F) {
    const MoeTab tb = moe_table(F);
    const MoeDownSched Sd{(const char*)(F.ws + WS_HID), (const char*)(F.ws + WS_W2_T), tb, F.G, (int)blockIdx.x};
    const EpiDown E{WSP(bf16_t, WS_YSLOT), WSP(int, WS_LINFO), WSP(float, WS_LW), tb.cnt};
    int Kd = DE; asm volatile("" : "+s"(Kd));
    if (F.skip) pg8::gemm_phase<EpiDown, MoeDownSched, true>(F.lds, Kd, Sd, E); else pg8::gemm_phase<EpiDown, MoeDownSched>(F.lds, Kd, Sd, E);
}

__device__ __forceinline__ void s6_router(Frame& F) {
    constexpr int WROW = 1032;
    LAS bf16_t* WT = (LAS bf16_t*)F.lds;
    LAS float* gsL = (LAS float*)(F.lds + 48 * WROW * 2);
    LAS float* shL = gsL + 1024;
    LAS float* biasL = shL + 1024;
    LAS float* lgt = biasL + 64;
    LAS int* cnt = (LAS int*)(F.lds + MISC_OFF + 256);
    LAS int* baseL = cnt + 32; LAS int* runL = cnt + 64; LAS int* eidL = cnt + 128; LAS float* ewL = (LAS float*)(cnt + 384);
    const int b = blockIdx.x >> 5;
    const float* mod = WSP(float, WS_MOD) + (size_t)b * NMOD;
    const float* W36 = WSP(float, WS_W36T);
    for (int i = F.tid; i < 36 * 256; i += NTHREADS) { const int jj = i >> 8, k4 = (i & 255) * 4; const f32x4 w = *(const f32x4*)(W36 + jj * 1024 + k4);
        u32x2 p; p.x = pk2(w.x, w.y); p.y = pk2(w.z, w.w); *(LAS u32x2*)(WT + jj * WROW + k4) = p; }
    for (int i = F.tid; i < 12 * 256; i += NTHREADS) { const int jj = 36 + (i >> 8), k4 = (i & 255) * 4; *(LAS u32x2*)(WT + jj * WROW + k4) = (u32x2){0u, 0u}; }
    if (F.tid < 256) { const int col = 4 * F.tid; const f32x4 g = *(const f32x4*)(F.g2 + col), s_ = *(const f32x4*)(mod + 4096 + col); *(LAS f32x4*)(gsL + col) = g * (s_ + 1.0f); *(LAS f32x4*)(shL + col) = *(const f32x4*)(mod + 3072 + col); }
    if (F.tid < 32) cnt[F.tid] = 0;
    __syncthreads();
    for (int jj = F.wave; jj < 36; jj += NWAVES) { float a = 0.f;
#pragma unroll
        for (int i = 0; i < 16; ++i) a += shL[F.lane + 64 * i] * W36[jj * 1024 + F.lane + 64 * i];
        a = wave_sum(a); if (F.lane == 0) biasL[jj] = a + ((jj < 4) ? F.b_rg[jj] : F.b_re[jj - 4]); }
    __syncthreads();
    const int fr = F.lane & 15, fq = F.lane >> 4, row0 = (blockIdx.x * NWAVES + F.wave) * 16, r = row0 + fr;
    const bf16_t* xr = WSP(bf16_t, WS_X1) + (size_t)r * D + 8 * fq;
    f32x4 D0 = {0.f, 0.f, 0.f, 0.f}, D1 = D0, D2 = D0; float ss = 0.f;
#pragma unroll 1
    for (int kb = 0; kb < 8; ++kb) {
        u32x4 xa[4];
#pragma unroll
        for (int i = 0; i < 4; ++i) xa[i] = *(const u32x4*)(xr + 32 * (4 * kb + i));
#pragma unroll
        for (int i = 0; i < 4; ++i) { const int k0 = 32 * (4 * kb + i) + 8 * fq;
            f32x4 a0, a1; unpack8v(xa[i], a0, a1);
            ss += (a0.x * a0.x + a0.y * a0.y) + (a0.z * a0.z + a0.w * a0.w) + (a1.x * a1.x + a1.y * a1.y) + (a1.z * a1.z + a1.w * a1.w);
            a0 *= *(const LAS f32x4*)(gsL + k0); a1 *= *(const LAS f32x4*)(gsL + k0 + 4);
            const bf16x8 A = __builtin_bit_cast(bf16x8, pack8v(a0, a1));
            const bf16x8 B0 = *(const LAS bf16x8*)(WT + fr * WROW + k0), B1 = *(const LAS bf16x8*)(WT + (16 + fr) * WROW + k0), B2 = *(const LAS bf16x8*)(WT + (32 + fr) * WROW + k0);
            D0 = __builtin_amdgcn_mfma_f32_16x16x32_bf16(A, B0, D0, 0, 0, 0);
            D1 = __builtin_amdgcn_mfma_f32_16x16x32_bf16(A, B1, D1, 0, 0, 0);
            D2 = __builtin_amdgcn_mfma_f32_16x16x32_bf16(A, B2, D2, 0, 0, 0); }
    }
    ss += __shfl_xor(ss, 16); ss += __shfl_xor(ss, 32);
    const float rinv = rsqrtf(ss * (1.f / D) + EPS);
    { int t2 = threadIdx.x; asm volatile("" : "+v"(t2)); F.lane = t2 & 63; }
    const int fr_ = F.lane & 15, fq_ = F.lane >> 4;
    {
        LAS float* lw = lgt + F.wave * 16 * 37;
#pragma unroll
        for (int reg = 0; reg < 4; ++reg) { const float rv = __shfl(rinv, 4 * fq_ + reg); const int tk = 4 * fq_ + reg;
            lw[tk * 37 + fr_] = D0[reg] * rv + biasL[fr_]; lw[tk * 37 + 16 + fr_] = D1[reg] * rv + biasL[16 + fr_];
            if (fr_ < 4) lw[tk * 37 + 32 + fr_] = D2[reg] * rv + biasL[32 + fr_]; }
    }
    {
        const int r_ = row0 + fr_; const bf16_t* xr_ = WSP(bf16_t, WS_X1) + (size_t)r_ * D + 8 * fq_;
        unsigned char* o = WSP(unsigned char, WS_H2) + (size_t)r_ * D + 8 * fq_;
#pragma unroll 1
        for (int kb = 0; kb < 8; ++kb) {
            u32x4 xa[4];
#pragma unroll
            for (int i = 0; i < 4; ++i) xa[i] = *(const u32x4*)(xr_ + 32 * (4 * kb + i));
#pragma unroll
            for (int i = 0; i < 4; ++i) { const int k0 = 32 * (4 * kb + i) + 8 * fq_; f32x4 a0, a1; unpack8v(xa[i], a0, a1);
                const f32x4 h0 = a0 * rinv * *(const LAS f32x4*)(gsL + k0) + *(const LAS f32x4*)(shL + k0), h1 = a1 * rinv * *(const LAS f32x4*)(gsL + k0 + 4) + *(const LAS f32x4*)(shL + k0 + 4);
                *(u32x2*)(o + 32 * (4 * kb + i)) = pack8_fp8(h0, h1); }
        }
    }
    if (F.lane < 16) {
        const int t = row0 + F.lane; const LAS float* lw = lgt + (F.wave * 16 + F.lane) * 37;
        float lg[36];
#pragma unroll
        for (int jj = 0; jj < 36; ++jj) lg[jj] = lw[jj];
        int gi = 0; float gm = lg[0];
#pragma unroll
        for (int i = 1; i < 4; ++i) if (lg[i] > gm) { gm = lg[i]; gi = i; }
        float den = 0.f;
#pragma unroll
        for (int i = 0; i < 4; ++i) den += __expf(lg[i] - gm);
        const float gw_ = 1.f / den;
        float v1 = -INFINITY, v2 = -INFINITY; int e1 = 0, e2 = 0;
#pragma unroll
        for (int i = 0; i < 8; ++i) { const float el = (gi == 0) ? lg[4 + i] : (gi == 1) ? lg[12 + i] : (gi == 2) ? lg[20 + i] : lg[28 + i];
            const bool c1 = el > v1, c2 = el > v2;
            v2 = c1 ? v1 : (c2 ? el : v2); e2 = c1 ? e1 : (c2 ? i : e2); v1 = c1 ? el : v1; e1 = c1 ? i : e1; }
        const float p1 = 1.f / (1.f + __expf(v2 - v1)), p2 = 1.f - p1;
        const int id1 = gi * 8 + e1, id2 = gi * 8 + e2;
        const int la = 2 * (F.wave * 16 + F.lane);
        eidL[la] = id1; eidL[la + 1] = id2; ewL[la] = p1 * gw_; ewL[la + 1] = p2 * gw_;
        lds_add(&cnt[id1], 1); lds_add(&cnt[id2], 1);
    }
    __syncthreads();
    if (F.tid < 32) { baseL[F.tid] = (int)__hip_atomic_fetch_add(WSP(unsigned, WS_CTL) + CW_GCNT + 64 * F.tid, (unsigned)cnt[F.tid], __ATOMIC_RELAXED, __HIP_MEMORY_SCOPE_AGENT); runL[F.tid] = 0; }
    __syncthreads();
    if (F.tid < 256) { const int e = eidL[F.tid]; const int pos = baseL[e] + lds_add(&runL[e], 1);
        WSP(int, WS_LINFO)[(size_t)e * 65536 + pos] = 2 * (blockIdx.x * 128) + F.tid; WSP(float, WS_LW)[(size_t)e * 65536 + pos] = ewL[F.tid]; }
    __syncthreads();
}

__device__ __forceinline__ void s7_lists(Frame& F) {
    LAS int* sm = (LAS int*)F.lds;
    const int* bc = WSP(int, WS_BCNT);
    if (F.tid < 32) { int tot = 0, base = 0; for (int bb = 0; bb < 256; ++bb) { const int c = bc[bb * 32 + F.tid]; if (bb < (int)blockIdx.x) base += c; tot += c; }
        sm[F.tid] = tot; sm[32 + F.tid] = base; sm[96 + F.tid] = 0; }
    __syncthreads();
    if (F.tid == 0) { int ps = 0; for (int e = 0; e < 32; ++e) { sm[64 + e] = ps; ps += (sm[e] + 255) & ~255; }
        if (blockIdx.x == 0) { int* te = WSP(int, WS_TILEE); int pm = 0; for (int e = 0; e < 32; ++e) { const int n = (sm[e] + 255) >> 8; for (int i = 0; i < n; ++i) te[1 + pm++] = e; } te[0] = pm; } }
    __syncthreads();
    int* atok = WSP(int, WS_ATOK); int* ainfo = WSP(int, WS_AINFO); float* aw = WSP(float, WS_AW);
    if (F.tid < 256) { const int a = blockIdx.x * 256 + F.tid;
        const int e = WSP(int, WS_EID)[a]; const int rank = lds_add(&sm[96 + e], 1); const int pos = sm[64 + e] + sm[32 + e] + rank;
        atok[pos] = a >> 1; ainfo[pos] = a; aw[pos] = WSP(float, WS_EW)[a]; }
    if (blockIdx.x < 32) { const int e = blockIdx.x; const int lo = sm[64 + e] + sm[e], hi = sm[64 + e] + ((sm[e] + 255) & ~255);
        for (int p = lo + F.tid; p < hi; p += NTHREADS) { atok[p] = 0; ainfo[p] = -1; aw[p] = 0.f; } }
}

struct RowsGather { const bf16_t* base; const int* idx; __device__ __forceinline__ const bf16_t* operator()(int r) const { return base + (size_t)idx[r] * 1024; } };
__device__ __forceinline__ void s8_simple(Frame& F) {
    LAS float* tile = (LAS float*)F.lds; LAS float* tile2 = tile + 64 * 65;
    const int* te = WSP(int, WS_TILEE); const int nmt = te[0];
    const int row = F.tid >> 3, seg = F.tid & 7;
    for (int it = blockIdx.x; it < nmt * 4 * 8; it += F.G) {
        const int rt = it >> 3, ct = it & 7, e = te[1 + (rt >> 2)], pos0 = 64 * rt, hc = 64 * ct;
        const RowsGather ar{WSP(bf16_t, WS_H2), WSP(int, WS_ATOK) + pos0};
        const bf16_t* wb = WSP(bf16_t, WS_W13_T) + ((size_t)e * 1024 + 256 * (hc >> 7) + (hc & 127)) * 1024;
        const RowsLinear b1{wb, 1024}, b3{wb + (size_t)128 * 1024, 1024};
        sgemm_tile(tile, 1024, ar, b1, F.wave, F.lane); sgemm_tile(tile2, 1024, ar, b3, F.wave, F.lane); __syncthreads();
        const float wt = WSP(float, WS_AW)[pos0 + row]; float v[8];
#pragma unroll
        for (int e8 = 0; e8 < 8; ++e8) { const float a = tile[row * 65 + 8 * seg + e8], c = tile2[row * 65 + 8 * seg + e8]; v[e8] = (a / (1.f + __expf(-a))) * c * wt; }
        *(u32x4*)(WSP(bf16_t, WS_HID) + (size_t)(pos0 + row) * 512 + hc + 8 * seg) = pack8(v);
        __syncthreads();
    }
}
__device__ __forceinline__ void s9_simple(Frame& F) {
    LAS float* tile = (LAS float*)F.lds;
    const int* te = WSP(int, WS_TILEE); const int nmt = te[0];
    const int row = F.tid >> 3, seg = F.tid & 7;
    for (int it = blockIdx.x; it < nmt * 4 * 16; it += F.G) {
        const int rt = it >> 4, ct = it & 15, e = te[1 + (rt >> 2)], pos0 = 64 * rt;
        const RowsLinear ar{WSP(bf16_t, WS_HID) + (size_t)pos0 * 512, 512};
        const RowsLinear br{WSP(bf16_t, WS_W2_T) + ((size_t)e * 1024 + 64 * ct) * 512, 512};
        sgemm_tile(tile, 512, ar, br, F.wave, F.lane); __syncthreads();
        const int info = WSP(int, WS_AINFO)[pos0 + row];
        if (info >= 0) { float v[8];
#pragma unroll
            for (int e8 = 0; e8 < 8; ++e8) v[e8] = tile[row * 65 + 8 * seg + e8];
            *(u32x4*)(WSP(bf16_t, WS_YSLOT) + (size_t)info * 1024 + 64 * ct + 8 * seg) = pack8(v); }
        __syncthreads();
    }
}
__device__ __forceinline__ void s10_combine(Frame& F) {
    const bf16_t* Y = WSP(bf16_t, WS_YSLOT); const bf16_t* X1 = WSP(bf16_t, WS_X1);
    const int stride = F.G * NTHREADS;
    for (int i0 = blockIdx.x * NTHREADS + F.tid; i0 < T * 128; i0 += 2 * stride) {
        u32x4 ya[2], yb[2], xx[2]; f32x4 g0[2], g1[2];
#pragma unroll
        for (int q = 0; q < 2; ++q) { const int i = i0 + q * stride; const int t = i >> 7, c0 = (i & 127) * 8, b = t / S;
            ya[q] = __builtin_nontemporal_load((const u32x4*)(Y + (size_t)(2 * t) * 1024 + c0)); yb[q] = __builtin_nontemporal_load((const u32x4*)(Y + (size_t)(2 * t + 1) * 1024 + c0)); xx[q] = __builtin_nontemporal_load((const u32x4*)(X1 + (size_t)t * D + c0));
            const float* ga2 = WSP(float, WS_MOD) + (size_t)b * NMOD + 5120 + c0; g0[q] = *(const f32x4*)ga2; g1[q] = *(const f32x4*)(ga2 + 4); }
#pragma unroll
        for (int q = 0; q < 2; ++q) { const int i = i0 + q * stride; const int t = i >> 7, c0 = (i & 127) * 8;
            f32x4 y0a, y0b, y1a, y1b, xa, xb; unpack8v(ya[q], y0a, y0b); unpack8v(yb[q], y1a, y1b); unpack8v(xx[q], xa, xb);
            float* o = F.out + (size_t)t * D + c0;
            __builtin_nontemporal_store(xa + g0[q] * (y0a + y1a), (f32x4*)o); __builtin_nontemporal_store(xb + g1[q] * (y0b + y1b), (f32x4*)(o + 4)); }
    }
}

constexpr int N_PHASES = 11;
struct Args { const float* in[21]; float* out; unsigned char* ws; int ph_lo, ph_hi; };
__global__ void __launch_bounds__(NTHREADS, 2) mega_fwd(Args args) {
    extern __shared__ __attribute__((aligned(16))) unsigned char lds_raw[];
    Frame F;
    F.lds = (LAS unsigned char*)lds_raw;
    F.tid = threadIdx.x; F.lane = F.tid & 63; F.wave = __builtin_amdgcn_readfirstlane(F.tid >> 6); F.G = gridDim.x; F.skip = 0;
    F.x = args.in[0]; F.c = args.in[1]; F.w_ada = args.in[2]; F.b_ada = args.in[3]; F.g1 = args.in[4]; F.g2 = args.in[5]; F.w_in = args.in[6]; F.g_q = args.in[7]; F.g_k = args.in[8];
    F.conv_w = args.in[9]; F.conv_b = args.in[10]; F.w_pa = args.in[11]; F.w_pb = args.in[12]; F.w_o = args.in[13]; F.w_rg = args.in[14]; F.b_rg = args.in[15]; F.w_re = args.in[16]; F.b_re = args.in[17];
    F.w1 = args.in[18]; F.w3 = args.in[19]; F.w2 = args.in[20]; F.out = args.out; F.ws = args.ws;
    volatile LAS unsigned* MISC = (volatile LAS unsigned*)(F.lds + MISC_OFF);
    if (F.tid < 64) MISC[F.tid] = 0u;
    __syncthreads();
    XcdBarrier bar = xcd_barrier_post((unsigned*)(F.ws + WS_CTL) + CW_BAR, MISC + 8);
    const int lo = args.ph_lo, hi = args.ph_hi;
    unsigned long long pst0 = 0, pst1 = 0;
#define PHASE(k, body) if (lo <= (k) && (k) < hi) { if (PROBE_PHASE == (k)) pst0 = __builtin_amdgcn_s_memrealtime(); for (int rep_ = 0; rep_ < 1 + ((REPEAT_MASK >> (k)) & 1); ++rep_) { { int t_ = threadIdx.x; asm volatile("" : "+v"(t_)); F.tid = t_; F.lane = t_ & 63; } body; __syncthreads(); } if ((NOEPI_MASK >> (k)) & 1) { int s_ = 1; asm volatile("" : "+s"(s_)); F.skip = s_; { int t_ = threadIdx.x; asm volatile("" : "+v"(t_)); F.tid = t_; F.lane = t_ & 63; } body; __syncthreads(); F.skip = 0; } if ((k) + 1 < hi) xcd_barrier(bar); if (PROBE_PHASE == (k)) pst1 = __builtin_amdgcn_s_memrealtime(); }
    PHASE(0, s0_prologue(F); wait_mod(F); s1_norm1(F))
    PHASE(2, s2_fast(F))
    PHASE(3, s3_fast(F, (char*)lds_raw))
    PHASE(4, s4_fast(F))
    PHASE(5, s5_fast(F))
    PHASE(6, s6_router(F))
    PHASE(8, s8_fast(F))
    PHASE(9, s9_fast(F))
    PHASE(10, s10_combine(F))
#undef PHASE
    if (PROBE_PHASE >= 0 && blockIdx.x == 0) { const unsigned long long t0 = __builtin_amdgcn_s_memrealtime(), dt = pst1 - pst0; while (__builtin_amdgcn_s_memrealtime() - t0 < dt) __builtin_amdgcn_s_sleep(8); }
}

extern "C" void kernel_launch(void* const* d_in, const int* in_sizes, int n_in, void* d_out, int out_size, void* d_ws, size_t ws_size, hipStream_t stream) {
    static int grid = 0;
    if (grid == 0) {
        if (n_in != 21 || in_sizes[0] != T * D || out_size != T * D || ws_size < WS_END) { fprintf(stderr, "kernel_launch: unexpected shapes (n_in %d, in0 %d, out %d, ws %zu); nothing launched\n", n_in, n_in > 0 ? in_sizes[0] : -1, out_size, ws_size); grid = -1; return; }
        int dev = 0, cus = 0, per_cu = 0;
        if (hipGetDevice(&dev) != hipSuccess || hipDeviceGetAttribute(&cus, hipDeviceAttributeMultiprocessorCount, dev) != hipSuccess) { grid = -1; return; }
        if (hipFuncSetAttribute((const void*)mega_fwd, hipFuncAttributeMaxDynamicSharedMemorySize, LDS_BYTES) != hipSuccess) { fprintf(stderr, "kernel_launch: hipFuncSetAttribute failed\n"); grid = -1; return; }
        if (hipOccupancyMaxActiveBlocksPerMultiprocessor(&per_cu, (const void*)mega_fwd, NTHREADS, LDS_BYTES) != hipSuccess || per_cu < 1) { fprintf(stderr, "kernel_launch: occupancy query says %d blocks per CU\n", per_cu); per_cu = 1; }
        (void)hipGetLastError();
        if (cus < 256) { fprintf(stderr, "kernel_launch: built for a 256-CU device, found %d CUs; nothing launched\n", cus); grid = -1; return; }
        grid = 256;
    }
    if (grid < 0) return;
    (void)hipMemsetAsync((char*)d_ws + WS_CTL, 0, CTL_ZERO_BYTES, stream);
    Args a{};
    for (int i = 0; i < 21; ++i) a.in[i] = (const float*)d_in[i];
    a.out = (float*)d_out; a.ws = (unsigned char*)d_ws; a.ph_lo = 0; a.ph_hi = N_PHASES;
    hipLaunchKernelGGL(mega_fwd, dim3(grid), dim3(NTHREADS), LDS_BYTES, stream, a);
}
```

```cpp
#include <hip/hip_runtime.h>
#include <hip/hip_bf16.h>
#include <cstdio>
#include <cstdint>

#ifndef REPEAT_MASK
#define REPEAT_MASK 0
#define NOEPI_MASK 0
#endif
#ifndef PROBE_PHASE
#define PROBE_PHASE -1
#endif
#define GAS __attribute__((address_space(1)))
#define LAS __attribute__((address_space(3)))
typedef unsigned short bf16_t;
typedef short bf16x8 __attribute__((ext_vector_type(8)));
typedef float f32x4 __attribute__((ext_vector_type(4)));
typedef unsigned u32x4 __attribute__((ext_vector_type(4)));
typedef unsigned u32x2 __attribute__((ext_vector_type(2)));

constexpr int T = 32768, D = 1024, NB = 8, S = 4096, NH = 8, DH = 64, NIN = 5120, NE = 32, DE = 512, NMOD = 6144;
constexpr int NTHREADS = 512, NWAVES = 8;
constexpr float EPS = 1e-6f;
constexpr float C2 = 0.125f * 1.4426950408889634f;
constexpr int MAX_MT = 288;
constexpr int NPAD = MAX_MT * 256;

constexpr size_t MiB = 1u << 20, KiB = 1024;
constexpr size_t WS_CTL = 0, CTL_ZERO_BYTES = 64 * KiB;
constexpr size_t WS_MOD = 1 * MiB;
constexpr size_t WS_ROPE = 1 * MiB + 256 * KiB;
constexpr size_t WS_KMEAN = 1 * MiB + 512 * KiB;
constexpr size_t WS_EID = 2 * MiB;
constexpr size_t WS_EW = 2 * MiB + 256 * KiB;
constexpr size_t WS_BCNT = 2 * MiB + 512 * KiB;
constexpr size_t WS_TILEE = 2 * MiB + 768 * KiB;
constexpr size_t WS_ATOK = 3 * MiB;
constexpr size_t WS_AINFO = 3 * MiB + 512 * KiB;
constexpr size_t WS_AW = 4 * MiB;
constexpr size_t WS_W36T = 5 * MiB;
constexpr size_t WS_WIN_T = 8 * MiB;
constexpr size_t WS_WIN8 = 14 * MiB;
constexpr size_t WS_H8 = 56 * MiB;
constexpr size_t WS_WP_T = 18 * MiB;
constexpr size_t WS_WO_T = 20 * MiB;
constexpr size_t WS_W13_T = 24 * MiB;
constexpr size_t WS_W2_T = 88 * MiB;
constexpr size_t WS_H = 120 * MiB;
constexpr size_t WS_YAB = 184 * MiB;
constexpr size_t WS_K = 248 * MiB;
constexpr size_t WS_V = 280 * MiB;
constexpr size_t WS_U = 312 * MiB;
constexpr size_t WS_BG = 344 * MiB;
constexpr size_t WS_GATES = 376 * MiB;
constexpr size_t WS_X1 = 184 * MiB;
constexpr size_t WS_H2 = 120 * MiB;
constexpr size_t WS_HID = 248 * MiB;
constexpr size_t WS_YSLOT = 320 * MiB;
constexpr size_t WS_LINFO = 448 * MiB;
constexpr size_t WS_LW = 456 * MiB;
constexpr size_t WS_END = 504 * MiB;
constexpr int CW_BAR = 4096, CW_MODCNT = 8192, CW_GCNT = 12288;

constexpr int LDS_BYTES = 159744;
constexpr int MISC_OFF = 147456;

__device__ __forceinline__ unsigned f2bf(float f) { unsigned u = __builtin_bit_cast(unsigned, f); return (u + 0x7fffu + ((u >> 16) & 1u)) >> 16; }
__device__ __forceinline__ float bf2f(unsigned h) { return __builtin_bit_cast(float, h << 16); }
typedef float f32x2_h __attribute__((ext_vector_type(2)));
typedef __bf16 bf16x2_h __attribute__((ext_vector_type(2)));
__device__ __forceinline__ unsigned pk2(float lo, float hi) { const f32x2_h v = {lo, hi}; return __builtin_bit_cast(unsigned, __builtin_convertvector(v, bf16x2_h)); }
__device__ __forceinline__ void unpack8(const u32x4 w, float (&v)[8]) {
    v[0] = bf2f(w.x & 0xffffu); v[1] = bf2f(w.x >> 16); v[2] = bf2f(w.y & 0xffffu); v[3] = bf2f(w.y >> 16);
    v[4] = bf2f(w.z & 0xffffu); v[5] = bf2f(w.z >> 16); v[6] = bf2f(w.w & 0xffffu); v[7] = bf2f(w.w >> 16);
}
__device__ __forceinline__ u32x4 pack8(const float (&v)[8]) { u32x4 w; w.x = pk2(v[0], v[1]); w.y = pk2(v[2], v[3]); w.z = pk2(v[4], v[5]); w.w = pk2(v[6], v[7]); return w; }
__device__ __forceinline__ u32x4 pack8v(const f32x4 a, const f32x4 b) { u32x4 w; w.x = pk2(a.x, a.y); w.y = pk2(a.z, a.w); w.z = pk2(b.x, b.y); w.w = pk2(b.z, b.w); return w; }
__device__ __forceinline__ void unpack8v(const u32x4 w, f32x4& a, f32x4& b) {
    a.x = bf2f(w.x & 0xffffu); a.y = bf2f(w.x >> 16); a.z = bf2f(w.y & 0xffffu); a.w = bf2f(w.y >> 16);
    b.x = bf2f(w.z & 0xffffu); b.y = bf2f(w.z >> 16); b.z = bf2f(w.w & 0xffffu); b.w = bf2f(w.w >> 16); }
#ifndef WT_STORES
#define WT_STORES 0
#define NT_STORES 1
#endif
__device__ __forceinline__ void st16(void* p, const u32x4 v) {
#if WT_STORES
    asm volatile("global_store_dwordx4 %0, %1, off sc1\n\ts_nop 1" :: "v"(p), "v"(v) : "memory");
#elif NT_STORES
    __builtin_nontemporal_store(v, (u32x4*)p);
#else
    *(u32x4*)p = v;
#endif
}
typedef int i32x8 __attribute__((ext_vector_type(8)));
__device__ __forceinline__ u32x2 pack8_fp8(const f32x4 a, const f32x4 b) {
    int lo = 0, hi = 0;
    lo = __builtin_amdgcn_cvt_pk_fp8_f32(a.x, a.y, lo, false); lo = __builtin_amdgcn_cvt_pk_fp8_f32(a.z, a.w, lo, true);
    hi = __builtin_amdgcn_cvt_pk_fp8_f32(b.x, b.y, hi, false); hi = __builtin_amdgcn_cvt_pk_fp8_f32(b.z, b.w, hi, true);
    return (u32x2){(unsigned)lo, (unsigned)hi};
}
constexpr float W8_SCALE = 64.f;
#define LDS_WAIT() asm volatile("s_waitcnt lgkmcnt(0)" ::: "memory")
__device__ __forceinline__ int lds_add(LAS int* p, int v) { return __hip_atomic_fetch_add(p, v, __ATOMIC_RELAXED, __HIP_MEMORY_SCOPE_WORKGROUP); }

#define XB_TMO      128
#define XB_XCNT(j)  (256  + 64 * (j))
#define XB_XSUB(j)  (1280 + 64 * (j))
#define XB_XGEN(j)  (2304 + 64 * (j))
#define XB_TOP      3328
#define XB_TOPGEN   3392
#define XCD_BAR_WORDS 3456
#define XB_SPIN_CAP (1u << 22)
__device__ __forceinline__ unsigned xb_ld(unsigned* p)              { return __hip_atomic_load(p, __ATOMIC_RELAXED, __HIP_MEMORY_SCOPE_AGENT); }
__device__ __forceinline__ unsigned xb_add(unsigned* p, unsigned v) { return __hip_atomic_fetch_add(p, v, __ATOMIC_RELAXED, __HIP_MEMORY_SCOPE_AGENT); }
__device__ __forceinline__ unsigned xb_xcc_id() { return (unsigned)__builtin_amdgcn_s_getreg((3 << 11) | 20) & 0xFu; }
#define XB_SPIN(cond, bar) do { unsigned _sp = 0; while (cond) { __builtin_amdgcn_s_sleep(1); \
    if ((++_sp & 255u) == 0u) { if (xb_ld(&(bar)[XB_TMO])) break; if (_sp > XB_SPIN_CAP) { atomicAdd(&(bar)[XB_TMO], 1u); break; } } } } while (0)
struct XcdBarrier { unsigned* bar; unsigned x; volatile LAS unsigned* st; };
__device__ __forceinline__ XcdBarrier xcd_barrier_post(unsigned* bar, volatile LAS unsigned* st) {
    XcdBarrier b; b.bar = bar; b.x = xb_xcc_id(); b.st = st;
    if (threadIdx.x == 0) (void)xb_add(&bar[XB_XCNT(b.x)], 1u);
    return b;
}
__device__ __forceinline__ void xcd_barrier_complete(unsigned* bar, unsigned x, unsigned& nloc, unsigned& nx) {
    const unsigned G = gridDim.x * gridDim.y * gridDim.z;
    unsigned sum, cnt, mine, sp = 0u;
    for (;;) {
        sum = 0u; cnt = 0u; mine = 0u;
#pragma unroll
        for (unsigned j = 0; j < 16; ++j) { const unsigned c = xb_ld(&bar[XB_XCNT(j)]); sum += c; cnt += (c > 0u) ? 1u : 0u; mine = (j == x) ? c : mine; }
        if (sum == G) break;
        __builtin_amdgcn_s_sleep(1);
        if ((++sp & 255u) == 0u) { if (xb_ld(&bar[XB_TMO])) break; if (sp > XB_SPIN_CAP) { atomicAdd(&bar[XB_TMO], 1u); break; } }
    }
    nloc = mine > 0u ? mine : 1u; nx = cnt > 0u ? cnt : 1u;
}
__device__ __forceinline__ void xcd_barrier(const XcdBarrier& b) {
    asm volatile("s_waitcnt vmcnt(0)" ::: "memory");
    __syncthreads();
    if (threadIdx.x == 0) {
        unsigned* bar = b.bar;
        __builtin_amdgcn_s_waitcnt(0);
        unsigned nloc = b.st[0], nx = b.st[1];
        if (nloc == 0u) { xcd_barrier_complete(bar, b.x, nloc, nx); b.st[0] = nloc; b.st[1] = nx; }
        const unsigned old = xb_add(&bar[XB_XSUB(b.x)], 1u);
        const unsigned gen = old / nloc;
        if (old + 1u == (gen + 1u) * nloc) {
            __builtin_amdgcn_fence(__ATOMIC_RELEASE, "agent");
            asm volatile("s_waitcnt vmcnt(0)" ::: "memory");
            const unsigned og = xb_add(&bar[XB_TOP], 1u);
            const unsigned tg = og / nx;
            if (og + 1u == (tg + 1u) * nx) xb_add(&bar[XB_TOPGEN], 1u);
            else XB_SPIN(xb_ld(&bar[XB_TOPGEN]) == tg, bar);
            __builtin_amdgcn_fence(__ATOMIC_ACQUIRE, "agent");
            xb_add(&bar[XB_XGEN(b.x)], 1u);
            asm volatile("s_waitcnt vmcnt(0)" ::: "memory");
        } else {
            XB_SPIN(xb_ld(&bar[XB_XGEN(b.x)]) == gen, bar);
            __builtin_amdgcn_fence(__ATOMIC_ACQUIRE, "agent");
            asm volatile("s_waitcnt vmcnt(0)" ::: "memory");
        }
    }
    __syncthreads();
}

struct Frame {
    LAS unsigned char* lds;
    int tid, lane, wave, G, skip;
    const float *x, *c, *w_ada, *b_ada, *g1, *g2, *w_in, *g_q, *g_k, *conv_w, *conv_b, *w_pa, *w_pb, *w_o, *w_rg, *b_rg, *w_re, *b_re, *w1, *w3, *w2;
    float* out; unsigned char* ws;
};
#define WSP(type, off) ((type*)(F.ws + (off)))

struct XItem { const float* src; unsigned char* dst; int N, pitch, fp8, swz; };
__device__ __forceinline__ void xitem_load(const XItem& it, f32x4 (&v)[8], int lane) {
    const int r8 = lane >> 3, c4 = lane & 7;
#pragma unroll
    for (int i = 0; i < 8; ++i) v[i] = __builtin_nontemporal_load((const f32x4*)(it.src + (size_t)(8 * i + r8) * it.N + 4 * c4));
}
__device__ __forceinline__ void xitem_store(const XItem& it, const f32x4 (&v)[8], LAS float* scr, int lane) {
    const int r8 = lane >> 3, c4 = lane & 7; const float scale = it.fp8 ? W8_SCALE : 1.f;
#pragma unroll
    for (int i = 0; i < 8; ++i) { LAS float* p = scr + (8 * i + r8) * 33 + 4 * c4; p[0] = v[i].x * scale; p[1] = v[i].y * scale; p[2] = v[i].z * scale; p[3] = v[i].w * scale; }
    LDS_WAIT(); asm volatile("" ::: "memory");
    if (it.fp8) {
        const int n = lane >> 1, kh = lane & 1; const LAS float* sp = scr + (32 * kh) * 33 + n;
#pragma unroll
        for (int p = 0; p < 2; ++p) { u32x4 o;
#pragma unroll
            for (int w = 0; w < 4; ++w) { const LAS float* q = sp + (16 * p + 4 * w) * 33; int x = 0;
                x = __builtin_amdgcn_cvt_pk_fp8_f32(q[0], q[33], x, false); x = __builtin_amdgcn_cvt_pk_fp8_f32(q[66], q[99], x, true); o[w] = (unsigned)x; }
            *(u32x4*)(it.dst + (size_t)n * it.pitch + 32 * kh + 16 * p) = o; }
    } else {
        const int c = lane & 7;
#pragma unroll
        for (int j = 0; j < 4; ++j) { const int n = (lane >> 3) + 8 * j; const LAS float* q = scr + (8 * c) * 33 + n;
            u32x4 o; o.x = pk2(q[0 * 33], q[1 * 33]); o.y = pk2(q[2 * 33], q[3 * 33]); o.z = pk2(q[4 * 33], q[5 * 33]); o.w = pk2(q[6 * 33], q[7 * 33]);
            const int nd = (it.swz && ((n >> 2) == 1 || (n >> 2) == 2)) ? (n ^ 12) : n;
            *(u32x4*)(it.dst + ((size_t)nd * it.pitch + 8 * c) * 2) = o; }
    }
    LDS_WAIT(); asm volatile("" ::: "memory");
}
__device__ __forceinline__ int win_dest_row(int sc) {
    if (sc < 32) { const int isk = sc >> 4, s2 = sc & 15, hh = s2 >> 1, bj = s2 & 1; return 512 * isk + 256 * (hh >> 2) + 128 * bj + 32 * (hh & 3); }
    if (sc < 48) return 0;
    if (sc < 64) { const int cx = 32 * (sc - 48); return 256 * (4 + (cx >> 7)) + (cx & 127); }
    if (sc < 80) return 2048 + 32 * (sc - 64);
    if (sc < 96) { const int cx = 32 * (sc - 80); return 256 * (4 + (cx >> 7)) + 128 + (cx & 127); }
    return 3072 + 32 * (sc - 96);
}
constexpr int X_NONEXP = 16 * 160 + 2 * (8 * 32) + 16 * 32, X_W2 = X_NONEXP + NE * 512, X_END = X_W2 + NE * 256;
__device__ __forceinline__ void convert_items(Frame& F, const int item_lo, const int item_hi, const int gw, const int NGW) {
    LAS float* scr = (LAS float*)(F.lds + F.wave * 16384);
    constexpr int I_IN = 16 * 160, I_PA = 8 * 32, I_O = 16 * 32, I_E1 = 16 * 16, I_E2 = 8 * 32;
    constexpr int NITEMS = I_IN + 2 * I_PA + I_O + NE * (2 * I_E1 + I_E2);
    auto decode = [&](int r) -> XItem {
        XItem x; x.swz = 0;
        if (r < I_IN) { const int kb = r / 160, sc = r % 160; x.src = F.w_in + (size_t)(64 * kb) * NIN + 32 * sc; x.N = NIN; x.pitch = 1024; x.swz = (sc < 32 && !(sc & 1)) ? 1 : 0;
            if (sc < 96 && !(sc >= 32 && sc < 48)) { x.fp8 = 0; x.dst = (unsigned char*)(WSP(bf16_t, WS_WIN_T) + (size_t)win_dest_row(sc) * 1024 + 64 * kb); }
            else { x.fp8 = 1; const int g = 32 * (sc - 96), cx = g & 1023;
                x.dst = WSP(unsigned char, WS_WIN8) + (size_t)(sc >= 96 ? 256 * (cx >> 7) + (g >= 1024 ? 128 : 0) + (cx & 127) : 2048 + 32 * (sc - 32)) * 1024 + 64 * kb; }
            return x; } r -= I_IN;
        if (r < I_PA) { const int kb = r / 32, sc = r % 32; x.src = F.w_pa + (size_t)(64 * kb) * 1024 + 32 * sc; x.N = 1024; x.pitch = 1024; x.fp8 = 0; x.dst = (unsigned char*)(WSP(bf16_t, WS_WP_T) + (size_t)(32 * sc) * 1024 + 64 * kb); return x; } r -= I_PA;
        if (r < I_PA) { const int kb = r / 32, sc = r % 32; x.src = F.w_pb + (size_t)(64 * kb) * 1024 + 32 * sc; x.N = 1024; x.pitch = 1024; x.fp8 = 0; x.dst = (unsigned char*)(WSP(bf16_t, WS_WP_T) + (size_t)(32 * sc) * 1024 + 512 + 64 * kb); return x; } r -= I_PA;
        if (r < I_O) { const int kb = r / 32, sc = r % 32; x.src = F.w_o + (size_t)(64 * kb) * 1024 + 32 * sc; x.N = 1024; x.pitch = 1024; x.fp8 = 1; x.dst = WSP(unsigned char, WS_WO_T) + (size_t)(32 * sc) * 1024 + 64 * kb; return x; } r -= I_O;
        x.fp8 = 1;
        if (r < NE * 2 * I_E1) { const int e = r / (2 * I_E1); r -= e * (2 * I_E1); const int is3 = r >= I_E1; if (is3) r -= I_E1; const int kb = r / 16, sc = r % 16;
            x.src = (is3 ? F.w3 : F.w1) + (size_t)e * D * DE + (size_t)(64 * kb) * DE + 32 * sc; x.N = DE; x.pitch = 1024;
            x.dst = WSP(unsigned char, WS_W13_T) + ((size_t)e * 1024 + 256 * (sc >> 2) + 128 * is3 + 32 * (sc & 3)) * 1024 + 64 * kb; return x; }
        r -= NE * 2 * I_E1;
        { const int e = r / I_E2; r -= e * I_E2; const int kb = r / 32, sc = r % 32;
            x.src = F.w2 + (size_t)e * DE * D + (size_t)(64 * kb) * D + 32 * sc; x.N = D; x.pitch = 512; x.dst = WSP(unsigned char, WS_W2_T) + ((size_t)e * 1024 + 32 * sc) * 512 + 64 * kb; }
        return x;
    };
    const int ihi = (item_hi < NITEMS) ? item_hi : NITEMS;
    if (item_lo + gw < ihi) {
        XItem cur = decode(item_lo + gw); f32x4 va[8], vb[8]; xitem_load(cur, va, F.lane);
        for (int it = item_lo + gw; it < ihi; it += 2 * NGW) {
            const int n1 = it + NGW, n2 = it + 2 * NGW; XItem nx1 = cur, nx2 = cur;
            if (n1 < ihi) { nx1 = decode(n1); xitem_load(nx1, vb, F.lane); }
            xitem_store(cur, va, scr, F.lane);
            if (n1 < ihi) { if (n2 < ihi) { nx2 = decode(n2); xitem_load(nx2, va, F.lane); }
                xitem_store(nx1, vb, scr, F.lane); cur = nx2; }
        }
    }
}

__device__ __forceinline__ void s0_prologue(Frame& F) {
    if (F.tid < 256) WSP(float, WS_KMEAN)[blockIdx.x * 256 + F.tid] = 0.f;
    if (F.tid < 144) { const int gt = blockIdx.x * 144 + F.tid; const int jj = gt >> 10, k = gt & 1023; WSP(float, WS_W36T)[gt] = (jj < 4) ? F.w_rg[k * 4 + jj] : F.w_re[k * 32 + (jj - 4)]; }
    if (F.tid < 128) { const int gt = blockIdx.x * 128 + F.tid; const int pos = gt >> 3, i = gt & 7; const float inv = powf(500000.0f, -(float)(2 * i) / 16.0f); const float ang = (float)pos * inv;
        WSP(float2, WS_ROPE)[gt] = make_float2(cosf(ang), sinf(ang)); }
    if (blockIdx.x < 192) {
        LAS float* sc = (LAS float*)F.lds;
        for (int i = F.tid; i < NB * D; i += NTHREADS) { const float v = F.c[i]; sc[i] = v / (1.f + expf(-v)); }
        __syncthreads();
        const int j0 = blockIdx.x * 32, col = j0 + (F.lane & 31), kpar = F.lane >> 5;
        float acc[8];
#pragma unroll
        for (int b = 0; b < 8; ++b) acc[b] = 0.f;
#pragma unroll
        for (int i0 = 0; i0 < 64; i0 += 32) { float wv[32];
#pragma unroll
            for (int i = 0; i < 32; ++i) wv[i] = F.w_ada[(size_t)(F.wave * 128 + 2 * (i0 + i) + kpar) * NMOD + col];
#pragma unroll
            for (int i = 0; i < 32; ++i) { const int k = F.wave * 128 + 2 * (i0 + i) + kpar;
#pragma unroll
                for (int b = 0; b < 8; ++b) acc[b] += sc[b * D + k] * wv[i]; } }
#pragma unroll
        for (int b = 0; b < 8; ++b) acc[b] += __shfl_xor(acc[b], 32);
        LAS float* red = (LAS float*)(F.lds + 32768);
        if (F.lane < 32) {
#pragma unroll
            for (int b = 0; b < 8; ++b) red[(F.wave * 8 + b) * 32 + F.lane] = acc[b]; }
        __syncthreads();
        if (F.tid < 256) { const int b = F.tid >> 5, cc = F.tid & 31; float s = F.b_ada[j0 + cc];
#pragma unroll
            for (int w = 0; w < 8; ++w) s += red[(w * 8 + b) * 32 + cc];
            WSP(float, WS_MOD)[b * NMOD + j0 + cc] = s; }
        asm volatile("s_waitcnt vmcnt(0)" ::: "memory");
        __syncthreads();
        if (F.tid == 0) { __builtin_amdgcn_fence(__ATOMIC_RELEASE, "agent"); asm volatile("s_waitcnt vmcnt(0)" ::: "memory");
            __hip_atomic_fetch_add(WSP(unsigned, WS_CTL) + CW_MODCNT, 1u, __ATOMIC_RELAXED, __HIP_MEMORY_SCOPE_AGENT); }
    }
    convert_items(F, 0, X_NONEXP, F.G * NWAVES - 1 - (blockIdx.x * NWAVES + F.wave), F.G * NWAVES);
}

__device__ __forceinline__ void wait_mod(Frame& F) {
    if (F.tid == 0) { unsigned* c = WSP(unsigned, WS_CTL) + CW_MODCNT; unsigned sp = 0;
        while (__hip_atomic_load(c, __ATOMIC_RELAXED, __HIP_MEMORY_SCOPE_AGENT) < 192u) { __builtin_amdgcn_s_sleep(2); if (++sp > (1u << 24)) break; }
        __builtin_amdgcn_fence(__ATOMIC_ACQUIRE, "agent"); asm volatile("s_waitcnt vmcnt(0)" ::: "memory"); }
    __syncthreads();
}
template <int N> __device__ __forceinline__ float dpp_ror(float v) { return __builtin_bit_cast(float, __builtin_amdgcn_update_dpp(0, __builtin_bit_cast(int, v), 0x120 + N, 0xF, 0xF, false)); }
__device__ __forceinline__ float xrow16_sum(float x) {
    float a = x, b = x;
    asm volatile("s_nop 1\n\tv_permlane16_swap_b32 %0, %1" : "+v"(a), "+v"(b));
    a += b; b = a;
    asm volatile("s_nop 1\n\tv_permlane32_swap_b32 %0, %1" : "+v"(a), "+v"(b));
    return a + b;
}
__device__ __forceinline__ float wave_sum(float v) {
#pragma unroll
    for (int o = 1; o < 64; o <<= 1) v += __shfl_xor(v, o);
    return v;
}
__device__ __forceinline__ void s1_norm1(Frame& F) {
    const int gw = blockIdx.x * NWAVES + F.wave;
    const int row0 = gw * 16, b = row0 / S;
    if (row0 >= T) return;
    const float* mod = WSP(float, WS_MOD) + (size_t)b * NMOD;
    f32x4 gs[4], sh[4];
#pragma unroll
    for (int j = 0; j < 4; ++j) { const int col = 4 * F.lane + 256 * j; const f32x4 g = *(const f32x4*)(F.g1 + col), s_ = *(const f32x4*)(mod + 1024 + col); gs[j] = g * (s_ + 1.0f); sh[j] = *(const f32x4*)(mod + col); }
    for (int r = 0; r < 16; r += 4) {
        f32x4 v[4][4]; float ss[4];
#pragma unroll
        for (int q = 0; q < 4; ++q) { const float* xr = F.x + (size_t)(row0 + r + q) * D;
#pragma unroll
            for (int j = 0; j < 4; ++j) v[q][j] = __builtin_nontemporal_load((const f32x4*)(xr + 4 * F.lane + 256 * j)); }
#pragma unroll
        for (int q = 0; q < 4; ++q) { ss[q] = 0.f;
#pragma unroll
            for (int j = 0; j < 4; ++j) ss[q] += (v[q][j].x * v[q][j].x + v[q][j].y * v[q][j].y) + (v[q][j].z * v[q][j].z + v[q][j].w * v[q][j].w); }
#pragma unroll
        for (int q = 0; q < 4; ++q) { const float rinv = rsqrtf(wave_sum(ss[q]) * (1.f / D) + EPS);
            bf16_t* o = WSP(bf16_t, WS_H) + (size_t)(row0 + r + q) * D;
#pragma unroll
            for (int j = 0; j < 4; ++j) { const f32x4 h = v[q][j] * rinv * gs[j] + sh[j]; u32x2 w; w.x = pk2(h.x, h.y); w.y = pk2(h.z, h.w); *(u32x2*)(o + 4 * F.lane + 256 * j) = w;
                int p8 = 0; p8 = __builtin_amdgcn_cvt_pk_fp8_f32(h.x, h.y, p8, false); p8 = __builtin_amdgcn_cvt_pk_fp8_f32(h.z, h.w, p8, true);
                *(int*)(WSP(unsigned char, WS_H8) + (size_t)(row0 + r + q) * D + 4 * F.lane + 256 * j) = p8; } }
    }
}

struct RowsLinear { const bf16_t* base; size_t pitch; __device__ __forceinline__ const bf16_t* operator()(int r) const { return base + (size_t)r * pitch; } };
template <class AR, class BR>
__device__ __forceinline__ void sgemm_tile(LAS float* tile, int K, const AR& arow, const BR& brow, int wave, int lane) {
    const int fr = lane & 15, fq = lane >> 4, rb = 16 * (wave & 3), cb = 32 * (wave >> 2);
    const bf16_t* ap = arow(rb + fr) + 8 * fq;
    const bf16_t* bp0 = brow(cb + fr) + 8 * fq;
    const bf16_t* bp1 = brow(cb + 16 + fr) + 8 * fq;
    f32x4 acc0 = {0.f, 0.f, 0.f, 0.f}, acc1 = {0.f, 0.f, 0.f, 0.f};
#pragma unroll 4
    for (int k = 0; k < K; k += 32) {
        const bf16x8 a = *(const bf16x8*)(ap + k), b0 = *(const bf16x8*)(bp0 + k), b1 = *(const bf16x8*)(bp1 + k);
        acc0 = __builtin_amdgcn_mfma_f32_16x16x32_bf16(a, b0, acc0, 0, 0, 0);
        acc1 = __builtin_amdgcn_mfma_f32_16x16x32_bf16(a, b1, acc1, 0, 0, 0);
    }
#pragma unroll
    for (int j = 0; j < 4; ++j) { tile[(rb + fq * 4 + j) * 65 + cb + fr] = acc0[j]; tile[(rb + fq * 4 + j) * 65 + cb + 16 + fr] = acc1[j]; }
}

struct WinRowsHead { const bf16_t* base; int rb; __device__ __forceinline__ const bf16_t* operator()(int d) const { return base + (size_t)(rb + 128 * (d >> 5) + (d & 31)) * 1024; } };
__device__ __forceinline__ void s2_simple(Frame& F) {
    LAS float* tile = (LAS float*)F.lds; LAS float* tile2 = tile + 64 * 65;
    const bf16_t* H = WSP(bf16_t, WS_H); const bf16_t* WT = WSP(bf16_t, WS_WIN_T);
    const int row = F.tid >> 3, seg = F.tid & 7;
    for (int it = blockIdx.x; it < 512 * 72; it += F.G) {
        const int rt = it / 72, ct = it % 72, r0 = rt * 64, gr = r0 + row;
        const RowsLinear ar{H + (size_t)r0 * 1024, 1024};
        float v[8];
        if (ct < 16) {
            const int isk = ct >> 3, hh = ct & 7;
            const WinRowsHead br{WT, 512 * isk + 256 * (hh >> 2) + 32 * (hh & 3)};
            sgemm_tile(tile, 1024, ar, br, F.wave, F.lane); __syncthreads();
            float ss = 0.f;
#pragma unroll
            for (int e = 0; e < 8; ++e) { v[e] = tile[row * 65 + 8 * seg + e]; ss += v[e] * v[e]; }
            ss += __shfl_xor(ss, 1); ss += __shfl_xor(ss, 2); ss += __shfl_xor(ss, 4);
            const float rinv = rsqrtf(ss * (1.f / 64.f) + EPS);
            const float* g = isk ? F.g_k : F.g_q;
            const int pos = gr & (S - 1);
#pragma unroll
            for (int e = 0; e < 8; ++e) { v[e] = v[e] * rinv * g[8 * seg + e]; const float pv = __shfl_xor(v[e], 1);
                if (seg < 2) { const float2 cs = WSP(float2, WS_ROPE)[pos * 8 + e]; v[e] = (seg == 0) ? (v[e] * cs.x - pv * cs.y) : (v[e] * cs.x + pv * cs.y); } }
            if (!isk) {
#pragma unroll
                for (int e = 0; e < 8; ++e) v[e] *= C2;
                *(u32x4*)(WSP(bf16_t, WS_YAB) + (size_t)gr * 1024 + hh * 64 + 8 * seg) = pack8(v);
            } else {
                *(u32x4*)(WSP(bf16_t, WS_K) + (size_t)gr * 512 + hh * 64 + 8 * seg) = pack8(v);
#pragma unroll
                for (int e = 0; e < 8; ++e) tile[row * 65 + 8 * seg + e] = v[e];
                __syncthreads();
                if (F.tid < 64) { float s = 0.f; for (int r = 0; r < 64; ++r) s += tile[r * 65 + F.tid];
                    const int b = r0 / S, blk = (r0 & (S - 1)) >> 8;
                    atomicAdd(WSP(float, WS_KMEAN) + ((size_t)(b * NH + hh) * 16 + blk) * 64 + F.tid, s * (1.f / 256.f)); }
            }
        } else if (ct < 24) {
            const RowsLinear br{WT + (size_t)(1024 + 64 * (ct - 16)) * 1024, 1024};
            sgemm_tile(tile, 1024, ar, br, F.wave, F.lane); __syncthreads();
#pragma unroll
            for (int e = 0; e < 8; ++e) v[e] = tile[row * 65 + 8 * seg + e];
            *(u32x4*)(WSP(bf16_t, WS_V) + (size_t)gr * 512 + 64 * (ct - 16) + 8 * seg) = pack8(v);
        } else if (ct < 32) {
            const int cu = 64 * (ct - 24), rb = 256 * (6 + (cu >> 7)) + (cu & 127);
            const RowsLinear bx{WT + (size_t)rb * 1024, 1024}, bc{WT + (size_t)(rb + 128) * 1024, 1024};
            sgemm_tile(tile, 1024, ar, bx, F.wave, F.lane); sgemm_tile(tile2, 1024, ar, bc, F.wave, F.lane); __syncthreads();
#pragma unroll
            for (int e = 0; e < 8; ++e) v[e] = tile[row * 65 + 8 * seg + e] * tile2[row * 65 + 8 * seg + e];
            *(u32x4*)(WSP(bf16_t, WS_U) + (size_t)gr * 512 + cu + 8 * seg) = pack8(v);
        } else if (ct < 40) {
            const RowsLinear br{WT + (size_t)(2560 + 64 * (ct - 32)) * 1024, 1024};
            sgemm_tile(tile, 1024, ar, br, F.wave, F.lane); __syncthreads();
#pragma unroll
            for (int e = 0; e < 8; ++e) v[e] = tile[row * 65 + 8 * seg + e];
            *(u32x4*)(WSP(bf16_t, WS_BG) + (size_t)gr * 512 + 64 * (ct - 32) + 8 * seg) = pack8(v);
        } else {
            const RowsLinear br{WT + (size_t)(3072 + 64 * (ct - 40)) * 1024, 1024};
            sgemm_tile(tile, 1024, ar, br, F.wave, F.lane); __syncthreads();
#pragma unroll
            for (int e = 0; e < 8; ++e) v[e] = 1.f / (1.f + __expf(-tile[row * 65 + 8 * seg + e]));
            *(u32x4*)(WSP(bf16_t, WS_GATES) + (size_t)gr * 2048 + 64 * (ct - 40) + 8 * seg) = pack8(v);
        }
        __syncthreads();
    }
}

namespace pg8 {
constexpr int BM = 256, BK = 64, HALF = 128, HTB = HALF * BK * 2, STAGE_BYTES = 8 * HTB, NXCD = 8, WGM = 4;
constexpr int VN_STASH = 147456 + 4096;
__device__ __forceinline__ int lds_byte(int r, int c) { const int st = (r >> 4) * 2 + (c >> 5), rr = r & 15, cc = c & 31, ob = rr * 64 + cc * 2; return st * 1024 + (ob ^ (((ob >> 9) & 1) << 5)); }
__device__ __forceinline__ void stage_rc(int b, int& R, int& C) { const int st = b / 1024, sb = b % 1024, swz = sb ^ (((sb >> 9) & 1) << 5); R = (st >> 1) * 16 + swz / 64; C = (st & 1) * 32 + (swz % 64) / 2; }
__device__ __forceinline__ int perm32(int rho) { const int n = rho >> 4, i = rho & 15; return 8 * (i >> 2) + 4 * n + (i & 3); }
struct Unit { int pm, pn; const char* a; const char* b; int e, rbase; };
__device__ __forceinline__ bool static_unit(int i, int G, int c, int nM, int nN, int& pm, int& pn) {
    const int nwg = nM * nN; const long L = (long)i * G + c; if (L >= nwg) return false;
    int wgid = (int)L; { const int q = nwg / NXCD, r = nwg % NXCD, xcd = wgid % NXCD, off = wgid / NXCD; wgid = (xcd < r ? xcd * (q + 1) : r * (q + 1) + (xcd - r) * q) + off; }
    const int nig = WGM * nN, gid = wgid / nig, fm = gid * WGM, gsz = (nM - fm) < WGM ? (nM - fm) : WGM;
    pm = fm + ((wgid % nig) % gsz); pn = (wgid % nig) / gsz; return true;
}
struct DenseSched {
    static constexpr bool GATHER = false, FP8 = false;
    const char* A; const char* Bt; int nM, nN, K, G, c;
    __device__ __forceinline__ bool next(int i, Unit& u) const { if (!static_unit(i, G, c, nM, nN, u.pm, u.pn)) return false;
        u.a = A + (size_t)u.pm * BM * K * 2; u.b = Bt + (size_t)u.pn * BM * K * 2; u.e = 0; u.rbase = 0; return true; }
    __device__ __forceinline__ int row_index(const Unit&, int) const { return 0; }
};

struct DenseSched8 {
    static constexpr bool GATHER = false, FP8 = true;
    const char* A; const char* Bt; int nM, nN, K, G, c;
    __device__ __forceinline__ bool next(int i, Unit& u) const { if (!static_unit(i, G, c, nM, nN, u.pm, u.pn)) return false;
        u.a = A + (size_t)u.pm * BM * K; u.b = Bt + (size_t)u.pn * BM * K; u.e = 0; u.rbase = 0; return true; }
    __device__ __forceinline__ int row_index(const Unit&, int) const { return 0; }
};
template <class Epi, class Sched, bool skip = false>
__device__ __forceinline__ void gemm_phase(LAS unsigned char* lds, const int K, const Sched& S, const Epi& E) {
    int tid_ = threadIdx.x; asm volatile("" : "+v"(tid_));
    const int tid = tid_, wid = __builtin_amdgcn_readfirstlane(tid >> 6), lane = tid & 63, wr = wid >> 2, wc = wid & 3, fr = lane & 15, fq = lane >> 4;
    constexpr bool FP8 = Sched::FP8;
    const int nt = FP8 ? K / 128 : K / BK;
    const int PB = FP8 ? K : 2 * K;
    unsigned voffB[2], vA[2][2], vN[2][2];
#pragma unroll
    for (int i = 0; i < 2; ++i) { int R, C; stage_rc(tid * 16 + i * 8192, R, C); const int Rb = (R & ~31) + perm32(R & 31);
        voffB[i] = (unsigned)(Rb * PB + C * 2);
        vA[0][i] = (unsigned)(R * PB + C * 2); vA[1][i] = (unsigned)((HALF + R) * PB + C * 2); vN[0][i] = vA[0][i]; vN[1][i] = vA[1][i]; }
    const size_t kstep = (size_t)(BK * 2);
    const size_t hstep = (size_t)HALF * PB;
    const unsigned ldsw = (unsigned)wid * 1024u;
    const int aoff = lds_byte(wr * 64 + fr, fq * 8), boff = lds_byte(wc * 32 + fr, fq * 8);
    const int aoff8a = lds_byte(wr * 64 + fr, fq * 16), aoff8b = lds_byte(wr * 64 + fr, fq * 16 + 8), boff8a = lds_byte(wc * 32 + fr, fq * 16), boff8b = lds_byte(wc * 32 + fr, fq * 16 + 8);
#define PG8_SA(b, h) (((b) * 2 + (h)) * HTB)
#define PG8_SB(b, h) ((4 + (b) * 2 + (h)) * HTB)
#define PG8_STAGE(bufoff, gbase, voff) do { _Pragma("unroll") for (int _i = 0; _i < 2; ++_i) \
        __builtin_amdgcn_global_load_lds((const unsigned*)((const char*)(gbase) + (voff)[_i]), (LAS unsigned*)(lds + (bufoff) + ldsw + _i * 8192), 16, 0, 0); } while (0)
#define PG8_LD16(off) (*(const LAS u32x4*)(lds + (off)))
#define PG8_LDA(dst, b, h) do { _Pragma("unroll") for (int m = 0; m < 4; ++m) { if constexpr (FP8) { dst##8[m] = __builtin_bit_cast(i32x8, __builtin_shufflevector(PG8_LD16(PG8_SA(b, h) + aoff8a + m * 2048), PG8_LD16(PG8_SA(b, h) + aoff8b + m * 2048), 0, 1, 2, 3, 4, 5, 6, 7)); } \
        else { _Pragma("unroll") for (int k = 0; k < 2; ++k) dst[m][k] = *(const LAS bf16x8*)(lds + PG8_SA(b, h) + aoff + m * 2048 + k * 1024); } } } while (0)
#define PG8_LDB(dst, b, h) do { _Pragma("unroll") for (int n = 0; n < 2; ++n) { if constexpr (FP8) { dst##8[n] = __builtin_bit_cast(i32x8, __builtin_shufflevector(PG8_LD16(PG8_SB(b, h) + boff8a + n * 2048), PG8_LD16(PG8_SB(b, h) + boff8b + n * 2048), 0, 1, 2, 3, 4, 5, 6, 7)); } \
        else { _Pragma("unroll") for (int k = 0; k < 2; ++k) dst[n][k] = *(const LAS bf16x8*)(lds + PG8_SB(b, h) + boff + n * 2048 + k * 1024); } } } while (0)
#define PG8_MMA(ai, bj, At, Bt) do { __builtin_amdgcn_s_setprio(1); _Pragma("unroll") for (int m = 0; m < 4; ++m) _Pragma("unroll") for (int n = 0; n < 2; ++n) { \
        if constexpr (FP8) { asm volatile("s_nop 1\n\tv_mfma_scale_f32_16x16x128_f8f6f4 %0, %1, %2, %0, %3, %3 op_sel_hi:[0,0,0]" : "+v"(acc[ai][bj][m][n]) : "v"(Bt##8[n]), "v"(At##8[m]), "v"(sc127)); } \
        else { _Pragma("unroll") for (int k = 0; k < 2; ++k) acc[ai][bj][m][n] = __builtin_amdgcn_mfma_f32_16x16x32_bf16(Bt[n][k], At[m][k], acc[ai][bj][m][n], 0, 0, 0); } } __builtin_amdgcn_s_setprio(0); } while (0)
#define PG8_WAIT_V(n) asm volatile("s_waitcnt vmcnt(" #n ")" ::: "memory")
#define PG8_WAIT_L(n) asm volatile("s_waitcnt lgkmcnt(" #n ")" ::: "memory")
#define PG8_BAR __builtin_amdgcn_s_barrier()
#define PG8_SCHED __builtin_amdgcn_sched_barrier(0)
#define PG8_AOFF(dst, u) do { int _t = threadIdx.x; asm volatile("" : "+v"(_t)); _Pragma("unroll") for (int _i = 0; _i < 2; ++_i) { int _R, _C; stage_rc(_t * 16 + _i * 8192, _R, _C); \
        _Pragma("unroll") for (int _h = 0; _h < 2; ++_h) dst[_h][_i] = (unsigned)(S.row_index(u, _h * HALF + _R) * PB + _C * 2); } } while (0)
    Unit cur, nxt; int ui = 0;
    if (!S.next(0, cur)) return;
    if constexpr (Sched::GATHER) PG8_AOFF(vA, cur);
    f32x4 acc[2][2][4][2];
#pragma unroll
    for (int a = 0; a < 2; ++a)
#pragma unroll
        for (int b = 0; b < 2; ++b)
#pragma unroll
            for (int m = 0; m < 4; ++m)
#pragma unroll
                for (int n = 0; n < 2; ++n) acc[a][b][m][n] = (f32x4){0.f, 0.f, 0.f, 0.f};
    const int sc127 = 127;
    bf16x8 At[4][2], B0[2][2], B1[2][2]; i32x8 At8[4], B08[2], B18[2];
    const char* cA = cur.a; const char* cB = cur.b;
    PG8_STAGE(PG8_SB(0, 0), cB, voffB); PG8_STAGE(PG8_SB(0, 1), cB + hstep, voffB); PG8_STAGE(PG8_SA(0, 0), cA, vA[0]); PG8_STAGE(PG8_SA(0, 1), cA, vA[1]);
    if (wr == 1) PG8_BAR;
    PG8_WAIT_V(2); PG8_BAR;
    PG8_STAGE(PG8_SB(1, 0), cB + kstep, voffB); PG8_STAGE(PG8_SA(1, 0), cA + kstep, vA[0]); PG8_STAGE(PG8_SB(1, 1), cB + hstep + kstep, voffB);
    PG8_WAIT_V(6); PG8_BAR;
    for (;;) {
        const bool has_next = S.next(ui + 1, nxt);
        const char* nA = has_next ? nxt.a : cA; const char* nB = has_next ? nxt.b : cB;
        if constexpr (Sched::GATHER) { if (has_next) PG8_AOFF(vN, nxt); else {
#pragma unroll
            for (int h = 0; h < 2; ++h)
#pragma unroll
                for (int i = 0; i < 2; ++i) vN[h][i] = vA[h][i]; }
            *(LAS u32x4*)(lds + VN_STASH + tid * 16) = (u32x4){vN[0][0], vN[0][1], vN[1][0], vN[1][1]}; }
        for (int hk = 0; hk < (Epi::HAS_MID ? 2 : 1); ++hk) {
        if constexpr (Epi::HAS_MID) { if (hk == 1 && !skip) E.mid(acc, cur, wr, wc, fr, fq); }
        const int tb = (Epi::HAS_MID && hk == 1) ? nt / 2 : 0, te = (Epi::HAS_MID && hk == 0) ? nt / 2 : nt;
#pragma unroll 1
        for (int t = tb; t < te; t += 2) {
            const bool last = (t == nt - 2);
            const char* a1 = cA + (size_t)(t + 1) * kstep;
            const char* a2 = last ? nA : cA + (size_t)(t + 2) * kstep; const char* b2 = last ? nB : cB + (size_t)(t + 2) * kstep;
            const char* a3 = a2 + kstep; const char* b3 = b2 + kstep;
            unsigned w0[2], w1[2];
#pragma unroll
            for (int i = 0; i < 2; ++i) { w0[i] = vA[0][i]; w1[i] = vA[1][i]; }
            if constexpr (Sched::GATHER) { if (last) { const u32x4 q = *(const LAS u32x4*)(lds + VN_STASH + tid * 16); w0[0] = q.x; w0[1] = q.y; w1[0] = q.z; w1[1] = q.w; } }
            PG8_LDB(B0, 0, 0); PG8_LDB(B1, 0, 1); PG8_SCHED; PG8_LDA(At, 0, 0); PG8_STAGE(PG8_SA(1, 1), a1, vA[1]);
            PG8_WAIT_V(8); PG8_WAIT_L(0); PG8_BAR; PG8_MMA(0, 0, At, B0); PG8_MMA(0, 1, At, B1); PG8_BAR; PG8_SCHED;
            PG8_LDA(At, 0, 1); PG8_STAGE(PG8_SB(0, 0), b2, voffB); PG8_STAGE(PG8_SB(0, 1), b2 + hstep, voffB); PG8_STAGE(PG8_SA(0, 0), a2, w0);
            PG8_WAIT_V(8); PG8_WAIT_L(0); PG8_BAR; PG8_MMA(1, 0, At, B0); PG8_MMA(1, 1, At, B1); PG8_BAR; PG8_SCHED;
            PG8_LDB(B0, 1, 0); PG8_LDB(B1, 1, 1); PG8_SCHED; PG8_LDA(At, 1, 0); PG8_STAGE(PG8_SA(0, 1), a2, w1);
            PG8_WAIT_V(8); PG8_WAIT_L(0); PG8_BAR; PG8_MMA(0, 0, At, B0); PG8_MMA(0, 1, At, B1); PG8_BAR; PG8_SCHED;
            PG8_LDA(At, 1, 1); PG8_STAGE(PG8_SB(1, 0), b3, voffB); PG8_STAGE(PG8_SB(1, 1), b3 + hstep, voffB); PG8_STAGE(PG8_SA(1, 0), a3, w0);
            PG8_WAIT_V(8); PG8_WAIT_L(0); PG8_BAR; PG8_MMA(1, 0, At, B0); PG8_MMA(1, 1, At, B1); PG8_BAR; PG8_SCHED;
        }
        }
        if (wr == 0) PG8_BAR;
        if constexpr (FP8) asm volatile("s_nop 15\n\ts_nop 7" ::: "memory");
        if constexpr (!skip) E(acc, cur, wr, wc, fr, fq); else {
#pragma unroll
            for (int a = 0; a < 2; ++a)
#pragma unroll
                for (int b = 0; b < 2; ++b)
#pragma unroll
                    for (int m = 0; m < 4; ++m)
#pragma unroll
                        for (int n = 0; n < 2; ++n) asm volatile("" :: "v"(acc[a][b][m][n])); }
        if (!has_next) break;
#pragma unroll
        for (int a = 0; a < 2; ++a)
#pragma unroll
            for (int b = 0; b < 2; ++b)
#pragma unroll
                for (int m = 0; m < 4; ++m)
#pragma unroll
                    for (int n = 0; n < 2; ++n) acc[a][b][m][n] = (f32x4){0.f, 0.f, 0.f, 0.f};
        cur = nxt; cA = nA; cB = nB; ++ui;
        if constexpr (Sched::GATHER) { const u32x4 q = *(const LAS u32x4*)(lds + VN_STASH + tid * 16); vA[0][0] = q.x; vA[0][1] = q.y; vA[1][0] = q.z; vA[1][1] = q.w; }
        if (wr == 1) PG8_BAR;
    }
    PG8_WAIT_V(0);
    PG8_BAR;
#undef PG8_SA
#undef PG8_SB
#undef PG8_STAGE
#undef PG8_LDA
#undef PG8_LDB
#undef PG8_MMA
#undef PG8_LD16
#undef PG8_WAIT_V
#undef PG8_WAIT_L
#undef PG8_BAR
#undef PG8_SCHED
#undef PG8_AOFF
}
}

typedef f32x4 Acc[2][2][4][2];
struct EpiG1 {
    static constexpr bool HAS_MID = false;
    unsigned char* ws; const float* g_q; const float* g_k;
    __device__ __forceinline__ void mid(Acc&, const pg8::Unit&, int, int, int, int) const {}
    __device__ __forceinline__ void operator()(Acc& acc, const pg8::Unit& u, int wr, int wc, int fr, int fq) const {
        const int pn = u.pn, row0 = u.pm * 256 + wr * 64 + fr;
        if (pn < 4) {
            const int isk = pn >> 1, hh = 4 * (pn & 1) + wc;
            const float* g = isk ? g_k : g_q;
            f32x4 gv[2][2];
#pragma unroll
            for (int bj = 0; bj < 2; ++bj)
#pragma unroll
                for (int n = 0; n < 2; ++n) gv[bj][n] = *(const f32x4*)(g + ((bj == 0 && fq < 2) ? 8 * n + 4 * fq : 32 * bj + 8 * fq + 4 * n));
            f32x4 cs_[2][2];
#pragma unroll
            for (int bj = 0; bj < 2; ++bj)
#pragma unroll
                for (int n = 0; n < 2; ++n) cs_[bj][n] = (f32x4){0.f, 0.f, 0.f, 0.f};
            f32x4 rf;
#pragma unroll
            for (int e = 0; e < 4; ++e) { const float f0 = exp2f(-(float)e * (0.125f * 18.931568569324174f)) * 0.15915494309189535f, f1 = exp2f(-(float)(4 + e) * (0.125f * 18.931568569324174f)) * 0.15915494309189535f;
                rf[e] = fq == 0 ? f0 : (fq == 1 ? f1 : 0.f); }
            bf16_t* dst = isk ? (bf16_t*)(ws + WS_K) : (bf16_t*)(ws + WS_YAB);
            const int pitch = isk ? 512 : 1024;
            const float sc = isk ? 1.f : C2;
#pragma unroll
            for (int ai = 0; ai < 2; ++ai)
#pragma unroll
                for (int m = 0; m < 4; ++m) {
                    const int r = row0 + 128 * ai + 16 * m; const float pos = (float)(r & (S - 1));
                    f32x4 v[2][2]; float ss = 0.f;
#pragma unroll
                    for (int bj = 0; bj < 2; ++bj)
#pragma unroll
                        for (int n = 0; n < 2; ++n) { v[bj][n] = acc[ai][bj][m][n]; ss += (v[bj][n].x * v[bj][n].x + v[bj][n].y * v[bj][n].y) + (v[bj][n].z * v[bj][n].z + v[bj][n].w * v[bj][n].w); }
                    ss = xrow16_sum(ss);
                    const float rinv = rsqrtf(ss * (1.f / 64.f) + EPS);
#pragma unroll
                    for (int bj = 0; bj < 2; ++bj)
#pragma unroll
                        for (int n = 0; n < 2; ++n) v[bj][n] = v[bj][n] * rinv * gv[bj][n];
#pragma unroll
                    for (int e = 0; e < 4; ++e) { const float rev = __builtin_amdgcn_fractf(pos * rf[e]), c = __builtin_amdgcn_cosf(rev), sn = __builtin_amdgcn_sinf(rev);
                        const float x1 = v[0][0][e], x2 = v[0][1][e]; v[0][0][e] = x1 * c - x2 * sn; v[0][1][e] = x2 * c + x1 * sn; }
                    if (isk) {
#pragma unroll
                        for (int bj = 0; bj < 2; ++bj)
#pragma unroll
                            for (int n = 0; n < 2; ++n) cs_[bj][n] += v[bj][n];
                    }
#pragma unroll
                    for (int bj = 0; bj < 2; ++bj) st16(dst + (size_t)r * pitch + hh * 64 + 32 * bj + 8 * fq, pack8v(v[bj][0] * sc, v[bj][1] * sc));
                }
            if (isk) {
                const int b = u.pm >> 4, blk = u.pm & 15;
                float* km = (float*)(ws + WS_KMEAN) + ((size_t)(b * NH + hh) * 16 + blk) * 64;
#pragma unroll
                for (int bj = 0; bj < 2; ++bj)
#pragma unroll
                    for (int n = 0; n < 2; ++n)
#pragma unroll
                        for (int e = 0; e < 4; ++e) { float s = cs_[bj][n][e]; s += dpp_ror<8>(s); s += dpp_ror<4>(s); s += dpp_ror<2>(s); s += dpp_ror<1>(s);
                            if (fr == 0) atomicAdd(km + 32 * bj + 8 * fq + 4 * n + e, s * (1.f / 256.f)); }
            }
        } else if (pn < 8) {
            bf16_t* dst = (bf16_t*)(ws + WS_U);
#pragma unroll
            for (int ai = 0; ai < 2; ++ai)
#pragma unroll
                for (int m = 0; m < 4; ++m) { const int r = row0 + 128 * ai + 16 * m;
                    const f32x4 a = acc[ai][0][m][0] * acc[ai][1][m][0], b = acc[ai][0][m][1] * acc[ai][1][m][1]; u32x4 w;
                    w.x = pk2(a.x, a.y); w.y = pk2(a.z, a.w); w.z = pk2(b.x, b.y); w.w = pk2(b.z, b.w);
                    st16(dst + (size_t)r * 512 + 128 * (pn - 4) + 32 * wc + 8 * fq, w); }
        } else {
            bf16_t* dst = (bf16_t*)(ws + WS_BG); const int pitch = 512, c0 = 256 * (pn - 8); const bool sig = false;
#pragma unroll
            for (int ai = 0; ai < 2; ++ai)
#pragma unroll
                for (int m = 0; m < 4; ++m) { const int r = row0 + 128 * ai + 16 * m;
#pragma unroll
                    for (int bj = 0; bj < 2; ++bj) { f32x4 a = acc[ai][bj][m][0], b = acc[ai][bj][m][1];
                        if (sig) {
#pragma unroll
                            for (int e = 0; e < 4; ++e) { a[e] = __builtin_amdgcn_rcpf(1.f + __expf(-a[e])); b[e] = __builtin_amdgcn_rcpf(1.f + __expf(-b[e])); } }
                        u32x4 w; w.x = pk2(a.x, a.y); w.y = pk2(a.z, a.w); w.z = pk2(b.x, b.y); w.w = pk2(b.z, b.w);
                        st16(dst + (size_t)r * pitch + c0 + 128 * bj + 32 * wc + 8 * fq, w); } }
        }
    }
};
struct EpiGate {
    static constexpr bool HAS_MID = false;
    bf16_t* gates; bf16_t* vout;
    __device__ __forceinline__ void mid(Acc&, const pg8::Unit&, int, int, int, int) const {}
    __device__ __forceinline__ void operator()(Acc& acc, const pg8::Unit& u, int wr, int wc, int fr, int fq) const {
        int row0 = u.pm * 256 + wr * 64 + fr; const int c0 = u.pn * 256 + 32 * wc + 8 * fq; asm volatile("" : "+v"(row0));
#pragma unroll
        for (int ai = 0; ai < 2; ++ai)
#pragma unroll
            for (int m = 0; m < 4; ++m) { const size_t r = (size_t)(row0 + 128 * ai + 16 * m);
                if (u.pn < 8) {
                    f32x4 ra[2], gb[2];
#pragma unroll
                    for (int n = 0; n < 2; ++n)
#pragma unroll
                        for (int e = 0; e < 4; ++e) { const float ea = __expf(acc[ai][0][m][n][e] * (-1.f / W8_SCALE)), eb = __expf(acc[ai][1][m][n][e] * (-1.f / W8_SCALE));
                            gb[n][e] = __builtin_amdgcn_rcpf(1.f + eb); ra[n][e] = fminf((1.f + eb) * __builtin_amdgcn_rcpf(1.f + ea), 3e4f); }
                    const size_t gc = r * 2048 + 128 * u.pn + 32 * wc + 8 * fq;
                    st16(gates + gc, pack8v(ra[0], ra[1])); st16(gates + gc + 1024, pack8v(gb[0], gb[1]));
                } else {
#pragma unroll
                    for (int bj = 0; bj < 2; ++bj) st16(vout + r * 512 + (c0 - 2048) + 128 * bj, pack8v(acc[ai][bj][m][0] * (1.f / W8_SCALE), acc[ai][bj][m][1] * (1.f / W8_SCALE))); } }
    }
};
__device__ __forceinline__ void s2_fast(Frame& F) {
    {
        const pg8::DenseSched Sd{(const char*)(F.ws + WS_H), (const char*)(F.ws + WS_WIN_T), T / 256, 10, 1024, F.G, (int)blockIdx.x};
        const EpiG1 E{F.ws, F.g_q, F.g_k};
        if (F.skip) pg8::gemm_phase<EpiG1, pg8::DenseSched, true>(F.lds, 1024, Sd, E); else pg8::gemm_phase<EpiG1, pg8::DenseSched>(F.lds, 1024, Sd, E); }
    {
        const pg8::DenseSched8 Sd{(const char*)(F.ws + WS_H8), (const char*)(F.ws + WS_WIN8), T / 256, 10, 1024, F.G, (int)blockIdx.x};
        const EpiGate E{WSP(bf16_t, WS_GATES), WSP(bf16_t, WS_V)};
        int Kg = D; asm volatile("" : "+s"(Kg));
        if (F.skip) pg8::gemm_phase<EpiGate, pg8::DenseSched8, true>(F.lds, Kg, Sd, E); else pg8::gemm_phase<EpiGate, pg8::DenseSched8>(F.lds, Kg, Sd, E); }
}

constexpr float NEG_BIG = -1e30f;
__device__ __forceinline__ void s3_simple(Frame& F) {
    LAS float* tS = (LAS float*)F.lds;
    LAS bf16_t* Pb = (LAS bf16_t*)(F.lds + 16896);
    LAS bf16_t* Vt = (LAS bf16_t*)(F.lds + 16896 + 9216);
    LAS float* mrow = (LAS float*)(F.lds + 16896 + 18432);
    LAS float* lrow = mrow + 64; LAS float* arow_ = mrow + 128; LAS int* sel = (LAS int*)(mrow + 192); LAS int* um = sel + 64;
    bf16_t* YAB = WSP(bf16_t, WS_YAB); const bf16_t* Kb = WSP(bf16_t, WS_K); const bf16_t* Vb = WSP(bf16_t, WS_V);
    const float* kmean = WSP(float, WS_KMEAN);
    const int row = F.tid >> 3, seg = F.tid & 7, fr = F.lane & 15, fq = F.lane >> 4, rb = 16 * (F.wave & 3), cb = 32 * (F.wave >> 2);
    for (int it = blockIdx.x; it < NB * NH * 64; it += F.G) {
        const int qc = it & 63, h = (it >> 6) & 7, b = it >> 9, cur = qc >> 2, t0 = 64 * qc;
        const size_t tb = (size_t)b * S;
        if (F.tid < 64) {
            float q[64];
            const bf16_t* qp = YAB + (tb + t0 + F.tid) * 1024 + h * 64;
#pragma unroll
            for (int i = 0; i < 8; ++i) { float t8[8]; unpack8(*(const u32x4*)(qp + 8 * i), t8);
#pragma unroll
                for (int e = 0; e < 8; ++e) q[8 * i + e] = t8[e]; }
            float b0 = -INFINITY, b1 = -INFINITY, b2 = -INFINITY; int i0 = -1, i1 = -1, i2 = -1;
            for (int j = 0; j < cur; ++j) { const float* km = kmean + ((size_t)(b * NH + h) * 16 + j) * 64; float s = 0.f;
#pragma unroll
                for (int d = 0; d < 64; ++d) s += q[d] * km[d];
                if (s > b0) { b2 = b1; i2 = i1; b1 = b0; i1 = i0; b0 = s; i0 = j; } else if (s > b1) { b2 = b1; i2 = i1; b1 = s; i1 = j; } else if (s > b2) { b2 = s; i2 = j; } }
            int m = 0; if (i0 >= 0) m |= 1 << i0; if (i1 >= 0) m |= 1 << i1; if (i2 >= 0) m |= 1 << i2;
            sel[F.tid] = m; mrow[F.tid] = NEG_BIG; lrow[F.tid] = 0.f;
            int u = m;
#pragma unroll
            for (int o = 1; o < 64; o <<= 1) u |= __shfl_xor(u, o);
            if (F.tid == 0) um[0] = u;
        }
        __syncthreads();
        const int umask = um[0];
        f32x4 o0 = {0.f, 0.f, 0.f, 0.f}, o1 = {0.f, 0.f, 0.f, 0.f};
        const RowsLinear aq{YAB + (tb + t0) * 1024 + h * 64, 1024};
        for (int j = 0; j <= cur; ++j) {
            if (j < cur && !((umask >> j) & 1)) continue;
            const int nkt = (j == cur) ? ((qc & 3) + 1) : 4;
            for (int kt = 0; kt < nkt; ++kt) {
                const int kbase = 256 * j + 64 * kt;
                const RowsLinear bk{Kb + (tb + kbase) * 512 + h * 64, 512};
                sgemm_tile(tS, 64, aq, bk, F.wave, F.lane);
                { float vv[8]; unpack8(*(const u32x4*)(Vb + (tb + kbase + row) * 512 + h * 64 + 8 * seg), vv);
#pragma unroll
                    for (int e = 0; e < 8; ++e) Vt[(8 * seg + e) * 72 + row] = (bf16_t)f2bf(vv[e]); }
                __syncthreads();
                {
                    float s[8]; float mx = NEG_BIG;
                    const bool rowsel = (j == cur) || ((sel[row] >> j) & 1);
#pragma unroll
                    for (int e = 0; e < 8; ++e) { const int c = 8 * seg + e; float x = tS[row * 65 + c];
                        if (!rowsel || (j == cur && kbase + c > t0 + row)) x = NEG_BIG; s[e] = x; mx = fmaxf(mx, x); }
                    mx = fmaxf(mx, __shfl_xor(mx, 1)); mx = fmaxf(mx, __shfl_xor(mx, 2)); mx = fmaxf(mx, __shfl_xor(mx, 4));
                    const float mold = mrow[row], mnew = fmaxf(mold, mx);
                    float alpha = 1.f, ps = 0.f; float p[8];
                    if (mnew <= NEG_BIG) {
#pragma unroll
                        for (int e = 0; e < 8; ++e) p[e] = 0.f;
                    } else { alpha = exp2f(mold - mnew);
#pragma unroll
                        for (int e = 0; e < 8; ++e) { p[e] = (s[e] <= NEG_BIG) ? 0.f : exp2f(s[e] - mnew); ps += p[e]; } }
                    ps += __shfl_xor(ps, 1); ps += __shfl_xor(ps, 2); ps += __shfl_xor(ps, 4);
                    const float lold = lrow[row];
                    *(LAS u32x4*)(Pb + row * 72 + 8 * seg) = pack8(p);
                    if (seg == 0) { mrow[row] = mnew; lrow[row] = lold * alpha + ps; arow_[row] = alpha; }
                }
                __syncthreads();
                {
#pragma unroll
                    for (int r = 0; r < 4; ++r) { const float a = arow_[rb + fq * 4 + r]; o0[r] *= a; o1[r] *= a; }
#pragma unroll
                    for (int ks = 0; ks < 2; ++ks) {
                        const bf16x8 a = *(const LAS bf16x8*)(Pb + (rb + fr) * 72 + 32 * ks + 8 * fq);
                        const bf16x8 v0 = *(const LAS bf16x8*)(Vt + (cb + fr) * 72 + 32 * ks + 8 * fq);
                        const bf16x8 v1 = *(const LAS bf16x8*)(Vt + (cb + 16 + fr) * 72 + 32 * ks + 8 * fq);
                        o0 = __builtin_amdgcn_mfma_f32_16x16x32_bf16(a, v0, o0, 0, 0, 0);
                        o1 = __builtin_amdgcn_mfma_f32_16x16x32_bf16(a, v1, o1, 0, 0, 0);
                    }
                }
                __syncthreads();
            }
        }
#pragma unroll
        for (int r = 0; r < 4; ++r) { const float li = 1.f / lrow[rb + fq * 4 + r]; tS[(rb + fq * 4 + r) * 65 + cb + fr] = o0[r] * li; tS[(rb + fq * 4 + r) * 65 + cb + 16 + fr] = o1[r] * li; }
        __syncthreads();
        { float v[8];
#pragma unroll
            for (int e = 0; e < 8; ++e) v[e] = tS[row * 65 + 8 * seg + e];
            *(u32x4*)(YAB + (tb + t0 + row) * 1024 + h * 64 + 8 * seg) = pack8(v); }
        __syncthreads();
    }
    const bf16_t* U = WSP(bf16_t, WS_U); const bf16_t* BG = WSP(bf16_t, WS_BG);
    for (int i = blockIdx.x * NTHREADS + F.tid; i < T * 64; i += F.G * NTHREADS) {
        const int t = i >> 6, c0 = (i & 63) * 8, pos = t & (S - 1);
        float u0[8], u1[8], u2[8], bg[8], y[8];
        unpack8(*(const u32x4*)(U + (size_t)t * 512 + c0), u2); unpack8(*(const u32x4*)(BG + (size_t)t * 512 + c0), bg);
        if (pos >= 1) unpack8(*(const u32x4*)(U + (size_t)(t - 1) * 512 + c0), u1); else {
#pragma unroll
            for (int e = 0; e < 8; ++e) u1[e] = 0.f; }
        if (pos >= 2) unpack8(*(const u32x4*)(U + (size_t)(t - 2) * 512 + c0), u0); else {
#pragma unroll
            for (int e = 0; e < 8; ++e) u0[e] = 0.f; }
#pragma unroll
        for (int e = 0; e < 8; ++e) y[e] = bg[e] * (F.conv_w[c0 + e] * u0[e] + F.conv_w[512 + c0 + e] * u1[e] + F.conv_w[1024 + c0 + e] * u2[e] + F.conv_b[c0 + e]);
        *(u32x4*)(YAB + (size_t)t * 1024 + 512 + c0) = pack8(y);
    }
}

namespace attn_body {
using bf16x8 = __attribute__((ext_vector_type(8))) short;
using s16x4 = __attribute__((ext_vector_type(4))) short;
using f32x16 = __attribute__((ext_vector_type(16))) float;
using u32x4 = __attribute__((ext_vector_type(4))) unsigned;
constexpr int SEQ = 4096, D = 64, DMQ = 1024, DMK = 512;
constexpr int NW = 8, QBLK = 32, QB = QBLK * NW, KVBLK = 64;
constexpr float NEGB = -1e30f;
__device__ __forceinline__ int crow(int r, int hi) { return (r & 3) + 8 * (r >> 2) + 4 * hi; }
#define SBAR() __builtin_amdgcn_sched_barrier(0)
__device__ __forceinline__ void cmask(f32x16& p0, f32x16& p1, int jb, int qrel, int hi) {
  const float NEG = -INFINITY; int kb = 64 * jb + 4 * hi;
  #pragma unroll
  for (int r = 0; r < 16; ++r) { int kv = kb + (r & 3) + 8 * (r >> 2); if (kv > qrel) p0[r] = NEG; if (kv + 32 > qrel) p1[r] = NEG; }
}
constexpr int NSLOT = 3, SLOTB = 8192;
constexpr int LDS_K = 0, LDS_V = NSLOT * SLOTB, LDS_WS = 2 * NSLOT * SLOTB, LDS_OST = LDS_WS + NW * 128 * 4, LDS_BYTES_A = LDS_OST + NW * 4096;
__device__ __forceinline__ void glds16(const void* gsrc, unsigned lds_dst) { unsigned keep;
  asm volatile("s_mov_b32 %0, m0\n\ts_mov_b32 m0, %2\n\ts_nop 0\n\tglobal_load_lds_dwordx4 %1, off\n\ts_mov_b32 m0, %0" : "=&s"(keep) : "v"(gsrc), "s"(lds_dst) : "memory"); }
__device__ __forceinline__ float max3f(float a, float b, float c) { float r; asm("v_max3_f32 %0, %1, %2, %3" : "=v"(r) : "v"(a), "v"(b), "v"(c)); return r; }
__device__ __forceinline__ float max2f(float a, float b) { float r; asm("v_max_f32_e32 %0, %1, %2" : "=v"(r) : "v"(a), "v"(b)); return r; }
__device__ __forceinline__ float fadd_s(float a, float b) { float r; asm("v_add_f32_e32 %0, %1, %2" : "=v"(r) : "v"(a), "v"(b)); return r; }
__device__ __forceinline__ float fsub_s(float a, float b) { float r; asm("v_sub_f32_e32 %0, %1, %2" : "=v"(r) : "v"(a), "v"(b)); return r; }
typedef float f32x2_t __attribute__((ext_vector_type(2))); typedef __bf16 bf16x2_t __attribute__((ext_vector_type(2)));
__device__ __forceinline__ unsigned cvtpk_s(float lo, float hi) { f32x2_t v = {lo, hi}; bf16x2_t b = __builtin_convertvector(v, bf16x2_t); return __builtin_bit_cast(unsigned, b); }
#define WAIT_BAR(N) asm volatile("s_waitcnt vmcnt(" #N ") lgkmcnt(0)\n\ts_barrier" ::: "memory")
__device__ __forceinline__ void qkt(f32x16& p0, f32x16& p1, const char* Kslot, const bf16x8* qr, const f32x16& negm, int r32, int hi) {
  const char* kb = Kslot + hi * 1024 + r32 * 16;
  #pragma unroll
  for (int d0 = 0; d0 < 4; ++d0) {
    const bf16x8 b0 = *reinterpret_cast<const bf16x8*>(kb + d0 * 2048);
    const bf16x8 b1 = *reinterpret_cast<const bf16x8*>(kb + d0 * 2048 + 512);
    if (d0 == 0) { p0 = __builtin_amdgcn_mfma_f32_32x32x16_bf16(b0, qr[0], negm, 0, 0, 0); p1 = __builtin_amdgcn_mfma_f32_32x32x16_bf16(b1, qr[0], negm, 0, 0, 0); }
    else { p0 = __builtin_amdgcn_mfma_f32_32x32x16_bf16(b0, qr[d0], p0, 0, 0, 0); p1 = __builtin_amdgcn_mfma_f32_32x32x16_bf16(b1, qr[d0], p1, 0, 0, 0); } }
}
typedef __attribute__((address_space(3))) const char* lds_cptr;
typedef __attribute__((address_space(3))) char* lds_ptr;
typedef short v4i16_t __attribute__((ext_vector_type(4)));
__device__ __forceinline__ void kload8(bf16x8* kf, lds_cptr kp) {
  kf[0] = *(const __attribute__((address_space(3))) bf16x8*)(kp);        kf[1] = *(const __attribute__((address_space(3))) bf16x8*)(kp + 512);
  kf[2] = *(const __attribute__((address_space(3))) bf16x8*)(kp + 2048); kf[3] = *(const __attribute__((address_space(3))) bf16x8*)(kp + 2560);
  kf[4] = *(const __attribute__((address_space(3))) bf16x8*)(kp + 4096); kf[5] = *(const __attribute__((address_space(3))) bf16x8*)(kp + 4608);
  kf[6] = *(const __attribute__((address_space(3))) bf16x8*)(kp + 6144); kf[7] = *(const __attribute__((address_space(3))) bf16x8*)(kp + 6656);
}
__device__ __forceinline__ void kload2(bf16x8* kf, lds_cptr kp, int j) { kf[2 * j] = *(const __attribute__((address_space(3))) bf16x8*)(kp + j * 2048); kf[2 * j + 1] = *(const __attribute__((address_space(3))) bf16x8*)(kp + j * 2048 + 512); }
__device__ __forceinline__ s16x4 vtr(lds_cptr p) { return __builtin_bit_cast(s16x4, __builtin_amdgcn_ds_read_tr16_b64_v4i16((__attribute__((address_space(3))) v4i16_t*)p)); }
__device__ __forceinline__ float rowmax(const f32x16& p0, const f32x16& p1) {
  float a = max3f(p0[0], p0[1], p1[0]), b = max3f(p0[2], p0[3], p1[1]); a = max3f(a, p1[2], p1[3]);
  #pragma unroll
  for (int r = 4; r < 16; r += 4) { a = max3f(a, p0[r], p0[r + 1]); b = max3f(b, p0[r + 2], p0[r + 3]); a = max3f(a, p1[r], p1[r + 1]); b = max3f(b, p1[r + 2], p1[r + 3]); }
  const float m = max2f(a, b);
  auto rr = __builtin_amdgcn_permlane32_swap(__float_as_uint(m), __float_as_uint(m), false, false);
  return max2f(__uint_as_float(rr[0]), __uint_as_float(rr[1]));
}
__device__ __forceinline__ void pv(f32x16* o, int vb, bf16x8 pa0, bf16x8 pa1, bf16x8 pa2, bf16x8 pa3) {
  #pragma unroll
  for (int d0 = 0; d0 < 2; ++d0) { s16x4 lo[4], hi[4];
    #pragma unroll
    for (int ks = 0; ks < 4; ++ks) {
      asm volatile("ds_read_b64_tr_b16 %0,%1 offset:%c2" : "=&v"(lo[ks]) : "v"(vb), "i"(d0 * 4096 + ks * 1024) : "memory");
      asm volatile("ds_read_b64_tr_b16 %0,%1 offset:%c2" : "=&v"(hi[ks]) : "v"(vb), "i"(d0 * 4096 + ks * 1024 + 512) : "memory"); }
    asm volatile("s_waitcnt lgkmcnt(0)" ::: "memory"); SBAR();
    #define PK(k) (bf16x8){lo[k][0], lo[k][1], lo[k][2], lo[k][3], hi[k][0], hi[k][1], hi[k][2], hi[k][3]}
    o[d0] = __builtin_amdgcn_mfma_f32_32x32x16_bf16(pa0, PK(0), o[d0], 0, 0, 0);
    o[d0] = __builtin_amdgcn_mfma_f32_32x32x16_bf16(pa1, PK(1), o[d0], 0, 0, 0);
    o[d0] = __builtin_amdgcn_mfma_f32_32x32x16_bf16(pa2, PK(2), o[d0], 0, 0, 0);
    o[d0] = __builtin_amdgcn_mfma_f32_32x32x16_bf16(pa3, PK(3), o[d0], 0, 0, 0);
    #undef PK
  }
}
#define ATTN_STORE16(p, v) st16((p), (v))
template <int THRL> __device__ __forceinline__ void attn_unit(int b, int h, int qb, const bf16_t* QO, bf16_t* Ob, const bf16_t* __restrict__ K, const bf16_t* __restrict__ V, const float* __restrict__ kmean, char* shm) {
  int tid_ = threadIdx.x; asm volatile("" : "+v"(tid_));
  const int tid = tid_, lane = tid & 63, r32 = lane & 31, hi = lane >> 5; const int wid = __builtin_amdgcn_readfirstlane(tid >> 6);
  const long rowbase = (long)b * SEQ; const int q0 = qb * QB;
  const bf16_t* Qw = QO + (rowbase + q0 + wid * QBLK) * DMQ + h * D;
  const bf16_t* Kh = K + rowbase * DMK + h * D, *Vh = V + rowbase * DMK + h * D;
  const unsigned lds0 = (unsigned)(uintptr_t)shm;
  float* wsf = (float*)(shm + LDS_WS) + wid * 128;
  const bf16_t* ksrc = Kh + (long)lane * DMK + wid * 8;
  const bf16_t* vsrc = Vh + (long)(16 * (wid & 3) + (lane >> 2)) * DMK + (wid >> 2) * 32 + (lane & 3) * 8;
  const unsigned kdst = lds0 + LDS_K + wid * 1024, vdst = lds0 + LDS_V + wid * 1024;
  #define DMA_K(t, slot) glds16(ksrc + (long)(t) * KVBLK * DMK, (unsigned)__builtin_amdgcn_readfirstlane(kdst + (slot)))
  #define DMA_V(t, slot) glds16(vsrc + (long)(t) * KVBLK * DMK, (unsigned)__builtin_amdgcn_readfirstlane(vdst + (slot)))
  DMA_K(0, 0); DMA_V(0, 0); DMA_K(1, SLOTB);
  bf16x8 qr[4];
  #pragma unroll
  for (int d0 = 0; d0 < 4; ++d0) qr[d0] = *reinterpret_cast<const bf16x8*>(&Qw[(long)r32 * DMQ + d0 * 16 + hi * 8]);
  unsigned selm = 0u;
  if (qb > 0) {
    float* kmL = (float*)(shm + LDS_OST);
    const float* kmg = kmean + ((size_t)(b * 8 + h) * 16) * 64;
    for (int i = tid; i < qb * 64; i += 512) kmL[i] = kmg[i];
    asm volatile("s_waitcnt vmcnt(0) lgkmcnt(0)\n\ts_barrier" ::: "memory");
    float qf[32];
    #pragma unroll
    for (int d0 = 0; d0 < 4; ++d0)
      #pragma unroll
      for (int e = 0; e < 8; ++e) qf[8 * d0 + e] = __uint_as_float(((unsigned)(unsigned short)qr[d0][e]) << 16);
    float b0 = -INFINITY, b1 = -INFINITY, b2 = -INFINITY; int i0 = -1, i1 = -1, i2 = -1;
    for (int j = 0; j < qb; ++j) {
      const float* km = kmL + j * 64 + 8 * hi; float sc = 0.f;
      #pragma unroll
      for (int d0 = 0; d0 < 4; ++d0)
        #pragma unroll
        for (int e = 0; e < 8; ++e) sc += qf[8 * d0 + e] * km[16 * d0 + e];
      sc += __shfl_xor(sc, 32);
      if (sc > b0) { b2 = b1; i2 = i1; b1 = b0; i1 = i0; b0 = sc; i0 = j; } else if (sc > b1) { b2 = b1; i2 = i1; b1 = sc; i1 = j; } else if (sc > b2) { b2 = sc; i2 = j; }
    }
    if (i0 >= 0) selm |= 1u << i0; if (i1 >= 0) selm |= 1u << i1; if (i2 >= 0) selm |= 1u << i2;
    asm volatile("s_waitcnt lgkmcnt(0)\n\ts_barrier" ::: "memory");
  }
  if (hi == 0) ((unsigned*)wsf)[64 + r32] = selm;
  { const lds_ptr qst = (lds_ptr)shm + LDS_OST + wid * 4096 + lane * 16;
    #pragma unroll
    for (int d0 = 0; d0 < 4; ++d0) *(__attribute__((address_space(3))) bf16x8*)(qst + d0 * 1024) = qr[d0]; }
  #define SELROW(j) (((j) >= qb) || ((((const unsigned*)wsf)[64 + r32] >> (j)) & 1u))
  #define NEGM_SET(blk) do { const float nv_ = SELROW(blk) ? -mhat : NEGB; _Pragma("unroll") for (int r = 0; r < 16; ++r) negm[r] = nv_; asm volatile("" : "+v"(negm)); } while (0)
  const int vb0 = (int)(lds0 + LDS_V) + ((lane >> 4) & 1) * 32 + (lane & 3) * 8 + (4 * hi + ((lane & 15) >> 2)) * 64;
  const char* Kbase = shm + LDS_K; bf16x8 kf[8];
  const lds_cptr qp0 = (lds_cptr)shm + LDS_OST + wid * 4096 + lane * 16;
  const lds_cptr shm3 = (lds_cptr)shm; const lds_cptr kp0 = shm3 + LDS_K + hi * 1024 + r32 * 16; const lds_cptr vp0 = shm3 + LDS_V + ((lane >> 4) & 1) * 32 + (lane & 3) * 8 + (4 * hi + ((lane & 15) >> 2)) * 64;
  const int NT = (q0 + QB) / KVBLK;
  float mhat = 0.f, l_reg = 0.f; f32x16 o[2]; o[0] = f32x16{}; o[1] = f32x16{}; f32x16 negm;
  NEGM_SET(0);
  const int qrel = wid * QBLK + r32;
  #define CMASK(P0, P1, t) do { int jb_ = (t) - (NT - 4); if (jb_ >= 0) cmask(P0, P1, jb_, qrel, hi); } while (0)
  bool resc = false;
  #define START(P0, P1) do { const float rm = rowmax(P0, P1); resc = false; \
    { const float dl = SELROW(0) ? rm : 0.f; mhat = fadd_s(mhat, dl); \
      _Pragma("unroll") for (int r = 0; r < 16; ++r) { P0[r] = fsub_s(P0[r], dl); P1[r] = fsub_s(P1[r], dl); } \
      NEGM_SET(0); } \
    _Pragma("unroll") for (int r = 0; r < 16; ++r) P0[r] = __builtin_amdgcn_exp2f(P0[r]); } while (0)
  #define RESC() do { if (resc) { asm volatile("s_waitcnt lgkmcnt(0)" ::: "memory"); \
      _Pragma("unroll") for (int d_ = 0; d_ < 2; ++d_) _Pragma("unroll") for (int r = 0; r < 16; ++r) o[d_][r] *= wsf[crow(r, hi)]; } } while (0)
  f32x16 pA0, pA1, pB0, pB1;
  int sl_prev = 0, sl_cur = 0, sl_next = SLOTB;
  #define ROT() do { sl_prev = sl_cur; sl_cur = sl_next; sl_next = (sl_next == (NSLOT - 1) * SLOTB) ? 0 : sl_next + SLOTB; } while (0)
  DMA_K(2, 2 * SLOTB);
  WAIT_BAR(3);
  qkt(pA0, pA1, Kbase, qr, negm, r32, hi); asm volatile("s_nop 15\n\ts_nop 7" : "+v"(pA0), "+v"(pA1)); CMASK(pA0, pA1, 0);
  START(pA0, pA1);
  _Pragma("unroll") for (int r = 0; r < 16; ++r) pA1[r] = __builtin_amdgcn_exp2f(pA1[r]);
  WAIT_BAR(0);
  DMA_K(3, 0); DMA_V(1, SLOTB);
  ROT();
  kload8(kf, kp0 + sl_cur);
  WAIT_BAR(2);
  s16x4 vlo[8], vhi[8]; u32x4 pw0, pw1, pw2, pw3; bf16x8 q0_, q1_, q2_, q3_;
  #define QRD(d) do { q##d##_ = *(const __attribute__((address_space(3))) bf16x8*)(qp0 + (d) * 1024); } while (0)
  QRD(0); QRD(1);
  #define PKW(P, B) cvtpk_s(P[B], P[B + 1])
  #define PAF(k) __builtin_bit_cast(bf16x8, pw##k)
  #define VFR(i) (bf16x8){vlo[i][0], vlo[i][1], vlo[i][2], vlo[i][3], vhi[i][0], vhi[i][1], vhi[i][2], vhi[i][3]}
  #define PIN(x) asm volatile("" : "+v"(x))
  #define MX3(a, b, c) __builtin_fmaxf(__builtin_fmaxf((a), (b)), (c))
  #define GAPA(MF, A0, A1, A2, A3, W0, W1, PW) do { MF; sacc += A0; sacc += A1; sacc += A2; sacc += A3; PIN(sacc); W0; W1; PIN(PW); SBAR(); } while (0)
  #define EX(v) __builtin_amdgcn_exp2f(v)
  #define GAPB(MF, X, B) do { MF; X[B] = EX(X[B]); X[B + 1] = EX(X[B + 1]); X[B + 2] = EX(X[B + 2]); X[B + 3] = EX(X[B + 3]); PIN(X); SBAR(); } while (0)
  #define VRD(i) do { vlo[i] = vtr(vp_ + (((i) >> 2) * 4096 + ((i) & 3) * 1024)); vhi[i] = vtr(vp_ + (((i) >> 2) * 4096 + ((i) & 3) * 1024 + 512)); } while (0)
  #define KRD(G, j) do { if (G) { kload2(kf, kp0 + sl_next, j); SBAR(); } } while (0)
  #define STEP(C0, C1, P0, P1, t, GK, GV, GL) do { SBAR(); \
    const lds_cptr vp_ = vp0 + sl_prev; \
    VRD(0); SBAR(); float sacc = (P0[0] + P0[1]); \
    GAPA(C0 = __builtin_amdgcn_mfma_f32_32x32x16_bf16(kf[0], q0_, negm, 0, 0, 0), P0[2], P0[3], P0[4], P0[5],     pw0[0] = PKW(P0, 0), pw0[1] = PKW(P0, 2), pw0); \
    VRD(4); SBAR(); GAPA(C1 = __builtin_amdgcn_mfma_f32_32x32x16_bf16(kf[1], q0_, negm, 0, 0, 0), P0[6], P0[7], P0[8], P0[9],     pw0[2] = PKW(P0, 4), pw0[3] = PKW(P0, 6), pw0); \
    QRD(2); SBAR(); \
    VRD(1); SBAR(); GAPA(C0 = __builtin_amdgcn_mfma_f32_32x32x16_bf16(kf[2], q1_, C0, 0, 0, 0),   P0[10], P0[11], P0[12], P0[13], pw1[0] = PKW(P0, 8), pw1[1] = PKW(P0, 10), pw1); \
    VRD(5); SBAR(); GAPA(C1 = __builtin_amdgcn_mfma_f32_32x32x16_bf16(kf[3], q1_, C1, 0, 0, 0),   P0[14], P0[15], P1[0], P1[1],   pw1[2] = PKW(P0, 12), pw1[3] = PKW(P0, 14), pw1); \
    QRD(3); SBAR(); \
    VRD(2); SBAR(); GAPA(C0 = __builtin_amdgcn_mfma_f32_32x32x16_bf16(kf[4], q2_, C0, 0, 0, 0),   P1[2], P1[3], P1[4], P1[5],     pw2[0] = PKW(P1, 0), pw2[1] = PKW(P1, 2), pw2); \
    VRD(6); SBAR(); GAPA(C1 = __builtin_amdgcn_mfma_f32_32x32x16_bf16(kf[5], q2_, C1, 0, 0, 0),   P1[6], P1[7], P1[8], P1[9],     pw2[2] = PKW(P1, 4), pw2[3] = PKW(P1, 6), pw2); \
    VRD(3); SBAR(); GAPA(C0 = __builtin_amdgcn_mfma_f32_32x32x16_bf16(kf[6], q3_, C0, 0, 0, 0),   P1[10], P1[11], P1[12], P1[13], pw3[0] = PKW(P1, 8), pw3[1] = PKW(P1, 10), pw3); \
    VRD(7); SBAR(); GAPA(C1 = __builtin_amdgcn_mfma_f32_32x32x16_bf16(kf[7], q3_, C1, 0, 0, 0),   P1[14], P1[15], 0.f, 0.f,       pw3[2] = PKW(P1, 12), pw3[3] = PKW(P1, 14), pw3); \
    l_reg += sacc; \
    if (GK) { DMA_K((t) + 3, sl_cur); } if (GV) { DMA_V((t) + 1, sl_next); } \
    CMASK(C0, C1, t); \
    { float a = MX3(C0[0], C0[1], C1[0]), b = MX3(C0[2], C0[3], C1[1]); a = MX3(a, C1[2], C1[3]); \
      _Pragma("unroll") for (int r = 4; r < 16; r += 4) { a = MX3(a, C0[r], C0[r + 1]); b = MX3(b, C0[r + 2], C0[r + 3]); a = MX3(a, C1[r], C1[r + 1]); b = MX3(b, C1[r + 2], C1[r + 3]); } \
      float rm = __builtin_fmaxf(a, b); { auto rr = __builtin_amdgcn_permlane32_swap(__float_as_uint(rm), __float_as_uint(rm), false, false); rm = __builtin_fmaxf(__uint_as_float(rr[0]), __uint_as_float(rr[1])); } \
      resc = false; \
      if (__builtin_expect(__any(rm > (float)THRL), 0)) { const float dl = __builtin_fmaxf(rm, 0.f); mhat += dl; \
        _Pragma("unroll") for (int r = 0; r < 16; ++r) { C0[r] -= dl; C1[r] -= dl; } \
        NEGM_SET(((t) + 1) >> 2); \
        const float f = __builtin_amdgcn_exp2f(-dl); l_reg *= f; if (hi == 0) wsf[r32] = f; resc = true; } \
      else if ((((t) + 1) & 3) == 0) { NEGM_SET(((t) + 1) >> 2); } } \
    SBAR(); \
    GAPB(o[0] = __builtin_amdgcn_mfma_f32_32x32x16_bf16(PAF(0), VFR(0), o[0], 0, 0, 0), C0, 0); \
    GAPB(o[1] = __builtin_amdgcn_mfma_f32_32x32x16_bf16(PAF(0), VFR(4), o[1], 0, 0, 0), C0, 4); \
    KRD(GL, 0); GAPB(o[0] = __builtin_amdgcn_mfma_f32_32x32x16_bf16(PAF(1), VFR(1), o[0], 0, 0, 0), C0, 8); \
    KRD(GL, 1); GAPB(o[1] = __builtin_amdgcn_mfma_f32_32x32x16_bf16(PAF(1), VFR(5), o[1], 0, 0, 0), C0, 12); \
    KRD(GL, 2); GAPB(o[0] = __builtin_amdgcn_mfma_f32_32x32x16_bf16(PAF(2), VFR(2), o[0], 0, 0, 0), C1, 0); \
    KRD(GL, 3); GAPB(o[1] = __builtin_amdgcn_mfma_f32_32x32x16_bf16(PAF(2), VFR(6), o[1], 0, 0, 0), C1, 4); \
    GAPB(o[0] = __builtin_amdgcn_mfma_f32_32x32x16_bf16(PAF(3), VFR(3), o[0], 0, 0, 0), C1, 8); \
    GAPB(o[1] = __builtin_amdgcn_mfma_f32_32x32x16_bf16(PAF(3), VFR(7), o[1], 0, 0, 0), C1, 12); \
    QRD(0); QRD(1); SBAR(); \
    } while (0)
  int t = 1;
  #undef CMASK
  #define CMASK(P0, P1, t) do {} while (0)
  for (; t + 5 < NT; t += 2) {
    STEP(pB0, pB1, pA0, pA1, t, true, true, true);     WAIT_BAR(2); RESC(); ROT();
    STEP(pA0, pA1, pB0, pB1, t + 1, true, true, true); WAIT_BAR(2); RESC(); ROT();
  }
  #undef CMASK
  #define CMASK(P0, P1, t) do { int jb_ = (t) - (NT - 4); if (jb_ >= 0) cmask(P0, P1, jb_, qrel, hi); } while (0)
  #define ENDW(tt) do { if ((tt) + 3 < NT) { WAIT_BAR(2); } else if ((tt) + 2 < NT) { WAIT_BAR(1); } else { WAIT_BAR(0); } } while (0)
  for (; t + 1 < NT; t += 2) {
    STEP(pB0, pB1, pA0, pA1, t, (t + 3 < NT), (t + 1 < NT), (t + 1 < NT));       ENDW(t);     RESC(); ROT();
    STEP(pA0, pA1, pB0, pB1, t + 1, (t + 4 < NT), (t + 2 < NT), (t + 2 < NT));   ENDW(t + 1); RESC(); ROT();
  }
  STEP(pB0, pB1, pA0, pA1, NT - 1, false, false, false); RESC();
  { float sacc = pB0[0] + pB0[1]; _Pragma("unroll") for (int r = 2; r < 16; ++r) sacc += pB0[r]; _Pragma("unroll") for (int r = 0; r < 16; ++r) sacc += pB1[r]; l_reg += sacc;
    pw0 = (u32x4){PKW(pB0, 0), PKW(pB0, 2), PKW(pB0, 4), PKW(pB0, 6)}; pw1 = (u32x4){PKW(pB0, 8), PKW(pB0, 10), PKW(pB0, 12), PKW(pB0, 14)}; pw2 = (u32x4){PKW(pB1, 0), PKW(pB1, 2), PKW(pB1, 4), PKW(pB1, 6)}; pw3 = (u32x4){PKW(pB1, 8), PKW(pB1, 10), PKW(pB1, 12), PKW(pB1, 14)};
    SBAR(); pv(o, vb0 + sl_cur, PAF(0), PAF(1), PAF(2), PAF(3)); }
  #undef PKW
  #undef PAF
  #undef VFR
  #undef PIN
  #undef MX3
  #undef GAPA
  #undef GAPB
  #undef EX
  #undef VRD
  #undef KRD
  #undef QRD
  #undef STEP
  #undef ENDW
  { auto rr = __builtin_amdgcn_permlane32_swap(__float_as_uint(l_reg), __float_as_uint(l_reg), false, false); l_reg = __uint_as_float(rr[0]) + __uint_as_float(rr[1]); }
  if (hi == 0) wsf[32 + r32] = l_reg; asm volatile("s_waitcnt lgkmcnt(0)" ::: "memory");
  float rli[16];
  #pragma unroll
  for (int r = 0; r < 16; ++r) rli[r] = __builtin_amdgcn_rcpf(wsf[32 + crow(r, hi)]);
  bf16_t* Ow = Ob + (rowbase + q0 + wid * QBLK) * DMQ + h * D;
  { bf16_t* stg = (bf16_t*)(shm + LDS_OST) + wid * 2048;
    #pragma unroll
    for (int r = 0; r < 16; ++r) { const int orow = crow(r, hi);
      #pragma unroll
      for (int d0 = 0; d0 < 2; ++d0) stg[orow * 64 + d0 * 32 + r32] = (bf16_t)f2bf(o[d0][r] * rli[r]); }
    asm volatile("s_waitcnt lgkmcnt(0)" ::: "memory");
    #pragma unroll
    for (int i = 0; i < 4; ++i) { const int row = i * 8 + (lane >> 3), ch = lane & 7; const u32x4 v = *(const u32x4*)(stg + row * 64 + ch * 8); ATTN_STORE16(Ow + (long)row * DMQ + ch * 8, v); } }
  asm volatile("s_waitcnt lgkmcnt(0)\n\ts_barrier" ::: "memory");
  #undef DMA_K
  #undef DMA_V
  #undef CMASK
  #undef START
  #undef RESC
  #undef ROT
  #undef SELROW
  #undef NEGM_SET
}
#undef SBAR
#undef WAIT_BAR
}
__device__ __forceinline__ void conv_pass(Frame& F) {
    bf16_t* YAB = WSP(bf16_t, WS_YAB); const bf16_t* U = WSP(bf16_t, WS_U); const bf16_t* BG = WSP(bf16_t, WS_BG);
    const int stride = F.G * NTHREADS;
    for (int i0 = blockIdx.x * NTHREADS + F.tid; i0 < T * 64; i0 += 2 * stride) {
        u32x4 r2[2], r1[2], r0[2], rb[2];
#pragma unroll
        for (int q = 0; q < 2; ++q) { const int i = i0 + q * stride; const int t = i >> 6, c0 = (i & 63) * 8, pos = t & (S - 1);
            r2[q] = *(const u32x4*)(U + (size_t)t * 512 + c0); rb[q] = __builtin_nontemporal_load((const u32x4*)(BG + (size_t)t * 512 + c0));
            r1[q] = (pos >= 1) ? *(const u32x4*)(U + (size_t)(t - 1) * 512 + c0) : (u32x4){0u, 0u, 0u, 0u};
            r0[q] = (pos >= 2) ? *(const u32x4*)(U + (size_t)(t - 2) * 512 + c0) : (u32x4){0u, 0u, 0u, 0u}; }
#pragma unroll
        for (int q = 0; q < 2; ++q) { const int i = i0 + q * stride; const int t = i >> 6, c0 = (i & 63) * 8;
            float u0[8], u1[8], u2[8], bg[8], y[8]; unpack8(r2[q], u2); unpack8(r1[q], u1); unpack8(r0[q], u0); unpack8(rb[q], bg);
#pragma unroll
            for (int e4 = 0; e4 < 2; ++e4) { const f32x4 w0 = *(const f32x4*)(F.conv_w + c0 + 4 * e4), w1 = *(const f32x4*)(F.conv_w + 512 + c0 + 4 * e4), w2 = *(const f32x4*)(F.conv_w + 1024 + c0 + 4 * e4), cb = *(const f32x4*)(F.conv_b + c0 + 4 * e4);
#pragma unroll
                for (int e = 0; e < 4; ++e) y[4 * e4 + e] = bg[4 * e4 + e] * (w0[e] * u0[4 * e4 + e] + w1[e] * u1[4 * e4 + e] + w2[e] * u2[4 * e4 + e] + cb[e]); }
            st16(YAB + (size_t)t * 1024 + 512 + c0, pack8(y)); }
    }
}
__device__ __forceinline__ void s3_attn(Frame& F, char* lds_gen, bf16_t* obase) {
    const int vcu = (blockIdx.x % 8) * (F.G / 8) + blockIdx.x / 8;
    const int s = vcu & 7, pr = vcu >> 3;
#pragma unroll 1
    for (int i = 0; i < 4; ++i) {
        const int bh = 2 * pr + (i >> 1), qb = (i & 1) ? 15 - s : s;
        attn_body::attn_unit<8>(bh >> 3, bh & 7, qb, WSP(bf16_t, WS_YAB), obase, WSP(bf16_t, WS_K), WSP(bf16_t, WS_V), WSP(float, WS_KMEAN), lds_gen);
        if (!(i & 1)) { { int t_ = threadIdx.x; asm volatile("" : "+v"(t_)); F.tid = t_; F.lane = t_ & 63; }
            const int lo = X_NONEXP + (i >> 1) * (NE * 256);
            convert_items(F, lo, lo + NE * 256, blockIdx.x * NWAVES + F.wave, F.G * NWAVES);
            __syncthreads(); }
    }
}
__device__ __forceinline__ void s3_fast(Frame& F, char* lds_gen) { s3_attn(F, lds_gen, WSP(bf16_t, WS_YAB)); conv_pass(F); }

__device__ __forceinline__ void s4_simple(Frame& F) {
    LAS float* tile = (LAS float*)F.lds; LAS float* tile2 = tile + 64 * 65;
    const bf16_t* YAB = WSP(bf16_t, WS_YAB); const bf16_t* WP = WSP(bf16_t, WS_WP_T); const bf16_t* GT = WSP(bf16_t, WS_GATES);
    const int row = F.tid >> 3, seg = F.tid & 7;
    for (int it = blockIdx.x; it < 512 * 16; it += F.G) {
        const int rt = it >> 4, ct = it & 15, r0 = rt * 64, gr = r0 + row;
        const RowsLinear aa{YAB + (size_t)r0 * 1024, 1024}, ab{YAB + (size_t)r0 * 1024 + 512, 1024};
        const RowsLinear ba{WP + (size_t)(64 * ct) * 1024, 1024}, bb{WP + (size_t)(64 * ct) * 1024 + 512, 1024};
        sgemm_tile(tile, 512, aa, ba, F.wave, F.lane); sgemm_tile(tile2, 512, ab, bb, F.wave, F.lane); __syncthreads();
        float ga[8], gb[8], v[8];
        unpack8(*(const u32x4*)(GT + (size_t)gr * 2048 + 64 * ct + 8 * seg), ga); unpack8(*(const u32x4*)(GT + (size_t)gr * 2048 + 1024 + 64 * ct + 8 * seg), gb);
#pragma unroll
        for (int e = 0; e < 8; ++e) v[e] = ga[e] * tile[row * 65 + 8 * seg + e] + gb[e] * tile2[row * 65 + 8 * seg + e];
        *(u32x4*)(WSP(bf16_t, WS_H) + (size_t)gr * 1024 + 64 * ct + 8 * seg) = pack8(v);
        __syncthreads();
    }
}
__device__ __forceinline__ void s5_simple(Frame& F) {
    LAS float* tile = (LAS float*)F.lds;
    const bf16_t* MG = WSP(bf16_t, WS_H); const bf16_t* WO = WSP(bf16_t, WS_WO_T);
    const int row = F.tid >> 3, seg = F.tid & 7;
    for (int it = blockIdx.x; it < 512 * 16; it += F.G) {
        const int rt = it >> 4, ct = it & 15, r0 = rt * 64, gr = r0 + row, b = r0 / S;
        const RowsLinear aa{MG + (size_t)r0 * 1024, 1024}, bb{WO + (size_t)(64 * ct) * 1024, 1024};
        sgemm_tile(tile, 1024, aa, bb, F.wave, F.lane); __syncthreads();
        const float* ga1 = WSP(float, WS_MOD) + (size_t)b * NMOD + 2048 + 64 * ct + 8 * seg;
        const float* xr = F.x + (size_t)gr * D + 64 * ct + 8 * seg; float* orow = F.out + (size_t)gr * D + 64 * ct + 8 * seg;
#pragma unroll
        for (int e4 = 0; e4 < 2; ++e4) { const f32x4 xv = *(const f32x4*)(xr + 4 * e4), gv = *(const f32x4*)(ga1 + 4 * e4); f32x4 o;
#pragma unroll
            for (int e = 0; e < 4; ++e) o[e] = xv[e] + gv[e] * tile[row * 65 + 8 * seg + 4 * e4 + e];
            *(f32x4*)(orow + 4 * e4) = o; }
        __syncthreads();
    }
}

struct EpiG2 {
    static constexpr bool HAS_MID = true;
    const bf16_t* gates; bf16_t* merged;
    __device__ __forceinline__ void mid(Acc& acc, const pg8::Unit& u, int wr, int wc, int fr, int fq) const {
        int row0 = u.pm * 256 + wr * 64 + fr; const int c0 = u.pn * 256 + 32 * wc + 8 * fq; asm volatile("" : "+v"(row0));
#pragma unroll
        for (int ai = 0; ai < 2; ++ai)
#pragma unroll
            for (int m = 0; m < 4; ++m) { const bf16_t* gp = gates + (size_t)(row0 + 128 * ai + 16 * m) * 2048 + c0;
#pragma unroll
                for (int bj = 0; bj < 2; ++bj) { f32x4 a0, a1; unpack8v(__builtin_nontemporal_load((const u32x4*)(gp + 128 * bj)), a0, a1);
                    acc[ai][bj][m][0] *= a0; acc[ai][bj][m][1] *= a1; } }
    }
    __device__ __forceinline__ void operator()(Acc& acc, const pg8::Unit& u, int wr, int wc, int fr, int fq) const {
        int row0 = u.pm * 256 + wr * 64 + fr; const int c0 = u.pn * 256 + 32 * wc + 8 * fq; asm volatile("" : "+v"(row0));
#pragma unroll
        for (int ai = 0; ai < 2; ++ai)
#pragma unroll
            for (int m = 0; m < 4; ++m) { const size_t r = (size_t)(row0 + 128 * ai + 16 * m);
#pragma unroll
                for (int bj = 0; bj < 2; ++bj) { f32x4 b0, b1; unpack8v(__builtin_nontemporal_load((const u32x4*)(gates + r * 2048 + 1024 + c0 + 128 * bj)), b0, b1);
                    *(u32x2*)((unsigned char*)merged + r * 1024 + c0 + 128 * bj) = pack8_fp8(acc[ai][bj][m][0] * b0, acc[ai][bj][m][1] * b1); } }
    }
};
__device__ __forceinline__ void s4_fast(Frame& F) {
    const pg8::DenseSched Sd{(const char*)(F.ws + WS_YAB), (const char*)(F.ws + WS_WP_T), T / 256, 4, 1024, F.G, (int)blockIdx.x};
    const EpiG2 E{WSP(bf16_t, WS_GATES), WSP(bf16_t, WS_H)};
    if (F.skip) pg8::gemm_phase<EpiG2, pg8::DenseSched, true>(F.lds, 1024, Sd, E); else pg8::gemm_phase<EpiG2, pg8::DenseSched>(F.lds, 1024, Sd, E);
}
struct EpiG3 {
    static constexpr bool HAS_MID = false;
    const float* x; bf16_t* x1; const float* mod;
    __device__ __forceinline__ void mid(Acc&, const pg8::Unit&, int, int, int, int) const {}
    __device__ __forceinline__ void operator()(Acc& acc, const pg8::Unit& u, int wr, int wc, int fr, int fq) const {
        int row0 = u.pm * 256 + wr * 64 + fr; const int c0 = u.pn * 256 + 32 * wc + 8 * fq, b = u.pm >> 4; asm volatile("" : "+v"(row0));
        f32x4 gv[2][2];
#pragma unroll
        for (int bj = 0; bj < 2; ++bj)
#pragma unroll
            for (int n = 0; n < 2; ++n) gv[bj][n] = *(const f32x4*)(mod + (size_t)b * NMOD + 2048 + c0 + 128 * bj + 4 * n) * (1.f / W8_SCALE);
#pragma unroll
        for (int ai = 0; ai < 2; ++ai)
#pragma unroll
            for (int m = 0; m < 4; ++m) { const size_t off = (size_t)(row0 + 128 * ai + 16 * m) * D + c0;
#pragma unroll
                for (int bj = 0; bj < 2; ++bj) { const f32x4 x0 = __builtin_nontemporal_load((const f32x4*)(x + off + 128 * bj)), x1v = __builtin_nontemporal_load((const f32x4*)(x + off + 128 * bj + 4));
                    st16(x1 + off + 128 * bj, pack8v(x0 + gv[bj][0] * acc[ai][bj][m][0], x1v + gv[bj][1] * acc[ai][bj][m][1])); }
                if (m == 3) asm volatile("" ::: "memory"); }
    }
};
__device__ __forceinline__ void s5_fast(Frame& F) {
    const pg8::DenseSched8 Sd{(const char*)(F.ws + WS_H), (const char*)(F.ws + WS_WO_T), T / 256, 4, 1024, F.G, (int)blockIdx.x};
    const EpiG3 E{F.x, WSP(bf16_t, WS_X1), WSP(float, WS_MOD)};
    int Ko = D; asm volatile("" : "+s"(Ko));
    pg8::gemm_phase<EpiG3, pg8::DenseSched8>(F.lds, Ko, Sd, E);
}
struct MoeTab { const LAS int* cnt; const LAS int* tstart; const LAS int* tile_e; int nM; };
__device__ __forceinline__ MoeTab moe_table(Frame& F) {
    LAS int* cntL = (LAS int*)(F.lds + MISC_OFF + 1024); LAS int* ts = cntL + 32; LAS int* te = cntL + 96;
    if (F.tid < 32) cntL[F.tid] = (int)__hip_atomic_load(WSP(unsigned, WS_CTL) + CW_GCNT + 64 * F.tid, __ATOMIC_RELAXED, __HIP_MEMORY_SCOPE_AGENT);
    __syncthreads();
    if (F.tid == 0) { int pm = 0; for (int e = 0; e < 32; ++e) { ts[e] = pm; const int n = (cntL[e] + 255) >> 8; for (int i = 0; i < n; ++i) te[pm++] = e; } ts[32] = pm; }
    __syncthreads();
    return MoeTab{cntL, ts, te, ts[32]};
}
struct MoeUpSched {
    static constexpr bool GATHER = true, FP8 = true;
    const char* h2; const char* w13; MoeTab tb; const int* linfo; int G, c;
    __device__ __forceinline__ bool next(int i, pg8::Unit& u) const { if (!pg8::static_unit(i, G, c, tb.nM, 4, u.pm, u.pn)) return false;
        u.e = tb.tile_e[u.pm]; u.rbase = (u.pm - tb.tstart[u.e]) * 256; u.a = h2; u.b = w13 + ((size_t)u.e * 1024 + 256 * u.pn) * 1024; return true; }
    __device__ __forceinline__ int row_index(const pg8::Unit& u, int r) const { const int rank = u.rbase + r; return rank < tb.cnt[u.e] ? (linfo[(size_t)u.e * 65536 + rank] >> 1) : 0; }
};
struct EpiUp {
    static constexpr bool HAS_MID = false;
    bf16_t* hid; const float* lw; const LAS int* cnt;
    __device__ __forceinline__ void mid(Acc&, const pg8::Unit&, int, int, int, int) const {}
    __device__ __forceinline__ void operator()(Acc& acc, const pg8::Unit& u, int wr, int wc, int fr, int fq) const {
        int rl0 = wr * 64 + fr; const int c0 = u.pn * 128 + 32 * wc + 8 * fq, n_e = cnt[u.e]; asm volatile("" : "+v"(rl0));
#pragma unroll
        for (int ai = 0; ai < 2; ++ai)
#pragma unroll
            for (int m = 0; m < 4; ++m) { const int rl = rl0 + 128 * ai + 16 * m, rank = u.rbase + rl; const float wt = rank < n_e ? 1.f : 0.f; f32x4 o[2];
#pragma unroll
                for (int n = 0; n < 2; ++n)
#pragma unroll
                    for (int e = 0; e < 4; ++e) { const float a = acc[ai][0][m][n][e] * (1.f / W8_SCALE), c = acc[ai][1][m][n][e] * (1.f / W8_SCALE); o[n][e] = a * __builtin_amdgcn_rcpf(1.f + __expf(-a)) * c * wt; }
                *(u32x2*)((unsigned char*)hid + (size_t)(u.pm * 256 + rl) * 512 + c0) = pack8_fp8(o[0], o[1]); }
    }
};
__device__ __forceinline__ void s8_fast(Frame& F) {
    const MoeTab tb = moe_table(F);
    const MoeUpSched Sd{(const char*)(F.ws + WS_H2), (const char*)(F.ws + WS_W13_T), tb, WSP(int, WS_LINFO), F.G, (int)blockIdx.x};
    const EpiUp E{WSP(bf16_t, WS_HID), WSP(float, WS_LW), tb.cnt};
    int Ku = D; asm volatile("" : "+s"(Ku));
    if (F.skip) pg8::gemm_phase<EpiUp, MoeUpSched, true>(F.lds, Ku, Sd, E); else pg8::gemm_phase<EpiUp, MoeUpSched>(F.lds, Ku, Sd, E);
    { int t_ = threadIdx.x; asm volatile("" : "+v"(t_)); F.tid = t_; F.lane = t_ & 63; }
    { const int units = tb.nM * 4, rem = units % F.G, nidle = (rem == 0) ? F.G : F.G - rem, me = (rem == 0) ? (int)blockIdx.x : (int)blockIdx.x - rem;
        if (me >= 0 && !F.skip) convert_items(F, X_W2, X_END, me * NWAVES + F.wave, nidle * NWAVES); }
}
struct MoeDownSched {
    static constexpr bool GATHER = false, FP8 = true;
    const char* hid; const char* w2; MoeTab tb; int G, c;
    __device__ __forceinline__ bool next(int i, pg8::Unit& u) const { if (!pg8::static_unit(i, G, c, tb.nM, 4, u.pm, u.pn)) return false;
        u.e = tb.tile_e[u.pm]; u.rbase = (u.pm - tb.tstart[u.e]) * 256; u.a = hid + (size_t)u.pm * 256 * 512; u.b = w2 + ((size_t)u.e * 1024 + 256 * u.pn) * 512; return true; }
    __device__ __forceinline__ int row_index(const pg8::Unit&, int) const { return 0; }
};
struct EpiDown {
    static constexpr bool HAS_MID = false;
    bf16_t* yslot; const int* linfo; const float* lw; const LAS int* cnt;
    __device__ __forceinline__ void mid(Acc&, const pg8::Unit&, int, int, int, int) const {}
    __device__ __forceinline__ void operator()(Acc& acc, const pg8::Unit& u, int wr, int wc, int fr, int fq) const {
        int rl0 = wr * 64 + fr; const int c0 = u.pn * 256 + 32 * wc + 8 * fq, n_e = cnt[u.e]; asm volatile("" : "+v"(rl0));
        int info[2][4]; float wt[2][4];
#pragma unroll
        for (int ai = 0; ai < 2; ++ai)
#pragma unroll
            for (int m = 0; m < 4; ++m) { const int rank = u.rbase + rl0 + 128 * ai + 16 * m, rc = rank < n_e ? rank : 0;
                info[ai][m] = linfo[(size_t)u.e * 65536 + rc]; wt[ai][m] = lw[(size_t)u.e * 65536 + rc] * (1.f / W8_SCALE); }
#pragma unroll
        for (int ai = 0; ai < 2; ++ai)
#pragma unroll
            for (int m = 0; m < 4; ++m) { const int rank = u.rbase + rl0 + 128 * ai + 16 * m;
                if (rank < n_e) {
#pragma unroll
                    for (int bj = 0; bj < 2; ++bj) st16(yslot + (size_t)info[ai][m] * 1024 + c0 + 128 * bj, pack8v(acc[ai][bj][m][0] * wt[ai][m], acc[ai][bj][m][1] * wt[ai][m])); } }
    }
};
__device__ __forceinline__ void s9_fast(Frame& F) {
    const MoeTab tb = moe_table(F);
    const MoeDownSched Sd{(const char*)(F.ws + WS_HID), (const char*)(F.ws + WS_W2_T), tb, F.G, (int)blockIdx.x};
    const EpiDown E{WSP(bf16_t, WS_YSLOT), WSP(int, WS_LINFO), WSP(float, WS_LW), tb.cnt};
    int Kd = DE; asm volatile("" : "+s"(Kd));
    if (F.skip) pg8::gemm_phase<EpiDown, MoeDownSched, true>(F.lds, Kd, Sd, E); else pg8::gemm_phase<EpiDown, MoeDownSched>(F.lds, Kd, Sd, E);
}

__device__ __forceinline__ void s6_router(Frame& F) {
    constexpr int WROW = 1032;
    LAS bf16_t* WT = (LAS bf16_t*)F.lds;
    LAS float* gsL = (LAS float*)(F.lds + 48 * WROW * 2);
    LAS float* shL = gsL + 1024;
    LAS float* biasL = shL + 1024;
    LAS float* lgt = biasL + 64;
    LAS int* cnt = (LAS int*)(F.lds + MISC_OFF + 256);
    LAS int* baseL = cnt + 32; LAS int* runL = cnt + 64; LAS int* eidL = cnt + 128; LAS float* ewL = (LAS float*)(cnt + 384);
    const int b = blockIdx.x >> 5;
    const float* mod = WSP(float, WS_MOD) + (size_t)b * NMOD;
    const float* W36 = WSP(float, WS_W36T);
    for (int i = F.tid; i < 36 * 256; i += NTHREADS) { const int jj = i >> 8, k4 = (i & 255) * 4; const f32x4 w = *(const f32x4*)(W36 + jj * 1024 + k4);
        u32x2 p; p.x = pk2(w.x, w.y); p.y = pk2(w.z, w.w); *(LAS u32x2*)(WT + jj * WROW + k4) = p; }
    for (int i = F.tid; i < 12 * 256; i += NTHREADS) { const int jj = 36 + (i >> 8), k4 = (i & 255) * 4; *(LAS u32x2*)(WT + jj * WROW + k4) = (u32x2){0u, 0u}; }
    if (F.tid < 256) { const int col = 4 * F.tid; const f32x4 g = *(const f32x4*)(F.g2 + col), s_ = *(const f32x4*)(mod + 4096 + col); *(LAS f32x4*)(gsL + col) = g * (s_ + 1.0f); *(LAS f32x4*)(shL + col) = *(const f32x4*)(mod + 3072 + col); }
    if (F.tid < 32) cnt[F.tid] = 0;
    __syncthreads();
    for (int jj = F.wave; jj < 36; jj += NWAVES) { float a = 0.f;
#pragma unroll
        for (int i = 0; i < 16; ++i) a += shL[F.lane + 64 * i] * W36[jj * 1024 + F.lane + 64 * i];
        a = wave_sum(a); if (F.lane == 0) biasL[jj] = a + ((jj < 4) ? F.b_rg[jj] : F.b_re[jj - 4]); }
    __syncthreads();
    const int fr = F.lane & 15, fq = F.lane >> 4, row0 = (blockIdx.x * NWAVES + F.wave) * 16, r = row0 + fr;
    const bf16_t* xr = WSP(bf16_t, WS_X1) + (size_t)r * D + 8 * fq;
    f32x4 D0 = {0.f, 0.f, 0.f, 0.f}, D1 = D0, D2 = D0; float ss = 0.f;
#pragma unroll 1
    for (int kb = 0; kb < 8; ++kb) {
        u32x4 xa[4];
#pragma unroll
        for (int i = 0; i < 4; ++i) xa[i] = *(const u32x4*)(xr + 32 * (4 * kb + i));
#pragma unroll
        for (int i = 0; i < 4; ++i) { const int k0 = 32 * (4 * kb + i) + 8 * fq;
            f32x4 a0, a1; unpack8v(xa[i], a0, a1);
            ss += (a0.x * a0.x + a0.y * a0.y) + (a0.z * a0.z + a0.w * a0.w) + (a1.x * a1.x + a1.y * a1.y) + (a1.z * a1.z + a1.w * a1.w);
            a0 *= *(const LAS f32x4*)(gsL + k0); a1 *= *(const LAS f32x4*)(gsL + k0 + 4);
            const bf16x8 A = __builtin_bit_cast(bf16x8, pack8v(a0, a1));
            const bf16x8 B0 = *(const LAS bf16x8*)(WT + fr * WROW + k0), B1 = *(const LAS bf16x8*)(WT + (16 + fr) * WROW + k0), B2 = *(const LAS bf16x8*)(WT + (32 + fr) * WROW + k0);
            D0 = __builtin_amdgcn_mfma_f32_16x16x32_bf16(A, B0, D0, 0, 0, 0);
            D1 = __builtin_amdgcn_mfma_f32_16x16x32_bf16(A, B1, D1, 0, 0, 0);
            D2 = __builtin_amdgcn_mfma_f32_16x16x32_bf16(A, B2, D2, 0, 0, 0); }
    }
    ss += __shfl_xor(ss, 16); ss += __shfl_xor(ss, 32);
    const float rinv = rsqrtf(ss * (1.f / D) + EPS);
    { int t2 = threadIdx.x; asm volatile("" : "+v"(t2)); F.lane = t2 & 63; }
    const int fr_ = F.lane & 15, fq_ = F.lane >> 4;
    {
        LAS float* lw = lgt + F.wave * 16 * 37;
#pragma unroll
        for (int reg = 0; reg < 4; ++reg) { const float rv = __shfl(rinv, 4 * fq_ + reg); const int tk = 4 * fq_ + reg;
            lw[tk * 37 + fr_] = D0[reg] * rv + biasL[fr_]; lw[tk * 37 + 16 + fr_] = D1[reg] * rv + biasL[16 + fr_];
            if (fr_ < 4) lw[tk * 37 + 32 + fr_] = D2[reg] * rv + biasL[32 + fr_]; }
    }
    {
        const int r_ = row0 + fr_; const bf16_t* xr_ = WSP(bf16_t, WS_X1) + (size_t)r_ * D + 8 * fq_;
        unsigned char* o = WSP(unsigned char, WS_H2) + (size_t)r_ * D + 8 * fq_;
#pragma unroll 1
        for (int kb = 0; kb < 8; ++kb) {
            u32x4 xa[4];
#pragma unroll
            for (int i = 0; i < 4; ++i) xa[i] = *(const u32x4*)(xr_ + 32 * (4 * kb + i));
#pragma unroll
            for (int i = 0; i < 4; ++i) { const int k0 = 32 * (4 * kb + i) + 8 * fq_; f32x4 a0, a1; unpack8v(xa[i], a0, a1);
                const f32x4 h0 = a0 * rinv * *(const LAS f32x4*)(gsL + k0) + *(const LAS f32x4*)(shL + k0), h1 = a1 * rinv * *(const LAS f32x4*)(gsL + k0 + 4) + *(const LAS f32x4*)(shL + k0 + 4);
                *(u32x2*)(o + 32 * (4 * kb + i)) = pack8_fp8(h0, h1); }
        }
    }
    if (F.lane < 16) {
        const int t = row0 + F.lane; const LAS float* lw = lgt + (F.wave * 16 + F.lane) * 37;
        float lg[36];
#pragma unroll
        for (int jj = 0; jj < 36; ++jj) lg[jj] = lw[jj];
        int gi = 0; float gm = lg[0];
#pragma unroll
        for (int i = 1; i < 4; ++i) if (lg[i] > gm) { gm = lg[i]; gi = i; }
        float den = 0.f;
#pragma unroll
        for (int i = 0; i < 4; ++i) den += __expf(lg[i] - gm);
        const float gw_ = 1.f / den;
        float v1 = -INFINITY, v2 = -INFINITY; int e1 = 0, e2 = 0;
#pragma unroll
        for (int i = 0; i < 8; ++i) { const float el = (gi == 0) ? lg[4 + i] : (gi == 1) ? lg[12 + i] : (gi == 2) ? lg[20 + i] : lg[28 + i];
            const bool c1 = el > v1, c2 = el > v2;
            v2 = c1 ? v1 : (c2 ? el : v2); e2 = c1 ? e1 : (c2 ? i : e2); v1 = c1 ? el : v1; e1 = c1 ? i : e1; }
        const float p1 = 1.f / (1.f + __expf(v2 - v1)), p2 = 1.f - p1;
        const int id1 = gi * 8 + e1, id2 = gi * 8 + e2;
        const int la = 2 * (F.wave * 16 + F.lane);
        eidL[la] = id1; eidL[la + 1] = id2; ewL[la] = p1 * gw_; ewL[la + 1] = p2 * gw_;
        lds_add(&cnt[id1], 1); lds_add(&cnt[id2], 1);
    }
    __syncthreads();
    if (F.tid < 32) { baseL[F.tid] = (int)__hip_atomic_fetch_add(WSP(unsigned, WS_CTL) + CW_GCNT + 64 * F.tid, (unsigned)cnt[F.tid], __ATOMIC_RELAXED, __HIP_MEMORY_SCOPE_AGENT); runL[F.tid] = 0; }
    __syncthreads();
    if (F.tid < 256) { const int e = eidL[F.tid]; const int pos = baseL[e] + lds_add(&runL[e], 1);
        WSP(int, WS_LINFO)[(size_t)e * 65536 + pos] = 2 * (blockIdx.x * 128) + F.tid; WSP(float, WS_LW)[(size_t)e * 65536 + pos] = ewL[F.tid]; }
    __syncthreads();
}

__device__ __forceinline__ void s7_lists(Frame& F) {
    LAS int* sm = (LAS int*)F.lds;
    const int* bc = WSP(int, WS_BCNT);
    if (F.tid < 32) { int tot = 0, base = 0; for (int bb = 0; bb < 256; ++bb) { const int c = bc[bb * 32 + F.tid]; if (bb < (int)blockIdx.x) base += c; tot += c; }
        sm[F.tid] = tot; sm[32 + F.tid] = base; sm[96 + F.tid] = 0; }
    __syncthreads();
    if (F.tid == 0) { int ps = 0; for (int e = 0; e < 32; ++e) { sm[64 + e] = ps; ps += (sm[e] + 255) & ~255; }
        if (blockIdx.x == 0) { int* te = WSP(int, WS_TILEE); int pm = 0; for (int e = 0; e < 32; ++e) { const int n = (sm[e] + 255) >> 8; for (int i = 0; i < n; ++i) te[1 + pm++] = e; } te[0] = pm; } }
    __syncthreads();
    int* atok = WSP(int, WS_ATOK); int* ainfo = WSP(int, WS_AINFO); float* aw = WSP(float, WS_AW);
    if (F.tid < 256) { const int a = blockIdx.x * 256 + F.tid;
        const int e = WSP(int, WS_EID)[a]; const int rank = lds_add(&sm[96 + e], 1); const int pos = sm[64 + e] + sm[32 + e] + rank;
        atok[pos] = a >> 1; ainfo[pos] = a; aw[pos] = WSP(float, WS_EW)[a]; }
    if (blockIdx.x < 32) { const int e = blockIdx.x; const int lo = sm[64 + e] + sm[e], hi = sm[64 + e] + ((sm[e] + 255) & ~255);
        for (int p = lo + F.tid; p < hi; p += NTHREADS) { atok[p] = 0; ainfo[p] = -1; aw[p] = 0.f; } }
}

struct RowsGather { const bf16_t* base; const int* idx; __device__ __forceinline__ const bf16_t* operator()(int r) const { return base + (size_t)idx[r] * 1024; } };
__device__ __forceinline__ void s8_simple(Frame& F) {
    LAS float* tile = (LAS float*)F.lds; LAS float* tile2 = tile + 64 * 65;
    const int* te = WSP(int, WS_TILEE); const int nmt = te[0];
    const int row = F.tid >> 3, seg = F.tid & 7;
    for (int it = blockIdx.x; it < nmt * 4 * 8; it += F.G) {
        const int rt = it >> 3, ct = it & 7, e = te[1 + (rt >> 2)], pos0 = 64 * rt, hc = 64 * ct;
        const RowsGather ar{WSP(bf16_t, WS_H2), WSP(int, WS_ATOK) + pos0};
        const bf16_t* wb = WSP(bf16_t, WS_W13_T) + ((size_t)e * 1024 + 256 * (hc >> 7) + (hc & 127)) * 1024;
        const RowsLinear b1{wb, 1024}, b3{wb + (size_t)128 * 1024, 1024};
        sgemm_tile(tile, 1024, ar, b1, F.wave, F.lane); sgemm_tile(tile2, 1024, ar, b3, F.wave, F.lane); __syncthreads();
        const float wt = WSP(float, WS_AW)[pos0 + row]; float v[8];
#pragma unroll
        for (int e8 = 0; e8 < 8; ++e8) { const float a = tile[row * 65 + 8 * seg + e8], c = tile2[row * 65 + 8 * seg + e8]; v[e8] = (a / (1.f + __expf(-a))) * c * wt; }
        *(u32x4*)(WSP(bf16_t, WS_HID) + (size_t)(pos0 + row) * 512 + hc + 8 * seg) = pack8(v);
        __syncthreads();
    }
}
__device__ __forceinline__ void s9_simple(Frame& F) {
    LAS float* tile = (LAS float*)F.lds;
    const int* te = WSP(int, WS_TILEE); const int nmt = te[0];
    const int row = F.tid >> 3, seg = F.tid & 7;
    for (int it = blockIdx.x; it < nmt * 4 * 16; it += F.G) {
        const int rt = it >> 4, ct = it & 15, e = te[1 + (rt >> 2)], pos0 = 64 * rt;
        const RowsLinear ar{WSP(bf16_t, WS_HID) + (size_t)pos0 * 512, 512};
        const RowsLinear br{WSP(bf16_t, WS_W2_T) + ((size_t)e * 1024 + 64 * ct) * 512, 512};
        sgemm_tile(tile, 512, ar, br, F.wave, F.lane); __syncthreads();
        const int info = WSP(int, WS_AINFO)[pos0 + row];
        if (info >= 0) { float v[8];
#pragma unroll
            for (int e8 = 0; e8 < 8; ++e8) v[e8] = tile[row * 65 + 8 * seg + e8];
            *(u32x4*)(WSP(bf16_t, WS_YSLOT) + (size_t)info * 1024 + 64 * ct + 8 * seg) = pack8(v); }
        __syncthreads();
    }
}
__device__ __forceinline__ void s10_combine(Frame& F) {
    const bf16_t* Y = WSP(bf16_t, WS_YSLOT); const bf16_t* X1 = WSP(bf16_t, WS_X1);
    const int stride = F.G * NTHREADS;
    for (int i0 = blockIdx.x * NTHREADS + F.tid; i0 < T * 128; i0 += 2 * stride) {
        u32x4 ya[2], yb[2], xx[2]; f32x4 g0[2], g1[2];
#pragma unroll
        for (int q = 0; q < 2; ++q) { const int i = i0 + q * stride; const int t = i >> 7, c0 = (i & 127) * 8, b = t / S;
            ya[q] = __builtin_nontemporal_load((const u32x4*)(Y + (size_t)(2 * t) * 1024 + c0)); yb[q] = __builtin_nontemporal_load((const u32x4*)(Y + (size_t)(2 * t + 1) * 1024 + c0)); xx[q] = __builtin_nontemporal_load((const u32x4*)(X1 + (size_t)t * D + c0));
            const float* ga2 = WSP(float, WS_MOD) + (size_t)b * NMOD + 5120 + c0; g0[q] = *(const f32x4*)ga2; g1[q] = *(const f32x4*)(ga2 + 4); }
#pragma unroll
        for (int q = 0; q < 2; ++q) { const int i = i0 + q * stride; const int t = i >> 7, c0 = (i & 127) * 8;
            f32x4 y0a, y0b, y1a, y1b, xa, xb; unpack8v(ya[q], y0a, y0b); unpack8v(yb[q], y1a, y1b); unpack8v(xx[q], xa, xb);
            float* o = F.out + (size_t)t * D + c0;
            __builtin_nontemporal_store(xa + g0[q] * (y0a + y1a), (f32x4*)o); __builtin_nontemporal_store(xb + g1[q] * (y0b + y1b), (f32x4*)(o + 4)); }
    }
}

constexpr int N_PHASES = 11;
struct Args { const float* in[21]; float* out; unsigned char* ws; int ph_lo, ph_hi; };
__global__ void __launch_bounds__(NTHREADS, 2) mega_fwd(Args args) {
    extern __shared__ __attribute__((aligned(16))) unsigned char lds_raw[];
    Frame F;
    F.lds = (LAS unsigned char*)lds_raw;
    F.tid = threadIdx.x; F.lane = F.tid & 63; F.wave = __builtin_amdgcn_readfirstlane(F.tid >> 6); F.G = gridDim.x; F.skip = 0;
    F.x = args.in[0]; F.c = args.in[1]; F.w_ada = args.in[2]; F.b_ada = args.in[3]; F.g1 = args.in[4]; F.g2 = args.in[5]; F.w_in = args.in[6]; F.g_q = args.in[7]; F.g_k = args.in[8];
    F.conv_w = args.in[9]; F.conv_b = args.in[10]; F.w_pa = args.in[11]; F.w_pb = args.in[12]; F.w_o = args.in[13]; F.w_rg = args.in[14]; F.b_rg = args.in[15]; F.w_re = args.in[16]; F.b_re = args.in[17];
    F.w1 = args.in[18]; F.w3 = args.in[19]; F.w2 = args.in[20]; F.out = args.out; F.ws = args.ws;
    volatile LAS unsigned* MISC = (volatile LAS unsigned*)(F.lds + MISC_OFF);
    if (F.tid < 64) MISC[F.tid] = 0u;
    __syncthreads();
    XcdBarrier bar = xcd_barrier_post((unsigned*)(F.ws + WS_CTL) + CW_BAR, MISC + 8);
    const int lo = args.ph_lo, hi = args.ph_hi;
    unsigned long long pst0 = 0, pst1 = 0;
#define PHASE(k, body) if (lo <= (k) && (k) < hi) { if (PROBE_PHASE == (k)) pst0 = __builtin_amdgcn_s_memrealtime(); for (int rep_ = 0; rep_ < 1 + ((REPEAT_MASK >> (k)) & 1); ++rep_) { { int t_ = threadIdx.x; asm volatile("" : "+v"(t_)); F.tid = t_; F.lane = t_ & 63; } body; __syncthreads(); } if ((NOEPI_MASK >> (k)) & 1) { int s_ = 1; asm volatile("" : "+s"(s_)); F.skip = s_; { int t_ = threadIdx.x; asm volatile("" : "+v"(t_)); F.tid = t_; F.lane = t_ & 63; } body; __syncthreads(); F.skip = 0; } if ((k) + 1 < hi) xcd_barrier(bar); if (PROBE_PHASE == (k)) pst1 = __builtin_amdgcn_s_memrealtime(); }
    PHASE(0, s0_prologue(F); wait_mod(F); s1_norm1(F))
    PHASE(2, s2_fast(F))
    PHASE(3, s3_fast(F, (char*)lds_raw))
    PHASE(4, s4_fast(F))
    PHASE(5, s5_fast(F))
    PHASE(6, s6_router(F))
    PHASE(8, s8_fast(F))
    PHASE(9, s9_fast(F))
    PHASE(10, s10_combine(F))
#undef PHASE
    if (PROBE_PHASE >= 0 && blockIdx.x == 0) { const unsigned long long t0 = __builtin_amdgcn_s_memrealtime(), dt = pst1 - pst0; while (__builtin_amdgcn_s_memrealtime() - t0 < dt) __builtin_amdgcn_s_sleep(8); }
}

extern "C" void kernel_launch(void* const* d_in, const int* in_sizes, int n_in, void* d_out, int out_size, void* d_ws, size_t ws_size, hipStream_t stream) {
    static int grid = 0;
    if (grid == 0) {
        if (n_in != 21 || in_sizes[0] != T * D || out_size != T * D || ws_size < WS_END) { fprintf(stderr, "kernel_launch: unexpected shapes (n_in %d, in0 %d, out %d, ws %zu); nothing launched\n", n_in, n_in > 0 ? in_sizes[0] : -1, out_size, ws_size); grid = -1; return; }
        int dev = 0, cus = 0, per_cu = 0;
        if (hipGetDevice(&dev) != hipSuccess || hipDeviceGetAttribute(&cus, hipDeviceAttributeMultiprocessorCount, dev) != hipSuccess) { grid = -1; return; }
        if (hipFuncSetAttribute((const void*)mega_fwd, hipFuncAttributeMaxDynamicSharedMemorySize, LDS_BYTES) != hipSuccess) { fprintf(stderr, "kernel_launch: hipFuncSetAttribute failed\n"); grid = -1; return; }
        if (hipOccupancyMaxActiveBlocksPerMultiprocessor(&per_cu, (const void*)mega_fwd, NTHREADS, LDS_BYTES) != hipSuccess || per_cu < 1) { fprintf(stderr, "kernel_launch: occupancy query says %d blocks per CU\n", per_cu); per_cu = 1; }
        (void)hipGetLastError();
        if (cus < 256) { fprintf(stderr, "kernel_launch: built for a 256-CU device, found %d CUs; nothing launched\n", cus); grid = -1; return; }
        grid = 256;
    }
    if (grid < 0) return;
    (void)hipMemsetAsync((char*)d_ws + WS_CTL, 0, CTL_ZERO_BYTES, stream);
    Args a{};
    for (int i = 0; i < 21; ++i) a.in[i] = (const float*)d_in[i];
    a.out = (float*)d_out; a.ws = (unsigned char*)d_ws; a.ph_lo = 0; a.ph_hi = N_PHASES;
    hipLaunchKernelGGL(mega_fwd, dim3(grid), dim3(NTHREADS), LDS_BYTES, stream, a);
}
```

```cpp
#include <hip/hip_runtime.h>
#include <hip/hip_bf16.h>
#include <cstdio>
#include <cstdint>

#ifndef REPEAT_MASK
#define REPEAT_MASK 0
#define NOEPI_MASK 0
#endif
#ifndef PROBE_PHASE
#define PROBE_PHASE -1
#endif
#define GAS __attribute__((address_space(1)))
#define LAS __attribute__((address_space(3)))
typedef unsigned short bf16_t;
typedef short bf16x8 __attribute__((ext_vector_type(8)));
typedef float f32x4 __attribute__((ext_vector_type(4)));
typedef unsigned u32x4 __attribute__((ext_vector_type(4)));
typedef unsigned u32x2 __attribute__((ext_vector_type(2)));

constexpr int T = 32768, D = 1024, NB = 8, S = 4096, NH = 8, DH = 64, NIN = 5120, NE = 32, DE = 512, NMOD = 6144;
constexpr int NTHREADS = 512, NWAVES = 8;
constexpr float EPS = 1e-6f;
constexpr float C2 = 0.125f * 1.4426950408889634f;
constexpr int MAX_MT = 288;
constexpr int NPAD = MAX_MT * 256;

constexpr size_t MiB = 1u << 20, KiB = 1024;
constexpr size_t WS_CTL = 0, CTL_ZERO_BYTES = 64 * KiB;
constexpr size_t WS_MOD = 1 * MiB;
constexpr size_t WS_ROPE = 1 * MiB + 256 * KiB;
constexpr size_t WS_KMEAN = 1 * MiB + 512 * KiB;
constexpr size_t WS_EID = 2 * MiB;
constexpr size_t WS_EW = 2 * MiB + 256 * KiB;
constexpr size_t WS_BCNT = 2 * MiB + 512 * KiB;
constexpr size_t WS_TILEE = 2 * MiB + 768 * KiB;
constexpr size_t WS_ATOK = 3 * MiB;
constexpr size_t WS_AINFO = 3 * MiB + 512 * KiB;
constexpr size_t WS_AW = 4 * MiB;
constexpr size_t WS_W36T = 5 * MiB;
constexpr size_t WS_WIN_T = 8 * MiB;
constexpr size_t WS_WIN8 = 14 * MiB;
constexpr size_t WS_H8 = 56 * MiB;
constexpr size_t WS_WP_T = 18 * MiB;
constexpr size_t WS_WO_T = 20 * MiB;
constexpr size_t WS_W13_T = 24 * MiB;
constexpr size_t WS_W2_T = 88 * MiB;
constexpr size_t WS_H = 120 * MiB;
constexpr size_t WS_YAB = 184 * MiB;
constexpr size_t WS_K = 248 * MiB;
constexpr size_t WS_V = 280 * MiB;
constexpr size_t WS_U = 312 * MiB;
constexpr size_t WS_BG = 344 * MiB;
constexpr size_t WS_GATES = 376 * MiB;
constexpr size_t WS_X1 = 184 * MiB;
constexpr size_t WS_H2 = 120 * MiB;
constexpr size_t WS_HID = 248 * MiB;
constexpr size_t WS_YSLOT = 320 * MiB;
constexpr size_t WS_LINFO = 448 * MiB;
constexpr size_t WS_LW = 456 * MiB;
constexpr size_t WS_END = 504 * MiB;
constexpr int CW_BAR = 4096, CW_MODCNT = 8192, CW_GCNT = 12288;

constexpr int LDS_BYTES = 159744;
constexpr int MISC_OFF = 147456;

__device__ __forceinline__ unsigned f2bf(float f) { unsigned u = __builtin_bit_cast(unsigned, f); return (u + 0x7fffu + ((u >> 16) & 1u)) >> 16; }
__device__ __forceinline__ float bf2f(unsigned h) { return __builtin_bit_cast(float, h << 16); }
typedef float f32x2_h __attribute__((ext_vector_type(2)));
typedef __bf16 bf16x2_h __attribute__((ext_vector_type(2)));
__device__ __forceinline__ unsigned pk2(float lo, float hi) { const f32x2_h v = {lo, hi}; return __builtin_bit_cast(unsigned, __builtin_convertvector(v, bf16x2_h)); }
__device__ __forceinline__ void unpack8(const u32x4 w, float (&v)[8]) {
    v[0] = bf2f(w.x & 0xffffu); v[1] = bf2f(w.x >> 16); v[2] = bf2f(w.y & 0xffffu); v[3] = bf2f(w.y >> 16);
    v[4] = bf2f(w.z & 0xffffu); v[5] = bf2f(w.z >> 16); v[6] = bf2f(w.w & 0xffffu); v[7] = bf2f(w.w >> 16);
}
__device__ __forceinline__ u32x4 pack8(const float (&v)[8]) { u32x4 w; w.x = pk2(v[0], v[1]); w.y = pk2(v[2], v[3]); w.z = pk2(v[4], v[5]); w.w = pk2(v[6], v[7]); return w; }
__device__ __forceinline__ u32x4 pack8v(const f32x4 a, const f32x4 b) { u32x4 w; w.x = pk2(a.x, a.y); w.y = pk2(a.z, a.w); w.z = pk2(b.x, b.y); w.w = pk2(b.z, b.w); return w; }
__device__ __forceinline__ void unpack8v(const u32x4 w, f32x4& a, f32x4& b) {
    a.x = bf2f(w.x & 0xffffu); a.y = bf2f(w.x >> 16); a.z = bf2f(w.y & 0xffffu); a.w = bf2f(w.y >> 16);
    b.x = bf2f(w.z & 0xffffu); b.y = bf2f(w.z >> 16); b.z = bf2f(w.w & 0xffffu); b.w = bf2f(w.w >> 16); }
#ifndef WT_STORES
#define WT_STORES 0
#define NT_STORES 1
#endif
__device__ __forceinline__ void st16(void* p, const u32x4 v) {
#if WT_STORES
    asm volatile("global_store_dwordx4 %0, %1, off sc1\n\ts_nop 1" :: "v"(p), "v"(v) : "memory");
#elif NT_STORES
    __builtin_nontemporal_store(v, (u32x4*)p);
#else
    *(u32x4*)p = v;
#endif
}
typedef int i32x8 __attribute__((ext_vector_type(8)));
__device__ __forceinline__ u32x2 pack8_fp8(const f32x4 a, const f32x4 b) {
    int lo = 0, hi = 0;
    lo = __builtin_amdgcn_cvt_pk_fp8_f32(a.x, a.y, lo, false); lo = __builtin_amdgcn_cvt_pk_fp8_f32(a.z, a.w, lo, true);
    hi = __builtin_amdgcn_cvt_pk_fp8_f32(b.x, b.y, hi, false); hi = __builtin_amdgcn_cvt_pk_fp8_f32(b.z, b.w, hi, true);
    return (u32x2){(unsigned)lo, (unsigned)hi};
}
constexpr float W8_SCALE = 64.f;
#define LDS_WAIT() asm volatile("s_waitcnt lgkmcnt(0)" ::: "memory")
__device__ __forceinline__ int lds_add(LAS int* p, int v) { return __hip_atomic_fetch_add(p, v, __ATOMIC_RELAXED, __HIP_MEMORY_SCOPE_WORKGROUP); }

#define XB_TMO      128
#define XB_XCNT(j)  (256  + 64 * (j))
#define XB_XSUB(j)  (1280 + 64 * (j))
#define XB_XGEN(j)  (2304 + 64 * (j))
#define XB_TOP      3328
#define XB_TOPGEN   3392
#define XCD_BAR_WORDS 3456
#define XB_SPIN_CAP (1u << 22)
__device__ __forceinline__ unsigned xb_ld(unsigned* p)              { return __hip_atomic_load(p, __ATOMIC_RELAXED, __HIP_MEMORY_SCOPE_AGENT); }
__device__ __forceinline__ unsigned xb_add(unsigned* p, unsigned v) { return __hip_atomic_fetch_add(p, v, __ATOMIC_RELAXED, __HIP_MEMORY_SCOPE_AGENT); }
__device__ __forceinline__ unsigned xb_xcc_id() { return (unsigned)__builtin_amdgcn_s_getreg((3 << 11) | 20) & 0xFu; }
#define XB_SPIN(cond, bar) do { unsigned _sp = 0; while (cond) { __builtin_amdgcn_s_sleep(1); \
    if ((++_sp & 255u) == 0u) { if (xb_ld(&(bar)[XB_TMO])) break; if (_sp > XB_SPIN_CAP) { atomicAdd(&(bar)[XB_TMO], 1u); break; } } } } while (0)
struct XcdBarrier { unsigned* bar; unsigned x; volatile LAS unsigned* st; };
__device__ __forceinline__ XcdBarrier xcd_barrier_post(unsigned* bar, volatile LAS unsigned* st) {
    XcdBarrier b; b.bar = bar; b.x = xb_xcc_id(); b.st = st;
    if (threadIdx.x == 0) (void)xb_add(&bar[XB_XCNT(b.x)], 1u);
    return b;
}
__device__ __forceinline__ void xcd_barrier_complete(unsigned* bar, unsigned x, unsigned& nloc, unsigned& nx) {
    const unsigned G = gridDim.x * gridDim.y * gridDim.z;
    unsigned sum, cnt, mine, sp = 0u;
    for (;;) {
        sum = 0u; cnt = 0u; mine = 0u;
#pragma unroll
        for (unsigned j = 0; j < 16; ++j) { const unsigned c = xb_ld(&bar[XB_XCNT(j)]); sum += c; cnt += (c > 0u) ? 1u : 0u; mine = (j == x) ? c : mine; }
        if (sum == G) break;
        __builtin_amdgcn_s_sleep(1);
        if ((++sp & 255u) == 0u) { if (xb_ld(&bar[XB_TMO])) break; if (sp > XB_SPIN_CAP) { atomicAdd(&bar[XB_TMO], 1u); break; } }
    }
    nloc = mine > 0u ? mine : 1u; nx = cnt > 0u ? cnt : 1u;
}
__device__ __forceinline__ void xcd_barrier(const XcdBarrier& b) {
    asm volatile("s_waitcnt vmcnt(0)" ::: "memory");
    __syncthreads();
    if (threadIdx.x == 0) {
        unsigned* bar = b.bar;
        __builtin_amdgcn_s_waitcnt(0);
        unsigned nloc = b.st[0], nx = b.st[1];
        if (nloc == 0u) { xcd_barrier_complete(bar, b.x, nloc, nx); b.st[0] = nloc; b.st[1] = nx; }
        const unsigned old = xb_add(&bar[XB_XSUB(b.x)], 1u);
        const unsigned gen = old / nloc;
        if (old + 1u == (gen + 1u) * nloc) {
            __builtin_amdgcn_fence(__ATOMIC_RELEASE, "agent");
            asm volatile("s_waitcnt vmcnt(0)" ::: "memory");
            const unsigned og = xb_add(&bar[XB_TOP], 1u);
            const unsigned tg = og / nx;
            if (og + 1u == (tg + 1u) * nx) xb_add(&bar[XB_TOPGEN], 1u);
            else XB_SPIN(xb_ld(&bar[XB_TOPGEN]) == tg, bar);
            __builtin_amdgcn_fence(__ATOMIC_ACQUIRE, "agent");
            xb_add(&bar[XB_XGEN(b.x)], 1u);
            asm volatile("s_waitcnt vmcnt(0)" ::: "memory");
        } else {
            XB_SPIN(xb_ld(&bar[XB_XGEN(b.x)]) == gen, bar);
            __builtin_amdgcn_fence(__ATOMIC_ACQUIRE, "agent");
            asm volatile("s_waitcnt vmcnt(0)" ::: "memory");
        }
    }
    __syncthreads();
}

struct Frame {
    LAS unsigned char* lds;
    int tid, lane, wave, G, skip;
    const float *x, *c, *w_ada, *b_ada, *g1, *g2, *w_in, *g_q, *g_k, *conv_w, *conv_b, *w_pa, *w_pb, *w_o, *w_rg, *b_rg, *w_re, *b_re, *w1, *w3, *w2;
    float* out; unsigned char* ws;
};
#define WSP(type, off) ((type*)(F.ws + (off)))

struct XItem { const float* src; unsigned char* dst; int N, pitch, fp8, swz; };
__device__ __forceinline__ void xitem_load(const XItem& it, f32x4 (&v)[8], int lane) {
    const int r8 = lane >> 3, c4 = lane & 7;
#pragma unroll
    for (int i = 0; i < 8; ++i) v[i] = __builtin_nontemporal_load((const f32x4*)(it.src + (size_t)(8 * i + r8) * it.N + 4 * c4));
}
__device__ __forceinline__ void xitem_store(const XItem& it, const f32x4 (&v)[8], LAS float* scr, int lane) {
    const int r8 = lane >> 3, c4 = lane & 7; const float scale = it.fp8 ? W8_SCALE : 1.f;
#pragma unroll
    for (int i = 0; i < 8; ++i) { LAS float* p = scr + (8 * i + r8) * 33 + 4 * c4; p[0] = v[i].x * scale; p[1] = v[i].y * scale; p[2] = v[i].z * scale; p[3] = v[i].w * scale; }
    LDS_WAIT(); asm volatile("" ::: "memory");
    if (it.fp8) {
        const int n = lane >> 1, kh = lane & 1; const LAS float* sp = scr + (32 * kh) * 33 + n;
#pragma unroll
        for (int p = 0; p < 2; ++p) { u32x4 o;
#pragma unroll
            for (int w = 0; w < 4; ++w) { const LAS float* q = sp + (16 * p + 4 * w) * 33; int x = 0;
                x = __builtin_amdgcn_cvt_pk_fp8_f32(q[0], q[33], x, false); x = __builtin_amdgcn_cvt_pk_fp8_f32(q[66], q[99], x, true); o[w] = (unsigned)x; }
            *(u32x4*)(it.dst + (size_t)n * it.pitch + 32 * kh + 16 * p) = o; }
    } else {
        const int c = lane & 7;
#pragma unroll
        for (int j = 0; j < 4; ++j) { const int n = (lane >> 3) + 8 * j; const LAS float* q = scr + (8 * c) * 33 + n;
            u32x4 o; o.x = pk2(q[0 * 33], q[1 * 33]); o.y = pk2(q[2 * 33], q[3 * 33]); o.z = pk2(q[4 * 33], q[5 * 33]); o.w = pk2(q[6 * 33], q[7 * 33]);
            const int nd = (it.swz && ((n >> 2) == 1 || (n >> 2) == 2)) ? (n ^ 12) : n;
            *(u32x4*)(it.dst + ((size_t)nd * it.pitch + 8 * c) * 2) = o; }
    }
    LDS_WAIT(); asm volatile("" ::: "memory");
}
__device__ __forceinline__ int win_dest_row(int sc) {
    if (sc < 32) { const int isk = sc >> 4, s2 = sc & 15, hh = s2 >> 1, bj = s2 & 1; return 512 * isk + 256 * (hh >> 2) + 128 * bj + 32 * (hh & 3); }
    if (sc < 48) return 0;
    if (sc < 64) { const int cx = 32 * (sc - 48); return 256 * (4 + (cx >> 7)) + (cx & 127); }
    if (sc < 80) return 2048 + 32 * (sc - 64);
    if (sc < 96) { const int cx = 32 * (sc - 80); return 256 * (4 + (cx >> 7)) + 128 + (cx & 127); }
    return 3072 + 32 * (sc - 96);
}
constexpr int X_NONEXP = 16 * 160 + 2 * (8 * 32) + 16 * 32, X_W2 = X_NONEXP + NE * 512, X_END = X_W2 + NE * 256;
__device__ __forceinline__ void convert_items(Frame& F, const int item_lo, const int item_hi, const int gw, const int NGW) {
    LAS float* scr = (LAS float*)(F.lds + F.wave * 16384);
    constexpr int I_IN = 16 * 160, I_PA = 8 * 32, I_O = 16 * 32, I_E1 = 16 * 16, I_E2 = 8 * 32;
    constexpr int NITEMS = I_IN + 2 * I_PA + I_O + NE * (2 * I_E1 + I_E2);
    auto decode = [&](int r) -> XItem {
        XItem x; x.swz = 0;
        if (r < I_IN) { const int kb = r / 160, sc = r % 160; x.src = F.w_in + (size_t)(64 * kb) * NIN + 32 * sc; x.N = NIN; x.pitch = 1024; x.swz = (sc < 32 && !(sc & 1)) ? 1 : 0;
            if (sc < 96 && !(sc >= 32 && sc < 48)) { x.fp8 = 0; x.dst = (unsigned char*)(WSP(bf16_t, WS_WIN_T) + (size_t)win_dest_row(sc) * 1024 + 64 * kb); }
            else { x.fp8 = 1; const int g = 32 * (sc - 96), cx = g & 1023;
                x.dst = WSP(unsigned char, WS_WIN8) + (size_t)(sc >= 96 ? 256 * (cx >> 7) + (g >= 1024 ? 128 : 0) + (cx & 127) : 2048 + 32 * (sc - 32)) * 1024 + 64 * kb; }
            return x; } r -= I_IN;
        if (r < I_PA) { const int kb = r / 32, sc = r % 32; x.src = F.w_pa + (size_t)(64 * kb) * 1024 + 32 * sc; x.N = 1024; x.pitch = 1024; x.fp8 = 0; x.dst = (unsigned char*)(WSP(bf16_t, WS_WP_T) + (size_t)(32 * sc) * 1024 + 64 * kb); return x; } r -= I_PA;
        if (r < I_PA) { const int kb = r / 32, sc = r % 32; x.src = F.w_pb + (size_t)(64 * kb) * 1024 + 32 * sc; x.N = 1024; x.pitch = 1024; x.fp8 = 0; x.dst = (unsigned char*)(WSP(bf16_t, WS_WP_T) + (size_t)(32 * sc) * 1024 + 512 + 64 * kb); return x; } r -= I_PA;
        if (r < I_O) { const int kb = r / 32, sc = r % 32; x.src = F.w_o + (size_t)(64 * kb) * 1024 + 32 * sc; x.N = 1024; x.pitch = 1024; x.fp8 = 1; x.dst = WSP(unsigned char, WS_WO_T) + (size_t)(32 * sc) * 1024 + 64 * kb; return x; } r -= I_O;
        x.fp8 = 1;
        if (r < NE * 2 * I_E1) { const int e = r / (2 * I_E1); r -= e * (2 * I_E1); const int is3 = r >= I_E1; if (is3) r -= I_E1; const int kb = r / 16, sc = r % 16;
            x.src = (is3 ? F.w3 : F.w1) + (size_t)e * D * DE + (size_t)(64 * kb) * DE + 32 * sc; x.N = DE; x.pitch = 1024;
            x.dst = WSP(unsigned char, WS_W13_T) + ((size_t)e * 1024 + 256 * (sc >> 2) + 128 * is3 + 32 * (sc & 3)) * 1024 + 64 * kb; return x; }
        r -= NE * 2 * I_E1;
        { const int e = r / I_E2; r -= e * I_E2; const int kb = r / 32, sc = r % 32;
            x.src = F.w2 + (size_t)e * DE * D + (size_t)(64 * kb) * D + 32 * sc; x.N = D; x.pitch = 512; x.dst = WSP(unsigned char, WS_W2_T) + ((size_t)e * 1024 + 32 * sc) * 512 + 64 * kb; }
        return x;
    };
    const int ihi = (item_hi < NITEMS) ? item_hi : NITEMS;
    if (item_lo + gw < ihi) {
        XItem cur = decode(item_lo + gw); f32x4 va[8], vb[8]; xitem_load(cur, va, F.lane);
        for (int it = item_lo + gw; it < ihi; it += 2 * NGW) {
            const int n1 = it + NGW, n2 = it + 2 * NGW; XItem nx1 = cur, nx2 = cur;
            if (n1 < ihi) { nx1 = decode(n1); xitem_load(nx1, vb, F.lane); }
            xitem_store(cur, va, scr, F.lane);
            if (n1 < ihi) { if (n2 < ihi) { nx2 = decode(n2); xitem_load(nx2, va, F.lane); }
                xitem_store(nx1, vb, scr, F.lane); cur = nx2; }
        }
    }
}

__device__ __forceinline__ void s0_prologue(Frame& F) {
    if (F.tid < 256) WSP(float, WS_KMEAN)[blockIdx.x * 256 + F.tid] = 0.f;
    if (F.tid < 144) { const int gt = blockIdx.x * 144 + F.tid; const int jj = gt >> 10, k = gt & 1023; WSP(float, WS_W36T)[gt] = (jj < 4) ? F.w_rg[k * 4 + jj] : F.w_re[k * 32 + (jj - 4)]; }
    if (F.tid < 128) { const int gt = blockIdx.x * 128 + F.tid; const int pos = gt >> 3, i = gt & 7; const float inv = powf(500000.0f, -(float)(2 * i) / 16.0f); const float ang = (float)pos * inv;
        WSP(float2, WS_ROPE)[gt] = make_float2(cosf(ang), sinf(ang)); }
    if (blockIdx.x < 192) {
        LAS float* sc = (LAS float*)F.lds;
        for (int i = F.tid; i < NB * D; i += NTHREADS) { const float v = F.c[i]; sc[i] = v / (1.f + expf(-v)); }
        __syncthreads();
        const int j0 = blockIdx.x * 32, col = j0 + (F.lane & 31), kpar = F.lane >> 5;
        float acc[8];
#pragma unroll
        for (int b = 0; b < 8; ++b) acc[b] = 0.f;
#pragma unroll
        for (int i0 = 0; i0 < 64; i0 += 32) { float wv[32];
#pragma unroll
            for (int i = 0; i < 32; ++i) wv[i] = F.w_ada[(size_t)(F.wave * 128 + 2 * (i0 + i) + kpar) * NMOD + col];
#pragma unroll
            for (int i = 0; i < 32; ++i) { const int k = F.wave * 128 + 2 * (i0 + i) + kpar;
#pragma unroll
                for (int b = 0; b < 8; ++b) acc[b] += sc[b * D + k] * wv[i]; } }
#pragma unroll
        for (int b = 0; b < 8; ++b) acc[b] += __shfl_xor(acc[b], 32);
        LAS float* red = (LAS float*)(F.lds + 32768);
        if (F.lane < 32) {
#pragma unroll
            for (int b = 0; b < 8; ++b) red[(F.wave * 8 + b) * 32 + F.lane] = acc[b]; }
        __syncthreads();
        if (F.tid < 256) { const int b = F.tid >> 5, cc = F.tid & 31; float s = F.b_ada[j0 + cc];
#pragma unroll
            for (int w = 0; w < 8; ++w) s += red[(w * 8 + b) * 32 + cc];
            WSP(float, WS_MOD)[b * NMOD + j0 + cc] = s; }
        asm volatile("s_waitcnt vmcnt(0)" ::: "memory");
        __syncthreads();
        if (F.tid == 0) { __builtin_amdgcn_fence(__ATOMIC_RELEASE, "agent"); asm volatile("s_waitcnt vmcnt(0)" ::: "memory");
            __hip_atomic_fetch_add(WSP(unsigned, WS_CTL) + CW_MODCNT, 1u, __ATOMIC_RELAXED, __HIP_MEMORY_SCOPE_AGENT); }
    }
    convert_items(F, 0, X_NONEXP, F.G * NWAVES - 1 - (blockIdx.x * NWAVES + F.wave), F.G * NWAVES);
}

__device__ __forceinline__ void wait_mod(Frame& F) {
    if (F.tid == 0) { unsigned* c = WSP(unsigned, WS_CTL) + CW_MODCNT; unsigned sp = 0;
        while (__hip_atomic_load(c, __ATOMIC_RELAXED, __HIP_MEMORY_SCOPE_AGENT) < 192u) { __builtin_amdgcn_s_sleep(2); if (++sp > (1u << 24)) break; }
        __builtin_amdgcn_fence(__ATOMIC_ACQUIRE, "agent"); asm volatile("s_waitcnt vmcnt(0)" ::: "memory"); }
    __syncthreads();
}
template <int N> __device__ __forceinline__ float dpp_ror(float v) { return __builtin_bit_cast(float, __builtin_amdgcn_update_dpp(0, __builtin_bit_cast(int, v), 0x120 + N, 0xF, 0xF, false)); }
__device__ __forceinline__ float xrow16_sum(float x) {
    float a = x, b = x;
    asm volatile("s_nop 1\n\tv_permlane16_swap_b32 %0, %1" : "+v"(a), "+v"(b));
    a += b; b = a;
    asm volatile("s_nop 1\n\tv_permlane32_swap_b32 %0, %1" : "+v"(a), "+v"(b));
    return a + b;
}
__device__ __forceinline__ float wave_sum(float v) {
#pragma unroll
    for (int o = 1; o < 64; o <<= 1) v += __shfl_xor(v, o);
    return v;
}
__device__ __forceinline__ void s1_norm1(Frame& F) {
    const int gw = blockIdx.x * NWAVES + F.wave;
    const int row0 = gw * 16, b = row0 / S;
    if (row0 >= T) return;
    const float* mod = WSP(float, WS_MOD) + (size_t)b * NMOD;
    f32x4 gs[4], sh[4];
#pragma unroll
    for (int j = 0; j < 4; ++j) { const int col = 4 * F.lane + 256 * j; const f32x4 g = *(const f32x4*)(F.g1 + col), s_ = *(const f32x4*)(mod + 1024 + col); gs[j] = g * (s_ + 1.0f); sh[j] = *(const f32x4*)(mod + col); }
    for (int r = 0; r < 16; r += 4) {
        f32x4 v[4][4]; float ss[4];
#pragma unroll
        for (int q = 0; q < 4; ++q) { const float* xr = F.x + (size_t)(row0 + r + q) * D;
#pragma unroll
            for (int j = 0; j < 4; ++j) v[q][j] = __builtin_nontemporal_load((const f32x4*)(xr + 4 * F.lane + 256 * j)); }
#pragma unroll
        for (int q = 0; q < 4; ++q) { ss[q] = 0.f;
#pragma unroll
            for (int j = 0; j < 4; ++j) ss[q] += (v[q][j].x * v[q][j].x + v[q][j].y * v[q][j].y) + (v[q][j].z * v[q][j].z + v[q][j].w * v[q][j].w); }
#pragma unroll
        for (int q = 0; q < 4; ++q) { const float rinv = rsqrtf(wave_sum(ss[q]) * (1.f / D) + EPS);
            bf16_t* o = WSP(bf16_t, WS_H) + (size_t)(row0 + r + q) * D;
#pragma unroll
            for (int j = 0; j < 4; ++j) { const f32x4 h = v[q][j] * rinv * gs[j] + sh[j]; u32x2 w; w.x = pk2(h.x, h.y); w.y = pk2(h.z, h.w); *(u32x2*)(o + 4 * F.lane + 256 * j) = w;
                int p8 = 0; p8 = __builtin_amdgcn_cvt_pk_fp8_f32(h.x, h.y, p8, false); p8 = __builtin_amdgcn_cvt_pk_fp8_f32(h.z, h.w, p8, true);
                *(int*)(WSP(unsigned char, WS_H8) + (size_t)(row0 + r + q) * D + 4 * F.lane + 256 * j) = p8; } }
    }
}

struct RowsLinear { const bf16_t* base; size_t pitch; __device__ __forceinline__ const bf16_t* operator()(int r) const { return base + (size_t)r * pitch; } };
template <class AR, class BR>
__device__ __forceinline__ void sgemm_tile(LAS float* tile, int K, const AR& arow, const BR& brow, int wave, int lane) {
    const int fr = lane & 15, fq = lane >> 4, rb = 16 * (wave & 3), cb = 32 * (wave >> 2);
    const bf16_t* ap = arow(rb + fr) + 8 * fq;
    const bf16_t* bp0 = brow(cb + fr) + 8 * fq;
    const bf16_t* bp1 = brow(cb + 16 + fr) + 8 * fq;
    f32x4 acc0 = {0.f, 0.f, 0.f, 0.f}, acc1 = {0.f, 0.f, 0.f, 0.f};
#pragma unroll 4
    for (int k = 0; k < K; k += 32) {
        const bf16x8 a = *(const bf16x8*)(ap + k), b0 = *(const bf16x8*)(bp0 + k), b1 = *(const bf16x8*)(bp1 + k);
        acc0 = __builtin_amdgcn_mfma_f32_16x16x32_bf16(a, b0, acc0, 0, 0, 0);
        acc1 = __builtin_amdgcn_mfma_f32_16x16x32_bf16(a, b1, acc1, 0, 0, 0);
    }
#pragma unroll
    for (int j = 0; j < 4; ++j) { tile[(rb + fq * 4 + j) * 65 + cb + fr] = acc0[j]; tile[(rb + fq * 4 + j) * 65 + cb + 16 + fr] = acc1[j]; }
}

struct WinRowsHead { const bf16_t* base; int rb; __device__ __forceinline__ const bf16_t* operator()(int d) const { return base + (size_t)(rb + 128 * (d >> 5) + (d & 31)) * 1024; } };
__device__ __forceinline__ void s2_simple(Frame& F) {
    LAS float* tile = (LAS float*)F.lds; LAS float* tile2 = tile + 64 * 65;
    const bf16_t* H = WSP(bf16_t, WS_H); const bf16_t* WT = WSP(bf16_t, WS_WIN_T);
    const int row = F.tid >> 3, seg = F.tid & 7;
    for (int it = blockIdx.x; it < 512 * 72; it += F.G) {
        const int rt = it / 72, ct = it % 72, r0 = rt * 64, gr = r0 + row;
        const RowsLinear ar{H + (size_t)r0 * 1024, 1024};
        float v[8];
        if (ct < 16) {
            const int isk = ct >> 3, hh = ct & 7;
            const WinRowsHead br{WT, 512 * isk + 256 * (hh >> 2) + 32 * (hh & 3)};
            sgemm_tile(tile, 1024, ar, br, F.wave, F.lane); __syncthreads();
            float ss = 0.f;
#pragma unroll
            for (int e = 0; e < 8; ++e) { v[e] = tile[row * 65 + 8 * seg + e]; ss += v[e] * v[e]; }
            ss += __shfl_xor(ss, 1); ss += __shfl_xor(ss, 2); ss += __shfl_xor(ss, 4);
            const float rinv = rsqrtf(ss * (1.f / 64.f) + EPS);
            const float* g = isk ? F.g_k : F.g_q;
            const int pos = gr & (S - 1);
#pragma unroll
            for (int e = 0; e < 8; ++e) { v[e] = v[e] * rinv * g[8 * seg + e]; const float pv = __shfl_xor(v[e], 1);
                if (seg < 2) { const float2 cs = WSP(float2, WS_ROPE)[pos * 8 + e]; v[e] = (seg == 0) ? (v[e] * cs.x - pv * cs.y) : (v[e] * cs.x + pv * cs.y); } }
            if (!isk) {
#pragma unroll
                for (int e = 0; e < 8; ++e) v[e] *= C2;
                *(u32x4*)(WSP(bf16_t, WS_YAB) + (size_t)gr * 1024 + hh * 64 + 8 * seg) = pack8(v);
            } else {
                *(u32x4*)(WSP(bf16_t, WS_K) + (size_t)gr * 512 + hh * 64 + 8 * seg) = pack8(v);
#pragma unroll
                for (int e = 0; e < 8; ++e) tile[row * 65 + 8 * seg + e] = v[e];
                __syncthreads();
                if (F.tid < 64) { float s = 0.f; for (int r = 0; r < 64; ++r) s += tile[r * 65 + F.tid];
                    const int b = r0 / S, blk = (r0 & (S - 1)) >> 8;
                    atomicAdd(WSP(float, WS_KMEAN) + ((size_t)(b * NH + hh) * 16 + blk) * 64 + F.tid, s * (1.f / 256.f)); }
            }
        } else if (ct < 24) {
            const RowsLinear br{WT + (size_t)(1024 + 64 * (ct - 16)) * 1024, 1024};
            sgemm_tile(tile, 1024, ar, br, F.wave, F.lane); __syncthreads();
#pragma unroll
            for (int e = 0; e < 8; ++e) v[e] = tile[row * 65 + 8 * seg + e];
            *(u32x4*)(WSP(bf16_t, WS_V) + (size_t)gr * 512 + 64 * (ct - 16) + 8 * seg) = pack8(v);
        } else if (ct < 32) {
            const int cu = 64 * (ct - 24), rb = 256 * (6 + (cu >> 7)) + (cu & 127);
            const RowsLinear bx{WT + (size_t)rb * 1024, 1024}, bc{WT + (size_t)(rb + 128) * 1024, 1024};
            sgemm_tile(tile, 1024, ar, bx, F.wave, F.lane); sgemm_tile(tile2, 1024, ar, bc, F.wave, F.lane); __syncthreads();
#pragma unroll
            for (int e = 0; e < 8; ++e) v[e] = tile[row * 65 + 8 * seg + e] * tile2[row * 65 + 8 * seg + e];
            *(u32x4*)(WSP(bf16_t, WS_U) + (size_t)gr * 512 + cu + 8 * seg) = pack8(v);
        } else if (ct < 40) {
            const RowsLinear br{WT + (size_t)(2560 + 64 * (ct - 32)) * 1024, 1024};
            sgemm_tile(tile, 1024, ar, br, F.wave, F.lane); __syncthreads();
#pragma unroll
            for (int e = 0; e < 8; ++e) v[e] = tile[row * 65 + 8 * seg + e];
            *(u32x4*)(WSP(bf16_t, WS_BG) + (size_t)gr * 512 + 64 * (ct - 32) + 8 * seg) = pack8(v);
        } else {
            const RowsLinear br{WT + (size_t)(3072 + 64 * (ct - 40)) * 1024, 1024};
            sgemm_tile(tile, 1024, ar, br, F.wave, F.lane); __syncthreads();
#pragma unroll
            for (int e = 0; e < 8; ++e) v[e] = 1.f / (1.f + __expf(-tile[row * 65 + 8 * seg + e]));
            *(u32x4*)(WSP(bf16_t, WS_GATES) + (size_t)gr * 2048 + 64 * (ct - 40) + 8 * seg) = pack8(v);
        }
        __syncthreads();
    }
}

namespace pg8 {
constexpr int BM = 256, BK = 64, HALF = 128, HTB = HALF * BK * 2, STAGE_BYTES = 8 * HTB, NXCD = 8, WGM = 4;
constexpr int VN_STASH = 147456 + 4096;
__device__ __forceinline__ int lds_byte(int r, int c) { const int st = (r >> 4) * 2 + (c >> 5), rr = r & 15, cc = c & 31, ob = rr * 64 + cc * 2; return st * 1024 + (ob ^ (((ob >> 9) & 1) << 5)); }
__device__ __forceinline__ void stage_rc(int b, int& R, int& C) { const int st = b / 1024, sb = b % 1024, swz = sb ^ (((sb >> 9) & 1) << 5); R = (st >> 1) * 16 + swz / 64; C = (st & 1) * 32 + (swz % 64) / 2; }
__device__ __forceinline__ int perm32(int rho) { const int n = rho >> 4, i = rho & 15; return 8 * (i >> 2) + 4 * n + (i & 3); }
struct Unit { int pm, pn; const char* a; const char* b; int e, rbase; };
__device__ __forceinline__ bool static_unit(int i, int G, int c, int nM, int nN, int& pm, int& pn) {
    const int nwg = nM * nN; const long L = (long)i * G + c; if (L >= nwg) return false;
    int wgid = (int)L; { const int q = nwg / NXCD, r = nwg % NXCD, xcd = wgid % NXCD, off = wgid / NXCD; wgid = (xcd < r ? xcd * (q + 1) : r * (q + 1) + (xcd - r) * q) + off; }
    const int nig = WGM * nN, gid = wgid / nig, fm = gid * WGM, gsz = (nM - fm) < WGM ? (nM - fm) : WGM;
    pm = fm + ((wgid % nig) % gsz); pn = (wgid % nig) / gsz; return true;
}
struct DenseSched {
    static constexpr bool GATHER = false, FP8 = false;
    const char* A; const char* Bt; int nM, nN, K, G, c;
    __device__ __forceinline__ bool next(int i, Unit& u) const { if (!static_unit(i, G, c, nM, nN, u.pm, u.pn)) return false;
        u.a = A + (size_t)u.pm * BM * K * 2; u.b = Bt + (size_t)u.pn * BM * K * 2; u.e = 0; u.rbase = 0; return true; }
    __device__ __forceinline__ int row_index(const Unit&, int) const { return 0; }
};

struct DenseSched8 {
    static constexpr bool GATHER = false, FP8 = true;
    const char* A; const char* Bt; int nM, nN, K, G, c;
    __device__ __forceinline__ bool next(int i, Unit& u) const { if (!static_unit(i, G, c, nM, nN, u.pm, u.pn)) return false;
        u.a = A + (size_t)u.pm * BM * K; u.b = Bt + (size_t)u.pn * BM * K; u.e = 0; u.rbase = 0; return true; }
    __device__ __forceinline__ int row_index(const Unit&, int) const { return 0; }
};
template <class Epi, class Sched, bool skip = false>
__device__ __forceinline__ void gemm_phase(LAS unsigned char* lds, const int K, const Sched& S, const Epi& E) {
    int tid_ = threadIdx.x; asm volatile("" : "+v"(tid_));
    const int tid = tid_, wid = __builtin_amdgcn_readfirstlane(tid >> 6), lane = tid & 63, wr = wid >> 2, wc = wid & 3, fr = lane & 15, fq = lane >> 4;
    constexpr bool FP8 = Sched::FP8;
    const int nt = FP8 ? K / 128 : K / BK;
    const int PB = FP8 ? K : 2 * K;
    unsigned voffB[2], vA[2][2], vN[2][2];
#pragma unroll
    for (int i = 0; i < 2; ++i) { int R, C; stage_rc(tid * 16 + i * 8192, R, C); const int Rb = (R & ~31) + perm32(R & 31);
        voffB[i] = (unsigned)(Rb * PB + C * 2);
        vA[0][i] = (unsigned)(R * PB + C * 2); vA[1][i] = (unsigned)((HALF + R) * PB + C * 2); vN[0][i] = vA[0][i]; vN[1][i] = vA[1][i]; }
    const size_t kstep = (size_t)(BK * 2);
    const size_t hstep = (size_t)HALF * PB;
    const unsigned ldsw = (unsigned)wid * 1024u;
    const int aoff = lds_byte(wr * 64 + fr, fq * 8), boff = lds_byte(wc * 32 + fr, fq * 8);
    const int aoff8a = lds_byte(wr * 64 + fr, fq * 16), aoff8b = lds_byte(wr * 64 + fr, fq * 16 + 8), boff8a = lds_byte(wc * 32 + fr, fq * 16), boff8b = lds_byte(wc * 32 + fr, fq * 16 + 8);
#define PG8_SA(b, h) (((b) * 2 + (h)) * HTB)
#define PG8_SB(b, h) ((4 + (b) * 2 + (h)) * HTB)
#define PG8_STAGE(bufoff, gbase, voff) do { _Pragma("unroll") for (int _i = 0; _i < 2; ++_i) \
        __builtin_amdgcn_global_load_lds((const unsigned*)((const char*)(gbase) + (voff)[_i]), (LAS unsigned*)(lds + (bufoff) + ldsw + _i * 8192), 16, 0, 0); } while (0)
#define PG8_LD16(off) (*(const LAS u32x4*)(lds + (off)))
#define PG8_LDA(dst, b, h) do { _Pragma("unroll") for (int m = 0; m < 4; ++m) { if constexpr (FP8) { dst##8[m] = __builtin_bit_cast(i32x8, __builtin_shufflevector(PG8_LD16(PG8_SA(b, h) + aoff8a + m * 2048), PG8_LD16(PG8_SA(b, h) + aoff8b + m * 2048), 0, 1, 2, 3, 4, 5, 6, 7)); } \
        else { _Pragma("unroll") for (int k = 0; k < 2; ++k) dst[m][k] = *(const LAS bf16x8*)(lds + PG8_SA(b, h) + aoff + m * 2048 + k * 1024); } } } while (0)
#define PG8_LDB(dst, b, h) do { _Pragma("unroll") for (int n = 0; n < 2; ++n) { if constexpr (FP8) { dst##8[n] = __builtin_bit_cast(i32x8, __builtin_shufflevector(PG8_LD16(PG8_SB(b, h) + boff8a + n * 2048), PG8_LD16(PG8_SB(b, h) + boff8b + n * 2048), 0, 1, 2, 3, 4, 5, 6, 7)); } \
        else { _Pragma("unroll") for (int k = 0; k < 2; ++k) dst[n][k] = *(const LAS bf16x8*)(lds + PG8_SB(b, h) + boff + n * 2048 + k * 1024); } } } while (0)
#define PG8_MMA(ai, bj, At, Bt) do { __builtin_amdgcn_s_setprio(1); _Pragma("unroll") for (int m = 0; m < 4; ++m) _Pragma("unroll") for (int n = 0; n < 2; ++n) { \
        if constexpr (FP8) { asm volatile("s_nop 1\n\tv_mfma_scale_f32_16x16x128_f8f6f4 %0, %1, %2, %0, %3, %3 op_sel_hi:[0,0,0]" : "+v"(acc[ai][bj][m][n]) : "v"(Bt##8[n]), "v"(At##8[m]), "v"(sc127)); } \
        else { _Pragma("unroll") for (int k = 0; k < 2; ++k) acc[ai][bj][m][n] = __builtin_amdgcn_mfma_f32_16x16x32_bf16(Bt[n][k], At[m][k], acc[ai][bj][m][n], 0, 0, 0); } } __builtin_amdgcn_s_setprio(0); } while (0)
#define PG8_WAIT_V(n) asm volatile("s_waitcnt vmcnt(" #n ")" ::: "memory")
#define PG8_WAIT_L(n) asm volatile("s_waitcnt lgkmcnt(" #n ")" ::: "memory")
#define PG8_BAR __builtin_amdgcn_s_barrier()
#define PG8_SCHED __builtin_amdgcn_sched_barrier(0)
#define PG8_AOFF(dst, u) do { int _t = threadIdx.x; asm volatile("" : "+v"(_t)); _Pragma("unroll") for (int _i = 0; _i < 2; ++_i) { int _R, _C; stage_rc(_t * 16 + _i * 8192, _R, _C); \
        _Pragma("unroll") for (int _h = 0; _h < 2; ++_h) dst[_h][_i] = (unsigned)(S.row_index(u, _h * HALF + _R) * PB + _C * 2); } } while (0)
    Unit cur, nxt; int ui = 0;
    if (!S.next(0, cur)) return;
    if constexpr (Sched::GATHER) PG8_AOFF(vA, cur);
    f32x4 acc[2][2][4][2]; typename Epi::State est;
#pragma unroll
    for (int a = 0; a < 2; ++a)
#pragma unroll
        for (int b = 0; b < 2; ++b)
#pragma unroll
            for (int m = 0; m < 4; ++m)
#pragma unroll
                for (int n = 0; n < 2; ++n) acc[a][b][m][n] = (f32x4){0.f, 0.f, 0.f, 0.f};
    const int sc127 = 127;
    bf16x8 At[4][2], B0[2][2], B1[2][2]; i32x8 At8[4], B08[2], B18[2];
    const char* cA = cur.a; const char* cB = cur.b;
    PG8_STAGE(PG8_SB(0, 0), cB, voffB); PG8_STAGE(PG8_SB(0, 1), cB + hstep, voffB); PG8_STAGE(PG8_SA(0, 0), cA, vA[0]); PG8_STAGE(PG8_SA(0, 1), cA, vA[1]);
    if (wr == 1) PG8_BAR;
    PG8_WAIT_V(2); PG8_BAR;
    PG8_STAGE(PG8_SB(1, 0), cB + kstep, voffB); PG8_STAGE(PG8_SA(1, 0), cA + kstep, vA[0]); PG8_STAGE(PG8_SB(1, 1), cB + hstep + kstep, voffB);
    PG8_WAIT_V(6); PG8_BAR;
    for (;;) {
        const bool has_next = S.next(ui + 1, nxt);
        const char* nA = has_next ? nxt.a : cA; const char* nB = has_next ? nxt.b : cB;
        if constexpr (Sched::GATHER) { if (has_next) PG8_AOFF(vN, nxt); else {
#pragma unroll
            for (int h = 0; h < 2; ++h)
#pragma unroll
                for (int i = 0; i < 2; ++i) vN[h][i] = vA[h][i]; }
            *(LAS u32x4*)(lds + VN_STASH + tid * 16) = (u32x4){vN[0][0], vN[0][1], vN[1][0], vN[1][1]}; }
        for (int hk = 0; hk < (Epi::HAS_MID ? 2 : 1); ++hk) {
        if constexpr (Epi::HAS_MID) { if (hk == 1 && !skip) E.mid(acc, cur, wr, wc, fr, fq, est); }
        const int tb = (Epi::HAS_MID && hk == 1) ? nt / 2 : 0, te = (Epi::HAS_MID && hk == 0) ? nt / 2 : nt;
#pragma unroll 1
        for (int t = tb; t < te; t += 2) {
            const bool last = (t == nt - 2);
            const char* a1 = cA + (size_t)(t + 1) * kstep;
            const char* a2 = last ? nA : cA + (size_t)(t + 2) * kstep; const char* b2 = last ? nB : cB + (size_t)(t + 2) * kstep;
            const char* a3 = a2 + kstep; const char* b3 = b2 + kstep;
            unsigned w0[2], w1[2];
#pragma unroll
            for (int i = 0; i < 2; ++i) { w0[i] = vA[0][i]; w1[i] = vA[1][i]; }
            if constexpr (Sched::GATHER) { if (last) { const u32x4 q = *(const LAS u32x4*)(lds + VN_STASH + tid * 16); w0[0] = q.x; w0[1] = q.y; w1[0] = q.z; w1[1] = q.w; } }
            PG8_LDB(B0, 0, 0); PG8_LDB(B1, 0, 1); PG8_SCHED; PG8_LDA(At, 0, 0); PG8_STAGE(PG8_SA(1, 1), a1, vA[1]);
            PG8_WAIT_V(8); PG8_WAIT_L(0); PG8_BAR; PG8_MMA(0, 0, At, B0); PG8_MMA(0, 1, At, B1); PG8_BAR; PG8_SCHED;
            PG8_LDA(At, 0, 1); PG8_STAGE(PG8_SB(0, 0), b2, voffB); PG8_STAGE(PG8_SB(0, 1), b2 + hstep, voffB); PG8_STAGE(PG8_SA(0, 0), a2, w0);
            PG8_WAIT_V(8); PG8_WAIT_L(0); PG8_BAR; PG8_MMA(1, 0, At, B0); PG8_MMA(1, 1, At, B1); PG8_BAR; PG8_SCHED;
            PG8_LDB(B0, 1, 0); PG8_LDB(B1, 1, 1); PG8_SCHED; PG8_LDA(At, 1, 0); PG8_STAGE(PG8_SA(0, 1), a2, w1);
            PG8_WAIT_V(8); PG8_WAIT_L(0); PG8_BAR; PG8_MMA(0, 0, At, B0); PG8_MMA(0, 1, At, B1); PG8_BAR; PG8_SCHED;
            PG8_LDA(At, 1, 1); PG8_STAGE(PG8_SB(1, 0), b3, voffB); PG8_STAGE(PG8_SB(1, 1), b3 + hstep, voffB); PG8_STAGE(PG8_SA(1, 0), a3, w0);
            PG8_WAIT_V(8); PG8_WAIT_L(0); PG8_BAR; PG8_MMA(1, 0, At, B0); PG8_MMA(1, 1, At, B1); PG8_BAR; PG8_SCHED;
        }
        }
        if (wr == 0) PG8_BAR;
        if constexpr (FP8) asm volatile("s_nop 15\n\ts_nop 7" ::: "memory");
        if constexpr (!skip) E(acc, cur, wr, wc, fr, fq, est); else {
#pragma unroll
            for (int a = 0; a < 2; ++a)
#pragma unroll
                for (int b = 0; b < 2; ++b)
#pragma unroll
                    for (int m = 0; m < 4; ++m)
#pragma unroll
                        for (int n = 0; n < 2; ++n) asm volatile("" :: "v"(acc[a][b][m][n])); }
        if (!has_next) break;
#pragma unroll
        for (int a = 0; a < 2; ++a)
#pragma unroll
            for (int b = 0; b < 2; ++b)
#pragma unroll
                for (int m = 0; m < 4; ++m)
#pragma unroll
                    for (int n = 0; n < 2; ++n) acc[a][b][m][n] = (f32x4){0.f, 0.f, 0.f, 0.f};
        cur = nxt; cA = nA; cB = nB; ++ui;
        if constexpr (Sched::GATHER) { const u32x4 q = *(const LAS u32x4*)(lds + VN_STASH + tid * 16); vA[0][0] = q.x; vA[0][1] = q.y; vA[1][0] = q.z; vA[1][1] = q.w; }
        if (wr == 1) PG8_BAR;
    }
    PG8_WAIT_V(0);
    PG8_BAR;
#undef PG8_SA
#undef PG8_SB
#undef PG8_STAGE
#undef PG8_LDA
#undef PG8_LDB
#undef PG8_MMA
#undef PG8_LD16
#undef PG8_WAIT_V
#undef PG8_WAIT_L
#undef PG8_BAR
#undef PG8_SCHED
#undef PG8_AOFF
}
}

typedef f32x4 Acc[2][2][4][2];
struct EpiG1 {
    static constexpr bool HAS_MID = false;
    unsigned char* ws; const float* g_q; const float* g_k;
    struct State {}; __device__ __forceinline__ void mid(Acc&, const pg8::Unit&, int, int, int, int, State&) const {}
    __device__ __forceinline__ void operator()(Acc& acc, const pg8::Unit& u, int wr, int wc, int fr, int fq, State& st) const {
        const int pn = u.pn, row0 = u.pm * 256 + wr * 64 + fr;
        if (pn < 4) {
            const int isk = pn >> 1, hh = 4 * (pn & 1) + wc;
            const float* g = isk ? g_k : g_q;
            f32x4 gv[2][2];
#pragma unroll
            for (int bj = 0; bj < 2; ++bj)
#pragma unroll
                for (int n = 0; n < 2; ++n) gv[bj][n] = *(const f32x4*)(g + ((bj == 0 && fq < 2) ? 8 * n + 4 * fq : 32 * bj + 8 * fq + 4 * n));
            f32x4 cs_[2][2];
#pragma unroll
            for (int bj = 0; bj < 2; ++bj)
#pragma unroll
                for (int n = 0; n < 2; ++n) cs_[bj][n] = (f32x4){0.f, 0.f, 0.f, 0.f};
            f32x4 rf;
#pragma unroll
            for (int e = 0; e < 4; ++e) { const float f0 = exp2f(-(float)e * (0.125f * 18.931568569324174f)) * 0.15915494309189535f, f1 = exp2f(-(float)(4 + e) * (0.125f * 18.931568569324174f)) * 0.15915494309189535f;
                rf[e] = fq == 0 ? f0 : (fq == 1 ? f1 : 0.f); }
            bf16_t* dst = isk ? (bf16_t*)(ws + WS_K) : (bf16_t*)(ws + WS_YAB);
            const int pitch = isk ? 512 : 1024;
            const float sc = isk ? 1.f : C2;
#pragma unroll
            for (int ai = 0; ai < 2; ++ai)
#pragma unroll
                for (int m = 0; m < 4; ++m) {
                    const int r = row0 + 128 * ai + 16 * m; const float pos = (float)(r & (S - 1));
                    f32x4 v[2][2]; float ss = 0.f;
#pragma unroll
                    for (int bj = 0; bj < 2; ++bj)
#pragma unroll
                        for (int n = 0; n < 2; ++n) { v[bj][n] = acc[ai][bj][m][n]; ss += (v[bj][n].x * v[bj][n].x + v[bj][n].y * v[bj][n].y) + (v[bj][n].z * v[bj][n].z + v[bj][n].w * v[bj][n].w); }
                    ss = xrow16_sum(ss);
                    const float rinv = rsqrtf(ss * (1.f / 64.f) + EPS);
#pragma unroll
                    for (int bj = 0; bj < 2; ++bj)
#pragma unroll
                        for (int n = 0; n < 2; ++n) v[bj][n] = v[bj][n] * rinv * gv[bj][n];
#pragma unroll
                    for (int e = 0; e < 4; ++e) { const float rev = __builtin_amdgcn_fractf(pos * rf[e]), c = __builtin_amdgcn_cosf(rev), sn = __builtin_amdgcn_sinf(rev);
                        const float x1 = v[0][0][e], x2 = v[0][1][e]; v[0][0][e] = x1 * c - x2 * sn; v[0][1][e] = x2 * c + x1 * sn; }
                    if (isk) {
#pragma unroll
                        for (int bj = 0; bj < 2; ++bj)
#pragma unroll
                            for (int n = 0; n < 2; ++n) cs_[bj][n] += v[bj][n];
                    }
#pragma unroll
                    for (int bj = 0; bj < 2; ++bj) st16(dst + (size_t)r * pitch + hh * 64 + 32 * bj + 8 * fq, pack8v(v[bj][0] * sc, v[bj][1] * sc));
                }
            if (isk) {
                const int b = u.pm >> 4, blk = u.pm & 15;
                float* km = (float*)(ws + WS_KMEAN) + ((size_t)(b * NH + hh) * 16 + blk) * 64;
#pragma unroll
                for (int bj = 0; bj < 2; ++bj)
#pragma unroll
                    for (int n = 0; n < 2; ++n)
#pragma unroll
                        for (int e = 0; e < 4; ++e) { float s = cs_[bj][n][e]; s += dpp_ror<8>(s); s += dpp_ror<4>(s); s += dpp_ror<2>(s); s += dpp_ror<1>(s);
                            if (fr == 0) atomicAdd(km + 32 * bj + 8 * fq + 4 * n + e, s * (1.f / 256.f)); }
            }
        } else if (pn < 8) {
            bf16_t* dst = (bf16_t*)(ws + WS_U);
#pragma unroll
            for (int ai = 0; ai < 2; ++ai)
#pragma unroll
                for (int m = 0; m < 4; ++m) { const int r = row0 + 128 * ai + 16 * m;
                    const f32x4 a = acc[ai][0][m][0] * acc[ai][1][m][0], b = acc[ai][0][m][1] * acc[ai][1][m][1]; u32x4 w;
                    w.x = pk2(a.x, a.y); w.y = pk2(a.z, a.w); w.z = pk2(b.x, b.y); w.w = pk2(b.z, b.w);
                    st16(dst + (size_t)r * 512 + 128 * (pn - 4) + 32 * wc + 8 * fq, w); }
        } else {
            bf16_t* dst = (bf16_t*)(ws + WS_BG); const int pitch = 512, c0 = 256 * (pn - 8); const bool sig = false;
#pragma unroll
            for (int ai = 0; ai < 2; ++ai)
#pragma unroll
                for (int m = 0; m < 4; ++m) { const int r = row0 + 128 * ai + 16 * m;
#pragma unroll
                    for (int bj = 0; bj < 2; ++bj) { f32x4 a = acc[ai][bj][m][0], b = acc[ai][bj][m][1];
                        if (sig) {
#pragma unroll
                            for (int e = 0; e < 4; ++e) { a[e] = __builtin_amdgcn_rcpf(1.f + __expf(-a[e])); b[e] = __builtin_amdgcn_rcpf(1.f + __expf(-b[e])); } }
                        u32x4 w; w.x = pk2(a.x, a.y); w.y = pk2(a.z, a.w); w.z = pk2(b.x, b.y); w.w = pk2(b.z, b.w);
                        st16(dst + (size_t)r * pitch + c0 + 128 * bj + 32 * wc + 8 * fq, w); } }
        }
    }
};
struct EpiGate {
    static constexpr bool HAS_MID = false;
    bf16_t* gates; bf16_t* vout;
    struct State {}; __device__ __forceinline__ void mid(Acc&, const pg8::Unit&, int, int, int, int, State&) const {}
    __device__ __forceinline__ void operator()(Acc& acc, const pg8::Unit& u, int wr, int wc, int fr, int fq, State& st) const {
        int row0 = u.pm * 256 + wr * 64 + fr; const int c0 = u.pn * 256 + 32 * wc + 8 * fq; asm volatile("" : "+v"(row0));
#pragma unroll
        for (int ai = 0; ai < 2; ++ai)
#pragma unroll
            for (int m = 0; m < 4; ++m) { const size_t r = (size_t)(row0 + 128 * ai + 16 * m);
                if (u.pn < 8) {
                    f32x4 ra[2], gb[2];
#pragma unroll
                    for (int n = 0; n < 2; ++n)
#pragma unroll
                        for (int e = 0; e < 4; ++e) { const float ea = __expf(acc[ai][0][m][n][e] * (-1.f / W8_SCALE)), eb = __expf(acc[ai][1][m][n][e] * (-1.f / W8_SCALE));
                            gb[n][e] = __builtin_amdgcn_rcpf(1.f + eb); ra[n][e] = fminf((1.f + eb) * __builtin_amdgcn_rcpf(1.f + ea), 3e4f); }
                    const size_t gc = ((size_t)(u.pm * 4 + (u.pn >> 1)) * 256 + (size_t)(r - (size_t)u.pm * 256)) * 256 + 128 * (u.pn & 1) + 32 * wc + 8 * fq;
                    st16(gates + gc, pack8v(ra[0], ra[1])); st16(gates + gc + (size_t)T * 1024, pack8v(gb[0], gb[1]));
                } else {
#pragma unroll
                    for (int bj = 0; bj < 2; ++bj) st16(vout + r * 512 + (c0 - 2048) + 128 * bj, pack8v(acc[ai][bj][m][0] * (1.f / W8_SCALE), acc[ai][bj][m][1] * (1.f / W8_SCALE))); } }
    }
};
__device__ __forceinline__ void s2_fast(Frame& F) {
    {
        const pg8::DenseSched Sd{(const char*)(F.ws + WS_H), (const char*)(F.ws + WS_WIN_T), T / 256, 10, 1024, F.G, (int)blockIdx.x};
        const EpiG1 E{F.ws, F.g_q, F.g_k};
        if (F.skip) pg8::gemm_phase<EpiG1, pg8::DenseSched, true>(F.lds, 1024, Sd, E); else pg8::gemm_phase<EpiG1, pg8::DenseSched>(F.lds, 1024, Sd, E); }
    {
        const pg8::DenseSched8 Sd{(const char*)(F.ws + WS_H8), (const char*)(F.ws + WS_WIN8), T / 256, 10, 1024, F.G, (int)blockIdx.x};
        const EpiGate E{WSP(bf16_t, WS_GATES), WSP(bf16_t, WS_V)};
        int Kg = D; asm volatile("" : "+s"(Kg));
        if (F.skip) pg8::gemm_phase<EpiGate, pg8::DenseSched8, true>(F.lds, Kg, Sd, E); else pg8::gemm_phase<EpiGate, pg8::DenseSched8>(F.lds, Kg, Sd, E); }
}

constexpr float NEG_BIG = -1e30f;
__device__ __forceinline__ void s3_simple(Frame& F) {
    LAS float* tS = (LAS float*)F.lds;
    LAS bf16_t* Pb = (LAS bf16_t*)(F.lds + 16896);
    LAS bf16_t* Vt = (LAS bf16_t*)(F.lds + 16896 + 9216);
    LAS float* mrow = (LAS float*)(F.lds + 16896 + 18432);
    LAS float* lrow = mrow + 64; LAS float* arow_ = mrow + 128; LAS int* sel = (LAS int*)(mrow + 192); LAS int* um = sel + 64;
    bf16_t* YAB = WSP(bf16_t, WS_YAB); const bf16_t* Kb = WSP(bf16_t, WS_K); const bf16_t* Vb = WSP(bf16_t, WS_V);
    const float* kmean = WSP(float, WS_KMEAN);
    const int row = F.tid >> 3, seg = F.tid & 7, fr = F.lane & 15, fq = F.lane >> 4, rb = 16 * (F.wave & 3), cb = 32 * (F.wave >> 2);
    for (int it = blockIdx.x; it < NB * NH * 64; it += F.G) {
        const int qc = it & 63, h = (it >> 6) & 7, b = it >> 9, cur = qc >> 2, t0 = 64 * qc;
        const size_t tb = (size_t)b * S;
        if (F.tid < 64) {
            float q[64];
            const bf16_t* qp = YAB + (tb + t0 + F.tid) * 1024 + h * 64;
#pragma unroll
            for (int i = 0; i < 8; ++i) { float t8[8]; unpack8(*(const u32x4*)(qp + 8 * i), t8);
#pragma unroll
                for (int e = 0; e < 8; ++e) q[8 * i + e] = t8[e]; }
            float b0 = -INFINITY, b1 = -INFINITY, b2 = -INFINITY; int i0 = -1, i1 = -1, i2 = -1;
            for (int j = 0; j < cur; ++j) { const float* km = kmean + ((size_t)(b * NH + h) * 16 + j) * 64; float s = 0.f;
#pragma unroll
                for (int d = 0; d < 64; ++d) s += q[d] * km[d];
                if (s > b0) { b2 = b1; i2 = i1; b1 = b0; i1 = i0; b0 = s; i0 = j; } else if (s > b1) { b2 = b1; i2 = i1; b1 = s; i1 = j; } else if (s > b2) { b2 = s; i2 = j; } }
            int m = 0; if (i0 >= 0) m |= 1 << i0; if (i1 >= 0) m |= 1 << i1; if (i2 >= 0) m |= 1 << i2;
            sel[F.tid] = m; mrow[F.tid] = NEG_BIG; lrow[F.tid] = 0.f;
            int u = m;
#pragma unroll
            for (int o = 1; o < 64; o <<= 1) u |= __shfl_xor(u, o);
            if (F.tid == 0) um[0] = u;
        }
        __syncthreads();
        const int umask = um[0];
        f32x4 o0 = {0.f, 0.f, 0.f, 0.f}, o1 = {0.f, 0.f, 0.f, 0.f};
        const RowsLinear aq{YAB + (tb + t0) * 1024 + h * 64, 1024};
        for (int j = 0; j <= cur; ++j) {
            if (j < cur && !((umask >> j) & 1)) continue;
            const int nkt = (j == cur) ? ((qc & 3) + 1) : 4;
            for (int kt = 0; kt < nkt; ++kt) {
                const int kbase = 256 * j + 64 * kt;
                const RowsLinear bk{Kb + (tb + kbase) * 512 + h * 64, 512};
                sgemm_tile(tS, 64, aq, bk, F.wave, F.lane);
                { float vv[8]; unpack8(*(const u32x4*)(Vb + (tb + kbase + row) * 512 + h * 64 + 8 * seg), vv);
#pragma unroll
                    for (int e = 0; e < 8; ++e) Vt[(8 * seg + e) * 72 + row] = (bf16_t)f2bf(vv[e]); }
                __syncthreads();
                {
                    float s[8]; float mx = NEG_BIG;
                    const bool rowsel = (j == cur) || ((sel[row] >> j) & 1);
#pragma unroll
                    for (int e = 0; e < 8; ++e) { const int c = 8 * seg + e; float x = tS[row * 65 + c];
                        if (!rowsel || (j == cur && kbase + c > t0 + row)) x = NEG_BIG; s[e] = x; mx = fmaxf(mx, x); }
                    mx = fmaxf(mx, __shfl_xor(mx, 1)); mx = fmaxf(mx, __shfl_xor(mx, 2)); mx = fmaxf(mx, __shfl_xor(mx, 4));
                    const float mold = mrow[row], mnew = fmaxf(mold, mx);
                    float alpha = 1.f, ps = 0.f; float p[8];
                    if (mnew <= NEG_BIG) {
#pragma unroll
                        for (int e = 0; e < 8; ++e) p[e] = 0.f;
                    } else { alpha = exp2f(mold - mnew);
#pragma unroll
                        for (int e = 0; e < 8; ++e) { p[e] = (s[e] <= NEG_BIG) ? 0.f : exp2f(s[e] - mnew); ps += p[e]; } }
                    ps += __shfl_xor(ps, 1); ps += __shfl_xor(ps, 2); ps += __shfl_xor(ps, 4);
                    const float lold = lrow[row];
                    *(LAS u32x4*)(Pb + row * 72 + 8 * seg) = pack8(p);
                    if (seg == 0) { mrow[row] = mnew; lrow[row] = lold * alpha + ps; arow_[row] = alpha; }
                }
                __syncthreads();
                {
#pragma unroll
                    for (int r = 0; r < 4; ++r) { const float a = arow_[rb + fq * 4 + r]; o0[r] *= a; o1[r] *= a; }
#pragma unroll
                    for (int ks = 0; ks < 2; ++ks) {
                        const bf16x8 a = *(const LAS bf16x8*)(Pb + (rb + fr) * 72 + 32 * ks + 8 * fq);
                        const bf16x8 v0 = *(const LAS bf16x8*)(Vt + (cb + fr) * 72 + 32 * ks + 8 * fq);
                        const bf16x8 v1 = *(const LAS bf16x8*)(Vt + (cb + 16 + fr) * 72 + 32 * ks + 8 * fq);
                        o0 = __builtin_amdgcn_mfma_f32_16x16x32_bf16(a, v0, o0, 0, 0, 0);
                        o1 = __builtin_amdgcn_mfma_f32_16x16x32_bf16(a, v1, o1, 0, 0, 0);
                    }
                }
                __syncthreads();
            }
        }
#pragma unroll
        for (int r = 0; r < 4; ++r) { const float li = 1.f / lrow[rb + fq * 4 + r]; tS[(rb + fq * 4 + r) * 65 + cb + fr] = o0[r] * li; tS[(rb + fq * 4 + r) * 65 + cb + 16 + fr] = o1[r] * li; }
        __syncthreads();
        { float v[8];
#pragma unroll
            for (int e = 0; e < 8; ++e) v[e] = tS[row * 65 + 8 * seg + e];
            *(u32x4*)(YAB + (tb + t0 + row) * 1024 + h * 64 + 8 * seg) = pack8(v); }
        __syncthreads();
    }
    const bf16_t* U = WSP(bf16_t, WS_U); const bf16_t* BG = WSP(bf16_t, WS_BG);
    for (int i = blockIdx.x * NTHREADS + F.tid; i < T * 64; i += F.G * NTHREADS) {
        const int t = i >> 6, c0 = (i & 63) * 8, pos = t & (S - 1);
        float u0[8], u1[8], u2[8], bg[8], y[8];
        unpack8(*(const u32x4*)(U + (size_t)t * 512 + c0), u2); unpack8(*(const u32x4*)(BG + (size_t)t * 512 + c0), bg);
        if (pos >= 1) unpack8(*(const u32x4*)(U + (size_t)(t - 1) * 512 + c0), u1); else {
#pragma unroll
            for (int e = 0; e < 8; ++e) u1[e] = 0.f; }
        if (pos >= 2) unpack8(*(const u32x4*)(U + (size_t)(t - 2) * 512 + c0), u0); else {
#pragma unroll
            for (int e = 0; e < 8; ++e) u0[e] = 0.f; }
#pragma unroll
        for (int e = 0; e < 8; ++e) y[e] = bg[e] * (F.conv_w[c0 + e] * u0[e] + F.conv_w[512 + c0 + e] * u1[e] + F.conv_w[1024 + c0 + e] * u2[e] + F.conv_b[c0 + e]);
        *(u32x4*)(YAB + (size_t)t * 1024 + 512 + c0) = pack8(y);
    }
}

namespace attn_body {
using bf16x8 = __attribute__((ext_vector_type(8))) short;
using s16x4 = __attribute__((ext_vector_type(4))) short;
using f32x16 = __attribute__((ext_vector_type(16))) float;
using u32x4 = __attribute__((ext_vector_type(4))) unsigned;
constexpr int SEQ = 4096, D = 64, DMQ = 1024, DMK = 512;
constexpr int NW = 8, QBLK = 32, QB = QBLK * NW, KVBLK = 64;
constexpr float NEGB = -1e30f;
__device__ __forceinline__ int crow(int r, int hi) { return (r & 3) + 8 * (r >> 2) + 4 * hi; }
#define SBAR() __builtin_amdgcn_sched_barrier(0)
__device__ __forceinline__ void cmask(f32x16& p0, f32x16& p1, int jb, int qrel, int hi) {
  const float NEG = -INFINITY; int kb = 64 * jb + 4 * hi;
  #pragma unroll
  for (int r = 0; r < 16; ++r) { int kv = kb + (r & 3) + 8 * (r >> 2); if (kv > qrel) p0[r] = NEG; if (kv + 32 > qrel) p1[r] = NEG; }
}
constexpr int NSLOT = 3, SLOTB = 8192;
constexpr int LDS_K = 0, LDS_V = NSLOT * SLOTB, LDS_WS = 2 * NSLOT * SLOTB, LDS_OST = LDS_WS + NW * 128 * 4, LDS_BYTES_A = LDS_OST + NW * 4096;
__device__ __forceinline__ void glds16(const void* gsrc, unsigned lds_dst) { unsigned keep;
  asm volatile("s_mov_b32 %0, m0\n\ts_mov_b32 m0, %2\n\ts_nop 0\n\tglobal_load_lds_dwordx4 %1, off\n\ts_mov_b32 m0, %0" : "=&s"(keep) : "v"(gsrc), "s"(lds_dst) : "memory"); }
__device__ __forceinline__ float max3f(float a, float b, float c) { float r; asm("v_max3_f32 %0, %1, %2, %3" : "=v"(r) : "v"(a), "v"(b), "v"(c)); return r; }
__device__ __forceinline__ float max2f(float a, float b) { float r; asm("v_max_f32_e32 %0, %1, %2" : "=v"(r) : "v"(a), "v"(b)); return r; }
__device__ __forceinline__ float fadd_s(float a, float b) { float r; asm("v_add_f32_e32 %0, %1, %2" : "=v"(r) : "v"(a), "v"(b)); return r; }
__device__ __forceinline__ float fsub_s(float a, float b) { float r; asm("v_sub_f32_e32 %0, %1, %2" : "=v"(r) : "v"(a), "v"(b)); return r; }
typedef float f32x2_t __attribute__((ext_vector_type(2))); typedef __bf16 bf16x2_t __attribute__((ext_vector_type(2)));
__device__ __forceinline__ unsigned cvtpk_s(float lo, float hi) { f32x2_t v = {lo, hi}; bf16x2_t b = __builtin_convertvector(v, bf16x2_t); return __builtin_bit_cast(unsigned, b); }
#define WAIT_BAR(N) asm volatile("s_waitcnt vmcnt(" #N ") lgkmcnt(0)\n\ts_barrier" ::: "memory")
__device__ __forceinline__ void qkt(f32x16& p0, f32x16& p1, const char* Kslot, const bf16x8* qr, const f32x16& negm, int r32, int hi) {
  const char* kb = Kslot + hi * 1024 + r32 * 16;
  #pragma unroll
  for (int d0 = 0; d0 < 4; ++d0) {
    const bf16x8 b0 = *reinterpret_cast<const bf16x8*>(kb + d0 * 2048);
    const bf16x8 b1 = *reinterpret_cast<const bf16x8*>(kb + d0 * 2048 + 512);
    if (d0 == 0) { p0 = __builtin_amdgcn_mfma_f32_32x32x16_bf16(b0, qr[0], negm, 0, 0, 0); p1 = __builtin_amdgcn_mfma_f32_32x32x16_bf16(b1, qr[0], negm, 0, 0, 0); }
    else { p0 = __builtin_amdgcn_mfma_f32_32x32x16_bf16(b0, qr[d0], p0, 0, 0, 0); p1 = __builtin_amdgcn_mfma_f32_32x32x16_bf16(b1, qr[d0], p1, 0, 0, 0); } }
}
typedef __attribute__((address_space(3))) const char* lds_cptr;
typedef __attribute__((address_space(3))) char* lds_ptr;
typedef short v4i16_t __attribute__((ext_vector_type(4)));
__device__ __forceinline__ void kload8(bf16x8* kf, lds_cptr kp) {
  kf[0] = *(const __attribute__((address_space(3))) bf16x8*)(kp);        kf[1] = *(const __attribute__((address_space(3))) bf16x8*)(kp + 512);
  kf[2] = *(const __attribute__((address_space(3))) bf16x8*)(kp + 2048); kf[3] = *(const __attribute__((address_space(3))) bf16x8*)(kp + 2560);
  kf[4] = *(const __attribute__((address_space(3))) bf16x8*)(kp + 4096); kf[5] = *(const __attribute__((address_space(3))) bf16x8*)(kp + 4608);
  kf[6] = *(const __attribute__((address_space(3))) bf16x8*)(kp + 6144); kf[7] = *(const __attribute__((address_space(3))) bf16x8*)(kp + 6656);
}
__device__ __forceinline__ void kload2(bf16x8* kf, lds_cptr kp, int j) { kf[2 * j] = *(const __attribute__((address_space(3))) bf16x8*)(kp + j * 2048); kf[2 * j + 1] = *(const __attribute__((address_space(3))) bf16x8*)(kp + j * 2048 + 512); }
__device__ __forceinline__ s16x4 vtr(lds_cptr p) { return __builtin_bit_cast(s16x4, __builtin_amdgcn_ds_read_tr16_b64_v4i16((__attribute__((address_space(3))) v4i16_t*)p)); }
__device__ __forceinline__ float rowmax(const f32x16& p0, const f32x16& p1) {
  float a = max3f(p0[0], p0[1], p1[0]), b = max3f(p0[2], p0[3], p1[1]); a = max3f(a, p1[2], p1[3]);
  #pragma unroll
  for (int r = 4; r < 16; r += 4) { a = max3f(a, p0[r], p0[r + 1]); b = max3f(b, p0[r + 2], p0[r + 3]); a = max3f(a, p1[r], p1[r + 1]); b = max3f(b, p1[r + 2], p1[r + 3]); }
  const float m = max2f(a, b);
  auto rr = __builtin_amdgcn_permlane32_swap(__float_as_uint(m), __float_as_uint(m), false, false);
  return max2f(__uint_as_float(rr[0]), __uint_as_float(rr[1]));
}
__device__ __forceinline__ void pv(f32x16* o, int vb, bf16x8 pa0, bf16x8 pa1, bf16x8 pa2, bf16x8 pa3) {
  #pragma unroll
  for (int d0 = 0; d0 < 2; ++d0) { s16x4 lo[4], hi[4];
    #pragma unroll
    for (int ks = 0; ks < 4; ++ks) {
      asm volatile("ds_read_b64_tr_b16 %0,%1 offset:%c2" : "=&v"(lo[ks]) : "v"(vb), "i"(d0 * 4096 + ks * 1024) : "memory");
      asm volatile("ds_read_b64_tr_b16 %0,%1 offset:%c2" : "=&v"(hi[ks]) : "v"(vb), "i"(d0 * 4096 + ks * 1024 + 512) : "memory"); }
    asm volatile("s_waitcnt lgkmcnt(0)" ::: "memory"); SBAR();
    #define PK(k) (bf16x8){lo[k][0], lo[k][1], lo[k][2], lo[k][3], hi[k][0], hi[k][1], hi[k][2], hi[k][3]}
    o[d0] = __builtin_amdgcn_mfma_f32_32x32x16_bf16(pa0, PK(0), o[d0], 0, 0, 0);
    o[d0] = __builtin_amdgcn_mfma_f32_32x32x16_bf16(pa1, PK(1), o[d0], 0, 0, 0);
    o[d0] = __builtin_amdgcn_mfma_f32_32x32x16_bf16(pa2, PK(2), o[d0], 0, 0, 0);
    o[d0] = __builtin_amdgcn_mfma_f32_32x32x16_bf16(pa3, PK(3), o[d0], 0, 0, 0);
    #undef PK
  }
}
#define ATTN_STORE16(p, v) st16((p), (v))
template <int THRL> __device__ __forceinline__ void attn_unit(int b, int h, int qb, const bf16_t* QO, bf16_t* Ob, const bf16_t* __restrict__ K, const bf16_t* __restrict__ V, const float* __restrict__ kmean, char* shm) {
  int tid_ = threadIdx.x; asm volatile("" : "+v"(tid_));
  const int tid = tid_, lane = tid & 63, r32 = lane & 31, hi = lane >> 5; const int wid = __builtin_amdgcn_readfirstlane(tid >> 6);
  const long rowbase = (long)b * SEQ; const int q0 = qb * QB;
  const bf16_t* Qw = QO + (rowbase + q0 + wid * QBLK) * DMQ + h * D;
  const bf16_t* Kh = K + rowbase * DMK + h * D, *Vh = V + rowbase * DMK + h * D;
  const unsigned lds0 = (unsigned)(uintptr_t)shm;
  float* wsf = (float*)(shm + LDS_WS) + wid * 128;
  const bf16_t* ksrc = Kh + (long)lane * DMK + wid * 8;
  const bf16_t* vsrc = Vh + (long)(16 * (wid & 3) + (lane >> 2)) * DMK + (wid >> 2) * 32 + (lane & 3) * 8;
  const unsigned kdst = lds0 + LDS_K + wid * 1024, vdst = lds0 + LDS_V + wid * 1024;
  #define DMA_K(t, slot) glds16(ksrc + (long)(t) * KVBLK * DMK, (unsigned)__builtin_amdgcn_readfirstlane(kdst + (slot)))
  #define DMA_V(t, slot) glds16(vsrc + (long)(t) * KVBLK * DMK, (unsigned)__builtin_amdgcn_readfirstlane(vdst + (slot)))
  DMA_K(0, 0); DMA_V(0, 0); DMA_K(1, SLOTB);
  bf16x8 qr[4];
  #pragma unroll
  for (int d0 = 0; d0 < 4; ++d0) qr[d0] = *reinterpret_cast<const bf16x8*>(&Qw[(long)r32 * DMQ + d0 * 16 + hi * 8]);
  unsigned selm = 0u;
  if (qb > 0) {
    float* kmL = (float*)(shm + LDS_OST);
    const float* kmg = kmean + ((size_t)(b * 8 + h) * 16) * 64;
    for (int i = tid; i < qb * 64; i += 512) kmL[i] = kmg[i];
    asm volatile("s_waitcnt vmcnt(0) lgkmcnt(0)\n\ts_barrier" ::: "memory");
    float qf[32];
    #pragma unroll
    for (int d0 = 0; d0 < 4; ++d0)
      #pragma unroll
      for (int e = 0; e < 8; ++e) qf[8 * d0 + e] = __uint_as_float(((unsigned)(unsigned short)qr[d0][e]) << 16);
    float b0 = -INFINITY, b1 = -INFINITY, b2 = -INFINITY; int i0 = -1, i1 = -1, i2 = -1;
    for (int j = 0; j < qb; ++j) {
      const float* km = kmL + j * 64 + 8 * hi; float sc = 0.f;
      #pragma unroll
      for (int d0 = 0; d0 < 4; ++d0)
        #pragma unroll
        for (int e = 0; e < 8; ++e) sc += qf[8 * d0 + e] * km[16 * d0 + e];
      sc += __shfl_xor(sc, 32);
      if (sc > b0) { b2 = b1; i2 = i1; b1 = b0; i1 = i0; b0 = sc; i0 = j; } else if (sc > b1) { b2 = b1; i2 = i1; b1 = sc; i1 = j; } else if (sc > b2) { b2 = sc; i2 = j; }
    }
    if (i0 >= 0) selm |= 1u << i0; if (i1 >= 0) selm |= 1u << i1; if (i2 >= 0) selm |= 1u << i2;
    asm volatile("s_waitcnt lgkmcnt(0)\n\ts_barrier" ::: "memory");
  }
  if (hi == 0) ((unsigned*)wsf)[64 + r32] = selm;
  { const lds_ptr qst = (lds_ptr)shm + LDS_OST + wid * 4096 + lane * 16;
    #pragma unroll
    for (int d0 = 0; d0 < 4; ++d0) *(__attribute__((address_space(3))) bf16x8*)(qst + d0 * 1024) = qr[d0]; }
  #define SELROW(j) (((j) >= qb) || ((((const unsigned*)wsf)[64 + r32] >> (j)) & 1u))
  #define NEGM_SET(blk) do { const float nv_ = SELROW(blk) ? -mhat : NEGB; _Pragma("unroll") for (int r = 0; r < 16; ++r) negm[r] = nv_; asm volatile("" : "+v"(negm)); } while (0)
  const int vb0 = (int)(lds0 + LDS_V) + ((lane >> 4) & 1) * 32 + (lane & 3) * 8 + (4 * hi + ((lane & 15) >> 2)) * 64;
  const char* Kbase = shm + LDS_K; bf16x8 kf[8];
  const lds_cptr qp0 = (lds_cptr)shm + LDS_OST + wid * 4096 + lane * 16;
  const lds_cptr shm3 = (lds_cptr)shm; const lds_cptr kp0 = shm3 + LDS_K + hi * 1024 + r32 * 16; const lds_cptr vp0 = shm3 + LDS_V + ((lane >> 4) & 1) * 32 + (lane & 3) * 8 + (4 * hi + ((lane & 15) >> 2)) * 64;
  const int NT = (q0 + QB) / KVBLK;
  float mhat = 0.f, l_reg = 0.f; f32x16 o[2]; o[0] = f32x16{}; o[1] = f32x16{}; f32x16 negm;
  NEGM_SET(0);
  const int qrel = wid * QBLK + r32;
  #define CMASK(P0, P1, t) do { int jb_ = (t) - (NT - 4); if (jb_ >= 0) cmask(P0, P1, jb_, qrel, hi); } while (0)
  bool resc = false;
  #define START(P0, P1) do { const float rm = rowmax(P0, P1); resc = false; \
    { const float dl = SELROW(0) ? rm : 0.f; mhat = fadd_s(mhat, dl); \
      _Pragma("unroll") for (int r = 0; r < 16; ++r) { P0[r] = fsub_s(P0[r], dl); P1[r] = fsub_s(P1[r], dl); } \
      NEGM_SET(0); } \
    _Pragma("unroll") for (int r = 0; r < 16; ++r) P0[r] = __builtin_amdgcn_exp2f(P0[r]); } while (0)
  #define RESC() do { if (resc) { asm volatile("s_waitcnt lgkmcnt(0)" ::: "memory"); \
      _Pragma("unroll") for (int d_ = 0; d_ < 2; ++d_) _Pragma("unroll") for (int r = 0; r < 16; ++r) o[d_][r] *= wsf[crow(r, hi)]; } } while (0)
  f32x16 pA0, pA1, pB0, pB1;
  int sl_prev = 0, sl_cur = 0, sl_next = SLOTB;
  #define ROT() do { sl_prev = sl_cur; sl_cur = sl_next; sl_next = (sl_next == (NSLOT - 1) * SLOTB) ? 0 : sl_next + SLOTB; } while (0)
  DMA_K(2, 2 * SLOTB);
  WAIT_BAR(3);
  qkt(pA0, pA1, Kbase, qr, negm, r32, hi); asm volatile("s_nop 15\n\ts_nop 7" : "+v"(pA0), "+v"(pA1)); CMASK(pA0, pA1, 0);
  START(pA0, pA1);
  _Pragma("unroll") for (int r = 0; r < 16; ++r) pA1[r] = __builtin_amdgcn_exp2f(pA1[r]);
  WAIT_BAR(0);
  DMA_K(3, 0); DMA_V(1, SLOTB);
  ROT();
  kload8(kf, kp0 + sl_cur);
  WAIT_BAR(2);
  s16x4 vlo[8], vhi[8]; u32x4 pw0, pw1, pw2, pw3; bf16x8 q0_, q1_, q2_, q3_;
  #define QRD(d) do { q##d##_ = *(const __attribute__((address_space(3))) bf16x8*)(qp0 + (d) * 1024); } while (0)
  QRD(0); QRD(1);
  #define PKW(P, B) cvtpk_s(P[B], P[B + 1])
  #define PAF(k) __builtin_bit_cast(bf16x8, pw##k)
  #define VFR(i) (bf16x8){vlo[i][0], vlo[i][1], vlo[i][2], vlo[i][3], vhi[i][0], vhi[i][1], vhi[i][2], vhi[i][3]}
  #define PIN(x) asm volatile("" : "+v"(x))
  #define MX3(a, b, c) __builtin_fmaxf(__builtin_fmaxf((a), (b)), (c))
  #define GAPA(MF, A0, A1, A2, A3, W0, W1, PW) do { MF; sacc += A0; sacc += A1; sacc += A2; sacc += A3; PIN(sacc); W0; W1; PIN(PW); SBAR(); } while (0)
  #define EX(v) __builtin_amdgcn_exp2f(v)
  #define GAPB(MF, X, B) do { MF; X[B] = EX(X[B]); X[B + 1] = EX(X[B + 1]); X[B + 2] = EX(X[B + 2]); X[B + 3] = EX(X[B + 3]); PIN(X); SBAR(); } while (0)
  #define VRD(i) do { vlo[i] = vtr(vp_ + (((i) >> 2) * 4096 + ((i) & 3) * 1024)); vhi[i] = vtr(vp_ + (((i) >> 2) * 4096 + ((i) & 3) * 1024 + 512)); } while (0)
  #define KRD(G, j) do { if (G) { kload2(kf, kp0 + sl_next, j); SBAR(); } } while (0)
  #define STEP(C0, C1, P0, P1, t, GK, GV, GL) do { SBAR(); \
    const lds_cptr vp_ = vp0 + sl_prev; \
    VRD(0); SBAR(); float sacc = (P0[0] + P0[1]); \
    GAPA(C0 = __builtin_amdgcn_mfma_f32_32x32x16_bf16(kf[0], q0_, negm, 0, 0, 0), P0[2], P0[3], P0[4], P0[5],     pw0[0] = PKW(P0, 0), pw0[1] = PKW(P0, 2), pw0); \
    VRD(4); SBAR(); GAPA(C1 = __builtin_amdgcn_mfma_f32_32x32x16_bf16(kf[1], q0_, negm, 0, 0, 0), P0[6], P0[7], P0[8], P0[9],     pw0[2] = PKW(P0, 4), pw0[3] = PKW(P0, 6), pw0); \
    QRD(2); SBAR(); \
    VRD(1); SBAR(); GAPA(C0 = __builtin_amdgcn_mfma_f32_32x32x16_bf16(kf[2], q1_, C0, 0, 0, 0),   P0[10], P0[11], P0[12], P0[13], pw1[0] = PKW(P0, 8), pw1[1] = PKW(P0, 10), pw1); \
    VRD(5); SBAR(); GAPA(C1 = __builtin_amdgcn_mfma_f32_32x32x16_bf16(kf[3], q1_, C1, 0, 0, 0),   P0[14], P0[15], P1[0], P1[1],   pw1[2] = PKW(P0, 12), pw1[3] = PKW(P0, 14), pw1); \
    QRD(3); SBAR(); \
    VRD(2); SBAR(); GAPA(C0 = __builtin_amdgcn_mfma_f32_32x32x16_bf16(kf[4], q2_, C0, 0, 0, 0),   P1[2], P1[3], P1[4], P1[5],     pw2[0] = PKW(P1, 0), pw2[1] = PKW(P1, 2), pw2); \
    VRD(6); SBAR(); GAPA(C1 = __builtin_amdgcn_mfma_f32_32x32x16_bf16(kf[5], q2_, C1, 0, 0, 0),   P1[6], P1[7], P1[8], P1[9],     pw2[2] = PKW(P1, 4), pw2[3] = PKW(P1, 6), pw2); \
    VRD(3); SBAR(); GAPA(C0 = __builtin_amdgcn_mfma_f32_32x32x16_bf16(kf[6], q3_, C0, 0, 0, 0),   P1[10], P1[11], P1[12], P1[13], pw3[0] = PKW(P1, 8), pw3[1] = PKW(P1, 10), pw3); \
    VRD(7); SBAR(); GAPA(C1 = __builtin_amdgcn_mfma_f32_32x32x16_bf16(kf[7], q3_, C1, 0, 0, 0),   P1[14], P1[15], 0.f, 0.f,       pw3[2] = PKW(P1, 12), pw3[3] = PKW(P1, 14), pw3); \
    l_reg += sacc; \
    if (GK) { DMA_K((t) + 3, sl_cur); } if (GV) { DMA_V((t) + 1, sl_next); } \
    CMASK(C0, C1, t); \
    { float a = MX3(C0[0], C0[1], C1[0]), b = MX3(C0[2], C0[3], C1[1]); a = MX3(a, C1[2], C1[3]); \
      _Pragma("unroll") for (int r = 4; r < 16; r += 4) { a = MX3(a, C0[r], C0[r + 1]); b = MX3(b, C0[r + 2], C0[r + 3]); a = MX3(a, C1[r], C1[r + 1]); b = MX3(b, C1[r + 2], C1[r + 3]); } \
      float rm = __builtin_fmaxf(a, b); { auto rr = __builtin_amdgcn_permlane32_swap(__float_as_uint(rm), __float_as_uint(rm), false, false); rm = __builtin_fmaxf(__uint_as_float(rr[0]), __uint_as_float(rr[1])); } \
      resc = false; \
      if (__builtin_expect(__any(rm > (float)THRL), 0)) { const float dl = __builtin_fmaxf(rm, 0.f); mhat += dl; \
        _Pragma("unroll") for (int r = 0; r < 16; ++r) { C0[r] -= dl; C1[r] -= dl; } \
        NEGM_SET(((t) + 1) >> 2); \
        const float f = __builtin_amdgcn_exp2f(-dl); l_reg *= f; if (hi == 0) wsf[r32] = f; resc = true; } \
      else if ((((t) + 1) & 3) == 0) { NEGM_SET(((t) + 1) >> 2); } } \
    SBAR(); \
    GAPB(o[0] = __builtin_amdgcn_mfma_f32_32x32x16_bf16(PAF(0), VFR(0), o[0], 0, 0, 0), C0, 0); \
    GAPB(o[1] = __builtin_amdgcn_mfma_f32_32x32x16_bf16(PAF(0), VFR(4), o[1], 0, 0, 0), C0, 4); \
    KRD(GL, 0); GAPB(o[0] = __builtin_amdgcn_mfma_f32_32x32x16_bf16(PAF(1), VFR(1), o[0], 0, 0, 0), C0, 8); \
    KRD(GL, 1); GAPB(o[1] = __builtin_amdgcn_mfma_f32_32x32x16_bf16(PAF(1), VFR(5), o[1], 0, 0, 0), C0, 12); \
    KRD(GL, 2); GAPB(o[0] = __builtin_amdgcn_mfma_f32_32x32x16_bf16(PAF(2), VFR(2), o[0], 0, 0, 0), C1, 0); \
    KRD(GL, 3); GAPB(o[1] = __builtin_amdgcn_mfma_f32_32x32x16_bf16(PAF(2), VFR(6), o[1], 0, 0, 0), C1, 4); \
    GAPB(o[0] = __builtin_amdgcn_mfma_f32_32x32x16_bf16(PAF(3), VFR(3), o[0], 0, 0, 0), C1, 8); \
    GAPB(o[1] = __builtin_amdgcn_mfma_f32_32x32x16_bf16(PAF(3), VFR(7), o[1], 0, 0, 0), C1, 12); \
    QRD(0); QRD(1); SBAR(); \
    } while (0)
  int t = 1;
  #undef CMASK
  #define CMASK(P0, P1, t) do {} while (0)
  for (; t + 5 < NT; t += 2) {
    STEP(pB0, pB1, pA0, pA1, t, true, true, true);     WAIT_BAR(2); RESC(); ROT();
    STEP(pA0, pA1, pB0, pB1, t + 1, true, true, true); WAIT_BAR(2); RESC(); ROT();
  }
  #undef CMASK
  #define CMASK(P0, P1, t) do { int jb_ = (t) - (NT - 4); if (jb_ >= 0) cmask(P0, P1, jb_, qrel, hi); } while (0)
  #define ENDW(tt) do { if ((tt) + 3 < NT) { WAIT_BAR(2); } else if ((tt) + 2 < NT) { WAIT_BAR(1); } else { WAIT_BAR(0); } } while (0)
  for (; t + 1 < NT; t += 2) {
    STEP(pB0, pB1, pA0, pA1, t, (t + 3 < NT), (t + 1 < NT), (t + 1 < NT));       ENDW(t);     RESC(); ROT();
    STEP(pA0, pA1, pB0, pB1, t + 1, (t + 4 < NT), (t + 2 < NT), (t + 2 < NT));   ENDW(t + 1); RESC(); ROT();
  }
  STEP(pB0, pB1, pA0, pA1, NT - 1, false, false, false); RESC();
  { float sacc = pB0[0] + pB0[1]; _Pragma("unroll") for (int r = 2; r < 16; ++r) sacc += pB0[r]; _Pragma("unroll") for (int r = 0; r < 16; ++r) sacc += pB1[r]; l_reg += sacc;
    pw0 = (u32x4){PKW(pB0, 0), PKW(pB0, 2), PKW(pB0, 4), PKW(pB0, 6)}; pw1 = (u32x4){PKW(pB0, 8), PKW(pB0, 10), PKW(pB0, 12), PKW(pB0, 14)}; pw2 = (u32x4){PKW(pB1, 0), PKW(pB1, 2), PKW(pB1, 4), PKW(pB1, 6)}; pw3 = (u32x4){PKW(pB1, 8), PKW(pB1, 10), PKW(pB1, 12), PKW(pB1, 14)};
    SBAR(); pv(o, vb0 + sl_cur, PAF(0), PAF(1), PAF(2), PAF(3)); }
  #undef PKW
  #undef PAF
  #undef VFR
  #undef PIN
  #undef MX3
  #undef GAPA
  #undef GAPB
  #undef EX
  #undef VRD
  #undef KRD
  #undef QRD
  #undef STEP
  #undef ENDW
  { auto rr = __builtin_amdgcn_permlane32_swap(__float_as_uint(l_reg), __float_as_uint(l_reg), false, false); l_reg = __uint_as_float(rr[0]) + __uint_as_float(rr[1]); }
  if (hi == 0) wsf[32 + r32] = l_reg; asm volatile("s_waitcnt lgkmcnt(0)" ::: "memory");
  float rli[16];
  #pragma unroll
  for (int r = 0; r < 16; ++r) rli[r] = __builtin_amdgcn_rcpf(wsf[32 + crow(r, hi)]);
  bf16_t* Ow = Ob + (rowbase + q0 + wid * QBLK) * DMQ + h * D;
  { bf16_t* stg = (bf16_t*)(shm + LDS_OST) + wid * 2048;
    #pragma unroll
    for (int r = 0; r < 16; ++r) { const int orow = crow(r, hi);
      #pragma unroll
      for (int d0 = 0; d0 < 2; ++d0) stg[orow * 64 + d0 * 32 + r32] = (bf16_t)f2bf(o[d0][r] * rli[r]); }
    asm volatile("s_waitcnt lgkmcnt(0)" ::: "memory");
    #pragma unroll
    for (int i = 0; i < 4; ++i) { const int row = i * 8 + (lane >> 3), ch = lane & 7; const u32x4 v = *(const u32x4*)(stg + row * 64 + ch * 8); ATTN_STORE16(Ow + (long)row * DMQ + ch * 8, v); } }
  asm volatile("s_waitcnt lgkmcnt(0)\n\ts_barrier" ::: "memory");
  #undef DMA_K
  #undef DMA_V
  #undef CMASK
  #undef START
  #undef RESC
  #undef ROT
  #undef SELROW
  #undef NEGM_SET
}
#undef SBAR
#undef WAIT_BAR
}
__device__ __forceinline__ void conv_pass(Frame& F) {
    bf16_t* YAB = WSP(bf16_t, WS_YAB); const bf16_t* U = WSP(bf16_t, WS_U); const bf16_t* BG = WSP(bf16_t, WS_BG);
    const int stride = F.G * NTHREADS;
    for (int i0 = blockIdx.x * NTHREADS + F.tid; i0 < T * 64; i0 += 2 * stride) {
        u32x4 r2[2], r1[2], r0[2], rb[2];
#pragma unroll
        for (int q = 0; q < 2; ++q) { const int i = i0 + q * stride; const int t = i >> 6, c0 = (i & 63) * 8, pos = t & (S - 1);
            r2[q] = *(const u32x4*)(U + (size_t)t * 512 + c0); rb[q] = __builtin_nontemporal_load((const u32x4*)(BG + (size_t)t * 512 + c0));
            r1[q] = (pos >= 1) ? *(const u32x4*)(U + (size_t)(t - 1) * 512 + c0) : (u32x4){0u, 0u, 0u, 0u};
            r0[q] = (pos >= 2) ? *(const u32x4*)(U + (size_t)(t - 2) * 512 + c0) : (u32x4){0u, 0u, 0u, 0u}; }
#pragma unroll
        for (int q = 0; q < 2; ++q) { const int i = i0 + q * stride; const int t = i >> 6, c0 = (i & 63) * 8;
            float u0[8], u1[8], u2[8], bg[8], y[8]; unpack8(r2[q], u2); unpack8(r1[q], u1); unpack8(r0[q], u0); unpack8(rb[q], bg);
#pragma unroll
            for (int e4 = 0; e4 < 2; ++e4) { const f32x4 w0 = *(const f32x4*)(F.conv_w + c0 + 4 * e4), w1 = *(const f32x4*)(F.conv_w + 512 + c0 + 4 * e4), w2 = *(const f32x4*)(F.conv_w + 1024 + c0 + 4 * e4), cb = *(const f32x4*)(F.conv_b + c0 + 4 * e4);
#pragma unroll
                for (int e = 0; e < 4; ++e) y[4 * e4 + e] = bg[4 * e4 + e] * (w0[e] * u0[4 * e4 + e] + w1[e] * u1[4 * e4 + e] + w2[e] * u2[4 * e4 + e] + cb[e]); }
            st16(YAB + (size_t)t * 1024 + 512 + c0, pack8(y)); }
    }
}
__device__ __forceinline__ void s3_attn(Frame& F, char* lds_gen, bf16_t* obase) {
    const int vcu = (blockIdx.x % 8) * (F.G / 8) + blockIdx.x / 8;
    const int s = vcu & 7, pr = vcu >> 3;
#pragma unroll 1
    for (int i = 0; i < 4; ++i) {
        const int bh = 2 * pr + (i >> 1), qb = (i & 1) ? 15 - s : s;
        attn_body::attn_unit<8>(bh >> 3, bh & 7, qb, WSP(bf16_t, WS_YAB), obase, WSP(bf16_t, WS_K), WSP(bf16_t, WS_V), WSP(float, WS_KMEAN), lds_gen);
        if (!(i & 1)) { { int t_ = threadIdx.x; asm volatile("" : "+v"(t_)); F.tid = t_; F.lane = t_ & 63; }
            const int lo = X_NONEXP + (i >> 1) * (NE * 256);
            convert_items(F, lo, lo + NE * 256, blockIdx.x * NWAVES + F.wave, F.G * NWAVES);
            __syncthreads(); }
    }
}
__device__ __forceinline__ void s3_fast(Frame& F, char* lds_gen) { s3_attn(F, lds_gen, WSP(bf16_t, WS_YAB)); conv_pass(F); }

__device__ __forceinline__ void s4_simple(Frame& F) {
    LAS float* tile = (LAS float*)F.lds; LAS float* tile2 = tile + 64 * 65;
    const bf16_t* YAB = WSP(bf16_t, WS_YAB); const bf16_t* WP = WSP(bf16_t, WS_WP_T); const bf16_t* GT = WSP(bf16_t, WS_GATES);
    const int row = F.tid >> 3, seg = F.tid & 7;
    for (int it = blockIdx.x; it < 512 * 16; it += F.G) {
        const int rt = it >> 4, ct = it & 15, r0 = rt * 64, gr = r0 + row;
        const RowsLinear aa{YAB + (size_t)r0 * 1024, 1024}, ab{YAB + (size_t)r0 * 1024 + 512, 1024};
        const RowsLinear ba{WP + (size_t)(64 * ct) * 1024, 1024}, bb{WP + (size_t)(64 * ct) * 1024 + 512, 1024};
        sgemm_tile(tile, 512, aa, ba, F.wave, F.lane); sgemm_tile(tile2, 512, ab, bb, F.wave, F.lane); __syncthreads();
        float ga[8], gb[8], v[8];
        unpack8(*(const u32x4*)(GT + (size_t)gr * 2048 + 64 * ct + 8 * seg), ga); unpack8(*(const u32x4*)(GT + (size_t)gr * 2048 + 1024 + 64 * ct + 8 * seg), gb);
#pragma unroll
        for (int e = 0; e < 8; ++e) v[e] = ga[e] * tile[row * 65 + 8 * seg + e] + gb[e] * tile2[row * 65 + 8 * seg + e];
        *(u32x4*)(WSP(bf16_t, WS_H) + (size_t)gr * 1024 + 64 * ct + 8 * seg) = pack8(v);
        __syncthreads();
    }
}
__device__ __forceinline__ void s5_simple(Frame& F) {
    LAS float* tile = (LAS float*)F.lds;
    const bf16_t* MG = WSP(bf16_t, WS_H); const bf16_t* WO = WSP(bf16_t, WS_WO_T);
    const int row = F.tid >> 3, seg = F.tid & 7;
    for (int it = blockIdx.x; it < 512 * 16; it += F.G) {
        const int rt = it >> 4, ct = it & 15, r0 = rt * 64, gr = r0 + row, b = r0 / S;
        const RowsLinear aa{MG + (size_t)r0 * 1024, 1024}, bb{WO + (size_t)(64 * ct) * 1024, 1024};
        sgemm_tile(tile, 1024, aa, bb, F.wave, F.lane); __syncthreads();
        const float* ga1 = WSP(float, WS_MOD) + (size_t)b * NMOD + 2048 + 64 * ct + 8 * seg;
        const float* xr = F.x + (size_t)gr * D + 64 * ct + 8 * seg; float* orow = F.out + (size_t)gr * D + 64 * ct + 8 * seg;
#pragma unroll
        for (int e4 = 0; e4 < 2; ++e4) { const f32x4 xv = *(const f32x4*)(xr + 4 * e4), gv = *(const f32x4*)(ga1 + 4 * e4); f32x4 o;
#pragma unroll
            for (int e = 0; e < 4; ++e) o[e] = xv[e] + gv[e] * tile[row * 65 + 8 * seg + 4 * e4 + e];
            *(f32x4*)(orow + 4 * e4) = o; }
        __syncthreads();
    }
}

struct EpiG2 {
    static constexpr bool HAS_MID = true;
    const bf16_t* gates; bf16_t* merged;
    struct State {};
    __device__ __forceinline__ void mid(Acc& acc, const pg8::Unit& u, int wr, int wc, int fr, int fq, State&) const {
        int rl0 = wr * 64 + fr; const int ct = 32 * wc + 8 * fq; asm volatile("" : "+v"(rl0));
        u32x4 ra[2][4][2];
#pragma unroll
        for (int ai = 0; ai < 2; ++ai)
#pragma unroll
            for (int m = 0; m < 4; ++m) { const bf16_t* gp = gates + ((size_t)(u.pm * 4 + u.pn) * 256 + (size_t)(rl0 + 128 * ai + 16 * m)) * 256 + ct;
#pragma unroll
                for (int bj = 0; bj < 2; ++bj) ra[ai][m][bj] = *(const u32x4*)(gp + 128 * bj); }
        asm volatile("s_waitcnt vmcnt(0)" ::: "memory");
#pragma unroll
        for (int ai = 0; ai < 2; ++ai)
#pragma unroll
            for (int m = 0; m < 4; ++m)
#pragma unroll
                for (int bj = 0; bj < 2; ++bj) { f32x4 a0, a1; unpack8v(ra[ai][m][bj], a0, a1); acc[ai][bj][m][0] *= a0; acc[ai][bj][m][1] *= a1; }
    }
    __device__ __forceinline__ void operator()(Acc& acc, const pg8::Unit& u, int wr, int wc, int fr, int fq, State&) const {
        int rl0 = wr * 64 + fr; const int ct = 32 * wc + 8 * fq, c0 = u.pn * 256 + ct; asm volatile("" : "+v"(rl0)); const int row0 = u.pm * 256 + rl0;
        u32x4 gb[2][4][2];
#pragma unroll
        for (int ai = 0; ai < 2; ++ai)
#pragma unroll
            for (int m = 0; m < 4; ++m) { const bf16_t* gp = gates + (size_t)T * 1024 + ((size_t)(u.pm * 4 + u.pn) * 256 + (size_t)(rl0 + 128 * ai + 16 * m)) * 256 + ct;
#pragma unroll
                for (int bj = 0; bj < 2; ++bj) gb[ai][m][bj] = *(const u32x4*)(gp + 128 * bj); }
        asm volatile("s_waitcnt vmcnt(0)" ::: "memory");
#pragma unroll
        for (int ai = 0; ai < 2; ++ai)
#pragma unroll
            for (int m = 0; m < 4; ++m) { const size_t r = (size_t)(row0 + 128 * ai + 16 * m);
#pragma unroll
                for (int bj = 0; bj < 2; ++bj) { f32x4 b0, b1; unpack8v(gb[ai][m][bj], b0, b1);
                    *(u32x2*)((unsigned char*)merged + r * 1024 + c0 + 128 * bj) = pack8_fp8(acc[ai][bj][m][0] * b0, acc[ai][bj][m][1] * b1); } }
    }
};
__device__ __forceinline__ void s4_fast(Frame& F) {
    const pg8::DenseSched Sd{(const char*)(F.ws + WS_YAB), (const char*)(F.ws + WS_WP_T), T / 256, 4, 1024, F.G, (int)blockIdx.x};
    const EpiG2 E{WSP(bf16_t, WS_GATES), WSP(bf16_t, WS_H)};
    if (F.skip) pg8::gemm_phase<EpiG2, pg8::DenseSched, true>(F.lds, 1024, Sd, E); else pg8::gemm_phase<EpiG2, pg8::DenseSched>(F.lds, 1024, Sd, E);
}
struct EpiG3 {
    static constexpr bool HAS_MID = false;
    const float* x; bf16_t* x1; const float* mod;
    struct State {}; __device__ __forceinline__ void mid(Acc&, const pg8::Unit&, int, int, int, int, State&) const {}
    __device__ __forceinline__ void operator()(Acc& acc, const pg8::Unit& u, int wr, int wc, int fr, int fq, State& st) const {
        int row0 = u.pm * 256 + wr * 64 + fr; const int c0 = u.pn * 256 + 32 * wc + 8 * fq, b = u.pm >> 4; asm volatile("" : "+v"(row0));
        f32x4 gv[2][2];
#pragma unroll
        for (int bj = 0; bj < 2; ++bj)
#pragma unroll
            for (int n = 0; n < 2; ++n) gv[bj][n] = *(const f32x4*)(mod + (size_t)b * NMOD + 2048 + c0 + 128 * bj + 4 * n) * (1.f / W8_SCALE);
#pragma unroll
        for (int ai = 0; ai < 2; ++ai)
#pragma unroll
            for (int m = 0; m < 4; ++m) { const size_t off = (size_t)(row0 + 128 * ai + 16 * m) * D + c0;
#pragma unroll
                for (int bj = 0; bj < 2; ++bj) { const f32x4 x0 = __builtin_nontemporal_load((const f32x4*)(x + off + 128 * bj)), x1v = __builtin_nontemporal_load((const f32x4*)(x + off + 128 * bj + 4));
                    st16(x1 + off + 128 * bj, pack8v(x0 + gv[bj][0] * acc[ai][bj][m][0], x1v + gv[bj][1] * acc[ai][bj][m][1])); }
                if (m == 3) asm volatile("" ::: "memory"); }
    }
};
__device__ __forceinline__ void s5_fast(Frame& F) {
    const pg8::DenseSched8 Sd{(const char*)(F.ws + WS_H), (const char*)(F.ws + WS_WO_T), T / 256, 4, 1024, F.G, (int)blockIdx.x};
    const EpiG3 E{F.x, WSP(bf16_t, WS_X1), WSP(float, WS_MOD)};
    int Ko = D; asm volatile("" : "+s"(Ko));
    pg8::gemm_phase<EpiG3, pg8::DenseSched8>(F.lds, Ko, Sd, E);
}
struct MoeTab { const LAS int* cnt; const LAS int* tstart; const LAS int* tile_e; int nM; };
__device__ __forceinline__ MoeTab moe_table(Frame& F) {
    LAS int* cntL = (LAS int*)(F.lds + MISC_OFF + 1024); LAS int* ts = cntL + 32; LAS int* te = cntL + 96;
    if (F.tid < 32) cntL[F.tid] = (int)__hip_atomic_load(WSP(unsigned, WS_CTL) + CW_GCNT + 64 * F.tid, __ATOMIC_RELAXED, __HIP_MEMORY_SCOPE_AGENT);
    __syncthreads();
    if (F.tid == 0) { int pm = 0; for (int e = 0; e < 32; ++e) { ts[e] = pm; const int n = (cntL[e] + 255) >> 8; for (int i = 0; i < n; ++i) te[pm++] = e; } ts[32] = pm; }
    __syncthreads();
    return MoeTab{cntL, ts, te, ts[32]};
}
struct MoeUpSched {
    static constexpr bool GATHER = true, FP8 = true;
    const char* h2; const char* w13; MoeTab tb; const int* linfo; int G, c;
    __device__ __forceinline__ bool next(int i, pg8::Unit& u) const { if (!pg8::static_unit(i, G, c, tb.nM, 4, u.pm, u.pn)) return false;
        u.e = tb.tile_e[u.pm]; u.rbase = (u.pm - tb.tstart[u.e]) * 256; u.a = h2; u.b = w13 + ((size_t)u.e * 1024 + 256 * u.pn) * 1024; return true; }
    __device__ __forceinline__ int row_index(const pg8::Unit& u, int r) const { const int rank = u.rbase + r; return rank < tb.cnt[u.e] ? (linfo[(size_t)u.e * 65536 + rank] >> 1) : 0; }
};
struct EpiUp {
    static constexpr bool HAS_MID = false;
    bf16_t* hid; const float* lw; const LAS int* cnt;
    struct State {}; __device__ __forceinline__ void mid(Acc&, const pg8::Unit&, int, int, int, int, State&) const {}
    __device__ __forceinline__ void operator()(Acc& acc, const pg8::Unit& u, int wr, int wc, int fr, int fq, State& st) const {
        int rl0 = wr * 64 + fr; const int c0 = u.pn * 128 + 32 * wc + 8 * fq, n_e = cnt[u.e]; asm volatile("" : "+v"(rl0));
#pragma unroll
        for (int ai = 0; ai < 2; ++ai)
#pragma unroll
            for (int m = 0; m < 4; ++m) { const int rl = rl0 + 128 * ai + 16 * m, rank = u.rbase + rl; const float wt = rank < n_e ? 1.f : 0.f; f32x4 o[2];
#pragma unroll
                for (int n = 0; n < 2; ++n)
#pragma unroll
                    for (int e = 0; e < 4; ++e) { const float a = acc[ai][0][m][n][e] * (1.f / W8_SCALE), c = acc[ai][1][m][n][e] * (1.f / W8_SCALE); o[n][e] = a * __builtin_amdgcn_rcpf(1.f + __expf(-a)) * c * wt; }
                *(u32x2*)((unsigned char*)hid + (size_t)(u.pm * 256 + rl) * 512 + c0) = pack8_fp8(o[0], o[1]); }
    }
};
__device__ __forceinline__ void s8_fast(Frame& F) {
    const MoeTab tb = moe_table(F);
    const MoeUpSched Sd{(const char*)(F.ws + WS_H2), (const char*)(F.ws + WS_W13_T), tb, WSP(int, WS_LINFO), F.G, (int)blockIdx.x};
    const EpiUp E{WSP(bf16_t, WS_HID), WSP(float, WS_LW), tb.cnt};
    int Ku = D; asm volatile("" : "+s"(Ku));
    if (F.skip) pg8::gemm_phase<EpiUp, MoeUpSched, true>(F.lds, Ku, Sd, E); else pg8::gemm_phase<EpiUp, MoeUpSched>(F.lds, Ku, Sd, E);
    { int t_ = threadIdx.x; asm volatile("" : "+v"(t_)); F.tid = t_; F.lane = t_ & 63; }
    { const int units = tb.nM * 4, rem = units % F.G, nidle = (rem == 0) ? F.G : F.G - rem, me = (rem == 0) ? (int)blockIdx.x : (int)blockIdx.x - rem;
        if (me >= 0 && !F.skip) convert_items(F, X_W2, X_END, me * NWAVES + F.wave, nidle * NWAVES); }
}
struct MoeDownSched {
    static constexpr bool GATHER = false, FP8 = true;
    const char* hid; const char* w2; MoeTab tb; int G, c;
    __device__ __forceinline__ bool next(int i, pg8::Unit& u) const { if (!pg8::static_unit(i, G, c, tb.nM, 4, u.pm, u.pn)) return false;
        u.e = tb.tile_e[u.pm]; u.rbase = (u.pm - tb.tstart[u.e]) * 256; u.a = hid + (size_t)u.pm * 256 * 512; u.b = w2 + ((size_t)u.e * 1024 + 256 * u.pn) * 512; return true; }
    __device__ __forceinline__ int row_index(const pg8::Unit&, int) const { return 0; }
};
struct EpiDown {
    static constexpr bool HAS_MID = false;
    bf16_t* yslot; const int* linfo; const float* lw; const LAS int* cnt;
    struct State {}; __device__ __forceinline__ void mid(Acc&, const pg8::Unit&, int, int, int, int, State&) const {}
    __device__ __forceinline__ void operator()(Acc& acc, const pg8::Unit& u, int wr, int wc, int fr, int fq, State& st) const {
        int rl0 = wr * 64 + fr; const int c0 = u.pn * 256 + 32 * wc + 8 * fq, n_e = cnt[u.e]; asm volatile("" : "+v"(rl0));
        int info[2][4]; float wt[2][4];
#pragma unroll
        for (int ai = 0; ai < 2; ++ai)
#pragma unroll
            for (int m = 0; m < 4; ++m) { const int rank = u.rbase + rl0 + 128 * ai + 16 * m, rc = rank < n_e ? rank : 0;
                info[ai][m] = linfo[(size_t)u.e * 65536 + rc]; wt[ai][m] = lw[(size_t)u.e * 65536 + rc] * (1.f / W8_SCALE); }
#pragma unroll
        for (int ai = 0; ai < 2; ++ai)
#pragma unroll
            for (int m = 0; m < 4; ++m) { const int rank = u.rbase + rl0 + 128 * ai + 16 * m;
                if (rank < n_e) {
#pragma unroll
                    for (int bj = 0; bj < 2; ++bj) st16(yslot + (size_t)info[ai][m] * 1024 + c0 + 128 * bj, pack8v(acc[ai][bj][m][0] * wt[ai][m], acc[ai][bj][m][1] * wt[ai][m])); } }
    }
};
__device__ __forceinline__ void s9_fast(Frame& F) {
    const MoeTab tb = moe_table(F);
    const MoeDownSched Sd{(const char*)(F.ws + WS_HID), (const char*)(F.ws + WS_W2_T), tb, F.G, (int)blockIdx.x};
    const EpiDown E{WSP(bf16_t, WS_YSLOT), WSP(int, WS_LINFO), WSP(float, WS_LW), tb.cnt};
    int Kd = DE; asm volatile("" : "+s"(Kd));
    if (F.skip) pg8::gemm_phase<EpiDown, MoeDownSched, true>(F.lds, Kd, Sd, E); else pg8::gemm_phase<EpiDown, MoeDownSched>(F.lds, Kd, Sd, E);
}

__device__ __forceinline__ void s6_router(Frame& F) {
    constexpr int WROW = 1032;
    LAS bf16_t* WT = (LAS bf16_t*)F.lds;
    LAS float* gsL = (LAS float*)(F.lds + 48 * WROW * 2);
    LAS float* shL = gsL + 1024;
    LAS float* biasL = shL + 1024;
    LAS float* lgt = biasL + 64;
    LAS int* cnt = (LAS int*)(F.lds + MISC_OFF + 256);
    LAS int* baseL = cnt + 32; LAS int* runL = cnt + 64; LAS int* eidL = cnt + 128; LAS float* ewL = (LAS float*)(cnt + 384);
    const int b = blockIdx.x >> 5;
    const float* mod = WSP(float, WS_MOD) + (size_t)b * NMOD;
    const float* W36 = WSP(float, WS_W36T);
    for (int i = F.tid; i < 36 * 256; i += NTHREADS) { const int jj = i >> 8, k4 = (i & 255) * 4; const f32x4 w = *(const f32x4*)(W36 + jj * 1024 + k4);
        u32x2 p; p.x = pk2(w.x, w.y); p.y = pk2(w.z, w.w); *(LAS u32x2*)(WT + jj * WROW + k4) = p; }
    for (int i = F.tid; i < 12 * 256; i += NTHREADS) { const int jj = 36 + (i >> 8), k4 = (i & 255) * 4; *(LAS u32x2*)(WT + jj * WROW + k4) = (u32x2){0u, 0u}; }
    if (F.tid < 256) { const int col = 4 * F.tid; const f32x4 g = *(const f32x4*)(F.g2 + col), s_ = *(const f32x4*)(mod + 4096 + col); *(LAS f32x4*)(gsL + col) = g * (s_ + 1.0f); *(LAS f32x4*)(shL + col) = *(const f32x4*)(mod + 3072 + col); }
    if (F.tid < 32) cnt[F.tid] = 0;
    __syncthreads();
    for (int jj = F.wave; jj < 36; jj += NWAVES) { float a = 0.f;
#pragma unroll
        for (int i = 0; i < 16; ++i) a += shL[F.lane + 64 * i] * W36[jj * 1024 + F.lane + 64 * i];
        a = wave_sum(a); if (F.lane == 0) biasL[jj] = a + ((jj < 4) ? F.b_rg[jj] : F.b_re[jj - 4]); }
    __syncthreads();
    const int fr = F.lane & 15, fq = F.lane >> 4, row0 = (blockIdx.x * NWAVES + F.wave) * 16, r = row0 + fr;
    const bf16_t* xr = WSP(bf16_t, WS_X1) + (size_t)r * D + 8 * fq;
    f32x4 D0 = {0.f, 0.f, 0.f, 0.f}, D1 = D0, D2 = D0; float ss = 0.f;
#pragma unroll 1
    for (int kb = 0; kb < 8; ++kb) {
        u32x4 xa[4];
#pragma unroll
        for (int i = 0; i < 4; ++i) xa[i] = *(const u32x4*)(xr + 32 * (4 * kb + i));
#pragma unroll
        for (int i = 0; i < 4; ++i) { const int k0 = 32 * (4 * kb + i) + 8 * fq;
            f32x4 a0, a1; unpack8v(xa[i], a0, a1);
            ss += (a0.x * a0.x + a0.y * a0.y) + (a0.z * a0.z + a0.w * a0.w) + (a1.x * a1.x + a1.y * a1.y) + (a1.z * a1.z + a1.w * a1.w);
            a0 *= *(const LAS f32x4*)(gsL + k0); a1 *= *(const LAS f32x4*)(gsL + k0 + 4);
            const bf16x8 A = __builtin_bit_cast(bf16x8, pack8v(a0, a1));
            const bf16x8 B0 = *(const LAS bf16x8*)(WT + fr * WROW + k0), B1 = *(const LAS bf16x8*)(WT + (16 + fr) * WROW + k0), B2 = *(const LAS bf16x8*)(WT + (32 + fr) * WROW + k0);
            D0 = __builtin_amdgcn_mfma_f32_16x16x32_bf16(A, B0, D0, 0, 0, 0);
            D1 = __builtin_amdgcn_mfma_f32_16x16x32_bf16(A, B1, D1, 0, 0, 0);
            D2 = __builtin_amdgcn_mfma_f32_16x16x32_bf16(A, B2, D2, 0, 0, 0); }
    }
    ss += __shfl_xor(ss, 16); ss += __shfl_xor(ss, 32);
    const float rinv = rsqrtf(ss * (1.f / D) + EPS);
    { int t2 = threadIdx.x; asm volatile("" : "+v"(t2)); F.lane = t2 & 63; }
    const int fr_ = F.lane & 15, fq_ = F.lane >> 4;
    {
        LAS float* lw = lgt + F.wave * 16 * 37;
#pragma unroll
        for (int reg = 0; reg < 4; ++reg) { const float rv = __shfl(rinv, 4 * fq_ + reg); const int tk = 4 * fq_ + reg;
            lw[tk * 37 + fr_] = D0[reg] * rv + biasL[fr_]; lw[tk * 37 + 16 + fr_] = D1[reg] * rv + biasL[16 + fr_];
            if (fr_ < 4) lw[tk * 37 + 32 + fr_] = D2[reg] * rv + biasL[32 + fr_]; }
    }
    {
        const int r_ = row0 + fr_; const bf16_t* xr_ = WSP(bf16_t, WS_X1) + (size_t)r_ * D + 8 * fq_;
        unsigned char* o = WSP(unsigned char, WS_H2) + (size_t)r_ * D + 8 * fq_;
#pragma unroll 1
        for (int kb = 0; kb < 8; ++kb) {
            u32x4 xa[4];
#pragma unroll
            for (int i = 0; i < 4; ++i) xa[i] = *(const u32x4*)(xr_ + 32 * (4 * kb + i));
#pragma unroll
            for (int i = 0; i < 4; ++i) { const int k0 = 32 * (4 * kb + i) + 8 * fq_; f32x4 a0, a1; unpack8v(xa[i], a0, a1);
                const f32x4 h0 = a0 * rinv * *(const LAS f32x4*)(gsL + k0) + *(const LAS f32x4*)(shL + k0), h1 = a1 * rinv * *(const LAS f32x4*)(gsL + k0 + 4) + *(const LAS f32x4*)(shL + k0 + 4);
                *(u32x2*)(o + 32 * (4 * kb + i)) = pack8_fp8(h0, h1); }
        }
    }
    if (F.lane < 16) {
        const int t = row0 + F.lane; const LAS float* lw = lgt + (F.wave * 16 + F.lane) * 37;
        float lg[36];
#pragma unroll
        for (int jj = 0; jj < 36; ++jj) lg[jj] = lw[jj];
        int gi = 0; float gm = lg[0];
#pragma unroll
        for (int i = 1; i < 4; ++i) if (lg[i] > gm) { gm = lg[i]; gi = i; }
        float den = 0.f;
#pragma unroll
        for (int i = 0; i < 4; ++i) den += __expf(lg[i] - gm);
        const float gw_ = 1.f / den;
        float v1 = -INFINITY, v2 = -INFINITY; int e1 = 0, e2 = 0;
#pragma unroll
        for (int i = 0; i < 8; ++i) { const float el = (gi == 0) ? lg[4 + i] : (gi == 1) ? lg[12 + i] : (gi == 2) ? lg[20 + i] : lg[28 + i];
            const bool c1 = el > v1, c2 = el > v2;
            v2 = c1 ? v1 : (c2 ? el : v2); e2 = c1 ? e1 : (c2 ? i : e2); v1 = c1 ? el : v1; e1 = c1 ? i : e1; }
        const float p1 = 1.f / (1.f + __expf(v2 - v1)), p2 = 1.f - p1;
        const int id1 = gi * 8 + e1, id2 = gi * 8 + e2;
        const int la = 2 * (F.wave * 16 + F.lane);
        eidL[la] = id1; eidL[la + 1] = id2; ewL[la] = p1 * gw_; ewL[la + 1] = p2 * gw_;
        lds_add(&cnt[id1], 1); lds_add(&cnt[id2], 1);
    }
    __syncthreads();
    if (F.tid < 32) { baseL[F.tid] = (int)__hip_atomic_fetch_add(WSP(unsigned, WS_CTL) + CW_GCNT + 64 * F.tid, (unsigned)cnt[F.tid], __ATOMIC_RELAXED, __HIP_MEMORY_SCOPE_AGENT); runL[F.tid] = 0; }
    __syncthreads();
    if (F.tid < 256) { const int e = eidL[F.tid]; const int pos = baseL[e] + lds_add(&runL[e], 1);
        WSP(int, WS_LINFO)[(size_t)e * 65536 + pos] = 2 * (blockIdx.x * 128) + F.tid; WSP(float, WS_LW)[(size_t)e * 65536 + pos] = ewL[F.tid]; }
    __syncthreads();
}

__device__ __forceinline__ void s7_lists(Frame& F) {
    LAS int* sm = (LAS int*)F.lds;
    const int* bc = WSP(int, WS_BCNT);
    if (F.tid < 32) { int tot = 0, base = 0; for (int bb = 0; bb < 256; ++bb) { const int c = bc[bb * 32 + F.tid]; if (bb < (int)blockIdx.x) base += c; tot += c; }
        sm[F.tid] = tot; sm[32 + F.tid] = base; sm[96 + F.tid] = 0; }
    __syncthreads();
    if (F.tid == 0) { int ps = 0; for (int e = 0; e < 32; ++e) { sm[64 + e] = ps; ps += (sm[e] + 255) & ~255; }
        if (blockIdx.x == 0) { int* te = WSP(int, WS_TILEE); int pm = 0; for (int e = 0; e < 32; ++e) { const int n = (sm[e] + 255) >> 8; for (int i = 0; i < n; ++i) te[1 + pm++] = e; } te[0] = pm; } }
    __syncthreads();
    int* atok = WSP(int, WS_ATOK); int* ainfo = WSP(int, WS_AINFO); float* aw = WSP(float, WS_AW);
    if (F.tid < 256) { const int a = blockIdx.x * 256 + F.tid;
        const int e = WSP(int, WS_EID)[a]; const int rank = lds_add(&sm[96 + e], 1); const int pos = sm[64 + e] + sm[32 + e] + rank;
        atok[pos] = a >> 1; ainfo[pos] = a; aw[pos] = WSP(float, WS_EW)[a]; }
    if (blockIdx.x < 32) { const int e = blockIdx.x; const int lo = sm[64 + e] + sm[e], hi = sm[64 + e] + ((sm[e] + 255) & ~255);
        for (int p = lo + F.tid; p < hi; p += NTHREADS) { atok[p] = 0; ainfo[p] = -1; aw[p] = 0.f; } }
}

struct RowsGather { const bf16_t* base; const int* idx; __device__ __forceinline__ const bf16_t* operator()(int r) const { return base + (size_t)idx[r] * 1024; } };
__device__ __forceinline__ void s8_simple(Frame& F) {
    LAS float* tile = (LAS float*)F.lds; LAS float* tile2 = tile + 64 * 65;
    const int* te = WSP(int, WS_TILEE); const int nmt = te[0];
    const int row = F.tid >> 3, seg = F.tid & 7;
    for (int it = blockIdx.x; it < nmt * 4 * 8; it += F.G) {
        const int rt = it >> 3, ct = it & 7, e = te[1 + (rt >> 2)], pos0 = 64 * rt, hc = 64 * ct;
        const RowsGather ar{WSP(bf16_t, WS_H2), WSP(int, WS_ATOK) + pos0};
        const bf16_t* wb = WSP(bf16_t, WS_W13_T) + ((size_t)e * 1024 + 256 * (hc >> 7) + (hc & 127)) * 1024;
        const RowsLinear b1{wb, 1024}, b3{wb + (size_t)128 * 1024, 1024};
        sgemm_tile(tile, 1024, ar, b1, F.wave, F.lane); sgemm_tile(tile2, 1024, ar, b3, F.wave, F.lane); __syncthreads();
        const float wt = WSP(float, WS_AW)[pos0 + row]; float v[8];
#pragma unroll
        for (int e8 = 0; e8 < 8; ++e8) { const float a = tile[row * 65 + 8 * seg + e8], c = tile2[row * 65 + 8 * seg + e8]; v[e8] = (a / (1.f + __expf(-a))) * c * wt; }
        *(u32x4*)(WSP(bf16_t, WS_HID) + (size_t)(pos0 + row) * 512 + hc + 8 * seg) = pack8(v);
        __syncthreads();
    }
}
__device__ __forceinline__ void s9_simple(Frame& F) {
    LAS float* tile = (LAS float*)F.lds;
    const int* te = WSP(int, WS_TILEE); const int nmt = te[0];
    const int row = F.tid >> 3, seg = F.tid & 7;
    for (int it = blockIdx.x; it < nmt * 4 * 16; it += F.G) {
        const int rt = it >> 4, ct = it & 15, e = te[1 + (rt >> 2)], pos0 = 64 * rt;
        const RowsLinear ar{WSP(bf16_t, WS_HID) + (size_t)pos0 * 512, 512};
        const RowsLinear br{WSP(bf16_t, WS_W2_T) + ((size_t)e * 1024 + 64 * ct) * 512, 512};
        sgemm_tile(tile, 512, ar, br, F.wave, F.lane); __syncthreads();
        const int info = WSP(int, WS_AINFO)[pos0 + row];
        if (info >= 0) { float v[8];
#pragma unroll
            for (int e8 = 0; e8 < 8; ++e8) v[e8] = tile[row * 65 + 8 * seg + e8];
            *(u32x4*)(WSP(bf16_t, WS_YSLOT) + (size_t)info * 1024 + 64 * ct + 8 * seg) = pack8(v); }
        __syncthreads();
    }
}
__device__ __forceinline__ void s10_combine(Frame& F) {
    const bf16_t* Y = WSP(bf16_t, WS_YSLOT); const bf16_t* X1 = WSP(bf16_t, WS_X1);
    const int stride = F.G * NTHREADS;
    for (int i0 = blockIdx.x * NTHREADS + F.tid; i0 < T * 128; i0 += 2 * stride) {
        u32x4 ya[2], yb[2], xx[2]; f32x4 g0[2], g1[2];
#pragma unroll
        for (int q = 0; q < 2; ++q) { const int i = i0 + q * stride; const int t = i >> 7, c0 = (i & 127) * 8, b = t / S;
            ya[q] = __builtin_nontemporal_load((const u32x4*)(Y + (size_t)(2 * t) * 1024 + c0)); yb[q] = __builtin_nontemporal_load((const u32x4*)(Y + (size_t)(2 * t + 1) * 1024 + c0)); xx[q] = __builtin_nontemporal_load((const u32x4*)(X1 + (size_t)t * D + c0));
            const float* ga2 = WSP(float, WS_MOD) + (size_t)b * NMOD + 5120 + c0; g0[q] = *(const f32x4*)ga2; g1[q] = *(const f32x4*)(ga2 + 4); }
#pragma unroll
        for (int q = 0; q < 2; ++q) { const int i = i0 + q * stride; const int t = i >> 7, c0 = (i & 127) * 8;
            f32x4 y0a, y0b, y1a, y1b, xa, xb; unpack8v(ya[q], y0a, y0b); unpack8v(yb[q], y1a, y1b); unpack8v(xx[q], xa, xb);
            float* o = F.out + (size_t)t * D + c0;
            __builtin_nontemporal_store(xa + g0[q] * (y0a + y1a), (f32x4*)o); __builtin_nontemporal_store(xb + g1[q] * (y0b + y1b), (f32x4*)(o + 4)); }
    }
}

constexpr int N_PHASES = 11;
struct Args { const float* in[21]; float* out; unsigned char* ws; int ph_lo, ph_hi; };
__global__ void __launch_bounds__(NTHREADS, 2) mega_fwd(Args args) {
    extern __shared__ __attribute__((aligned(16))) unsigned char lds_raw[];
    Frame F;
    F.lds = (LAS unsigned char*)lds_raw;
    F.tid = threadIdx.x; F.lane = F.tid & 63; F.wave = __builtin_amdgcn_readfirstlane(F.tid >> 6); F.G = gridDim.x; F.skip = 0;
    F.x = args.in[0]; F.c = args.in[1]; F.w_ada = args.in[2]; F.b_ada = args.in[3]; F.g1 = args.in[4]; F.g2 = args.in[5]; F.w_in = args.in[6]; F.g_q = args.in[7]; F.g_k = args.in[8];
    F.conv_w = args.in[9]; F.conv_b = args.in[10]; F.w_pa = args.in[11]; F.w_pb = args.in[12]; F.w_o = args.in[13]; F.w_rg = args.in[14]; F.b_rg = args.in[15]; F.w_re = args.in[16]; F.b_re = args.in[17];
    F.w1 = args.in[18]; F.w3 = args.in[19]; F.w2 = args.in[20]; F.out = args.out; F.ws = args.ws;
    volatile LAS unsigned* MISC = (volatile LAS unsigned*)(F.lds + MISC_OFF);
    if (F.tid < 64) MISC[F.tid] = 0u;
    __syncthreads();
    XcdBarrier bar = xcd_barrier_post((unsigned*)(F.ws + WS_CTL) + CW_BAR, MISC + 8);
    const int lo = args.ph_lo, hi = args.ph_hi;
    unsigned long long pst0 = 0, pst1 = 0;
#define PHASE(k, body) if (lo <= (k) && (k) < hi) { if (PROBE_PHASE == (k)) pst0 = __builtin_amdgcn_s_memrealtime(); for (int rep_ = 0; rep_ < 1 + ((REPEAT_MASK >> (k)) & 1); ++rep_) { { int t_ = threadIdx.x; asm volatile("" : "+v"(t_)); F.tid = t_; F.lane = t_ & 63; } body; __syncthreads(); } if ((NOEPI_MASK >> (k)) & 1) { int s_ = 1; asm volatile("" : "+s"(s_)); F.skip = s_; { int t_ = threadIdx.x; asm volatile("" : "+v"(t_)); F.tid = t_; F.lane = t_ & 63; } body; __syncthreads(); F.skip = 0; } if ((k) + 1 < hi) xcd_barrier(bar); if (PROBE_PHASE == (k)) pst1 = __builtin_amdgcn_s_memrealtime(); }
    PHASE(0, s0_prologue(F); wait_mod(F); s1_norm1(F))
    PHASE(2, s2_fast(F))
    PHASE(3, s3_fast(F, (char*)lds_raw))
    PHASE(4, s4_fast(F))
    PHASE(5, s5_fast(F))
    PHASE(6, s6_router(F))
    PHASE(8, s8_fast(F))
    PHASE(9, s9_fast(F))
    PHASE(10, s10_combine(F))
#undef PHASE
    if (PROBE_PHASE >= 0 && blockIdx.x == 0) { const unsigned long long t0 = __builtin_amdgcn_s_memrealtime(), dt = pst1 - pst0; while (__builtin_amdgcn_s_memrealtime() - t0 < dt) __builtin_amdgcn_s_sleep(8); }
}

extern "C" void kernel_launch(void* const* d_in, const int* in_sizes, int n_in, void* d_out, int out_size, void* d_ws, size_t ws_size, hipStream_t stream) {
    static int grid = 0;
    if (grid == 0) {
        if (n_in != 21 || in_sizes[0] != T * D || out_size != T * D || ws_size < WS_END) { fprintf(stderr, "kernel_launch: unexpected shapes (n_in %d, in0 %d, out %d, ws %zu); nothing launched\n", n_in, n_in > 0 ? in_sizes[0] : -1, out_size, ws_size); grid = -1; return; }
        int dev = 0, cus = 0, per_cu = 0;
        if (hipGetDevice(&dev) != hipSuccess || hipDeviceGetAttribute(&cus, hipDeviceAttributeMultiprocessorCount, dev) != hipSuccess) { grid = -1; return; }
        if (hipFuncSetAttribute((const void*)mega_fwd, hipFuncAttributeMaxDynamicSharedMemorySize, LDS_BYTES) != hipSuccess) { fprintf(stderr, "kernel_launch: hipFuncSetAttribute failed\n"); grid = -1; return; }
        if (hipOccupancyMaxActiveBlocksPerMultiprocessor(&per_cu, (const void*)mega_fwd, NTHREADS, LDS_BYTES) != hipSuccess || per_cu < 1) { fprintf(stderr, "kernel_launch: occupancy query says %d blocks per CU\n", per_cu); per_cu = 1; }
        (void)hipGetLastError();
        if (cus < 256) { fprintf(stderr, "kernel_launch: built for a 256-CU device, found %d CUs; nothing launched\n", cus); grid = -1; return; }
        grid = 256;
    }
    if (grid < 0) return;
    (void)hipMemsetAsync((char*)d_ws + WS_CTL, 0, CTL_ZERO_BYTES, stream);
    Args a{};
    for (int i = 0; i < 21; ++i) a.in[i] = (const float*)d_in[i];
    a.out = (float*)d_out; a.ws = (unsigned char*)d_ws; a.ph_lo = 0; a.ph_hi = N_PHASES;
    hipLaunchKernelGGL(mega_fwd, dim3(grid), dim3(NTHREADS), LDS_BYTES, stream, a);
}
```

```cpp
#include <hip/hip_runtime.h>
#include <hip/hip_bf16.h>
#include <cstdio>
#include <cstdint>

#ifndef REPEAT_MASK
#define REPEAT_MASK 0
#define NOEPI_MASK 0
#endif
#ifndef PROBE_PHASE
#define PROBE_PHASE -1
#endif
#define GAS __attribute__((address_space(1)))
#define LAS __attribute__((address_space(3)))
typedef unsigned short bf16_t;
typedef short bf16x8 __attribute__((ext_vector_type(8)));
typedef float f32x4 __attribute__((ext_vector_type(4)));
typedef unsigned u32x4 __attribute__((ext_vector_type(4)));
typedef unsigned u32x2 __attribute__((ext_vector_type(2)));

constexpr int T = 32768, D = 1024, NB = 8, S = 4096, NH = 8, DH = 64, NIN = 5120, NE = 32, DE = 512, NMOD = 6144;
constexpr int NTHREADS = 512, NWAVES = 8;
constexpr float EPS = 1e-6f;
constexpr float C2 = 0.125f * 1.4426950408889634f;
constexpr int MAX_MT = 288;
constexpr int NPAD = MAX_MT * 256;

constexpr size_t MiB = 1u << 20, KiB = 1024;
constexpr size_t WS_CTL = 0, CTL_ZERO_BYTES = 64 * KiB;
constexpr size_t WS_MOD = 1 * MiB;
constexpr size_t WS_ROPE = 1 * MiB + 256 * KiB;
constexpr size_t WS_KMEAN = 1 * MiB + 512 * KiB;
constexpr size_t WS_EID = 2 * MiB;
constexpr size_t WS_EW = 2 * MiB + 256 * KiB;
constexpr size_t WS_BCNT = 2 * MiB + 512 * KiB;
constexpr size_t WS_TILEE = 2 * MiB + 768 * KiB;
constexpr size_t WS_ATOK = 3 * MiB;
constexpr size_t WS_AINFO = 3 * MiB + 512 * KiB;
constexpr size_t WS_AW = 4 * MiB;
constexpr size_t WS_W36T = 5 * MiB;
constexpr size_t WS_WIN_T = 8 * MiB;
constexpr size_t WS_WIN8 = 14 * MiB;
constexpr size_t WS_H8 = 56 * MiB;
constexpr size_t WS_WP_T = 18 * MiB;
constexpr size_t WS_WO_T = 20 * MiB;
constexpr size_t WS_W13_T = 24 * MiB;
constexpr size_t WS_W2_T = 88 * MiB;
constexpr size_t WS_H = 120 * MiB;
constexpr size_t WS_YAB = 184 * MiB;
constexpr size_t WS_K = 248 * MiB;
constexpr size_t WS_V = 280 * MiB;
constexpr size_t WS_U = 312 * MiB;
constexpr size_t WS_BG = 344 * MiB;
constexpr size_t WS_GATES = 376 * MiB;
constexpr size_t WS_X1 = 184 * MiB;
constexpr size_t WS_H2 = 120 * MiB;
constexpr size_t WS_HID = 248 * MiB;
constexpr size_t WS_YSLOT = 320 * MiB;
constexpr size_t WS_LINFO = 448 * MiB;
constexpr size_t WS_LW = 456 * MiB;
constexpr size_t WS_END = 504 * MiB;
constexpr int CW_BAR = 4096, CW_MODCNT = 8192, CW_GCNT = 12288;

constexpr int LDS_BYTES = 159744;
constexpr int MISC_OFF = 147456;

__device__ __forceinline__ unsigned f2bf(float f) { unsigned u = __builtin_bit_cast(unsigned, f); return (u + 0x7fffu + ((u >> 16) & 1u)) >> 16; }
__device__ __forceinline__ float bf2f(unsigned h) { return __builtin_bit_cast(float, h << 16); }
typedef float f32x2_h __attribute__((ext_vector_type(2)));
typedef __bf16 bf16x2_h __attribute__((ext_vector_type(2)));
__device__ __forceinline__ unsigned pk2(float lo, float hi) { const f32x2_h v = {lo, hi}; return __builtin_bit_cast(unsigned, __builtin_convertvector(v, bf16x2_h)); }
__device__ __forceinline__ void unpack8(const u32x4 w, float (&v)[8]) {
    v[0] = bf2f(w.x & 0xffffu); v[1] = bf2f(w.x >> 16); v[2] = bf2f(w.y & 0xffffu); v[3] = bf2f(w.y >> 16);
    v[4] = bf2f(w.z & 0xffffu); v[5] = bf2f(w.z >> 16); v[6] = bf2f(w.w & 0xffffu); v[7] = bf2f(w.w >> 16);
}
__device__ __forceinline__ u32x4 pack8(const float (&v)[8]) { u32x4 w; w.x = pk2(v[0], v[1]); w.y = pk2(v[2], v[3]); w.z = pk2(v[4], v[5]); w.w = pk2(v[6], v[7]); return w; }
__device__ __forceinline__ u32x4 pack8v(const f32x4 a, const f32x4 b) { u32x4 w; w.x = pk2(a.x, a.y); w.y = pk2(a.z, a.w); w.z = pk2(b.x, b.y); w.w = pk2(b.z, b.w); return w; }
__device__ __forceinline__ void unpack8v(const u32x4 w, f32x4& a, f32x4& b) {
    a.x = bf2f(w.x & 0xffffu); a.y = bf2f(w.x >> 16); a.z = bf2f(w.y & 0xffffu); a.w = bf2f(w.y >> 16);
    b.x = bf2f(w.z & 0xffffu); b.y = bf2f(w.z >> 16); b.z = bf2f(w.w & 0xffffu); b.w = bf2f(w.w >> 16); }
#ifndef WT_STORES
#define WT_STORES 0
#define NT_STORES 1
#endif
__device__ __forceinline__ void st16(void* p, const u32x4 v) {
#if WT_STORES
    asm volatile("global_store_dwordx4 %0, %1, off sc1\n\ts_nop 1" :: "v"(p), "v"(v) : "memory");
#elif NT_STORES
    __builtin_nontemporal_store(v, (u32x4*)p);
#else
    *(u32x4*)p = v;
#endif
}
typedef int i32x8 __attribute__((ext_vector_type(8)));
__device__ __forceinline__ u32x2 pack8_fp8(const f32x4 a, const f32x4 b) {
    int lo = 0, hi = 0;
    lo = __builtin_amdgcn_cvt_pk_fp8_f32(a.x, a.y, lo, false); lo = __builtin_amdgcn_cvt_pk_fp8_f32(a.z, a.w, lo, true);
    hi = __builtin_amdgcn_cvt_pk_fp8_f32(b.x, b.y, hi, false); hi = __builtin_amdgcn_cvt_pk_fp8_f32(b.z, b.w, hi, true);
    return (u32x2){(unsigned)lo, (unsigned)hi};
}
constexpr float W8_SCALE = 64.f;
#define LDS_WAIT() asm volatile("s_waitcnt lgkmcnt(0)" ::: "memory")
__device__ __forceinline__ int lds_add(LAS int* p, int v) { return __hip_atomic_fetch_add(p, v, __ATOMIC_RELAXED, __HIP_MEMORY_SCOPE_WORKGROUP); }

#define XB_TMO      128
#define XB_XCNT(j)  (256  + 64 * (j))
#define XB_XSUB(j)  (1280 + 64 * (j))
#define XB_XGEN(j)  (2304 + 64 * (j))
#define XB_TOP      3328
#define XB_TOPGEN   3392
#define XCD_BAR_WORDS 3456
#define XB_SPIN_CAP (1u << 22)
__device__ __forceinline__ unsigned xb_ld(unsigned* p)              { return __hip_atomic_load(p, __ATOMIC_RELAXED, __HIP_MEMORY_SCOPE_AGENT); }
__device__ __forceinline__ unsigned xb_add(unsigned* p, unsigned v) { return __hip_atomic_fetch_add(p, v, __ATOMIC_RELAXED, __HIP_MEMORY_SCOPE_AGENT); }
__device__ __forceinline__ unsigned xb_xcc_id() { return (unsigned)__builtin_amdgcn_s_getreg((3 << 11) | 20) & 0xFu; }
#define XB_SPIN(cond, bar) do { unsigned _sp = 0; while (cond) { __builtin_amdgcn_s_sleep(1); \
    if ((++_sp & 255u) == 0u) { if (xb_ld(&(bar)[XB_TMO])) break; if (_sp > XB_SPIN_CAP) { atomicAdd(&(bar)[XB_TMO], 1u); break; } } } } while (0)
struct XcdBarrier { unsigned* bar; unsigned x; volatile LAS unsigned* st; };
__device__ __forceinline__ XcdBarrier xcd_barrier_post(unsigned* bar, volatile LAS unsigned* st) {
    XcdBarrier b; b.bar = bar; b.x = xb_xcc_id(); b.st = st;
    if (threadIdx.x == 0) (void)xb_add(&bar[XB_XCNT(b.x)], 1u);
    return b;
}
__device__ __forceinline__ void xcd_barrier_complete(unsigned* bar, unsigned x, unsigned& nloc, unsigned& nx) {
    const unsigned G = gridDim.x * gridDim.y * gridDim.z;
    unsigned sum, cnt, mine, sp = 0u;
    for (;;) {
        sum = 0u; cnt = 0u; mine = 0u;
#pragma unroll
        for (unsigned j = 0; j < 16; ++j) { const unsigned c = xb_ld(&bar[XB_XCNT(j)]); sum += c; cnt += (c > 0u) ? 1u : 0u; mine = (j == x) ? c : mine; }
        if (sum == G) break;
        __builtin_amdgcn_s_sleep(1);
        if ((++sp & 255u) == 0u) { if (xb_ld(&bar[XB_TMO])) break; if (sp > XB_SPIN_CAP) { atomicAdd(&bar[XB_TMO], 1u); break; } }
    }
    nloc = mine > 0u ? mine : 1u; nx = cnt > 0u ? cnt : 1u;
}
__device__ __forceinline__ void xcd_barrier(const XcdBarrier& b) {
    asm volatile("s_waitcnt vmcnt(0)" ::: "memory");
    __syncthreads();
    if (threadIdx.x == 0) {
        unsigned* bar = b.bar;
        __builtin_amdgcn_s_waitcnt(0);
        unsigned nloc = b.st[0], nx = b.st[1];
        if (nloc == 0u) { xcd_barrier_complete(bar, b.x, nloc, nx); b.st[0] = nloc; b.st[1] = nx; }
        const unsigned old = xb_add(&bar[XB_XSUB(b.x)], 1u);
        const unsigned gen = old / nloc;
        if (old + 1u == (gen + 1u) * nloc) {
            __builtin_amdgcn_fence(__ATOMIC_RELEASE, "agent");
            asm volatile("s_waitcnt vmcnt(0)" ::: "memory");
            const unsigned og = xb_add(&bar[XB_TOP], 1u);
            const unsigned tg = og / nx;
            if (og + 1u == (tg + 1u) * nx) xb_add(&bar[XB_TOPGEN], 1u);
            else XB_SPIN(xb_ld(&bar[XB_TOPGEN]) == tg, bar);
            __builtin_amdgcn_fence(__ATOMIC_ACQUIRE, "agent");
            xb_add(&bar[XB_XGEN(b.x)], 1u);
            asm volatile("s_waitcnt vmcnt(0)" ::: "memory");
        } else {
            XB_SPIN(xb_ld(&bar[XB_XGEN(b.x)]) == gen, bar);
            __builtin_amdgcn_fence(__ATOMIC_ACQUIRE, "agent");
            asm volatile("s_waitcnt vmcnt(0)" ::: "memory");
        }
    }
    __syncthreads();
}

struct Frame {
    LAS unsigned char* lds;
    int tid, lane, wave, G, skip;
    const float *x, *c, *w_ada, *b_ada, *g1, *g2, *w_in, *g_q, *g_k, *conv_w, *conv_b, *w_pa, *w_pb, *w_o, *w_rg, *b_rg, *w_re, *b_re, *w1, *w3, *w2;
    float* out; unsigned char* ws;
};
#define WSP(type, off) ((type*)(F.ws + (off)))

struct XItem { const float* src; unsigned char* dst; int N, pitch, fp8, swz; };
__device__ __forceinline__ void xitem_load(const XItem& it, f32x4 (&v)[8], int lane) {
    const int r8 = lane >> 3, c4 = lane & 7;
#pragma unroll
    for (int i = 0; i < 8; ++i) v[i] = __builtin_nontemporal_load((const f32x4*)(it.src + (size_t)(8 * i + r8) * it.N + 4 * c4));
}
__device__ __forceinline__ void xitem_store(const XItem& it, const f32x4 (&v)[8], LAS float* scr, int lane) {
    const int r8 = lane >> 3, c4 = lane & 7; const float scale = it.fp8 ? W8_SCALE : 1.f;
#pragma unroll
    for (int i = 0; i < 8; ++i) { LAS float* p = scr + (8 * i + r8) * 33 + 4 * c4; p[0] = v[i].x * scale; p[1] = v[i].y * scale; p[2] = v[i].z * scale; p[3] = v[i].w * scale; }
    LDS_WAIT(); asm volatile("" ::: "memory");
    if (it.fp8) {
        const int n = lane >> 1, kh = lane & 1; const LAS float* sp = scr + (32 * kh) * 33 + n;
#pragma unroll
        for (int p = 0; p < 2; ++p) { u32x4 o;
#pragma unroll
            for (int w = 0; w < 4; ++w) { const LAS float* q = sp + (16 * p + 4 * w) * 33; int x = 0;
                x = __builtin_amdgcn_cvt_pk_fp8_f32(q[0], q[33], x, false); x = __builtin_amdgcn_cvt_pk_fp8_f32(q[66], q[99], x, true); o[w] = (unsigned)x; }
            *(u32x4*)(it.dst + (size_t)n * it.pitch + 32 * kh + 16 * p) = o; }
    } else {
        const int c = lane & 7;
#pragma unroll
        for (int j = 0; j < 4; ++j) { const int n = (lane >> 3) + 8 * j; const LAS float* q = scr + (8 * c) * 33 + n;
            u32x4 o; o.x = pk2(q[0 * 33], q[1 * 33]); o.y = pk2(q[2 * 33], q[3 * 33]); o.z = pk2(q[4 * 33], q[5 * 33]); o.w = pk2(q[6 * 33], q[7 * 33]);
            const int nd = (it.swz && ((n >> 2) == 1 || (n >> 2) == 2)) ? (n ^ 12) : n;
            *(u32x4*)(it.dst + ((size_t)nd * it.pitch + 8 * c) * 2) = o; }
    }
    LDS_WAIT(); asm volatile("" ::: "memory");
}
__device__ __forceinline__ int win_dest_row(int sc) {
    if (sc < 32) { const int isk = sc >> 4, s2 = sc & 15, hh = s2 >> 1, bj = s2 & 1; return 512 * isk + 256 * (hh >> 2) + 128 * bj + 32 * (hh & 3); }
    if (sc < 48) return 0;
    if (sc < 64) { const int cx = 32 * (sc - 48); return 256 * (4 + (cx >> 7)) + (cx & 127); }
    if (sc < 80) return 2048 + 32 * (sc - 64);
    if (sc < 96) { const int cx = 32 * (sc - 80); return 256 * (4 + (cx >> 7)) + 128 + (cx & 127); }
    return 3072 + 32 * (sc - 96);
}
constexpr int X_NONEXP = 16 * 160 + 2 * (8 * 32) + 16 * 32, X_W2 = X_NONEXP + NE * 512, X_END = X_W2 + NE * 256;
__device__ __forceinline__ void convert_items(Frame& F, const int item_lo, const int item_hi, const int gw, const int NGW) {
    LAS float* scr = (LAS float*)(F.lds + F.wave * 16384);
    constexpr int I_IN = 16 * 160, I_PA = 8 * 32, I_O = 16 * 32, I_E1 = 16 * 16, I_E2 = 8 * 32;
    constexpr int NITEMS = I_IN + 2 * I_PA + I_O + NE * (2 * I_E1 + I_E2);
    auto decode = [&](int r) -> XItem {
        XItem x; x.swz = 0;
        if (r < I_IN) { const int kb = r / 160, sc = r % 160; x.src = F.w_in + (size_t)(64 * kb) * NIN + 32 * sc; x.N = NIN; x.pitch = 1024; x.swz = (sc < 32 && !(sc & 1)) ? 1 : 0;
            if (sc < 96 && !(sc >= 32 && sc < 48)) { x.fp8 = 0; x.dst = (unsigned char*)(WSP(bf16_t, WS_WIN_T) + (size_t)win_dest_row(sc) * 1024 + 64 * kb); }
            else { x.fp8 = 1; const int g = 32 * (sc - 96), cx = g & 1023;
                x.dst = WSP(unsigned char, WS_WIN8) + (size_t)(sc >= 96 ? 256 * (cx >> 7) + (g >= 1024 ? 128 : 0) + (cx & 127) : 2048 + 32 * (sc - 32)) * 1024 + 64 * kb; }
            return x; } r -= I_IN;
        if (r < I_PA) { const int kb = r / 32, sc = r % 32; x.src = F.w_pa + (size_t)(64 * kb) * 1024 + 32 * sc; x.N = 1024; x.pitch = 1024; x.fp8 = 0; x.dst = (unsigned char*)(WSP(bf16_t, WS_WP_T) + (size_t)(32 * sc) * 1024 + 64 * kb); return x; } r -= I_PA;
        if (r < I_PA) { const int kb = r / 32, sc = r % 32; x.src = F.w_pb + (size_t)(64 * kb) * 1024 + 32 * sc; x.N = 1024; x.pitch = 1024; x.fp8 = 0; x.dst = (unsigned char*)(WSP(bf16_t, WS_WP_T) + (size_t)(32 * sc) * 1024 + 512 + 64 * kb); return x; } r -= I_PA;
        if (r < I_O) { const int kb = r / 32, sc = r % 32; x.src = F.w_o + (size_t)(64 * kb) * 1024 + 32 * sc; x.N = 1024; x.pitch = 1024; x.fp8 = 1; x.dst = WSP(unsigned char, WS_WO_T) + (size_t)(32 * sc) * 1024 + 64 * kb; return x; } r -= I_O;
        x.fp8 = 1;
        if (r < NE * 2 * I_E1) { const int e = r / (2 * I_E1); r -= e * (2 * I_E1); const int is3 = r >= I_E1; if (is3) r -= I_E1; const int kb = r / 16, sc = r % 16;
            x.src = (is3 ? F.w3 : F.w1) + (size_t)e * D * DE + (size_t)(64 * kb) * DE + 32 * sc; x.N = DE; x.pitch = 1024;
            x.dst = WSP(unsigned char, WS_W13_T) + ((size_t)e * 1024 + 256 * (sc >> 2) + 128 * is3 + 32 * (sc & 3)) * 1024 + 64 * kb; return x; }
        r -= NE * 2 * I_E1;
        { const int e = r / I_E2; r -= e * I_E2; const int kb = r / 32, sc = r % 32;
            x.src = F.w2 + (size_t)e * DE * D + (size_t)(64 * kb) * D + 32 * sc; x.N = D; x.pitch = 512; x.dst = WSP(unsigned char, WS_W2_T) + ((size_t)e * 1024 + 32 * sc) * 512 + 64 * kb; }
        return x;
    };
    const int ihi = (item_hi < NITEMS) ? item_hi : NITEMS;
    if (item_lo + gw < ihi) {
        XItem cur = decode(item_lo + gw); f32x4 va[8], vb[8]; xitem_load(cur, va, F.lane);
        for (int it = item_lo + gw; it < ihi; it += 2 * NGW) {
            const int n1 = it + NGW, n2 = it + 2 * NGW; XItem nx1 = cur, nx2 = cur;
            if (n1 < ihi) { nx1 = decode(n1); xitem_load(nx1, vb, F.lane); }
            xitem_store(cur, va, scr, F.lane);
            if (n1 < ihi) { if (n2 < ihi) { nx2 = decode(n2); xitem_load(nx2, va, F.lane); }
                xitem_store(nx1, vb, scr, F.lane); cur = nx2; }
        }
    }
}

__device__ __forceinline__ void s0_prologue(Frame& F) {
    if (F.tid < 256) WSP(float, WS_KMEAN)[blockIdx.x * 256 + F.tid] = 0.f;
    if (F.tid < 144) { const int gt = blockIdx.x * 144 + F.tid; const int jj = gt >> 10, k = gt & 1023; WSP(float, WS_W36T)[gt] = (jj < 4) ? F.w_rg[k * 4 + jj] : F.w_re[k * 32 + (jj - 4)]; }
    if (F.tid < 128) { const int gt = blockIdx.x * 128 + F.tid; const int pos = gt >> 3, i = gt & 7; const float inv = powf(500000.0f, -(float)(2 * i) / 16.0f); const float ang = (float)pos * inv;
        WSP(float2, WS_ROPE)[gt] = make_float2(cosf(ang), sinf(ang)); }
    if (blockIdx.x < 192) {
        LAS float* sc = (LAS float*)F.lds;
        for (int i = F.tid; i < NB * D; i += NTHREADS) { const float v = F.c[i]; sc[i] = v / (1.f + expf(-v)); }
        __syncthreads();
        const int j0 = blockIdx.x * 32, col = j0 + (F.lane & 31), kpar = F.lane >> 5;
        float acc[8];
#pragma unroll
        for (int b = 0; b < 8; ++b) acc[b] = 0.f;
#pragma unroll
        for (int i0 = 0; i0 < 64; i0 += 32) { float wv[32];
#pragma unroll
            for (int i = 0; i < 32; ++i) wv[i] = F.w_ada[(size_t)(F.wave * 128 + 2 * (i0 + i) + kpar) * NMOD + col];
#pragma unroll
            for (int i = 0; i < 32; ++i) { const int k = F.wave * 128 + 2 * (i0 + i) + kpar;
#pragma unroll
                for (int b = 0; b < 8; ++b) acc[b] += sc[b * D + k] * wv[i]; } }
#pragma unroll
        for (int b = 0; b < 8; ++b) acc[b] += __shfl_xor(acc[b], 32);
        LAS float* red = (LAS float*)(F.lds + 32768);
        if (F.lane < 32) {
#pragma unroll
            for (int b = 0; b < 8; ++b) red[(F.wave * 8 + b) * 32 + F.lane] = acc[b]; }
        __syncthreads();
        if (F.tid < 256) { const int b = F.tid >> 5, cc = F.tid & 31; float s = F.b_ada[j0 + cc];
#pragma unroll
            for (int w = 0; w < 8; ++w) s += red[(w * 8 + b) * 32 + cc];
            WSP(float, WS_MOD)[b * NMOD + j0 + cc] = s; }
        asm volatile("s_waitcnt vmcnt(0)" ::: "memory");
        __syncthreads();
        if (F.tid == 0) { __builtin_amdgcn_fence(__ATOMIC_RELEASE, "agent"); asm volatile("s_waitcnt vmcnt(0)" ::: "memory");
            __hip_atomic_fetch_add(WSP(unsigned, WS_CTL) + CW_MODCNT, 1u, __ATOMIC_RELAXED, __HIP_MEMORY_SCOPE_AGENT); }
    }
    convert_items(F, 0, X_NONEXP, F.G * NWAVES - 1 - (blockIdx.x * NWAVES + F.wave), F.G * NWAVES);
}

__device__ __forceinline__ void wait_mod(Frame& F) {
    if (F.tid == 0) { unsigned* c = WSP(unsigned, WS_CTL) + CW_MODCNT; unsigned sp = 0;
        while (__hip_atomic_load(c, __ATOMIC_RELAXED, __HIP_MEMORY_SCOPE_AGENT) < 192u) { __builtin_amdgcn_s_sleep(2); if (++sp > (1u << 24)) break; }
        __builtin_amdgcn_fence(__ATOMIC_ACQUIRE, "agent"); asm volatile("s_waitcnt vmcnt(0)" ::: "memory"); }
    __syncthreads();
}
template <int N> __device__ __forceinline__ float dpp_ror(float v) { return __builtin_bit_cast(float, __builtin_amdgcn_update_dpp(0, __builtin_bit_cast(int, v), 0x120 + N, 0xF, 0xF, false)); }
__device__ __forceinline__ float xrow16_sum(float x) {
    float a = x, b = x;
    asm volatile("s_nop 1\n\tv_permlane16_swap_b32 %0, %1" : "+v"(a), "+v"(b));
    a += b; b = a;
    asm volatile("s_nop 1\n\tv_permlane32_swap_b32 %0, %1" : "+v"(a), "+v"(b));
    return a + b;
}
__device__ __forceinline__ float wave_sum(float v) {
#pragma unroll
    for (int o = 1; o < 64; o <<= 1) v += __shfl_xor(v, o);
    return v;
}
__device__ __forceinline__ void s1_norm1(Frame& F) {
    const int gw = blockIdx.x * NWAVES + F.wave;
    const int row0 = gw * 16, b = row0 / S;
    if (row0 >= T) return;
    const float* mod = WSP(float, WS_MOD) + (size_t)b * NMOD;
    f32x4 gs[4], sh[4];
#pragma unroll
    for (int j = 0; j < 4; ++j) { const int col = 4 * F.lane + 256 * j; const f32x4 g = *(const f32x4*)(F.g1 + col), s_ = *(const f32x4*)(mod + 1024 + col); gs[j] = g * (s_ + 1.0f); sh[j] = *(const f32x4*)(mod + col); }
    for (int r = 0; r < 16; r += 4) {
        f32x4 v[4][4]; float ss[4];
#pragma unroll
        for (int q = 0; q < 4; ++q) { const float* xr = F.x + (size_t)(row0 + r + q) * D;
#pragma unroll
            for (int j = 0; j < 4; ++j) v[q][j] = __builtin_nontemporal_load((const f32x4*)(xr + 4 * F.lane + 256 * j)); }
#pragma unroll
        for (int q = 0; q < 4; ++q) { ss[q] = 0.f;
#pragma unroll
            for (int j = 0; j < 4; ++j) ss[q] += (v[q][j].x * v[q][j].x + v[q][j].y * v[q][j].y) + (v[q][j].z * v[q][j].z + v[q][j].w * v[q][j].w); }
#pragma unroll
        for (int q = 0; q < 4; ++q) { const float rinv = rsqrtf(wave_sum(ss[q]) * (1.f / D) + EPS);
            bf16_t* o = WSP(bf16_t, WS_H) + (size_t)(row0 + r + q) * D;
#pragma unroll
            for (int j = 0; j < 4; ++j) { const f32x4 h = v[q][j] * rinv * gs[j] + sh[j]; u32x2 w; w.x = pk2(h.x, h.y); w.y = pk2(h.z, h.w); *(u32x2*)(o + 4 * F.lane + 256 * j) = w;
                int p8 = 0; p8 = __builtin_amdgcn_cvt_pk_fp8_f32(h.x, h.y, p8, false); p8 = __builtin_amdgcn_cvt_pk_fp8_f32(h.z, h.w, p8, true);
                *(int*)(WSP(unsigned char, WS_H8) + (size_t)(row0 + r + q) * D + 4 * F.lane + 256 * j) = p8; } }
    }
}

struct RowsLinear { const bf16_t* base; size_t pitch; __device__ __forceinline__ const bf16_t* operator()(int r) const { return base + (size_t)r * pitch; } };
template <class AR, class BR>
__device__ __forceinline__ void sgemm_tile(LAS float* tile, int K, const AR& arow, const BR& brow, int wave, int lane) {
    const int fr = lane & 15, fq = lane >> 4, rb = 16 * (wave & 3), cb = 32 * (wave >> 2);
    const bf16_t* ap = arow(rb + fr) + 8 * fq;
    const bf16_t* bp0 = brow(cb + fr) + 8 * fq;
    const bf16_t* bp1 = brow(cb + 16 + fr) + 8 * fq;
    f32x4 acc0 = {0.f, 0.f, 0.f, 0.f}, acc1 = {0.f, 0.f, 0.f, 0.f};
#pragma unroll 4
    for (int k = 0; k < K; k += 32) {
        const bf16x8 a = *(const bf16x8*)(ap + k), b0 = *(const bf16x8*)(bp0 + k), b1 = *(const bf16x8*)(bp1 + k);
        acc0 = __builtin_amdgcn_mfma_f32_16x16x32_bf16(a, b0, acc0, 0, 0, 0);
        acc1 = __builtin_amdgcn_mfma_f32_16x16x32_bf16(a, b1, acc1, 0, 0, 0);
    }
#pragma unroll
    for (int j = 0; j < 4; ++j) { tile[(rb + fq * 4 + j) * 65 + cb + fr] = acc0[j]; tile[(rb + fq * 4 + j) * 65 + cb + 16 + fr] = acc1[j]; }
}

struct WinRowsHead { const bf16_t* base; int rb; __device__ __forceinline__ const bf16_t* operator()(int d) const { return base + (size_t)(rb + 128 * (d >> 5) + (d & 31)) * 1024; } };
__device__ __forceinline__ void s2_simple(Frame& F) {
    LAS float* tile = (LAS float*)F.lds; LAS float* tile2 = tile + 64 * 65;
    const bf16_t* H = WSP(bf16_t, WS_H); const bf16_t* WT = WSP(bf16_t, WS_WIN_T);
    const int row = F.tid >> 3, seg = F.tid & 7;
    for (int it = blockIdx.x; it < 512 * 72; it += F.G) {
        const int rt = it / 72, ct = it % 72, r0 = rt * 64, gr = r0 + row;
        const RowsLinear ar{H + (size_t)r0 * 1024, 1024};
        float v[8];
        if (ct < 16) {
            const int isk = ct >> 3, hh = ct & 7;
            const WinRowsHead br{WT, 512 * isk + 256 * (hh >> 2) + 32 * (hh & 3)};
            sgemm_tile(tile, 1024, ar, br, F.wave, F.lane); __syncthreads();
            float ss = 0.f;
#pragma unroll
            for (int e = 0; e < 8; ++e) { v[e] = tile[row * 65 + 8 * seg + e]; ss += v[e] * v[e]; }
            ss += __shfl_xor(ss, 1); ss += __shfl_xor(ss, 2); ss += __shfl_xor(ss, 4);
            const float rinv = rsqrtf(ss * (1.f / 64.f) + EPS);
            const float* g = isk ? F.g_k : F.g_q;
            const int pos = gr & (S - 1);
#pragma unroll
            for (int e = 0; e < 8; ++e) { v[e] = v[e] * rinv * g[8 * seg + e]; const float pv = __shfl_xor(v[e], 1);
                if (seg < 2) { const float2 cs = WSP(float2, WS_ROPE)[pos * 8 + e]; v[e] = (seg == 0) ? (v[e] * cs.x - pv * cs.y) : (v[e] * cs.x + pv * cs.y); } }
            if (!isk) {
#pragma unroll
                for (int e = 0; e < 8; ++e) v[e] *= C2;
                *(u32x4*)(WSP(bf16_t, WS_YAB) + (size_t)gr * 1024 + hh * 64 + 8 * seg) = pack8(v);
            } else {
                *(u32x4*)(WSP(bf16_t, WS_K) + (size_t)gr * 512 + hh * 64 + 8 * seg) = pack8(v);
#pragma unroll
                for (int e = 0; e < 8; ++e) tile[row * 65 + 8 * seg + e] = v[e];
                __syncthreads();
                if (F.tid < 64) { float s = 0.f; for (int r = 0; r < 64; ++r) s += tile[r * 65 + F.tid];
                    const int b = r0 / S, blk = (r0 & (S - 1)) >> 8;
                    atomicAdd(WSP(float, WS_KMEAN) + ((size_t)(b * NH + hh) * 16 + blk) * 64 + F.tid, s * (1.f / 256.f)); }
            }
        } else if (ct < 24) {
            const RowsLinear br{WT + (size_t)(1024 + 64 * (ct - 16)) * 1024, 1024};
            sgemm_tile(tile, 1024, ar, br, F.wave, F.lane); __syncthreads();
#pragma unroll
            for (int e = 0; e < 8; ++e) v[e] = tile[row * 65 + 8 * seg + e];
            *(u32x4*)(WSP(bf16_t, WS_V) + (size_t)gr * 512 + 64 * (ct - 16) + 8 * seg) = pack8(v);
        } else if (ct < 32) {
            const int cu = 64 * (ct - 24), rb = 256 * (6 + (cu >> 7)) + (cu & 127);
            const RowsLinear bx{WT + (size_t)rb * 1024, 1024}, bc{WT + (size_t)(rb + 128) * 1024, 1024};
            sgemm_tile(tile, 1024, ar, bx, F.wave, F.lane); sgemm_tile(tile2, 1024, ar, bc, F.wave, F.lane); __syncthreads();
#pragma unroll
            for (int e = 0; e < 8; ++e) v[e] = tile[row * 65 + 8 * seg + e] * tile2[row * 65 + 8 * seg + e];
            *(u32x4*)(WSP(bf16_t, WS_U) + (size_t)gr * 512 + cu + 8 * seg) = pack8(v);
        } else if (ct < 40) {
            const RowsLinear br{WT + (size_t)(2560 + 64 * (ct - 32)) * 1024, 1024};
            sgemm_tile(tile, 1024, ar, br, F.wave, F.lane); __syncthreads();
#pragma unroll
            for (int e = 0; e < 8; ++e) v[e] = tile[row * 65 + 8 * seg + e];
            *(u32x4*)(WSP(bf16_t, WS_BG) + (size_t)gr * 512 + 64 * (ct - 32) + 8 * seg) = pack8(v);
        } else {
            const RowsLinear br{WT + (size_t)(3072 + 64 * (ct - 40)) * 1024, 1024};
            sgemm_tile(tile, 1024, ar, br, F.wave, F.lane); __syncthreads();
#pragma unroll
            for (int e = 0; e < 8; ++e) v[e] = 1.f / (1.f + __expf(-tile[row * 65 + 8 * seg + e]));
            *(u32x4*)(WSP(bf16_t, WS_GATES) + (size_t)gr * 2048 + 64 * (ct - 40) + 8 * seg) = pack8(v);
        }
        __syncthreads();
    }
}

namespace pg8 {
constexpr int BM = 256, BK = 64, HALF = 128, HTB = HALF * BK * 2, STAGE_BYTES = 8 * HTB, NXCD = 8, WGM = 4;
constexpr int VN_STASH = 147456 + 4096;
__device__ __forceinline__ int lds_byte(int r, int c) { const int st = (r >> 4) * 2 + (c >> 5), rr = r & 15, cc = c & 31, ob = rr * 64 + cc * 2; return st * 1024 + (ob ^ (((ob >> 9) & 1) << 5)); }
__device__ __forceinline__ void stage_rc(int b, int& R, int& C) { const int st = b / 1024, sb = b % 1024, swz = sb ^ (((sb >> 9) & 1) << 5); R = (st >> 1) * 16 + swz / 64; C = (st & 1) * 32 + (swz % 64) / 2; }
__device__ __forceinline__ int perm32(int rho) { const int n = rho >> 4, i = rho & 15; return 8 * (i >> 2) + 4 * n + (i & 3); }
struct Unit { int pm, pn; const char* a; const char* b; int e, rbase; };
__device__ __forceinline__ bool static_unit(int i, int G, int c, int nM, int nN, int& pm, int& pn) {
    const int nwg = nM * nN; const long L = (long)i * G + c; if (L >= nwg) return false;
    int wgid = (int)L; { const int q = nwg / NXCD, r = nwg % NXCD, xcd = wgid % NXCD, off = wgid / NXCD; wgid = (xcd < r ? xcd * (q + 1) : r * (q + 1) + (xcd - r) * q) + off; }
    const int nig = WGM * nN, gid = wgid / nig, fm = gid * WGM, gsz = (nM - fm) < WGM ? (nM - fm) : WGM;
    pm = fm + ((wgid % nig) % gsz); pn = (wgid % nig) / gsz; return true;
}
struct DenseSched {
    static constexpr bool GATHER = false, FP8 = false;
    const char* A; const char* Bt; int nM, nN, K, G, c;
    __device__ __forceinline__ bool next(int i, Unit& u) const { if (!static_unit(i, G, c, nM, nN, u.pm, u.pn)) return false;
        u.a = A + (size_t)u.pm * BM * K * 2; u.b = Bt + (size_t)u.pn * BM * K * 2; u.e = 0; u.rbase = 0; return true; }
    __device__ __forceinline__ int row_index(const Unit&, int) const { return 0; }
};

struct DenseSched8 {
    static constexpr bool GATHER = false, FP8 = true;
    const char* A; const char* Bt; int nM, nN, K, G, c;
    __device__ __forceinline__ bool next(int i, Unit& u) const { if (!static_unit(i, G, c, nM, nN, u.pm, u.pn)) return false;
        u.a = A + (size_t)u.pm * BM * K; u.b = Bt + (size_t)u.pn * BM * K; u.e = 0; u.rbase = 0; return true; }
    __device__ __forceinline__ int row_index(const Unit&, int) const { return 0; }
};
template <class Epi, class Sched, bool skip = false>
__device__ __forceinline__ void gemm_phase(LAS unsigned char* lds, const int K, const Sched& S, const Epi& E) {
    int tid_ = threadIdx.x; asm volatile("" : "+v"(tid_));
    const int tid = tid_, wid = __builtin_amdgcn_readfirstlane(tid >> 6), lane = tid & 63, wr = wid >> 2, wc = wid & 3, fr = lane & 15, fq = lane >> 4;
    constexpr bool FP8 = Sched::FP8;
    const int nt = FP8 ? K / 128 : K / BK;
    const int PB = FP8 ? K : 2 * K;
    unsigned voffB[2], vA[2][2], vN[2][2];
#pragma unroll
    for (int i = 0; i < 2; ++i) { int R, C; stage_rc(tid * 16 + i * 8192, R, C); const int Rb = (R & ~31) + perm32(R & 31);
        voffB[i] = (unsigned)(Rb * PB + C * 2);
        vA[0][i] = (unsigned)(R * PB + C * 2); vA[1][i] = (unsigned)((HALF + R) * PB + C * 2); vN[0][i] = vA[0][i]; vN[1][i] = vA[1][i]; }
    const size_t kstep = (size_t)(BK * 2);
    const size_t hstep = (size_t)HALF * PB;
    const unsigned ldsw = (unsigned)wid * 1024u;
    const int aoff = lds_byte(wr * 64 + fr, fq * 8), boff = lds_byte(wc * 32 + fr, fq * 8);
    const int aoff8a = lds_byte(wr * 64 + fr, fq * 16), aoff8b = lds_byte(wr * 64 + fr, fq * 16 + 8), boff8a = lds_byte(wc * 32 + fr, fq * 16), boff8b = lds_byte(wc * 32 + fr, fq * 16 + 8);
#define PG8_SA(b, h) (((b) * 2 + (h)) * HTB)
#define PG8_SB(b, h) ((4 + (b) * 2 + (h)) * HTB)
#define PG8_STAGE(bufoff, gbase, voff) do { _Pragma("unroll") for (int _i = 0; _i < 2; ++_i) \
        __builtin_amdgcn_global_load_lds((const unsigned*)((const char*)(gbase) + (voff)[_i]), (LAS unsigned*)(lds + (bufoff) + ldsw + _i * 8192), 16, 0, 0); } while (0)
#define PG8_LD16(off) (*(const LAS u32x4*)(lds + (off)))
#define PG8_LDA(dst, b, h) do { _Pragma("unroll") for (int m = 0; m < 4; ++m) { if constexpr (FP8) { dst##8[m] = __builtin_bit_cast(i32x8, __builtin_shufflevector(PG8_LD16(PG8_SA(b, h) + aoff8a + m * 2048), PG8_LD16(PG8_SA(b, h) + aoff8b + m * 2048), 0, 1, 2, 3, 4, 5, 6, 7)); } \
        else { _Pragma("unroll") for (int k = 0; k < 2; ++k) dst[m][k] = *(const LAS bf16x8*)(lds + PG8_SA(b, h) + aoff + m * 2048 + k * 1024); } } } while (0)
#define PG8_LDB(dst, b, h) do { _Pragma("unroll") for (int n = 0; n < 2; ++n) { if constexpr (FP8) { dst##8[n] = __builtin_bit_cast(i32x8, __builtin_shufflevector(PG8_LD16(PG8_SB(b, h) + boff8a + n * 2048), PG8_LD16(PG8_SB(b, h) + boff8b + n * 2048), 0, 1, 2, 3, 4, 5, 6, 7)); } \
        else { _Pragma("unroll") for (int k = 0; k < 2; ++k) dst[n][k] = *(const LAS bf16x8*)(lds + PG8_SB(b, h) + boff + n * 2048 + k * 1024); } } } while (0)
#define PG8_MMA(ai, bj, At, Bt) do { __builtin_amdgcn_s_setprio(1); _Pragma("unroll") for (int m = 0; m < 4; ++m) _Pragma("unroll") for (int n = 0; n < 2; ++n) { \
        if constexpr (FP8) { asm volatile("s_nop 1\n\tv_mfma_scale_f32_16x16x128_f8f6f4 %0, %1, %2, %0, %3, %3 op_sel_hi:[0,0,0]" : "+v"(acc[ai][bj][m][n]) : "v"(Bt##8[n]), "v"(At##8[m]), "v"(sc127)); } \
        else { _Pragma("unroll") for (int k = 0; k < 2; ++k) acc[ai][bj][m][n] = __builtin_amdgcn_mfma_f32_16x16x32_bf16(Bt[n][k], At[m][k], acc[ai][bj][m][n], 0, 0, 0); } } __builtin_amdgcn_s_setprio(0); } while (0)
#define PG8_WAIT_V(n) asm volatile("s_waitcnt vmcnt(" #n ")" ::: "memory")
#define PG8_WAIT_L(n) asm volatile("s_waitcnt lgkmcnt(" #n ")" ::: "memory")
#define PG8_BAR __builtin_amdgcn_s_barrier()
#define PG8_SCHED __builtin_amdgcn_sched_barrier(0)
#define PG8_AOFF(dst, u) do { int _t = threadIdx.x; asm volatile("" : "+v"(_t)); _Pragma("unroll") for (int _i = 0; _i < 2; ++_i) { int _R, _C; stage_rc(_t * 16 + _i * 8192, _R, _C); \
        _Pragma("unroll") for (int _h = 0; _h < 2; ++_h) dst[_h][_i] = (unsigned)(S.row_index(u, _h * HALF + _R) * PB + _C * 2); } } while (0)
    Unit cur, nxt; int ui = 0;
    if (!S.next(0, cur)) return;
    if constexpr (Sched::GATHER) PG8_AOFF(vA, cur);
    f32x4 acc[2][2][4][2]; typename Epi::State est;
#pragma unroll
    for (int a = 0; a < 2; ++a)
#pragma unroll
        for (int b = 0; b < 2; ++b)
#pragma unroll
            for (int m = 0; m < 4; ++m)
#pragma unroll
                for (int n = 0; n < 2; ++n) acc[a][b][m][n] = (f32x4){0.f, 0.f, 0.f, 0.f};
    const int sc127 = 127;
    bf16x8 At[4][2], B0[2][2], B1[2][2]; i32x8 At8[4], B08[2], B18[2];
    const char* cA = cur.a; const char* cB = cur.b;
    PG8_STAGE(PG8_SB(0, 0), cB, voffB); PG8_STAGE(PG8_SB(0, 1), cB + hstep, voffB); PG8_STAGE(PG8_SA(0, 0), cA, vA[0]); PG8_STAGE(PG8_SA(0, 1), cA, vA[1]);
    if (wr == 1) PG8_BAR;
    PG8_WAIT_V(2); PG8_BAR;
    PG8_STAGE(PG8_SB(1, 0), cB + kstep, voffB); PG8_STAGE(PG8_SA(1, 0), cA + kstep, vA[0]); PG8_STAGE(PG8_SB(1, 1), cB + hstep + kstep, voffB);
    PG8_WAIT_V(6); PG8_BAR;
    for (;;) {
        const bool has_next = S.next(ui + 1, nxt);
        const char* nA = has_next ? nxt.a : cA; const char* nB = has_next ? nxt.b : cB;
        if constexpr (Sched::GATHER) { if (has_next) PG8_AOFF(vN, nxt); else {
#pragma unroll
            for (int h = 0; h < 2; ++h)
#pragma unroll
                for (int i = 0; i < 2; ++i) vN[h][i] = vA[h][i]; }
            *(LAS u32x4*)(lds + VN_STASH + tid * 16) = (u32x4){vN[0][0], vN[0][1], vN[1][0], vN[1][1]}; }
        for (int hk = 0; hk < (Epi::HAS_MID ? 2 : 1); ++hk) {
        if constexpr (Epi::HAS_MID) { if (hk == 1 && !skip) E.mid(acc, cur, wr, wc, fr, fq, est); }
        const int tb = (Epi::HAS_MID && hk == 1) ? nt / 2 : 0, te = (Epi::HAS_MID && hk == 0) ? nt / 2 : nt;
#pragma unroll 1
        for (int t = tb; t < te; t += 2) {
            const bool last = (t == nt - 2);
            const char* a1 = cA + (size_t)(t + 1) * kstep;
            const char* a2 = last ? nA : cA + (size_t)(t + 2) * kstep; const char* b2 = last ? nB : cB + (size_t)(t + 2) * kstep;
            const char* a3 = a2 + kstep; const char* b3 = b2 + kstep;
            unsigned w0[2], w1[2];
#pragma unroll
            for (int i = 0; i < 2; ++i) { w0[i] = vA[0][i]; w1[i] = vA[1][i]; }
            if constexpr (Sched::GATHER) { if (last) { const u32x4 q = *(const LAS u32x4*)(lds + VN_STASH + tid * 16); w0[0] = q.x; w0[1] = q.y; w1[0] = q.z; w1[1] = q.w; } }
            PG8_LDB(B0, 0, 0); PG8_LDB(B1, 0, 1); PG8_SCHED; PG8_LDA(At, 0, 0); PG8_STAGE(PG8_SA(1, 1), a1, vA[1]);
            PG8_WAIT_V(8); PG8_WAIT_L(0); PG8_BAR; PG8_MMA(0, 0, At, B0); PG8_MMA(0, 1, At, B1); PG8_BAR; PG8_SCHED;
            PG8_LDA(At, 0, 1); PG8_STAGE(PG8_SB(0, 0), b2, voffB); PG8_STAGE(PG8_SB(0, 1), b2 + hstep, voffB); PG8_STAGE(PG8_SA(0, 0), a2, w0);
            PG8_WAIT_V(8); PG8_WAIT_L(0); PG8_BAR; PG8_MMA(1, 0, At, B0); PG8_MMA(1, 1, At, B1); PG8_BAR; PG8_SCHED;
            PG8_LDB(B0, 1, 0); PG8_LDB(B1, 1, 1); PG8_SCHED; PG8_LDA(At, 1, 0); PG8_STAGE(PG8_SA(0, 1), a2, w1);
            PG8_WAIT_V(8); PG8_WAIT_L(0); PG8_BAR; PG8_MMA(0, 0, At, B0); PG8_MMA(0, 1, At, B1); PG8_BAR; PG8_SCHED;
            PG8_LDA(At, 1, 1); PG8_STAGE(PG8_SB(1, 0), b3, voffB); PG8_STAGE(PG8_SB(1, 1), b3 + hstep, voffB); PG8_STAGE(PG8_SA(1, 0), a3, w0);
            PG8_WAIT_V(8); PG8_WAIT_L(0); PG8_BAR; PG8_MMA(1, 0, At, B0); PG8_MMA(1, 1, At, B1); PG8_BAR; PG8_SCHED;
        }
        }
        if (wr == 0) PG8_BAR;
        if constexpr (FP8) asm volatile("s_nop 15\n\ts_nop 7" ::: "memory");
        if constexpr (!skip) E(acc, cur, wr, wc, fr, fq, est); else {
#pragma unroll
            for (int a = 0; a < 2; ++a)
#pragma unroll
                for (int b = 0; b < 2; ++b)
#pragma unroll
                    for (int m = 0; m < 4; ++m)
#pragma unroll
                        for (int n = 0; n < 2; ++n) asm volatile("" :: "v"(acc[a][b][m][n])); }
        if (!has_next) break;
#pragma unroll
        for (int a = 0; a < 2; ++a)
#pragma unroll
            for (int b = 0; b < 2; ++b)
#pragma unroll
                for (int m = 0; m < 4; ++m)
#pragma unroll
                    for (int n = 0; n < 2; ++n) acc[a][b][m][n] = (f32x4){0.f, 0.f, 0.f, 0.f};
        cur = nxt; cA = nA; cB = nB; ++ui;
        if constexpr (Sched::GATHER) { const u32x4 q = *(const LAS u32x4*)(lds + VN_STASH + tid * 16); vA[0][0] = q.x; vA[0][1] = q.y; vA[1][0] = q.z; vA[1][1] = q.w; }
        if (wr == 1) PG8_BAR;
    }
    PG8_WAIT_V(0);
    PG8_BAR;
#undef PG8_SA
#undef PG8_SB
#undef PG8_STAGE
#undef PG8_LDA
#undef PG8_LDB
#undef PG8_MMA
#undef PG8_LD16
#undef PG8_WAIT_V
#undef PG8_WAIT_L
#undef PG8_BAR
#undef PG8_SCHED
#undef PG8_AOFF
}
}

typedef f32x4 Acc[2][2][4][2];
struct EpiG1 {
    static constexpr bool HAS_MID = false;
    unsigned char* ws; const float* g_q; const float* g_k;
    struct State {}; __device__ __forceinline__ void mid(Acc&, const pg8::Unit&, int, int, int, int, State&) const {}
    __device__ __forceinline__ void operator()(Acc& acc, const pg8::Unit& u, int wr, int wc, int fr, int fq, State& st) const {
        const int pn = u.pn, row0 = u.pm * 256 + wr * 64 + fr;
        if (pn < 4) {
            const int isk = pn >> 1, hh = 4 * (pn & 1) + wc;
            const float* g = isk ? g_k : g_q;
            f32x4 gv[2][2];
#pragma unroll
            for (int bj = 0; bj < 2; ++bj)
#pragma unroll
                for (int n = 0; n < 2; ++n) gv[bj][n] = *(const f32x4*)(g + ((bj == 0 && fq < 2) ? 8 * n + 4 * fq : 32 * bj + 8 * fq + 4 * n));
            f32x4 cs_[2][2];
#pragma unroll
            for (int bj = 0; bj < 2; ++bj)
#pragma unroll
                for (int n = 0; n < 2; ++n) cs_[bj][n] = (f32x4){0.f, 0.f, 0.f, 0.f};
            f32x4 rf;
#pragma unroll
            for (int e = 0; e < 4; ++e) { const float f0 = exp2f(-(float)e * (0.125f * 18.931568569324174f)) * 0.15915494309189535f, f1 = exp2f(-(float)(4 + e) * (0.125f * 18.931568569324174f)) * 0.15915494309189535f;
                rf[e] = fq == 0 ? f0 : (fq == 1 ? f1 : 0.f); }
            bf16_t* dst = isk ? (bf16_t*)(ws + WS_K) : (bf16_t*)(ws + WS_YAB);
            const int pitch = isk ? 512 : 1024;
            const float sc = isk ? 1.f : C2;
#pragma unroll
            for (int ai = 0; ai < 2; ++ai)
#pragma unroll
                for (int m = 0; m < 4; ++m) {
                    const int r = row0 + 128 * ai + 16 * m; const float pos = (float)(r & (S - 1));
                    f32x4 v[2][2]; float ss = 0.f;
#pragma unroll
                    for (int bj = 0; bj < 2; ++bj)
#pragma unroll
                        for (int n = 0; n < 2; ++n) { v[bj][n] = acc[ai][bj][m][n]; ss += (v[bj][n].x * v[bj][n].x + v[bj][n].y * v[bj][n].y) + (v[bj][n].z * v[bj][n].z + v[bj][n].w * v[bj][n].w); }
                    ss = xrow16_sum(ss);
                    const float rinv = rsqrtf(ss * (1.f / 64.f) + EPS);
#pragma unroll
                    for (int bj = 0; bj < 2; ++bj)
#pragma unroll
                        for (int n = 0; n < 2; ++n) v[bj][n] = v[bj][n] * rinv * gv[bj][n];
#pragma unroll
                    for (int e = 0; e < 4; ++e) { const float rev = __builtin_amdgcn_fractf(pos * rf[e]), c = __builtin_amdgcn_cosf(rev), sn = __builtin_amdgcn_sinf(rev);
                        const float x1 = v[0][0][e], x2 = v[0][1][e]; v[0][0][e] = x1 * c - x2 * sn; v[0][1][e] = x2 * c + x1 * sn; }
                    if (isk) {
#pragma unroll
                        for (int bj = 0; bj < 2; ++bj)
#pragma unroll
                            for (int n = 0; n < 2; ++n) cs_[bj][n] += v[bj][n];
                    }
#pragma unroll
                    for (int bj = 0; bj < 2; ++bj) st16(dst + (size_t)r * pitch + hh * 64 + 32 * bj + 8 * fq, pack8v(v[bj][0] * sc, v[bj][1] * sc));
                }
            if (isk) {
                const int b = u.pm >> 4, blk = u.pm & 15;
                float* km = (float*)(ws + WS_KMEAN) + ((size_t)(b * NH + hh) * 16 + blk) * 64;
#pragma unroll
                for (int bj = 0; bj < 2; ++bj)
#pragma unroll
                    for (int n = 0; n < 2; ++n)
#pragma unroll
                        for (int e = 0; e < 4; ++e) { float s = cs_[bj][n][e]; s += dpp_ror<8>(s); s += dpp_ror<4>(s); s += dpp_ror<2>(s); s += dpp_ror<1>(s);
                            if (fr == 0) atomicAdd(km + 32 * bj + 8 * fq + 4 * n + e, s * (1.f / 256.f)); }
            }
        } else if (pn < 8) {
            bf16_t* dst = (bf16_t*)(ws + WS_U);
#pragma unroll
            for (int ai = 0; ai < 2; ++ai)
#pragma unroll
                for (int m = 0; m < 4; ++m) { const int r = row0 + 128 * ai + 16 * m;
                    const f32x4 a = acc[ai][0][m][0] * acc[ai][1][m][0], b = acc[ai][0][m][1] * acc[ai][1][m][1]; u32x4 w;
                    w.x = pk2(a.x, a.y); w.y = pk2(a.z, a.w); w.z = pk2(b.x, b.y); w.w = pk2(b.z, b.w);
                    st16(dst + (size_t)r * 512 + 128 * (pn - 4) + 32 * wc + 8 * fq, w); }
        } else {
            bf16_t* dst = (bf16_t*)(ws + WS_BG); const int pitch = 512, c0 = 256 * (pn - 8); const bool sig = false;
#pragma unroll
            for (int ai = 0; ai < 2; ++ai)
#pragma unroll
                for (int m = 0; m < 4; ++m) { const int r = row0 + 128 * ai + 16 * m;
#pragma unroll
                    for (int bj = 0; bj < 2; ++bj) { f32x4 a = acc[ai][bj][m][0], b = acc[ai][bj][m][1];
                        if (sig) {
#pragma unroll
                            for (int e = 0; e < 4; ++e) { a[e] = __builtin_amdgcn_rcpf(1.f + __expf(-a[e])); b[e] = __builtin_amdgcn_rcpf(1.f + __expf(-b[e])); } }
                        u32x4 w; w.x = pk2(a.x, a.y); w.y = pk2(a.z, a.w); w.z = pk2(b.x, b.y); w.w = pk2(b.z, b.w);
                        st16(dst + (size_t)r * pitch + c0 + 128 * bj + 32 * wc + 8 * fq, w); } }
        }
    }
};
struct EpiGate {
    static constexpr bool HAS_MID = false;
    bf16_t* gates; bf16_t* vout;
    struct State {}; __device__ __forceinline__ void mid(Acc&, const pg8::Unit&, int, int, int, int, State&) const {}
    __device__ __forceinline__ void operator()(Acc& acc, const pg8::Unit& u, int wr, int wc, int fr, int fq, State& st) const {
        int row0 = u.pm * 256 + wr * 64 + fr; const int c0 = u.pn * 256 + 32 * wc + 8 * fq; asm volatile("" : "+v"(row0));
#pragma unroll
        for (int ai = 0; ai < 2; ++ai)
#pragma unroll
            for (int m = 0; m < 4; ++m) { const size_t r = (size_t)(row0 + 128 * ai + 16 * m);
                if (u.pn < 8) {
                    f32x4 ra[2], gb[2];
#pragma unroll
                    for (int n = 0; n < 2; ++n)
#pragma unroll
                        for (int e = 0; e < 4; ++e) { const float xa = __builtin_amdgcn_fmed3f(acc[ai][0][m][n][e] * (-1.f / W8_SCALE), -40.f, 40.f), xb = __builtin_amdgcn_fmed3f(acc[ai][1][m][n][e] * (-1.f / W8_SCALE), -40.f, 40.f);
                            const float pa = 1.f + __expf(xa), pb = 1.f + __expf(xb), rr = __builtin_amdgcn_rcpf(pa * pb);
                            gb[n][e] = rr * pa; ra[n][e] = fminf(pb * pb * rr, 3e4f); }
                    const size_t gc = ((size_t)(u.pm * 4 + (u.pn >> 1)) * 256 + (size_t)(r - (size_t)u.pm * 256)) * 256 + 128 * (u.pn & 1) + 32 * wc + 8 * fq;
                    st16(gates + gc, pack8v(ra[0], ra[1])); st16(gates + gc + (size_t)T * 1024, pack8v(gb[0], gb[1]));
                } else {
#pragma unroll
                    for (int bj = 0; bj < 2; ++bj) st16(vout + r * 512 + (c0 - 2048) + 128 * bj, pack8v(acc[ai][bj][m][0] * (1.f / W8_SCALE), acc[ai][bj][m][1] * (1.f / W8_SCALE))); } }
    }
};
__device__ __forceinline__ void s2_fast(Frame& F) {
    {
        const pg8::DenseSched Sd{(const char*)(F.ws + WS_H), (const char*)(F.ws + WS_WIN_T), T / 256, 10, 1024, F.G, (int)blockIdx.x};
        const EpiG1 E{F.ws, F.g_q, F.g_k};
        if (F.skip) pg8::gemm_phase<EpiG1, pg8::DenseSched, true>(F.lds, 1024, Sd, E); else pg8::gemm_phase<EpiG1, pg8::DenseSched>(F.lds, 1024, Sd, E); }
    {
        const pg8::DenseSched8 Sd{(const char*)(F.ws + WS_H8), (const char*)(F.ws + WS_WIN8), T / 256, 10, 1024, F.G, (int)blockIdx.x};
        const EpiGate E{WSP(bf16_t, WS_GATES), WSP(bf16_t, WS_V)};
        int Kg = D; asm volatile("" : "+s"(Kg));
        if (F.skip) pg8::gemm_phase<EpiGate, pg8::DenseSched8, true>(F.lds, Kg, Sd, E); else pg8::gemm_phase<EpiGate, pg8::DenseSched8>(F.lds, Kg, Sd, E); }
}

constexpr float NEG_BIG = -1e30f;
__device__ __forceinline__ void s3_simple(Frame& F) {
    LAS float* tS = (LAS float*)F.lds;
    LAS bf16_t* Pb = (LAS bf16_t*)(F.lds + 16896);
    LAS bf16_t* Vt = (LAS bf16_t*)(F.lds + 16896 + 9216);
    LAS float* mrow = (LAS float*)(F.lds + 16896 + 18432);
    LAS float* lrow = mrow + 64; LAS float* arow_ = mrow + 128; LAS int* sel = (LAS int*)(mrow + 192); LAS int* um = sel + 64;
    bf16_t* YAB = WSP(bf16_t, WS_YAB); const bf16_t* Kb = WSP(bf16_t, WS_K); const bf16_t* Vb = WSP(bf16_t, WS_V);
    const float* kmean = WSP(float, WS_KMEAN);
    const int row = F.tid >> 3, seg = F.tid & 7, fr = F.lane & 15, fq = F.lane >> 4, rb = 16 * (F.wave & 3), cb = 32 * (F.wave >> 2);
    for (int it = blockIdx.x; it < NB * NH * 64; it += F.G) {
        const int qc = it & 63, h = (it >> 6) & 7, b = it >> 9, cur = qc >> 2, t0 = 64 * qc;
        const size_t tb = (size_t)b * S;
        if (F.tid < 64) {
            float q[64];
            const bf16_t* qp = YAB + (tb + t0 + F.tid) * 1024 + h * 64;
#pragma unroll
            for (int i = 0; i < 8; ++i) { float t8[8]; unpack8(*(const u32x4*)(qp + 8 * i), t8);
#pragma unroll
                for (int e = 0; e < 8; ++e) q[8 * i + e] = t8[e]; }
            float b0 = -INFINITY, b1 = -INFINITY, b2 = -INFINITY; int i0 = -1, i1 = -1, i2 = -1;
            for (int j = 0; j < cur; ++j) { const float* km = kmean + ((size_t)(b * NH + h) * 16 + j) * 64; float s = 0.f;
#pragma unroll
                for (int d = 0; d < 64; ++d) s += q[d] * km[d];
                if (s > b0) { b2 = b1; i2 = i1; b1 = b0; i1 = i0; b0 = s; i0 = j; } else if (s > b1) { b2 = b1; i2 = i1; b1 = s; i1 = j; } else if (s > b2) { b2 = s; i2 = j; } }
            int m = 0; if (i0 >= 0) m |= 1 << i0; if (i1 >= 0) m |= 1 << i1; if (i2 >= 0) m |= 1 << i2;
            sel[F.tid] = m; mrow[F.tid] = NEG_BIG; lrow[F.tid] = 0.f;
            int u = m;
#pragma unroll
            for (int o = 1; o < 64; o <<= 1) u |= __shfl_xor(u, o);
            if (F.tid == 0) um[0] = u;
        }
        __syncthreads();
        const int umask = um[0];
        f32x4 o0 = {0.f, 0.f, 0.f, 0.f}, o1 = {0.f, 0.f, 0.f, 0.f};
        const RowsLinear aq{YAB + (tb + t0) * 1024 + h * 64, 1024};
        for (int j = 0; j <= cur; ++j) {
            if (j < cur && !((umask >> j) & 1)) continue;
            const int nkt = (j == cur) ? ((qc & 3) + 1) : 4;
            for (int kt = 0; kt < nkt; ++kt) {
                const int kbase = 256 * j + 64 * kt;
                const RowsLinear bk{Kb + (tb + kbase) * 512 + h * 64, 512};
                sgemm_tile(tS, 64, aq, bk, F.wave, F.lane);
                { float vv[8]; unpack8(*(const u32x4*)(Vb + (tb + kbase + row) * 512 + h * 64 + 8 * seg), vv);
#pragma unroll
                    for (int e = 0; e < 8; ++e) Vt[(8 * seg + e) * 72 + row] = (bf16_t)f2bf(vv[e]); }
                __syncthreads();
                {
                    float s[8]; float mx = NEG_BIG;
                    const bool rowsel = (j == cur) || ((sel[row] >> j) & 1);
#pragma unroll
                    for (int e = 0; e < 8; ++e) { const int c = 8 * seg + e; float x = tS[row * 65 + c];
                        if (!rowsel || (j == cur && kbase + c > t0 + row)) x = NEG_BIG; s[e] = x; mx = fmaxf(mx, x); }
                    mx = fmaxf(mx, __shfl_xor(mx, 1)); mx = fmaxf(mx, __shfl_xor(mx, 2)); mx = fmaxf(mx, __shfl_xor(mx, 4));
                    const float mold = mrow[row], mnew = fmaxf(mold, mx);
                    float alpha = 1.f, ps = 0.f; float p[8];
                    if (mnew <= NEG_BIG) {
#pragma unroll
                        for (int e = 0; e < 8; ++e) p[e] = 0.f;
                    } else { alpha = exp2f(mold - mnew);
#pragma unroll
                        for (int e = 0; e < 8; ++e) { p[e] = (s[e] <= NEG_BIG) ? 0.f : exp2f(s[e] - mnew); ps += p[e]; } }
                    ps += __shfl_xor(ps, 1); ps += __shfl_xor(ps, 2); ps += __shfl_xor(ps, 4);
                    const float lold = lrow[row];
                    *(LAS u32x4*)(Pb + row * 72 + 8 * seg) = pack8(p);
                    if (seg == 0) { mrow[row] = mnew; lrow[row] = lold * alpha + ps; arow_[row] = alpha; }
                }
                __syncthreads();
                {
#pragma unroll
                    for (int r = 0; r < 4; ++r) { const float a = arow_[rb + fq * 4 + r]; o0[r] *= a; o1[r] *= a; }
#pragma unroll
                    for (int ks = 0; ks < 2; ++ks) {
                        const bf16x8 a = *(const LAS bf16x8*)(Pb + (rb + fr) * 72 + 32 * ks + 8 * fq);
                        const bf16x8 v0 = *(const LAS bf16x8*)(Vt + (cb + fr) * 72 + 32 * ks + 8 * fq);
                        const bf16x8 v1 = *(const LAS bf16x8*)(Vt + (cb + 16 + fr) * 72 + 32 * ks + 8 * fq);
                        o0 = __builtin_amdgcn_mfma_f32_16x16x32_bf16(a, v0, o0, 0, 0, 0);
                        o1 = __builtin_amdgcn_mfma_f32_16x16x32_bf16(a, v1, o1, 0, 0, 0);
                    }
                }
                __syncthreads();
            }
        }
#pragma unroll
        for (int r = 0; r < 4; ++r) { const float li = 1.f / lrow[rb + fq * 4 + r]; tS[(rb + fq * 4 + r) * 65 + cb + fr] = o0[r] * li; tS[(rb + fq * 4 + r) * 65 + cb + 16 + fr] = o1[r] * li; }
        __syncthreads();
        { float v[8];
#pragma unroll
            for (int e = 0; e < 8; ++e) v[e] = tS[row * 65 + 8 * seg + e];
            *(u32x4*)(YAB + (tb + t0 + row) * 1024 + h * 64 + 8 * seg) = pack8(v); }
        __syncthreads();
    }
    const bf16_t* U = WSP(bf16_t, WS_U); const bf16_t* BG = WSP(bf16_t, WS_BG);
    for (int i = blockIdx.x * NTHREADS + F.tid; i < T * 64; i += F.G * NTHREADS) {
        const int t = i >> 6, c0 = (i & 63) * 8, pos = t & (S - 1);
        float u0[8], u1[8], u2[8], bg[8], y[8];
        unpack8(*(const u32x4*)(U + (size_t)t * 512 + c0), u2); unpack8(*(const u32x4*)(BG + (size_t)t * 512 + c0), bg);
        if (pos >= 1) unpack8(*(const u32x4*)(U + (size_t)(t - 1) * 512 + c0), u1); else {
#pragma unroll
            for (int e = 0; e < 8; ++e) u1[e] = 0.f; }
        if (pos >= 2) unpack8(*(const u32x4*)(U + (size_t)(t - 2) * 512 + c0), u0); else {
#pragma unroll
            for (int e = 0; e < 8; ++e) u0[e] = 0.f; }
#pragma unroll
        for (int e = 0; e < 8; ++e) y[e] = bg[e] * (F.conv_w[c0 + e] * u0[e] + F.conv_w[512 + c0 + e] * u1[e] + F.conv_w[1024 + c0 + e] * u2[e] + F.conv_b[c0 + e]);
        *(u32x4*)(YAB + (size_t)t * 1024 + 512 + c0) = pack8(y);
    }
}

namespace attn_body {
using bf16x8 = __attribute__((ext_vector_type(8))) short;
using s16x4 = __attribute__((ext_vector_type(4))) short;
using f32x16 = __attribute__((ext_vector_type(16))) float;
using u32x4 = __attribute__((ext_vector_type(4))) unsigned;
constexpr int SEQ = 4096, D = 64, DMQ = 1024, DMK = 512;
constexpr int NW = 8, QBLK = 32, QB = QBLK * NW, KVBLK = 64;
constexpr float NEGB = -1e30f;
__device__ __forceinline__ int crow(int r, int hi) { return (r & 3) + 8 * (r >> 2) + 4 * hi; }
#define SBAR() __builtin_amdgcn_sched_barrier(0)
__device__ __forceinline__ void cmask(f32x16& p0, f32x16& p1, int jb, int qrel, int hi) {
  const float NEG = -INFINITY; int kb = 64 * jb + 4 * hi;
  #pragma unroll
  for (int r = 0; r < 16; ++r) { int kv = kb + (r & 3) + 8 * (r >> 2); if (kv > qrel) p0[r] = NEG; if (kv + 32 > qrel) p1[r] = NEG; }
}
constexpr int NSLOT = 3, SLOTB = 8192;
constexpr int LDS_K = 0, LDS_V = NSLOT * SLOTB, LDS_WS = 2 * NSLOT * SLOTB, LDS_OST = LDS_WS + NW * 128 * 4, LDS_BYTES_A = LDS_OST + NW * 4096;
__device__ __forceinline__ void glds16(const void* gsrc, unsigned lds_dst) { unsigned keep;
  asm volatile("s_mov_b32 %0, m0\n\ts_mov_b32 m0, %2\n\ts_nop 0\n\tglobal_load_lds_dwordx4 %1, off\n\ts_mov_b32 m0, %0" : "=&s"(keep) : "v"(gsrc), "s"(lds_dst) : "memory"); }
__device__ __forceinline__ float max3f(float a, float b, float c) { float r; asm("v_max3_f32 %0, %1, %2, %3" : "=v"(r) : "v"(a), "v"(b), "v"(c)); return r; }
__device__ __forceinline__ float max2f(float a, float b) { float r; asm("v_max_f32_e32 %0, %1, %2" : "=v"(r) : "v"(a), "v"(b)); return r; }
__device__ __forceinline__ float fadd_s(float a, float b) { float r; asm("v_add_f32_e32 %0, %1, %2" : "=v"(r) : "v"(a), "v"(b)); return r; }
__device__ __forceinline__ float fsub_s(float a, float b) { float r; asm("v_sub_f32_e32 %0, %1, %2" : "=v"(r) : "v"(a), "v"(b)); return r; }
typedef float f32x2_t __attribute__((ext_vector_type(2))); typedef __bf16 bf16x2_t __attribute__((ext_vector_type(2)));
__device__ __forceinline__ unsigned cvtpk_s(float lo, float hi) { f32x2_t v = {lo, hi}; bf16x2_t b = __builtin_convertvector(v, bf16x2_t); return __builtin_bit_cast(unsigned, b); }
#define WAIT_BAR(N) asm volatile("s_waitcnt vmcnt(" #N ") lgkmcnt(0)\n\ts_barrier" ::: "memory")
__device__ __forceinline__ void qkt(f32x16& p0, f32x16& p1, const char* Kslot, const bf16x8* qr, const f32x16& negm, int r32, int hi) {
  const char* kb = Kslot + hi * 1024 + r32 * 16;
  #pragma unroll
  for (int d0 = 0; d0 < 4; ++d0) {
    const bf16x8 b0 = *reinterpret_cast<const bf16x8*>(kb + d0 * 2048);
    const bf16x8 b1 = *reinterpret_cast<const bf16x8*>(kb + d0 * 2048 + 512);
    if (d0 == 0) { p0 = __builtin_amdgcn_mfma_f32_32x32x16_bf16(b0, qr[0], negm, 0, 0, 0); p1 = __builtin_amdgcn_mfma_f32_32x32x16_bf16(b1, qr[0], negm, 0, 0, 0); }
    else { p0 = __builtin_amdgcn_mfma_f32_32x32x16_bf16(b0, qr[d0], p0, 0, 0, 0); p1 = __builtin_amdgcn_mfma_f32_32x32x16_bf16(b1, qr[d0], p1, 0, 0, 0); } }
}
typedef __attribute__((address_space(3))) const char* lds_cptr;
typedef __attribute__((address_space(3))) char* lds_ptr;
typedef short v4i16_t __attribute__((ext_vector_type(4)));
__device__ __forceinline__ void kload8(bf16x8* kf, lds_cptr kp) {
  kf[0] = *(const __attribute__((address_space(3))) bf16x8*)(kp);        kf[1] = *(const __attribute__((address_space(3))) bf16x8*)(kp + 512);
  kf[2] = *(const __attribute__((address_space(3))) bf16x8*)(kp + 2048); kf[3] = *(const __attribute__((address_space(3))) bf16x8*)(kp + 2560);
  kf[4] = *(const __attribute__((address_space(3))) bf16x8*)(kp + 4096); kf[5] = *(const __attribute__((address_space(3))) bf16x8*)(kp + 4608);
  kf[6] = *(const __attribute__((address_space(3))) bf16x8*)(kp + 6144); kf[7] = *(const __attribute__((address_space(3))) bf16x8*)(kp + 6656);
}
__device__ __forceinline__ void kload2(bf16x8* kf, lds_cptr kp, int j) { kf[2 * j] = *(const __attribute__((address_space(3))) bf16x8*)(kp + j * 2048); kf[2 * j + 1] = *(const __attribute__((address_space(3))) bf16x8*)(kp + j * 2048 + 512); }
__device__ __forceinline__ s16x4 vtr(lds_cptr p) { return __builtin_bit_cast(s16x4, __builtin_amdgcn_ds_read_tr16_b64_v4i16((__attribute__((address_space(3))) v4i16_t*)p)); }
__device__ __forceinline__ float rowmax(const f32x16& p0, const f32x16& p1) {
  float a = max3f(p0[0], p0[1], p1[0]), b = max3f(p0[2], p0[3], p1[1]); a = max3f(a, p1[2], p1[3]);
  #pragma unroll
  for (int r = 4; r < 16; r += 4) { a = max3f(a, p0[r], p0[r + 1]); b = max3f(b, p0[r + 2], p0[r + 3]); a = max3f(a, p1[r], p1[r + 1]); b = max3f(b, p1[r + 2], p1[r + 3]); }
  const float m = max2f(a, b);
  auto rr = __builtin_amdgcn_permlane32_swap(__float_as_uint(m), __float_as_uint(m), false, false);
  return max2f(__uint_as_float(rr[0]), __uint_as_float(rr[1]));
}
__device__ __forceinline__ void pv(f32x16* o, int vb, bf16x8 pa0, bf16x8 pa1, bf16x8 pa2, bf16x8 pa3) {
  #pragma unroll
  for (int d0 = 0; d0 < 2; ++d0) { s16x4 lo[4], hi[4];
    #pragma unroll
    for (int ks = 0; ks < 4; ++ks) {
      asm volatile("ds_read_b64_tr_b16 %0,%1 offset:%c2" : "=&v"(lo[ks]) : "v"(vb), "i"(d0 * 4096 + ks * 1024) : "memory");
      asm volatile("ds_read_b64_tr_b16 %0,%1 offset:%c2" : "=&v"(hi[ks]) : "v"(vb), "i"(d0 * 4096 + ks * 1024 + 512) : "memory"); }
    asm volatile("s_waitcnt lgkmcnt(0)" ::: "memory"); SBAR();
    #define PK(k) (bf16x8){lo[k][0], lo[k][1], lo[k][2], lo[k][3], hi[k][0], hi[k][1], hi[k][2], hi[k][3]}
    o[d0] = __builtin_amdgcn_mfma_f32_32x32x16_bf16(pa0, PK(0), o[d0], 0, 0, 0);
    o[d0] = __builtin_amdgcn_mfma_f32_32x32x16_bf16(pa1, PK(1), o[d0], 0, 0, 0);
    o[d0] = __builtin_amdgcn_mfma_f32_32x32x16_bf16(pa2, PK(2), o[d0], 0, 0, 0);
    o[d0] = __builtin_amdgcn_mfma_f32_32x32x16_bf16(pa3, PK(3), o[d0], 0, 0, 0);
    #undef PK
  }
}
#define ATTN_STORE16(p, v) st16((p), (v))
template <int THRL> __device__ __forceinline__ void attn_unit(int b, int h, int qb, const bf16_t* QO, bf16_t* Ob, const bf16_t* __restrict__ K, const bf16_t* __restrict__ V, const float* __restrict__ kmean, char* shm) {
  int tid_ = threadIdx.x; asm volatile("" : "+v"(tid_));
  const int tid = tid_, lane = tid & 63, r32 = lane & 31, hi = lane >> 5; const int wid = __builtin_amdgcn_readfirstlane(tid >> 6);
  const long rowbase = (long)b * SEQ; const int q0 = qb * QB;
  const bf16_t* Qw = QO + (rowbase + q0 + wid * QBLK) * DMQ + h * D;
  const bf16_t* Kh = K + rowbase * DMK + h * D, *Vh = V + rowbase * DMK + h * D;
  const unsigned lds0 = (unsigned)(uintptr_t)shm;
  float* wsf = (float*)(shm + LDS_WS) + wid * 128;
  const bf16_t* ksrc = Kh + (long)lane * DMK + wid * 8;
  const bf16_t* vsrc = Vh + (long)(16 * (wid & 3) + (lane >> 2)) * DMK + (wid >> 2) * 32 + (lane & 3) * 8;
  const unsigned kdst = lds0 + LDS_K + wid * 1024, vdst = lds0 + LDS_V + wid * 1024;
  #define DMA_K(t, slot) glds16(ksrc + (long)(t) * KVBLK * DMK, (unsigned)__builtin_amdgcn_readfirstlane(kdst + (slot)))
  #define DMA_V(t, slot) glds16(vsrc + (long)(t) * KVBLK * DMK, (unsigned)__builtin_amdgcn_readfirstlane(vdst + (slot)))
  DMA_K(0, 0); DMA_V(0, 0); DMA_K(1, SLOTB);
  bf16x8 qr[4];
  #pragma unroll
  for (int d0 = 0; d0 < 4; ++d0) qr[d0] = *reinterpret_cast<const bf16x8*>(&Qw[(long)r32 * DMQ + d0 * 16 + hi * 8]);
  unsigned selm = 0u;
  if (qb > 0) {
    float* kmL = (float*)(shm + LDS_OST);
    const float* kmg = kmean + ((size_t)(b * 8 + h) * 16) * 64;
    for (int i = tid; i < qb * 64; i += 512) kmL[i] = kmg[i];
    asm volatile("s_waitcnt vmcnt(0) lgkmcnt(0)\n\ts_barrier" ::: "memory");
    float qf[32];
    #pragma unroll
    for (int d0 = 0; d0 < 4; ++d0)
      #pragma unroll
      for (int e = 0; e < 8; ++e) qf[8 * d0 + e] = __uint_as_float(((unsigned)(unsigned short)qr[d0][e]) << 16);
    float b0 = -INFINITY, b1 = -INFINITY, b2 = -INFINITY; int i0 = -1, i1 = -1, i2 = -1;
    for (int j = 0; j < qb; ++j) {
      const float* km = kmL + j * 64 + 8 * hi; float sc = 0.f;
      #pragma unroll
      for (int d0 = 0; d0 < 4; ++d0)
        #pragma unroll
        for (int e = 0; e < 8; ++e) sc += qf[8 * d0 + e] * km[16 * d0 + e];
      sc += __shfl_xor(sc, 32);
      if (sc > b0) { b2 = b1; i2 = i1; b1 = b0; i1 = i0; b0 = sc; i0 = j; } else if (sc > b1) { b2 = b1; i2 = i1; b1 = sc; i1 = j; } else if (sc > b2) { b2 = sc; i2 = j; }
    }
    if (i0 >= 0) selm |= 1u << i0; if (i1 >= 0) selm |= 1u << i1; if (i2 >= 0) selm |= 1u << i2;
    asm volatile("s_waitcnt lgkmcnt(0)\n\ts_barrier" ::: "memory");
  }
  if (hi == 0) ((unsigned*)wsf)[64 + r32] = selm;
  { const lds_ptr qst = (lds_ptr)shm + LDS_OST + wid * 4096 + lane * 16;
    #pragma unroll
    for (int d0 = 0; d0 < 4; ++d0) *(__attribute__((address_space(3))) bf16x8*)(qst + d0 * 1024) = qr[d0]; }
  #define SELROW(j) (((j) >= qb) || ((((const unsigned*)wsf)[64 + r32] >> (j)) & 1u))
  #define NEGM_SET(blk) do { const float nv_ = SELROW(blk) ? -mhat : NEGB; _Pragma("unroll") for (int r = 0; r < 16; ++r) negm[r] = nv_; asm volatile("" : "+v"(negm)); } while (0)
  const int vb0 = (int)(lds0 + LDS_V) + ((lane >> 4) & 1) * 32 + (lane & 3) * 8 + (4 * hi + ((lane & 15) >> 2)) * 64;
  const char* Kbase = shm + LDS_K; bf16x8 kf[8];
  const lds_cptr qp0 = (lds_cptr)shm + LDS_OST + wid * 4096 + lane * 16;
  const lds_cptr shm3 = (lds_cptr)shm; const lds_cptr kp0 = shm3 + LDS_K + hi * 1024 + r32 * 16; const lds_cptr vp0 = shm3 + LDS_V + ((lane >> 4) & 1) * 32 + (lane & 3) * 8 + (4 * hi + ((lane & 15) >> 2)) * 64;
  const int NT = (q0 + QB) / KVBLK;
  float mhat = 0.f, l_reg = 0.f; f32x16 o[2]; o[0] = f32x16{}; o[1] = f32x16{}; f32x16 negm;
  NEGM_SET(0);
  const int qrel = wid * QBLK + r32;
  #define CMASK(P0, P1, t) do { int jb_ = (t) - (NT - 4); if (jb_ >= 0) cmask(P0, P1, jb_, qrel, hi); } while (0)
  bool resc = false;
  #define START(P0, P1) do { const float rm = rowmax(P0, P1); resc = false; \
    { const float dl = SELROW(0) ? rm : 0.f; mhat = fadd_s(mhat, dl); \
      _Pragma("unroll") for (int r = 0; r < 16; ++r) { P0[r] = fsub_s(P0[r], dl); P1[r] = fsub_s(P1[r], dl); } \
      NEGM_SET(0); } \
    _Pragma("unroll") for (int r = 0; r < 16; ++r) P0[r] = __builtin_amdgcn_exp2f(P0[r]); } while (0)
  #define RESC() do { if (resc) { asm volatile("s_waitcnt lgkmcnt(0)" ::: "memory"); \
      _Pragma("unroll") for (int d_ = 0; d_ < 2; ++d_) _Pragma("unroll") for (int r = 0; r < 16; ++r) o[d_][r] *= wsf[crow(r, hi)]; } } while (0)
  f32x16 pA0, pA1, pB0, pB1;
  int sl_prev = 0, sl_cur = 0, sl_next = SLOTB;
  #define ROT() do { sl_prev = sl_cur; sl_cur = sl_next; sl_next = (sl_next == (NSLOT - 1) * SLOTB) ? 0 : sl_next + SLOTB; } while (0)
  DMA_K(2, 2 * SLOTB);
  WAIT_BAR(3);
  qkt(pA0, pA1, Kbase, qr, negm, r32, hi); asm volatile("s_nop 15\n\ts_nop 7" : "+v"(pA0), "+v"(pA1)); CMASK(pA0, pA1, 0);
  START(pA0, pA1);
  _Pragma("unroll") for (int r = 0; r < 16; ++r) pA1[r] = __builtin_amdgcn_exp2f(pA1[r]);
  WAIT_BAR(0);
  DMA_K(3, 0); DMA_V(1, SLOTB);
  ROT();
  kload8(kf, kp0 + sl_cur);
  WAIT_BAR(2);
  s16x4 vlo[8], vhi[8]; u32x4 pw0, pw1, pw2, pw3; bf16x8 q0_, q1_, q2_, q3_;
  #define QRD(d) do { q##d##_ = *(const __attribute__((address_space(3))) bf16x8*)(qp0 + (d) * 1024); } while (0)
  QRD(0); QRD(1);
  #define PKW(P, B) cvtpk_s(P[B], P[B + 1])
  #define PAF(k) __builtin_bit_cast(bf16x8, pw##k)
  #define VFR(i) (bf16x8){vlo[i][0], vlo[i][1], vlo[i][2], vlo[i][3], vhi[i][0], vhi[i][1], vhi[i][2], vhi[i][3]}
  #define PIN(x) asm volatile("" : "+v"(x))
  #define MX3(a, b, c) __builtin_fmaxf(__builtin_fmaxf((a), (b)), (c))
  #define GAPA(MF, A0, A1, A2, A3, W0, W1, PW) do { MF; sacc += A0; sacc += A1; sacc += A2; sacc += A3; PIN(sacc); W0; W1; PIN(PW); SBAR(); } while (0)
  #define EX(v) __builtin_amdgcn_exp2f(v)
  #define GAPB(MF, X, B) do { MF; X[B] = EX(X[B]); X[B + 1] = EX(X[B + 1]); X[B + 2] = EX(X[B + 2]); X[B + 3] = EX(X[B + 3]); PIN(X); SBAR(); } while (0)
  #define VRD(i) do { vlo[i] = vtr(vp_ + (((i) >> 2) * 4096 + ((i) & 3) * 1024)); vhi[i] = vtr(vp_ + (((i) >> 2) * 4096 + ((i) & 3) * 1024 + 512)); } while (0)
  #define KRD(G, j) do { if (G) { kload2(kf, kp0 + sl_next, j); SBAR(); } } while (0)
  #define STEP(C0, C1, P0, P1, t, GK, GV, GL) do { SBAR(); \
    const lds_cptr vp_ = vp0 + sl_prev; \
    VRD(0); SBAR(); float sacc = (P0[0] + P0[1]); \
    GAPA(C0 = __builtin_amdgcn_mfma_f32_32x32x16_bf16(kf[0], q0_, negm, 0, 0, 0), P0[2], P0[3], P0[4], P0[5],     pw0[0] = PKW(P0, 0), pw0[1] = PKW(P0, 2), pw0); \
    VRD(4); SBAR(); GAPA(C1 = __builtin_amdgcn_mfma_f32_32x32x16_bf16(kf[1], q0_, negm, 0, 0, 0), P0[6], P0[7], P0[8], P0[9],     pw0[2] = PKW(P0, 4), pw0[3] = PKW(P0, 6), pw0); \
    QRD(2); SBAR(); \
    VRD(1); SBAR(); GAPA(C0 = __builtin_amdgcn_mfma_f32_32x32x16_bf16(kf[2], q1_, C0, 0, 0, 0),   P0[10], P0[11], P0[12], P0[13], pw1[0] = PKW(P0, 8), pw1[1] = PKW(P0, 10), pw1); \
    VRD(5); SBAR(); GAPA(C1 = __builtin_amdgcn_mfma_f32_32x32x16_bf16(kf[3], q1_, C1, 0, 0, 0),   P0[14], P0[15], P1[0], P1[1],   pw1[2] = PKW(P0, 12), pw1[3] = PKW(P0, 14), pw1); \
    QRD(3); SBAR(); \
    VRD(2); SBAR(); GAPA(C0 = __builtin_amdgcn_mfma_f32_32x32x16_bf16(kf[4], q2_, C0, 0, 0, 0),   P1[2], P1[3], P1[4], P1[5],     pw2[0] = PKW(P1, 0), pw2[1] = PKW(P1, 2), pw2); \
    VRD(6); SBAR(); GAPA(C1 = __builtin_amdgcn_mfma_f32_32x32x16_bf16(kf[5], q2_, C1, 0, 0, 0),   P1[6], P1[7], P1[8], P1[9],     pw2[2] = PKW(P1, 4), pw2[3] = PKW(P1, 6), pw2); \
    VRD(3); SBAR(); GAPA(C0 = __builtin_amdgcn_mfma_f32_32x32x16_bf16(kf[6], q3_, C0, 0, 0, 0),   P1[10], P1[11], P1[12], P1[13], pw3[0] = PKW(P1, 8), pw3[1] = PKW(P1, 10), pw3); \
    VRD(7); SBAR(); GAPA(C1 = __builtin_amdgcn_mfma_f32_32x32x16_bf16(kf[7], q3_, C1, 0, 0, 0),   P1[14], P1[15], 0.f, 0.f,       pw3[2] = PKW(P1, 12), pw3[3] = PKW(P1, 14), pw3); \
    l_reg += sacc; \
    if (GK) { DMA_K((t) + 3, sl_cur); } if (GV) { DMA_V((t) + 1, sl_next); } \
    CMASK(C0, C1, t); \
    { float a = MX3(C0[0], C0[1], C1[0]), b = MX3(C0[2], C0[3], C1[1]); a = MX3(a, C1[2], C1[3]); \
      _Pragma("unroll") for (int r = 4; r < 16; r += 4) { a = MX3(a, C0[r], C0[r + 1]); b = MX3(b, C0[r + 2], C0[r + 3]); a = MX3(a, C1[r], C1[r + 1]); b = MX3(b, C1[r + 2], C1[r + 3]); } \
      float rm = __builtin_fmaxf(a, b); { auto rr = __builtin_amdgcn_permlane32_swap(__float_as_uint(rm), __float_as_uint(rm), false, false); rm = __builtin_fmaxf(__uint_as_float(rr[0]), __uint_as_float(rr[1])); } \
      resc = false; \
      if (__builtin_expect(__any(rm > (float)THRL), 0)) { const float dl = __builtin_fmaxf(rm, 0.f); mhat += dl; \
        _Pragma("unroll") for (int r = 0; r < 16; ++r) { C0[r] -= dl; C1[r] -= dl; } \
        NEGM_SET(((t) + 1) >> 2); \
        const float f = __builtin_amdgcn_exp2f(-dl); l_reg *= f; if (hi == 0) wsf[r32] = f; resc = true; } \
      else if ((((t) + 1) & 3) == 0) { NEGM_SET(((t) + 1) >> 2); } } \
    SBAR(); \
    GAPB(o[0] = __builtin_amdgcn_mfma_f32_32x32x16_bf16(PAF(0), VFR(0), o[0], 0, 0, 0), C0, 0); \
    GAPB(o[1] = __builtin_amdgcn_mfma_f32_32x32x16_bf16(PAF(0), VFR(4), o[1], 0, 0, 0), C0, 4); \
    KRD(GL, 0); GAPB(o[0] = __builtin_amdgcn_mfma_f32_32x32x16_bf16(PAF(1), VFR(1), o[0], 0, 0, 0), C0, 8); \
    KRD(GL, 1); GAPB(o[1] = __builtin_amdgcn_mfma_f32_32x32x16_bf16(PAF(1), VFR(5), o[1], 0, 0, 0), C0, 12); \
    KRD(GL, 2); GAPB(o[0] = __builtin_amdgcn_mfma_f32_32x32x16_bf16(PAF(2), VFR(2), o[0], 0, 0, 0), C1, 0); \
    KRD(GL, 3); GAPB(o[1] = __builtin_amdgcn_mfma_f32_32x32x16_bf16(PAF(2), VFR(6), o[1], 0, 0, 0), C1, 4); \
    GAPB(o[0] = __builtin_amdgcn_mfma_f32_32x32x16_bf16(PAF(3), VFR(3), o[0], 0, 0, 0), C1, 8); \
    GAPB(o[1] = __builtin_amdgcn_mfma_f32_32x32x16_bf16(PAF(3), VFR(7), o[1], 0, 0, 0), C1, 12); \
    QRD(0); QRD(1); SBAR(); \
    } while (0)
  int t = 1;
  #undef CMASK
  #define CMASK(P0, P1, t) do {} while (0)
  for (; t + 5 < NT; t += 2) {
    STEP(pB0, pB1, pA0, pA1, t, true, true, true);     WAIT_BAR(2); RESC(); ROT();
    STEP(pA0, pA1, pB0, pB1, t + 1, true, true, true); WAIT_BAR(2); RESC(); ROT();
  }
  #undef CMASK
  #define CMASK(P0, P1, t) do { int jb_ = (t) - (NT - 4); if (jb_ >= 0) cmask(P0, P1, jb_, qrel, hi); } while (0)
  #define ENDW(tt) do { if ((tt) + 3 < NT) { WAIT_BAR(2); } else if ((tt) + 2 < NT) { WAIT_BAR(1); } else { WAIT_BAR(0); } } while (0)
  for (; t + 1 < NT; t += 2) {
    STEP(pB0, pB1, pA0, pA1, t, (t + 3 < NT), (t + 1 < NT), (t + 1 < NT));       ENDW(t);     RESC(); ROT();
    STEP(pA0, pA1, pB0, pB1, t + 1, (t + 4 < NT), (t + 2 < NT), (t + 2 < NT));   ENDW(t + 1); RESC(); ROT();
  }
  STEP(pB0, pB1, pA0, pA1, NT - 1, false, false, false); RESC();
  { float sacc = pB0[0] + pB0[1]; _Pragma("unroll") for (int r = 2; r < 16; ++r) sacc += pB0[r]; _Pragma("unroll") for (int r = 0; r < 16; ++r) sacc += pB1[r]; l_reg += sacc;
    pw0 = (u32x4){PKW(pB0, 0), PKW(pB0, 2), PKW(pB0, 4), PKW(pB0, 6)}; pw1 = (u32x4){PKW(pB0, 8), PKW(pB0, 10), PKW(pB0, 12), PKW(pB0, 14)}; pw2 = (u32x4){PKW(pB1, 0), PKW(pB1, 2), PKW(pB1, 4), PKW(pB1, 6)}; pw3 = (u32x4){PKW(pB1, 8), PKW(pB1, 10), PKW(pB1, 12), PKW(pB1, 14)};
    SBAR(); pv(o, vb0 + sl_cur, PAF(0), PAF(1), PAF(2), PAF(3)); }
  #undef PKW
  #undef PAF
  #undef VFR
  #undef PIN
  #undef MX3
  #undef GAPA
  #undef GAPB
  #undef EX
  #undef VRD
  #undef KRD
  #undef QRD
  #undef STEP
  #undef ENDW
  { auto rr = __builtin_amdgcn_permlane32_swap(__float_as_uint(l_reg), __float_as_uint(l_reg), false, false); l_reg = __uint_as_float(rr[0]) + __uint_as_float(rr[1]); }
  if (hi == 0) wsf[32 + r32] = l_reg; asm volatile("s_waitcnt lgkmcnt(0)" ::: "memory");
  float rli[16];
  #pragma unroll
  for (int r = 0; r < 16; ++r) rli[r] = __builtin_amdgcn_rcpf(wsf[32 + crow(r, hi)]);
  bf16_t* Ow = Ob + (rowbase + q0 + wid * QBLK) * DMQ + h * D;
  { bf16_t* stg = (bf16_t*)(shm + LDS_OST) + wid * 2048;
    #pragma unroll
    for (int r = 0; r < 16; ++r) { const int orow = crow(r, hi);
      #pragma unroll
      for (int d0 = 0; d0 < 2; ++d0) stg[orow * 64 + d0 * 32 + r32] = (bf16_t)f2bf(o[d0][r] * rli[r]); }
    asm volatile("s_waitcnt lgkmcnt(0)" ::: "memory");
    #pragma unroll
    for (int i = 0; i < 4; ++i) { const int row = i * 8 + (lane >> 3), ch = lane & 7; const u32x4 v = *(const u32x4*)(stg + row * 64 + ch * 8); ATTN_STORE16(Ow + (long)row * DMQ + ch * 8, v); } }
  asm volatile("s_waitcnt lgkmcnt(0)\n\ts_barrier" ::: "memory");
  #undef DMA_K
  #undef DMA_V
  #undef CMASK
  #undef START
  #undef RESC
  #undef ROT
  #undef SELROW
  #undef NEGM_SET
}
#undef SBAR
#undef WAIT_BAR
}
__device__ __forceinline__ void conv_pass(Frame& F) {
    bf16_t* YAB = WSP(bf16_t, WS_YAB); const bf16_t* U = WSP(bf16_t, WS_U); const bf16_t* BG = WSP(bf16_t, WS_BG);
    const int stride = F.G * NTHREADS;
    for (int i0 = blockIdx.x * NTHREADS + F.tid; i0 < T * 64; i0 += 2 * stride) {
        u32x4 r2[2], r1[2], r0[2], rb[2];
#pragma unroll
        for (int q = 0; q < 2; ++q) { const int i = i0 + q * stride; const int t = i >> 6, c0 = (i & 63) * 8, pos = t & (S - 1);
            r2[q] = *(const u32x4*)(U + (size_t)t * 512 + c0); rb[q] = __builtin_nontemporal_load((const u32x4*)(BG + (size_t)t * 512 + c0));
            r1[q] = (pos >= 1) ? *(const u32x4*)(U + (size_t)(t - 1) * 512 + c0) : (u32x4){0u, 0u, 0u, 0u};
            r0[q] = (pos >= 2) ? *(const u32x4*)(U + (size_t)(t - 2) * 512 + c0) : (u32x4){0u, 0u, 0u, 0u}; }
#pragma unroll
        for (int q = 0; q < 2; ++q) { const int i = i0 + q * stride; const int t = i >> 6, c0 = (i & 63) * 8;
            float u0[8], u1[8], u2[8], bg[8], y[8]; unpack8(r2[q], u2); unpack8(r1[q], u1); unpack8(r0[q], u0); unpack8(rb[q], bg);
#pragma unroll
            for (int e4 = 0; e4 < 2; ++e4) { const f32x4 w0 = *(const f32x4*)(F.conv_w + c0 + 4 * e4), w1 = *(const f32x4*)(F.conv_w + 512 + c0 + 4 * e4), w2 = *(const f32x4*)(F.conv_w + 1024 + c0 + 4 * e4), cb = *(const f32x4*)(F.conv_b + c0 + 4 * e4);
#pragma unroll
                for (int e = 0; e < 4; ++e) y[4 * e4 + e] = bg[4 * e4 + e] * (w0[e] * u0[4 * e4 + e] + w1[e] * u1[4 * e4 + e] + w2[e] * u2[4 * e4 + e] + cb[e]); }
            st16(YAB + (size_t)t * 1024 + 512 + c0, pack8(y)); }
    }
}
__device__ __forceinline__ void s3_attn(Frame& F, char* lds_gen, bf16_t* obase) {
    const int vcu = (blockIdx.x % 8) * (F.G / 8) + blockIdx.x / 8;
    const int s = vcu & 7, pr = vcu >> 3;
#pragma unroll 1
    for (int i = 0; i < 4; ++i) {
        const int bh = 2 * pr + (i >> 1), qb = (i & 1) ? 15 - s : s;
        attn_body::attn_unit<8>(bh >> 3, bh & 7, qb, WSP(bf16_t, WS_YAB), obase, WSP(bf16_t, WS_K), WSP(bf16_t, WS_V), WSP(float, WS_KMEAN), lds_gen);
        if (!(i & 1)) { { int t_ = threadIdx.x; asm volatile("" : "+v"(t_)); F.tid = t_; F.lane = t_ & 63; }
            const int lo = X_NONEXP + (i >> 1) * (NE * 256);
            convert_items(F, lo, lo + NE * 256, blockIdx.x * NWAVES + F.wave, F.G * NWAVES);
            __syncthreads(); }
    }
}
__device__ __forceinline__ void s3_fast(Frame& F, char* lds_gen) { s3_attn(F, lds_gen, WSP(bf16_t, WS_YAB)); conv_pass(F); }

__device__ __forceinline__ void s4_simple(Frame& F) {
    LAS float* tile = (LAS float*)F.lds; LAS float* tile2 = tile + 64 * 65;
    const bf16_t* YAB = WSP(bf16_t, WS_YAB); const bf16_t* WP = WSP(bf16_t, WS_WP_T); const bf16_t* GT = WSP(bf16_t, WS_GATES);
    const int row = F.tid >> 3, seg = F.tid & 7;
    for (int it = blockIdx.x; it < 512 * 16; it += F.G) {
        const int rt = it >> 4, ct = it & 15, r0 = rt * 64, gr = r0 + row;
        const RowsLinear aa{YAB + (size_t)r0 * 1024, 1024}, ab{YAB + (size_t)r0 * 1024 + 512, 1024};
        const RowsLinear ba{WP + (size_t)(64 * ct) * 1024, 1024}, bb{WP + (size_t)(64 * ct) * 1024 + 512, 1024};
        sgemm_tile(tile, 512, aa, ba, F.wave, F.lane); sgemm_tile(tile2, 512, ab, bb, F.wave, F.lane); __syncthreads();
        float ga[8], gb[8], v[8];
        unpack8(*(const u32x4*)(GT + (size_t)gr * 2048 + 64 * ct + 8 * seg), ga); unpack8(*(const u32x4*)(GT + (size_t)gr * 2048 + 1024 + 64 * ct + 8 * seg), gb);
#pragma unroll
        for (int e = 0; e < 8; ++e) v[e] = ga[e] * tile[row * 65 + 8 * seg + e] + gb[e] * tile2[row * 65 + 8 * seg + e];
        *(u32x4*)(WSP(bf16_t, WS_H) + (size_t)gr * 1024 + 64 * ct + 8 * seg) = pack8(v);
        __syncthreads();
    }
}
__device__ __forceinline__ void s5_simple(Frame& F) {
    LAS float* tile = (LAS float*)F.lds;
    const bf16_t* MG = WSP(bf16_t, WS_H); const bf16_t* WO = WSP(bf16_t, WS_WO_T);
    const int row = F.tid >> 3, seg = F.tid & 7;
    for (int it = blockIdx.x; it < 512 * 16; it += F.G) {
        const int rt = it >> 4, ct = it & 15, r0 = rt * 64, gr = r0 + row, b = r0 / S;
        const RowsLinear aa{MG + (size_t)r0 * 1024, 1024}, bb{WO + (size_t)(64 * ct) * 1024, 1024};
        sgemm_tile(tile, 1024, aa, bb, F.wave, F.lane); __syncthreads();
        const float* ga1 = WSP(float, WS_MOD) + (size_t)b * NMOD + 2048 + 64 * ct + 8 * seg;
        const float* xr = F.x + (size_t)gr * D + 64 * ct + 8 * seg; float* orow = F.out + (size_t)gr * D + 64 * ct + 8 * seg;
#pragma unroll
        for (int e4 = 0; e4 < 2; ++e4) { const f32x4 xv = *(const f32x4*)(xr + 4 * e4), gv = *(const f32x4*)(ga1 + 4 * e4); f32x4 o;
#pragma unroll
            for (int e = 0; e < 4; ++e) o[e] = xv[e] + gv[e] * tile[row * 65 + 8 * seg + 4 * e4 + e];
            *(f32x4*)(orow + 4 * e4) = o; }
        __syncthreads();
    }
}

struct EpiG2 {
    static constexpr bool HAS_MID = true;
    const bf16_t* gates; bf16_t* merged;
    struct State {};
    __device__ __forceinline__ void mid(Acc& acc, const pg8::Unit& u, int wr, int wc, int fr, int fq, State&) const {
        int rl0 = wr * 64 + fr; const int ct = 32 * wc + 8 * fq; asm volatile("" : "+v"(rl0));
        u32x4 ra[2][4][2];
#pragma unroll
        for (int ai = 0; ai < 2; ++ai)
#pragma unroll
            for (int m = 0; m < 4; ++m) { const bf16_t* gp = gates + ((size_t)(u.pm * 4 + u.pn) * 256 + (size_t)(rl0 + 128 * ai + 16 * m)) * 256 + ct;
#pragma unroll
                for (int bj = 0; bj < 2; ++bj) ra[ai][m][bj] = *(const u32x4*)(gp + 128 * bj); }
        asm volatile("s_waitcnt vmcnt(0)" ::: "memory");
#pragma unroll
        for (int ai = 0; ai < 2; ++ai)
#pragma unroll
            for (int m = 0; m < 4; ++m)
#pragma unroll
                for (int bj = 0; bj < 2; ++bj) { f32x4 a0, a1; unpack8v(ra[ai][m][bj], a0, a1); acc[ai][bj][m][0] *= a0; acc[ai][bj][m][1] *= a1; }
    }
    __device__ __forceinline__ void operator()(Acc& acc, const pg8::Unit& u, int wr, int wc, int fr, int fq, State&) const {
        int rl0 = wr * 64 + fr; const int ct = 32 * wc + 8 * fq, c0 = u.pn * 256 + ct; asm volatile("" : "+v"(rl0)); const int row0 = u.pm * 256 + rl0;
        u32x4 gb[2][4][2];
#pragma unroll
        for (int ai = 0; ai < 2; ++ai)
#pragma unroll
            for (int m = 0; m < 4; ++m) { const bf16_t* gp = gates + (size_t)T * 1024 + ((size_t)(u.pm * 4 + u.pn) * 256 + (size_t)(rl0 + 128 * ai + 16 * m)) * 256 + ct;
#pragma unroll
                for (int bj = 0; bj < 2; ++bj) gb[ai][m][bj] = *(const u32x4*)(gp + 128 * bj); }
        asm volatile("s_waitcnt vmcnt(0)" ::: "memory");
#pragma unroll
        for (int ai = 0; ai < 2; ++ai)
#pragma unroll
            for (int m = 0; m < 4; ++m) { const size_t r = (size_t)(row0 + 128 * ai + 16 * m);
#pragma unroll
                for (int bj = 0; bj < 2; ++bj) { f32x4 b0, b1; unpack8v(gb[ai][m][bj], b0, b1);
                    *(u32x2*)((unsigned char*)merged + r * 1024 + c0 + 128 * bj) = pack8_fp8(acc[ai][bj][m][0] * b0, acc[ai][bj][m][1] * b1); } }
    }
};
__device__ __forceinline__ void s4_fast(Frame& F) {
    const pg8::DenseSched Sd{(const char*)(F.ws + WS_YAB), (const char*)(F.ws + WS_WP_T), T / 256, 4, 1024, F.G, (int)blockIdx.x};
    const EpiG2 E{WSP(bf16_t, WS_GATES), WSP(bf16_t, WS_H)};
    if (F.skip) pg8::gemm_phase<EpiG2, pg8::DenseSched, true>(F.lds, 1024, Sd, E); else pg8::gemm_phase<EpiG2, pg8::DenseSched>(F.lds, 1024, Sd, E);
}
struct EpiG3 {
    static constexpr bool HAS_MID = false;
    const float* x; bf16_t* x1; const float* mod;
    struct State {}; __device__ __forceinline__ void mid(Acc&, const pg8::Unit&, int, int, int, int, State&) const {}
    __device__ __forceinline__ void operator()(Acc& acc, const pg8::Unit& u, int wr, int wc, int fr, int fq, State& st) const {
        int row0 = u.pm * 256 + wr * 64 + fr; const int c0 = u.pn * 256 + 32 * wc + 8 * fq, b = u.pm >> 4; asm volatile("" : "+v"(row0));
        f32x4 gv[2][2];
#pragma unroll
        for (int bj = 0; bj < 2; ++bj)
#pragma unroll
            for (int n = 0; n < 2; ++n) gv[bj][n] = *(const f32x4*)(mod + (size_t)b * NMOD + 2048 + c0 + 128 * bj + 4 * n) * (1.f / W8_SCALE);
#pragma unroll
        for (int ai = 0; ai < 2; ++ai)
#pragma unroll
            for (int m = 0; m < 4; ++m) { const size_t off = (size_t)(row0 + 128 * ai + 16 * m) * D + c0;
#pragma unroll
                for (int bj = 0; bj < 2; ++bj) { const f32x4 x0 = __builtin_nontemporal_load((const f32x4*)(x + off + 128 * bj)), x1v = __builtin_nontemporal_load((const f32x4*)(x + off + 128 * bj + 4));
                    st16(x1 + off + 128 * bj, pack8v(x0 + gv[bj][0] * acc[ai][bj][m][0], x1v + gv[bj][1] * acc[ai][bj][m][1])); }
                if (m == 3) asm volatile("" ::: "memory"); }
    }
};
__device__ __forceinline__ void s5_fast(Frame& F) {
    const pg8::DenseSched8 Sd{(const char*)(F.ws + WS_H), (const char*)(F.ws + WS_WO_T), T / 256, 4, 1024, F.G, (int)blockIdx.x};
    const EpiG3 E{F.x, WSP(bf16_t, WS_X1), WSP(float, WS_MOD)};
    int Ko = D; asm volatile("" : "+s"(Ko));
    pg8::gemm_phase<EpiG3, pg8::DenseSched8>(F.lds, Ko, Sd, E);
}
struct MoeTab { const LAS int* cnt; const LAS int* tstart; const LAS int* tile_e; int nM; };
__device__ __forceinline__ MoeTab moe_table(Frame& F) {
    LAS int* cntL = (LAS int*)(F.lds + MISC_OFF + 1024); LAS int* ts = cntL + 32; LAS int* te = cntL + 96;
    if (F.tid < 32) cntL[F.tid] = (int)__hip_atomic_load(WSP(unsigned, WS_CTL) + CW_GCNT + 64 * F.tid, __ATOMIC_RELAXED, __HIP_MEMORY_SCOPE_AGENT);
    __syncthreads();
    if (F.tid == 0) { int pm = 0; for (int e = 0; e < 32; ++e) { ts[e] = pm; const int n = (cntL[e] + 255) >> 8; for (int i = 0; i < n; ++i) te[pm++] = e; } ts[32] = pm; }
    __syncthreads();
    return MoeTab{cntL, ts, te, ts[32]};
}
struct MoeUpSched {
    static constexpr bool GATHER = true, FP8 = true;
    const char* h2; const char* w13; MoeTab tb; const int* linfo; int G, c;
    __device__ __forceinline__ bool next(int i, pg8::Unit& u) const { if (!pg8::static_unit(i, G, c, tb.nM, 4, u.pm, u.pn)) return false;
        u.e = tb.tile_e[u.pm]; u.rbase = (u.pm - tb.tstart[u.e]) * 256; u.a = h2; u.b = w13 + ((size_t)u.e * 1024 + 256 * u.pn) * 1024; return true; }
    __device__ __forceinline__ int row_index(const pg8::Unit& u, int r) const { const int rank = u.rbase + r; return rank < tb.cnt[u.e] ? (linfo[(size_t)u.e * 65536 + rank] >> 1) : 0; }
};
struct EpiUp {
    static constexpr bool HAS_MID = false;
    bf16_t* hid; const float* lw; const LAS int* cnt;
    struct State {}; __device__ __forceinline__ void mid(Acc&, const pg8::Unit&, int, int, int, int, State&) const {}
    __device__ __forceinline__ void operator()(Acc& acc, const pg8::Unit& u, int wr, int wc, int fr, int fq, State& st) const {
        int rl0 = wr * 64 + fr; const int c0 = u.pn * 128 + 32 * wc + 8 * fq, n_e = cnt[u.e]; asm volatile("" : "+v"(rl0));
#pragma unroll
        for (int ai = 0; ai < 2; ++ai)
#pragma unroll
            for (int m = 0; m < 4; ++m) { const int rl = rl0 + 128 * ai + 16 * m, rank = u.rbase + rl; const float wt = rank < n_e ? 1.f : 0.f; f32x4 o[2];
#pragma unroll
                for (int n = 0; n < 2; ++n)
#pragma unroll
                    for (int e = 0; e < 4; ++e) { const float a = acc[ai][0][m][n][e] * (1.f / W8_SCALE), c = acc[ai][1][m][n][e] * (1.f / W8_SCALE); o[n][e] = a * __builtin_amdgcn_rcpf(1.f + __expf(-a)) * c * wt; }
                *(u32x2*)((unsigned char*)hid + (size_t)(u.pm * 256 + rl) * 512 + c0) = pack8_fp8(o[0], o[1]); }
    }
};
__device__ __forceinline__ void s8_fast(Frame& F) {
    const MoeTab tb = moe_table(F);
    const MoeUpSched Sd{(const char*)(F.ws + WS_H2), (const char*)(F.ws + WS_W13_T), tb, WSP(int, WS_LINFO), F.G, (int)blockIdx.x};
    const EpiUp E{WSP(bf16_t, WS_HID), WSP(float, WS_LW), tb.cnt};
    int Ku = D; asm volatile("" : "+s"(Ku));
    if (F.skip) pg8::gemm_phase<EpiUp, MoeUpSched, true>(F.lds, Ku, Sd, E); else pg8::gemm_phase<EpiUp, MoeUpSched>(F.lds, Ku, Sd, E);
    { int t_ = threadIdx.x; asm volatile("" : "+v"(t_)); F.tid = t_; F.lane = t_ & 63; }
    { const int units = tb.nM * 4, rem = units % F.G, nidle = (rem == 0) ? F.G : F.G - rem, me = (rem == 0) ? (int)blockIdx.x : (int)blockIdx.x - rem;
        if (me >= 0 && !F.skip) convert_items(F, X_W2, X_END, me * NWAVES + F.wave, nidle * NWAVES); }
}
struct MoeDownSched {
    static constexpr bool GATHER = false, FP8 = true;
    const char* hid; const char* w2; MoeTab tb; int G, c;
    __device__ __forceinline__ bool next(int i, pg8::Unit& u) const { if (!pg8::static_unit(i, G, c, tb.nM, 4, u.pm, u.pn)) return false;
        u.e = tb.tile_e[u.pm]; u.rbase = (u.pm - tb.tstart[u.e]) * 256; u.a = hid + (size_t)u.pm * 256 * 512; u.b = w2 + ((size_t)u.e * 1024 + 256 * u.pn) * 512; return true; }
    __device__ __forceinline__ int row_index(const pg8::Unit&, int) const { return 0; }
};
struct EpiDown {
    static constexpr bool HAS_MID = false;
    bf16_t* yslot; const int* linfo; const float* lw; const LAS int* cnt;
    struct State {}; __device__ __forceinline__ void mid(Acc&, const pg8::Unit&, int, int, int, int, State&) const {}
    __device__ __forceinline__ void operator()(Acc& acc, const pg8::Unit& u, int wr, int wc, int fr, int fq, State& st) const {
        int rl0 = wr * 64 + fr; const int c0 = u.pn * 256 + 32 * wc + 8 * fq, n_e = cnt[u.e]; asm volatile("" : "+v"(rl0));
        int info[2][4]; float wt[2][4];
#pragma unroll
        for (int ai = 0; ai < 2; ++ai)
#pragma unroll
            for (int m = 0; m < 4; ++m) { const int rank = u.rbase + rl0 + 128 * ai + 16 * m, rc = rank < n_e ? rank : 0;
                info[ai][m] = linfo[(size_t)u.e * 65536 + rc]; wt[ai][m] = lw[(size_t)u.e * 65536 + rc] * (1.f / W8_SCALE); }
#pragma unroll
        for (int ai = 0; ai < 2; ++ai)
#pragma unroll
            for (int m = 0; m < 4; ++m) { const int rank = u.rbase + rl0 + 128 * ai + 16 * m;
                if (rank < n_e) {
#pragma unroll
                    for (int bj = 0; bj < 2; ++bj) st16(yslot + (size_t)info[ai][m] * 1024 + c0 + 128 * bj, pack8v(acc[ai][bj][m][0] * wt[ai][m], acc[ai][bj][m][1] * wt[ai][m])); } }
    }
};
__device__ __forceinline__ void s9_fast(Frame& F) {
    const MoeTab tb = moe_table(F);
    const MoeDownSched Sd{(const char*)(F.ws + WS_HID), (const char*)(F.ws + WS_W2_T), tb, F.G, (int)blockIdx.x};
    const EpiDown E{WSP(bf16_t, WS_YSLOT), WSP(int, WS_LINFO), WSP(float, WS_LW), tb.cnt};
    int Kd = DE; asm volatile("" : "+s"(Kd));
    if (F.skip) pg8::gemm_phase<EpiDown, MoeDownSched, true>(F.lds, Kd, Sd, E); else pg8::gemm_phase<EpiDown, MoeDownSched>(F.lds, Kd, Sd, E);
}

__device__ __forceinline__ void s6_router(Frame& F) {
    constexpr int WROW = 1032;
    LAS bf16_t* WT = (LAS bf16_t*)F.lds;
    LAS float* gsL = (LAS float*)(F.lds + 48 * WROW * 2);
    LAS float* shL = gsL + 1024;
    LAS float* biasL = shL + 1024;
    LAS float* lgt = biasL + 64;
    LAS int* cnt = (LAS int*)(F.lds + MISC_OFF + 256);
    LAS int* baseL = cnt + 32; LAS int* runL = cnt + 64; LAS int* eidL = cnt + 128; LAS float* ewL = (LAS float*)(cnt + 384);
    const int b = blockIdx.x >> 5;
    const float* mod = WSP(float, WS_MOD) + (size_t)b * NMOD;
    const float* W36 = WSP(float, WS_W36T);
    for (int i = F.tid; i < 36 * 256; i += NTHREADS) { const int jj = i >> 8, k4 = (i & 255) * 4; const f32x4 w = *(const f32x4*)(W36 + jj * 1024 + k4);
        u32x2 p; p.x = pk2(w.x, w.y); p.y = pk2(w.z, w.w); *(LAS u32x2*)(WT + jj * WROW + k4) = p; }
    for (int i = F.tid; i < 12 * 256; i += NTHREADS) { const int jj = 36 + (i >> 8), k4 = (i & 255) * 4; *(LAS u32x2*)(WT + jj * WROW + k4) = (u32x2){0u, 0u}; }
    if (F.tid < 256) { const int col = 4 * F.tid; const f32x4 g = *(const f32x4*)(F.g2 + col), s_ = *(const f32x4*)(mod + 4096 + col); *(LAS f32x4*)(gsL + col) = g * (s_ + 1.0f); *(LAS f32x4*)(shL + col) = *(const f32x4*)(mod + 3072 + col); }
    if (F.tid < 32) cnt[F.tid] = 0;
    __syncthreads();
    for (int jj = F.wave; jj < 36; jj += NWAVES) { float a = 0.f;
#pragma unroll
        for (int i = 0; i < 16; ++i) a += shL[F.lane + 64 * i] * W36[jj * 1024 + F.lane + 64 * i];
        a = wave_sum(a); if (F.lane == 0) biasL[jj] = a + ((jj < 4) ? F.b_rg[jj] : F.b_re[jj - 4]); }
    __syncthreads();
    const int fr = F.lane & 15, fq = F.lane >> 4, row0 = (blockIdx.x * NWAVES + F.wave) * 16, r = row0 + fr;
    const bf16_t* xr = WSP(bf16_t, WS_X1) + (size_t)r * D + 8 * fq;
    f32x4 D0 = {0.f, 0.f, 0.f, 0.f}, D1 = D0, D2 = D0; float ss = 0.f;
#pragma unroll 1
    for (int kb = 0; kb < 8; ++kb) {
        u32x4 xa[4];
#pragma unroll
        for (int i = 0; i < 4; ++i) xa[i] = *(const u32x4*)(xr + 32 * (4 * kb + i));
#pragma unroll
        for (int i = 0; i < 4; ++i) { const int k0 = 32 * (4 * kb + i) + 8 * fq;
            f32x4 a0, a1; unpack8v(xa[i], a0, a1);
            ss += (a0.x * a0.x + a0.y * a0.y) + (a0.z * a0.z + a0.w * a0.w) + (a1.x * a1.x + a1.y * a1.y) + (a1.z * a1.z + a1.w * a1.w);
            a0 *= *(const LAS f32x4*)(gsL + k0); a1 *= *(const LAS f32x4*)(gsL + k0 + 4);
            const bf16x8 A = __builtin_bit_cast(bf16x8, pack8v(a0, a1));
            const bf16x8 B0 = *(const LAS bf16x8*)(WT + fr * WROW + k0), B1 = *(const LAS bf16x8*)(WT + (16 + fr) * WROW + k0), B2 = *(const LAS bf16x8*)(WT + (32 + fr) * WROW + k0);
            D0 = __builtin_amdgcn_mfma_f32_16x16x32_bf16(A, B0, D0, 0, 0, 0);
            D1 = __builtin_amdgcn_mfma_f32_16x16x32_bf16(A, B1, D1, 0, 0, 0);
            D2 = __builtin_amdgcn_mfma_f32_16x16x32_bf16(A, B2, D2, 0, 0, 0); }
    }
    ss += __shfl_xor(ss, 16); ss += __shfl_xor(ss, 32);
    const float rinv = rsqrtf(ss * (1.f / D) + EPS);
    { int t2 = threadIdx.x; asm volatile("" : "+v"(t2)); F.lane = t2 & 63; }
    const int fr_ = F.lane & 15, fq_ = F.lane >> 4;
    {
        LAS float* lw = lgt + F.wave * 16 * 37;
#pragma unroll
        for (int reg = 0; reg < 4; ++reg) { const float rv = __shfl(rinv, 4 * fq_ + reg); const int tk = 4 * fq_ + reg;
            lw[tk * 37 + fr_] = D0[reg] * rv + biasL[fr_]; lw[tk * 37 + 16 + fr_] = D1[reg] * rv + biasL[16 + fr_];
            if (fr_ < 4) lw[tk * 37 + 32 + fr_] = D2[reg] * rv + biasL[32 + fr_]; }
    }
    {
        const int r_ = row0 + fr_; const bf16_t* xr_ = WSP(bf16_t, WS_X1) + (size_t)r_ * D + 8 * fq_;
        unsigned char* o = WSP(unsigned char, WS_H2) + (size_t)r_ * D + 8 * fq_;
#pragma unroll 1
        for (int kb = 0; kb < 8; ++kb) {
            u32x4 xa[4];
#pragma unroll
            for (int i = 0; i < 4; ++i) xa[i] = *(const u32x4*)(xr_ + 32 * (4 * kb + i));
#pragma unroll
            for (int i = 0; i < 4; ++i) { const int k0 = 32 * (4 * kb + i) + 8 * fq_; f32x4 a0, a1; unpack8v(xa[i], a0, a1);
                const f32x4 h0 = a0 * rinv * *(const LAS f32x4*)(gsL + k0) + *(const LAS f32x4*)(shL + k0), h1 = a1 * rinv * *(const LAS f32x4*)(gsL + k0 + 4) + *(const LAS f32x4*)(shL + k0 + 4);
                *(u32x2*)(o + 32 * (4 * kb + i)) = pack8_fp8(h0, h1); }
        }
    }
    if (F.lane < 16) {
        const int t = row0 + F.lane; const LAS float* lw = lgt + (F.wave * 16 + F.lane) * 37;
        float lg[36];
#pragma unroll
        for (int jj = 0; jj < 36; ++jj) lg[jj] = lw[jj];
        int gi = 0; float gm = lg[0];
#pragma unroll
        for (int i = 1; i < 4; ++i) if (lg[i] > gm) { gm = lg[i]; gi = i; }
        float den = 0.f;
#pragma unroll
        for (int i = 0; i < 4; ++i) den += __expf(lg[i] - gm);
        const float gw_ = 1.f / den;
        float v1 = -INFINITY, v2 = -INFINITY; int e1 = 0, e2 = 0;
#pragma unroll
        for (int i = 0; i < 8; ++i) { const float el = (gi == 0) ? lg[4 + i] : (gi == 1) ? lg[12 + i] : (gi == 2) ? lg[20 + i] : lg[28 + i];
            const bool c1 = el > v1, c2 = el > v2;
            v2 = c1 ? v1 : (c2 ? el : v2); e2 = c1 ? e1 : (c2 ? i : e2); v1 = c1 ? el : v1; e1 = c1 ? i : e1; }
        const float p1 = 1.f / (1.f + __expf(v2 - v1)), p2 = 1.f - p1;
        const int id1 = gi * 8 + e1, id2 = gi * 8 + e2;
        const int la = 2 * (F.wave * 16 + F.lane);
        eidL[la] = id1; eidL[la + 1] = id2; ewL[la] = p1 * gw_; ewL[la + 1] = p2 * gw_;
        lds_add(&cnt[id1], 1); lds_add(&cnt[id2], 1);
    }
    __syncthreads();
    if (F.tid < 32) { baseL[F.tid] = (int)__hip_atomic_fetch_add(WSP(unsigned, WS_CTL) + CW_GCNT + 64 * F.tid, (unsigned)cnt[F.tid], __ATOMIC_RELAXED, __HIP_MEMORY_SCOPE_AGENT); runL[F.tid] = 0; }
    __syncthreads();
    if (F.tid < 256) { const int e = eidL[F.tid]; const int pos = baseL[e] + lds_add(&runL[e], 1);
        WSP(int, WS_LINFO)[(size_t)e * 65536 + pos] = 2 * (blockIdx.x * 128) + F.tid; WSP(float, WS_LW)[(size_t)e * 65536 + pos] = ewL[F.tid]; }
    __syncthreads();
}

__device__ __forceinline__ void s7_lists(Frame& F) {
    LAS int* sm = (LAS int*)F.lds;
    const int* bc = WSP(int, WS_BCNT);
    if (F.tid < 32) { int tot = 0, base = 0; for (int bb = 0; bb < 256; ++bb) { const int c = bc[bb * 32 + F.tid]; if (bb < (int)blockIdx.x) base += c; tot += c; }
        sm[F.tid] = tot; sm[32 + F.tid] = base; sm[96 + F.tid] = 0; }
    __syncthreads();
    if (F.tid == 0) { int ps = 0; for (int e = 0; e < 32; ++e) { sm[64 + e] = ps; ps += (sm[e] + 255) & ~255; }
        if (blockIdx.x == 0) { int* te = WSP(int, WS_TILEE); int pm = 0; for (int e = 0; e < 32; ++e) { const int n = (sm[e] + 255) >> 8; for (int i = 0; i < n; ++i) te[1 + pm++] = e; } te[0] = pm; } }
    __syncthreads();
    int* atok = WSP(int, WS_ATOK); int* ainfo = WSP(int, WS_AINFO); float* aw = WSP(float, WS_AW);
    if (F.tid < 256) { const int a = blockIdx.x * 256 + F.tid;
        const int e = WSP(int, WS_EID)[a]; const int rank = lds_add(&sm[96 + e], 1); const int pos = sm[64 + e] + sm[32 + e] + rank;
        atok[pos] = a >> 1; ainfo[pos] = a; aw[pos] = WSP(float, WS_EW)[a]; }
    if (blockIdx.x < 32) { const int e = blockIdx.x; const int lo = sm[64 + e] + sm[e], hi = sm[64 + e] + ((sm[e] + 255) & ~255);
        for (int p = lo + F.tid; p < hi; p += NTHREADS) { atok[p] = 0; ainfo[p] = -1; aw[p] = 0.f; } }
}

struct RowsGather { const bf16_t* base; const int* idx; __device__ __forceinline__ const bf16_t* operator()(int r) const { return base + (size_t)idx[r] * 1024; } };
__device__ __forceinline__ void s8_simple(Frame& F) {
    LAS float* tile = (LAS float*)F.lds; LAS float* tile2 = tile + 64 * 65;
    const int* te = WSP(int, WS_TILEE); const int nmt = te[0];
    const int row = F.tid >> 3, seg = F.tid & 7;
    for (int it = blockIdx.x; it < nmt * 4 * 8; it += F.G) {
        const int rt = it >> 3, ct = it & 7, e = te[1 + (rt >> 2)], pos0 = 64 * rt, hc = 64 * ct;
        const RowsGather ar{WSP(bf16_t, WS_H2), WSP(int, WS_ATOK) + pos0};
        const bf16_t* wb = WSP(bf16_t, WS_W13_T) + ((size_t)e * 1024 + 256 * (hc >> 7) + (hc & 127)) * 1024;
        const RowsLinear b1{wb, 1024}, b3{wb + (size_t)128 * 1024, 1024};
        sgemm_tile(tile, 1024, ar, b1, F.wave, F.lane); sgemm_tile(tile2, 1024, ar, b3, F.wave, F.lane); __syncthreads();
        const float wt = WSP(float, WS_AW)[pos0 + row]; float v[8];
#pragma unroll
        for (int e8 = 0; e8 < 8; ++e8) { const float a = tile[row * 65 + 8 * seg + e8], c = tile2[row * 65 + 8 * seg + e8]; v[e8] = (a / (1.f + __expf(-a))) * c * wt; }
        *(u32x4*)(WSP(bf16_t, WS_HID) + (size_t)(pos0 + row) * 512 + hc + 8 * seg) = pack8(v);
        __syncthreads();
    }
}
__device__ __forceinline__ void s9_simple(Frame& F) {
    LAS float* tile = (LAS float*)F.lds;
    const int* te = WSP(int, WS_TILEE); const int nmt = te[0];
    const int row = F.tid >> 3, seg = F.tid & 7;
    for (int it = blockIdx.x; it < nmt * 4 * 16; it += F.G) {
        const int rt = it >> 4, ct = it & 15, e = te[1 + (rt >> 2)], pos0 = 64 * rt;
        const RowsLinear ar{WSP(bf16_t, WS_HID) + (size_t)pos0 * 512, 512};
        const RowsLinear br{WSP(bf16_t, WS_W2_T) + ((size_t)e * 1024 + 64 * ct) * 512, 512};
        sgemm_tile(tile, 512, ar, br, F.wave, F.lane); __syncthreads();
        const int info = WSP(int, WS_AINFO)[pos0 + row];
        if (info >= 0) { float v[8];
#pragma unroll
            for (int e8 = 0; e8 < 8; ++e8) v[e8] = tile[row * 65 + 8 * seg + e8];
            *(u32x4*)(WSP(bf16_t, WS_YSLOT) + (size_t)info * 1024 + 64 * ct + 8 * seg) = pack8(v); }
        __syncthreads();
    }
}
__device__ __forceinline__ void s10_combine(Frame& F) {
    const bf16_t* Y = WSP(bf16_t, WS_YSLOT); const bf16_t* X1 = WSP(bf16_t, WS_X1);
    const int stride = F.G * NTHREADS;
    for (int i0 = blockIdx.x * NTHREADS + F.tid; i0 < T * 128; i0 += 2 * stride) {
        u32x4 ya[2], yb[2], xx[2]; f32x4 g0[2], g1[2];
#pragma unroll
        for (int q = 0; q < 2; ++q) { const int i = i0 + q * stride; const int t = i >> 7, c0 = (i & 127) * 8, b = t / S;
            ya[q] = __builtin_nontemporal_load((const u32x4*)(Y + (size_t)(2 * t) * 1024 + c0)); yb[q] = __builtin_nontemporal_load((const u32x4*)(Y + (size_t)(2 * t + 1) * 1024 + c0)); xx[q] = __builtin_nontemporal_load((const u32x4*)(X1 + (size_t)t * D + c0));
            const float* ga2 = WSP(float, WS_MOD) + (size_t)b * NMOD + 5120 + c0; g0[q] = *(const f32x4*)ga2; g1[q] = *(const f32x4*)(ga2 + 4); }
#pragma unroll
        for (int q = 0; q < 2; ++q) { const int i = i0 + q * stride; const int t = i >> 7, c0 = (i & 127) * 8;
            f32x4 y0a, y0b, y1a, y1b, xa, xb; unpack8v(ya[q], y0a, y0b); unpack8v(yb[q], y1a, y1b); unpack8v(xx[q], xa, xb);
            float* o = F.out + (size_t)t * D + c0;
            __builtin_nontemporal_store(xa + g0[q] * (y0a + y1a), (f32x4*)o); __builtin_nontemporal_store(xb + g1[q] * (y0b + y1b), (f32x4*)(o + 4)); }
    }
}

constexpr int N_PHASES = 11;
struct Args { const float* in[21]; float* out; unsigned char* ws; int ph_lo, ph_hi; };
__global__ void __launch_bounds__(NTHREADS, 2) mega_fwd(Args args) {
    extern __shared__ __attribute__((aligned(16))) unsigned char lds_raw[];
    Frame F;
    F.lds = (LAS unsigned char*)lds_raw;
    F.tid = threadIdx.x; F.lane = F.tid & 63; F.wave = __builtin_amdgcn_readfirstlane(F.tid >> 6); F.G = gridDim.x; F.skip = 0;
    F.x = args.in[0]; F.c = args.in[1]; F.w_ada = args.in[2]; F.b_ada = args.in[3]; F.g1 = args.in[4]; F.g2 = args.in[5]; F.w_in = args.in[6]; F.g_q = args.in[7]; F.g_k = args.in[8];
    F.conv_w = args.in[9]; F.conv_b = args.in[10]; F.w_pa = args.in[11]; F.w_pb = args.in[12]; F.w_o = args.in[13]; F.w_rg = args.in[14]; F.b_rg = args.in[15]; F.w_re = args.in[16]; F.b_re = args.in[17];
    F.w1 = args.in[18]; F.w3 = args.in[19]; F.w2 = args.in[20]; F.out = args.out; F.ws = args.ws;
    volatile LAS unsigned* MISC = (volatile LAS unsigned*)(F.lds + MISC_OFF);
    if (F.tid < 64) MISC[F.tid] = 0u;
    __syncthreads();
    XcdBarrier bar = xcd_barrier_post((unsigned*)(F.ws + WS_CTL) + CW_BAR, MISC + 8);
    const int lo = args.ph_lo, hi = args.ph_hi;
    unsigned long long pst0 = 0, pst1 = 0;
#define PHASE(k, body) if (lo <= (k) && (k) < hi) { if (PROBE_PHASE == (k)) pst0 = __builtin_amdgcn_s_memrealtime(); for (int rep_ = 0; rep_ < 1 + ((REPEAT_MASK >> (k)) & 1); ++rep_) { { int t_ = threadIdx.x; asm volatile("" : "+v"(t_)); F.tid = t_; F.lane = t_ & 63; } body; __syncthreads(); } if ((NOEPI_MASK >> (k)) & 1) { int s_ = 1; asm volatile("" : "+s"(s_)); F.skip = s_; { int t_ = threadIdx.x; asm volatile("" : "+v"(t_)); F.tid = t_; F.lane = t_ & 63; } body; __syncthreads(); F.skip = 0; } if ((k) + 1 < hi) xcd_barrier(bar); if (PROBE_PHASE == (k)) pst1 = __builtin_amdgcn_s_memrealtime(); }
    PHASE(0, s0_prologue(F); wait_mod(F); s1_norm1(F))
    PHASE(2, s2_fast(F))
    PHASE(3, s3_fast(F, (char*)lds_raw))
    PHASE(4, s4_fast(F))
    PHASE(5, s5_fast(F))
    PHASE(6, s6_router(F))
    PHASE(8, s8_fast(F))
    PHASE(9, s9_fast(F))
    PHASE(10, s10_combine(F))
#undef PHASE
    if (PROBE_PHASE >= 0 && blockIdx.x == 0) { const unsigned long long t0 = __builtin_amdgcn_s_memrealtime(), dt = pst1 - pst0; while (__builtin_amdgcn_s_memrealtime() - t0 < dt) __builtin_amdgcn_s_sleep(8); }
}

extern "C" void kernel_launch(void* const* d_in, const int* in_sizes, int n_in, void* d_out, int out_size, void* d_ws, size_t ws_size, hipStream_t stream) {
    static int grid = 0;
    if (grid == 0) {
        if (n_in != 21 || in_sizes[0] != T * D || out_size != T * D || ws_size < WS_END) { fprintf(stderr, "kernel_launch: unexpected shapes (n_in %d, in0 %d, out %d, ws %zu); nothing launched\n", n_in, n_in > 0 ? in_sizes[0] : -1, out_size, ws_size); grid = -1; return; }
        int dev = 0, cus = 0, per_cu = 0;
        if (hipGetDevice(&dev) != hipSuccess || hipDeviceGetAttribute(&cus, hipDeviceAttributeMultiprocessorCount, dev) != hipSuccess) { grid = -1; return; }
        if (hipFuncSetAttribute((const void*)mega_fwd, hipFuncAttributeMaxDynamicSharedMemorySize, LDS_BYTES) != hipSuccess) { fprintf(stderr, "kernel_launch: hipFuncSetAttribute failed\n"); grid = -1; return; }
        if (hipOccupancyMaxActiveBlocksPerMultiprocessor(&per_cu, (const void*)mega_fwd, NTHREADS, LDS_BYTES) != hipSuccess || per_cu < 1) { fprintf(stderr, "kernel_launch: occupancy query says %d blocks per CU\n", per_cu); per_cu = 1; }
        (void)hipGetLastError();
        if (cus < 256) { fprintf(stderr, "kernel_launch: built for a 256-CU device, found %d CUs; nothing launched\n", cus); grid = -1; return; }
        grid = 256;
    }
    if (grid < 0) return;
    (void)hipMemsetAsync((char*)d_ws + WS_CTL, 0, CTL_ZERO_BYTES, stream);
    Args a{};
    for (int i = 0; i < 21; ++i) a.in[i] = (const float*)d_in[i];
    a.out = (float*)d_out; a.ws = (unsigned char*)d_ws; a.ph_lo = 0; a.ph_hi = N_PHASES;
    hipLaunchKernelGGL(mega_fwd, dim3(grid), dim3(NTHREADS), LDS_BYTES, stream, a);
}
```

```cpp
#include <hip/hip_runtime.h>
#include <hip/hip_bf16.h>
#include <cstdio>
#include <cstdint>

#ifndef REPEAT_MASK
#define REPEAT_MASK 0
#define NOEPI_MASK 0
#endif
#ifndef PROBE_PHASE
#define PROBE_PHASE -1
#endif
#define GAS __attribute__((address_space(1)))
#define LAS __attribute__((address_space(3)))
typedef unsigned short bf16_t;
typedef short bf16x8 __attribute__((ext_vector_type(8)));
typedef float f32x4 __attribute__((ext_vector_type(4)));
typedef unsigned u32x4 __attribute__((ext_vector_type(4)));
typedef unsigned u32x2 __attribute__((ext_vector_type(2)));

constexpr int T = 32768, D = 1024, NB = 8, S = 4096, NH = 8, DH = 64, NIN = 5120, NE = 32, DE = 512, NMOD = 6144;
constexpr int NTHREADS = 512, NWAVES = 8;
constexpr float EPS = 1e-6f;
constexpr float C2 = 0.125f * 1.4426950408889634f;
constexpr int MAX_MT = 288;
constexpr int NPAD = MAX_MT * 256;

constexpr size_t MiB = 1u << 20, KiB = 1024;
constexpr size_t WS_CTL = 0, CTL_ZERO_BYTES = 64 * KiB;
constexpr size_t WS_MOD = 1 * MiB;
constexpr size_t WS_ROPE = 1 * MiB + 256 * KiB;
constexpr size_t WS_KMEAN = 1 * MiB + 512 * KiB;
constexpr size_t WS_EID = 2 * MiB;
constexpr size_t WS_EW = 2 * MiB + 256 * KiB;
constexpr size_t WS_BCNT = 2 * MiB + 512 * KiB;
constexpr size_t WS_TILEE = 2 * MiB + 768 * KiB;
constexpr size_t WS_ATOK = 3 * MiB;
constexpr size_t WS_AINFO = 3 * MiB + 512 * KiB;
constexpr size_t WS_AW = 4 * MiB;
constexpr size_t WS_W36T = 5 * MiB;
constexpr size_t WS_WIN_T = 8 * MiB;
constexpr size_t WS_WIN8 = 14 * MiB;
constexpr size_t WS_H8 = 56 * MiB;
constexpr size_t WS_WP_T = 18 * MiB;
constexpr size_t WS_WO_T = 20 * MiB;
constexpr size_t WS_W13_T = 24 * MiB;
constexpr size_t WS_W2_T = 88 * MiB;
constexpr size_t WS_H = 120 * MiB;
constexpr size_t WS_YAB = 184 * MiB;
constexpr size_t WS_K = 248 * MiB;
constexpr size_t WS_V = 280 * MiB;
constexpr size_t WS_U = 312 * MiB;
constexpr size_t WS_BG = 344 * MiB;
constexpr size_t WS_GATES = 376 * MiB;
constexpr size_t WS_X1 = 184 * MiB;
constexpr size_t WS_H2 = 120 * MiB;
constexpr size_t WS_HID = 248 * MiB;
constexpr size_t WS_YSLOT = 320 * MiB;
constexpr size_t WS_LINFO = 448 * MiB;
constexpr size_t WS_LW = 456 * MiB;
constexpr size_t WS_END = 504 * MiB;
constexpr int CW_BAR = 4096, CW_MODCNT = 8192, CW_GCNT = 12288;

constexpr int LDS_BYTES = 159744;
constexpr int MISC_OFF = 147456;

__device__ __forceinline__ unsigned f2bf(float f) { unsigned u = __builtin_bit_cast(unsigned, f); return (u + 0x7fffu + ((u >> 16) & 1u)) >> 16; }
__device__ __forceinline__ float bf2f(unsigned h) { return __builtin_bit_cast(float, h << 16); }
typedef float f32x2_h __attribute__((ext_vector_type(2)));
typedef __bf16 bf16x2_h __attribute__((ext_vector_type(2)));
__device__ __forceinline__ unsigned pk2(float lo, float hi) { const f32x2_h v = {lo, hi}; return __builtin_bit_cast(unsigned, __builtin_convertvector(v, bf16x2_h)); }
__device__ __forceinline__ void unpack8(const u32x4 w, float (&v)[8]) {
    v[0] = bf2f(w.x & 0xffffu); v[1] = bf2f(w.x >> 16); v[2] = bf2f(w.y & 0xffffu); v[3] = bf2f(w.y >> 16);
    v[4] = bf2f(w.z & 0xffffu); v[5] = bf2f(w.z >> 16); v[6] = bf2f(w.w & 0xffffu); v[7] = bf2f(w.w >> 16);
}
__device__ __forceinline__ u32x4 pack8(const float (&v)[8]) { u32x4 w; w.x = pk2(v[0], v[1]); w.y = pk2(v[2], v[3]); w.z = pk2(v[4], v[5]); w.w = pk2(v[6], v[7]); return w; }
__device__ __forceinline__ u32x4 pack8v(const f32x4 a, const f32x4 b) { u32x4 w; w.x = pk2(a.x, a.y); w.y = pk2(a.z, a.w); w.z = pk2(b.x, b.y); w.w = pk2(b.z, b.w); return w; }
__device__ __forceinline__ void unpack8v(const u32x4 w, f32x4& a, f32x4& b) {
    a.x = bf2f(w.x & 0xffffu); a.y = bf2f(w.x >> 16); a.z = bf2f(w.y & 0xffffu); a.w = bf2f(w.y >> 16);
    b.x = bf2f(w.z & 0xffffu); b.y = bf2f(w.z >> 16); b.z = bf2f(w.w & 0xffffu); b.w = bf2f(w.w >> 16); }
#ifndef WT_STORES
#define WT_STORES 0
#define NT_STORES 1
#endif
__device__ __forceinline__ void st16(void* p, const u32x4 v) {
#if WT_STORES
    asm volatile("global_store_dwordx4 %0, %1, off sc1\n\ts_nop 1" :: "v"(p), "v"(v) : "memory");
#elif NT_STORES
    __builtin_nontemporal_store(v, (u32x4*)p);
#else
    *(u32x4*)p = v;
#endif
}
typedef int i32x8 __attribute__((ext_vector_type(8)));
__device__ __forceinline__ u32x2 pack8_fp8(const f32x4 a, const f32x4 b) {
    int lo = 0, hi = 0;
    lo = __builtin_amdgcn_cvt_pk_fp8_f32(a.x, a.y, lo, false); lo = __builtin_amdgcn_cvt_pk_fp8_f32(a.z, a.w, lo, true);
    hi = __builtin_amdgcn_cvt_pk_fp8_f32(b.x, b.y, hi, false); hi = __builtin_amdgcn_cvt_pk_fp8_f32(b.z, b.w, hi, true);
    return (u32x2){(unsigned)lo, (unsigned)hi};
}
constexpr float W8_SCALE = 64.f;
#define LDS_WAIT() asm volatile("s_waitcnt lgkmcnt(0)" ::: "memory")
__device__ __forceinline__ int lds_add(LAS int* p, int v) { return __hip_atomic_fetch_add(p, v, __ATOMIC_RELAXED, __HIP_MEMORY_SCOPE_WORKGROUP); }

#define XB_TMO      128
#define XB_XCNT(j)  (256  + 64 * (j))
#define XB_XSUB(j)  (1280 + 64 * (j))
#define XB_XGEN(j)  (2304 + 64 * (j))
#define XB_TOP      3328
#define XB_TOPGEN   3392
#define XCD_BAR_WORDS 3456
#define XB_SPIN_CAP (1u << 22)
__device__ __forceinline__ unsigned xb_ld(unsigned* p)              { return __hip_atomic_load(p, __ATOMIC_RELAXED, __HIP_MEMORY_SCOPE_AGENT); }
__device__ __forceinline__ unsigned xb_add(unsigned* p, unsigned v) { return __hip_atomic_fetch_add(p, v, __ATOMIC_RELAXED, __HIP_MEMORY_SCOPE_AGENT); }
__device__ __forceinline__ unsigned xb_xcc_id() { return (unsigned)__builtin_amdgcn_s_getreg((3 << 11) | 20) & 0xFu; }
#define XB_SPIN(cond, bar) do { unsigned _sp = 0; while (cond) { __builtin_amdgcn_s_sleep(1); \
    if ((++_sp & 255u) == 0u) { if (xb_ld(&(bar)[XB_TMO])) break; if (_sp > XB_SPIN_CAP) { atomicAdd(&(bar)[XB_TMO], 1u); break; } } } } while (0)
struct XcdBarrier { unsigned* bar; unsigned x; volatile LAS unsigned* st; };
__device__ __forceinline__ XcdBarrier xcd_barrier_post(unsigned* bar, volatile LAS unsigned* st) {
    XcdBarrier b; b.bar = bar; b.x = xb_xcc_id(); b.st = st;
    if (threadIdx.x == 0) (void)xb_add(&bar[XB_XCNT(b.x)], 1u);
    return b;
}
__device__ __forceinline__ void xcd_barrier_complete(unsigned* bar, unsigned x, unsigned& nloc, unsigned& nx) {
    const unsigned G = gridDim.x * gridDim.y * gridDim.z;
    unsigned sum, cnt, mine, sp = 0u;
    for (;;) {
        sum = 0u; cnt = 0u; mine = 0u;
#pragma unroll
        for (unsigned j = 0; j < 16; ++j) { const unsigned c = xb_ld(&bar[XB_XCNT(j)]); sum += c; cnt += (c > 0u) ? 1u : 0u; mine = (j == x) ? c : mine; }
        if (sum == G) break;
        __builtin_amdgcn_s_sleep(1);
        if ((++sp & 255u) == 0u) { if (xb_ld(&bar[XB_TMO])) break; if (sp > XB_SPIN_CAP) { atomicAdd(&bar[XB_TMO], 1u); break; } }
    }
    nloc = mine > 0u ? mine : 1u; nx = cnt > 0u ? cnt : 1u;
}
__device__ __forceinline__ void xcd_barrier(const XcdBarrier& b) {
    asm volatile("s_waitcnt vmcnt(0)" ::: "memory");
    __syncthreads();
    if (threadIdx.x == 0) {
        unsigned* bar = b.bar;
        __builtin_amdgcn_s_waitcnt(0);
        unsigned nloc = b.st[0], nx = b.st[1];
        if (nloc == 0u) { xcd_barrier_complete(bar, b.x, nloc, nx); b.st[0] = nloc; b.st[1] = nx; }
        const unsigned old = xb_add(&bar[XB_XSUB(b.x)], 1u);
        const unsigned gen = old / nloc;
        if (old + 1u == (gen + 1u) * nloc) {
            __builtin_amdgcn_fence(__ATOMIC_RELEASE, "agent");
            asm volatile("s_waitcnt vmcnt(0)" ::: "memory");
            const unsigned og = xb_add(&bar[XB_TOP], 1u);
            const unsigned tg = og / nx;
            if (og + 1u == (tg + 1u) * nx) xb_add(&bar[XB_TOPGEN], 1u);
            else XB_SPIN(xb_ld(&bar[XB_TOPGEN]) == tg, bar);
            __builtin_amdgcn_fence(__ATOMIC_ACQUIRE, "agent");
            xb_add(&bar[XB_XGEN(b.x)], 1u);
            asm volatile("s_waitcnt vmcnt(0)" ::: "memory");
        } else {
            XB_SPIN(xb_ld(&bar[XB_XGEN(b.x)]) == gen, bar);
            __builtin_amdgcn_fence(__ATOMIC_ACQUIRE, "agent");
            asm volatile("s_waitcnt vmcnt(0)" ::: "memory");
        }
    }
    __syncthreads();
}

struct Frame {
    LAS unsigned char* lds;
    int tid, lane, wave, G, skip;
    const float *x, *c, *w_ada, *b_ada, *g1, *g2, *w_in, *g_q, *g_k, *conv_w, *conv_b, *w_pa, *w_pb, *w_o, *w_rg, *b_rg, *w_re, *b_re, *w1, *w3, *w2;
    float* out; unsigned char* ws;
};
#define WSP(type, off) ((type*)(F.ws + (off)))

struct XItem { const float* src; unsigned char* dst; int N, pitch, fp8, swz; };
__device__ __forceinline__ void xitem_load(const XItem& it, f32x4 (&v)[8], int lane) {
    const int r8 = lane >> 3, c4 = lane & 7;
#pragma unroll
    for (int i = 0; i < 8; ++i) v[i] = __builtin_nontemporal_load((const f32x4*)(it.src + (size_t)(8 * i + r8) * it.N + 4 * c4));
}
__device__ __forceinline__ void xitem_store(const XItem& it, const f32x4 (&v)[8], LAS float* scr, int lane) {
    const int r8 = lane >> 3, c4 = lane & 7; const float scale = it.fp8 ? W8_SCALE : 1.f;
#pragma unroll
    for (int i = 0; i < 8; ++i) { LAS float* p = scr + (8 * i + r8) * 33 + 4 * c4; p[0] = v[i].x * scale; p[1] = v[i].y * scale; p[2] = v[i].z * scale; p[3] = v[i].w * scale; }
    LDS_WAIT(); asm volatile("" ::: "memory");
    if (it.fp8) {
        const int n = lane >> 1, kh = lane & 1; const LAS float* sp = scr + (32 * kh) * 33 + n;
#pragma unroll
        for (int p = 0; p < 2; ++p) { u32x4 o;
#pragma unroll
            for (int w = 0; w < 4; ++w) { const LAS float* q = sp + (16 * p + 4 * w) * 33; int x = 0;
                x = __builtin_amdgcn_cvt_pk_fp8_f32(q[0], q[33], x, false); x = __builtin_amdgcn_cvt_pk_fp8_f32(q[66], q[99], x, true); o[w] = (unsigned)x; }
            *(u32x4*)(it.dst + (size_t)n * it.pitch + 32 * kh + 16 * p) = o; }
    } else {
        const int c = lane & 7;
#pragma unroll
        for (int j = 0; j < 4; ++j) { const int n = (lane >> 3) + 8 * j; const LAS float* q = scr + (8 * c) * 33 + n;
            u32x4 o; o.x = pk2(q[0 * 33], q[1 * 33]); o.y = pk2(q[2 * 33], q[3 * 33]); o.z = pk2(q[4 * 33], q[5 * 33]); o.w = pk2(q[6 * 33], q[7 * 33]);
            const int nd = (it.swz && ((n >> 2) == 1 || (n >> 2) == 2)) ? (n ^ 12) : n;
            *(u32x4*)(it.dst + ((size_t)nd * it.pitch + 8 * c) * 2) = o; }
    }
    LDS_WAIT(); asm volatile("" ::: "memory");
}
__device__ __forceinline__ int win_dest_row(int sc) {
    if (sc < 32) { const int isk = sc >> 4, s2 = sc & 15, hh = s2 >> 1, bj = s2 & 1; return 512 * isk + 256 * (hh >> 2) + 128 * bj + 32 * (hh & 3); }
    if (sc < 48) return 0;
    if (sc < 64) { const int cx = 32 * (sc - 48); return 256 * (4 + (cx >> 7)) + (cx & 127); }
    if (sc < 80) return 2048 + 32 * (sc - 64);
    if (sc < 96) { const int cx = 32 * (sc - 80); return 256 * (4 + (cx >> 7)) + 128 + (cx & 127); }
    return 3072 + 32 * (sc - 96);
}
constexpr int X_NONEXP = 16 * 160 + 2 * (8 * 32) + 16 * 32, X_W2 = X_NONEXP + NE * 512, X_END = X_W2 + NE * 256;
__device__ __forceinline__ void convert_items(Frame& F, const int item_lo, const int item_hi, const int gw, const int NGW) {
    LAS float* scr = (LAS float*)(F.lds + F.wave * 16384);
    constexpr int I_IN = 16 * 160, I_PA = 8 * 32, I_O = 16 * 32, I_E1 = 16 * 16, I_E2 = 8 * 32;
    constexpr int NITEMS = I_IN + 2 * I_PA + I_O + NE * (2 * I_E1 + I_E2);
    auto decode = [&](int r) -> XItem {
        XItem x; x.swz = 0;
        if (r < I_IN) { const int kb = r / 160, sc = r % 160; x.src = F.w_in + (size_t)(64 * kb) * NIN + 32 * sc; x.N = NIN; x.pitch = 1024; x.swz = (sc < 32 && !(sc & 1)) ? 1 : 0;
            if (sc < 96 && !(sc >= 32 && sc < 48)) { x.fp8 = 0; x.dst = (unsigned char*)(WSP(bf16_t, WS_WIN_T) + (size_t)win_dest_row(sc) * 1024 + 64 * kb); }
            else { x.fp8 = 1; const int g = 32 * (sc - 96), cx = g & 1023;
                x.dst = WSP(unsigned char, WS_WIN8) + (size_t)(sc >= 96 ? 256 * (cx >> 7) + (g >= 1024 ? 128 : 0) + (cx & 127) : 2048 + 32 * (sc - 32)) * 1024 + 64 * kb; }
            return x; } r -= I_IN;
        if (r < I_PA) { const int kb = r / 32, sc = r % 32; x.src = F.w_pa + (size_t)(64 * kb) * 1024 + 32 * sc; x.N = 1024; x.pitch = 1024; x.fp8 = 0; x.dst = (unsigned char*)(WSP(bf16_t, WS_WP_T) + (size_t)(32 * sc) * 1024 + 64 * kb); return x; } r -= I_PA;
        if (r < I_PA) { const int kb = r / 32, sc = r % 32; x.src = F.w_pb + (size_t)(64 * kb) * 1024 + 32 * sc; x.N = 1024; x.pitch = 1024; x.fp8 = 0; x.dst = (unsigned char*)(WSP(bf16_t, WS_WP_T) + (size_t)(32 * sc) * 1024 + 512 + 64 * kb); return x; } r -= I_PA;
        if (r < I_O) { const int kb = r / 32, sc = r % 32; x.src = F.w_o + (size_t)(64 * kb) * 1024 + 32 * sc; x.N = 1024; x.pitch = 1024; x.fp8 = 1; x.dst = WSP(unsigned char, WS_WO_T) + (size_t)(32 * sc) * 1024 + 64 * kb; return x; } r -= I_O;
        x.fp8 = 1;
        if (r < NE * 2 * I_E1) { const int e = r / (2 * I_E1); r -= e * (2 * I_E1); const int is3 = r >= I_E1; if (is3) r -= I_E1; const int kb = r / 16, sc = r % 16;
            x.src = (is3 ? F.w3 : F.w1) + (size_t)e * D * DE + (size_t)(64 * kb) * DE + 32 * sc; x.N = DE; x.pitch = 1024;
            x.dst = WSP(unsigned char, WS_W13_T) + ((size_t)e * 1024 + 256 * (sc >> 2) + 128 * is3 + 32 * (sc & 3)) * 1024 + 64 * kb; return x; }
        r -= NE * 2 * I_E1;
        { const int e = r / I_E2; r -= e * I_E2; const int kb = r / 32, sc = r % 32;
            x.src = F.w2 + (size_t)e * DE * D + (size_t)(64 * kb) * D + 32 * sc; x.N = D; x.pitch = 512; x.dst = WSP(unsigned char, WS_W2_T) + ((size_t)e * 1024 + 32 * sc) * 512 + 64 * kb; }
        return x;
    };
    const int ihi = (item_hi < NITEMS) ? item_hi : NITEMS;
    if (item_lo + gw < ihi) {
        XItem cur = decode(item_lo + gw); f32x4 va[8], vb[8]; xitem_load(cur, va, F.lane);
        for (int it = item_lo + gw; it < ihi; it += 2 * NGW) {
            const int n1 = it + NGW, n2 = it + 2 * NGW; XItem nx1 = cur, nx2 = cur;
            if (n1 < ihi) { nx1 = decode(n1); xitem_load(nx1, vb, F.lane); }
            xitem_store(cur, va, scr, F.lane);
            if (n1 < ihi) { if (n2 < ihi) { nx2 = decode(n2); xitem_load(nx2, va, F.lane); }
                xitem_store(nx1, vb, scr, F.lane); cur = nx2; }
        }
    }
}

__device__ __forceinline__ void s0_prologue(Frame& F) {
    if (F.tid < 256) WSP(float, WS_KMEAN)[blockIdx.x * 256 + F.tid] = 0.f;
    if (F.tid < 144) { const int gt = blockIdx.x * 144 + F.tid; const int jj = gt >> 10, k = gt & 1023; WSP(float, WS_W36T)[gt] = (jj < 4) ? F.w_rg[k * 4 + jj] : F.w_re[k * 32 + (jj - 4)]; }
    if (blockIdx.x < 192) {
        LAS float* sc = (LAS float*)F.lds;
        for (int i = F.tid; i < NB * D; i += NTHREADS) { const float v = F.c[i]; sc[i] = v / (1.f + expf(-v)); }
        __syncthreads();
        const int j0 = blockIdx.x * 32, col = j0 + (F.lane & 31), kpar = F.lane >> 5;
        float acc[8];
#pragma unroll
        for (int b = 0; b < 8; ++b) acc[b] = 0.f;
#pragma unroll
        for (int i0 = 0; i0 < 64; i0 += 32) { float wv[32];
#pragma unroll
            for (int i = 0; i < 32; ++i) wv[i] = F.w_ada[(size_t)(F.wave * 128 + 2 * (i0 + i) + kpar) * NMOD + col];
#pragma unroll
            for (int i = 0; i < 32; ++i) { const int k = F.wave * 128 + 2 * (i0 + i) + kpar;
#pragma unroll
                for (int b = 0; b < 8; ++b) acc[b] += sc[b * D + k] * wv[i]; } }
#pragma unroll
        for (int b = 0; b < 8; ++b) acc[b] += __shfl_xor(acc[b], 32);
        LAS float* red = (LAS float*)(F.lds + 32768);
        if (F.lane < 32) {
#pragma unroll
            for (int b = 0; b < 8; ++b) red[(F.wave * 8 + b) * 32 + F.lane] = acc[b]; }
        __syncthreads();
        if (F.tid < 256) { const int b = F.tid >> 5, cc = F.tid & 31; float s = F.b_ada[j0 + cc];
#pragma unroll
            for (int w = 0; w < 8; ++w) s += red[(w * 8 + b) * 32 + cc];
            WSP(float, WS_MOD)[b * NMOD + j0 + cc] = s; }
        asm volatile("s_waitcnt vmcnt(0)" ::: "memory");
        __syncthreads();
        if (F.tid == 0) { __builtin_amdgcn_fence(__ATOMIC_RELEASE, "agent"); asm volatile("s_waitcnt vmcnt(0)" ::: "memory");
            __hip_atomic_fetch_add(WSP(unsigned, WS_CTL) + CW_MODCNT, 1u, __ATOMIC_RELAXED, __HIP_MEMORY_SCOPE_AGENT); }
    }
    convert_items(F, 0, X_NONEXP, F.G * NWAVES - 1 - (blockIdx.x * NWAVES + F.wave), F.G * NWAVES);
}

__device__ __forceinline__ void wait_mod(Frame& F) {
    if (F.tid == 0) { unsigned* c = WSP(unsigned, WS_CTL) + CW_MODCNT; unsigned sp = 0;
        while (__hip_atomic_load(c, __ATOMIC_RELAXED, __HIP_MEMORY_SCOPE_AGENT) < 192u) { __builtin_amdgcn_s_sleep(2); if (++sp > (1u << 24)) break; }
        __builtin_amdgcn_fence(__ATOMIC_ACQUIRE, "agent"); asm volatile("s_waitcnt vmcnt(0)" ::: "memory"); }
    __syncthreads();
}
template <int N> __device__ __forceinline__ float dpp_ror(float v) { return __builtin_bit_cast(float, __builtin_amdgcn_update_dpp(0, __builtin_bit_cast(int, v), 0x120 + N, 0xF, 0xF, false)); }
__device__ __forceinline__ float xrow16_sum(float x) {
    float a = x, b = x;
    asm volatile("s_nop 1\n\tv_permlane16_swap_b32 %0, %1" : "+v"(a), "+v"(b));
    a += b; b = a;
    asm volatile("s_nop 1\n\tv_permlane32_swap_b32 %0, %1" : "+v"(a), "+v"(b));
    return a + b;
}
__device__ __forceinline__ float wave_sum(float v) {
#pragma unroll
    for (int o = 1; o < 64; o <<= 1) v += __shfl_xor(v, o);
    return v;
}
__device__ __forceinline__ void s1_norm1(Frame& F) {
    const int gw = blockIdx.x * NWAVES + F.wave;
    const int row0 = gw * 16, b = row0 / S;
    if (row0 >= T) return;
    const float* mod = WSP(float, WS_MOD) + (size_t)b * NMOD;
    f32x4 gs[4], sh[4];
#pragma unroll
    for (int j = 0; j < 4; ++j) { const int col = 4 * F.lane + 256 * j; const f32x4 g = *(const f32x4*)(F.g1 + col), s_ = *(const f32x4*)(mod + 1024 + col); gs[j] = g * (s_ + 1.0f); sh[j] = *(const f32x4*)(mod + col); }
    for (int r = 0; r < 16; r += 4) {
        f32x4 v[4][4]; float ss[4];
#pragma unroll
        for (int q = 0; q < 4; ++q) { const float* xr = F.x + (size_t)(row0 + r + q) * D;
#pragma unroll
            for (int j = 0; j < 4; ++j) v[q][j] = __builtin_nontemporal_load((const f32x4*)(xr + 4 * F.lane + 256 * j)); }
#pragma unroll
        for (int q = 0; q < 4; ++q) { ss[q] = 0.f;
#pragma unroll
            for (int j = 0; j < 4; ++j) ss[q] += (v[q][j].x * v[q][j].x + v[q][j].y * v[q][j].y) + (v[q][j].z * v[q][j].z + v[q][j].w * v[q][j].w); }
#pragma unroll
        for (int q = 0; q < 4; ++q) { const float rinv = rsqrtf(wave_sum(ss[q]) * (1.f / D) + EPS);
            bf16_t* o = WSP(bf16_t, WS_H) + (size_t)(row0 + r + q) * D;
#pragma unroll
            for (int j = 0; j < 4; ++j) { const f32x4 h = v[q][j] * rinv * gs[j] + sh[j]; u32x2 w; w.x = pk2(h.x, h.y); w.y = pk2(h.z, h.w); *(u32x2*)(o + 4 * F.lane + 256 * j) = w;
                int p8 = 0; p8 = __builtin_amdgcn_cvt_pk_fp8_f32(h.x, h.y, p8, false); p8 = __builtin_amdgcn_cvt_pk_fp8_f32(h.z, h.w, p8, true);
                *(int*)(WSP(unsigned char, WS_H8) + (size_t)(row0 + r + q) * D + 4 * F.lane + 256 * j) = p8; } }
    }
}

struct RowsLinear { const bf16_t* base; size_t pitch; __device__ __forceinline__ const bf16_t* operator()(int r) const { return base + (size_t)r * pitch; } };
template <class AR, class BR>
__device__ __forceinline__ void sgemm_tile(LAS float* tile, int K, const AR& arow, const BR& brow, int wave, int lane) {
    const int fr = lane & 15, fq = lane >> 4, rb = 16 * (wave & 3), cb = 32 * (wave >> 2);
    const bf16_t* ap = arow(rb + fr) + 8 * fq;
    const bf16_t* bp0 = brow(cb + fr) + 8 * fq;
    const bf16_t* bp1 = brow(cb + 16 + fr) + 8 * fq;
    f32x4 acc0 = {0.f, 0.f, 0.f, 0.f}, acc1 = {0.f, 0.f, 0.f, 0.f};
#pragma unroll 4
    for (int k = 0; k < K; k += 32) {
        const bf16x8 a = *(const bf16x8*)(ap + k), b0 = *(const bf16x8*)(bp0 + k), b1 = *(const bf16x8*)(bp1 + k);
        acc0 = __builtin_amdgcn_mfma_f32_16x16x32_bf16(a, b0, acc0, 0, 0, 0);
        acc1 = __builtin_amdgcn_mfma_f32_16x16x32_bf16(a, b1, acc1, 0, 0, 0);
    }
#pragma unroll
    for (int j = 0; j < 4; ++j) { tile[(rb + fq * 4 + j) * 65 + cb + fr] = acc0[j]; tile[(rb + fq * 4 + j) * 65 + cb + 16 + fr] = acc1[j]; }
}

struct WinRowsHead { const bf16_t* base; int rb; __device__ __forceinline__ const bf16_t* operator()(int d) const { return base + (size_t)(rb + 128 * (d >> 5) + (d & 31)) * 1024; } };
__device__ __forceinline__ void s2_simple(Frame& F) {
    LAS float* tile = (LAS float*)F.lds; LAS float* tile2 = tile + 64 * 65;
    const bf16_t* H = WSP(bf16_t, WS_H); const bf16_t* WT = WSP(bf16_t, WS_WIN_T);
    const int row = F.tid >> 3, seg = F.tid & 7;
    for (int it = blockIdx.x; it < 512 * 72; it += F.G) {
        const int rt = it / 72, ct = it % 72, r0 = rt * 64, gr = r0 + row;
        const RowsLinear ar{H + (size_t)r0 * 1024, 1024};
        float v[8];
        if (ct < 16) {
            const int isk = ct >> 3, hh = ct & 7;
            const WinRowsHead br{WT, 512 * isk + 256 * (hh >> 2) + 32 * (hh & 3)};
            sgemm_tile(tile, 1024, ar, br, F.wave, F.lane); __syncthreads();
            float ss = 0.f;
#pragma unroll
            for (int e = 0; e < 8; ++e) { v[e] = tile[row * 65 + 8 * seg + e]; ss += v[e] * v[e]; }
            ss += __shfl_xor(ss, 1); ss += __shfl_xor(ss, 2); ss += __shfl_xor(ss, 4);
            const float rinv = rsqrtf(ss * (1.f / 64.f) + EPS);
            const float* g = isk ? F.g_k : F.g_q;
            const int pos = gr & (S - 1);
#pragma unroll
            for (int e = 0; e < 8; ++e) { v[e] = v[e] * rinv * g[8 * seg + e]; const float pv = __shfl_xor(v[e], 1);
                if (seg < 2) { const float2 cs = WSP(float2, WS_ROPE)[pos * 8 + e]; v[e] = (seg == 0) ? (v[e] * cs.x - pv * cs.y) : (v[e] * cs.x + pv * cs.y); } }
            if (!isk) {
#pragma unroll
                for (int e = 0; e < 8; ++e) v[e] *= C2;
                *(u32x4*)(WSP(bf16_t, WS_YAB) + (size_t)gr * 1024 + hh * 64 + 8 * seg) = pack8(v);
            } else {
                *(u32x4*)(WSP(bf16_t, WS_K) + (size_t)gr * 512 + hh * 64 + 8 * seg) = pack8(v);
#pragma unroll
                for (int e = 0; e < 8; ++e) tile[row * 65 + 8 * seg + e] = v[e];
                __syncthreads();
                if (F.tid < 64) { float s = 0.f; for (int r = 0; r < 64; ++r) s += tile[r * 65 + F.tid];
                    const int b = r0 / S, blk = (r0 & (S - 1)) >> 8;
                    atomicAdd(WSP(float, WS_KMEAN) + ((size_t)(b * NH + hh) * 16 + blk) * 64 + F.tid, s * (1.f / 256.f)); }
            }
        } else if (ct < 24) {
            const RowsLinear br{WT + (size_t)(1024 + 64 * (ct - 16)) * 1024, 1024};
            sgemm_tile(tile, 1024, ar, br, F.wave, F.lane); __syncthreads();
#pragma unroll
            for (int e = 0; e < 8; ++e) v[e] = tile[row * 65 + 8 * seg + e];
            *(u32x4*)(WSP(bf16_t, WS_V) + (size_t)gr * 512 + 64 * (ct - 16) + 8 * seg) = pack8(v);
        } else if (ct < 32) {
            const int cu = 64 * (ct - 24), rb = 256 * (6 + (cu >> 7)) + (cu & 127);
            const RowsLinear bx{WT + (size_t)rb * 1024, 1024}, bc{WT + (size_t)(rb + 128) * 1024, 1024};
            sgemm_tile(tile, 1024, ar, bx, F.wave, F.lane); sgemm_tile(tile2, 1024, ar, bc, F.wave, F.lane); __syncthreads();
#pragma unroll
            for (int e = 0; e < 8; ++e) v[e] = tile[row * 65 + 8 * seg + e] * tile2[row * 65 + 8 * seg + e];
            *(u32x4*)(WSP(bf16_t, WS_U) + (size_t)gr * 512 + cu + 8 * seg) = pack8(v);
        } else if (ct < 40) {
            const RowsLinear br{WT + (size_t)(2560 + 64 * (ct - 32)) * 1024, 1024};
            sgemm_tile(tile, 1024, ar, br, F.wave, F.lane); __syncthreads();
#pragma unroll
            for (int e = 0; e < 8; ++e) v[e] = tile[row * 65 + 8 * seg + e];
            *(u32x4*)(WSP(bf16_t, WS_BG) + (size_t)gr * 512 + 64 * (ct - 32) + 8 * seg) = pack8(v);
        } else {
            const RowsLinear br{WT + (size_t)(3072 + 64 * (ct - 40)) * 1024, 1024};
            sgemm_tile(tile, 1024, ar, br, F.wave, F.lane); __syncthreads();
#pragma unroll
            for (int e = 0; e < 8; ++e) v[e] = 1.f / (1.f + __expf(-tile[row * 65 + 8 * seg + e]));
            *(u32x4*)(WSP(bf16_t, WS_GATES) + (size_t)gr * 2048 + 64 * (ct - 40) + 8 * seg) = pack8(v);
        }
        __syncthreads();
    }
}

namespace pg8 {
constexpr int BM = 256, BK = 64, HALF = 128, HTB = HALF * BK * 2, STAGE_BYTES = 8 * HTB, NXCD = 8, WGM = 4;
constexpr int VN_STASH = 147456 + 4096;
__device__ __forceinline__ int lds_byte(int r, int c) { const int st = (r >> 4) * 2 + (c >> 5), rr = r & 15, cc = c & 31, ob = rr * 64 + cc * 2; return st * 1024 + (ob ^ (((ob >> 9) & 1) << 5)); }
__device__ __forceinline__ void stage_rc(int b, int& R, int& C) { const int st = b / 1024, sb = b % 1024, swz = sb ^ (((sb >> 9) & 1) << 5); R = (st >> 1) * 16 + swz / 64; C = (st & 1) * 32 + (swz % 64) / 2; }
__device__ __forceinline__ int perm32(int rho) { const int n = rho >> 4, i = rho & 15; return 8 * (i >> 2) + 4 * n + (i & 3); }
struct Unit { int pm, pn; const char* a; const char* b; int e, rbase; };
__device__ __forceinline__ bool static_unit(int i, int G, int c, int nM, int nN, int& pm, int& pn) {
    const int nwg = nM * nN; const long L = (long)i * G + c; if (L >= nwg) return false;
    int wgid = (int)L; { const int q = nwg / NXCD, r = nwg % NXCD, xcd = wgid % NXCD, off = wgid / NXCD; wgid = (xcd < r ? xcd * (q + 1) : r * (q + 1) + (xcd - r) * q) + off; }
    const int nig = WGM * nN, gid = wgid / nig, fm = gid * WGM, gsz = (nM - fm) < WGM ? (nM - fm) : WGM;
    pm = fm + ((wgid % nig) % gsz); pn = (wgid % nig) / gsz; return true;
}
struct DenseSched {
    static constexpr bool GATHER = false, FP8 = false;
    const char* A; const char* Bt; int nM, nN, K, G, c;
    __device__ __forceinline__ bool next(int i, Unit& u) const { if (!static_unit(i, G, c, nM, nN, u.pm, u.pn)) return false;
        u.a = A + (size_t)u.pm * BM * K * 2; u.b = Bt + (size_t)u.pn * BM * K * 2; u.e = 0; u.rbase = 0; return true; }
    __device__ __forceinline__ int row_index(const Unit&, int) const { return 0; }
};

struct DenseSched8 {
    static constexpr bool GATHER = false, FP8 = true;
    const char* A; const char* Bt; int nM, nN, K, G, c;
    __device__ __forceinline__ bool next(int i, Unit& u) const { if (!static_unit(i, G, c, nM, nN, u.pm, u.pn)) return false;
        u.a = A + (size_t)u.pm * BM * K; u.b = Bt + (size_t)u.pn * BM * K; u.e = 0; u.rbase = 0; return true; }
    __device__ __forceinline__ int row_index(const Unit&, int) const { return 0; }
};
template <class Epi, class Sched, bool skip = false>
__device__ __forceinline__ void gemm_phase(LAS unsigned char* lds, const int K, const Sched& S, const Epi& E) {
    int tid_ = threadIdx.x; asm volatile("" : "+v"(tid_));
    const int tid = tid_, wid = __builtin_amdgcn_readfirstlane(tid >> 6), lane = tid & 63, wr = wid >> 2, wc = wid & 3, fr = lane & 15, fq = lane >> 4;
    constexpr bool FP8 = Sched::FP8;
    const int nt = FP8 ? K / 128 : K / BK;
    const int PB = FP8 ? K : 2 * K;
    unsigned voffB[2], vA[2][2], vN[2][2];
#pragma unroll
    for (int i = 0; i < 2; ++i) { int R, C; stage_rc(tid * 16 + i * 8192, R, C); const int Rb = (R & ~31) + perm32(R & 31);
        voffB[i] = (unsigned)(Rb * PB + C * 2);
        vA[0][i] = (unsigned)(R * PB + C * 2); vA[1][i] = (unsigned)((HALF + R) * PB + C * 2); vN[0][i] = vA[0][i]; vN[1][i] = vA[1][i]; }
    const size_t kstep = (size_t)(BK * 2);
    const size_t hstep = (size_t)HALF * PB;
    const unsigned ldsw = (unsigned)wid * 1024u;
    const int aoff = lds_byte(wr * 64 + fr, fq * 8), boff = lds_byte(wc * 32 + fr, fq * 8);
    const int aoff8a = lds_byte(wr * 64 + fr, fq * 16), aoff8b = lds_byte(wr * 64 + fr, fq * 16 + 8), boff8a = lds_byte(wc * 32 + fr, fq * 16), boff8b = lds_byte(wc * 32 + fr, fq * 16 + 8);
#define PG8_SA(b, h) (((b) * 2 + (h)) * HTB)
#define PG8_SB(b, h) ((4 + (b) * 2 + (h)) * HTB)
#define PG8_STAGE(bufoff, gbase, voff) do { _Pragma("unroll") for (int _i = 0; _i < 2; ++_i) \
        __builtin_amdgcn_global_load_lds((const unsigned*)((const char*)(gbase) + (voff)[_i]), (LAS unsigned*)(lds + (bufoff) + ldsw + _i * 8192), 16, 0, 0); } while (0)
#define PG8_LD16(off) (*(const LAS u32x4*)(lds + (off)))
#define PG8_LDA(dst, b, h) do { _Pragma("unroll") for (int m = 0; m < 4; ++m) { if constexpr (FP8) { dst##8[m] = __builtin_bit_cast(i32x8, __builtin_shufflevector(PG8_LD16(PG8_SA(b, h) + aoff8a + m * 2048), PG8_LD16(PG8_SA(b, h) + aoff8b + m * 2048), 0, 1, 2, 3, 4, 5, 6, 7)); } \
        else { _Pragma("unroll") for (int k = 0; k < 2; ++k) dst[m][k] = *(const LAS bf16x8*)(lds + PG8_SA(b, h) + aoff + m * 2048 + k * 1024); } } } while (0)
#define PG8_LDB(dst, b, h) do { _Pragma("unroll") for (int n = 0; n < 2; ++n) { if constexpr (FP8) { dst##8[n] = __builtin_bit_cast(i32x8, __builtin_shufflevector(PG8_LD16(PG8_SB(b, h) + boff8a + n * 2048), PG8_LD16(PG8_SB(b, h) + boff8b + n * 2048), 0, 1, 2, 3, 4, 5, 6, 7)); } \
        else { _Pragma("unroll") for (int k = 0; k < 2; ++k) dst[n][k] = *(const LAS bf16x8*)(lds + PG8_SB(b, h) + boff + n * 2048 + k * 1024); } } } while (0)
#define PG8_MMA(ai, bj, At, Bt) do { __builtin_amdgcn_s_setprio(1); _Pragma("unroll") for (int m = 0; m < 4; ++m) _Pragma("unroll") for (int n = 0; n < 2; ++n) { \
        if constexpr (FP8) { asm volatile("s_nop 1\n\tv_mfma_scale_f32_16x16x128_f8f6f4 %0, %1, %2, %0, %3, %3 op_sel_hi:[0,0,0]" : "+v"(acc[ai][bj][m][n]) : "v"(Bt##8[n]), "v"(At##8[m]), "v"(sc127)); } \
        else { _Pragma("unroll") for (int k = 0; k < 2; ++k) acc[ai][bj][m][n] = __builtin_amdgcn_mfma_f32_16x16x32_bf16(Bt[n][k], At[m][k], acc[ai][bj][m][n], 0, 0, 0); } } __builtin_amdgcn_s_setprio(0); } while (0)
#define PG8_WAIT_V(n) asm volatile("s_waitcnt vmcnt(" #n ")" ::: "memory")
#define PG8_WAIT_L(n) asm volatile("s_waitcnt lgkmcnt(" #n ")" ::: "memory")
#define PG8_BAR __builtin_amdgcn_s_barrier()
#define PG8_SCHED __builtin_amdgcn_sched_barrier(0)
#define PG8_AOFF(dst, u) do { int _t = threadIdx.x; asm volatile("" : "+v"(_t)); _Pragma("unroll") for (int _i = 0; _i < 2; ++_i) { int _R, _C; stage_rc(_t * 16 + _i * 8192, _R, _C); \
        _Pragma("unroll") for (int _h = 0; _h < 2; ++_h) dst[_h][_i] = (unsigned)(S.row_index(u, _h * HALF + _R) * PB + _C * 2); } } while (0)
    Unit cur, nxt; int ui = 0;
    if (!S.next(0, cur)) return;
    if constexpr (Sched::GATHER) PG8_AOFF(vA, cur);
    f32x4 acc[2][2][4][2]; typename Epi::State est;
#pragma unroll
    for (int a = 0; a < 2; ++a)
#pragma unroll
        for (int b = 0; b < 2; ++b)
#pragma unroll
            for (int m = 0; m < 4; ++m)
#pragma unroll
                for (int n = 0; n < 2; ++n) acc[a][b][m][n] = (f32x4){0.f, 0.f, 0.f, 0.f};
    const int sc127 = 127;
    bf16x8 At[4][2], B0[2][2], B1[2][2]; i32x8 At8[4], B08[2], B18[2];
    const char* cA = cur.a; const char* cB = cur.b;
    PG8_STAGE(PG8_SB(0, 0), cB, voffB); PG8_STAGE(PG8_SB(0, 1), cB + hstep, voffB); PG8_STAGE(PG8_SA(0, 0), cA, vA[0]); PG8_STAGE(PG8_SA(0, 1), cA, vA[1]);
    if (wr == 1) PG8_BAR;
    PG8_WAIT_V(2); PG8_BAR;
    PG8_STAGE(PG8_SB(1, 0), cB + kstep, voffB); PG8_STAGE(PG8_SA(1, 0), cA + kstep, vA[0]); PG8_STAGE(PG8_SB(1, 1), cB + hstep + kstep, voffB);
    PG8_WAIT_V(6); PG8_BAR;
    for (;;) {
        const bool has_next = S.next(ui + 1, nxt);
        const char* nA = has_next ? nxt.a : cA; const char* nB = has_next ? nxt.b : cB;
        if constexpr (Sched::GATHER) { if (has_next) PG8_AOFF(vN, nxt); else {
#pragma unroll
            for (int h = 0; h < 2; ++h)
#pragma unroll
                for (int i = 0; i < 2; ++i) vN[h][i] = vA[h][i]; }
            *(LAS u32x4*)(lds + VN_STASH + tid * 16) = (u32x4){vN[0][0], vN[0][1], vN[1][0], vN[1][1]}; }
        for (int hk = 0; hk < (Epi::HAS_MID ? 2 : 1); ++hk) {
        if constexpr (Epi::HAS_MID) { if (hk == 1 && !skip) E.mid(acc, cur, wr, wc, fr, fq, est); }
        const int tb = (Epi::HAS_MID && hk == 1) ? nt / 2 : 0, te = (Epi::HAS_MID && hk == 0) ? nt / 2 : nt;
#pragma unroll 1
        for (int t = tb; t < te; t += 2) {
            const bool last = (t == nt - 2);
            const char* a1 = cA + (size_t)(t + 1) * kstep;
            const char* a2 = last ? nA : cA + (size_t)(t + 2) * kstep; const char* b2 = last ? nB : cB + (size_t)(t + 2) * kstep;
            const char* a3 = a2 + kstep; const char* b3 = b2 + kstep;
            unsigned w0[2], w1[2];
#pragma unroll
            for (int i = 0; i < 2; ++i) { w0[i] = vA[0][i]; w1[i] = vA[1][i]; }
            if constexpr (Sched::GATHER) { if (last) { const u32x4 q = *(const LAS u32x4*)(lds + VN_STASH + tid * 16); w0[0] = q.x; w0[1] = q.y; w1[0] = q.z; w1[1] = q.w; } }
            PG8_LDB(B0, 0, 0); PG8_LDB(B1, 0, 1); PG8_SCHED; PG8_LDA(At, 0, 0); PG8_STAGE(PG8_SA(1, 1), a1, vA[1]);
            PG8_WAIT_V(8); PG8_WAIT_L(0); PG8_BAR; PG8_MMA(0, 0, At, B0); PG8_MMA(0, 1, At, B1); PG8_BAR; PG8_SCHED;
            PG8_LDA(At, 0, 1); PG8_STAGE(PG8_SB(0, 0), b2, voffB); PG8_STAGE(PG8_SB(0, 1), b2 + hstep, voffB); PG8_STAGE(PG8_SA(0, 0), a2, w0);
            PG8_WAIT_V(8); PG8_WAIT_L(0); PG8_BAR; PG8_MMA(1, 0, At, B0); PG8_MMA(1, 1, At, B1); PG8_BAR; PG8_SCHED;
            PG8_LDB(B0, 1, 0); PG8_LDB(B1, 1, 1); PG8_SCHED; PG8_LDA(At, 1, 0); PG8_STAGE(PG8_SA(0, 1), a2, w1);
            PG8_WAIT_V(8); PG8_WAIT_L(0); PG8_BAR; PG8_MMA(0, 0, At, B0); PG8_MMA(0, 1, At, B1); PG8_BAR; PG8_SCHED;
            PG8_LDA(At, 1, 1); PG8_STAGE(PG8_SB(1, 0), b3, voffB); PG8_STAGE(PG8_SB(1, 1), b3 + hstep, voffB); PG8_STAGE(PG8_SA(1, 0), a3, w0);
            PG8_WAIT_V(8); PG8_WAIT_L(0); PG8_BAR; PG8_MMA(1, 0, At, B0); PG8_MMA(1, 1, At, B1); PG8_BAR; PG8_SCHED;
        }
        }
        if (wr == 0) PG8_BAR;
        if constexpr (FP8) asm volatile("s_nop 15\n\ts_nop 7" ::: "memory");
        if constexpr (!skip) E(acc, cur, wr, wc, fr, fq, est); else {
#pragma unroll
            for (int a = 0; a < 2; ++a)
#pragma unroll
                for (int b = 0; b < 2; ++b)
#pragma unroll
                    for (int m = 0; m < 4; ++m)
#pragma unroll
                        for (int n = 0; n < 2; ++n) asm volatile("" :: "v"(acc[a][b][m][n])); }
        if (!has_next) break;
#pragma unroll
        for (int a = 0; a < 2; ++a)
#pragma unroll
            for (int b = 0; b < 2; ++b)
#pragma unroll
                for (int m = 0; m < 4; ++m)
#pragma unroll
                    for (int n = 0; n < 2; ++n) acc[a][b][m][n] = (f32x4){0.f, 0.f, 0.f, 0.f};
        cur = nxt; cA = nA; cB = nB; ++ui;
        if constexpr (Sched::GATHER) { const u32x4 q = *(const LAS u32x4*)(lds + VN_STASH + tid * 16); vA[0][0] = q.x; vA[0][1] = q.y; vA[1][0] = q.z; vA[1][1] = q.w; }
        if (wr == 1) PG8_BAR;
    }
    PG8_WAIT_V(0);
    PG8_BAR;
#undef PG8_SA
#undef PG8_SB
#undef PG8_STAGE
#undef PG8_LDA
#undef PG8_LDB
#undef PG8_MMA
#undef PG8_LD16
#undef PG8_WAIT_V
#undef PG8_WAIT_L
#undef PG8_BAR
#undef PG8_SCHED
#undef PG8_AOFF
}
}

typedef f32x4 Acc[2][2][4][2];
struct EpiG1 {
    static constexpr bool HAS_MID = false;
    unsigned char* ws; const float* g_q; const float* g_k;
    struct State {}; __device__ __forceinline__ void mid(Acc&, const pg8::Unit&, int, int, int, int, State&) const {}
    __device__ __forceinline__ void operator()(Acc& acc, const pg8::Unit& u, int wr, int wc, int fr, int fq, State& st) const {
        const int pn = u.pn, row0 = u.pm * 256 + wr * 64 + fr;
        if (pn < 4) {
            const int isk = pn >> 1, hh = 4 * (pn & 1) + wc;
            const float* g = isk ? g_k : g_q;
            f32x4 gv[2][2];
#pragma unroll
            for (int bj = 0; bj < 2; ++bj)
#pragma unroll
                for (int n = 0; n < 2; ++n) gv[bj][n] = *(const f32x4*)(g + ((bj == 0 && fq < 2) ? 8 * n + 4 * fq : 32 * bj + 8 * fq + 4 * n));
            f32x4 cs_[2][2];
#pragma unroll
            for (int bj = 0; bj < 2; ++bj)
#pragma unroll
                for (int n = 0; n < 2; ++n) cs_[bj][n] = (f32x4){0.f, 0.f, 0.f, 0.f};
            f32x4 rf;
#pragma unroll
            for (int e = 0; e < 4; ++e) { const float f0 = exp2f(-(float)e * (0.125f * 18.931568569324174f)) * 0.15915494309189535f, f1 = exp2f(-(float)(4 + e) * (0.125f * 18.931568569324174f)) * 0.15915494309189535f;
                rf[e] = fq == 0 ? f0 : (fq == 1 ? f1 : 0.f); }
            bf16_t* dst = isk ? (bf16_t*)(ws + WS_K) : (bf16_t*)(ws + WS_YAB);
            const int pitch = isk ? 512 : 1024;
            const float sc = isk ? 1.f : C2;
#pragma unroll
            for (int ai = 0; ai < 2; ++ai)
#pragma unroll
                for (int m = 0; m < 4; ++m) {
                    const int r = row0 + 128 * ai + 16 * m; const float pos = (float)(r & (S - 1));
                    f32x4 v[2][2]; float ss = 0.f;
#pragma unroll
                    for (int bj = 0; bj < 2; ++bj)
#pragma unroll
                        for (int n = 0; n < 2; ++n) { v[bj][n] = acc[ai][bj][m][n]; ss += (v[bj][n].x * v[bj][n].x + v[bj][n].y * v[bj][n].y) + (v[bj][n].z * v[bj][n].z + v[bj][n].w * v[bj][n].w); }
                    ss = xrow16_sum(ss);
                    const float rinv = rsqrtf(ss * (1.f / 64.f) + EPS);
#pragma unroll
                    for (int bj = 0; bj < 2; ++bj)
#pragma unroll
                        for (int n = 0; n < 2; ++n) v[bj][n] = v[bj][n] * rinv * gv[bj][n];
#pragma unroll
                    for (int e = 0; e < 4; ++e) { const float rev = __builtin_amdgcn_fractf(pos * rf[e]), c = __builtin_amdgcn_cosf(rev), sn = __builtin_amdgcn_sinf(rev);
                        const float x1 = v[0][0][e], x2 = v[0][1][e]; v[0][0][e] = x1 * c - x2 * sn; v[0][1][e] = x2 * c + x1 * sn; }
                    if (isk) {
#pragma unroll
                        for (int bj = 0; bj < 2; ++bj)
#pragma unroll
                            for (int n = 0; n < 2; ++n) cs_[bj][n] += v[bj][n];
                    }
#pragma unroll
                    for (int bj = 0; bj < 2; ++bj) st16(dst + (size_t)r * pitch + hh * 64 + 32 * bj + 8 * fq, pack8v(v[bj][0] * sc, v[bj][1] * sc));
                }
            if (isk) {
                const int b = u.pm >> 4, blk = u.pm & 15;
                float* km = (float*)(ws + WS_KMEAN) + ((size_t)(b * NH + hh) * 16 + blk) * 64;
#pragma unroll
                for (int bj = 0; bj < 2; ++bj)
#pragma unroll
                    for (int n = 0; n < 2; ++n)
#pragma unroll
                        for (int e = 0; e < 4; ++e) { float s = cs_[bj][n][e]; s += dpp_ror<8>(s); s += dpp_ror<4>(s); s += dpp_ror<2>(s); s += dpp_ror<1>(s);
                            if (fr == 0) atomicAdd(km + 32 * bj + 8 * fq + 4 * n + e, s * (1.f / 256.f)); }
            }
        } else if (pn < 8) {
            bf16_t* dst = (bf16_t*)(ws + WS_U);
#pragma unroll
            for (int ai = 0; ai < 2; ++ai)
#pragma unroll
                for (int m = 0; m < 4; ++m) { const int r = row0 + 128 * ai + 16 * m;
                    const f32x4 a = acc[ai][0][m][0] * acc[ai][1][m][0], b = acc[ai][0][m][1] * acc[ai][1][m][1]; u32x4 w;
                    w.x = pk2(a.x, a.y); w.y = pk2(a.z, a.w); w.z = pk2(b.x, b.y); w.w = pk2(b.z, b.w);
                    st16(dst + (size_t)r * 512 + 128 * (pn - 4) + 32 * wc + 8 * fq, w); }
        } else {
            bf16_t* dst = (bf16_t*)(ws + WS_BG); const int pitch = 512, c0 = 256 * (pn - 8); const bool sig = false;
#pragma unroll
            for (int ai = 0; ai < 2; ++ai)
#pragma unroll
                for (int m = 0; m < 4; ++m) { const int r = row0 + 128 * ai + 16 * m;
#pragma unroll
                    for (int bj = 0; bj < 2; ++bj) { f32x4 a = acc[ai][bj][m][0], b = acc[ai][bj][m][1];
                        if (sig) {
#pragma unroll
                            for (int e = 0; e < 4; ++e) { a[e] = __builtin_amdgcn_rcpf(1.f + __expf(-a[e])); b[e] = __builtin_amdgcn_rcpf(1.f + __expf(-b[e])); } }
                        u32x4 w; w.x = pk2(a.x, a.y); w.y = pk2(a.z, a.w); w.z = pk2(b.x, b.y); w.w = pk2(b.z, b.w);
                        st16(dst + (size_t)r * pitch + c0 + 128 * bj + 32 * wc + 8 * fq, w); } }
        }
    }
};
struct EpiGate {
    static constexpr bool HAS_MID = false;
    bf16_t* gates; bf16_t* vout;
    struct State {}; __device__ __forceinline__ void mid(Acc&, const pg8::Unit&, int, int, int, int, State&) const {}
    __device__ __forceinline__ void operator()(Acc& acc, const pg8::Unit& u, int wr, int wc, int fr, int fq, State& st) const {
        int row0 = u.pm * 256 + wr * 64 + fr; const int c0 = u.pn * 256 + 32 * wc + 8 * fq; asm volatile("" : "+v"(row0));
#pragma unroll
        for (int ai = 0; ai < 2; ++ai)
#pragma unroll
            for (int m = 0; m < 4; ++m) { const size_t r = (size_t)(row0 + 128 * ai + 16 * m);
                if (u.pn < 8) {
                    f32x4 ra[2], gb[2];
#pragma unroll
                    for (int n = 0; n < 2; ++n)
#pragma unroll
                        for (int e = 0; e < 4; ++e) { const float xa = __builtin_amdgcn_fmed3f(acc[ai][0][m][n][e] * (-1.f / W8_SCALE), -40.f, 40.f), xb = __builtin_amdgcn_fmed3f(acc[ai][1][m][n][e] * (-1.f / W8_SCALE), -40.f, 40.f);
                            const float pa = 1.f + __expf(xa), pb = 1.f + __expf(xb), rr = __builtin_amdgcn_rcpf(pa * pb);
                            gb[n][e] = rr * pa; ra[n][e] = fminf(pb * pb * rr, 3e4f); }
                    const size_t gc = ((size_t)(u.pm * 4 + (u.pn >> 1)) * 256 + (size_t)(r - (size_t)u.pm * 256)) * 256 + 128 * (u.pn & 1) + 32 * wc + 8 * fq;
                    st16(gates + gc, pack8v(ra[0], ra[1])); st16(gates + gc + (size_t)T * 1024, pack8v(gb[0], gb[1]));
                } else {
#pragma unroll
                    for (int bj = 0; bj < 2; ++bj) st16(vout + r * 512 + (c0 - 2048) + 128 * bj, pack8v(acc[ai][bj][m][0] * (1.f / W8_SCALE), acc[ai][bj][m][1] * (1.f / W8_SCALE))); } }
    }
};
__device__ __forceinline__ void s2_fast(Frame& F) {
    {
        const pg8::DenseSched Sd{(const char*)(F.ws + WS_H), (const char*)(F.ws + WS_WIN_T), T / 256, 10, 1024, F.G, (int)blockIdx.x};
        const EpiG1 E{F.ws, F.g_q, F.g_k};
        if (F.skip) pg8::gemm_phase<EpiG1, pg8::DenseSched, true>(F.lds, 1024, Sd, E); else pg8::gemm_phase<EpiG1, pg8::DenseSched>(F.lds, 1024, Sd, E); }
    {
        const pg8::DenseSched8 Sd{(const char*)(F.ws + WS_H8), (const char*)(F.ws + WS_WIN8), T / 256, 10, 1024, F.G, (int)blockIdx.x};
        const EpiGate E{WSP(bf16_t, WS_GATES), WSP(bf16_t, WS_V)};
        int Kg = D; asm volatile("" : "+s"(Kg));
        if (F.skip) pg8::gemm_phase<EpiGate, pg8::DenseSched8, true>(F.lds, Kg, Sd, E); else pg8::gemm_phase<EpiGate, pg8::DenseSched8>(F.lds, Kg, Sd, E); }
}

constexpr float NEG_BIG = -1e30f;
__device__ __forceinline__ void s3_simple(Frame& F) {
    LAS float* tS = (LAS float*)F.lds;
    LAS bf16_t* Pb = (LAS bf16_t*)(F.lds + 16896);
    LAS bf16_t* Vt = (LAS bf16_t*)(F.lds + 16896 + 9216);
    LAS float* mrow = (LAS float*)(F.lds + 16896 + 18432);
    LAS float* lrow = mrow + 64; LAS float* arow_ = mrow + 128; LAS int* sel = (LAS int*)(mrow + 192); LAS int* um = sel + 64;
    bf16_t* YAB = WSP(bf16_t, WS_YAB); const bf16_t* Kb = WSP(bf16_t, WS_K); const bf16_t* Vb = WSP(bf16_t, WS_V);
    const float* kmean = WSP(float, WS_KMEAN);
    const int row = F.tid >> 3, seg = F.tid & 7, fr = F.lane & 15, fq = F.lane >> 4, rb = 16 * (F.wave & 3), cb = 32 * (F.wave >> 2);
    for (int it = blockIdx.x; it < NB * NH * 64; it += F.G) {
        const int qc = it & 63, h = (it >> 6) & 7, b = it >> 9, cur = qc >> 2, t0 = 64 * qc;
        const size_t tb = (size_t)b * S;
        if (F.tid < 64) {
            float q[64];
            const bf16_t* qp = YAB + (tb + t0 + F.tid) * 1024 + h * 64;
#pragma unroll
            for (int i = 0; i < 8; ++i) { float t8[8]; unpack8(*(const u32x4*)(qp + 8 * i), t8);
#pragma unroll
                for (int e = 0; e < 8; ++e) q[8 * i + e] = t8[e]; }
            float b0 = -INFINITY, b1 = -INFINITY, b2 = -INFINITY; int i0 = -1, i1 = -1, i2 = -1;
            for (int j = 0; j < cur; ++j) { const float* km = kmean + ((size_t)(b * NH + h) * 16 + j) * 64; float s = 0.f;
#pragma unroll
                for (int d = 0; d < 64; ++d) s += q[d] * km[d];
                if (s > b0) { b2 = b1; i2 = i1; b1 = b0; i1 = i0; b0 = s; i0 = j; } else if (s > b1) { b2 = b1; i2 = i1; b1 = s; i1 = j; } else if (s > b2) { b2 = s; i2 = j; } }
            int m = 0; if (i0 >= 0) m |= 1 << i0; if (i1 >= 0) m |= 1 << i1; if (i2 >= 0) m |= 1 << i2;
            sel[F.tid] = m; mrow[F.tid] = NEG_BIG; lrow[F.tid] = 0.f;
            int u = m;
#pragma unroll
            for (int o = 1; o < 64; o <<= 1) u |= __shfl_xor(u, o);
            if (F.tid == 0) um[0] = u;
        }
        __syncthreads();
        const int umask = um[0];
        f32x4 o0 = {0.f, 0.f, 0.f, 0.f}, o1 = {0.f, 0.f, 0.f, 0.f};
        const RowsLinear aq{YAB + (tb + t0) * 1024 + h * 64, 1024};
        for (int j = 0; j <= cur; ++j) {
            if (j < cur && !((umask >> j) & 1)) continue;
            const int nkt = (j == cur) ? ((qc & 3) + 1) : 4;
            for (int kt = 0; kt < nkt; ++kt) {
                const int kbase = 256 * j + 64 * kt;
                const RowsLinear bk{Kb + (tb + kbase) * 512 + h * 64, 512};
                sgemm_tile(tS, 64, aq, bk, F.wave, F.lane);
                { float vv[8]; unpack8(*(const u32x4*)(Vb + (tb + kbase + row) * 512 + h * 64 + 8 * seg), vv);
#pragma unroll
                    for (int e = 0; e < 8; ++e) Vt[(8 * seg + e) * 72 + row] = (bf16_t)f2bf(vv[e]); }
                __syncthreads();
                {
                    float s[8]; float mx = NEG_BIG;
                    const bool rowsel = (j == cur) || ((sel[row] >> j) & 1);
#pragma unroll
                    for (int e = 0; e < 8; ++e) { const int c = 8 * seg + e; float x = tS[row * 65 + c];
                        if (!rowsel || (j == cur && kbase + c > t0 + row)) x = NEG_BIG; s[e] = x; mx = fmaxf(mx, x); }
                    mx = fmaxf(mx, __shfl_xor(mx, 1)); mx = fmaxf(mx, __shfl_xor(mx, 2)); mx = fmaxf(mx, __shfl_xor(mx, 4));
                    const float mold = mrow[row], mnew = fmaxf(mold, mx);
                    float alpha = 1.f, ps = 0.f; float p[8];
                    if (mnew <= NEG_BIG) {
#pragma unroll
                        for (int e = 0; e < 8; ++e) p[e] = 0.f;
                    } else { alpha = exp2f(mold - mnew);
#pragma unroll
                        for (int e = 0; e < 8; ++e) { p[e] = (s[e] <= NEG_BIG) ? 0.f : exp2f(s[e] - mnew); ps += p[e]; } }
                    ps += __shfl_xor(ps, 1); ps += __shfl_xor(ps, 2); ps += __shfl_xor(ps, 4);
                    const float lold = lrow[row];
                    *(LAS u32x4*)(Pb + row * 72 + 8 * seg) = pack8(p);
                    if (seg == 0) { mrow[row] = mnew; lrow[row] = lold * alpha + ps; arow_[row] = alpha; }
                }
                __syncthreads();
                {
#pragma unroll
                    for (int r = 0; r < 4; ++r) { const float a = arow_[rb + fq * 4 + r]; o0[r] *= a; o1[r] *= a; }
#pragma unroll
                    for (int ks = 0; ks < 2; ++ks) {
                        const bf16x8 a = *(const LAS bf16x8*)(Pb + (rb + fr) * 72 + 32 * ks + 8 * fq);
                        const bf16x8 v0 = *(const LAS bf16x8*)(Vt + (cb + fr) * 72 + 32 * ks + 8 * fq);
                        const bf16x8 v1 = *(const LAS bf16x8*)(Vt + (cb + 16 + fr) * 72 + 32 * ks + 8 * fq);
                        o0 = __builtin_amdgcn_mfma_f32_16x16x32_bf16(a, v0, o0, 0, 0, 0);
                        o1 = __builtin_amdgcn_mfma_f32_16x16x32_bf16(a, v1, o1, 0, 0, 0);
                    }
                }
                __syncthreads();
            }
        }
#pragma unroll
        for (int r = 0; r < 4; ++r) { const float li = 1.f / lrow[rb + fq * 4 + r]; tS[(rb + fq * 4 + r) * 65 + cb + fr] = o0[r] * li; tS[(rb + fq * 4 + r) * 65 + cb + 16 + fr] = o1[r] * li; }
        __syncthreads();
        { float v[8];
#pragma unroll
            for (int e = 0; e < 8; ++e) v[e] = tS[row * 65 + 8 * seg + e];
            *(u32x4*)(YAB + (tb + t0 + row) * 1024 + h * 64 + 8 * seg) = pack8(v); }
        __syncthreads();
    }
    const bf16_t* U = WSP(bf16_t, WS_U); const bf16_t* BG = WSP(bf16_t, WS_BG);
    for (int i = blockIdx.x * NTHREADS + F.tid; i < T * 64; i += F.G * NTHREADS) {
        const int t = i >> 6, c0 = (i & 63) * 8, pos = t & (S - 1);
        float u0[8], u1[8], u2[8], bg[8], y[8];
        unpack8(*(const u32x4*)(U + (size_t)t * 512 + c0), u2); unpack8(*(const u32x4*)(BG + (size_t)t * 512 + c0), bg);
        if (pos >= 1) unpack8(*(const u32x4*)(U + (size_t)(t - 1) * 512 + c0), u1); else {
#pragma unroll
            for (int e = 0; e < 8; ++e) u1[e] = 0.f; }
        if (pos >= 2) unpack8(*(const u32x4*)(U + (size_t)(t - 2) * 512 + c0), u0); else {
#pragma unroll
            for (int e = 0; e < 8; ++e) u0[e] = 0.f; }
#pragma unroll
        for (int e = 0; e < 8; ++e) y[e] = bg[e] * (F.conv_w[c0 + e] * u0[e] + F.conv_w[512 + c0 + e] * u1[e] + F.conv_w[1024 + c0 + e] * u2[e] + F.conv_b[c0 + e]);
        *(u32x4*)(YAB + (size_t)t * 1024 + 512 + c0) = pack8(y);
    }
}

namespace attn_body {
using bf16x8 = __attribute__((ext_vector_type(8))) short;
using s16x4 = __attribute__((ext_vector_type(4))) short;
using f32x16 = __attribute__((ext_vector_type(16))) float;
using u32x4 = __attribute__((ext_vector_type(4))) unsigned;
constexpr int SEQ = 4096, D = 64, DMQ = 1024, DMK = 512;
constexpr int NW = 8, QBLK = 32, QB = QBLK * NW, KVBLK = 64;
constexpr float NEGB = -1e30f;
__device__ __forceinline__ int crow(int r, int hi) { return (r & 3) + 8 * (r >> 2) + 4 * hi; }
#define SBAR() __builtin_amdgcn_sched_barrier(0)
__device__ __forceinline__ void cmask(f32x16& p0, f32x16& p1, int jb, int qrel, int hi) {
  const float NEG = -INFINITY; int kb = 64 * jb + 4 * hi;
  #pragma unroll
  for (int r = 0; r < 16; ++r) { int kv = kb + (r & 3) + 8 * (r >> 2); if (kv > qrel) p0[r] = NEG; if (kv + 32 > qrel) p1[r] = NEG; }
}
constexpr int NSLOT = 3, SLOTB = 8192;
constexpr int LDS_K = 0, LDS_V = NSLOT * SLOTB, LDS_WS = 2 * NSLOT * SLOTB, LDS_OST = LDS_WS + NW * 128 * 4, LDS_BYTES_A = LDS_OST + NW * 4096;
__device__ __forceinline__ void glds16(const void* gsrc, unsigned lds_dst) { unsigned keep;
  asm volatile("s_mov_b32 %0, m0\n\ts_mov_b32 m0, %2\n\ts_nop 0\n\tglobal_load_lds_dwordx4 %1, off\n\ts_mov_b32 m0, %0" : "=&s"(keep) : "v"(gsrc), "s"(lds_dst) : "memory"); }
__device__ __forceinline__ float max3f(float a, float b, float c) { float r; asm("v_max3_f32 %0, %1, %2, %3" : "=v"(r) : "v"(a), "v"(b), "v"(c)); return r; }
__device__ __forceinline__ float max2f(float a, float b) { float r; asm("v_max_f32_e32 %0, %1, %2" : "=v"(r) : "v"(a), "v"(b)); return r; }
__device__ __forceinline__ float fadd_s(float a, float b) { float r; asm("v_add_f32_e32 %0, %1, %2" : "=v"(r) : "v"(a), "v"(b)); return r; }
__device__ __forceinline__ float fsub_s(float a, float b) { float r; asm("v_sub_f32_e32 %0, %1, %2" : "=v"(r) : "v"(a), "v"(b)); return r; }
typedef float f32x2_t __attribute__((ext_vector_type(2))); typedef __bf16 bf16x2_t __attribute__((ext_vector_type(2)));
__device__ __forceinline__ unsigned cvtpk_s(float lo, float hi) { f32x2_t v = {lo, hi}; bf16x2_t b = __builtin_convertvector(v, bf16x2_t); return __builtin_bit_cast(unsigned, b); }
#define WAIT_BAR(N) asm volatile("s_waitcnt vmcnt(" #N ") lgkmcnt(0)\n\ts_barrier" ::: "memory")
__device__ __forceinline__ void qkt(f32x16& p0, f32x16& p1, const char* Kslot, const bf16x8* qr, const f32x16& negm, int r32, int hi) {
  const char* kb = Kslot + hi * 1024 + r32 * 16;
  #pragma unroll
  for (int d0 = 0; d0 < 4; ++d0) {
    const bf16x8 b0 = *reinterpret_cast<const bf16x8*>(kb + d0 * 2048);
    const bf16x8 b1 = *reinterpret_cast<const bf16x8*>(kb + d0 * 2048 + 512);
    if (d0 == 0) { p0 = __builtin_amdgcn_mfma_f32_32x32x16_bf16(b0, qr[0], negm, 0, 0, 0); p1 = __builtin_amdgcn_mfma_f32_32x32x16_bf16(b1, qr[0], negm, 0, 0, 0); }
    else { p0 = __builtin_amdgcn_mfma_f32_32x32x16_bf16(b0, qr[d0], p0, 0, 0, 0); p1 = __builtin_amdgcn_mfma_f32_32x32x16_bf16(b1, qr[d0], p1, 0, 0, 0); } }
}
typedef __attribute__((address_space(3))) const char* lds_cptr;
typedef __attribute__((address_space(3))) char* lds_ptr;
typedef short v4i16_t __attribute__((ext_vector_type(4)));
__device__ __forceinline__ void kload8(bf16x8* kf, lds_cptr kp) {
  kf[0] = *(const __attribute__((address_space(3))) bf16x8*)(kp);        kf[1] = *(const __attribute__((address_space(3))) bf16x8*)(kp + 512);
  kf[2] = *(const __attribute__((address_space(3))) bf16x8*)(kp + 2048); kf[3] = *(const __attribute__((address_space(3))) bf16x8*)(kp + 2560);
  kf[4] = *(const __attribute__((address_space(3))) bf16x8*)(kp + 4096); kf[5] = *(const __attribute__((address_space(3))) bf16x8*)(kp + 4608);
  kf[6] = *(const __attribute__((address_space(3))) bf16x8*)(kp + 6144); kf[7] = *(const __attribute__((address_space(3))) bf16x8*)(kp + 6656);
}
__device__ __forceinline__ void kload2(bf16x8* kf, lds_cptr kp, int j) { kf[2 * j] = *(const __attribute__((address_space(3))) bf16x8*)(kp + j * 2048); kf[2 * j + 1] = *(const __attribute__((address_space(3))) bf16x8*)(kp + j * 2048 + 512); }
__device__ __forceinline__ s16x4 vtr(lds_cptr p) { return __builtin_bit_cast(s16x4, __builtin_amdgcn_ds_read_tr16_b64_v4i16((__attribute__((address_space(3))) v4i16_t*)p)); }
__device__ __forceinline__ float rowmax(const f32x16& p0, const f32x16& p1) {
  float a = max3f(p0[0], p0[1], p1[0]), b = max3f(p0[2], p0[3], p1[1]); a = max3f(a, p1[2], p1[3]);
  #pragma unroll
  for (int r = 4; r < 16; r += 4) { a = max3f(a, p0[r], p0[r + 1]); b = max3f(b, p0[r + 2], p0[r + 3]); a = max3f(a, p1[r], p1[r + 1]); b = max3f(b, p1[r + 2], p1[r + 3]); }
  const float m = max2f(a, b);
  auto rr = __builtin_amdgcn_permlane32_swap(__float_as_uint(m), __float_as_uint(m), false, false);
  return max2f(__uint_as_float(rr[0]), __uint_as_float(rr[1]));
}
__device__ __forceinline__ void pv(f32x16* o, int vb, bf16x8 pa0, bf16x8 pa1, bf16x8 pa2, bf16x8 pa3) {
  #pragma unroll
  for (int d0 = 0; d0 < 2; ++d0) { s16x4 lo[4], hi[4];
    #pragma unroll
    for (int ks = 0; ks < 4; ++ks) {
      asm volatile("ds_read_b64_tr_b16 %0,%1 offset:%c2" : "=&v"(lo[ks]) : "v"(vb), "i"(d0 * 4096 + ks * 1024) : "memory");
      asm volatile("ds_read_b64_tr_b16 %0,%1 offset:%c2" : "=&v"(hi[ks]) : "v"(vb), "i"(d0 * 4096 + ks * 1024 + 512) : "memory"); }
    asm volatile("s_waitcnt lgkmcnt(0)" ::: "memory"); SBAR();
    #define PK(k) (bf16x8){lo[k][0], lo[k][1], lo[k][2], lo[k][3], hi[k][0], hi[k][1], hi[k][2], hi[k][3]}
    o[d0] = __builtin_amdgcn_mfma_f32_32x32x16_bf16(pa0, PK(0), o[d0], 0, 0, 0);
    o[d0] = __builtin_amdgcn_mfma_f32_32x32x16_bf16(pa1, PK(1), o[d0], 0, 0, 0);
    o[d0] = __builtin_amdgcn_mfma_f32_32x32x16_bf16(pa2, PK(2), o[d0], 0, 0, 0);
    o[d0] = __builtin_amdgcn_mfma_f32_32x32x16_bf16(pa3, PK(3), o[d0], 0, 0, 0);
    #undef PK
  }
}
#define ATTN_STORE16(p, v) st16((p), (v))
template <int THRL> __device__ __forceinline__ void attn_unit(int b, int h, int qb, const bf16_t* QO, bf16_t* Ob, const bf16_t* __restrict__ K, const bf16_t* __restrict__ V, const float* __restrict__ kmean, char* shm) {
  int tid_ = threadIdx.x; asm volatile("" : "+v"(tid_));
  const int tid = tid_, lane = tid & 63, r32 = lane & 31, hi = lane >> 5; const int wid = __builtin_amdgcn_readfirstlane(tid >> 6);
  const long rowbase = (long)b * SEQ; const int q0 = qb * QB;
  const bf16_t* Qw = QO + (rowbase + q0 + wid * QBLK) * DMQ + h * D;
  const bf16_t* Kh = K + rowbase * DMK + h * D, *Vh = V + rowbase * DMK + h * D;
  const unsigned lds0 = (unsigned)(uintptr_t)shm;
  float* wsf = (float*)(shm + LDS_WS) + wid * 128;
  const bf16_t* ksrc = Kh + (long)lane * DMK + wid * 8;
  const bf16_t* vsrc = Vh + (long)(16 * (wid & 3) + (lane >> 2)) * DMK + (wid >> 2) * 32 + (lane & 3) * 8;
  const unsigned kdst = lds0 + LDS_K + wid * 1024, vdst = lds0 + LDS_V + wid * 1024;
  #define DMA_K(t, slot) glds16(ksrc + (long)(t) * KVBLK * DMK, (unsigned)__builtin_amdgcn_readfirstlane(kdst + (slot)))
  #define DMA_V(t, slot) glds16(vsrc + (long)(t) * KVBLK * DMK, (unsigned)__builtin_amdgcn_readfirstlane(vdst + (slot)))
  DMA_K(0, 0); DMA_V(0, 0); DMA_K(1, SLOTB);
  bf16x8 qr[4];
  #pragma unroll
  for (int d0 = 0; d0 < 4; ++d0) qr[d0] = *reinterpret_cast<const bf16x8*>(&Qw[(long)r32 * DMQ + d0 * 16 + hi * 8]);
  unsigned selm = 0u;
  if (qb > 0) {
    float* kmL = (float*)(shm + LDS_OST);
    const float* kmg = kmean + ((size_t)(b * 8 + h) * 16) * 64;
    for (int i = tid; i < qb * 64; i += 512) kmL[i] = kmg[i];
    asm volatile("s_waitcnt vmcnt(0) lgkmcnt(0)\n\ts_barrier" ::: "memory");
    float qf[32];
    #pragma unroll
    for (int d0 = 0; d0 < 4; ++d0)
      #pragma unroll
      for (int e = 0; e < 8; ++e) qf[8 * d0 + e] = __uint_as_float(((unsigned)(unsigned short)qr[d0][e]) << 16);
    float b0 = -INFINITY, b1 = -INFINITY, b2 = -INFINITY; int i0 = -1, i1 = -1, i2 = -1;
    for (int j = 0; j < qb; ++j) {
      const float* km = kmL + j * 64 + 8 * hi; float sc = 0.f;
      #pragma unroll
      for (int d0 = 0; d0 < 4; ++d0)
        #pragma unroll
        for (int e = 0; e < 8; ++e) sc += qf[8 * d0 + e] * km[16 * d0 + e];
      sc += __shfl_xor(sc, 32);
      if (sc > b0) { b2 = b1; i2 = i1; b1 = b0; i1 = i0; b0 = sc; i0 = j; } else if (sc > b1) { b2 = b1; i2 = i1; b1 = sc; i1 = j; } else if (sc > b2) { b2 = sc; i2 = j; }
    }
    if (i0 >= 0) selm |= 1u << i0; if (i1 >= 0) selm |= 1u << i1; if (i2 >= 0) selm |= 1u << i2;
    asm volatile("s_waitcnt lgkmcnt(0)\n\ts_barrier" ::: "memory");
  }
  if (hi == 0) ((unsigned*)wsf)[64 + r32] = selm;
  { const lds_ptr qst = (lds_ptr)shm + LDS_OST + wid * 4096 + lane * 16;
    #pragma unroll
    for (int d0 = 0; d0 < 4; ++d0) *(__attribute__((address_space(3))) bf16x8*)(qst + d0 * 1024) = qr[d0]; }
  #define SELROW(j) (((j) >= qb) || ((((const unsigned*)wsf)[64 + r32] >> (j)) & 1u))
  #define NEGM_SET(blk) do { const float nv_ = SELROW(blk) ? -mhat : NEGB; _Pragma("unroll") for (int r = 0; r < 16; ++r) negm[r] = nv_; asm volatile("" : "+v"(negm)); } while (0)
  const int vb0 = (int)(lds0 + LDS_V) + ((lane >> 4) & 1) * 32 + (lane & 3) * 8 + (4 * hi + ((lane & 15) >> 2)) * 64;
  const char* Kbase = shm + LDS_K; bf16x8 kf[8];
  const lds_cptr qp0 = (lds_cptr)shm + LDS_OST + wid * 4096 + lane * 16;
  const lds_cptr shm3 = (lds_cptr)shm; const lds_cptr kp0 = shm3 + LDS_K + hi * 1024 + r32 * 16; const lds_cptr vp0 = shm3 + LDS_V + ((lane >> 4) & 1) * 32 + (lane & 3) * 8 + (4 * hi + ((lane & 15) >> 2)) * 64;
  const int NT = (q0 + QB) / KVBLK;
  float mhat = 0.f, l_reg = 0.f; f32x16 o[2]; o[0] = f32x16{}; o[1] = f32x16{}; f32x16 negm;
  NEGM_SET(0);
  const int qrel = wid * QBLK + r32;
  #define CMASK(P0, P1, t) do { int jb_ = (t) - (NT - 4); if (jb_ >= 0) cmask(P0, P1, jb_, qrel, hi); } while (0)
  bool resc = false;
  #define START(P0, P1) do { const float rm = rowmax(P0, P1); resc = false; \
    { const float dl = SELROW(0) ? rm : 0.f; mhat = fadd_s(mhat, dl); \
      _Pragma("unroll") for (int r = 0; r < 16; ++r) { P0[r] = fsub_s(P0[r], dl); P1[r] = fsub_s(P1[r], dl); } \
      NEGM_SET(0); } \
    _Pragma("unroll") for (int r = 0; r < 16; ++r) P0[r] = __builtin_amdgcn_exp2f(P0[r]); } while (0)
  #define RESC() do { if (resc) { asm volatile("s_waitcnt lgkmcnt(0)" ::: "memory"); \
      _Pragma("unroll") for (int d_ = 0; d_ < 2; ++d_) _Pragma("unroll") for (int r = 0; r < 16; ++r) o[d_][r] *= wsf[crow(r, hi)]; } } while (0)
  f32x16 pA0, pA1, pB0, pB1;
  int sl_prev = 0, sl_cur = 0, sl_next = SLOTB;
  #define ROT() do { sl_prev = sl_cur; sl_cur = sl_next; sl_next = (sl_next == (NSLOT - 1) * SLOTB) ? 0 : sl_next + SLOTB; } while (0)
  DMA_K(2, 2 * SLOTB);
  WAIT_BAR(3);
  qkt(pA0, pA1, Kbase, qr, negm, r32, hi); asm volatile("s_nop 15\n\ts_nop 7" : "+v"(pA0), "+v"(pA1)); CMASK(pA0, pA1, 0);
  START(pA0, pA1);
  _Pragma("unroll") for (int r = 0; r < 16; ++r) pA1[r] = __builtin_amdgcn_exp2f(pA1[r]);
  WAIT_BAR(0);
  DMA_K(3, 0); DMA_V(1, SLOTB);
  ROT();
  kload8(kf, kp0 + sl_cur);
  WAIT_BAR(2);
  s16x4 vlo[8], vhi[8]; u32x4 pw0, pw1, pw2, pw3; bf16x8 q0_, q1_, q2_, q3_;
  #define QRD(d) do { q##d##_ = *(const __attribute__((address_space(3))) bf16x8*)(qp0 + (d) * 1024); } while (0)
  QRD(0); QRD(1);
  #define PKW(P, B) cvtpk_s(P[B], P[B + 1])
  #define PAF(k) __builtin_bit_cast(bf16x8, pw##k)
  #define VFR(i) (bf16x8){vlo[i][0], vlo[i][1], vlo[i][2], vlo[i][3], vhi[i][0], vhi[i][1], vhi[i][2], vhi[i][3]}
  #define PIN(x) asm volatile("" : "+v"(x))
  #define MX3(a, b, c) __builtin_fmaxf(__builtin_fmaxf((a), (b)), (c))
  #define GAPA(MF, A0, A1, A2, A3, W0, W1, PW) do { MF; sacc += A0; sacc += A1; sacc += A2; sacc += A3; PIN(sacc); W0; W1; PIN(PW); SBAR(); } while (0)
  #define EX(v) __builtin_amdgcn_exp2f(v)
  #define GAPB(MF, X, B) do { MF; X[B] = EX(X[B]); X[B + 1] = EX(X[B + 1]); X[B + 2] = EX(X[B + 2]); X[B + 3] = EX(X[B + 3]); PIN(X); SBAR(); } while (0)
  #define VRD(i) do { vlo[i] = vtr(vp_ + (((i) >> 2) * 4096 + ((i) & 3) * 1024)); vhi[i] = vtr(vp_ + (((i) >> 2) * 4096 + ((i) & 3) * 1024 + 512)); } while (0)
  #define KRD(G, j) do { if (G) { kload2(kf, kp0 + sl_next, j); SBAR(); } } while (0)
  #define STEP(C0, C1, P0, P1, t, GK, GV, GL) do { SBAR(); \
    const lds_cptr vp_ = vp0 + sl_prev; \
    VRD(0); SBAR(); float sacc = (P0[0] + P0[1]); \
    GAPA(C0 = __builtin_amdgcn_mfma_f32_32x32x16_bf16(kf[0], q0_, negm, 0, 0, 0), P0[2], P0[3], P0[4], P0[5],     pw0[0] = PKW(P0, 0), pw0[1] = PKW(P0, 2), pw0); \
    VRD(4); SBAR(); GAPA(C1 = __builtin_amdgcn_mfma_f32_32x32x16_bf16(kf[1], q0_, negm, 0, 0, 0), P0[6], P0[7], P0[8], P0[9],     pw0[2] = PKW(P0, 4), pw0[3] = PKW(P0, 6), pw0); \
    QRD(2); SBAR(); \
    VRD(1); SBAR(); GAPA(C0 = __builtin_amdgcn_mfma_f32_32x32x16_bf16(kf[2], q1_, C0, 0, 0, 0),   P0[10], P0[11], P0[12], P0[13], pw1[0] = PKW(P0, 8), pw1[1] = PKW(P0, 10), pw1); \
    VRD(5); SBAR(); GAPA(C1 = __builtin_amdgcn_mfma_f32_32x32x16_bf16(kf[3], q1_, C1, 0, 0, 0),   P0[14], P0[15], P1[0], P1[1],   pw1[2] = PKW(P0, 12), pw1[3] = PKW(P0, 14), pw1); \
    QRD(3); SBAR(); \
    VRD(2); SBAR(); GAPA(C0 = __builtin_amdgcn_mfma_f32_32x32x16_bf16(kf[4], q2_, C0, 0, 0, 0),   P1[2], P1[3], P1[4], P1[5],     pw2[0] = PKW(P1, 0), pw2[1] = PKW(P1, 2), pw2); \
    VRD(6); SBAR(); GAPA(C1 = __builtin_amdgcn_mfma_f32_32x32x16_bf16(kf[5], q2_, C1, 0, 0, 0),   P1[6], P1[7], P1[8], P1[9],     pw2[2] = PKW(P1, 4), pw2[3] = PKW(P1, 6), pw2); \
    VRD(3); SBAR(); GAPA(C0 = __builtin_amdgcn_mfma_f32_32x32x16_bf16(kf[6], q3_, C0, 0, 0, 0),   P1[10], P1[11], P1[12], P1[13], pw3[0] = PKW(P1, 8), pw3[1] = PKW(P1, 10), pw3); \
    VRD(7); SBAR(); GAPA(C1 = __builtin_amdgcn_mfma_f32_32x32x16_bf16(kf[7], q3_, C1, 0, 0, 0),   P1[14], P1[15], 0.f, 0.f,       pw3[2] = PKW(P1, 12), pw3[3] = PKW(P1, 14), pw3); \
    l_reg += sacc; \
    if (GK) { DMA_K((t) + 3, sl_cur); } if (GV) { DMA_V((t) + 1, sl_next); } \
    CMASK(C0, C1, t); \
    { float a = MX3(C0[0], C0[1], C1[0]), b = MX3(C0[2], C0[3], C1[1]); a = MX3(a, C1[2], C1[3]); \
      _Pragma("unroll") for (int r = 4; r < 16; r += 4) { a = MX3(a, C0[r], C0[r + 1]); b = MX3(b, C0[r + 2], C0[r + 3]); a = MX3(a, C1[r], C1[r + 1]); b = MX3(b, C1[r + 2], C1[r + 3]); } \
      float rm = __builtin_fmaxf(a, b); { auto rr = __builtin_amdgcn_permlane32_swap(__float_as_uint(rm), __float_as_uint(rm), false, false); rm = __builtin_fmaxf(__uint_as_float(rr[0]), __uint_as_float(rr[1])); } \
      resc = false; \
      if (__builtin_expect(__any(rm > (float)THRL), 0)) { const float dl = __builtin_fmaxf(rm, 0.f); mhat += dl; \
        _Pragma("unroll") for (int r = 0; r < 16; ++r) { C0[r] -= dl; C1[r] -= dl; } \
        NEGM_SET(((t) + 1) >> 2); \
        const float f = __builtin_amdgcn_exp2f(-dl); l_reg *= f; if (hi == 0) wsf[r32] = f; resc = true; } \
      else if ((((t) + 1) & 3) == 0) { NEGM_SET(((t) + 1) >> 2); } } \
    SBAR(); \
    GAPB(o[0] = __builtin_amdgcn_mfma_f32_32x32x16_bf16(PAF(0), VFR(0), o[0], 0, 0, 0), C0, 0); \
    GAPB(o[1] = __builtin_amdgcn_mfma_f32_32x32x16_bf16(PAF(0), VFR(4), o[1], 0, 0, 0), C0, 4); \
    KRD(GL, 0); GAPB(o[0] = __builtin_amdgcn_mfma_f32_32x32x16_bf16(PAF(1), VFR(1), o[0], 0, 0, 0), C0, 8); \
    KRD(GL, 1); GAPB(o[1] = __builtin_amdgcn_mfma_f32_32x32x16_bf16(PAF(1), VFR(5), o[1], 0, 0, 0), C0, 12); \
    KRD(GL, 2); GAPB(o[0] = __builtin_amdgcn_mfma_f32_32x32x16_bf16(PAF(2), VFR(2), o[0], 0, 0, 0), C1, 0); \
    KRD(GL, 3); GAPB(o[1] = __builtin_amdgcn_mfma_f32_32x32x16_bf16(PAF(2), VFR(6), o[1], 0, 0, 0), C1, 4); \
    GAPB(o[0] = __builtin_amdgcn_mfma_f32_32x32x16_bf16(PAF(3), VFR(3), o[0], 0, 0, 0), C1, 8); \
    GAPB(o[1] = __builtin_amdgcn_mfma_f32_32x32x16_bf16(PAF(3), VFR(7), o[1], 0, 0, 0), C1, 12); \
    QRD(0); QRD(1); SBAR(); \
    } while (0)
  int t = 1;
  #undef CMASK
  #define CMASK(P0, P1, t) do {} while (0)
  for (; t + 5 < NT; t += 2) {
    STEP(pB0, pB1, pA0, pA1, t, true, true, true);     WAIT_BAR(2); RESC(); ROT();
    STEP(pA0, pA1, pB0, pB1, t + 1, true, true, true); WAIT_BAR(2); RESC(); ROT();
  }
  #undef CMASK
  #define CMASK(P0, P1, t) do { int jb_ = (t) - (NT - 4); if (jb_ >= 0) cmask(P0, P1, jb_, qrel, hi); } while (0)
  #define ENDW(tt) do { if ((tt) + 3 < NT) { WAIT_BAR(2); } else if ((tt) + 2 < NT) { WAIT_BAR(1); } else { WAIT_BAR(0); } } while (0)
  for (; t + 1 < NT; t += 2) {
    STEP(pB0, pB1, pA0, pA1, t, (t + 3 < NT), (t + 1 < NT), (t + 1 < NT));       ENDW(t);     RESC(); ROT();
    STEP(pA0, pA1, pB0, pB1, t + 1, (t + 4 < NT), (t + 2 < NT), (t + 2 < NT));   ENDW(t + 1); RESC(); ROT();
  }
  STEP(pB0, pB1, pA0, pA1, NT - 1, false, false, false); RESC();
  { float sacc = pB0[0] + pB0[1]; _Pragma("unroll") for (int r = 2; r < 16; ++r) sacc += pB0[r]; _Pragma("unroll") for (int r = 0; r < 16; ++r) sacc += pB1[r]; l_reg += sacc;
    pw0 = (u32x4){PKW(pB0, 0), PKW(pB0, 2), PKW(pB0, 4), PKW(pB0, 6)}; pw1 = (u32x4){PKW(pB0, 8), PKW(pB0, 10), PKW(pB0, 12), PKW(pB0, 14)}; pw2 = (u32x4){PKW(pB1, 0), PKW(pB1, 2), PKW(pB1, 4), PKW(pB1, 6)}; pw3 = (u32x4){PKW(pB1, 8), PKW(pB1, 10), PKW(pB1, 12), PKW(pB1, 14)};
    SBAR(); pv(o, vb0 + sl_cur, PAF(0), PAF(1), PAF(2), PAF(3)); }
  #undef PKW
  #undef PAF
  #undef VFR
  #undef PIN
  #undef MX3
  #undef GAPA
  #undef GAPB
  #undef EX
  #undef VRD
  #undef KRD
  #undef QRD
  #undef STEP
  #undef ENDW
  { auto rr = __builtin_amdgcn_permlane32_swap(__float_as_uint(l_reg), __float_as_uint(l_reg), false, false); l_reg = __uint_as_float(rr[0]) + __uint_as_float(rr[1]); }
  if (hi == 0) wsf[32 + r32] = l_reg; asm volatile("s_waitcnt lgkmcnt(0)" ::: "memory");
  float rli[16];
  #pragma unroll
  for (int r = 0; r < 16; ++r) rli[r] = __builtin_amdgcn_rcpf(wsf[32 + crow(r, hi)]);
  bf16_t* Ow = Ob + (rowbase + q0 + wid * QBLK) * DMQ + h * D;
  { bf16_t* stg = (bf16_t*)(shm + LDS_OST) + wid * 2048;
    #pragma unroll
    for (int r = 0; r < 16; ++r) { const int orow = crow(r, hi);
      #pragma unroll
      for (int d0 = 0; d0 < 2; ++d0) stg[orow * 64 + d0 * 32 + r32] = (bf16_t)f2bf(o[d0][r] * rli[r]); }
    asm volatile("s_waitcnt lgkmcnt(0)" ::: "memory");
    #pragma unroll
    for (int i = 0; i < 4; ++i) { const int row = i * 8 + (lane >> 3), ch = lane & 7; const u32x4 v = *(const u32x4*)(stg + row * 64 + ch * 8); ATTN_STORE16(Ow + (long)row * DMQ + ch * 8, v); } }
  asm volatile("s_waitcnt lgkmcnt(0)\n\ts_barrier" ::: "memory");
  #undef DMA_K
  #undef DMA_V
  #undef CMASK
  #undef START
  #undef RESC
  #undef ROT
  #undef SELROW
  #undef NEGM_SET
}
#undef SBAR
#undef WAIT_BAR
}
__device__ __forceinline__ void conv_pass(Frame& F) {
    bf16_t* YAB = WSP(bf16_t, WS_YAB); const bf16_t* U = WSP(bf16_t, WS_U); const bf16_t* BG = WSP(bf16_t, WS_BG);
    const int stride = F.G * NTHREADS;
    for (int i0 = blockIdx.x * NTHREADS + F.tid; i0 < T * 64; i0 += 2 * stride) {
        u32x4 r2[2], r1[2], r0[2], rb[2];
#pragma unroll
        for (int q = 0; q < 2; ++q) { const int i = i0 + q * stride; const int t = i >> 6, c0 = (i & 63) * 8, pos = t & (S - 1);
            r2[q] = *(const u32x4*)(U + (size_t)t * 512 + c0); rb[q] = __builtin_nontemporal_load((const u32x4*)(BG + (size_t)t * 512 + c0));
            r1[q] = (pos >= 1) ? *(const u32x4*)(U + (size_t)(t - 1) * 512 + c0) : (u32x4){0u, 0u, 0u, 0u};
            r0[q] = (pos >= 2) ? *(const u32x4*)(U + (size_t)(t - 2) * 512 + c0) : (u32x4){0u, 0u, 0u, 0u}; }
#pragma unroll
        for (int q = 0; q < 2; ++q) { const int i = i0 + q * stride; const int t = i >> 6, c0 = (i & 63) * 8;
            float u0[8], u1[8], u2[8], bg[8], y[8]; unpack8(r2[q], u2); unpack8(r1[q], u1); unpack8(r0[q], u0); unpack8(rb[q], bg);
#pragma unroll
            for (int e4 = 0; e4 < 2; ++e4) { const f32x4 w0 = *(const f32x4*)(F.conv_w + c0 + 4 * e4), w1 = *(const f32x4*)(F.conv_w + 512 + c0 + 4 * e4), w2 = *(const f32x4*)(F.conv_w + 1024 + c0 + 4 * e4), cb = *(const f32x4*)(F.conv_b + c0 + 4 * e4);
#pragma unroll
                for (int e = 0; e < 4; ++e) y[4 * e4 + e] = bg[4 * e4 + e] * (w0[e] * u0[4 * e4 + e] + w1[e] * u1[4 * e4 + e] + w2[e] * u2[4 * e4 + e] + cb[e]); }
            st16(YAB + (size_t)t * 1024 + 512 + c0, pack8(y)); }
    }
}
__device__ __forceinline__ void s3_attn(Frame& F, char* lds_gen, bf16_t* obase) {
    const int vcu = (blockIdx.x % 8) * (F.G / 8) + blockIdx.x / 8;
    const int s = vcu & 7, pr = vcu >> 3;
#pragma unroll 1
    for (int i = 0; i < 4; ++i) {
        const int bh = 2 * pr + (i >> 1), qb = (i & 1) ? 15 - s : s;
        attn_body::attn_unit<8>(bh >> 3, bh & 7, qb, WSP(bf16_t, WS_YAB), obase, WSP(bf16_t, WS_K), WSP(bf16_t, WS_V), WSP(float, WS_KMEAN), lds_gen);
        if (!(i & 1)) { { int t_ = threadIdx.x; asm volatile("" : "+v"(t_)); F.tid = t_; F.lane = t_ & 63; }
            const int lo = X_NONEXP + (i >> 1) * (NE * 256);
            convert_items(F, lo, lo + NE * 256, blockIdx.x * NWAVES + F.wave, F.G * NWAVES);
            __syncthreads(); }
    }
}
__device__ __forceinline__ void s3_fast(Frame& F, char* lds_gen) { s3_attn(F, lds_gen, WSP(bf16_t, WS_YAB)); conv_pass(F); }

__device__ __forceinline__ void s4_simple(Frame& F) {
    LAS float* tile = (LAS float*)F.lds; LAS float* tile2 = tile + 64 * 65;
    const bf16_t* YAB = WSP(bf16_t, WS_YAB); const bf16_t* WP = WSP(bf16_t, WS_WP_T); const bf16_t* GT = WSP(bf16_t, WS_GATES);
    const int row = F.tid >> 3, seg = F.tid & 7;
    for (int it = blockIdx.x; it < 512 * 16; it += F.G) {
        const int rt = it >> 4, ct = it & 15, r0 = rt * 64, gr = r0 + row;
        const RowsLinear aa{YAB + (size_t)r0 * 1024, 1024}, ab{YAB + (size_t)r0 * 1024 + 512, 1024};
        const RowsLinear ba{WP + (size_t)(64 * ct) * 1024, 1024}, bb{WP + (size_t)(64 * ct) * 1024 + 512, 1024};
        sgemm_tile(tile, 512, aa, ba, F.wave, F.lane); sgemm_tile(tile2, 512, ab, bb, F.wave, F.lane); __syncthreads();
        float ga[8], gb[8], v[8];
        unpack8(*(const u32x4*)(GT + (size_t)gr * 2048 + 64 * ct + 8 * seg), ga); unpack8(*(const u32x4*)(GT + (size_t)gr * 2048 + 1024 + 64 * ct + 8 * seg), gb);
#pragma unroll
        for (int e = 0; e < 8; ++e) v[e] = ga[e] * tile[row * 65 + 8 * seg + e] + gb[e] * tile2[row * 65 + 8 * seg + e];
        *(u32x4*)(WSP(bf16_t, WS_H) + (size_t)gr * 1024 + 64 * ct + 8 * seg) = pack8(v);
        __syncthreads();
    }
}
__device__ __forceinline__ void s5_simple(Frame& F) {
    LAS float* tile = (LAS float*)F.lds;
    const bf16_t* MG = WSP(bf16_t, WS_H); const bf16_t* WO = WSP(bf16_t, WS_WO_T);
    const int row = F.tid >> 3, seg = F.tid & 7;
    for (int it = blockIdx.x; it < 512 * 16; it += F.G) {
        const int rt = it >> 4, ct = it & 15, r0 = rt * 64, gr = r0 + row, b = r0 / S;
        const RowsLinear aa{MG + (size_t)r0 * 1024, 1024}, bb{WO + (size_t)(64 * ct) * 1024, 1024};
        sgemm_tile(tile, 1024, aa, bb, F.wave, F.lane); __syncthreads();
        const float* ga1 = WSP(float, WS_MOD) + (size_t)b * NMOD + 2048 + 64 * ct + 8 * seg;
        const float* xr = F.x + (size_t)gr * D + 64 * ct + 8 * seg; float* orow = F.out + (size_t)gr * D + 64 * ct + 8 * seg;
#pragma unroll
        for (int e4 = 0; e4 < 2; ++e4) { const f32x4 xv = *(const f32x4*)(xr + 4 * e4), gv = *(const f32x4*)(ga1 + 4 * e4); f32x4 o;
#pragma unroll
            for (int e = 0; e < 4; ++e) o[e] = xv[e] + gv[e] * tile[row * 65 + 8 * seg + 4 * e4 + e];
            *(f32x4*)(orow + 4 * e4) = o; }
        __syncthreads();
    }
}

struct EpiG2 {
    static constexpr bool HAS_MID = true;
    const bf16_t* gates; bf16_t* merged;
    struct State {};
    __device__ __forceinline__ void mid(Acc& acc, const pg8::Unit& u, int wr, int wc, int fr, int fq, State&) const {
        int rl0 = wr * 64 + fr; const int ct = 32 * wc + 8 * fq; asm volatile("" : "+v"(rl0));
        u32x4 ra[2][4][2];
#pragma unroll
        for (int ai = 0; ai < 2; ++ai)
#pragma unroll
            for (int m = 0; m < 4; ++m) { const bf16_t* gp = gates + ((size_t)(u.pm * 4 + u.pn) * 256 + (size_t)(rl0 + 128 * ai + 16 * m)) * 256 + ct;
#pragma unroll
                for (int bj = 0; bj < 2; ++bj) ra[ai][m][bj] = *(const u32x4*)(gp + 128 * bj); }
        asm volatile("s_waitcnt vmcnt(0)" ::: "memory");
#pragma unroll
        for (int ai = 0; ai < 2; ++ai)
#pragma unroll
            for (int m = 0; m < 4; ++m)
#pragma unroll
                for (int bj = 0; bj < 2; ++bj) { f32x4 a0, a1; unpack8v(ra[ai][m][bj], a0, a1); acc[ai][bj][m][0] *= a0; acc[ai][bj][m][1] *= a1; }
    }
    __device__ __forceinline__ void operator()(Acc& acc, const pg8::Unit& u, int wr, int wc, int fr, int fq, State&) const {
        int rl0 = wr * 64 + fr; const int ct = 32 * wc + 8 * fq, c0 = u.pn * 256 + ct; asm volatile("" : "+v"(rl0)); const int row0 = u.pm * 256 + rl0;
        u32x4 gb[2][4][2];
#pragma unroll
        for (int ai = 0; ai < 2; ++ai)
#pragma unroll
            for (int m = 0; m < 4; ++m) { const bf16_t* gp = gates + (size_t)T * 1024 + ((size_t)(u.pm * 4 + u.pn) * 256 + (size_t)(rl0 + 128 * ai + 16 * m)) * 256 + ct;
#pragma unroll
                for (int bj = 0; bj < 2; ++bj) gb[ai][m][bj] = *(const u32x4*)(gp + 128 * bj); }
        asm volatile("s_waitcnt vmcnt(0)" ::: "memory");
#pragma unroll
        for (int ai = 0; ai < 2; ++ai)
#pragma unroll
            for (int m = 0; m < 4; ++m) { const size_t r = (size_t)(row0 + 128 * ai + 16 * m);
#pragma unroll
                for (int bj = 0; bj < 2; ++bj) { f32x4 b0, b1; unpack8v(gb[ai][m][bj], b0, b1);
                    *(u32x2*)((unsigned char*)merged + r * 1024 + c0 + 128 * bj) = pack8_fp8(acc[ai][bj][m][0] * b0, acc[ai][bj][m][1] * b1); } }
    }
};
__device__ __forceinline__ void s4_fast(Frame& F) {
    const pg8::DenseSched Sd{(const char*)(F.ws + WS_YAB), (const char*)(F.ws + WS_WP_T), T / 256, 4, 1024, F.G, (int)blockIdx.x};
    const EpiG2 E{WSP(bf16_t, WS_GATES), WSP(bf16_t, WS_H)};
    if (F.skip) pg8::gemm_phase<EpiG2, pg8::DenseSched, true>(F.lds, 1024, Sd, E); else pg8::gemm_phase<EpiG2, pg8::DenseSched>(F.lds, 1024, Sd, E);
}
struct EpiG3 {
    static constexpr bool HAS_MID = false;
    const float* x; bf16_t* x1; const float* mod;
    struct State {}; __device__ __forceinline__ void mid(Acc&, const pg8::Unit&, int, int, int, int, State&) const {}
    __device__ __forceinline__ void operator()(Acc& acc, const pg8::Unit& u, int wr, int wc, int fr, int fq, State& st) const {
        int row0 = u.pm * 256 + wr * 64 + fr; const int c0 = u.pn * 256 + 32 * wc + 8 * fq, b = u.pm >> 4; asm volatile("" : "+v"(row0));
        f32x4 gv[2][2];
#pragma unroll
        for (int bj = 0; bj < 2; ++bj)
#pragma unroll
            for (int n = 0; n < 2; ++n) gv[bj][n] = *(const f32x4*)(mod + (size_t)b * NMOD + 2048 + c0 + 128 * bj + 4 * n) * (1.f / W8_SCALE);
#pragma unroll
        for (int ai = 0; ai < 2; ++ai)
#pragma unroll
            for (int m = 0; m < 4; ++m) { const size_t off = (size_t)(row0 + 128 * ai + 16 * m) * D + c0;
#pragma unroll
                for (int bj = 0; bj < 2; ++bj) { const f32x4 x0 = __builtin_nontemporal_load((const f32x4*)(x + off + 128 * bj)), x1v = __builtin_nontemporal_load((const f32x4*)(x + off + 128 * bj + 4));
                    st16(x1 + off + 128 * bj, pack8v(x0 + gv[bj][0] * acc[ai][bj][m][0], x1v + gv[bj][1] * acc[ai][bj][m][1])); }
                if (m == 3) asm volatile("" ::: "memory"); }
    }
};
__device__ __forceinline__ void s5_fast(Frame& F) {
    const pg8::DenseSched8 Sd{(const char*)(F.ws + WS_H), (const char*)(F.ws + WS_WO_T), T / 256, 4, 1024, F.G, (int)blockIdx.x};
    const EpiG3 E{F.x, WSP(bf16_t, WS_X1), WSP(float, WS_MOD)};
    int Ko = D; asm volatile("" : "+s"(Ko));
    pg8::gemm_phase<EpiG3, pg8::DenseSched8>(F.lds, Ko, Sd, E);
}
struct MoeTab { const LAS int* cnt; const LAS int* tstart; const LAS int* tile_e; int nM; };
__device__ __forceinline__ MoeTab moe_table(Frame& F) {
    LAS int* cntL = (LAS int*)(F.lds + MISC_OFF + 1024); LAS int* ts = cntL + 32; LAS int* te = cntL + 96;
    if (F.tid < 32) cntL[F.tid] = (int)__hip_atomic_load(WSP(unsigned, WS_CTL) + CW_GCNT + 64 * F.tid, __ATOMIC_RELAXED, __HIP_MEMORY_SCOPE_AGENT);
    __syncthreads();
    if (F.tid == 0) { int pm = 0; for (int e = 0; e < 32; ++e) { ts[e] = pm; const int n = (cntL[e] + 255) >> 8; for (int i = 0; i < n; ++i) te[pm++] = e; } ts[32] = pm; }
    __syncthreads();
    return MoeTab{cntL, ts, te, ts[32]};
}
struct MoeUpSched {
    static constexpr bool GATHER = true, FP8 = true;
    const char* h2; const char* w13; MoeTab tb; const int* linfo; int G, c;
    __device__ __forceinline__ bool next(int i, pg8::Unit& u) const { if (!pg8::static_unit(i, G, c, tb.nM, 4, u.pm, u.pn)) return false;
        u.e = tb.tile_e[u.pm]; u.rbase = (u.pm - tb.tstart[u.e]) * 256; u.a = h2; u.b = w13 + ((size_t)u.e * 1024 + 256 * u.pn) * 1024; return true; }
    __device__ __forceinline__ int row_index(const pg8::Unit& u, int r) const { const int rank = u.rbase + r; return rank < tb.cnt[u.e] ? (linfo[(size_t)u.e * 65536 + rank] >> 1) : 0; }
};
struct EpiUp {
    static constexpr bool HAS_MID = false;
    bf16_t* hid; const float* lw; const LAS int* cnt;
    struct State {}; __device__ __forceinline__ void mid(Acc&, const pg8::Unit&, int, int, int, int, State&) const {}
    __device__ __forceinline__ void operator()(Acc& acc, const pg8::Unit& u, int wr, int wc, int fr, int fq, State& st) const {
        int rl0 = wr * 64 + fr; const int c0 = u.pn * 128 + 32 * wc + 8 * fq, n_e = cnt[u.e]; asm volatile("" : "+v"(rl0));
#pragma unroll
        for (int ai = 0; ai < 2; ++ai)
#pragma unroll
            for (int m = 0; m < 4; ++m) { const int rl = rl0 + 128 * ai + 16 * m, rank = u.rbase + rl; const float wt = rank < n_e ? 1.f : 0.f; f32x4 o[2];
#pragma unroll
                for (int n = 0; n < 2; ++n)
#pragma unroll
                    for (int e = 0; e < 4; ++e) { const float a = acc[ai][0][m][n][e] * (1.f / W8_SCALE), c = acc[ai][1][m][n][e] * (1.f / W8_SCALE); o[n][e] = a * __builtin_amdgcn_rcpf(1.f + __expf(-a)) * c * wt; }
                *(u32x2*)((unsigned char*)hid + (size_t)(u.pm * 256 + rl) * 512 + c0) = pack8_fp8(o[0], o[1]); }
    }
};
__device__ __forceinline__ void s8_fast(Frame& F) {
    const MoeTab tb = moe_table(F);
    const MoeUpSched Sd{(const char*)(F.ws + WS_H2), (const char*)(F.ws + WS_W13_T), tb, WSP(int, WS_LINFO), F.G, (int)blockIdx.x};
    const EpiUp E{WSP(bf16_t, WS_HID), WSP(float, WS_LW), tb.cnt};
    int Ku = D; asm volatile("" : "+s"(Ku));
    if (F.skip) pg8::gemm_phase<EpiUp, MoeUpSched, true>(F.lds, Ku, Sd, E); else pg8::gemm_phase<EpiUp, MoeUpSched>(F.lds, Ku, Sd, E);
    { int t_ = threadIdx.x; asm volatile("" : "+v"(t_)); F.tid = t_; F.lane = t_ & 63; }
    { const int units = tb.nM * 4, rem = units % F.G, nidle = (rem == 0) ? F.G : F.G - rem, me = (rem == 0) ? (int)blockIdx.x : (int)blockIdx.x - rem;
        if (me >= 0 && !F.skip) convert_items(F, X_W2, X_END, me * NWAVES + F.wave, nidle * NWAVES); }
}
struct MoeDownSched {
    static constexpr bool GATHER = false, FP8 = true;
    const char* hid; const char* w2; MoeTab tb; int G, c;
    __device__ __forceinline__ bool next(int i, pg8::Unit& u) const { if (!pg8::static_unit(i, G, c, tb.nM, 4, u.pm, u.pn)) return false;
        u.e = tb.tile_e[u.pm]; u.rbase = (u.pm - tb.tstart[u.e]) * 256; u.a = hid + (size_t)u.pm * 256 * 512; u.b = w2 + ((size_t)u.e * 1024 + 256 * u.pn) * 512; return true; }
    __device__ __forceinline__ int row_index(const pg8::Unit&, int) const { return 0; }
};
struct EpiDown {
    static constexpr bool HAS_MID = false;
    bf16_t* yslot; const int* linfo; const float* lw; const LAS int* cnt;
    struct State {}; __device__ __forceinline__ void mid(Acc&, const pg8::Unit&, int, int, int, int, State&) const {}
    __device__ __forceinline__ void operator()(Acc& acc, const pg8::Unit& u, int wr, int wc, int fr, int fq, State& st) const {
        int rl0 = wr * 64 + fr; const int c0 = u.pn * 256 + 32 * wc + 8 * fq, n_e = cnt[u.e]; asm volatile("" : "+v"(rl0));
        int info[2][4]; float wt[2][4];
#pragma unroll
        for (int ai = 0; ai < 2; ++ai)
#pragma unroll
            for (int m = 0; m < 4; ++m) { const int rank = u.rbase + rl0 + 128 * ai + 16 * m, rc = rank < n_e ? rank : 0;
                info[ai][m] = linfo[(size_t)u.e * 65536 + rc]; wt[ai][m] = lw[(size_t)u.e * 65536 + rc] * (1.f / W8_SCALE); }
#pragma unroll
        for (int ai = 0; ai < 2; ++ai)
#pragma unroll
            for (int m = 0; m < 4; ++m) { const int rank = u.rbase + rl0 + 128 * ai + 16 * m;
                if (rank < n_e) {
#pragma unroll
                    for (int bj = 0; bj < 2; ++bj) st16(yslot + (size_t)info[ai][m] * 1024 + c0 + 128 * bj, pack8v(acc[ai][bj][m][0] * wt[ai][m], acc[ai][bj][m][1] * wt[ai][m])); } }
    }
};
__device__ __forceinline__ void s9_fast(Frame& F) {
    const MoeTab tb = moe_table(F);
    const MoeDownSched Sd{(const char*)(F.ws + WS_HID), (const char*)(F.ws + WS_W2_T), tb, F.G, (int)blockIdx.x};
    const EpiDown E{WSP(bf16_t, WS_YSLOT), WSP(int, WS_LINFO), WSP(float, WS_LW), tb.cnt};
    int Kd = DE; asm volatile("" : "+s"(Kd));
    if (F.skip) pg8::gemm_phase<EpiDown, MoeDownSched, true>(F.lds, Kd, Sd, E); else pg8::gemm_phase<EpiDown, MoeDownSched>(F.lds, Kd, Sd, E);
}

__device__ __forceinline__ void s6_router(Frame& F) {
    constexpr int WROW = 1032;
    LAS bf16_t* WT = (LAS bf16_t*)F.lds;
    LAS float* gsL = (LAS float*)(F.lds + 48 * WROW * 2);
    LAS float* shL = gsL + 1024;
    LAS float* biasL = shL + 1024;
    LAS float* lgt = biasL + 64;
    LAS int* cnt = (LAS int*)(F.lds + MISC_OFF + 256);
    LAS int* baseL = cnt + 32; LAS int* runL = cnt + 64; LAS int* eidL = cnt + 128; LAS float* ewL = (LAS float*)(cnt + 384);
    const int b = blockIdx.x >> 5;
    const float* mod = WSP(float, WS_MOD) + (size_t)b * NMOD;
    const float* W36 = WSP(float, WS_W36T);
    for (int i = F.tid; i < 36 * 256; i += NTHREADS) { const int jj = i >> 8, k4 = (i & 255) * 4; const f32x4 w = *(const f32x4*)(W36 + jj * 1024 + k4);
        u32x2 p; p.x = pk2(w.x, w.y); p.y = pk2(w.z, w.w); *(LAS u32x2*)(WT + jj * WROW + k4) = p; }
    for (int i = F.tid; i < 12 * 256; i += NTHREADS) { const int jj = 36 + (i >> 8), k4 = (i & 255) * 4; *(LAS u32x2*)(WT + jj * WROW + k4) = (u32x2){0u, 0u}; }
    if (F.tid < 256) { const int col = 4 * F.tid; const f32x4 g = *(const f32x4*)(F.g2 + col), s_ = *(const f32x4*)(mod + 4096 + col); *(LAS f32x4*)(gsL + col) = g * (s_ + 1.0f); *(LAS f32x4*)(shL + col) = *(const f32x4*)(mod + 3072 + col); }
    if (F.tid < 32) cnt[F.tid] = 0;
    __syncthreads();
    for (int jj = F.wave; jj < 36; jj += NWAVES) { float a = 0.f;
#pragma unroll
        for (int i = 0; i < 16; ++i) a += shL[F.lane + 64 * i] * W36[jj * 1024 + F.lane + 64 * i];
        a = wave_sum(a); if (F.lane == 0) biasL[jj] = a + ((jj < 4) ? F.b_rg[jj] : F.b_re[jj - 4]); }
    __syncthreads();
    const int fr = F.lane & 15, fq = F.lane >> 4, row0 = (blockIdx.x * NWAVES + F.wave) * 16, r = row0 + fr;
    const bf16_t* xr = WSP(bf16_t, WS_X1) + (size_t)r * D + 8 * fq;
    f32x4 D0 = {0.f, 0.f, 0.f, 0.f}, D1 = D0, D2 = D0; float ss = 0.f;
#pragma unroll 1
    for (int kb = 0; kb < 8; ++kb) {
        u32x4 xa[4];
#pragma unroll
        for (int i = 0; i < 4; ++i) xa[i] = *(const u32x4*)(xr + 32 * (4 * kb + i));
#pragma unroll
        for (int i = 0; i < 4; ++i) { const int k0 = 32 * (4 * kb + i) + 8 * fq;
            f32x4 a0, a1; unpack8v(xa[i], a0, a1);
            ss += (a0.x * a0.x + a0.y * a0.y) + (a0.z * a0.z + a0.w * a0.w) + (a1.x * a1.x + a1.y * a1.y) + (a1.z * a1.z + a1.w * a1.w);
            a0 *= *(const LAS f32x4*)(gsL + k0); a1 *= *(const LAS f32x4*)(gsL + k0 + 4);
            const bf16x8 A = __builtin_bit_cast(bf16x8, pack8v(a0, a1));
            const bf16x8 B0 = *(const LAS bf16x8*)(WT + fr * WROW + k0), B1 = *(const LAS bf16x8*)(WT + (16 + fr) * WROW + k0), B2 = *(const LAS bf16x8*)(WT + (32 + fr) * WROW + k0);
            D0 = __builtin_amdgcn_mfma_f32_16x16x32_bf16(A, B0, D0, 0, 0, 0);
            D1 = __builtin_amdgcn_mfma_f32_16x16x32_bf16(A, B1, D1, 0, 0, 0);
            D2 = __builtin_amdgcn_mfma_f32_16x16x32_bf16(A, B2, D2, 0, 0, 0); }
    }
    ss += __shfl_xor(ss, 16); ss += __shfl_xor(ss, 32);
    const float rinv = rsqrtf(ss * (1.f / D) + EPS);
    { int t2 = threadIdx.x; asm volatile("" : "+v"(t2)); F.lane = t2 & 63; }
    const int fr_ = F.lane & 15, fq_ = F.lane >> 4;
    {
        LAS float* lw = lgt + F.wave * 16 * 37;
#pragma unroll
        for (int reg = 0; reg < 4; ++reg) { const float rv = __shfl(rinv, 4 * fq_ + reg); const int tk = 4 * fq_ + reg;
            lw[tk * 37 + fr_] = D0[reg] * rv + biasL[fr_]; lw[tk * 37 + 16 + fr_] = D1[reg] * rv + biasL[16 + fr_];
            if (fr_ < 4) lw[tk * 37 + 32 + fr_] = D2[reg] * rv + biasL[32 + fr_]; }
    }
    {
        const int r_ = row0 + fr_; const bf16_t* xr_ = WSP(bf16_t, WS_X1) + (size_t)r_ * D + 8 * fq_;
        unsigned char* o = WSP(unsigned char, WS_H2) + (size_t)r_ * D + 8 * fq_;
#pragma unroll 1
        for (int kb = 0; kb < 8; ++kb) {
            u32x4 xa[4];
#pragma unroll
            for (int i = 0; i < 4; ++i) xa[i] = *(const u32x4*)(xr_ + 32 * (4 * kb + i));
#pragma unroll
            for (int i = 0; i < 4; ++i) { const int k0 = 32 * (4 * kb + i) + 8 * fq_; f32x4 a0, a1; unpack8v(xa[i], a0, a1);
                const f32x4 h0 = a0 * rinv * *(const LAS f32x4*)(gsL + k0) + *(const LAS f32x4*)(shL + k0), h1 = a1 * rinv * *(const LAS f32x4*)(gsL + k0 + 4) + *(const LAS f32x4*)(shL + k0 + 4);
                *(u32x2*)(o + 32 * (4 * kb + i)) = pack8_fp8(h0, h1); }
        }
    }
    if (F.lane < 16) {
        const int t = row0 + F.lane; const LAS float* lw = lgt + (F.wave * 16 + F.lane) * 37;
        float lg[36];
#pragma unroll
        for (int jj = 0; jj < 36; ++jj) lg[jj] = lw[jj];
        int gi = 0; float gm = lg[0];
#pragma unroll
        for (int i = 1; i < 4; ++i) if (lg[i] > gm) { gm = lg[i]; gi = i; }
        float den = 0.f;
#pragma unroll
        for (int i = 0; i < 4; ++i) den += __expf(lg[i] - gm);
        const float gw_ = 1.f / den;
        float v1 = -INFINITY, v2 = -INFINITY; int e1 = 0, e2 = 0;
#pragma unroll
        for (int i = 0; i < 8; ++i) { const float el = (gi == 0) ? lg[4 + i] : (gi == 1) ? lg[12 + i] : (gi == 2) ? lg[20 + i] : lg[28 + i];
            const bool c1 = el > v1, c2 = el > v2;
            v2 = c1 ? v1 : (c2 ? el : v2); e2 = c1 ? e1 : (c2 ? i : e2); v1 = c1 ? el : v1; e1 = c1 ? i : e1; }
        const float p1 = 1.f / (1.f + __expf(v2 - v1)), p2 = 1.f - p1;
        const int id1 = gi * 8 + e1, id2 = gi * 8 + e2;
        const int la = 2 * (F.wave * 16 + F.lane);
        eidL[la] = id1; eidL[la + 1] = id2; ewL[la] = p1 * gw_; ewL[la + 1] = p2 * gw_;
        lds_add(&cnt[id1], 1); lds_add(&cnt[id2], 1);
    }
    __syncthreads();
    if (F.tid < 32) { baseL[F.tid] = (int)__hip_atomic_fetch_add(WSP(unsigned, WS_CTL) + CW_GCNT + 64 * F.tid, (unsigned)cnt[F.tid], __ATOMIC_RELAXED, __HIP_MEMORY_SCOPE_AGENT); runL[F.tid] = 0; }
    __syncthreads();
    if (F.tid < 256) { const int e = eidL[F.tid]; const int pos = baseL[e] + lds_add(&runL[e], 1);
        WSP(int, WS_LINFO)[(size_t)e * 65536 + pos] = 2 * (blockIdx.x * 128) + F.tid; WSP(float, WS_LW)[(size_t)e * 65536 + pos] = ewL[F.tid]; }
    __syncthreads();
}

__device__ __forceinline__ void s7_lists(Frame& F) {
    LAS int* sm = (LAS int*)F.lds;
    const int* bc = WSP(int, WS_BCNT);
    if (F.tid < 32) { int tot = 0, base = 0; for (int bb = 0; bb < 256; ++bb) { const int c = bc[bb * 32 + F.tid]; if (bb < (int)blockIdx.x) base += c; tot += c; }
        sm[F.tid] = tot; sm[32 + F.tid] = base; sm[96 + F.tid] = 0; }
    __syncthreads();
    if (F.tid == 0) { int ps = 0; for (int e = 0; e < 32; ++e) { sm[64 + e] = ps; ps += (sm[e] + 255) & ~255; }
        if (blockIdx.x == 0) { int* te = WSP(int, WS_TILEE); int pm = 0; for (int e = 0; e < 32; ++e) { const int n = (sm[e] + 255) >> 8; for (int i = 0; i < n; ++i) te[1 + pm++] = e; } te[0] = pm; } }
    __syncthreads();
    int* atok = WSP(int, WS_ATOK); int* ainfo = WSP(int, WS_AINFO); float* aw = WSP(float, WS_AW);
    if (F.tid < 256) { const int a = blockIdx.x * 256 + F.tid;
        const int e = WSP(int, WS_EID)[a]; const int rank = lds_add(&sm[96 + e], 1); const int pos = sm[64 + e] + sm[32 + e] + rank;
        atok[pos] = a >> 1; ainfo[pos] = a; aw[pos] = WSP(float, WS_EW)[a]; }
    if (blockIdx.x < 32) { const int e = blockIdx.x; const int lo = sm[64 + e] + sm[e], hi = sm[64 + e] + ((sm[e] + 255) & ~255);
        for (int p = lo + F.tid; p < hi; p += NTHREADS) { atok[p] = 0; ainfo[p] = -1; aw[p] = 0.f; } }
}

struct RowsGather { const bf16_t* base; const int* idx; __device__ __forceinline__ const bf16_t* operator()(int r) const { return base + (size_t)idx[r] * 1024; } };
__device__ __forceinline__ void s8_simple(Frame& F) {
    LAS float* tile = (LAS float*)F.lds; LAS float* tile2 = tile + 64 * 65;
    const int* te = WSP(int, WS_TILEE); const int nmt = te[0];
    const int row = F.tid >> 3, seg = F.tid & 7;
    for (int it = blockIdx.x; it < nmt * 4 * 8; it += F.G) {
        const int rt = it >> 3, ct = it & 7, e = te[1 + (rt >> 2)], pos0 = 64 * rt, hc = 64 * ct;
        const RowsGather ar{WSP(bf16_t, WS_H2), WSP(int, WS_ATOK) + pos0};
        const bf16_t* wb = WSP(bf16_t, WS_W13_T) + ((size_t)e * 1024 + 256 * (hc >> 7) + (hc & 127)) * 1024;
        const RowsLinear b1{wb, 1024}, b3{wb + (size_t)128 * 1024, 1024};
        sgemm_tile(tile, 1024, ar, b1, F.wave, F.lane); sgemm_tile(tile2, 1024, ar, b3, F.wave, F.lane); __syncthreads();
        const float wt = WSP(float, WS_AW)[pos0 + row]; float v[8];
#pragma unroll
        for (int e8 = 0; e8 < 8; ++e8) { const float a = tile[row * 65 + 8 * seg + e8], c = tile2[row * 65 + 8 * seg + e8]; v[e8] = (a / (1.f + __expf(-a))) * c * wt; }
        *(u32x4*)(WSP(bf16_t, WS_HID) + (size_t)(pos0 + row) * 512 + hc + 8 * seg) = pack8(v);
        __syncthreads();
    }
}
__device__ __forceinline__ void s9_simple(Frame& F) {
    LAS float* tile = (LAS float*)F.lds;
    const int* te = WSP(int, WS_TILEE); const int nmt = te[0];
    const int row = F.tid >> 3, seg = F.tid & 7;
    for (int it = blockIdx.x; it < nmt * 4 * 16; it += F.G) {
        const int rt = it >> 4, ct = it & 15, e = te[1 + (rt >> 2)], pos0 = 64 * rt;
        const RowsLinear ar{WSP(bf16_t, WS_HID) + (size_t)pos0 * 512, 512};
        const RowsLinear br{WSP(bf16_t, WS_W2_T) + ((size_t)e * 1024 + 64 * ct) * 512, 512};
        sgemm_tile(tile, 512, ar, br, F.wave, F.lane); __syncthreads();
        const int info = WSP(int, WS_AINFO)[pos0 + row];
        if (info >= 0) { float v[8];
#pragma unroll
            for (int e8 = 0; e8 < 8; ++e8) v[e8] = tile[row * 65 + 8 * seg + e8];
            *(u32x4*)(WSP(bf16_t, WS_YSLOT) + (size_t)info * 1024 + 64 * ct + 8 * seg) = pack8(v); }
        __syncthreads();
    }
}
__device__ __forceinline__ void s10_combine(Frame& F) {
    const bf16_t* Y = WSP(bf16_t, WS_YSLOT); const bf16_t* X1 = WSP(bf16_t, WS_X1);
    const int stride = F.G * NTHREADS;
    for (int i0 = blockIdx.x * NTHREADS + F.tid; i0 < T * 128; i0 += 2 * stride) {
        u32x4 ya[2], yb[2], xx[2]; f32x4 g0[2], g1[2];
#pragma unroll
        for (int q = 0; q < 2; ++q) { const int i = i0 + q * stride; const int t = i >> 7, c0 = (i & 127) * 8, b = t / S;
            ya[q] = __builtin_nontemporal_load((const u32x4*)(Y + (size_t)(2 * t) * 1024 + c0)); yb[q] = __builtin_nontemporal_load((const u32x4*)(Y + (size_t)(2 * t + 1) * 1024 + c0)); xx[q] = __builtin_nontemporal_load((const u32x4*)(X1 + (size_t)t * D + c0));
            const float* ga2 = WSP(float, WS_MOD) + (size_t)b * NMOD + 5120 + c0; g0[q] = *(const f32x4*)ga2; g1[q] = *(const f32x4*)(ga2 + 4); }
#pragma unroll
        for (int q = 0; q < 2; ++q) { const int i = i0 + q * stride; const int t = i >> 7, c0 = (i & 127) * 8;
            f32x4 y0a, y0b, y1a, y1b, xa, xb; unpack8v(ya[q], y0a, y0b); unpack8v(yb[q], y1a, y1b); unpack8v(xx[q], xa, xb);
            float* o = F.out + (size_t)t * D + c0;
            __builtin_nontemporal_store(xa + g0[q] * (y0a + y1a), (f32x4*)o); __builtin_nontemporal_store(xb + g1[q] * (y0b + y1b), (f32x4*)(o + 4)); }
    }
}

constexpr int N_PHASES = 11;
struct Args { const float* in[21]; float* out; unsigned char* ws; int ph_lo, ph_hi; };
__global__ void __launch_bounds__(NTHREADS, 2) mega_fwd(Args args) {
    extern __shared__ __attribute__((aligned(16))) unsigned char lds_raw[];
    Frame F;
    F.lds = (LAS unsigned char*)lds_raw;
    F.tid = threadIdx.x; F.lane = F.tid & 63; F.wave = __builtin_amdgcn_readfirstlane(F.tid >> 6); F.G = gridDim.x; F.skip = 0;
    F.x = args.in[0]; F.c = args.in[1]; F.w_ada = args.in[2]; F.b_ada = args.in[3]; F.g1 = args.in[4]; F.g2 = args.in[5]; F.w_in = args.in[6]; F.g_q = args.in[7]; F.g_k = args.in[8];
    F.conv_w = args.in[9]; F.conv_b = args.in[10]; F.w_pa = args.in[11]; F.w_pb = args.in[12]; F.w_o = args.in[13]; F.w_rg = args.in[14]; F.b_rg = args.in[15]; F.w_re = args.in[16]; F.b_re = args.in[17];
    F.w1 = args.in[18]; F.w3 = args.in[19]; F.w2 = args.in[20]; F.out = args.out; F.ws = args.ws;
    volatile LAS unsigned* MISC = (volatile LAS unsigned*)(F.lds + MISC_OFF);
    if (F.tid < 64) MISC[F.tid] = 0u;
    __syncthreads();
    XcdBarrier bar = xcd_barrier_post((unsigned*)(F.ws + WS_CTL) + CW_BAR, MISC + 8);
    const int lo = args.ph_lo, hi = args.ph_hi;
    unsigned long long pst0 = 0, pst1 = 0;
#define PHASE(k, body) if (lo <= (k) && (k) < hi) { if (PROBE_PHASE == (k)) pst0 = __builtin_amdgcn_s_memrealtime(); for (int rep_ = 0; rep_ < 1 + ((REPEAT_MASK >> (k)) & 1); ++rep_) { { int t_ = threadIdx.x; asm volatile("" : "+v"(t_)); F.tid = t_; F.lane = t_ & 63; } body; __syncthreads(); } if ((NOEPI_MASK >> (k)) & 1) { int s_ = 1; asm volatile("" : "+s"(s_)); F.skip = s_; { int t_ = threadIdx.x; asm volatile("" : "+v"(t_)); F.tid = t_; F.lane = t_ & 63; } body; __syncthreads(); F.skip = 0; } if ((k) + 1 < hi) xcd_barrier(bar); if (PROBE_PHASE == (k)) pst1 = __builtin_amdgcn_s_memrealtime(); }
    PHASE(0, s0_prologue(F); wait_mod(F); s1_norm1(F))
    PHASE(2, s2_fast(F))
    PHASE(3, s3_fast(F, (char*)lds_raw))
    PHASE(4, s4_fast(F))
    PHASE(5, s5_fast(F))
    PHASE(6, s6_router(F))
    PHASE(8, s8_fast(F))
    PHASE(9, s9_fast(F))
    PHASE(10, s10_combine(F))
#undef PHASE
    if (PROBE_PHASE >= 0 && blockIdx.x == 0) { const unsigned long long t0 = __builtin_amdgcn_s_memrealtime(), dt = pst1 - pst0; while (__builtin_amdgcn_s_memrealtime() - t0 < dt) __builtin_amdgcn_s_sleep(8); }
}

extern "C" void kernel_launch(void* const* d_in, const int* in_sizes, int n_in, void* d_out, int out_size, void* d_ws, size_t ws_size, hipStream_t stream) {
    static int grid = 0;
    if (grid == 0) {
        if (n_in != 21 || in_sizes[0] != T * D || out_size != T * D || ws_size < WS_END) { fprintf(stderr, "kernel_launch: unexpected shapes (n_in %d, in0 %d, out %d, ws %zu); nothing launched\n", n_in, n_in > 0 ? in_sizes[0] : -1, out_size, ws_size); grid = -1; return; }
        int dev = 0, cus = 0, per_cu = 0;
        if (hipGetDevice(&dev) != hipSuccess || hipDeviceGetAttribute(&cus, hipDeviceAttributeMultiprocessorCount, dev) != hipSuccess) { grid = -1; return; }
        if (hipFuncSetAttribute((const void*)mega_fwd, hipFuncAttributeMaxDynamicSharedMemorySize, LDS_BYTES) != hipSuccess) { fprintf(stderr, "kernel_launch: hipFuncSetAttribute failed\n"); grid = -1; return; }
        if (hipOccupancyMaxActiveBlocksPerMultiprocessor(&per_cu, (const void*)mega_fwd, NTHREADS, LDS_BYTES) != hipSuccess || per_cu < 1) { fprintf(stderr, "kernel_launch: occupancy query says %d blocks per CU\n", per_cu); per_cu = 1; }
        (void)hipGetLastError();
        if (cus < 256) { fprintf(stderr, "kernel_launch: built for a 256-CU device, found %d CUs; nothing launched\n", cus); grid = -1; return; }
        grid = 256;
    }
    if (grid < 0) return;
    (void)hipMemsetAsync((char*)d_ws + WS_CTL, 0, CTL_ZERO_BYTES, stream);
    Args a{};
    for (int i = 0; i < 21; ++i) a.in[i] = (const float*)d_in[i];
    a.out = (float*)d_out; a.ws = (unsigned char*)d_ws; a.ph_lo = 0; a.ph_hi = N_PHASES;
    hipLaunchKernelGGL(mega_fwd, dim3(grid), dim3(NTHREADS), LDS_BYTES, stream, a);
}
```
